# Optimizing an MI355X kernel written in HIP

```python
import math
import jax, jax.numpy as jnp
from jax import lax
import numpy as np

D_MODEL = 1024
BATCH = 8
SEQ = 4096
DEPTH = 4

GRID_W = 64
CTX_LEN = 256
EPS = 1e-6
ROPE_THETA = 10000.0
NEG = -1e30

HEAD_DIM = 64
BLOCK = 128
WINDOW = 128
FOURIER_DIM = D_MODEL // 2
FOURIER_GROUPS = 4
FOURIER_GROUP_DIM = FOURIER_DIM // FOURIER_GROUPS
WIN_HEADS = (D_MODEL // 2) // HEAD_DIM
WIN_KV_HEADS = WIN_HEADS // 4
MIX_IN_DIM = FOURIER_DIM + (WIN_HEADS + 2 * WIN_KV_HEADS) * HEAD_DIM
DIFF_HEADS = D_MODEL // (2 * HEAD_DIM)
FFN_DIM = 2816
N_EXPERTS = 8
TOP_K = 2
EXPERT_DIM = 7 * D_MODEL // 2

kernel_name = "hybrid_fourier_window_diffattn_moe_dit"


def rmsnorm(x, g):
    xf = x.astype(jnp.float32)
    y = xf * lax.rsqrt(jnp.mean(xf * xf, axis=-1, keepdims=True) + EPS)
    return (y * g.astype(jnp.float32)).astype(x.dtype)


def modulate(x, g, shift, scale):
    return rmsnorm(x, g) * (1 + scale) + shift


def rope_tables(rows_count):
    rows = jnp.repeat(jnp.arange(rows_count), GRID_W).astype(jnp.float32)
    cols = jnp.tile(jnp.arange(GRID_W), rows_count).astype(jnp.float32)
    axis_dim = HEAD_DIM // 2
    inv = ROPE_THETA ** (-jnp.arange(0, axis_dim, 2, dtype=jnp.float32) / axis_dim)
    ar = rows[:, None] * inv
    ac = cols[:, None] * inv
    return (jnp.cos(ar)[:, None, :], jnp.sin(ar)[:, None, :],
            jnp.cos(ac)[:, None, :], jnp.sin(ac)[:, None, :])


def rope_axis(p, cos, sin):
    p1, p2 = jnp.split(p, 2, axis=-1)
    return jnp.concatenate([p1 * cos - p2 * sin, p2 * cos + p1 * sin], axis=-1)


def apply_rope2d(x, rope):
    cos_r, sin_r, cos_c, sin_c = rope
    half = x.shape[-1] // 2
    out = jnp.concatenate([rope_axis(x[..., :half], cos_r, sin_r),
                           rope_axis(x[..., half:], cos_c, sin_c)], axis=-1)
    return out.astype(x.dtype)


def fourier_mix(u):
    uf = u.astype(jnp.float32)
    return jnp.real(jnp.fft.fft2(uf, axes=(1, 3), norm="ortho")).astype(u.dtype)


def sink_column(sink, lead_shape, hkv, g):
    s = sink.astype(jnp.float32).reshape((1,) * (len(lead_shape) - 3) + (hkv, g, 1, 1))
    return jnp.broadcast_to(s, lead_shape + (1,))


def window_attention(q, k, v, kc, vc, sink):
    B, L, Hq, d = q.shape
    Hkv = k.shape[2]
    G = Hq // Hkv
    C = kc.shape[1]
    nb = L // BLOCK
    scale = d ** -0.5
    qb = q.reshape(B, nb, BLOCK, Hkv, G, d)
    pad = ((0, 0), (BLOCK, BLOCK), (0, 0), (0, 0))
    kp = jnp.pad(k, pad).reshape(B, nb + 2, BLOCK, Hkv, d)
    vp = jnp.pad(v, pad).reshape(B, nb + 2, BLOCK, Hkv, d)
    kw = jnp.concatenate([kp[:, :-2], kp[:, 1:-1], kp[:, 2:]], axis=2)
    vw = jnp.concatenate([vp[:, :-2], vp[:, 1:-1], vp[:, 2:]], axis=2)
    blk = jnp.arange(nb)[:, None, None]
    qabs = blk * BLOCK + jnp.arange(BLOCK)[None, :, None]
    kabs = (blk - 1) * BLOCK + jnp.arange(3 * BLOCK)[None, None, :]
    valid = (jnp.abs(qabs - kabs) <= WINDOW) & (kabs >= 0) & (kabs < L)
    s_loc = jnp.einsum('bnqhgd,bnkhd->bnhgqk', qb, kw).astype(jnp.float32) * scale
    s_loc = jnp.where(valid[None, :, None, None], s_loc, NEG)
    s_ctx = jnp.einsum('bnqhgd,bkhd->bnhgqk', qb, kc).astype(jnp.float32) * scale
    s_sink = sink_column(sink, s_loc.shape[:-1], Hkv, G)
    p = jax.nn.softmax(jnp.concatenate([s_ctx, s_loc, s_sink], axis=-1), axis=-1)
    p_ctx = p[..., :C].astype(v.dtype)
    p_loc = p[..., C:C + 3 * BLOCK].astype(v.dtype)
    o = (jnp.einsum('bnhgqk,bkhd->bnqhgd', p_ctx, vc)
         + jnp.einsum('bnhgqk,bnkhd->bnqhgd', p_loc, vw))
    return o.reshape(B, L, Hq * d)


def context_gqa_attention(q, k, v, sink):
    B, C, Hq, d = q.shape
    Hkv = k.shape[2]
    G = Hq // Hkv
    qg = q.reshape(B, C, Hkv, G, d)
    s = jnp.einsum('bqhgd,bkhd->bhgqk', qg, k).astype(jnp.float32) * (d ** -0.5)
    s_sink = sink_column(sink, s.shape[:-1], Hkv, G)
    p = jax.nn.softmax(jnp.concatenate([s, s_sink], axis=-1), axis=-1)[..., :C]
    o = jnp.einsum('bhgqk,bkhd->bqhgd', p.astype(v.dtype), v)
    return o.reshape(B, C, Hq * d)


def fourier_window_mixer(hx, hc, w_in, w_out, sink, rope, need_ctx):
    def split_proj(h):
        B, L, _ = h.shape
        z = h @ w_in
        o1 = FOURIER_DIM
        o2 = o1 + WIN_HEADS * HEAD_DIM
        o3 = o2 + WIN_KV_HEADS * HEAD_DIM
        f = z[..., :o1].reshape(B, L, FOURIER_GROUPS, FOURIER_GROUP_DIM)
        q = z[..., o1:o2].reshape(B, L, WIN_HEADS, HEAD_DIM)
        k = z[..., o2:o3].reshape(B, L, WIN_KV_HEADS, HEAD_DIM)
        v = z[..., o3:].reshape(B, L, WIN_KV_HEADS, HEAD_DIM)
        return f, q, k, v
    fx, qx, kx, vx = split_proj(hx)
    fc, qc, kc, vc = split_proj(hc)
    B, L, _ = hx.shape
    qx = apply_rope2d(qx, rope)
    kx = apply_rope2d(kx, rope)
    ox = jnp.concatenate([fourier_mix(fx).reshape(B, L, FOURIER_DIM),
                          window_attention(qx, kx, vx, kc, vc, sink)], axis=-1) @ w_out
    if not need_ctx:
        return ox, None
    C = hc.shape[1]
    oc = jnp.concatenate([fourier_mix(fc).reshape(B, C, FOURIER_DIM),
                          context_gqa_attention(qc, kc, vc, sink)], axis=-1) @ w_out
    return ox, oc


def diff_attend(q, k, v, lam):
    s = jnp.einsum('bqhcd,bkhcd->bhcqk', q, k).astype(jnp.float32) * (q.shape[-1] ** -0.5)
    p = jax.nn.softmax(s, axis=-1)
    w = p[:, :, 0] - lam * p[:, :, 1]
    return jnp.einsum('bhqk,bkhe->bqhe', w.astype(v.dtype), v)


def diff_mixer(hx, hc, w_qkv, w_out, lam_vec, subln_g, lam_init, rope, need_ctx):
    def proj(h, use_rope):
        B, L, _ = h.shape
        q, k, v = jnp.split(h @ w_qkv, 3, axis=-1)
        q = q.reshape(B, L, 2 * DIFF_HEADS, HEAD_DIM)
        k = k.reshape(B, L, 2 * DIFF_HEADS, HEAD_DIM)
        if use_rope:
            q = apply_rope2d(q, rope)
            k = apply_rope2d(k, rope)
        q = q.reshape(B, L, DIFF_HEADS, 2, HEAD_DIM)
        k = k.reshape(B, L, DIFF_HEADS, 2, HEAD_DIM)
        v = v.reshape(B, L, DIFF_HEADS, 2 * HEAD_DIM)
        return q, k, v
    lv = lam_vec.astype(jnp.float32)
    lam = jnp.exp(jnp.sum(lv[0] * lv[1])) - jnp.exp(jnp.sum(lv[2] * lv[3])) + lam_init
    qx, kx, vx = proj(hx, True)
    qc, kc, vc = proj(hc, False)
    B, L, _ = hx.shape
    nb = L // BLOCK
    k_all = jnp.concatenate([kc, kx], axis=1)
    v_all = jnp.concatenate([vc, vx], axis=1)
    qb = jnp.moveaxis(qx.reshape(B, nb, BLOCK, DIFF_HEADS, 2, HEAD_DIM), 1, 0)
    ob = lax.map(lambda qblk: diff_attend(qblk, k_all, v_all, lam), qb)
    ox = jnp.moveaxis(ob, 0, 1).reshape(B, L, DIFF_HEADS, 2 * HEAD_DIM)
    ox = (rmsnorm(ox, subln_g) * (1.0 - lam_init)).reshape(B, L, D_MODEL) @ w_out
    if not need_ctx:
        return ox, None
    C = hc.shape[1]
    oc = diff_attend(qc, kc, vc, lam)
    oc = (rmsnorm(oc, subln_g) * (1.0 - lam_init)).reshape(B, C, D_MODEL) @ w_out
    return ox, oc


def swiglu(h, w_in, w_out):
    g, u = jnp.split(h @ w_in, 2, axis=-1)
    return (jax.nn.silu(g) * u) @ w_out


def moe_swiglu(h, router_w, w_in, w_out):
    logits = jnp.einsum('btd,de->bte', h, router_w).astype(jnp.float32)
    top_vals, top_idx = lax.top_k(logits, TOP_K)
    gates = jax.nn.softmax(top_vals, axis=-1)
    combine = jnp.sum(jax.nn.one_hot(top_idx, N_EXPERTS, dtype=jnp.float32) * gates[..., None], axis=-2)
    out = jnp.zeros_like(h)
    for e in range(N_EXPERTS):
        out = out + combine[..., e:e + 1].astype(h.dtype) * swiglu(h, w_in[e], w_out[e])
    return out


def lambda_init_fn(layer):
    return 0.8 - 0.6 * math.exp(-0.3 * layer)


def setup_inputs(seed: int = 0) -> dict:
    key = jax.random.key(seed)
    ks = jax.random.split(key, 20)
    n_even = (DEPTH + 1) // 2
    n_odd = DEPTH // 2
    f32 = jnp.float32

    def w(k, shape, fan_in, gain=1.0):
        return jax.random.normal(k, shape, f32) * (gain * fan_in ** -0.5)

    return {
        "x": jax.random.normal(ks[0], (BATCH, SEQ, D_MODEL), f32),
        "c": jax.random.normal(ks[1], (BATCH, D_MODEL), f32),
        "ctx": jax.random.normal(ks[2], (BATCH, CTX_LEN, D_MODEL), f32),
        "c_ctx": jax.random.normal(ks[3], (D_MODEL,), f32),
        "ada_w": w(ks[4], (DEPTH, D_MODEL, 6 * D_MODEL), D_MODEL, 0.5),
        "ada_b": 0.01 * jax.random.normal(ks[5], (DEPTH, 6 * D_MODEL), f32),
        "norm_g": 1.0 + 0.01 * jax.random.normal(ks[6], (DEPTH, 4, D_MODEL), f32),
        "mix_in_w": w(ks[7], (n_even, D_MODEL, MIX_IN_DIM), D_MODEL),
        "mix_out_w": w(ks[8], (n_even, D_MODEL, D_MODEL), D_MODEL),
        "win_sink": 0.5 * jax.random.normal(ks[9], (n_even, WIN_HEADS), f32),
        "diff_qkv_w": w(ks[10], (n_odd, D_MODEL, 3 * D_MODEL), D_MODEL),
        "diff_out_w": w(ks[11], (n_odd, D_MODEL, D_MODEL), D_MODEL),
        "diff_lambda": 0.1 * jax.random.normal(ks[12], (n_odd, 4, HEAD_DIM), f32),
        "diff_subln_g": 1.0 + 0.01 * jax.random.normal(ks[13], (n_odd, 2 * HEAD_DIM), f32),
        "ffn_in_w": w(ks[14], (n_even, D_MODEL, 2 * FFN_DIM), D_MODEL),
        "ffn_out_w": w(ks[15], (n_even, FFN_DIM, D_MODEL), FFN_DIM),
        "router_w": w(ks[16], (n_odd, D_MODEL, N_EXPERTS), D_MODEL),
        "expert_in_w": w(ks[17], (n_odd, N_EXPERTS, D_MODEL, 2 * EXPERT_DIM), D_MODEL),
        "expert_out_w": w(ks[18], (n_odd, N_EXPERTS, EXPERT_DIM, D_MODEL), EXPERT_DIM),
    }


def reference(x, c, ctx, c_ctx, ada_w, ada_b, norm_g, mix_in_w, mix_out_w, win_sink,
              diff_qkv_w, diff_out_w, diff_lambda, diff_subln_g,
              ffn_in_w, ffn_out_w, router_w, expert_in_w, expert_out_w):
    n_tok = x.shape[1]
    ROWS = n_tok // GRID_W
    rope = rope_tables(ROWS)
    for layer in range(DEPTH):
        j = layer // 2
        even = layer % 2 == 0
        need_ctx = layer < DEPTH - 1
        mod_x = (jax.nn.silu(c) @ ada_w[layer] + ada_b[layer])[:, None, :]
        mod_c = jax.nn.silu(c_ctx) @ ada_w[layer] + ada_b[layer]
        sh1x, sc1x, g1x, sh2x, sc2x, g2x = jnp.split(mod_x, 6, axis=-1)
        sh1c, sc1c, g1c, sh2c, sc2c, g2c = jnp.split(mod_c, 6, axis=-1)

        def channel(h):
            if even:
                return swiglu(h, ffn_in_w[j], ffn_out_w[j])
            return moe_swiglu(h, router_w[j], expert_in_w[j], expert_out_w[j])

        hx = modulate(x, norm_g[layer, 0], sh1x, sc1x)
        hc = modulate(ctx, norm_g[layer, 0], sh1c, sc1c)
        if even:
            yx, yc = fourier_window_mixer(hx, hc, mix_in_w[j], mix_out_w[j], win_sink[j], rope, need_ctx)
        else:
            yx, yc = diff_mixer(hx, hc, diff_qkv_w[j], diff_out_w[j], diff_lambda[j], diff_subln_g[j],
                                lambda_init_fn(layer), rope, need_ctx)
        x = x + g1x * rmsnorm(yx, norm_g[layer, 1])
        hx = modulate(x, norm_g[layer, 2], sh2x, sc2x)
        x = x + g2x * rmsnorm(channel(hx), norm_g[layer, 3])
        if need_ctx:
            ctx = ctx + g1c * rmsnorm(yc, norm_g[layer, 1])
            hc = modulate(ctx, norm_g[layer, 2], sh2c, sc2c)
            ctx = ctx + g2c * rmsnorm(channel(hc), norm_g[layer, 3])
    return x
```

```cpp
#include <hip/hip_runtime.h>
#include <cstdio>
#include <cstdint>

#ifndef PHMASK
#define PHMASK 0xFFFFFFFFu
#endif
#define PH_ON(i) ((PHMASK >> (i)) & 1u)
#ifndef REP_DIFF
#define REP_DIFF 1
#endif
#ifndef REP_MOE
#define REP_MOE 1
#endif
#ifndef REP_P0
#define REP_P0 1
#endif
#ifndef REP_P0B
#define REP_P0B 1
#endif
#ifndef EXTRA_BARS
#define EXTRA_BARS 0
#endif
#ifndef REP_EPI
#define REP_EPI 1
#endif
#ifndef WAITSEL
#define WAITSEL 0xFFFFu
#endif
#ifndef WAITPROBE
#define WAITPROBE 0
#endif
#ifndef KREP
#define KREP 1
#endif
#ifndef REP_PROJ
#define REP_PROJ 1
#endif
#ifndef REP_FOUR
#define REP_FOUR 1
#endif
#ifndef REP_WIN
#define REP_WIN 1
#endif
#define LAS __attribute__((address_space(3)))
#define GAS __attribute__((address_space(1)))
typedef unsigned short bf16_t;
typedef short bf16x8 __attribute__((ext_vector_type(8)));
typedef short s16x4 __attribute__((ext_vector_type(4)));
typedef float f32x2 __attribute__((ext_vector_type(2)));
typedef float f32x4 __attribute__((ext_vector_type(4)));
typedef float f32x16 __attribute__((ext_vector_type(16)));
typedef unsigned u32x2 __attribute__((ext_vector_type(2)));
typedef unsigned u32x4 __attribute__((ext_vector_type(4)));
typedef __bf16 bf16x2_t __attribute__((ext_vector_type(2)));
typedef int v8i_t __attribute__((ext_vector_type(8)));

constexpr int DM = 1024, NB = 8, SEQ = 4096, CTX = 256, DEPTH = 4;
constexpr int RL = NB * SEQ, RC = NB * CTX, RT = RL + RC;
constexpr int MIXIN = 1280, FFN = 2816, NEXP = 8, EDIM = 3584;
constexpr int MAXSLOT = 71680;
constexpr float EPS = 1e-6f;
constexpr float LOG2E = 1.4426950408889634f;
constexpr float QK_C = 0.125f * LOG2E;

constexpr size_t MiB = 1u << 20;
constexpr size_t WS_CTL = 0, CTL_BYTES = 32 * 1024;
constexpr size_t WS_MOD = 1 * MiB;
constexpr size_t WS_ROPE = WS_MOD + 900 * 1024;
constexpr size_t WS_WP = WS_ROPE + 8 * 1024;
constexpr size_t WS_ROUTE = 2 * MiB;
constexpr size_t WS_CS = 4 * MiB;
constexpr size_t WS_CSC = 68 * MiB;
constexpr size_t WS_WMIXIN = 72 * MiB;
constexpr size_t WS_WMIXOUT = 77 * MiB;
constexpr size_t WS_WQKV = 81 * MiB;
constexpr size_t WS_WDOUT = 93 * MiB;
constexpr size_t WS_WFFNIN = 97 * MiB;
constexpr size_t WS_WFFNOUT = 119 * MiB;
constexpr size_t WS_WEXPIN = 130 * MiB;
constexpr size_t WS_WEXPOUT = 354 * MiB;
constexpr size_t WS_X = 466 * MiB;
constexpr size_t WS_H = 602 * MiB;
constexpr size_t WS_YO = 670 * MiB;
constexpr size_t WS_RA = 738 * MiB;
constexpr size_t WS_Z = WS_RA;
constexpr size_t WS_Y = WS_RA + 85 * MiB;
constexpr size_t WS_PQT = WS_RA + 153 * MiB;
constexpr size_t WS_O = WS_RA + 204 * MiB;
constexpr size_t WS_RB = 1010 * MiB;
constexpr size_t WS_A2 = WS_RB;
constexpr size_t WS_PQTC = WS_RB + 190 * MiB;
constexpr size_t WS_A2M = WS_H;
constexpr size_t WS_HS = 1092 * MiB;
constexpr size_t WS_END = 1364 * MiB;
static_assert(WS_A2M + (size_t)MAXSLOT * EDIM * 2 <= WS_HS, "A2m overlay");
static_assert(WS_HS + (size_t)NEXP * RT * DM <= WS_END && WS_HS + (size_t)MAXSLOT * DM * 2 <= WS_END && WS_PQTC + 64 * MiB <= WS_END, "ws end");

constexpr int CW_TMO = 0;
constexpr int CW_CNT = 64;
constexpr int CW_BAR = 4096;

constexpr int RING_BYTES = 131072;
constexpr int MISC_OFF = RING_BYTES + 320;
constexpr int LDS_BYTES = 147456;

__device__ __forceinline__ unsigned cvtpk(float lo, float hi) { f32x2 v = {lo, hi}; bf16x2_t b = __builtin_convertvector(v, bf16x2_t); return __builtin_bit_cast(unsigned, b); }
#ifndef F8_DENSE
#define F8_DENSE false
#endif
#ifndef F8_FOUR
#define F8_FOUR false
#endif
constexpr float F8_SCS = 256.f, F8_SPQ = 8.f;
constexpr float F8_SH = 4.f, F8_SW = 64.f, F8_SA = 4.f;
__device__ __forceinline__ float f8clamp(float v) { return __builtin_amdgcn_fmed3f(v, -448.f, 448.f); }
__device__ __forceinline__ unsigned pk4_fp8(float a, float b, float c, float d) {
    unsigned w = 0; w = __builtin_amdgcn_cvt_pk_fp8_f32(f8clamp(a), f8clamp(b), w, false); w = __builtin_amdgcn_cvt_pk_fp8_f32(f8clamp(c), f8clamp(d), w, true); return w; }
__device__ __forceinline__ float bf_lo(unsigned u) { return __uint_as_float(u << 16); }
__device__ __forceinline__ float bf_hi(unsigned u) { return __uint_as_float(u & 0xffff0000u); }
__device__ __forceinline__ float wave_sum(float v, int lane) {
#pragma unroll
    for (int o = 1; o < 64; o <<= 1) v += __int_as_float(__builtin_amdgcn_ds_bpermute((lane ^ o) << 2, __float_as_int(v)));
    return v;
}
__device__ __forceinline__ unsigned rfl(unsigned v) { return (unsigned)__builtin_amdgcn_readfirstlane((int)v); }
__device__ __forceinline__ const char* uptr(const char* p) {
    unsigned lo = (unsigned)__builtin_amdgcn_readfirstlane((int)(unsigned)(uintptr_t)p), hi = (unsigned)__builtin_amdgcn_readfirstlane((int)(unsigned)((uintptr_t)p >> 32));
    asm volatile("" : "+s"(lo), "+s"(hi));
    return (const char*)(((uintptr_t)hi << 32) | lo);
}
__device__ __forceinline__ GAS unsigned char* gptr(const void* p) {
    unsigned lo = (unsigned)__builtin_amdgcn_readfirstlane((int)(unsigned)(uintptr_t)p), hi = (unsigned)__builtin_amdgcn_readfirstlane((int)(unsigned)((uintptr_t)p >> 32));
    asm volatile("" : "+s"(lo), "+s"(hi));
    return (GAS unsigned char*)(((uintptr_t)hi << 32) | lo);
}
__device__ __forceinline__ int sopaque(int v) { v = __builtin_amdgcn_readfirstlane(v); asm volatile("" : "+s"(v)); return v; }
__device__ __forceinline__ int opaque(int v) { asm volatile("" : "+v"(v)); return v; }
#define LDS_WAIT() asm volatile("s_waitcnt lgkmcnt(0)" ::: "memory")
#define VM_WAIT() asm volatile("s_waitcnt vmcnt(0)" ::: "memory")
#define SBAR() __builtin_amdgcn_sched_barrier(0)

namespace pg8 {
constexpr int BM = 256, BK = 64, HALF = 128, HTB = HALF * BK * 2, STAGE_BYTES = 8 * HTB, NXCD = 8, WGM = 8;
__host__ __device__ __forceinline__ int lds_byte(int r, int c) { const int st = (r >> 4) * 2 + (c >> 5), rr = r & 15, cc = c & 31, ob = rr * 64 + cc * 2; return st * 1024 + (ob ^ (((ob >> 9) & 1) << 5)); }
__host__ __device__ __forceinline__ void stage_rc(int b, int& R, int& C) { const int st = b / 1024, sb = b % 1024, swz = sb ^ (((sb >> 9) & 1) << 5); R = (st >> 1) * 16 + swz / 64; C = (st & 1) * 32 + (swz % 64) / 2; }
__host__ __device__ __forceinline__ int perm32(int rho) { const int n = rho >> 4, i = rho & 15; return 8 * (i >> 2) + 4 * n + (i & 3); }

struct Unit { int pm, pn, e, nkt; };
struct Dims { int lda, ldb; };

__device__ __forceinline__ int xcd_remap(int wgid, int nwg) {
    const int q = nwg / NXCD, r = nwg % NXCD, xcd = wgid % NXCD, off = wgid / NXCD;
    return (xcd < r ? xcd * (q + 1) : r * (q + 1) + (xcd - r) * q) + off;
}

#ifndef ALIGN_SWIGLU
#define ALIGN_SWIGLU true
#endif
#ifndef ALIGN_DEFAULT
#define ALIGN_DEFAULT true
#endif
template <class Epi, class Sched, bool F8 = false, bool ALIGN_EPI = ALIGN_DEFAULT>
__device__ __forceinline__ void gemm_phase(LAS unsigned char* lds, const Dims g, const Sched& S, const Epi& E) {
    const int tid = opaque(threadIdx.x), wid = __builtin_amdgcn_readfirstlane(tid >> 6), lane = tid & 63, wr = wid >> 2, wc = wid & 3, fr = lane & 15, fq = lane >> 4;
    unsigned voffA[2], voffB[2];
#pragma unroll
    for (int i = 0; i < 2; ++i) { int R, C; stage_rc(tid * 16 + i * 8192, R, C); const int Rb = Epi::PERM ? ((R & ~31) + perm32(R & 31)) : R;
        voffA[i] = (unsigned)(R * g.lda + C) * 2u; voffB[i] = (unsigned)(Rb * g.ldb + C) * 2u; }
    const size_t kstep = (size_t)(BK * 2);
    const size_t hstepA = (size_t)HALF * g.lda * 2, hstepB = (size_t)HALF * g.ldb * 2;
    const unsigned ldsw = (unsigned)wid * 1024u;
    const int aoff = lds_byte(wr * 64 + fr, fq * 8), boff = lds_byte(wc * 32 + fr, fq * 8);
#define PG8_SA(b, h) (((b) * 2 + (h)) * HTB)
#define PG8_SB(b, h) ((4 + (b) * 2 + (h)) * HTB)
#define PG8_STAGE(bufoff, gbase, voff) do { _Pragma("unroll") for (int _i = 0; _i < 2; ++_i) \
        __builtin_amdgcn_global_load_lds((const unsigned*)((const char*)(gbase) + (voff)[_i]), (LAS unsigned*)(lds + (bufoff) + ldsw + _i * 8192), 16, 0, 0); } while (0)
#define PG8_LDA(dst, b, h) do { _Pragma("unroll") for (int m = 0; m < 4; ++m) _Pragma("unroll") for (int k = 0; k < 2; ++k) dst[m][k] = *(const LAS bf16x8*)(lds + PG8_SA(b, h) + aoff + m * 2048 + k * 1024); } while (0)
#define PG8_LDB(dst, b, h) do { _Pragma("unroll") for (int n = 0; n < 2; ++n) _Pragma("unroll") for (int k = 0; k < 2; ++k) dst[n][k] = *(const LAS bf16x8*)(lds + PG8_SB(b, h) + boff + n * 2048 + k * 1024); } while (0)
#define PG8_V8(x) __builtin_bit_cast(v8i_t, (x))
#define PG8_MMA(ai, bj, At, Bt) do { __builtin_amdgcn_s_setprio(1); _Pragma("unroll") for (int m = 0; m < 4; ++m) _Pragma("unroll") for (int n = 0; n < 2; ++n) { \
        if constexpr (F8) { struct P2 { bf16x8 a, b; }; const v8i_t a8_ = PG8_V8((P2{Bt[n][0], Bt[n][1]})), b8_ = PG8_V8((P2{At[m][0], At[m][1]})); \
            asm volatile("v_mfma_f32_16x16x128_f8f6f4 %0, %1, %2, %0" : "+v"(acc[ai][bj][m][n]) : "v"(a8_), "v"(b8_)); }   \
        else { _Pragma("unroll") for (int k = 0; k < 2; ++k) acc[ai][bj][m][n] = __builtin_amdgcn_mfma_f32_16x16x32_bf16(Bt[n][k], At[m][k], acc[ai][bj][m][n], 0, 0, 0); } } \
        __builtin_amdgcn_s_setprio(0); } while (0)
#define PG8_WAIT_V(n) asm volatile("s_waitcnt vmcnt(" #n ")" ::: "memory")
#define PG8_WAIT_L(n) asm volatile("s_waitcnt lgkmcnt(" #n ")" ::: "memory")
#define PG8_BAR __builtin_amdgcn_s_barrier()
#define PG8_SCHED __builtin_amdgcn_sched_barrier(0)
    Unit cur, nxt; int ui = 0;
    if (!S.next(0, cur)) return;
    f32x4 acc[2][2][4][2];
#pragma unroll
    for (int a = 0; a < 2; ++a)
#pragma unroll
        for (int b = 0; b < 2; ++b)
#pragma unroll
            for (int m = 0; m < 4; ++m)
#pragma unroll
                for (int n = 0; n < 2; ++n) acc[a][b][m][n] = (f32x4){0.f, 0.f, 0.f, 0.f};
    bf16x8 At[4][2], B0[2][2], B1[2][2];
    const char* cA = uptr(S.aptr(cur)); const char* cB = uptr(S.bptr(cur));
    PG8_STAGE(PG8_SB(0, 0), cB, voffB); PG8_STAGE(PG8_SB(0, 1), cB + hstepB, voffB); PG8_STAGE(PG8_SA(0, 0), cA, voffA); PG8_STAGE(PG8_SA(0, 1), cA + hstepA, voffA);
    if (wr == 1) PG8_BAR;
    PG8_WAIT_V(2); PG8_BAR;
    PG8_STAGE(PG8_SB(1, 0), cB + kstep, voffB); PG8_STAGE(PG8_SA(1, 0), cA + kstep, voffA); PG8_STAGE(PG8_SB(1, 1), cB + hstepB + kstep, voffB);
    PG8_WAIT_V(6); PG8_BAR;
    for (;;) {
        const bool has_next = S.next(ui + 1, nxt);
        const char* nA = uptr(has_next ? S.aptr(nxt) : cA); const char* nB = uptr(has_next ? S.bptr(nxt) : cB);
        const int nt = sopaque(cur.nkt);
        for (int t = 0; t < KREP * nt; t += 2) {
            const bool last = (t == KREP * nt - 2);
            const char* a1 = cA + (size_t)(KREP == 1 ? t + 1 : (t + 1) % nt) * kstep;
            const char* a2 = last ? nA : cA + (size_t)(KREP == 1 ? t + 2 : (t + 2) % nt) * kstep; const char* b2 = last ? nB : cB + (size_t)(KREP == 1 ? t + 2 : (t + 2) % nt) * kstep;
            const char* a3 = a2 + kstep; const char* b3 = b2 + kstep;
            PG8_LDB(B0, 0, 0); PG8_LDB(B1, 0, 1); PG8_SCHED; PG8_LDA(At, 0, 0); PG8_STAGE(PG8_SA(1, 1), a1 + hstepA, voffA);
            PG8_WAIT_V(8); PG8_WAIT_L(0); PG8_BAR; PG8_MMA(0, 0, At, B0); PG8_MMA(0, 1, At, B1); PG8_BAR; PG8_SCHED;
            PG8_LDA(At, 0, 1); PG8_STAGE(PG8_SB(0, 0), b2, voffB); PG8_STAGE(PG8_SB(0, 1), b2 + hstepB, voffB); PG8_STAGE(PG8_SA(0, 0), a2, voffA);
            PG8_WAIT_V(8); PG8_WAIT_L(0); PG8_BAR; PG8_MMA(1, 0, At, B0); PG8_MMA(1, 1, At, B1); PG8_BAR; PG8_SCHED;
            PG8_LDB(B0, 1, 0); PG8_LDB(B1, 1, 1); PG8_SCHED; PG8_LDA(At, 1, 0); PG8_STAGE(PG8_SA(0, 1), a2 + hstepA, voffA);
            PG8_WAIT_V(8); PG8_WAIT_L(0); PG8_BAR; PG8_MMA(0, 0, At, B0); PG8_MMA(0, 1, At, B1); PG8_BAR; PG8_SCHED;
            PG8_LDA(At, 1, 1); PG8_STAGE(PG8_SB(1, 0), b3, voffB); PG8_STAGE(PG8_SB(1, 1), b3 + hstepB, voffB); PG8_STAGE(PG8_SA(1, 0), a3, voffA);
            PG8_WAIT_V(8); PG8_WAIT_L(0); PG8_BAR; PG8_MMA(1, 0, At, B0); PG8_MMA(1, 1, At, B1); PG8_BAR; PG8_SCHED;
        }
        if constexpr (ALIGN_EPI) { if (wr == 0) PG8_BAR; }
        if constexpr (F8) asm volatile("s_nop 15\n\ts_nop 15" ::: "memory");
        for (int repe = 0; repe < REP_EPI; ++repe) { const int l2 = opaque(threadIdx.x) & 63; E(acc, cur, wr, wc, l2 & 15, l2 >> 4); }
        if (!has_next) break;
#pragma unroll
        for (int a = 0; a < 2; ++a)
#pragma unroll
            for (int b = 0; b < 2; ++b)
#pragma unroll
                for (int m = 0; m < 4; ++m)
#pragma unroll
                    for (int n = 0; n < 2; ++n) acc[a][b][m][n] = (f32x4){0.f, 0.f, 0.f, 0.f};
        cur = nxt; cA = nA; cB = nB; ++ui;
        if constexpr (ALIGN_EPI) { if (wr == 1) PG8_BAR; }
    }
    PG8_WAIT_V(0);
    if constexpr (!ALIGN_EPI) { if (wr == 0) PG8_BAR; }
    PG8_BAR;
#undef PG8_SA
#undef PG8_SB
#undef PG8_STAGE
#undef PG8_LDA
#undef PG8_LDB
#undef PG8_MMA
#undef PG8_V8
#undef PG8_WAIT_V
#undef PG8_WAIT_L
#undef PG8_BAR
#undef PG8_SCHED
}
}
using pg8::Unit;

struct EpiStore {
    static constexpr bool PERM = true;
    bf16_t* O; int ldc; float scale;
    __device__ __forceinline__ void operator()(const f32x4 (&acc)[2][2][4][2], const Unit& u, int wr, int wc, int fr, int fq) const {
        const int row0 = u.pm * 256 + wr * 64 + fr, col0 = u.pn * 256 + wc * 32 + 8 * fq;
#pragma unroll
        for (int ai = 0; ai < 2; ++ai)
#pragma unroll
            for (int m = 0; m < 4; ++m) { bf16_t* rowp = O + (size_t)(row0 + ai * 128 + m * 16) * ldc + col0;
#pragma unroll
                for (int bj = 0; bj < 2; ++bj) { const f32x4 v0 = acc[ai][bj][m][0] * (scale * (1.f / KREP)), v1 = acc[ai][bj][m][1] * (scale * (1.f / KREP));
                    u32x4 w; w.x = cvtpk(v0[0], v0[1]); w.y = cvtpk(v0[2], v0[3]); w.z = cvtpk(v1[0], v1[1]); w.w = cvtpk(v1[2], v1[3]);
                    *(u32x4*)(rowp + bj * 128) = w; } }
    }
};
template <bool F8OUT> struct EpiSwiglu {
    static constexpr bool PERM = true;
    unsigned char* O; int ldc; float scale;
    __device__ __forceinline__ void operator()(const f32x4 (&acc)[2][2][4][2], const Unit& u, int wr, int wc, int fr, int fq) const {
        const int row0 = u.pm * 256 + wr * 64 + fr, col0 = u.pn * 128 + wc * 32 + 8 * fq;
        const float us = F8OUT ? scale * F8_SA : scale;
        const float k1 = -scale * LOG2E * (1.f / KREP), ik2 = 1.f / (scale * us * (1.f / KREP) * (1.f / KREP));
#pragma unroll
        for (int ai = 0; ai < 2; ++ai)
#pragma unroll
            for (int m = 0; m < 4; ++m) { unsigned char* rowp = O + ((size_t)(row0 + ai * 128 + m * 16) * ldc + col0) * (F8OUT ? 1 : 2);
                float r[8];
#pragma unroll
                for (int n = 0; n < 2; ++n) { const f32x4 g = acc[ai][0][m][n], u = acc[ai][1][m][n]; const f32x4 t = g * k1;
                    f32x4 e; e[0] = __builtin_amdgcn_exp2f(t[0]); e[1] = __builtin_amdgcn_exp2f(t[1]); e[2] = __builtin_amdgcn_exp2f(t[2]); e[3] = __builtin_amdgcn_exp2f(t[3]);
                    const f32x4 d = e * ik2 + ik2;
                    f32x4 q; q[0] = __builtin_amdgcn_rcpf(d[0]); q[1] = __builtin_amdgcn_rcpf(d[1]); q[2] = __builtin_amdgcn_rcpf(d[2]); q[3] = __builtin_amdgcn_rcpf(d[3]);
                    const f32x4 o = (g * u) * q; r[n * 4 + 0] = o[0]; r[n * 4 + 1] = o[1]; r[n * 4 + 2] = o[2]; r[n * 4 + 3] = o[3]; }
                if constexpr (F8OUT) { u32x2 w; w.x = pk4_fp8(r[0], r[1], r[2], r[3]); w.y = pk4_fp8(r[4], r[5], r[6], r[7]); *(u32x2*)rowp = w; }
                else { u32x4 w; w.x = cvtpk(r[0], r[1]); w.y = cvtpk(r[2], r[3]); w.z = cvtpk(r[4], r[5]); w.w = cvtpk(r[6], r[7]); *(u32x4*)rowp = w; } }
    }
};
struct EpiRope {
    static constexpr bool PERM = false;
    bf16_t* O; int ldc; int rlo, rhi; const f32x2* cs;
    int qlo, qhi; float qscale;
    __device__ __forceinline__ void operator()(const f32x4 (&acc)[2][2][4][2], const Unit& u, int wr, int wc, int fr, int fq) const {
        const int row0 = u.pm * 256 + wr * 64 + fr, col0 = u.pn * 256 + wc * 32 + 4 * fq;
        const bool lat = u.pm < 128;
#pragma unroll
        for (int ai = 0; ai < 2; ++ai)
#pragma unroll
            for (int m = 0; m < 4; ++m) { const int row = row0 + ai * 128 + m * 16; bf16_t* rowp = O + (size_t)row * ldc + col0;
                const int t = row & 4095, pos = (wc & 1) ? (t & 63) : (t >> 6);
                const f32x2* c4 = cs + pos * 16 + 4 * fq;
                const f32x2 c0 = c4[0], c1 = c4[1], c2 = c4[2], c3 = c4[3];
#pragma unroll
                for (int bj = 0; bj < 2; ++bj) { f32x4 p1 = acc[ai][bj][m][0] * (1.f / KREP), p2 = acc[ai][bj][m][1] * (1.f / KREP);
                    const int blk = u.pn * 2 + bj;
                    if (lat && blk >= rlo && blk < rhi) {
                        const f32x4 cv = {c0.x, c1.x, c2.x, c3.x}, sv = {c0.y, c1.y, c2.y, c3.y};
                        const f32x4 o1 = p1 * cv - p2 * sv, o2 = p2 * cv + p1 * sv; p1 = o1; p2 = o2; }
                    if (blk >= qlo && blk < qhi) { p1 = p1 * qscale; p2 = p2 * qscale; }
                    u32x2 w1, w2; w1.x = cvtpk(p1[0], p1[1]); w1.y = cvtpk(p1[2], p1[3]); w2.x = cvtpk(p2[0], p2[1]); w2.y = cvtpk(p2[2], p2[3]);
                    *(u32x2*)(rowp + bj * 128) = w1; *(u32x2*)(rowp + bj * 128 + 16) = w2; } }
    }
};
struct EpiPQt {
    static constexpr bool PERM = true;
    bf16_t* Plat; bf16_t* Pctx;
    __device__ __forceinline__ void operator()(const f32x4 (&acc)[2][2][4][2], const Unit& u, int wr, int wc, int fr, int fq) const {
        const bool ctx = u.e >= 32; const int bg = ctx ? u.e - 32 : u.e; const int L = ctx ? CTX : SEQ;
        constexpr int EB = F8_FOUR ? 1 : 2;
        unsigned char* base = (unsigned char*)(ctx ? Pctx : Plat) + (size_t)bg * 128 * 8192 * EB;
        const int col0 = u.pn * 256 + wc * 32 + 8 * fq;
#pragma unroll
        for (int ai = 0; ai < 2; ++ai)
#pragma unroll
            for (int m = 0; m < 4; ++m) { unsigned char* rowp = base + ((size_t)(wr * 64 + m * 16 + fr) * 8192 + ai * L + col0) * EB;
#pragma unroll
                for (int bj = 0; bj < 2; ++bj) { const f32x4 v0 = acc[ai][bj][m][0] * (1.f / KREP), v1 = acc[ai][bj][m][1] * (1.f / KREP);
                    if constexpr (F8_FOUR) { u32x2 w; w.x = pk4_fp8(v0[0] * F8_SPQ, v0[1] * F8_SPQ, v0[2] * F8_SPQ, v0[3] * F8_SPQ); w.y = pk4_fp8(v1[0] * F8_SPQ, v1[1] * F8_SPQ, v1[2] * F8_SPQ, v1[3] * F8_SPQ); *(u32x2*)(rowp + bj * 128) = w; }
                    else { u32x4 w; w.x = cvtpk(v0[0], v0[1]); w.y = cvtpk(v0[2], v0[3]); w.z = cvtpk(v1[0], v1[1]); w.w = cvtpk(v1[2], v1[3]); *(u32x4*)(rowp + bj * 128 * 2) = w; } } }
    }
};
struct EpiFour2 {
    static constexpr bool PERM = true;
    bf16_t* O;
    __device__ __forceinline__ void operator()(const f32x4 (&acc)[2][2][4][2], const Unit& u, int wr, int wc, int fr, int fq) const {
        EpiStore s{O, DM, (u.pm < 128 ? 0.0013810679320049757f   : 0.005524271728019903f  ) * (F8_FOUR ? 1.f / (F8_SCS * F8_SPQ) : 1.f)};
        s(acc, u, wr, wc, fr, fq);
    }
};

struct SchedDense {
    const char* A; const char* B; int nM, nN, nwg, G, c, nkt; size_t tA, tB;
    __device__ __forceinline__ void init(const void* A_, int lda, const void* B_, int ldb, int M, int N, int K, int G_, int c_) {
        A = (const char*)A_; B = (const char*)B_; nM = M / 256; nN = N / 256; nwg = nM * nN; G = G_; c = c_; nkt = K / 64; tA = (size_t)256 * lda * 2; tB = (size_t)256 * ldb * 2; }
    __device__ __forceinline__ bool next(int i, Unit& u) const {
        const long L = (long)i * G + c; if (L >= nwg) return false;
        const int wgid = pg8::xcd_remap((int)L, nwg);
        const int nig = pg8::WGM * nN, gid = wgid / nig, fm = gid * pg8::WGM, gsz = (nM - fm) < pg8::WGM ? (nM - fm) : pg8::WGM;
        u.pm = fm + ((wgid % nig) % gsz); u.pn = (wgid % nig) / gsz; u.e = 0; u.nkt = nkt; return true;
    }
    __device__ __forceinline__ const char* aptr(const Unit& u) const { return A + (size_t)u.pm * tA; }
    __device__ __forceinline__ const char* bptr(const Unit& u) const { return B + (size_t)u.pn * tB; }
};
struct SchedGroup {
    const char* A; const char* B; int P1, P2, P3, P4, P5, P6, P7, nRT, nN, nwg, G, c, nkt; size_t tA, tB, gB, aE;
    __device__ __forceinline__ bool next(int i, Unit& u) const {
        const long L = (long)i * G + c; if (L >= nwg) return false;
        const int wgid = pg8::xcd_remap((int)L, nwg);
        const int nig = pg8::WGM * nN, gid = wgid / nig, fm = gid * pg8::WGM, gsz = (nRT - fm) < pg8::WGM ? (nRT - fm) : pg8::WGM;
        const int rt = fm + ((wgid % nig) % gsz);
        u.pm = rt; u.pn = (wgid % nig) / gsz; u.nkt = nkt;
        u.e = (rt >= P1) + (rt >= P2) + (rt >= P3) + (rt >= P4) + (rt >= P5) + (rt >= P6) + (rt >= P7); return true;
    }
    __device__ __forceinline__ const char* aptr(const Unit& u) const {
        if (aE == 0) return A + (size_t)u.pm * tA;
        const int pe = u.e == 0 ? 0 : u.e == 1 ? P1 : u.e == 2 ? P2 : u.e == 3 ? P3 : u.e == 4 ? P4 : u.e == 5 ? P5 : u.e == 6 ? P6 : P7;
        return A + (size_t)u.e * aE + (size_t)(u.pm - pe) * tA; }
    __device__ __forceinline__ const char* bptr(const Unit& u) const { return B + (size_t)u.e * gB + (size_t)u.pn * tB; }
};
struct SchedF1 {
    const char* Wp; const char* Z; int G, c;
    __device__ __forceinline__ bool next(int i, Unit& u) const {
        const int L = i * G + c; if (L >= 544) return false;
        u.pm = 0; u.nkt = 2;
        if (L < 512) { u.e = L >> 4; u.pn = L & 15; } else { u.e = 32 + (L - 512); u.pn = 0; }
        return true;
    }
    __device__ __forceinline__ const char* aptr(const Unit&) const { return Wp; }
    __device__ __forceinline__ const char* bptr(const Unit& u) const {
        const bool ctx = u.e >= 32; const int bg = ctx ? u.e - 32 : u.e, b = bg >> 2, gq = bg & 3;
        const size_t row0 = ctx ? (size_t)RL + b * CTX : (size_t)b * SEQ + u.pn * 256;
        return Z + (row0 * MIXIN + gq * 128) * 2; }
};
struct SchedF2 {
    const char* CSl; const char* CSc; const char* Plat; const char* Pctx; int G, vcu;
    static constexpr size_t EB = F8_FOUR ? 1 : 2;
    __device__ __forceinline__ bool next(int i, Unit& u) const {
        const int L = i * G + vcu; if (L >= 272) return false;
        if (L < 256) { const int b = L >> 5, mt = (L & 31) >> 1; u.pm = b * 16 + mt; u.pn = L & 1; u.e = b; u.nkt = F8_FOUR ? 64 : 128; }
        else { const int b = (L - 256) >> 1; u.pm = 128 + b; u.pn = L & 1; u.e = 8 + b; u.nkt = F8_FOUR ? 4 : 8; }
        return true;
    }
    __device__ __forceinline__ const char* aptr(const Unit& u) const { return u.e < 8 ? CSl + (size_t)(u.pm & 15) * 256 * 8192 * EB : CSc; }
    __device__ __forceinline__ const char* bptr(const Unit& u) const { return (u.e < 8 ? Plat + (size_t)u.e * 512 * 8192 * EB : Pctx + (size_t)(u.e - 8) * 512 * 8192 * EB) + (size_t)u.pn * 256 * 8192 * EB; }
};

#define XB_TMO      128
#define XB_XCNT(j)  (256  + 64 * (j))
#define XB_XSUB(j)  (1280 + 64 * (j))
#define XB_XGEN(j)  (2304 + 64 * (j))
#define XB_TOP      3328
#define XB_TOPGEN   3392
#define XCD_BAR_WORDS 3456
#define XB_SPIN_CAP (1u << 21)
__device__ __forceinline__ unsigned xb_ld(unsigned* p)              { return __hip_atomic_load(p, __ATOMIC_RELAXED, __HIP_MEMORY_SCOPE_AGENT); }
__device__ __forceinline__ unsigned xb_add(unsigned* p, unsigned v) { return __hip_atomic_fetch_add(p, v, __ATOMIC_RELAXED, __HIP_MEMORY_SCOPE_AGENT); }
__device__ __forceinline__ unsigned xb_xcc_id() { return (unsigned)__builtin_amdgcn_s_getreg((3 << 11) | 20) & 0xFu; }
#define XB_SPIN(cond, bar) do { unsigned _sp = 0; while (cond) { __builtin_amdgcn_s_sleep(1); \
    if ((++_sp & 255u) == 0u) { if (xb_ld(&(bar)[XB_TMO])) break; if (_sp > XB_SPIN_CAP) { atomicAdd(&(bar)[XB_TMO], 1u); break; } } } } while (0)
struct XcdBarrier { unsigned* bar; unsigned x; volatile LAS unsigned* st; };
__device__ __forceinline__ XcdBarrier xcd_barrier_post(unsigned* bar, volatile LAS unsigned* st) {
    XcdBarrier b; b.bar = bar; b.x = xb_xcc_id(); b.st = st;
    if (threadIdx.x == 0) (void)xb_add(&bar[XB_XCNT(b.x)], 1u);
    return b;
}
__device__ __forceinline__ void xcd_barrier_complete(unsigned* bar, unsigned x, unsigned& nloc, unsigned& nx) {
    const unsigned G = gridDim.x * gridDim.y * gridDim.z;
    unsigned sum, cnt, mine, sp = 0u;
    for (;;) {
        sum = 0u; cnt = 0u; mine = 0u;
#pragma unroll
        for (unsigned j = 0; j < 16; ++j) { const unsigned c = xb_ld(&bar[XB_XCNT(j)]); sum += c; cnt += (c > 0u) ? 1u : 0u; mine = (j == x) ? c : mine; }
        if (sum == G) break;
        __builtin_amdgcn_s_sleep(1);
        if ((++sp & 255u) == 0u) { if (xb_ld(&bar[XB_TMO])) break; if (sp > XB_SPIN_CAP) { atomicAdd(&bar[XB_TMO], 1u); break; } }
    }
    nloc = mine > 0u ? mine : 1u; nx = cnt > 0u ? cnt : 1u;
}
__device__ __forceinline__ void xcd_barrier(const XcdBarrier& b) {
    asm volatile("s_waitcnt vmcnt(0)" ::: "memory");
    __syncthreads();
    if (threadIdx.x == 0) {
        unsigned* bar = (unsigned*)uptr((const char*)b.bar);
        __builtin_amdgcn_s_waitcnt(0);
        unsigned nloc = b.st[0], nx = b.st[1];
        if (nloc == 0u) { xcd_barrier_complete(bar, b.x, nloc, nx); b.st[0] = nloc; b.st[1] = nx; }
        const unsigned old = xb_add(&bar[XB_XSUB(b.x)], 1u);
        const unsigned gen = old / nloc;
        if (old + 1u == (gen + 1u) * nloc) {
            __builtin_amdgcn_fence(__ATOMIC_RELEASE, "agent");
            asm volatile("s_waitcnt vmcnt(0)" ::: "memory");
            const unsigned og = xb_add(&bar[XB_TOP], 1u);
            const unsigned tg = og / nx;
            if (og + 1u == (tg + 1u) * nx) xb_add(&bar[XB_TOPGEN], 1u);
            else XB_SPIN(xb_ld(&bar[XB_TOPGEN]) == tg, bar);
            __builtin_amdgcn_fence(__ATOMIC_ACQUIRE, "agent");
            xb_add(&bar[XB_XGEN(b.x)], 1u);
            asm volatile("s_waitcnt vmcnt(0)" ::: "memory");
        } else {
            XB_SPIN(xb_ld(&bar[XB_XGEN(b.x)]) == gen, bar);
            __builtin_amdgcn_fence(__ATOMIC_ACQUIRE, "agent");
            asm volatile("s_waitcnt vmcnt(0)" ::: "memory");
        }
    }
    __syncthreads();
}

__device__ __forceinline__ int crow(int r, int hi) { return (r & 3) + 8 * (r >> 2) + 4 * hi; }
template <int KW> __device__ __forceinline__ int kswz(int row, int colB) { return KW == 128 ? row * 256 + (colB ^ ((row & 7) << 4)) : row * 128 + (colB ^ (((row >> 1) & 7) << 4)); }
template <int DV> __device__ __forceinline__ int v_st(int k, int c) { const int kk = (k & ~0xC) | ((k & 4) << 1) | ((k & 8) >> 1); return ((kk >> 3) * (DV / 32) + (c >> 5)) * 512 + ((kk & 7) * 32 + (c & 31)) * 2; }
__device__ __forceinline__ int v_rd_base(int lane) { return ((lane & 3) << 3) | (((lane >> 2) & 3) << 6) | (((lane >> 4) & 1) << 5) | (((lane >> 5) & 1) << 8); }
template <int OFF> __device__ __forceinline__ s16x4 tr_read(int vb) { s16x4 r; asm volatile("ds_read_b64_tr_b16 %0, %1 offset:%2" : "=&v"(r) : "v"(vb), "i"(OFF) : "memory"); return r; }
template <int DV, int D0> __device__ __forceinline__ void pv_one(f32x16& od, int vb, bf16x8 pa0, bf16x8 pa1, bf16x8 pa2, bf16x8 pa3) {
    constexpr int KS = (DV / 32) * 1024, HF = (DV / 32) * 512;
    const s16x4 l0 = tr_read<D0 * 512 + 0 * KS>(vb), h0 = tr_read<D0 * 512 + 0 * KS + HF>(vb), l1 = tr_read<D0 * 512 + 1 * KS>(vb), h1 = tr_read<D0 * 512 + 1 * KS + HF>(vb);
    const s16x4 l2 = tr_read<D0 * 512 + 2 * KS>(vb), h2 = tr_read<D0 * 512 + 2 * KS + HF>(vb), l3 = tr_read<D0 * 512 + 3 * KS>(vb), h3 = tr_read<D0 * 512 + 3 * KS + HF>(vb);
    asm volatile("s_waitcnt lgkmcnt(0)" ::: "memory"); SBAR();
#define PKV(L, H) (bf16x8){L[0], L[1], L[2], L[3], H[0], H[1], H[2], H[3]}
    od = __builtin_amdgcn_mfma_f32_32x32x16_bf16(pa0, PKV(l0, h0), od, 0, 0, 0);
    od = __builtin_amdgcn_mfma_f32_32x32x16_bf16(pa1, PKV(l1, h1), od, 0, 0, 0);
    od = __builtin_amdgcn_mfma_f32_32x32x16_bf16(pa2, PKV(l2, h2), od, 0, 0, 0);
    od = __builtin_amdgcn_mfma_f32_32x32x16_bf16(pa3, PKV(l3, h3), od, 0, 0, 0);
#undef PKV
}
#define PV_RD(D0, L, H) do { L[0] = tr_read<(D0) * 512 + 0 * KS>(vb); H[0] = tr_read<(D0) * 512 + 0 * KS + HF>(vb); L[1] = tr_read<(D0) * 512 + 1 * KS>(vb); H[1] = tr_read<(D0) * 512 + 1 * KS + HF>(vb); \
    L[2] = tr_read<(D0) * 512 + 2 * KS>(vb); H[2] = tr_read<(D0) * 512 + 2 * KS + HF>(vb); L[3] = tr_read<(D0) * 512 + 3 * KS>(vb); H[3] = tr_read<(D0) * 512 + 3 * KS + HF>(vb); } while (0)
#define PV_MM(od, L, H) do { od = __builtin_amdgcn_mfma_f32_32x32x16_bf16(pa0, PKV(L[0], H[0]), od, 0, 0, 0); od = __builtin_amdgcn_mfma_f32_32x32x16_bf16(pa1, PKV(L[1], H[1]), od, 0, 0, 0); \
    od = __builtin_amdgcn_mfma_f32_32x32x16_bf16(pa2, PKV(L[2], H[2]), od, 0, 0, 0); od = __builtin_amdgcn_mfma_f32_32x32x16_bf16(pa3, PKV(L[3], H[3]), od, 0, 0, 0); } while (0)
#define PKV(L, H) (bf16x8){L[0], L[1], L[2], L[3], H[0], H[1], H[2], H[3]}
template <int DV> __device__ __forceinline__ void pv_all(f32x16* o, int vb, bf16x8 pa0, bf16x8 pa1, bf16x8 pa2, bf16x8 pa3) {
    constexpr int KS = (DV / 32) * 1024, HF = (DV / 32) * 512;
    s16x4 la[4], ha[4], lb[4], hb[4];
    PV_RD(0, la, ha);
    PV_RD(1, lb, hb); asm volatile("s_waitcnt lgkmcnt(8)" ::: "memory"); SBAR(); PV_MM(o[0], la, ha);
    if constexpr (DV == 128) {
        PV_RD(2, la, ha); asm volatile("s_waitcnt lgkmcnt(8)" ::: "memory"); SBAR(); PV_MM(o[1], lb, hb);
        PV_RD(3, lb, hb); asm volatile("s_waitcnt lgkmcnt(8)" ::: "memory"); SBAR(); PV_MM(o[2], la, ha);
        asm volatile("s_waitcnt lgkmcnt(0)" ::: "memory"); SBAR(); PV_MM(o[3], lb, hb);
    } else {
        asm volatile("s_waitcnt lgkmcnt(0)" ::: "memory"); SBAR(); PV_MM(o[1], lb, hb);
    }
}
#undef PV_RD
#undef PV_MM
#undef PKV
template <int KW> __device__ __forceinline__ void qkt64(f32x16& p0, f32x16& p1, const char* Ks, const bf16x8* qr, int kcb, int r32, int hi) {
    bf16x8 kb0[4], kb1[4];
#pragma unroll
    for (int d0 = 0; d0 < 4; ++d0) { const int cb = kcb + (d0 * 16 + hi * 8) * 2;
        kb0[d0] = *reinterpret_cast<const bf16x8*>(Ks + kswz<KW>(r32, cb));
        kb1[d0] = *reinterpret_cast<const bf16x8*>(Ks + kswz<KW>(32 + r32, cb)); }
    p0 = f32x16{}; p1 = f32x16{};
#pragma unroll
    for (int d0 = 0; d0 < 4; ++d0) {
        p0 = __builtin_amdgcn_mfma_f32_32x32x16_bf16(kb0[d0], qr[d0], p0, 0, 0, 0);
        p1 = __builtin_amdgcn_mfma_f32_32x32x16_bf16(kb1[d0], qr[d0], p1, 0, 0, 0); }
}
template <int KW> __device__ __forceinline__ void qkt64n(f32x16& p0, f32x16& p1, const char* Ks, const bf16x8* qr, int kcb, int r32, int hi, const f32x16& cinit) {
#pragma unroll
    for (int d0 = 0; d0 < 4; ++d0) { const int cb = kcb + (d0 * 16 + hi * 8) * 2;
        const bf16x8 b0 = *reinterpret_cast<const bf16x8*>(Ks + kswz<KW>(r32, cb));
        const bf16x8 b1 = *reinterpret_cast<const bf16x8*>(Ks + kswz<KW>(32 + r32, cb));
        if (d0 == 0) { p0 = __builtin_amdgcn_mfma_f32_32x32x16_bf16(b0, qr[0], cinit, 0, 0, 0); p1 = __builtin_amdgcn_mfma_f32_32x32x16_bf16(b1, qr[0], cinit, 0, 0, 0); }
        else { p0 = __builtin_amdgcn_mfma_f32_32x32x16_bf16(b0, qr[d0], p0, 0, 0, 0); p1 = __builtin_amdgcn_mfma_f32_32x32x16_bf16(b1, qr[d0], p1, 0, 0, 0); } }
}
template <int ND> __device__ __forceinline__ void softmax_step(f32x16& p0, f32x16& p1, float& m_reg, float& l_reg, f32x16* o, float* al_l, int r32, int hi,
                                                              bf16x8& pa0, bf16x8& pa1, bf16x8& pa2, bf16x8& pa3) {
    float pmax = p0[0];
#pragma unroll
    for (int r = 1; r < 16; ++r) pmax = fmaxf(pmax, p0[r]);
#pragma unroll
    for (int r = 0; r < 16; ++r) pmax = fmaxf(pmax, p1[r]);
    { auto rr = __builtin_amdgcn_permlane32_swap(__float_as_uint(pmax), __float_as_uint(pmax), false, false); pmax = fmaxf(__uint_as_float(rr[0]), __uint_as_float(rr[1])); }
    const float mn = fmaxf(m_reg, pmax);
    const float alpha = __builtin_amdgcn_exp2f((m_reg - mn) * QK_C); m_reg = mn;
    const float mnC = -mn * QK_C;
#pragma unroll
    for (int r = 0; r < 16; ++r) { p0[r] = __builtin_amdgcn_exp2f(fmaf(p0[r], QK_C, mnC)); p1[r] = __builtin_amdgcn_exp2f(fmaf(p1[r], QK_C, mnC)); }
    float ps = 0.f;
#pragma unroll
    for (int r = 0; r < 16; ++r) ps += p0[r] + p1[r];
    { auto rr = __builtin_amdgcn_permlane32_swap(__float_as_uint(ps), __float_as_uint(ps), false, false); ps = __uint_as_float(rr[0]) + __uint_as_float(rr[1]); }
    l_reg = l_reg * alpha + ps;
    if (__any(alpha < 1.f)) { if (hi == 0) al_l[r32] = alpha; LDS_WAIT();
#pragma unroll
        for (int d = 0; d < ND; ++d)
#pragma unroll
            for (int r = 0; r < 16; ++r) o[d][r] *= al_l[crow(r, hi)];
    }
#define PK4(P, BASE, OUT) do { unsigned a0 = cvtpk(P[BASE + 0], P[BASE + 1]), a1 = cvtpk(P[BASE + 2], P[BASE + 3]);   \
    unsigned b0 = cvtpk(P[BASE + 4], P[BASE + 5]), b1 = cvtpk(P[BASE + 6], P[BASE + 7]);                              \
    auto r0 = __builtin_amdgcn_permlane32_swap(a0, b0, false, false); auto r1 = __builtin_amdgcn_permlane32_swap(a1, b1, false, false); \
    u32x4 w = {r0[0], r1[0], r0[1], r1[1]}; OUT = *reinterpret_cast<bf16x8*>(&w); } while (0)
    PK4(p0, 0, pa0); PK4(p0, 8, pa1); PK4(p1, 0, pa2); PK4(p1, 8, pa3);
#undef PK4
}

constexpr int AT_K = 0, AT_V = 16384, AT_WS = 32768, AT_XCH = 36864;

__device__ __forceinline__ void win_attn_unit(char* lds, const bf16_t* Z, bf16_t* Y, const float* sink, int b, int kvh, int qc, bool ctxq) {
    const int tid = opaque(threadIdx.x), wid = __builtin_amdgcn_readfirstlane(tid >> 6), lane = tid & 63, r32 = lane & 31, hi = lane >> 5;
    const int head = kvh * 4 + (wid >> 1), qsub = wid & 1;
    const int q0 = qc * 64;
    const size_t qrow0 = (ctxq ? (size_t)RL + b * CTX : (size_t)b * SEQ) + q0 + qsub * 32;
    float* wsf = (float*)(lds + AT_WS) + wid * 128; float* al_l = wsf; float* li_l = wsf + 32;
    bf16x8 qr[4];
    { const bf16_t* qp = Z + (qrow0 + r32) * MIXIN + 512 + head * 64 + hi * 8;
#pragma unroll
      for (int d0 = 0; d0 < 4; ++d0) qr[d0] = *reinterpret_cast<const bf16x8*>(qp + d0 * 16); }
    float m_reg = -1e30f, l_reg = 0.f; f32x16 o[2] = {};
    const int srow = tid >> 3, scol = (tid & 7) * 8;
    const int vb = (int)(uintptr_t)(lds + AT_V) + v_rd_base(lane);
    const int qrel = qsub * 32 + r32;
    const int NT = ctxq ? 4 : 9;
    for (int t = 0; t < NT; ++t) {
        size_t krow; int mode = 0;
        if (t < 4) krow = (size_t)RL + b * CTX + t * 64;
        else { const int p0 = q0 - 128 + (t - 4) * 64; if (p0 < 0 || p0 >= SEQ) continue; krow = (size_t)b * SEQ + p0; mode = (t == 4) ? 1 : (t == 8) ? 2 : 0; }
        __syncthreads();
        { const bf16_t* kp = Z + (krow + srow) * MIXIN + 1024 + kvh * 64 + scol;
          const bf16x8 kv = *reinterpret_cast<const bf16x8*>(kp), vv = *reinterpret_cast<const bf16x8*>(kp + 128);
          *reinterpret_cast<bf16x8*>(lds + AT_K + kswz<64>(srow, scol * 2)) = kv;
          *reinterpret_cast<bf16x8*>(lds + AT_V + v_st<64>(srow, scol)) = vv; }
        __syncthreads();
        f32x16 p0, p1; qkt64<64>(p0, p1, lds + AT_K, qr, 0, r32, hi);
        if (mode == 1) {
#pragma unroll
            for (int r = 0; r < 16; ++r) { const int kk = crow(r, hi); if (kk < qrel) p0[r] = -1e30f; if (kk + 32 < qrel) p1[r] = -1e30f; } }
        else if (mode == 2) {
#pragma unroll
            for (int r = 0; r < 16; ++r) { const int kk = crow(r, hi); if (kk > qrel) p0[r] = -1e30f; if (kk + 32 > qrel) p1[r] = -1e30f; } }
        bf16x8 pa0, pa1, pa2, pa3;
        softmax_step<2>(p0, p1, m_reg, l_reg, o, al_l, r32, hi, pa0, pa1, pa2, pa3);
        pv_one<64, 0>(o[0], vb, pa0, pa1, pa2, pa3); pv_one<64, 1>(o[1], vb, pa0, pa1, pa2, pa3);
    }
    l_reg += __builtin_amdgcn_exp2f(sink[head] * LOG2E - m_reg * QK_C);
    if (hi == 0) li_l[r32] = l_reg; LDS_WAIT();
    bf16_t* yp = Y + qrow0 * DM + 512 + head * 64;
#pragma unroll
    for (int r = 0; r < 16; ++r) { const int orow = crow(r, hi); const float rl = __builtin_amdgcn_rcpf(li_l[orow]);
#pragma unroll
        for (int d0 = 0; d0 < 2; ++d0) { const unsigned w = cvtpk(o[d0][r] * rl, 0.f); yp[(size_t)orow * DM + d0 * 32 + r32] = (bf16_t)(w & 0xffffu); } }
}

constexpr float DA_THR = 8.f;
constexpr float DA_THRL = DA_THR * LOG2E;
template <bool FIRST> __device__ __forceinline__ void da_partialSM(f32x16& p0, f32x16& p1, float& mhat, f32x16& negm, float& alpha) {
    float pmax = fmaxf(p0[0], p0[1]), pmb = fmaxf(p1[0], p1[1]);
#pragma unroll
    for (int r = 2; r < 16; r += 2) { pmax = fmaxf(fmaxf(pmax, p0[r]), p0[r + 1]); pmb = fmaxf(fmaxf(pmb, p1[r]), p1[r + 1]); }
    pmax = fmaxf(pmax, pmb);
    { auto rr = __builtin_amdgcn_permlane32_swap(__float_as_uint(pmax), __float_as_uint(pmax), false, false); pmax = fmaxf(__uint_as_float(rr[0]), __uint_as_float(rr[1])); }
    alpha = 1.f;
    if (FIRST || !__builtin_expect(__all(pmax <= DA_THRL), 1)) {
        const float dl = FIRST ? pmax : fmaxf(pmax, 0.f);
        mhat += dl; alpha = __builtin_amdgcn_exp2f(-dl);
#pragma unroll
        for (int r = 0; r < 16; ++r) { p0[r] -= dl; p1[r] -= dl; negm[r] = -mhat; }
    }
#pragma unroll
    for (int r = 0; r < 16; ++r) p0[r] = __builtin_amdgcn_exp2f(p0[r]);
}
__device__ __forceinline__ void da_finishSM(f32x16& p0, f32x16& p1, float alpha, float& l_reg, bf16x8& pa0, bf16x8& pa1, bf16x8& pa2, bf16x8& pa3) {
#pragma unroll
    for (int r = 0; r < 16; ++r) p1[r] = __builtin_amdgcn_exp2f(p1[r]);
    float s0 = p0[0], s1 = p0[1], s2 = p0[2], s3 = p0[3];
#pragma unroll
    for (int r = 4; r < 16; r += 4) { s0 += p0[r]; s1 += p0[r + 1]; s2 += p0[r + 2]; s3 += p0[r + 3]; }
#pragma unroll
    for (int r = 0; r < 16; r += 4) { s0 += p1[r]; s1 += p1[r + 1]; s2 += p1[r + 2]; s3 += p1[r + 3]; }
    float ps = (s0 + s1) + (s2 + s3);
    { auto rr = __builtin_amdgcn_permlane32_swap(__float_as_uint(ps), __float_as_uint(ps), false, false); ps = __uint_as_float(rr[0]) + __uint_as_float(rr[1]); }
    l_reg = l_reg * alpha + ps;
#define PK4(P, BASE, OUT) do { unsigned a0 = cvtpk(P[BASE + 0], P[BASE + 1]), a1 = cvtpk(P[BASE + 2], P[BASE + 3]);   \
    unsigned b0 = cvtpk(P[BASE + 4], P[BASE + 5]), b1 = cvtpk(P[BASE + 6], P[BASE + 7]);                              \
    auto r0 = __builtin_amdgcn_permlane32_swap(a0, b0, false, false); auto r1 = __builtin_amdgcn_permlane32_swap(a1, b1, false, false); \
    u32x4 w = {r0[0], r1[0], r0[1], r1[1]}; OUT = *reinterpret_cast<bf16x8*>(&w); } while (0)
    PK4(p0, 0, pa0); PK4(p0, 8, pa1); PK4(p1, 0, pa2); PK4(p1, 8, pa3);
#undef PK4
}
__device__ __forceinline__ void da_pv(f32x16* o, int vb, bf16x8 pa0, bf16x8 pa1, bf16x8 pa2, bf16x8 pa3) {
    pv_all<128>(o, vb, pa0, pa1, pa2, pa3);
}
constexpr int DA_V = 0, DA_K = 32768, DA_WS = 65536, DA_XCH = 0;
__device__ __forceinline__ void diff_attn_unit(char* lds, const bf16_t* QKV, bf16_t* O, const float* subg, float lam, float oscale, int b, int h, int qb, bool ctxq) {
    const int tid = opaque(threadIdx.x), wid = __builtin_amdgcn_readfirstlane(tid >> 6), lane = tid & 63, r32 = lane & 31, hi = lane >> 5;
    const int comp = wid >> 2, qsub = wid & 3;
    const size_t qrow0 = (ctxq ? (size_t)RL + b * CTX : (size_t)b * SEQ) + qb * 128 + qsub * 32;
    char* V_lds = lds + DA_V; char* K_lds = lds + DA_K;
    float* wsf = (float*)(lds + DA_WS) + wid * 128; float* al_l = wsf; float* li_l = wsf + 32;
    __syncthreads();
    bf16x8 qr[4];
    { const bf16_t* qp = QKV + (qrow0 + r32) * 3072 + (2 * h + comp) * 64 + hi * 8;
#pragma unroll
      for (int d0 = 0; d0 < 4; ++d0) qr[d0] = *reinterpret_cast<const bf16x8*>(qp + d0 * 16); }
    float m_reg = 0.f, l_reg = 0.f; f32x16 o[4] = {}; f32x16 negm = {};
    const int sr = tid >> 4, sc = (tid & 15) * 8, vst0 = v_st<128>(sr, sc), vst1 = v_st<128>(32 + sr, sc);
    const int vb0 = (int)(uintptr_t)V_lds + v_rd_base(lane);
    const int kcb = comp * 128;
    const bf16_t* kvp = QKV + (size_t)sr * 3072 + 1024 + h * 128 + sc;
    const size_t rowc = (size_t)RL + b * CTX, rowl = (size_t)b * SEQ;
    const int NT = ctxq ? 4 : 68;
    struct { bf16x8 vs0, vs1, ks0, ks1; } sr_[1];
#define KROW(t) ((t) < 4 ? rowc + (size_t)(t) * 64 : rowl + (size_t)((t) - 4) * 64)
#define SLOAD(i, t) do { const bf16_t* p_ = kvp + KROW(t) * 3072; sr_[i].vs0 = *reinterpret_cast<const bf16x8*>(p_ + 1024); sr_[i].vs1 = *reinterpret_cast<const bf16x8*>(p_ + 32 * 3072 + 1024); \
    sr_[i].ks0 = *reinterpret_cast<const bf16x8*>(p_); sr_[i].ks1 = *reinterpret_cast<const bf16x8*>(p_ + 32 * 3072); } while (0)
#define SWRITE(bf, i) do { *reinterpret_cast<bf16x8*>(V_lds + (bf) * 16384 + vst0) = sr_[i].vs0; *reinterpret_cast<bf16x8*>(V_lds + (bf) * 16384 + vst1) = sr_[i].vs1; \
    *reinterpret_cast<bf16x8*>(K_lds + (bf) * 16384 + kswz<128>(sr, sc * 2)) = sr_[i].ks0; *reinterpret_cast<bf16x8*>(K_lds + (bf) * 16384 + kswz<128>(32 + sr, sc * 2)) = sr_[i].ks1; } while (0)
#define SWAIT() asm volatile("s_waitcnt vmcnt(0)" ::: "memory")
#define RESC(a) do { if (__any((a) < 1.f)) { if (hi == 0) al_l[r32] = (a); LDS_WAIT(); \
    _Pragma("unroll") for (int d = 0; d < 4; ++d) _Pragma("unroll") for (int r = 0; r < 16; ++r) o[d][r] *= al_l[crow(r, hi)]; } } while (0)
    f32x16 pA0, pA1, pB0, pB1; float alA, alB; bf16x8 pa0, pa1, pa2, pa3;
    SLOAD(0, 0); VM_WAIT(); SWRITE(0, 0); __syncthreads();
    qkt64n<128>(pA0, pA1, K_lds, qr, kcb, r32, hi, negm); da_partialSM<true>(pA0, pA1, m_reg, negm, alA);
    SLOAD(0, 1);
    SWAIT(); SWRITE(1, 0); __syncthreads();
    for (int j = 1; j + 1 < NT; j += 2) {
        SBAR(); qkt64n<128>(pB0, pB1, K_lds + 16384, qr, kcb, r32, hi, negm);
        da_finishSM(pA0, pA1, alA, l_reg, pa0, pa1, pa2, pa3); SBAR();
        SLOAD(0, j + 1); SBAR();
        da_pv(o, vb0, pa0, pa1, pa2, pa3); da_partialSM<false>(pB0, pB1, m_reg, negm, alB);
        __syncthreads(); SWAIT(); SWRITE(0, 0);
        RESC(alB); __syncthreads();
        SBAR(); qkt64n<128>(pA0, pA1, K_lds, qr, kcb, r32, hi, negm);
        da_finishSM(pB0, pB1, alB, l_reg, pa0, pa1, pa2, pa3); SBAR();
        SLOAD(0, j + 2); SBAR();
        da_pv(o, vb0 + 16384, pa0, pa1, pa2, pa3); da_partialSM<false>(pA0, pA1, m_reg, negm, alA);
        __syncthreads(); SWAIT(); SWRITE(1, 0);
        RESC(alA); __syncthreads();
    }
    SBAR(); qkt64n<128>(pB0, pB1, K_lds + 16384, qr, kcb, r32, hi, negm);
    da_finishSM(pA0, pA1, alA, l_reg, pa0, pa1, pa2, pa3); SBAR();
    da_pv(o, vb0, pa0, pa1, pa2, pa3); da_partialSM<false>(pB0, pB1, m_reg, negm, alB);
    __syncthreads(); RESC(alB);
    da_finishSM(pB0, pB1, alB, l_reg, pa0, pa1, pa2, pa3); SBAR();
    da_pv(o, vb0 + 16384, pa0, pa1, pa2, pa3);
#undef KROW
#undef SLOAD
#undef SWRITE
#undef SWAIT
#undef RESC
    if (hi == 0) li_l[r32] = l_reg; LDS_WAIT();
    float rl[16];
#pragma unroll
    for (int r = 0; r < 16; ++r) rl[r] = __builtin_amdgcn_rcpf(li_l[crow(r, hi)]);
    __syncthreads();
    float* xch = (float*)(lds + DA_XCH) + qsub * (32 * 132);
    if (comp == 1) {
#pragma unroll
        for (int d0 = 0; d0 < 4; ++d0)
#pragma unroll
            for (int r = 0; r < 16; ++r) xch[crow(r, hi) * 132 + d0 * 32 + r32] = o[d0][r] * rl[r];
    }
    __syncthreads();
    if (comp == 0) {
#pragma unroll
        for (int d0 = 0; d0 < 4; ++d0)
#pragma unroll
            for (int r = 0; r < 16; ++r) { const int idx = crow(r, hi) * 132 + d0 * 32 + r32; const float v = o[d0][r] * rl[r] - lam * xch[idx]; xch[idx] = v; }
        LDS_WAIT();
        const int row = lane >> 1, hf = lane & 1; const float* rp = xch + row * 132 + hf * 64;
        f32x4 v[16]; float ss = 0.f;
#pragma unroll
        for (int j = 0; j < 16; ++j) { v[j] = *reinterpret_cast<const f32x4*>(rp + 4 * j); ss += v[j][0] * v[j][0] + v[j][1] * v[j][1] + v[j][2] * v[j][2] + v[j][3] * v[j][3]; }
        ss += __int_as_float(__builtin_amdgcn_ds_bpermute((lane ^ 1) << 2, __float_as_int(ss)));
        const float rs = __builtin_amdgcn_rsqf(ss * (1.f / 128.f) + EPS) * oscale;
        bf16_t* op = O + (qrow0 + row) * DM + h * 128 + hf * 64;
#pragma unroll
        for (int j = 0; j < 16; j += 2) { const f32x4 g0 = *reinterpret_cast<const f32x4*>(subg + hf * 64 + 4 * j), g1 = *reinterpret_cast<const f32x4*>(subg + hf * 64 + 4 * j + 4);
            const f32x4 a = v[j] * g0 * rs, c = v[j + 1] * g1 * rs;
            u32x4 w; w.x = cvtpk(a[0], a[1]); w.y = cvtpk(a[2], a[3]); w.z = cvtpk(c[0], c[1]); w.w = cvtpk(c[2], c[3]);
            *reinterpret_cast<u32x4*>(op + 4 * j) = w; }
    }
}

constexpr int WA_V = 0, WA_K = 16384, WA_WS = 32768, WA_ST = 36864;
__device__ __forceinline__ void wa_mask(f32x16& p0, f32x16& p1, int mode, int qrel, int hi) {
    if (mode == 1) {
#pragma unroll
        for (int r = 0; r < 16; ++r) { const int kk = crow(r, hi); if (kk < qrel) p0[r] = -1e30f; if (kk + 32 < qrel) p1[r] = -1e30f; } }
    else if (mode == 2) {
#pragma unroll
        for (int r = 0; r < 16; ++r) { const int kk = crow(r, hi); if (kk > qrel) p0[r] = -1e30f; if (kk + 32 > qrel) p1[r] = -1e30f; } }
    else if (mode == 3) {
#pragma unroll
        for (int r = 0; r < 16; ++r) { p0[r] = -1e30f; p1[r] = -1e30f; } }
}
__device__ __forceinline__ void win_attn_unit2(char* lds, const bf16_t* Z, bf16_t* Y, const float* sink, int b, int kvh, int qc, bool ctxq) {
    const int tid = opaque(threadIdx.x), wid = __builtin_amdgcn_readfirstlane(tid >> 6), lane = tid & 63, r32 = lane & 31, hi = lane >> 5;
    const int head = kvh * 4 + (wid >> 1), qsub = wid & 1, q0 = qc * 64;
    const size_t rowc = (size_t)RL + b * CTX, rowl = (size_t)b * SEQ;
    const size_t qrow0 = (ctxq ? rowc : rowl) + q0 + qsub * 32;
    char* V_lds = lds + WA_V; char* K_lds = lds + WA_K;
    float* wsf = (float*)(lds + WA_WS) + wid * 128; float* al_l = wsf; float* li_l = wsf + 32;
    __syncthreads();
    bf16x8 qr[4];
    { const bf16_t* qp = Z + (qrow0 + r32) * MIXIN + 512 + head * 64 + hi * 8;
#pragma unroll
      for (int d0 = 0; d0 < 4; ++d0) qr[d0] = *reinterpret_cast<const bf16x8*>(qp + d0 * 16); }
    float m_reg = 0.f, l_reg = 0.f; f32x16 o[2] = {}; f32x16 negm = {};
    const int srow = tid >> 3, scol = (tid & 7) * 8, vst = v_st<64>(srow, scol), kst = kswz<64>(srow, scol * 2);
    const int vb0 = (int)(uintptr_t)V_lds + v_rd_base(lane);
    const bf16_t* kvp = Z + (size_t)srow * MIXIN + 1024 + kvh * 64 + scol;
    const int skip_lo = ctxq ? 0 : (q0 == 0 ? 2 : q0 == 64 ? 1 : 0);
    const int nloc = ctxq ? 0 : 5 - skip_lo - (q0 == SEQ - 64 ? 2 : q0 == SEQ - 128 ? 1 : 0);
    const int NTr = 4 + nloc, NT = (NTr + 1) & ~1;
    const int qrel = qsub * 32 + r32;
    struct { bf16x8 vs, ks; } sr_;
#define KROW(t) ((t) < 4 ? rowc + (size_t)(t) * 64 : (t) < NTr ? rowl + (size_t)(q0 - 128 + ((t) - 4 + skip_lo) * 64) : rowc)
#define TMODE(t) ((t) < 4 ? 0 : (t) >= NTr ? 3 : ((t) - 4 + skip_lo) == 0 ? 1 : ((t) - 4 + skip_lo) == 4 ? 2 : 0)
#define SLOAD(t) do { const bf16_t* p_ = kvp + KROW(t) * MIXIN; sr_.ks = *reinterpret_cast<const bf16x8*>(p_); sr_.vs = *reinterpret_cast<const bf16x8*>(p_ + 128); } while (0)
#define SWRITE(bf) do { *reinterpret_cast<bf16x8*>(V_lds + (bf) * 8192 + vst) = sr_.vs; *reinterpret_cast<bf16x8*>(K_lds + (bf) * 8192 + kst) = sr_.ks; } while (0)
#define SWAIT() asm volatile("s_waitcnt vmcnt(0)" ::: "memory")
#define RESC(a) do { if (__any((a) < 1.f)) { if (hi == 0) al_l[r32] = (a); LDS_WAIT(); \
    _Pragma("unroll") for (int d = 0; d < 2; ++d) _Pragma("unroll") for (int r = 0; r < 16; ++r) o[d][r] *= al_l[crow(r, hi)]; } } while (0)
#define WPV(vb) pv_all<64>(o, (vb), pa0, pa1, pa2, pa3)
    f32x16 pA0, pA1, pB0, pB1; float alA, alB; bf16x8 pa0, pa1, pa2, pa3;
    SLOAD(0); VM_WAIT(); SWRITE(0); __syncthreads();
    qkt64n<64>(pA0, pA1, K_lds, qr, 0, r32, hi, negm); da_partialSM<true>(pA0, pA1, m_reg, negm, alA);
    SLOAD(1);
    SWAIT(); SWRITE(1); __syncthreads();
    for (int j = 1; j + 1 < NT; j += 2) {
        SBAR(); qkt64n<64>(pB0, pB1, K_lds + 8192, qr, 0, r32, hi, negm);
        da_finishSM(pA0, pA1, alA, l_reg, pa0, pa1, pa2, pa3); SBAR();
        SLOAD(j + 1); SBAR();
        WPV(vb0); wa_mask(pB0, pB1, TMODE(j), qrel, hi); da_partialSM<false>(pB0, pB1, m_reg, negm, alB);
        __syncthreads(); SWAIT(); SWRITE(0);
        RESC(alB); __syncthreads();
        SBAR(); qkt64n<64>(pA0, pA1, K_lds, qr, 0, r32, hi, negm);
        da_finishSM(pB0, pB1, alB, l_reg, pa0, pa1, pa2, pa3); SBAR();
        SLOAD(j + 2); SBAR();
        WPV(vb0 + 8192); wa_mask(pA0, pA1, TMODE(j + 1), qrel, hi); da_partialSM<false>(pA0, pA1, m_reg, negm, alA);
        __syncthreads(); SWAIT(); SWRITE(1);
        RESC(alA); __syncthreads();
    }
    SBAR(); qkt64n<64>(pB0, pB1, K_lds + 8192, qr, 0, r32, hi, negm);
    da_finishSM(pA0, pA1, alA, l_reg, pa0, pa1, pa2, pa3); SBAR();
    WPV(vb0); wa_mask(pB0, pB1, TMODE(NT - 1), qrel, hi); da_partialSM<false>(pB0, pB1, m_reg, negm, alB);
    __syncthreads(); RESC(alB);
    da_finishSM(pB0, pB1, alB, l_reg, pa0, pa1, pa2, pa3); SBAR();
    WPV(vb0 + 8192);
#undef KROW
#undef TMODE
#undef SLOAD
#undef SWRITE
#undef SWAIT
#undef RESC
#undef WPV
    l_reg += __builtin_amdgcn_exp2f(sink[head] * LOG2E - m_reg);
    if (hi == 0) li_l[r32] = l_reg; LDS_WAIT();
    bf16_t* stg = (bf16_t*)(lds + WA_ST) + wid * 2048;
#pragma unroll
    for (int r = 0; r < 16; ++r) { const int orow = crow(r, hi); const float rl = __builtin_amdgcn_rcpf(li_l[orow]);
#pragma unroll
        for (int d0 = 0; d0 < 2; ++d0) stg[orow * 64 + d0 * 32 + r32] = (bf16_t)(cvtpk(o[d0][r] * rl, 0.f) & 0xffffu); }
    LDS_WAIT();
    bf16_t* yp = Y + qrow0 * DM + 512 + head * 64;
#pragma unroll
    for (int i = 0; i < 4; ++i) { const int row = i * 8 + (lane >> 3), ch = lane & 7; const u32x4 v = *reinterpret_cast<const u32x4*>(stg + row * 64 + ch * 8); *reinterpret_cast<u32x4*>(yp + (size_t)row * DM + ch * 8) = v; }
}

struct Args {
    const float *x, *c, *ctx, *c_ctx, *ada_w, *ada_b, *norm_g, *mix_in_w, *mix_out_w, *win_sink, *diff_qkv_w, *diff_out_w, *diff_lambda, *diff_subln_g,
                *ffn_in_w, *ffn_out_w, *router_w, *expert_in_w, *expert_out_w;
    float* out; unsigned char* ws; int ph_lo, ph_hi;
};
struct Frame {
    LAS unsigned char* lds; unsigned char* ldsg; volatile LAS unsigned* MISC; unsigned* ctl;
    int tid, lane, wave, vcu, G;
};

__device__ __forceinline__ unsigned f2bf(float f) { unsigned u = __builtin_bit_cast(unsigned, f); return (u + 0x7fffu + ((u >> 16) & 1u)) >> 16; }
__device__ __forceinline__ unsigned pk2(float lo, float hi) { return f2bf(lo) | (f2bf(hi) << 16); }
__device__ __forceinline__ void transpose_item(const float* W, int K, int N, bf16_t* WT, int n0, int c0, int k0, LAS float* scr, int lane) {
#pragma unroll 8
    for (int i = 0; i < 32; ++i) { const int kk = 2 * i + (lane >> 5); scr[kk * 33 + (lane & 31)] = W[(size_t)(k0 + kk) * N + c0 + (lane & 31)]; }
    LDS_WAIT(); asm volatile("" ::: "memory");
    const int c = lane & 7;
#pragma unroll
    for (int j = 0; j < 4; ++j) { const int n = (lane >> 3) + 8 * j; const LAS float* s = scr + (8 * c) * 33 + n;
        u32x4 o; o.x = pk2(s[0 * 33], s[1 * 33]); o.y = pk2(s[2 * 33], s[3 * 33]); o.z = pk2(s[4 * 33], s[5 * 33]); o.w = pk2(s[6 * 33], s[7 * 33]);
        *(u32x4*)(WT + (size_t)(n0 + n) * K + k0 + 8 * c) = o; }
    LDS_WAIT(); asm volatile("" ::: "memory");
}
__device__ __forceinline__ void transpose_item_f8(const float* W, int K, int N, unsigned char* WT, int n0, int c0, int k0, LAS float* scr, int lane) {
#pragma unroll 8
    for (int i = 0; i < 32; ++i) { const int kk = 2 * i + (lane >> 5); scr[kk * 33 + (lane & 31)] = W[(size_t)(k0 + kk) * N + c0 + (lane & 31)] * F8_SW; }
    LDS_WAIT(); asm volatile("" ::: "memory");
    const int c = lane & 7;
#pragma unroll
    for (int j = 0; j < 4; ++j) { const int n = (lane >> 3) + 8 * j; const LAS float* s = scr + (8 * c) * 33 + n;
        u32x2 o; o.x = pk4_fp8(s[0 * 33], s[1 * 33], s[2 * 33], s[3 * 33]); o.y = pk4_fp8(s[4 * 33], s[5 * 33], s[6 * 33], s[7 * 33]);
        *(u32x2*)(WT + (size_t)(n0 + n) * K + k0 + 8 * c) = o; }
    LDS_WAIT(); asm volatile("" ::: "memory");
}
__device__ __forceinline__ bool transpose_job(int& r, const float* W, int nb, int K, int N, void* WT, bool glu, bool f8, LAS float* scr, int lane) {
    const int nblk = N / 32, per = (K / 64) * nblk, tot = nb * per;
    if (r >= tot) { r -= tot; return false; }
    const int mtx = r / per, it = r % per, kb = it / nblk, nbk = it % nblk, n0 = 32 * nbk;
    int c0 = n0;
    if (glu) { const int tile = n0 >> 8, w = n0 & 255; c0 = (w < 128) ? tile * 128 + w : (N >> 1) + tile * 128 + (w - 128); }
    if (f8) transpose_item_f8(W + (size_t)mtx * K * N, K, N, (unsigned char*)WT + (size_t)mtx * K * N, n0, c0, 64 * kb, scr, lane);
    else transpose_item(W + (size_t)mtx * K * N, K, N, (bf16_t*)WT + (size_t)mtx * K * N, n0, c0, 64 * kb, scr, lane);
    return true;
}

struct ThinP {
    int nrows;
    const float* xin_lat; const float* xin_ctx;
    float* xout_lat; float* xout_ctx;
    int ymode;
    const bf16_t* Ysrc; const float* gate; const float* ga;
    bool h8;
    bf16_t* H; const float* gb; const float* shsc;
    const float* router; int* route; unsigned* cnt;
    unsigned char* HSv;
};
#define TH_DECL(PFX) f32x4 PFX##x0 = {}, PFX##x1 = {}, PFX##x2 = {}, PFX##x3 = {}; u32x2 PFX##ya0 = {}, PFX##ya1 = {}, PFX##ya2 = {}, PFX##ya3 = {}, PFX##yb0 = {}, PFX##yb1 = {}, PFX##yb2 = {}, PFX##yb3 = {}; float PFX##w0 = 0.f, PFX##w1 = 0.f
#define TH_LOAD(PFX, r_, it_) do { const int rr_ = (r_); \
    const float* xr_ = (rr_ < RL ? P.xin_lat + (size_t)rr_ * DM : P.xin_ctx + (size_t)(rr_ - RL) * DM) + 4 * lane; \
    PFX##x0 = *reinterpret_cast<const f32x4*>(xr_); PFX##x1 = *reinterpret_cast<const f32x4*>(xr_ + 256); PFX##x2 = *reinterpret_cast<const f32x4*>(xr_ + 512); PFX##x3 = *reinterpret_cast<const f32x4*>(xr_ + 768); \
    const bf16_t* ya_ = P.Ysrc; const bf16_t* yb_ = P.Ysrc; \
    if (P.ymode == 1) ya_ = P.Ysrc + (size_t)rr_ * DM; \
    else if (P.ymode == 2) { const LAS int* rt_ = rtl + (it_) * 6; \
        const int e0_ = rt_[0], p0_ = rt_[1], e1_ = rt_[2], p1_ = rt_[3]; PFX##w0 = __int_as_float(rt_[4]); PFX##w1 = __int_as_float(rt_[5]); \
        const unsigned b0_ = e0_ == 0 ? 0u : e0_ == 1 ? cb1 : e0_ == 2 ? cb2 : e0_ == 3 ? cb3 : e0_ == 4 ? cb4 : e0_ == 5 ? cb5 : e0_ == 6 ? cb6 : cb7; \
        const unsigned b1_ = e1_ == 0 ? 0u : e1_ == 1 ? cb1 : e1_ == 2 ? cb2 : e1_ == 3 ? cb3 : e1_ == 4 ? cb4 : e1_ == 5 ? cb5 : e1_ == 6 ? cb6 : cb7; \
        ya_ = P.Ysrc + (size_t)(b0_ + p0_) * DM; yb_ = P.Ysrc + (size_t)(b1_ + p1_) * DM; } \
    if (P.ymode) { ya_ += 4 * lane; PFX##ya0 = *reinterpret_cast<const u32x2*>(ya_); PFX##ya1 = *reinterpret_cast<const u32x2*>(ya_ + 256); PFX##ya2 = *reinterpret_cast<const u32x2*>(ya_ + 512); PFX##ya3 = *reinterpret_cast<const u32x2*>(ya_ + 768); } \
    if (P.ymode == 2) { yb_ += 4 * lane; PFX##yb0 = *reinterpret_cast<const u32x2*>(yb_); PFX##yb1 = *reinterpret_cast<const u32x2*>(yb_ + 256); PFX##yb2 = *reinterpret_cast<const u32x2*>(yb_ + 512); PFX##yb3 = *reinterpret_cast<const u32x2*>(yb_ + 768); } \
    } while (0)
#define TH_ARGS(PFX) PFX##x0, PFX##x1, PFX##x2, PFX##x3, PFX##ya0, PFX##ya1, PFX##ya2, PFX##ya3, PFX##yb0, PFX##yb1, PFX##yb2, PFX##yb3, PFX##w0, PFX##w1
__device__ __forceinline__ void thin_proc(const ThinP& P, f32x4 x0, f32x4 x1, f32x4 x2, f32x4 x3, u32x2 ya0, u32x2 ya1, u32x2 ya2, u32x2 ya3, u32x2 yb0, u32x2 yb1, u32x2 yb2, u32x2 yb3, float yw0, float yw1,
                                          int r, int li, int lane, LAS float* rwT, LAS int* rec, LAS unsigned* lcnt) {
    const int idx = r < RL ? (r >> 12) : 8;
    f32x4 xv[4] = {x0, x1, x2, x3};
    if (P.ymode) {
        f32x4 yv[4];
#define BF4(w) ((f32x4){bf_lo((w).x), bf_hi((w).x), bf_lo((w).y), bf_hi((w).y)})
        if (P.ymode == 1) { yv[0] = BF4(ya0); yv[1] = BF4(ya1); yv[2] = BF4(ya2); yv[3] = BF4(ya3); }
        else { yv[0] = BF4(ya0) * yw0 + BF4(yb0) * yw1; yv[1] = BF4(ya1) * yw0 + BF4(yb1) * yw1; yv[2] = BF4(ya2) * yw0 + BF4(yb2) * yw1; yv[3] = BF4(ya3) * yw0 + BF4(yb3) * yw1; }
#undef BF4
        float ss = 0.f;
#pragma unroll
        for (int j = 0; j < 4; ++j) ss += yv[j][0] * yv[j][0] + yv[j][1] * yv[j][1] + yv[j][2] * yv[j][2] + yv[j][3] * yv[j][3];
        const float rs = __builtin_amdgcn_rsqf(wave_sum(ss, lane) * (1.f / DM) + EPS);
        const float* gt = P.gate + (size_t)idx * 6144;
#pragma unroll
        for (int j = 0; j < 4; ++j) { const f32x4 g = *reinterpret_cast<const f32x4*>(gt + 4 * lane + 256 * j), a = *reinterpret_cast<const f32x4*>(P.ga + 4 * lane + 256 * j);
            xv[j] = xv[j] + g * (yv[j] * rs * a); }
    }
    if (P.xout_lat) { float* xo = r < RL ? P.xout_lat + (size_t)r * DM : P.xout_ctx + (size_t)(r - RL) * DM;
#pragma unroll
        for (int j = 0; j < 4; ++j) *reinterpret_cast<f32x4*>(xo + 4 * lane + 256 * j) = xv[j]; }
    if (P.H) {
        float ss = 0.f;
#pragma unroll
        for (int j = 0; j < 4; ++j) ss += xv[j][0] * xv[j][0] + xv[j][1] * xv[j][1] + xv[j][2] * xv[j][2] + xv[j][3] * xv[j][3];
        const float rs = __builtin_amdgcn_rsqf(wave_sum(ss, lane) * (1.f / DM) + EPS);
        const float* sh = P.shsc + (size_t)idx * 6144; bf16_t* hr = P.H + (size_t)r * DM;
        f32x4 hv[4];
#pragma unroll
        for (int j = 0; j < 4; ++j) { const f32x4 g = *reinterpret_cast<const f32x4*>(P.gb + 4 * lane + 256 * j), s = *reinterpret_cast<const f32x4*>(sh + 4 * lane + 256 * j), c = *reinterpret_cast<const f32x4*>(sh + 1024 + 4 * lane + 256 * j);
            hv[j] = xv[j] * rs * g * (c + 1.f) + s;
            if (P.h8) { *reinterpret_cast<unsigned*>((unsigned char*)P.H + (size_t)r * DM + 4 * lane + 256 * j) = pk4_fp8(hv[j][0] * F8_SH, hv[j][1] * F8_SH, hv[j][2] * F8_SH, hv[j][3] * F8_SH); }
            else { u32x2 w; w.x = cvtpk(hv[j][0], hv[j][1]); w.y = cvtpk(hv[j][2], hv[j][3]); *reinterpret_cast<u32x2*>(hr + 4 * lane + 256 * j) = w; } }
        if (P.router) {
            float lg[8];
#pragma unroll
            for (int e = 0; e < 8; ++e) { float a = 0.f;
#pragma unroll
                for (int j = 0; j < 4; ++j) { const f32x4 w = *reinterpret_cast<const LAS f32x4*>(rwT + e * 1024 + 4 * lane + 256 * j); a += hv[j][0] * w[0] + hv[j][1] * w[1] + hv[j][2] * w[2] + hv[j][3] * w[3]; }
                lg[e] = wave_sum(a, lane); }
            int i0 = 0; float v0 = lg[0];
#pragma unroll
            for (int e = 1; e < 8; ++e) if (lg[e] > v0) { v0 = lg[e]; i0 = e; }
            int i1 = -1; float v1 = -3.4e38f;
#pragma unroll
            for (int e = 0; e < 8; ++e) if (e != i0 && lg[e] > v1) { v1 = lg[e]; i1 = e; }
            const float w0 = 1.f / (1.f + __expf(v1 - v0)), w1 = 1.f - w0;
            if (lane == 0) { const unsigned lp0 = __hip_atomic_fetch_add(lcnt + i0, 1u, __ATOMIC_RELAXED, __HIP_MEMORY_SCOPE_WORKGROUP), lp1 = __hip_atomic_fetch_add(lcnt + i1, 1u, __ATOMIC_RELAXED, __HIP_MEMORY_SCOPE_WORKGROUP);
                LAS int* rc = rec + li * 6; rc[0] = i0; rc[1] = (int)lp0; rc[2] = i1; rc[3] = (int)lp1; rc[4] = __float_as_int(w0); rc[5] = __float_as_int(w1); }
        }
    }
}
__device__ __forceinline__ void thin_phase(Frame& F, const ThinP& P) {
    const int lane = opaque(F.lane);
    const int nlat = P.nrows < RL ? P.nrows : RL, nctx = P.nrows - nlat;
    const int chL = (nlat + F.G - 1) / F.G, chC = (nctx + F.G - 1) / F.G;
    const int r0L = F.vcu * chL, r0C = F.vcu * chC;
    const int nl = r0L >= nlat ? 0 : (r0L + chL <= nlat ? chL : nlat - r0L), nc = r0C >= nctx ? 0 : (r0C + chC <= nctx ? chC : nctx - r0C), nrw = nl + nc;
#define TROW(li_) ((li_) < nl ? r0L + (li_) : RL + r0C + ((li_) - nl))
    LAS float* rwT = (LAS float*)F.lds;
    LAS int* rec = (LAS int*)(F.lds + 32768);
    LAS unsigned* lcnt = (LAS unsigned*)(F.lds + 65536);
    unsigned cb1 = 0, cb2 = 0, cb3 = 0, cb4 = 0, cb5 = 0, cb6 = 0, cb7 = 0;
    if (P.ymode == 2) { unsigned a = 0;
        a += (xb_ld(P.cnt + 0) + 255u) & ~255u; cb1 = a; a += (xb_ld(P.cnt + 1) + 255u) & ~255u; cb2 = a; a += (xb_ld(P.cnt + 2) + 255u) & ~255u; cb3 = a;
        a += (xb_ld(P.cnt + 3) + 255u) & ~255u; cb4 = a; a += (xb_ld(P.cnt + 4) + 255u) & ~255u; cb5 = a; a += (xb_ld(P.cnt + 5) + 255u) & ~255u; cb6 = a;
        a += (xb_ld(P.cnt + 6) + 255u) & ~255u; cb7 = a; }
    if (P.router) {
        for (int i = F.tid; i < 8192; i += 512) { const int col = i >> 3, e = i & 7; rwT[e * 1024 + col] = P.router[i]; }
        if (F.tid < 16) lcnt[F.tid] = 0u;
        __syncthreads();
    }
    LAS int* rtl = (LAS int*)(F.lds + 98304) + F.wave * 6 * 64;
    if (P.ymode == 2) { const int li_ = F.wave + 8 * lane;
        if (li_ < nrw) { const int* rt = P.route + (size_t)TROW(li_) * 8; const u32x4 a = *reinterpret_cast<const u32x4*>(rt); const u32x2 b = *reinterpret_cast<const u32x2*>(rt + 4);
            LAS int* d = rtl + lane * 6; d[0] = (int)a.x; d[1] = (int)a.y; d[2] = (int)a.z; d[3] = (int)a.w; d[4] = (int)b.x; d[5] = (int)b.y; }
        LDS_WAIT(); }
    TH_DECL(A_); TH_DECL(B_);
    int li = F.wave;
    if (li < nrw) TH_LOAD(A_, TROW(li), 0);
    for (int it = 0; li < nrw; li += 16, it += 2) {
        const bool hb = li + 8 < nrw;
        if (hb) TH_LOAD(B_, TROW(li + 8), it + 1);
        thin_proc(P, TH_ARGS(A_), TROW(li), li, lane, rwT, rec, lcnt);
        if (li + 16 < nrw) TH_LOAD(A_, TROW(li + 16), it + 2);
        if (hb) thin_proc(P, TH_ARGS(B_), TROW(li + 8), li + 8, lane, rwT, rec, lcnt);
    }
    if (P.router) {
        __syncthreads();
        if (F.tid < 8) lcnt[8 + F.tid] = __hip_atomic_fetch_add(P.cnt + F.tid, lcnt[F.tid], __ATOMIC_RELAXED, __HIP_MEMORY_SCOPE_AGENT);
        __syncthreads();
        for (int i = F.tid; i < nrw; i += 512) { const LAS int* rc = rec + i * 6; int* rt = P.route + (size_t)TROW(i) * 8;
            const int e0 = rc[0], e1 = rc[2];
            rt[0] = e0; rt[1] = rc[1] + (int)lcnt[8 + e0]; rt[2] = e1; rt[3] = rc[3] + (int)lcnt[8 + e1]; rt[4] = rc[4]; rt[5] = rc[5]; }
        VM_WAIT();
        for (int lb = F.wave; lb < nrw; lb += 32) {
            u32x4 v[4]; size_t s0[4], s1[4];
#pragma unroll
            for (int q = 0; q < 4; ++q) { const int lq = lb + 8 * q; const int r = TROW(lq); if (lq < nrw) { const LAS int* rc = rec + lq * 6; const int e0 = rc[0], e1 = rc[2];
                s0[q] = (size_t)e0 * RT + (size_t)(rc[1] + (int)lcnt[8 + e0]); s1[q] = (size_t)e1 * RT + (size_t)(rc[3] + (int)lcnt[8 + e1]);
                v[q] = *(reinterpret_cast<const u32x4*>((const unsigned char*)P.H + (size_t)r * DM) + lane); } }
#pragma unroll
            for (int q = 0; q < 4; ++q) { if (lb + 8 * q < nrw) {
                *(reinterpret_cast<u32x4*>(P.HSv + s0[q] * DM) + lane) = v[q]; *(reinterpret_cast<u32x4*>(P.HSv + s1[q] * DM) + lane) = v[q]; } }
        }
        __syncthreads();
    }
#undef TROW
}

constexpr int NPHASE = 2 + DEPTH * 9;
__global__ void __launch_bounds__(512, 2) dit_fwd(Args args) {
    extern __shared__ __attribute__((aligned(16))) unsigned char lds[];
    Frame F;
    F.lds = (LAS unsigned char*)lds; F.ldsg = lds; F.MISC = (volatile LAS unsigned*)(F.lds + MISC_OFF);
    F.tid = threadIdx.x; F.lane = F.tid & 63; F.wave = __builtin_amdgcn_readfirstlane(F.tid >> 6);
    F.G = gridDim.x; { const int bx = blockIdx.x; F.vcu = (F.G % 8 == 0) ? (bx % 8) * (F.G / 8) + bx / 8 : bx; }
    F.ctl = (unsigned*)(args.ws + WS_CTL);
    for (int u = F.tid; u < (LDS_BYTES - RING_BYTES) / 4; u += 512) ((LAS unsigned*)(F.lds + RING_BYTES))[u] = 0u;
    __syncthreads();
    XcdBarrier bar = xcd_barrier_post(F.ctl + CW_BAR, F.MISC + 8);
    const int lo = args.ph_lo, hi = args.ph_hi;
    int ph = 0;
#define IN() (lo <= ph && ph < hi)
    unsigned long long wait_acc = 0;
#define SEAM() do { if (lo <= ph && ph + 1 < hi) { if (WAITPROBE) { const unsigned long long t0_ = __builtin_amdgcn_s_memrealtime(); xcd_barrier(bar); const unsigned long long dt_ = __builtin_amdgcn_s_memrealtime() - t0_; const int k_ = ph < 2 ? 9 + ph : (ph - 2) % 9; if ((WAITSEL >> k_) & 1u) wait_acc += dt_; } else xcd_barrier(bar); } ++ph; } while (0)
    GAS unsigned char* wsg = (GAS unsigned char*)args.ws;
#define WSP ((unsigned char*)wsg)
#define pMOD    ((float*)(WSP + WS_MOD))
#define pROPECS ((f32x2*)(WSP + WS_ROPE))
#define pWP     ((bf16_t*)(WSP + WS_WP))
#define pROUTE  ((int*)(WSP + WS_ROUTE))
#define pCS     ((bf16_t*)(WSP + WS_CS))
#define pCSC    ((bf16_t*)(WSP + WS_CSC))
#define pX      ((float*)(WSP + WS_X))
#define pH      ((bf16_t*)(WSP + WS_H))
#define pYO     ((bf16_t*)(WSP + WS_YO))
#define pZ      ((bf16_t*)(WSP + WS_Z))
#define pY      ((bf16_t*)(WSP + WS_Y))
#define pPQT    ((bf16_t*)(WSP + WS_PQT))
#define pPQTC   ((bf16_t*)(WSP + WS_PQTC))
#define pOB     ((bf16_t*)(WSP + WS_O))
#define pA2     ((bf16_t*)(WSP + WS_A2))
#define pA2M    ((bf16_t*)(WSP + WS_A2M))
#define pHS     ((bf16_t*)(WSP + WS_HS))
    const int vcu0 = F.vcu;
#define REFRAME() do { F.tid = opaque(threadIdx.x); F.lane = F.tid & 63; F.wave = __builtin_amdgcn_readfirstlane(F.tid >> 6); F.G = sopaque((int)gridDim.x); F.vcu = sopaque(vcu0); \
        wsg = gptr(args.ws); F.ctl = (unsigned*)(WSP + WS_CTL); } while (0)
    for (int rep0 = 0; rep0 < REP_P0; ++rep0)
    if (IN() && PH_ON(0)) { REFRAME();
        const int gw = F.vcu * 8 + F.wave, NGW = F.G * 8, gt = F.vcu * 512 + F.tid, NGT = F.G * 512;
        LAS float* ctab = (LAS float*)F.lds;
        LAS float* svec = (LAS float*)(F.lds + 16384);
        if (F.tid == 0) *(LAS unsigned*)(F.lds + 126976) = 0u;
        for (int i = F.tid; i < 4096; i += 512) ctab[i] = cospif((float)i * (1.f / 2048.f));
        for (int i = F.tid; i < 9 * 1024; i += 512) { const float v = i < 8192 ? args.c[i] : args.c_ctx[i - 8192]; svec[i] = v / (1.f + __expf(-v)); }
        __syncthreads();
        for (int i = gt; i < 4096 * 1024; i += NGT) { const int k = i >> 10, l0 = (i & 1023) * 8; float v[8];
#pragma unroll
            for (int e = 0; e < 8; ++e) { const int col = l0 + e, l = col & 4095; const int ph_ = (k * l) & 4095; v[e] = col < 4096 ? ctab[ph_] : -ctab[(ph_ - 1024) & 4095]; }
            if (F8_FOUR) *reinterpret_cast<u32x2*>((unsigned char*)pCS + (size_t)k * 8192 + l0) = (u32x2){pk4_fp8(v[0] * F8_SCS, v[1] * F8_SCS, v[2] * F8_SCS, v[3] * F8_SCS), pk4_fp8(v[4] * F8_SCS, v[5] * F8_SCS, v[6] * F8_SCS, v[7] * F8_SCS)};
            else *reinterpret_cast<u32x4*>(pCS + (size_t)k * 8192 + l0) = (u32x4){pk2(v[0], v[1]), pk2(v[2], v[3]), pk2(v[4], v[5]), pk2(v[6], v[7])}; }
        for (int i = gt; i < 256 * 64; i += NGT) { const int k = i >> 6, l0 = (i & 63) * 8; float v[8];
#pragma unroll
            for (int e = 0; e < 8; ++e) { const int col = l0 + e, l = col & 255; const int ph_ = (k * l * 16) & 4095; v[e] = col < 256 ? ctab[ph_] : -ctab[(ph_ - 1024) & 4095]; }
            if (F8_FOUR) *reinterpret_cast<u32x2*>((unsigned char*)pCSC + (size_t)k * 8192 + l0) = (u32x2){pk4_fp8(v[0] * F8_SCS, v[1] * F8_SCS, v[2] * F8_SCS, v[3] * F8_SCS), pk4_fp8(v[4] * F8_SCS, v[5] * F8_SCS, v[6] * F8_SCS, v[7] * F8_SCS)};
            else *reinterpret_cast<u32x4*>(pCSC + (size_t)k * 8192 + l0) = (u32x4){pk2(v[0], v[1]), pk2(v[2], v[3]), pk2(v[4], v[5]), pk2(v[6], v[7])}; }
        for (int i = gt; i < 256 * 128; i += NGT) { const int row = i >> 7, c = i & 127, m = row & 127; const int ph_ = (m * c * 32) & 4095;
            const float v = row < 128 ? ctab[ph_] : ctab[(ph_ - 1024) & 4095]; pWP[i] = (bf16_t)f2bf(v); }
        for (int i = gt; i < 64 * 16; i += NGT) { const int pos = i >> 4, k = i & 15; const float inv = __powf(10000.f, -(float)(2 * k) / 32.f); float s, c; sincosf((float)pos * inv, &s, &c); pROPECS[i] = (f32x2){c, s}; }
        for (int task = F.vcu + F.wave * F.G; task < 512; task += 8 * F.G) { const int layer = task >> 7, col = (task & 127) * 48 + F.lane;
            if (F.lane < 48) {
            const float* w = args.ada_w + (size_t)layer * DM * 6144 + col;
            float a0 = 0, a1 = 0, a2 = 0, a3 = 0, a4 = 0, a5 = 0, a6 = 0, a7 = 0, a8 = 0;
            for (int k0 = 0; k0 < DM; k0 += 32) { float wv[32];
#pragma unroll
                for (int i = 0; i < 32; ++i) wv[i] = w[(size_t)(k0 + i) * 6144];
#pragma unroll
                for (int i = 0; i < 32; ++i) { const int k = k0 + i;
                    a0 += svec[k] * wv[i]; a1 += svec[1024 + k] * wv[i]; a2 += svec[2048 + k] * wv[i]; a3 += svec[3072 + k] * wv[i]; a4 += svec[4096 + k] * wv[i];
                    a5 += svec[5120 + k] * wv[i]; a6 += svec[6144 + k] * wv[i]; a7 += svec[7168 + k] * wv[i]; a8 += svec[8192 + k] * wv[i]; } }
            const float bb = args.ada_b[layer * 6144 + col]; float* mo = pMOD + (size_t)layer * 9 * 6144 + col;
            mo[0] = a0 + bb; mo[6144] = a1 + bb; mo[2 * 6144] = a2 + bb; mo[3 * 6144] = a3 + bb; mo[4 * 6144] = a4 + bb; mo[5 * 6144] = a5 + bb; mo[6 * 6144] = a6 + bb; mo[7 * 6144] = a7 + bb; mo[8 * 6144] = a8 + bb; } }
        LAS float* scr = (LAS float*)(F.lds + 57344 + F.wave * 8448);
        LAS unsigned* wcnt = (LAS unsigned*)(F.lds + 126976);
        constexpr int NITEMS = 2 * (16 * 40) + 2 * (16 * 32) + 2 * (16 * 96) + 2 * (16 * 32) + 2 * (16 * 176) + 2 * (44 * 32) + 16 * (16 * 224) + 16 * (56 * 32);
        for (;;) {
            const int n = __builtin_amdgcn_readfirstlane((int)__hip_atomic_fetch_add(wcnt, F.lane == 0 ? 1u : 0u, __ATOMIC_RELAXED, __HIP_MEMORY_SCOPE_WORKGROUP));
            const int it = ((n >> 3) * F.G + F.vcu) * 8 + (n & 7);
            if (it >= NITEMS) break;
            int r = it;
            if (transpose_job(r, args.mix_in_w, 2, DM, MIXIN, (bf16_t*)(WSP + WS_WMIXIN), false, false, scr, F.lane)) continue;
            if (transpose_job(r, args.mix_out_w, 2, DM, DM, (bf16_t*)(WSP + WS_WMIXOUT), false, false, scr, F.lane)) continue;
            if (transpose_job(r, args.diff_qkv_w, 2, DM, 3072, (bf16_t*)(WSP + WS_WQKV), false, false, scr, F.lane)) continue;
            if (transpose_job(r, args.diff_out_w, 2, DM, DM, (bf16_t*)(WSP + WS_WDOUT), false, false, scr, F.lane)) continue;
            if (transpose_job(r, args.ffn_in_w, 2, DM, 2 * FFN, (bf16_t*)(WSP + WS_WFFNIN), true, F8_DENSE, scr, F.lane)) continue;
            if (transpose_job(r, args.ffn_out_w, 2, FFN, DM, (bf16_t*)(WSP + WS_WFFNOUT), false, F8_DENSE, scr, F.lane)) continue;
            if (transpose_job(r, args.expert_in_w, 16, DM, 2 * EDIM, (bf16_t*)(WSP + WS_WEXPIN), true, true, scr, F.lane)) continue;
            transpose_job(r, args.expert_out_w, 16, EDIM, DM, (bf16_t*)(WSP + WS_WEXPOUT), false, true, scr, F.lane);
        }
        __syncthreads();
    }
    SEAM();
    if (IN() && PH_ON(1)) { REFRAME();
        ThinP P{}; P.nrows = RT; P.xin_lat = args.x; P.xin_ctx = args.ctx; P.ymode = 0; P.H = pH; P.gb = args.norm_g; P.shsc = pMOD;
        for (int rep = 0; rep < REP_P0B; ++rep) thin_phase(F, P);
        for (int rep = 0; rep < EXTRA_BARS; ++rep) xcd_barrier(bar);
    }
    SEAM();

    for (int layer = 0; layer < DEPTH; ++layer) {
        const int j = layer >> 1; const bool even = !(layer & 1), lastl = layer == DEPTH - 1;
        const float* modl = pMOD + (size_t)layer * 9 * 6144; const float* ng = args.norm_g + (size_t)layer * 4 * DM;
        const int Mrows = lastl ? RL : RT;
        if (IN() && PH_ON(2)) { REFRAME();
            pg8::Dims d{DM, DM}; SchedDense S;
            if (even) { S.init(pH, DM, (bf16_t*)(WSP + WS_WMIXIN) + (size_t)j * MIXIN * DM, DM, RT, MIXIN, DM, F.G, (int)blockIdx.x);
                EpiRope E{pZ, MIXIN, 4, 9, pROPECS, 4, 8, QK_C}; for (int rep = 0; rep < REP_PROJ; ++rep) pg8::gemm_phase(F.lds, d, S, E); }
            else { S.init(pH, DM, (bf16_t*)(WSP + WS_WQKV) + (size_t)j * 3072 * DM, DM, RT, 3072, DM, F.G, (int)blockIdx.x);
                EpiRope E{pZ, 3072, 0, 16, pROPECS, 0, 8, QK_C}; for (int rep = 0; rep < REP_PROJ; ++rep) pg8::gemm_phase(F.lds, d, S, E); }
        }
        SEAM();
        if (IN() && PH_ON(3)) { REFRAME();
            if (even) {
                if (PH_ON(16)) { pg8::Dims d{128, MIXIN}; SchedF1 S{(const char*)pWP, (const char*)pZ, F.G, F.vcu}; EpiPQt E{pPQT, pPQTC}; for (int rep = 0; rep < REP_FOUR; ++rep) pg8::gemm_phase(F.lds, d, S, E); }
            } else {
                const float* lv = args.diff_lambda + j * 256;
                const int ln = opaque(F.lane); const float s01 = wave_sum(lv[ln] * lv[64 + ln], ln), s23 = wave_sum(lv[128 + ln] * lv[192 + ln], ln);
                const float lam_init = 0.8f - 0.6f * __expf(-0.3f * (float)layer);
                const float lam = __expf(s01) - __expf(s23) + lam_init;
                const float* subg = args.diff_subln_g + j * 128;
                const int nu = lastl ? 2048 : 2048 + 128;
                for (int rep = 0; rep < REP_DIFF; ++rep)
                for (int u = F.vcu; u < (PH_ON(18) ? nu : 0); u += F.G) {
                    if (u < 2048) diff_attn_unit((char*)lds, pZ, pOB, subg, lam, 1.f - lam_init, u >> 8, (u >> 5) & 7, u & 31, false);
                    else { const int v = u - 2048; diff_attn_unit((char*)lds, pZ, pOB, subg, lam, 1.f - lam_init, v >> 4, (v >> 1) & 7, v & 1, true); }
                }
                __syncthreads();
            }
        }
        SEAM();
        if (IN() && PH_ON(4)) { REFRAME();
            if (even) { pg8::Dims d{F8_FOUR ? 4096 : 8192, F8_FOUR ? 4096 : 8192}; SchedF2 S{(const char*)pCS, (const char*)pCSC, (const char*)pPQT, (const char*)pPQTC, F.G, F.vcu}; EpiFour2 E{pY}; for (int rep = 0; rep < REP_FOUR; ++rep) pg8::gemm_phase<EpiFour2, SchedF2, F8_FOUR>(F.lds, d, S, E);
                const float* sink = args.win_sink + j * 8;
                for (int rep = 0; rep < REP_WIN; ++rep)
                for (int u = F.vcu; u < (PH_ON(17) ? 1024 + 64 : 0); u += F.G) {
                    if (u < 1024) win_attn_unit2((char*)lds, pZ, pY, sink, u >> 7, (u >> 6) & 1, u & 63, false);
                    else { const int v = u - 1024; win_attn_unit2((char*)lds, pZ, pY, sink, v >> 3, (v >> 2) & 1, v & 3, true); }
                }
                __syncthreads();
            }
        }
        if (even) SEAM(); else ++ph;
        if (IN() && PH_ON(5)) { REFRAME();
            pg8::Dims d{DM, DM}; SchedDense S;
            S.init(even ? pY : pOB, DM, (bf16_t*)(WSP + (even ? WS_WMIXOUT : WS_WDOUT)) + (size_t)j * DM * DM, DM, Mrows, DM, DM, F.G, (int)blockIdx.x);
            EpiStore E{pYO, DM, 1.f}; for (int rep = 0; rep < REP_PROJ; ++rep) pg8::gemm_phase(F.lds, d, S, E);
        }
        SEAM();
        if (IN() && PH_ON(6)) { REFRAME();
            ThinP P{}; P.nrows = Mrows; P.xin_lat = layer == 0 ? args.x : pX; P.xin_ctx = layer == 0 ? args.ctx : pX + (size_t)RL * DM;
            P.xout_lat = pX; P.xout_ctx = pX + (size_t)RL * DM; P.ymode = 1; P.Ysrc = pYO; P.gate = modl + 2048; P.ga = ng + DM;
            P.H = pH; P.h8 = !even || F8_DENSE; P.gb = ng + 2 * DM; P.shsc = modl + 3072;
            if (!even) { P.router = args.router_w + (size_t)j * DM * 8; P.route = pROUTE; P.cnt = F.ctl + CW_CNT + 16 * j; P.HSv = (unsigned char*)pHS; }
            thin_phase(F, P);
        }
        SEAM();
        unsigned c0 = 0, c1 = 0, c2 = 0, c3 = 0, c4 = 0, c5 = 0, c6 = 0, c7 = 0;
        if (!even) { unsigned* cn = F.ctl + CW_CNT + 16 * j; unsigned a = 0;
            c0 = 0; a += (rfl(xb_ld(cn + 0)) + 255u) & ~255u; c1 = a; a += (rfl(xb_ld(cn + 1)) + 255u) & ~255u; c2 = a; a += (rfl(xb_ld(cn + 2)) + 255u) & ~255u; c3 = a;
            a += (rfl(xb_ld(cn + 3)) + 255u) & ~255u; c4 = a; a += (rfl(xb_ld(cn + 4)) + 255u) & ~255u; c5 = a; a += (rfl(xb_ld(cn + 5)) + 255u) & ~255u; c6 = a;
            a += (rfl(xb_ld(cn + 6)) + 255u) & ~255u; c7 = a; a += (rfl(xb_ld(cn + 7)) + 255u) & ~255u; c0 = a; }
        ++ph;
        if (IN() && PH_ON(8)) { REFRAME();
            const bool f8 = !even || F8_DENSE; const int eb = f8 ? 1 : 2;
            pg8::Dims d{DM * eb / 2, DM * eb / 2}; SchedGroup S;
            if (even) { S.A = (const char*)pH; S.B = (const char*)(WSP + WS_WFFNIN) + (size_t)j * 2 * FFN * DM * eb; S.nRT = RT / 256; S.P1 = S.P2 = S.P3 = S.P4 = S.P5 = S.P6 = S.P7 = 1 << 30; S.nN = 2 * FFN / 256; S.gB = 0; S.aE = 0; }
            else { S.aE = (size_t)RT * DM; S.A = (const char*)pHS; S.B = (const char*)(WSP + WS_WEXPIN) + (size_t)j * NEXP * 2 * EDIM * DM; S.nRT = (int)(c0 >> 8);
                S.P1 = (int)(c1 >> 8); S.P2 = (int)(c2 >> 8); S.P3 = (int)(c3 >> 8); S.P4 = (int)(c4 >> 8); S.P5 = (int)(c5 >> 8); S.P6 = (int)(c6 >> 8); S.P7 = (int)(c7 >> 8);
                S.nN = 2 * EDIM / 256; S.gB = (size_t)2 * EDIM * DM; }
            S.nwg = S.nRT * S.nN; S.G = F.G; S.c = (int)blockIdx.x; S.nkt = DM * eb / 128; S.tA = (size_t)256 * DM * eb; S.tB = (size_t)256 * DM * eb;
            if (f8) { EpiSwiglu<true> E{(unsigned char*)(even ? pA2 : pA2M), even ? FFN : EDIM, 1.f / (F8_SH * F8_SW)}; for (int rep = 0; rep < REP_MOE; ++rep) pg8::gemm_phase<EpiSwiglu<true>, SchedGroup, true, ALIGN_SWIGLU>(F.lds, d, S, E); }
            else { EpiSwiglu<false> E{(unsigned char*)pA2, FFN, 1.f}; for (int rep = 0; rep < REP_MOE; ++rep) pg8::gemm_phase<EpiSwiglu<false>, SchedGroup, false>(F.lds, d, S, E); }
        }
        SEAM();
        if (IN() && PH_ON(9)) { REFRAME();
            const bool f8 = !even || F8_DENSE; const int eb = f8 ? 1 : 2;
            const int Kh = even ? FFN : EDIM; pg8::Dims d{Kh * eb / 2, Kh * eb / 2}; SchedGroup S;
            if (even) { S.A = (const char*)pA2; S.B = (const char*)(WSP + WS_WFFNOUT) + (size_t)j * DM * FFN * eb; S.nRT = RT / 256; S.P1 = S.P2 = S.P3 = S.P4 = S.P5 = S.P6 = S.P7 = 1 << 30; S.gB = 0; }
            else { S.A = (const char*)pA2M; S.B = (const char*)(WSP + WS_WEXPOUT) + (size_t)j * NEXP * DM * EDIM; S.nRT = (int)(c0 >> 8);
                S.P1 = (int)(c1 >> 8); S.P2 = (int)(c2 >> 8); S.P3 = (int)(c3 >> 8); S.P4 = (int)(c4 >> 8); S.P5 = (int)(c5 >> 8); S.P6 = (int)(c6 >> 8); S.P7 = (int)(c7 >> 8);
                S.gB = (size_t)DM * EDIM; }
            S.aE = 0; S.nN = DM / 256; S.nwg = S.nRT * S.nN; S.G = F.G; S.c = (int)blockIdx.x; S.nkt = Kh * eb / 128; S.tA = (size_t)256 * Kh * eb; S.tB = (size_t)256 * Kh * eb;
            if (f8) { EpiStore E{even ? pYO : pHS, DM, 1.f / (F8_SA * F8_SW)}; for (int rep = 0; rep < REP_MOE; ++rep) pg8::gemm_phase<EpiStore, SchedGroup, true>(F.lds, d, S, E); }
            else { EpiStore E{pYO, DM, 1.f}; for (int rep = 0; rep < REP_MOE; ++rep) pg8::gemm_phase<EpiStore, SchedGroup, false>(F.lds, d, S, E); }
        }
        SEAM();
        if (IN() && PH_ON(10)) { REFRAME();
            ThinP P{}; P.nrows = Mrows; P.xin_lat = pX; P.xin_ctx = pX + (size_t)RL * DM;
            P.xout_lat = lastl ? args.out : pX; P.xout_ctx = pX + (size_t)RL * DM; P.ymode = even ? 1 : 2; P.Ysrc = even ? pYO : pHS; P.gate = modl + 5120; P.ga = ng + 3 * DM;
            P.route = pROUTE; P.cnt = F.ctl + CW_CNT + 16 * j;
            if (!lastl) { P.H = pH; P.gb = ng + 4 * DM; P.shsc = modl + 9 * 6144; }
            thin_phase(F, P);
        }
        SEAM();
    }
    if (WAITPROBE) {
        unsigned* wsum = F.ctl + 48;
        if (threadIdx.x == 0) __hip_atomic_fetch_add(wsum, (unsigned)wait_acc, __ATOMIC_RELAXED, __HIP_MEMORY_SCOPE_AGENT);
        xcd_barrier(bar);
        const unsigned mean = xb_ld(wsum) / gridDim.x; const unsigned long long t0_ = __builtin_amdgcn_s_memrealtime();
        while (__builtin_amdgcn_s_memrealtime() - t0_ < (unsigned long long)mean * WAITPROBE) __builtin_amdgcn_s_sleep(8);
    }
#undef IN
#undef SEAM
#undef REFRAME
}

#ifndef MK_PER_PHASE
#define MK_PER_PHASE 0
#endif
extern "C" void kernel_launch(void* const* d_in, const int* in_sizes, int n_in, void* d_out, int out_size, void* d_ws, size_t ws_size, hipStream_t stream) {
    static int grid = 0;
    if (grid == 0) {
        if (n_in != 19 || in_sizes[0] != RL * DM || out_size != RL * DM || ws_size < WS_END) {
            fprintf(stderr, "kernel_launch: unexpected shapes / workspace (n_in %d in0 %d out %d ws %zu need %zu)\n", n_in, n_in > 0 ? in_sizes[0] : -1, out_size, ws_size, (size_t)WS_END); grid = -1; return; }
        int dev = 0, cus = 0, per_cu = 0;
        if (hipGetDevice(&dev) != hipSuccess || hipDeviceGetAttribute(&cus, hipDeviceAttributeMultiprocessorCount, dev) != hipSuccess) { grid = -1; return; }
        if (hipFuncSetAttribute((const void*)dit_fwd, hipFuncAttributeMaxDynamicSharedMemorySize, LDS_BYTES) != hipSuccess) { fprintf(stderr, "kernel_launch: hipFuncSetAttribute failed\n"); grid = -1; return; }
        if (hipOccupancyMaxActiveBlocksPerMultiprocessor(&per_cu, (const void*)dit_fwd, 512, LDS_BYTES) != hipSuccess || per_cu < 1)
            fprintf(stderr, "kernel_launch: occupancy query reports %d\n", per_cu);
        (void)hipGetLastError();
        grid = cus;
    }
    if (grid < 0) return;
    if (hipMemsetAsync((char*)d_ws + WS_CTL, 0, CTL_BYTES, stream) != hipSuccess) return;
    Args a{};
    const float** ap = (const float**)&a;
    for (int i = 0; i < 19; ++i) ap[i] = (const float*)d_in[i];
    a.out = (float*)d_out; a.ws = (unsigned char*)d_ws;
#if MK_PER_PHASE
    for (int p = 0; p < NPHASE; ++p) { a.ph_lo = p; a.ph_hi = p + 1; hipLaunchKernelGGL(dit_fwd, dim3(grid), dim3(512), LDS_BYTES, stream, a); }
#else
    a.ph_lo = 0; a.ph_hi = NPHASE;
    hipLaunchKernelGGL(dit_fwd, dim3(grid), dim3(512), LDS_BYTES, stream, a);
#endif
}
```

```cpp
#include <hip/hip_runtime.h>
#include <cstdio>
#include <cstdint>

#ifndef PHMASK
#define PHMASK 0xFFFFFFFFu
#endif
#define PH_ON(i) ((PHMASK >> (i)) & 1u)
#ifndef REP_DIFF
#define REP_DIFF 1
#endif
#ifndef REP_MOE
#define REP_MOE 1
#endif
#ifndef REP_P0
#define REP_P0 1
#endif
#ifndef REP_P0B
#define REP_P0B 1
#endif
#ifndef EXTRA_BARS
#define EXTRA_BARS 0
#endif
#ifndef REP_EPI
#define REP_EPI 1
#endif
#ifndef WAITSEL
#define WAITSEL 0xFFFFu
#endif
#ifndef WAITPROBE
#define WAITPROBE 0
#endif
#ifndef KREP
#define KREP 1
#endif
#ifndef REP_PROJ
#define REP_PROJ 1
#endif
#ifndef REP_FOUR
#define REP_FOUR 1
#endif
#ifndef REP_WIN
#define REP_WIN 1
#endif
#define LAS __attribute__((address_space(3)))
#define GAS __attribute__((address_space(1)))
typedef unsigned short bf16_t;
typedef short bf16x8 __attribute__((ext_vector_type(8)));
typedef short s16x4 __attribute__((ext_vector_type(4)));
typedef float f32x2 __attribute__((ext_vector_type(2)));
typedef float f32x4 __attribute__((ext_vector_type(4)));
typedef float f32x16 __attribute__((ext_vector_type(16)));
typedef unsigned u32x2 __attribute__((ext_vector_type(2)));
typedef unsigned u32x4 __attribute__((ext_vector_type(4)));
typedef __bf16 bf16x2_t __attribute__((ext_vector_type(2)));
typedef int v8i_t __attribute__((ext_vector_type(8)));

constexpr int DM = 1024, NB = 8, SEQ = 4096, CTX = 256, DEPTH = 4;
constexpr int RL = NB * SEQ, RC = NB * CTX, RT = RL + RC;
constexpr int MIXIN = 1280, FFN = 2816, NEXP = 8, EDIM = 3584;
constexpr int MAXSLOT = 71680;
constexpr float EPS = 1e-6f;
constexpr float LOG2E = 1.4426950408889634f;
constexpr float QK_C = 0.125f * LOG2E;

constexpr size_t MiB = 1u << 20;
constexpr size_t WS_CTL = 0, CTL_BYTES = 32 * 1024;
constexpr size_t WS_MOD = 1 * MiB;
constexpr size_t WS_ROPE = WS_MOD + 900 * 1024;
constexpr size_t WS_WP = WS_ROPE + 8 * 1024;
constexpr size_t WS_ROUTE = 2 * MiB;
constexpr size_t WS_CS = 4 * MiB;
constexpr size_t WS_CSC = 68 * MiB;
constexpr size_t WS_WMIXIN = 72 * MiB;
constexpr size_t WS_WMIXOUT = 77 * MiB;
constexpr size_t WS_WQKV = 81 * MiB;
constexpr size_t WS_WDOUT = 93 * MiB;
constexpr size_t WS_WFFNIN = 97 * MiB;
constexpr size_t WS_WFFNOUT = 119 * MiB;
constexpr size_t WS_WEXPIN = 130 * MiB;
constexpr size_t WS_WEXPOUT = 354 * MiB;
constexpr size_t WS_X = 466 * MiB;
constexpr size_t WS_H = 602 * MiB;
constexpr size_t WS_YO = 670 * MiB;
constexpr size_t WS_RA = 738 * MiB;
constexpr size_t WS_Z = WS_RA;
constexpr size_t WS_Y = WS_RA + 85 * MiB;
constexpr size_t WS_PQT = WS_RA + 153 * MiB;
constexpr size_t WS_O = WS_RA + 204 * MiB;
constexpr size_t WS_RB = 1010 * MiB;
constexpr size_t WS_A2 = WS_RB;
constexpr size_t WS_PQTC = WS_RB + 190 * MiB;
constexpr size_t WS_A2M = WS_H;
constexpr size_t WS_HS = 1092 * MiB;
constexpr size_t WS_END = 1364 * MiB;
static_assert(WS_A2M + (size_t)MAXSLOT * EDIM * 2 <= WS_HS, "A2m overlay");
static_assert(WS_HS + (size_t)NEXP * RT * DM <= WS_END && WS_HS + (size_t)MAXSLOT * DM * 2 <= WS_END && WS_PQTC + 64 * MiB <= WS_END, "ws end");

constexpr int CW_TMO = 0;
constexpr int CW_CNT = 64;
constexpr int CW_BAR = 4096;

constexpr int RING_BYTES = 131072;
constexpr int MISC_OFF = RING_BYTES + 320;
constexpr int LDS_BYTES = 147456;

__device__ __forceinline__ unsigned cvtpk(float lo, float hi) { f32x2 v = {lo, hi}; bf16x2_t b = __builtin_convertvector(v, bf16x2_t); return __builtin_bit_cast(unsigned, b); }
#ifndef F8_DENSE
#define F8_DENSE false
#endif
#ifndef F8_FOUR
#define F8_FOUR false
#endif
constexpr float F8_SCS = 256.f, F8_SPQ = 8.f;
constexpr float F8_SH = 4.f, F8_SW = 64.f, F8_SA = 4.f;
__device__ __forceinline__ float f8clamp(float v) { return __builtin_amdgcn_fmed3f(v, -448.f, 448.f); }
__device__ __forceinline__ unsigned pk4_fp8(float a, float b, float c, float d) {
    unsigned w = 0; w = __builtin_amdgcn_cvt_pk_fp8_f32(f8clamp(a), f8clamp(b), w, false); w = __builtin_amdgcn_cvt_pk_fp8_f32(f8clamp(c), f8clamp(d), w, true); return w; }
__device__ __forceinline__ float bf_lo(unsigned u) { return __uint_as_float(u << 16); }
__device__ __forceinline__ float bf_hi(unsigned u) { return __uint_as_float(u & 0xffff0000u); }
__device__ __forceinline__ float wave_sum(float v, int lane) {
#pragma unroll
    for (int o = 1; o < 64; o <<= 1) v += __int_as_float(__builtin_amdgcn_ds_bpermute((lane ^ o) << 2, __float_as_int(v)));
    return v;
}
__device__ __forceinline__ unsigned rfl(unsigned v) { return (unsigned)__builtin_amdgcn_readfirstlane((int)v); }
__device__ __forceinline__ const char* uptr(const char* p) {
    unsigned lo = (unsigned)__builtin_amdgcn_readfirstlane((int)(unsigned)(uintptr_t)p), hi = (unsigned)__builtin_amdgcn_readfirstlane((int)(unsigned)((uintptr_t)p >> 32));
    asm volatile("" : "+s"(lo), "+s"(hi));
    return (const char*)(((uintptr_t)hi << 32) | lo);
}
__device__ __forceinline__ GAS unsigned char* gptr(const void* p) {
    unsigned lo = (unsigned)__builtin_amdgcn_readfirstlane((int)(unsigned)(uintptr_t)p), hi = (unsigned)__builtin_amdgcn_readfirstlane((int)(unsigned)((uintptr_t)p >> 32));
    asm volatile("" : "+s"(lo), "+s"(hi));
    return (GAS unsigned char*)(((uintptr_t)hi << 32) | lo);
}
__device__ __forceinline__ int sopaque(int v) { v = __builtin_amdgcn_readfirstlane(v); asm volatile("" : "+s"(v)); return v; }
__device__ __forceinline__ int opaque(int v) { asm volatile("" : "+v"(v)); return v; }
#define LDS_WAIT() asm volatile("s_waitcnt lgkmcnt(0)" ::: "memory")
#define VM_WAIT() asm volatile("s_waitcnt vmcnt(0)" ::: "memory")
#define SBAR() __builtin_amdgcn_sched_barrier(0)

namespace pg8 {
constexpr int BM = 256, BK = 64, HALF = 128, HTB = HALF * BK * 2, STAGE_BYTES = 8 * HTB, NXCD = 8, WGM = 8;
__host__ __device__ __forceinline__ int lds_byte(int r, int c) { const int st = (r >> 4) * 2 + (c >> 5), rr = r & 15, cc = c & 31, ob = rr * 64 + cc * 2; return st * 1024 + (ob ^ (((ob >> 9) & 1) << 5)); }
__host__ __device__ __forceinline__ void stage_rc(int b, int& R, int& C) { const int st = b / 1024, sb = b % 1024, swz = sb ^ (((sb >> 9) & 1) << 5); R = (st >> 1) * 16 + swz / 64; C = (st & 1) * 32 + (swz % 64) / 2; }
__host__ __device__ __forceinline__ int perm32(int rho) { const int n = rho >> 4, i = rho & 15; return 8 * (i >> 2) + 4 * n + (i & 3); }

struct Unit { int pm, pn, e, nkt; };
struct Dims { int lda, ldb; };

__device__ __forceinline__ int xcd_remap(int wgid, int nwg) {
    const int q = nwg / NXCD, r = nwg % NXCD, xcd = wgid % NXCD, off = wgid / NXCD;
    return (xcd < r ? xcd * (q + 1) : r * (q + 1) + (xcd - r) * q) + off;
}

#ifndef ALIGN_SWIGLU
#define ALIGN_SWIGLU true
#endif
#ifndef ALIGN_DEFAULT
#define ALIGN_DEFAULT true
#endif
template <class Epi, class Sched, bool F8 = false, bool ALIGN_EPI = ALIGN_DEFAULT>
__device__ __forceinline__ void gemm_phase(LAS unsigned char* lds, const Dims g, const Sched& S, const Epi& E) {
    const int tid = opaque(threadIdx.x), wid = __builtin_amdgcn_readfirstlane(tid >> 6), lane = tid & 63, wr = wid >> 2, wc = wid & 3, fr = lane & 15, fq = lane >> 4;
    unsigned voffA[2], voffB[2];
#pragma unroll
    for (int i = 0; i < 2; ++i) { int R, C; stage_rc(tid * 16 + i * 8192, R, C); const int Rb = Epi::PERM ? ((R & ~31) + perm32(R & 31)) : R;
        voffA[i] = (unsigned)(R * g.lda + C) * 2u; voffB[i] = (unsigned)(Rb * g.ldb + C) * 2u; }
    const size_t kstep = (size_t)(BK * 2);
    const size_t hstepA = (size_t)HALF * g.lda * 2, hstepB = (size_t)HALF * g.ldb * 2;
    const unsigned ldsw = (unsigned)wid * 1024u;
    const int aoff = lds_byte(wr * 64 + fr, fq * 8), boff = lds_byte(wc * 32 + fr, fq * 8);
#define PG8_SA(b, h) (((b) * 2 + (h)) * HTB)
#define PG8_SB(b, h) ((4 + (b) * 2 + (h)) * HTB)
#define PG8_STAGE(bufoff, gbase, voff) do { _Pragma("unroll") for (int _i = 0; _i < 2; ++_i) \
        __builtin_amdgcn_global_load_lds((const unsigned*)((const char*)(gbase) + (voff)[_i]), (LAS unsigned*)(lds + (bufoff) + ldsw + _i * 8192), 16, 0, 0); } while (0)
#define PG8_LDA(dst, b, h) do { _Pragma("unroll") for (int m = 0; m < 4; ++m) _Pragma("unroll") for (int k = 0; k < 2; ++k) dst[m][k] = *(const LAS bf16x8*)(lds + PG8_SA(b, h) + aoff + m * 2048 + k * 1024); } while (0)
#define PG8_LDB(dst, b, h) do { _Pragma("unroll") for (int n = 0; n < 2; ++n) _Pragma("unroll") for (int k = 0; k < 2; ++k) dst[n][k] = *(const LAS bf16x8*)(lds + PG8_SB(b, h) + boff + n * 2048 + k * 1024); } while (0)
#define PG8_V8(x) __builtin_bit_cast(v8i_t, (x))
#define PG8_MMA(ai, bj, At, Bt) do { __builtin_amdgcn_s_setprio(1); _Pragma("unroll") for (int m = 0; m < 4; ++m) _Pragma("unroll") for (int n = 0; n < 2; ++n) { \
        if constexpr (F8) { struct P2 { bf16x8 a, b; }; const v8i_t a8_ = PG8_V8((P2{Bt[n][0], Bt[n][1]})), b8_ = PG8_V8((P2{At[m][0], At[m][1]})); \
            asm volatile("v_mfma_f32_16x16x128_f8f6f4 %0, %1, %2, %0" : "+v"(acc[ai][bj][m][n]) : "v"(a8_), "v"(b8_)); }   \
        else { _Pragma("unroll") for (int k = 0; k < 2; ++k) acc[ai][bj][m][n] = __builtin_amdgcn_mfma_f32_16x16x32_bf16(Bt[n][k], At[m][k], acc[ai][bj][m][n], 0, 0, 0); } } \
        __builtin_amdgcn_s_setprio(0); } while (0)
#define PG8_WAIT_V(n) asm volatile("s_waitcnt vmcnt(" #n ")" ::: "memory")
#define PG8_WAIT_L(n) asm volatile("s_waitcnt lgkmcnt(" #n ")" ::: "memory")
#define PG8_BAR __builtin_amdgcn_s_barrier()
#define PG8_SCHED __builtin_amdgcn_sched_barrier(0)
    Unit cur, nxt; int ui = 0;
    if (!S.next(0, cur)) return;
    f32x4 acc[2][2][4][2];
#pragma unroll
    for (int a = 0; a < 2; ++a)
#pragma unroll
        for (int b = 0; b < 2; ++b)
#pragma unroll
            for (int m = 0; m < 4; ++m)
#pragma unroll
                for (int n = 0; n < 2; ++n) acc[a][b][m][n] = (f32x4){0.f, 0.f, 0.f, 0.f};
    bf16x8 At[4][2], B0[2][2], B1[2][2];
    const char* cA = uptr(S.aptr(cur)); const char* cB = uptr(S.bptr(cur));
    PG8_STAGE(PG8_SB(0, 0), cB, voffB); PG8_STAGE(PG8_SB(0, 1), cB + hstepB, voffB); PG8_STAGE(PG8_SA(0, 0), cA, voffA); PG8_STAGE(PG8_SA(0, 1), cA + hstepA, voffA);
    if (wr == 1) PG8_BAR;
    PG8_WAIT_V(2); PG8_BAR;
    PG8_STAGE(PG8_SB(1, 0), cB + kstep, voffB); PG8_STAGE(PG8_SA(1, 0), cA + kstep, voffA); PG8_STAGE(PG8_SB(1, 1), cB + hstepB + kstep, voffB);
    PG8_WAIT_V(6); PG8_BAR;
    for (;;) {
        const bool has_next = S.next(ui + 1, nxt);
        const char* nA = uptr(has_next ? S.aptr(nxt) : cA); const char* nB = uptr(has_next ? S.bptr(nxt) : cB);
        const int nt = sopaque(cur.nkt);
        for (int t = 0; t < KREP * nt; t += 2) {
            const bool last = (t == KREP * nt - 2);
            const char* a1 = cA + (size_t)(KREP == 1 ? t + 1 : (t + 1) % nt) * kstep;
            const char* a2 = last ? nA : cA + (size_t)(KREP == 1 ? t + 2 : (t + 2) % nt) * kstep; const char* b2 = last ? nB : cB + (size_t)(KREP == 1 ? t + 2 : (t + 2) % nt) * kstep;
            const char* a3 = a2 + kstep; const char* b3 = b2 + kstep;
            PG8_LDB(B0, 0, 0); PG8_LDB(B1, 0, 1); PG8_SCHED; PG8_LDA(At, 0, 0); PG8_STAGE(PG8_SA(1, 1), a1 + hstepA, voffA);
            PG8_WAIT_V(8); PG8_WAIT_L(0); PG8_BAR; PG8_MMA(0, 0, At, B0); PG8_MMA(0, 1, At, B1); PG8_BAR; PG8_SCHED;
            PG8_LDA(At, 0, 1); PG8_STAGE(PG8_SB(0, 0), b2, voffB); PG8_STAGE(PG8_SB(0, 1), b2 + hstepB, voffB); PG8_STAGE(PG8_SA(0, 0), a2, voffA);
            PG8_WAIT_V(8); PG8_WAIT_L(0); PG8_BAR; PG8_MMA(1, 0, At, B0); PG8_MMA(1, 1, At, B1); PG8_BAR; PG8_SCHED;
            PG8_LDB(B0, 1, 0); PG8_LDB(B1, 1, 1); PG8_SCHED; PG8_LDA(At, 1, 0); PG8_STAGE(PG8_SA(0, 1), a2 + hstepA, voffA);
            PG8_WAIT_V(8); PG8_WAIT_L(0); PG8_BAR; PG8_MMA(0, 0, At, B0); PG8_MMA(0, 1, At, B1); PG8_BAR; PG8_SCHED;
            PG8_LDA(At, 1, 1); PG8_STAGE(PG8_SB(1, 0), b3, voffB); PG8_STAGE(PG8_SB(1, 1), b3 + hstepB, voffB); PG8_STAGE(PG8_SA(1, 0), a3, voffA);
            PG8_WAIT_V(8); PG8_WAIT_L(0); PG8_BAR; PG8_MMA(1, 0, At, B0); PG8_MMA(1, 1, At, B1); PG8_BAR; PG8_SCHED;
        }
        if constexpr (ALIGN_EPI) { if (wr == 0) PG8_BAR; }
        if constexpr (F8) asm volatile("s_nop 15\n\ts_nop 15" ::: "memory");
        for (int repe = 0; repe < REP_EPI; ++repe) { const int l2 = opaque(threadIdx.x) & 63; E(acc, cur, wr, wc, l2 & 15, l2 >> 4); }
        if (!has_next) break;
#pragma unroll
        for (int a = 0; a < 2; ++a)
#pragma unroll
            for (int b = 0; b < 2; ++b)
#pragma unroll
                for (int m = 0; m < 4; ++m)
#pragma unroll
                    for (int n = 0; n < 2; ++n) acc[a][b][m][n] = (f32x4){0.f, 0.f, 0.f, 0.f};
        cur = nxt; cA = nA; cB = nB; ++ui;
        if constexpr (ALIGN_EPI) { if (wr == 1) PG8_BAR; }
    }
    PG8_WAIT_V(0);
    if constexpr (!ALIGN_EPI) { if (wr == 0) PG8_BAR; }
    PG8_BAR;
#undef PG8_SA
#undef PG8_SB
#undef PG8_STAGE
#undef PG8_LDA
#undef PG8_LDB
#undef PG8_MMA
#undef PG8_V8
#undef PG8_WAIT_V
#undef PG8_WAIT_L
#undef PG8_BAR
#undef PG8_SCHED
}
}
using pg8::Unit;

struct EpiStore {
    static constexpr bool PERM = true;
    bf16_t* O; int ldc; float scale;
    __device__ __forceinline__ void operator()(const f32x4 (&acc)[2][2][4][2], const Unit& u, int wr, int wc, int fr, int fq) const {
        const int row0 = u.pm * 256 + wr * 64 + fr, col0 = u.pn * 256 + wc * 32 + 8 * fq;
#pragma unroll
        for (int ai = 0; ai < 2; ++ai)
#pragma unroll
            for (int m = 0; m < 4; ++m) { bf16_t* rowp = O + (size_t)(row0 + ai * 128 + m * 16) * ldc + col0;
#pragma unroll
                for (int bj = 0; bj < 2; ++bj) { const f32x4 v0 = acc[ai][bj][m][0] * (scale * (1.f / KREP)), v1 = acc[ai][bj][m][1] * (scale * (1.f / KREP));
                    u32x4 w; w.x = cvtpk(v0[0], v0[1]); w.y = cvtpk(v0[2], v0[3]); w.z = cvtpk(v1[0], v1[1]); w.w = cvtpk(v1[2], v1[3]);
                    *(u32x4*)(rowp + bj * 128) = w; } }
    }
};
template <bool F8OUT> struct EpiSwiglu {
    static constexpr bool PERM = true;
    unsigned char* O; int ldc; float scale;
    __device__ __forceinline__ void operator()(const f32x4 (&acc)[2][2][4][2], const Unit& u, int wr, int wc, int fr, int fq) const {
        const int row0 = u.pm * 256 + wr * 64 + fr, col0 = u.pn * 128 + wc * 32 + 8 * fq;
        const float us = F8OUT ? scale * F8_SA : scale;
        const float k1 = -scale * LOG2E * (1.f / KREP), ik2 = 1.f / (scale * us * (1.f / KREP) * (1.f / KREP));
#pragma unroll
        for (int ai = 0; ai < 2; ++ai)
#pragma unroll
            for (int m = 0; m < 4; ++m) { unsigned char* rowp = O + ((size_t)(row0 + ai * 128 + m * 16) * ldc + col0) * (F8OUT ? 1 : 2);
                float r[8];
#pragma unroll
                for (int n = 0; n < 2; ++n) { const f32x4 g = acc[ai][0][m][n], u = acc[ai][1][m][n]; const f32x4 t = g * k1;
                    f32x4 e; e[0] = __builtin_amdgcn_exp2f(t[0]); e[1] = __builtin_amdgcn_exp2f(t[1]); e[2] = __builtin_amdgcn_exp2f(t[2]); e[3] = __builtin_amdgcn_exp2f(t[3]);
                    const f32x4 d = e * ik2 + ik2;
                    f32x4 q; q[0] = __builtin_amdgcn_rcpf(d[0]); q[1] = __builtin_amdgcn_rcpf(d[1]); q[2] = __builtin_amdgcn_rcpf(d[2]); q[3] = __builtin_amdgcn_rcpf(d[3]);
                    const f32x4 o = (g * u) * q; r[n * 4 + 0] = o[0]; r[n * 4 + 1] = o[1]; r[n * 4 + 2] = o[2]; r[n * 4 + 3] = o[3]; }
                if constexpr (F8OUT) { u32x2 w; w.x = pk4_fp8(r[0], r[1], r[2], r[3]); w.y = pk4_fp8(r[4], r[5], r[6], r[7]); *(u32x2*)rowp = w; }
                else { u32x4 w; w.x = cvtpk(r[0], r[1]); w.y = cvtpk(r[2], r[3]); w.z = cvtpk(r[4], r[5]); w.w = cvtpk(r[6], r[7]); *(u32x4*)rowp = w; } }
    }
};
struct EpiRope {
    static constexpr bool PERM = false;
    bf16_t* O; int ldc; int rlo, rhi; const f32x2* cs;
    int qlo, qhi; float qscale;
    __device__ __forceinline__ void operator()(const f32x4 (&acc)[2][2][4][2], const Unit& u, int wr, int wc, int fr, int fq) const {
        const int row0 = u.pm * 256 + wr * 64 + fr, col0 = u.pn * 256 + wc * 32 + 4 * fq;
        const bool lat = u.pm < 128;
#pragma unroll
        for (int ai = 0; ai < 2; ++ai)
#pragma unroll
            for (int m = 0; m < 4; ++m) { const int row = row0 + ai * 128 + m * 16; bf16_t* rowp = O + (size_t)row * ldc + col0;
                const int t = row & 4095, pos = (wc & 1) ? (t & 63) : (t >> 6);
                const f32x2* c4 = cs + pos * 16 + 4 * fq;
                const f32x2 c0 = c4[0], c1 = c4[1], c2 = c4[2], c3 = c4[3];
#pragma unroll
                for (int bj = 0; bj < 2; ++bj) { f32x4 p1 = acc[ai][bj][m][0] * (1.f / KREP), p2 = acc[ai][bj][m][1] * (1.f / KREP);
                    const int blk = u.pn * 2 + bj;
                    if (lat && blk >= rlo && blk < rhi) {
                        const f32x4 cv = {c0.x, c1.x, c2.x, c3.x}, sv = {c0.y, c1.y, c2.y, c3.y};
                        const f32x4 o1 = p1 * cv - p2 * sv, o2 = p2 * cv + p1 * sv; p1 = o1; p2 = o2; }
                    if (blk >= qlo && blk < qhi) { p1 = p1 * qscale; p2 = p2 * qscale; }
                    u32x2 w1, w2; w1.x = cvtpk(p1[0], p1[1]); w1.y = cvtpk(p1[2], p1[3]); w2.x = cvtpk(p2[0], p2[1]); w2.y = cvtpk(p2[2], p2[3]);
                    *(u32x2*)(rowp + bj * 128) = w1; *(u32x2*)(rowp + bj * 128 + 16) = w2; } }
    }
};
struct EpiPQt {
    static constexpr bool PERM = true;
    bf16_t* Plat; bf16_t* Pctx;
    __device__ __forceinline__ void operator()(const f32x4 (&acc)[2][2][4][2], const Unit& u, int wr, int wc, int fr, int fq) const {
        const bool ctx = u.e >= 32; const int bg = ctx ? u.e - 32 : u.e; const int L = ctx ? CTX : SEQ;
        constexpr int EB = F8_FOUR ? 1 : 2;
        unsigned char* base = (unsigned char*)(ctx ? Pctx : Plat) + (size_t)bg * 128 * 8192 * EB;
        const int col0 = u.pn * 256 + wc * 32 + 8 * fq;
#pragma unroll
        for (int ai = 0; ai < 2; ++ai)
#pragma unroll
            for (int m = 0; m < 4; ++m) { unsigned char* rowp = base + ((size_t)(wr * 64 + m * 16 + fr) * 8192 + ai * L + col0) * EB;
#pragma unroll
                for (int bj = 0; bj < 2; ++bj) { const f32x4 v0 = acc[ai][bj][m][0] * (1.f / KREP), v1 = acc[ai][bj][m][1] * (1.f / KREP);
                    if constexpr (F8_FOUR) { u32x2 w; w.x = pk4_fp8(v0[0] * F8_SPQ, v0[1] * F8_SPQ, v0[2] * F8_SPQ, v0[3] * F8_SPQ); w.y = pk4_fp8(v1[0] * F8_SPQ, v1[1] * F8_SPQ, v1[2] * F8_SPQ, v1[3] * F8_SPQ); *(u32x2*)(rowp + bj * 128) = w; }
                    else { u32x4 w; w.x = cvtpk(v0[0], v0[1]); w.y = cvtpk(v0[2], v0[3]); w.z = cvtpk(v1[0], v1[1]); w.w = cvtpk(v1[2], v1[3]); *(u32x4*)(rowp + bj * 128 * 2) = w; } } }
    }
};
struct EpiFour2 {
    static constexpr bool PERM = true;
    bf16_t* O;
    __device__ __forceinline__ void operator()(const f32x4 (&acc)[2][2][4][2], const Unit& u, int wr, int wc, int fr, int fq) const {
        EpiStore s{O, DM, (u.pm < 128 ? 0.0013810679320049757f   : 0.005524271728019903f  ) * (F8_FOUR ? 1.f / (F8_SCS * F8_SPQ) : 1.f)};
        s(acc, u, wr, wc, fr, fq);
    }
};

struct SchedDense {
    const char* A; const char* B; int nM, nN, nwg, G, c, nkt; size_t tA, tB;
    __device__ __forceinline__ void init(const void* A_, int lda, const void* B_, int ldb, int M, int N, int K, int G_, int c_) {
        A = (const char*)A_; B = (const char*)B_; nM = M / 256; nN = N / 256; nwg = nM * nN; G = G_; c = c_; nkt = K / 64; tA = (size_t)256 * lda * 2; tB = (size_t)256 * ldb * 2; }
    __device__ __forceinline__ bool next(int i, Unit& u) const {
        const long L = (long)i * G + c; if (L >= nwg) return false;
        const int wgid = pg8::xcd_remap((int)L, nwg);
        const int nig = pg8::WGM * nN, gid = wgid / nig, fm = gid * pg8::WGM, gsz = (nM - fm) < pg8::WGM ? (nM - fm) : pg8::WGM;
        u.pm = fm + ((wgid % nig) % gsz); u.pn = (wgid % nig) / gsz; u.e = 0; u.nkt = nkt; return true;
    }
    __device__ __forceinline__ const char* aptr(const Unit& u) const { return A + (size_t)u.pm * tA; }
    __device__ __forceinline__ const char* bptr(const Unit& u) const { return B + (size_t)u.pn * tB; }
};
struct SchedGroup {
    const char* A; const char* B; int P1, P2, P3, P4, P5, P6, P7, nRT, nN, nwg, G, c, nkt; size_t tA, tB, gB, aE;
    __device__ __forceinline__ bool next(int i, Unit& u) const {
        const long L = (long)i * G + c; if (L >= nwg) return false;
        const int wgid = pg8::xcd_remap((int)L, nwg);
        const int nig = pg8::WGM * nN, gid = wgid / nig, fm = gid * pg8::WGM, gsz = (nRT - fm) < pg8::WGM ? (nRT - fm) : pg8::WGM;
        const int rt = fm + ((wgid % nig) % gsz);
        u.pm = rt; u.pn = (wgid % nig) / gsz; u.nkt = nkt;
        u.e = (rt >= P1) + (rt >= P2) + (rt >= P3) + (rt >= P4) + (rt >= P5) + (rt >= P6) + (rt >= P7); return true;
    }
    __device__ __forceinline__ const char* aptr(const Unit& u) const {
        if (aE == 0) return A + (size_t)u.pm * tA;
        const int pe = u.e == 0 ? 0 : u.e == 1 ? P1 : u.e == 2 ? P2 : u.e == 3 ? P3 : u.e == 4 ? P4 : u.e == 5 ? P5 : u.e == 6 ? P6 : P7;
        return A + (size_t)u.e * aE + (size_t)(u.pm - pe) * tA; }
    __device__ __forceinline__ const char* bptr(const Unit& u) const { return B + (size_t)u.e * gB + (size_t)u.pn * tB; }
};
struct SchedF1 {
    const char* Wp; const char* Z; int G, c;
    __device__ __forceinline__ bool next(int i, Unit& u) const {
        const int L = i * G + c; if (L >= 544) return false;
        u.pm = 0; u.nkt = 2;
        if (L < 512) { u.e = L >> 4; u.pn = L & 15; } else { u.e = 32 + (L - 512); u.pn = 0; }
        return true;
    }
    __device__ __forceinline__ const char* aptr(const Unit&) const { return Wp; }
    __device__ __forceinline__ const char* bptr(const Unit& u) const {
        const bool ctx = u.e >= 32; const int bg = ctx ? u.e - 32 : u.e, b = bg >> 2, gq = bg & 3;
        const size_t row0 = ctx ? (size_t)RL + b * CTX : (size_t)b * SEQ + u.pn * 256;
        return Z + (row0 * MIXIN + gq * 128) * 2; }
};
struct SchedF2 {
    const char* CSl; const char* CSc; const char* Plat; const char* Pctx; int G, vcu;
    static constexpr size_t EB = F8_FOUR ? 1 : 2;
    __device__ __forceinline__ bool next(int i, Unit& u) const {
        const int L = i * G + vcu; if (L >= 272) return false;
        if (L < 256) { const int b = L >> 5, mt = (L & 31) >> 1; u.pm = b * 16 + mt; u.pn = L & 1; u.e = b; u.nkt = F8_FOUR ? 64 : 128; }
        else { const int b = (L - 256) >> 1; u.pm = 128 + b; u.pn = L & 1; u.e = 8 + b; u.nkt = F8_FOUR ? 4 : 8; }
        return true;
    }
    __device__ __forceinline__ const char* aptr(const Unit& u) const { return u.e < 8 ? CSl + (size_t)(u.pm & 15) * 256 * 8192 * EB : CSc; }
    __device__ __forceinline__ const char* bptr(const Unit& u) const { return (u.e < 8 ? Plat + (size_t)u.e * 512 * 8192 * EB : Pctx + (size_t)(u.e - 8) * 512 * 8192 * EB) + (size_t)u.pn * 256 * 8192 * EB; }
};

#define XB_TMO      128
#define XB_XCNT(j)  (256  + 64 * (j))
#define XB_XSUB(j)  (1280 + 64 * (j))
#define XB_XGEN(j)  (2304 + 64 * (j))
#define XB_TOP      3328
#define XB_TOPGEN   3392
#define XCD_BAR_WORDS 3456
#define XB_SPIN_CAP (1u << 21)
__device__ __forceinline__ unsigned xb_ld(unsigned* p)              { return __hip_atomic_load(p, __ATOMIC_RELAXED, __HIP_MEMORY_SCOPE_AGENT); }
__device__ __forceinline__ unsigned xb_add(unsigned* p, unsigned v) { return __hip_atomic_fetch_add(p, v, __ATOMIC_RELAXED, __HIP_MEMORY_SCOPE_AGENT); }
__device__ __forceinline__ unsigned xb_xcc_id() { return (unsigned)__builtin_amdgcn_s_getreg((3 << 11) | 20) & 0xFu; }
#define XB_SPIN(cond, bar) do { unsigned _sp = 0; while (cond) { __builtin_amdgcn_s_sleep(1); \
    if ((++_sp & 255u) == 0u) { if (xb_ld(&(bar)[XB_TMO])) break; if (_sp > XB_SPIN_CAP) { atomicAdd(&(bar)[XB_TMO], 1u); break; } } } } while (0)
struct XcdBarrier { unsigned* bar; unsigned x; volatile LAS unsigned* st; };
__device__ __forceinline__ XcdBarrier xcd_barrier_post(unsigned* bar, volatile LAS unsigned* st) {
    XcdBarrier b; b.bar = bar; b.x = xb_xcc_id(); b.st = st;
    if (threadIdx.x == 0) (void)xb_add(&bar[XB_XCNT(b.x)], 1u);
    return b;
}
__device__ __forceinline__ void xcd_barrier_complete(unsigned* bar, unsigned x, unsigned& nloc, unsigned& nx) {
    const unsigned G = gridDim.x * gridDim.y * gridDim.z;
    unsigned sum, cnt, mine, sp = 0u;
    for (;;) {
        sum = 0u; cnt = 0u; mine = 0u;
#pragma unroll
        for (unsigned j = 0; j < 16; ++j) { const unsigned c = xb_ld(&bar[XB_XCNT(j)]); sum += c; cnt += (c > 0u) ? 1u : 0u; mine = (j == x) ? c : mine; }
        if (sum == G) break;
        __builtin_amdgcn_s_sleep(1);
        if ((++sp & 255u) == 0u) { if (xb_ld(&bar[XB_TMO])) break; if (sp > XB_SPIN_CAP) { atomicAdd(&bar[XB_TMO], 1u); break; } }
    }
    nloc = mine > 0u ? mine : 1u; nx = cnt > 0u ? cnt : 1u;
}
__device__ __forceinline__ void xcd_barrier(const XcdBarrier& b) {
    asm volatile("s_waitcnt vmcnt(0)" ::: "memory");
    __syncthreads();
    if (threadIdx.x == 0) {
        unsigned* bar = (unsigned*)uptr((const char*)b.bar);
        __builtin_amdgcn_s_waitcnt(0);
        unsigned nloc = b.st[0], nx = b.st[1];
        if (nloc == 0u) { xcd_barrier_complete(bar, b.x, nloc, nx); b.st[0] = nloc; b.st[1] = nx; }
        const unsigned old = xb_add(&bar[XB_XSUB(b.x)], 1u);
        const unsigned gen = old / nloc;
        if (old + 1u == (gen + 1u) * nloc) {
            __builtin_amdgcn_fence(__ATOMIC_RELEASE, "agent");
            asm volatile("s_waitcnt vmcnt(0)" ::: "memory");
            const unsigned og = xb_add(&bar[XB_TOP], 1u);
            const unsigned tg = og / nx;
            if (og + 1u == (tg + 1u) * nx) xb_add(&bar[XB_TOPGEN], 1u);
            else XB_SPIN(xb_ld(&bar[XB_TOPGEN]) == tg, bar);
            __builtin_amdgcn_fence(__ATOMIC_ACQUIRE, "agent");
            xb_add(&bar[XB_XGEN(b.x)], 1u);
            asm volatile("s_waitcnt vmcnt(0)" ::: "memory");
        } else {
            XB_SPIN(xb_ld(&bar[XB_XGEN(b.x)]) == gen, bar);
            __builtin_amdgcn_fence(__ATOMIC_ACQUIRE, "agent");
            asm volatile("s_waitcnt vmcnt(0)" ::: "memory");
        }
    }
    __syncthreads();
}

__device__ __forceinline__ int crow(int r, int hi) { return (r & 3) + 8 * (r >> 2) + 4 * hi; }
template <int KW> __device__ __forceinline__ int kswz(int row, int colB) { return KW == 128 ? row * 256 + (colB ^ ((row & 7) << 4)) : row * 128 + (colB ^ (((row >> 1) & 7) << 4)); }
template <int DV> __device__ __forceinline__ int v_st(int k, int c) { const int kk = (k & ~0xC) | ((k & 4) << 1) | ((k & 8) >> 1); return ((kk >> 3) * (DV / 32) + (c >> 5)) * 512 + ((kk & 7) * 32 + (c & 31)) * 2; }
__device__ __forceinline__ int v_rd_base(int lane) { return ((lane & 3) << 3) | (((lane >> 2) & 3) << 6) | (((lane >> 4) & 1) << 5) | (((lane >> 5) & 1) << 8); }
template <int OFF> __device__ __forceinline__ s16x4 tr_read(int vb) { s16x4 r; asm volatile("ds_read_b64_tr_b16 %0, %1 offset:%2" : "=&v"(r) : "v"(vb), "i"(OFF) : "memory"); return r; }
template <int DV, int D0> __device__ __forceinline__ void pv_one(f32x16& od, int vb, bf16x8 pa0, bf16x8 pa1, bf16x8 pa2, bf16x8 pa3) {
    constexpr int KS = (DV / 32) * 1024, HF = (DV / 32) * 512;
    const s16x4 l0 = tr_read<D0 * 512 + 0 * KS>(vb), h0 = tr_read<D0 * 512 + 0 * KS + HF>(vb), l1 = tr_read<D0 * 512 + 1 * KS>(vb), h1 = tr_read<D0 * 512 + 1 * KS + HF>(vb);
    const s16x4 l2 = tr_read<D0 * 512 + 2 * KS>(vb), h2 = tr_read<D0 * 512 + 2 * KS + HF>(vb), l3 = tr_read<D0 * 512 + 3 * KS>(vb), h3 = tr_read<D0 * 512 + 3 * KS + HF>(vb);
    asm volatile("s_waitcnt lgkmcnt(0)" ::: "memory"); SBAR();
#define PKV(L, H) (bf16x8){L[0], L[1], L[2], L[3], H[0], H[1], H[2], H[3]}
    od = __builtin_amdgcn_mfma_f32_32x32x16_bf16(pa0, PKV(l0, h0), od, 0, 0, 0);
    od = __builtin_amdgcn_mfma_f32_32x32x16_bf16(pa1, PKV(l1, h1), od, 0, 0, 0);
    od = __builtin_amdgcn_mfma_f32_32x32x16_bf16(pa2, PKV(l2, h2), od, 0, 0, 0);
    od = __builtin_amdgcn_mfma_f32_32x32x16_bf16(pa3, PKV(l3, h3), od, 0, 0, 0);
#undef PKV
}
#define PV_RD(D0, L, H) do { L[0] = tr_read<(D0) * 512 + 0 * KS>(vb); H[0] = tr_read<(D0) * 512 + 0 * KS + HF>(vb); L[1] = tr_read<(D0) * 512 + 1 * KS>(vb); H[1] = tr_read<(D0) * 512 + 1 * KS + HF>(vb); \
    L[2] = tr_read<(D0) * 512 + 2 * KS>(vb); H[2] = tr_read<(D0) * 512 + 2 * KS + HF>(vb); L[3] = tr_read<(D0) * 512 + 3 * KS>(vb); H[3] = tr_read<(D0) * 512 + 3 * KS + HF>(vb); } while (0)
#define PV_MM(od, L, H) do { od = __builtin_amdgcn_mfma_f32_32x32x16_bf16(pa0, PKV(L[0], H[0]), od, 0, 0, 0); od = __builtin_amdgcn_mfma_f32_32x32x16_bf16(pa1, PKV(L[1], H[1]), od, 0, 0, 0); \
    od = __builtin_amdgcn_mfma_f32_32x32x16_bf16(pa2, PKV(L[2], H[2]), od, 0, 0, 0); od = __builtin_amdgcn_mfma_f32_32x32x16_bf16(pa3, PKV(L[3], H[3]), od, 0, 0, 0); } while (0)
#define PKV(L, H) (bf16x8){L[0], L[1], L[2], L[3], H[0], H[1], H[2], H[3]}
template <int DV> __device__ __forceinline__ void pv_all(f32x16* o, int vb, bf16x8 pa0, bf16x8 pa1, bf16x8 pa2, bf16x8 pa3) {
    constexpr int KS = (DV / 32) * 1024, HF = (DV / 32) * 512;
    s16x4 la[4], ha[4], lb[4], hb[4];
    PV_RD(0, la, ha);
    PV_RD(1, lb, hb); asm volatile("s_waitcnt lgkmcnt(8)" ::: "memory"); SBAR(); PV_MM(o[0], la, ha);
    if constexpr (DV == 128) {
        PV_RD(2, la, ha); asm volatile("s_waitcnt lgkmcnt(8)" ::: "memory"); SBAR(); PV_MM(o[1], lb, hb);
        PV_RD(3, lb, hb); asm volatile("s_waitcnt lgkmcnt(8)" ::: "memory"); SBAR(); PV_MM(o[2], la, ha);
        asm volatile("s_waitcnt lgkmcnt(0)" ::: "memory"); SBAR(); PV_MM(o[3], lb, hb);
    } else {
        asm volatile("s_waitcnt lgkmcnt(0)" ::: "memory"); SBAR(); PV_MM(o[1], lb, hb);
    }
}
#undef PV_RD
#undef PV_MM
#undef PKV
template <int KW> __device__ __forceinline__ void qkt64(f32x16& p0, f32x16& p1, const char* Ks, const bf16x8* qr, int kcb, int r32, int hi) {
    bf16x8 kb0[4], kb1[4];
#pragma unroll
    for (int d0 = 0; d0 < 4; ++d0) { const int cb = kcb + (d0 * 16 + hi * 8) * 2;
        kb0[d0] = *reinterpret_cast<const bf16x8*>(Ks + kswz<KW>(r32, cb));
        kb1[d0] = *reinterpret_cast<const bf16x8*>(Ks + kswz<KW>(32 + r32, cb)); }
    p0 = f32x16{}; p1 = f32x16{};
#pragma unroll
    for (int d0 = 0; d0 < 4; ++d0) {
        p0 = __builtin_amdgcn_mfma_f32_32x32x16_bf16(kb0[d0], qr[d0], p0, 0, 0, 0);
        p1 = __builtin_amdgcn_mfma_f32_32x32x16_bf16(kb1[d0], qr[d0], p1, 0, 0, 0); }
}
template <int KW> __device__ __forceinline__ void qkt64n(f32x16& p0, f32x16& p1, const char* Ks, const bf16x8* qr, int kcb, int r32, int hi, const f32x16& cinit) {
#pragma unroll
    for (int d0 = 0; d0 < 4; ++d0) { const int cb = kcb + (d0 * 16 + hi * 8) * 2;
        const bf16x8 b0 = *reinterpret_cast<const bf16x8*>(Ks + kswz<KW>(r32, cb));
        const bf16x8 b1 = *reinterpret_cast<const bf16x8*>(Ks + kswz<KW>(32 + r32, cb));
        if (d0 == 0) { p0 = __builtin_amdgcn_mfma_f32_32x32x16_bf16(b0, qr[0], cinit, 0, 0, 0); p1 = __builtin_amdgcn_mfma_f32_32x32x16_bf16(b1, qr[0], cinit, 0, 0, 0); }
        else { p0 = __builtin_amdgcn_mfma_f32_32x32x16_bf16(b0, qr[d0], p0, 0, 0, 0); p1 = __builtin_amdgcn_mfma_f32_32x32x16_bf16(b1, qr[d0], p1, 0, 0, 0); } }
}
template <int ND> __device__ __forceinline__ void softmax_step(f32x16& p0, f32x16& p1, float& m_reg, float& l_reg, f32x16* o, float* al_l, int r32, int hi,
                                                              bf16x8& pa0, bf16x8& pa1, bf16x8& pa2, bf16x8& pa3) {
    float pmax = p0[0];
#pragma unroll
    for (int r = 1; r < 16; ++r) pmax = fmaxf(pmax, p0[r]);
#pragma unroll
    for (int r = 0; r < 16; ++r) pmax = fmaxf(pmax, p1[r]);
    { auto rr = __builtin_amdgcn_permlane32_swap(__float_as_uint(pmax), __float_as_uint(pmax), false, false); pmax = fmaxf(__uint_as_float(rr[0]), __uint_as_float(rr[1])); }
    const float mn = fmaxf(m_reg, pmax);
    const float alpha = __builtin_amdgcn_exp2f((m_reg - mn) * QK_C); m_reg = mn;
    const float mnC = -mn * QK_C;
#pragma unroll
    for (int r = 0; r < 16; ++r) { p0[r] = __builtin_amdgcn_exp2f(fmaf(p0[r], QK_C, mnC)); p1[r] = __builtin_amdgcn_exp2f(fmaf(p1[r], QK_C, mnC)); }
    float ps = 0.f;
#pragma unroll
    for (int r = 0; r < 16; ++r) ps += p0[r] + p1[r];
    { auto rr = __builtin_amdgcn_permlane32_swap(__float_as_uint(ps), __float_as_uint(ps), false, false); ps = __uint_as_float(rr[0]) + __uint_as_float(rr[1]); }
    l_reg = l_reg * alpha + ps;
    if (__any(alpha < 1.f)) { if (hi == 0) al_l[r32] = alpha; LDS_WAIT();
#pragma unroll
        for (int d = 0; d < ND; ++d)
#pragma unroll
            for (int r = 0; r < 16; ++r) o[d][r] *= al_l[crow(r, hi)];
    }
#define PK4(P, BASE, OUT) do { unsigned a0 = cvtpk(P[BASE + 0], P[BASE + 1]), a1 = cvtpk(P[BASE + 2], P[BASE + 3]);   \
    unsigned b0 = cvtpk(P[BASE + 4], P[BASE + 5]), b1 = cvtpk(P[BASE + 6], P[BASE + 7]);                              \
    auto r0 = __builtin_amdgcn_permlane32_swap(a0, b0, false, false); auto r1 = __builtin_amdgcn_permlane32_swap(a1, b1, false, false); \
    u32x4 w = {r0[0], r1[0], r0[1], r1[1]}; OUT = *reinterpret_cast<bf16x8*>(&w); } while (0)
    PK4(p0, 0, pa0); PK4(p0, 8, pa1); PK4(p1, 0, pa2); PK4(p1, 8, pa3);
#undef PK4
}

constexpr int AT_K = 0, AT_V = 16384, AT_WS = 32768, AT_XCH = 36864;

__device__ __forceinline__ void win_attn_unit(char* lds, const bf16_t* Z, bf16_t* Y, const float* sink, int b, int kvh, int qc, bool ctxq) {
    const int tid = opaque(threadIdx.x), wid = __builtin_amdgcn_readfirstlane(tid >> 6), lane = tid & 63, r32 = lane & 31, hi = lane >> 5;
    const int head = kvh * 4 + (wid >> 1), qsub = wid & 1;
    const int q0 = qc * 64;
    const size_t qrow0 = (ctxq ? (size_t)RL + b * CTX : (size_t)b * SEQ) + q0 + qsub * 32;
    float* wsf = (float*)(lds + AT_WS) + wid * 128; float* al_l = wsf; float* li_l = wsf + 32;
    bf16x8 qr[4];
    { const bf16_t* qp = Z + (qrow0 + r32) * MIXIN + 512 + head * 64 + hi * 8;
#pragma unroll
      for (int d0 = 0; d0 < 4; ++d0) qr[d0] = *reinterpret_cast<const bf16x8*>(qp + d0 * 16); }
    float m_reg = -1e30f, l_reg = 0.f; f32x16 o[2] = {};
    const int srow = tid >> 3, scol = (tid & 7) * 8;
    const int vb = (int)(uintptr_t)(lds + AT_V) + v_rd_base(lane);
    const int qrel = qsub * 32 + r32;
    const int NT = ctxq ? 4 : 9;
    for (int t = 0; t < NT; ++t) {
        size_t krow; int mode = 0;
        if (t < 4) krow = (size_t)RL + b * CTX + t * 64;
        else { const int p0 = q0 - 128 + (t - 4) * 64; if (p0 < 0 || p0 >= SEQ) continue; krow = (size_t)b * SEQ + p0; mode = (t == 4) ? 1 : (t == 8) ? 2 : 0; }
        __syncthreads();
        { const bf16_t* kp = Z + (krow + srow) * MIXIN + 1024 + kvh * 64 + scol;
          const bf16x8 kv = *reinterpret_cast<const bf16x8*>(kp), vv = *reinterpret_cast<const bf16x8*>(kp + 128);
          *reinterpret_cast<bf16x8*>(lds + AT_K + kswz<64>(srow, scol * 2)) = kv;
          *reinterpret_cast<bf16x8*>(lds + AT_V + v_st<64>(srow, scol)) = vv; }
        __syncthreads();
        f32x16 p0, p1; qkt64<64>(p0, p1, lds + AT_K, qr, 0, r32, hi);
        if (mode == 1) {
#pragma unroll
            for (int r = 0; r < 16; ++r) { const int kk = crow(r, hi); if (kk < qrel) p0[r] = -1e30f; if (kk + 32 < qrel) p1[r] = -1e30f; } }
        else if (mode == 2) {
#pragma unroll
            for (int r = 0; r < 16; ++r) { const int kk = crow(r, hi); if (kk > qrel) p0[r] = -1e30f; if (kk + 32 > qrel) p1[r] = -1e30f; } }
        bf16x8 pa0, pa1, pa2, pa3;
        softmax_step<2>(p0, p1, m_reg, l_reg, o, al_l, r32, hi, pa0, pa1, pa2, pa3);
        pv_one<64, 0>(o[0], vb, pa0, pa1, pa2, pa3); pv_one<64, 1>(o[1], vb, pa0, pa1, pa2, pa3);
    }
    l_reg += __builtin_amdgcn_exp2f(sink[head] * LOG2E - m_reg * QK_C);
    if (hi == 0) li_l[r32] = l_reg; LDS_WAIT();
    bf16_t* yp = Y + qrow0 * DM + 512 + head * 64;
#pragma unroll
    for (int r = 0; r < 16; ++r) { const int orow = crow(r, hi); const float rl = __builtin_amdgcn_rcpf(li_l[orow]);
#pragma unroll
        for (int d0 = 0; d0 < 2; ++d0) { const unsigned w = cvtpk(o[d0][r] * rl, 0.f); yp[(size_t)orow * DM + d0 * 32 + r32] = (bf16_t)(w & 0xffffu); } }
}

constexpr float DA_THR = 8.f;
constexpr float DA_THRL = DA_THR * LOG2E;
template <bool FIRST> __device__ __forceinline__ void da_partialSM(f32x16& p0, f32x16& p1, float& mhat, f32x16& negm, float& alpha) {
    float pmax = fmaxf(p0[0], p0[1]), pmb = fmaxf(p1[0], p1[1]);
#pragma unroll
    for (int r = 2; r < 16; r += 2) { pmax = fmaxf(fmaxf(pmax, p0[r]), p0[r + 1]); pmb = fmaxf(fmaxf(pmb, p1[r]), p1[r + 1]); }
    pmax = fmaxf(pmax, pmb);
    { auto rr = __builtin_amdgcn_permlane32_swap(__float_as_uint(pmax), __float_as_uint(pmax), false, false); pmax = fmaxf(__uint_as_float(rr[0]), __uint_as_float(rr[1])); }
    alpha = 1.f;
    if (FIRST || !__builtin_expect(__all(pmax <= DA_THRL), 1)) {
        const float dl = FIRST ? pmax : fmaxf(pmax, 0.f);
        mhat += dl; alpha = __builtin_amdgcn_exp2f(-dl);
#pragma unroll
        for (int r = 0; r < 16; ++r) { p0[r] -= dl; p1[r] -= dl; negm[r] = -mhat; }
    }
#pragma unroll
    for (int r = 0; r < 16; ++r) p0[r] = __builtin_amdgcn_exp2f(p0[r]);
}
__device__ __forceinline__ void da_finishSM(f32x16& p0, f32x16& p1, float alpha, float& l_reg, bf16x8& pa0, bf16x8& pa1, bf16x8& pa2, bf16x8& pa3) {
#pragma unroll
    for (int r = 0; r < 16; ++r) p1[r] = __builtin_amdgcn_exp2f(p1[r]);
    float s0 = p0[0], s1 = p0[1], s2 = p0[2], s3 = p0[3];
#pragma unroll
    for (int r = 4; r < 16; r += 4) { s0 += p0[r]; s1 += p0[r + 1]; s2 += p0[r + 2]; s3 += p0[r + 3]; }
#pragma unroll
    for (int r = 0; r < 16; r += 4) { s0 += p1[r]; s1 += p1[r + 1]; s2 += p1[r + 2]; s3 += p1[r + 3]; }
    float ps = (s0 + s1) + (s2 + s3);
    { auto rr = __builtin_amdgcn_permlane32_swap(__float_as_uint(ps), __float_as_uint(ps), false, false); ps = __uint_as_float(rr[0]) + __uint_as_float(rr[1]); }
    l_reg = l_reg * alpha + ps;
#define PK4(P, BASE, OUT) do { unsigned a0 = cvtpk(P[BASE + 0], P[BASE + 1]), a1 = cvtpk(P[BASE + 2], P[BASE + 3]);   \
    unsigned b0 = cvtpk(P[BASE + 4], P[BASE + 5]), b1 = cvtpk(P[BASE + 6], P[BASE + 7]);                              \
    auto r0 = __builtin_amdgcn_permlane32_swap(a0, b0, false, false); auto r1 = __builtin_amdgcn_permlane32_swap(a1, b1, false, false); \
    u32x4 w = {r0[0], r1[0], r0[1], r1[1]}; OUT = *reinterpret_cast<bf16x8*>(&w); } while (0)
    PK4(p0, 0, pa0); PK4(p0, 8, pa1); PK4(p1, 0, pa2); PK4(p1, 8, pa3);
#undef PK4
}
__device__ __forceinline__ void da_pv(f32x16* o, int vb, bf16x8 pa0, bf16x8 pa1, bf16x8 pa2, bf16x8 pa3) {
    pv_all<128>(o, vb, pa0, pa1, pa2, pa3);
}
constexpr int DA_V = 0, DA_K = 49152, DA_WS = 81920, DA_XCH = 0;
__device__ __forceinline__ void diff_attn_unit(char* lds, const bf16_t* QKV, bf16_t* O, const float* subg, float lam, float oscale, int b, int h, int qb, bool ctxq) {
    const int tid = opaque(threadIdx.x), wid = __builtin_amdgcn_readfirstlane(tid >> 6), lane = tid & 63, r32 = lane & 31, hi = lane >> 5;
    const int comp = wid >> 2, qsub = wid & 3;
    const size_t qrow0 = (ctxq ? (size_t)RL + b * CTX : (size_t)b * SEQ) + qb * 128 + qsub * 32;
    char* V_lds = lds + DA_V; char* K_lds = lds + DA_K;
    float* wsf = (float*)(lds + DA_WS) + wid * 128; float* al_l = wsf; float* li_l = wsf + 32;
    __syncthreads();
    bf16x8 qr[4];
    { const bf16_t* qp = QKV + (qrow0 + r32) * 3072 + (2 * h + comp) * 64 + hi * 8;
#pragma unroll
      for (int d0 = 0; d0 < 4; ++d0) qr[d0] = *reinterpret_cast<const bf16x8*>(qp + d0 * 16); }
    float m_reg = 0.f, l_reg = 0.f; f32x16 o[4] = {}; f32x16 negm = {};
    const int sr = tid >> 4, sc = (tid & 15) * 8, vst0 = v_st<128>(sr, sc), vst1 = v_st<128>(32 + sr, sc);
    const int vb0 = (int)(uintptr_t)V_lds + v_rd_base(lane);
    const int kcb = comp * 128;
    const bf16_t* kvp = QKV + (size_t)sr * 3072 + 1024 + h * 128 + sc;
    const size_t rowc = (size_t)RL + b * CTX, rowl = (size_t)b * SEQ;
    const int NT = ctxq ? 4 : 68;
    bf16x8 ks0, ks1, vs0, vs1;
#define KROW(t) ((t) < 4 ? rowc + (size_t)(t) * 64 : rowl + (size_t)((t) - 4) * 64)
#define LOADK(t) do { const bf16_t* p_ = kvp + KROW(t) * 3072; ks0 = *reinterpret_cast<const bf16x8*>(p_); ks1 = *reinterpret_cast<const bf16x8*>(p_ + 32 * 3072); } while (0)
#define LOADV(t) do { const bf16_t* p_ = kvp + KROW(t) * 3072 + 1024; vs0 = *reinterpret_cast<const bf16x8*>(p_); vs1 = *reinterpret_cast<const bf16x8*>(p_ + 32 * 3072); } while (0)
#define WRITEK(bf) do { *reinterpret_cast<bf16x8*>(K_lds + (bf) * 16384 + kswz<128>(sr, sc * 2)) = ks0; *reinterpret_cast<bf16x8*>(K_lds + (bf) * 16384 + kswz<128>(32 + sr, sc * 2)) = ks1; } while (0)
#define WRITEV(bf) do { *reinterpret_cast<bf16x8*>(V_lds + (bf) * 16384 + vst0) = vs0; *reinterpret_cast<bf16x8*>(V_lds + (bf) * 16384 + vst1) = vs1; } while (0)
#define RESC(a) do { if (__any((a) < 1.f)) { if (hi == 0) al_l[r32] = (a); LDS_WAIT(); \
    _Pragma("unroll") for (int d = 0; d < 4; ++d) _Pragma("unroll") for (int r = 0; r < 16; ++r) o[d][r] *= al_l[crow(r, hi)]; } } while (0)
#define QKT(P0, P1, kb) do { SBAR(); qkt64n<128>(P0, P1, K_lds + (kb) * 16384, qr, kcb, r32, hi, negm); } while (0)
#define FIN(P0, P1, al) do { da_finishSM(P0, P1, al, l_reg, pa0, pa1, pa2, pa3); SBAR(); } while (0)
#define PVT(vi) da_pv(o, vb0 + (vi) * 16384, pa0, pa1, pa2, pa3)
    f32x16 pA0, pA1, pB0, pB1; float alA = 1.f, alB = 1.f; bf16x8 pa0, pa1, pa2, pa3;
    int vm2 = 1, vm1 = 2, vc = 0;
#define VROT() do { const int t_ = vm2; vm2 = vm1; vm1 = vc; vc = t_; } while (0)
    const bool grpB = comp != 0;
    LOADK(0); VM_WAIT(); WRITEK(0); LOADK(1); LOADV(0); __syncthreads();
    QKT(pA0, pA1, 0);
    if (!grpB) da_partialSM<true>(pA0, pA1, m_reg, negm, alA);
    VM_WAIT(); WRITEK(1); WRITEV(vc); LOADK(2); LOADV(1); VROT();
    __syncthreads();
    if (grpB) da_partialSM<true>(pA0, pA1, m_reg, negm, alA);
    QKT(pB0, pB1, 1); FIN(pA0, pA1, alA);
    if (!grpB) { PVT(vm1); da_partialSM<false>(pB0, pB1, m_reg, negm, alB); RESC(alB); }
    VM_WAIT(); WRITEK(0); WRITEV(vc); LOADK(3); LOADV(2); VROT();
    __syncthreads();
    for (int j = 2; j + 1 < NT; j += 2) {
        if (grpB) { PVT(vm2); da_partialSM<false>(pB0, pB1, m_reg, negm, alB); RESC(alB); }
        QKT(pA0, pA1, 0); FIN(pB0, pB1, alB);
        if (!grpB) { PVT(vm1); da_partialSM<false>(pA0, pA1, m_reg, negm, alA); RESC(alA); }
        VM_WAIT(); WRITEK(1); WRITEV(vc); if (j + 2 < NT) LOADK(j + 2); LOADV(j + 1); VROT();
        __syncthreads();
        if (grpB) { PVT(vm2); da_partialSM<false>(pA0, pA1, m_reg, negm, alA); RESC(alA); }
        QKT(pB0, pB1, 1); FIN(pA0, pA1, alA);
        if (!grpB) { PVT(vm1); da_partialSM<false>(pB0, pB1, m_reg, negm, alB); RESC(alB); }
        VM_WAIT(); if (j + 2 < NT) { WRITEK(0); } WRITEV(vc); if (j + 3 < NT) LOADK(j + 3); if (j + 2 < NT) LOADV(j + 2); VROT();
        __syncthreads();
    }
    if (grpB) { PVT(vm2); da_partialSM<false>(pB0, pB1, m_reg, negm, alB); RESC(alB); }
    FIN(pB0, pB1, alB); PVT(vm1);
#undef LOADK
#undef LOADV
#undef WRITEK
#undef WRITEV
#undef QKT
#undef FIN
#undef PVT
#undef VROT
#define SLOAD(a, b)
#define SWRITE(a, b)
#define SWAIT()
#undef KROW
#undef SLOAD
#undef SWRITE
#undef SWAIT
#undef RESC
    if (hi == 0) li_l[r32] = l_reg; LDS_WAIT();
    float rl[16];
#pragma unroll
    for (int r = 0; r < 16; ++r) rl[r] = __builtin_amdgcn_rcpf(li_l[crow(r, hi)]);
    __syncthreads();
    float* xch = (float*)(lds + DA_XCH) + qsub * (32 * 132);
    if (comp == 1) {
#pragma unroll
        for (int d0 = 0; d0 < 4; ++d0)
#pragma unroll
            for (int r = 0; r < 16; ++r) xch[crow(r, hi) * 132 + d0 * 32 + r32] = o[d0][r] * rl[r];
    }
    __syncthreads();
    if (comp == 0) {
#pragma unroll
        for (int d0 = 0; d0 < 4; ++d0)
#pragma unroll
            for (int r = 0; r < 16; ++r) { const int idx = crow(r, hi) * 132 + d0 * 32 + r32; const float v = o[d0][r] * rl[r] - lam * xch[idx]; xch[idx] = v; }
        LDS_WAIT();
        const int row = lane >> 1, hf = lane & 1; const float* rp = xch + row * 132 + hf * 64;
        f32x4 v[16]; float ss = 0.f;
#pragma unroll
        for (int j = 0; j < 16; ++j) { v[j] = *reinterpret_cast<const f32x4*>(rp + 4 * j); ss += v[j][0] * v[j][0] + v[j][1] * v[j][1] + v[j][2] * v[j][2] + v[j][3] * v[j][3]; }
        ss += __int_as_float(__builtin_amdgcn_ds_bpermute((lane ^ 1) << 2, __float_as_int(ss)));
        const float rs = __builtin_amdgcn_rsqf(ss * (1.f / 128.f) + EPS) * oscale;
        bf16_t* op = O + (qrow0 + row) * DM + h * 128 + hf * 64;
#pragma unroll
        for (int j = 0; j < 16; j += 2) { const f32x4 g0 = *reinterpret_cast<const f32x4*>(subg + hf * 64 + 4 * j), g1 = *reinterpret_cast<const f32x4*>(subg + hf * 64 + 4 * j + 4);
            const f32x4 a = v[j] * g0 * rs, c = v[j + 1] * g1 * rs;
            u32x4 w; w.x = cvtpk(a[0], a[1]); w.y = cvtpk(a[2], a[3]); w.z = cvtpk(c[0], c[1]); w.w = cvtpk(c[2], c[3]);
            *reinterpret_cast<u32x4*>(op + 4 * j) = w; }
    }
}

constexpr int WA_V = 0, WA_K = 16384, WA_WS = 32768, WA_ST = 36864;
__device__ __forceinline__ void wa_mask(f32x16& p0, f32x16& p1, int mode, int qrel, int hi) {
    if (mode == 1) {
#pragma unroll
        for (int r = 0; r < 16; ++r) { const int kk = crow(r, hi); if (kk < qrel) p0[r] = -1e30f; if (kk + 32 < qrel) p1[r] = -1e30f; } }
    else if (mode == 2) {
#pragma unroll
        for (int r = 0; r < 16; ++r) { const int kk = crow(r, hi); if (kk > qrel) p0[r] = -1e30f; if (kk + 32 > qrel) p1[r] = -1e30f; } }
    else if (mode == 3) {
#pragma unroll
        for (int r = 0; r < 16; ++r) { p0[r] = -1e30f; p1[r] = -1e30f; } }
}
__device__ __forceinline__ void win_attn_unit2(char* lds, const bf16_t* Z, bf16_t* Y, const float* sink, int b, int kvh, int qc, bool ctxq) {
    const int tid = opaque(threadIdx.x), wid = __builtin_amdgcn_readfirstlane(tid >> 6), lane = tid & 63, r32 = lane & 31, hi = lane >> 5;
    const int head = kvh * 4 + (wid >> 1), qsub = wid & 1, q0 = qc * 64;
    const size_t rowc = (size_t)RL + b * CTX, rowl = (size_t)b * SEQ;
    const size_t qrow0 = (ctxq ? rowc : rowl) + q0 + qsub * 32;
    char* V_lds = lds + WA_V; char* K_lds = lds + WA_K;
    float* wsf = (float*)(lds + WA_WS) + wid * 128; float* al_l = wsf; float* li_l = wsf + 32;
    __syncthreads();
    bf16x8 qr[4];
    { const bf16_t* qp = Z + (qrow0 + r32) * MIXIN + 512 + head * 64 + hi * 8;
#pragma unroll
      for (int d0 = 0; d0 < 4; ++d0) qr[d0] = *reinterpret_cast<const bf16x8*>(qp + d0 * 16); }
    float m_reg = 0.f, l_reg = 0.f; f32x16 o[2] = {}; f32x16 negm = {};
    const int srow = tid >> 3, scol = (tid & 7) * 8, vst = v_st<64>(srow, scol), kst = kswz<64>(srow, scol * 2);
    const int vb0 = (int)(uintptr_t)V_lds + v_rd_base(lane);
    const bf16_t* kvp = Z + (size_t)srow * MIXIN + 1024 + kvh * 64 + scol;
    const int skip_lo = ctxq ? 0 : (q0 == 0 ? 2 : q0 == 64 ? 1 : 0);
    const int nloc = ctxq ? 0 : 5 - skip_lo - (q0 == SEQ - 64 ? 2 : q0 == SEQ - 128 ? 1 : 0);
    const int NTr = 4 + nloc, NT = (NTr + 1) & ~1;
    const int qrel = qsub * 32 + r32;
    struct { bf16x8 vs, ks; } sr_;
#define KROW(t) ((t) < 4 ? rowc + (size_t)(t) * 64 : (t) < NTr ? rowl + (size_t)(q0 - 128 + ((t) - 4 + skip_lo) * 64) : rowc)
#define TMODE(t) ((t) < 4 ? 0 : (t) >= NTr ? 3 : ((t) - 4 + skip_lo) == 0 ? 1 : ((t) - 4 + skip_lo) == 4 ? 2 : 0)
#define SLOAD(t) do { const bf16_t* p_ = kvp + KROW(t) * MIXIN; sr_.ks = *reinterpret_cast<const bf16x8*>(p_); sr_.vs = *reinterpret_cast<const bf16x8*>(p_ + 128); } while (0)
#define SWRITE(bf) do { *reinterpret_cast<bf16x8*>(V_lds + (bf) * 8192 + vst) = sr_.vs; *reinterpret_cast<bf16x8*>(K_lds + (bf) * 8192 + kst) = sr_.ks; } while (0)
#define SWAIT() asm volatile("s_waitcnt vmcnt(0)" ::: "memory")
#define RESC(a) do { if (__any((a) < 1.f)) { if (hi == 0) al_l[r32] = (a); LDS_WAIT(); \
    _Pragma("unroll") for (int d = 0; d < 2; ++d) _Pragma("unroll") for (int r = 0; r < 16; ++r) o[d][r] *= al_l[crow(r, hi)]; } } while (0)
#define WPV(vb) pv_all<64>(o, (vb), pa0, pa1, pa2, pa3)
    f32x16 pA0, pA1, pB0, pB1; float alA, alB; bf16x8 pa0, pa1, pa2, pa3;
    SLOAD(0); VM_WAIT(); SWRITE(0); __syncthreads();
    qkt64n<64>(pA0, pA1, K_lds, qr, 0, r32, hi, negm); da_partialSM<true>(pA0, pA1, m_reg, negm, alA);
    SLOAD(1);
    SWAIT(); SWRITE(1); __syncthreads();
    for (int j = 1; j + 1 < NT; j += 2) {
        SBAR(); qkt64n<64>(pB0, pB1, K_lds + 8192, qr, 0, r32, hi, negm);
        da_finishSM(pA0, pA1, alA, l_reg, pa0, pa1, pa2, pa3); SBAR();
        SLOAD(j + 1); SBAR();
        WPV(vb0); wa_mask(pB0, pB1, TMODE(j), qrel, hi); da_partialSM<false>(pB0, pB1, m_reg, negm, alB);
        __syncthreads(); SWAIT(); SWRITE(0);
        RESC(alB); __syncthreads();
        SBAR(); qkt64n<64>(pA0, pA1, K_lds, qr, 0, r32, hi, negm);
        da_finishSM(pB0, pB1, alB, l_reg, pa0, pa1, pa2, pa3); SBAR();
        SLOAD(j + 2); SBAR();
        WPV(vb0 + 8192); wa_mask(pA0, pA1, TMODE(j + 1), qrel, hi); da_partialSM<false>(pA0, pA1, m_reg, negm, alA);
        __syncthreads(); SWAIT(); SWRITE(1);
        RESC(alA); __syncthreads();
    }
    SBAR(); qkt64n<64>(pB0, pB1, K_lds + 8192, qr, 0, r32, hi, negm);
    da_finishSM(pA0, pA1, alA, l_reg, pa0, pa1, pa2, pa3); SBAR();
    WPV(vb0); wa_mask(pB0, pB1, TMODE(NT - 1), qrel, hi); da_partialSM<false>(pB0, pB1, m_reg, negm, alB);
    __syncthreads(); RESC(alB);
    da_finishSM(pB0, pB1, alB, l_reg, pa0, pa1, pa2, pa3); SBAR();
    WPV(vb0 + 8192);
#undef KROW
#undef TMODE
#undef SLOAD
#undef SWRITE
#undef SWAIT
#undef RESC
#undef WPV
    l_reg += __builtin_amdgcn_exp2f(sink[head] * LOG2E - m_reg);
    if (hi == 0) li_l[r32] = l_reg; LDS_WAIT();
    bf16_t* stg = (bf16_t*)(lds + WA_ST) + wid * 2048;
#pragma unroll
    for (int r = 0; r < 16; ++r) { const int orow = crow(r, hi); const float rl = __builtin_amdgcn_rcpf(li_l[orow]);
#pragma unroll
        for (int d0 = 0; d0 < 2; ++d0) stg[orow * 64 + d0 * 32 + r32] = (bf16_t)(cvtpk(o[d0][r] * rl, 0.f) & 0xffffu); }
    LDS_WAIT();
    bf16_t* yp = Y + qrow0 * DM + 512 + head * 64;
#pragma unroll
    for (int i = 0; i < 4; ++i) { const int row = i * 8 + (lane >> 3), ch = lane & 7; const u32x4 v = *reinterpret_cast<const u32x4*>(stg + row * 64 + ch * 8); *reinterpret_cast<u32x4*>(yp + (size_t)row * DM + ch * 8) = v; }
}

struct Args {
    const float *x, *c, *ctx, *c_ctx, *ada_w, *ada_b, *norm_g, *mix_in_w, *mix_out_w, *win_sink, *diff_qkv_w, *diff_out_w, *diff_lambda, *diff_subln_g,
                *ffn_in_w, *ffn_out_w, *router_w, *expert_in_w, *expert_out_w;
    float* out; unsigned char* ws; int ph_lo, ph_hi;
};
struct Frame {
    LAS unsigned char* lds; unsigned char* ldsg; volatile LAS unsigned* MISC; unsigned* ctl;
    int tid, lane, wave, vcu, G;
};

__device__ __forceinline__ unsigned f2bf(float f) { unsigned u = __builtin_bit_cast(unsigned, f); return (u + 0x7fffu + ((u >> 16) & 1u)) >> 16; }
__device__ __forceinline__ unsigned pk2(float lo, float hi) { return f2bf(lo) | (f2bf(hi) << 16); }
__device__ __forceinline__ void transpose_item(const float* W, int K, int N, bf16_t* WT, int n0, int c0, int k0, LAS float* scr, int lane) {
#pragma unroll 8
    for (int i = 0; i < 32; ++i) { const int kk = 2 * i + (lane >> 5); scr[kk * 33 + (lane & 31)] = W[(size_t)(k0 + kk) * N + c0 + (lane & 31)]; }
    LDS_WAIT(); asm volatile("" ::: "memory");
    const int c = lane & 7;
#pragma unroll
    for (int j = 0; j < 4; ++j) { const int n = (lane >> 3) + 8 * j; const LAS float* s = scr + (8 * c) * 33 + n;
        u32x4 o; o.x = pk2(s[0 * 33], s[1 * 33]); o.y = pk2(s[2 * 33], s[3 * 33]); o.z = pk2(s[4 * 33], s[5 * 33]); o.w = pk2(s[6 * 33], s[7 * 33]);
        *(u32x4*)(WT + (size_t)(n0 + n) * K + k0 + 8 * c) = o; }
    LDS_WAIT(); asm volatile("" ::: "memory");
}
__device__ __forceinline__ void transpose_item_f8(const float* W, int K, int N, unsigned char* WT, int n0, int c0, int k0, LAS float* scr, int lane) {
#pragma unroll 8
    for (int i = 0; i < 32; ++i) { const int kk = 2 * i + (lane >> 5); scr[kk * 33 + (lane & 31)] = W[(size_t)(k0 + kk) * N + c0 + (lane & 31)] * F8_SW; }
    LDS_WAIT(); asm volatile("" ::: "memory");
    const int c = lane & 7;
#pragma unroll
    for (int j = 0; j < 4; ++j) { const int n = (lane >> 3) + 8 * j; const LAS float* s = scr + (8 * c) * 33 + n;
        u32x2 o; o.x = pk4_fp8(s[0 * 33], s[1 * 33], s[2 * 33], s[3 * 33]); o.y = pk4_fp8(s[4 * 33], s[5 * 33], s[6 * 33], s[7 * 33]);
        *(u32x2*)(WT + (size_t)(n0 + n) * K + k0 + 8 * c) = o; }
    LDS_WAIT(); asm volatile("" ::: "memory");
}
__device__ __forceinline__ bool transpose_job(int& r, const float* W, int nb, int K, int N, void* WT, bool glu, bool f8, LAS float* scr, int lane) {
    const int nblk = N / 32, per = (K / 64) * nblk, tot = nb * per;
    if (r >= tot) { r -= tot; return false; }
    const int mtx = r / per, it = r % per, kb = it / nblk, nbk = it % nblk, n0 = 32 * nbk;
    int c0 = n0;
    if (glu) { const int tile = n0 >> 8, w = n0 & 255; c0 = (w < 128) ? tile * 128 + w : (N >> 1) + tile * 128 + (w - 128); }
    if (f8) transpose_item_f8(W + (size_t)mtx * K * N, K, N, (unsigned char*)WT + (size_t)mtx * K * N, n0, c0, 64 * kb, scr, lane);
    else transpose_item(W + (size_t)mtx * K * N, K, N, (bf16_t*)WT + (size_t)mtx * K * N, n0, c0, 64 * kb, scr, lane);
    return true;
}

struct ThinP {
    int nrows;
    const float* xin_lat; const float* xin_ctx;
    float* xout_lat; float* xout_ctx;
    int ymode;
    const bf16_t* Ysrc; const float* gate; const float* ga;
    bool h8;
    bf16_t* H; const float* gb; const float* shsc;
    const float* router; int* route; unsigned* cnt;
    unsigned char* HSv;
};
#define TH_DECL(PFX) f32x4 PFX##x0 = {}, PFX##x1 = {}, PFX##x2 = {}, PFX##x3 = {}; u32x2 PFX##ya0 = {}, PFX##ya1 = {}, PFX##ya2 = {}, PFX##ya3 = {}, PFX##yb0 = {}, PFX##yb1 = {}, PFX##yb2 = {}, PFX##yb3 = {}; float PFX##w0 = 0.f, PFX##w1 = 0.f
#define TH_LOAD(PFX, r_, it_) do { const int rr_ = (r_); \
    const float* xr_ = (rr_ < RL ? P.xin_lat + (size_t)rr_ * DM : P.xin_ctx + (size_t)(rr_ - RL) * DM) + 4 * lane; \
    PFX##x0 = *reinterpret_cast<const f32x4*>(xr_); PFX##x1 = *reinterpret_cast<const f32x4*>(xr_ + 256); PFX##x2 = *reinterpret_cast<const f32x4*>(xr_ + 512); PFX##x3 = *reinterpret_cast<const f32x4*>(xr_ + 768); \
    const bf16_t* ya_ = P.Ysrc; const bf16_t* yb_ = P.Ysrc; \
    if (P.ymode == 1) ya_ = P.Ysrc + (size_t)rr_ * DM; \
    else if (P.ymode == 2) { const LAS int* rt_ = rtl + (it_) * 6; \
        const int e0_ = rt_[0], p0_ = rt_[1], e1_ = rt_[2], p1_ = rt_[3]; PFX##w0 = __int_as_float(rt_[4]); PFX##w1 = __int_as_float(rt_[5]); \
        const unsigned b0_ = e0_ == 0 ? 0u : e0_ == 1 ? cb1 : e0_ == 2 ? cb2 : e0_ == 3 ? cb3 : e0_ == 4 ? cb4 : e0_ == 5 ? cb5 : e0_ == 6 ? cb6 : cb7; \
        const unsigned b1_ = e1_ == 0 ? 0u : e1_ == 1 ? cb1 : e1_ == 2 ? cb2 : e1_ == 3 ? cb3 : e1_ == 4 ? cb4 : e1_ == 5 ? cb5 : e1_ == 6 ? cb6 : cb7; \
        ya_ = P.Ysrc + (size_t)(b0_ + p0_) * DM; yb_ = P.Ysrc + (size_t)(b1_ + p1_) * DM; } \
    if (P.ymode) { ya_ += 4 * lane; PFX##ya0 = *reinterpret_cast<const u32x2*>(ya_); PFX##ya1 = *reinterpret_cast<const u32x2*>(ya_ + 256); PFX##ya2 = *reinterpret_cast<const u32x2*>(ya_ + 512); PFX##ya3 = *reinterpret_cast<const u32x2*>(ya_ + 768); } \
    if (P.ymode == 2) { yb_ += 4 * lane; PFX##yb0 = *reinterpret_cast<const u32x2*>(yb_); PFX##yb1 = *reinterpret_cast<const u32x2*>(yb_ + 256); PFX##yb2 = *reinterpret_cast<const u32x2*>(yb_ + 512); PFX##yb3 = *reinterpret_cast<const u32x2*>(yb_ + 768); } \
    } while (0)
#define TH_ARGS(PFX) PFX##x0, PFX##x1, PFX##x2, PFX##x3, PFX##ya0, PFX##ya1, PFX##ya2, PFX##ya3, PFX##yb0, PFX##yb1, PFX##yb2, PFX##yb3, PFX##w0, PFX##w1
__device__ __forceinline__ void thin_proc(const ThinP& P, f32x4 x0, f32x4 x1, f32x4 x2, f32x4 x3, u32x2 ya0, u32x2 ya1, u32x2 ya2, u32x2 ya3, u32x2 yb0, u32x2 yb1, u32x2 yb2, u32x2 yb3, float yw0, float yw1,
                                          int r, int li, int lane, LAS float* rwT, LAS int* rec, LAS unsigned* lcnt) {
    const int idx = r < RL ? (r >> 12) : 8;
    f32x4 xv[4] = {x0, x1, x2, x3};
    if (P.ymode) {
        f32x4 yv[4];
#define BF4(w) ((f32x4){bf_lo((w).x), bf_hi((w).x), bf_lo((w).y), bf_hi((w).y)})
        if (P.ymode == 1) { yv[0] = BF4(ya0); yv[1] = BF4(ya1); yv[2] = BF4(ya2); yv[3] = BF4(ya3); }
        else { yv[0] = BF4(ya0) * yw0 + BF4(yb0) * yw1; yv[1] = BF4(ya1) * yw0 + BF4(yb1) * yw1; yv[2] = BF4(ya2) * yw0 + BF4(yb2) * yw1; yv[3] = BF4(ya3) * yw0 + BF4(yb3) * yw1; }
#undef BF4
        float ss = 0.f;
#pragma unroll
        for (int j = 0; j < 4; ++j) ss += yv[j][0] * yv[j][0] + yv[j][1] * yv[j][1] + yv[j][2] * yv[j][2] + yv[j][3] * yv[j][3];
        const float rs = __builtin_amdgcn_rsqf(wave_sum(ss, lane) * (1.f / DM) + EPS);
        const float* gt = P.gate + (size_t)idx * 6144;
#pragma unroll
        for (int j = 0; j < 4; ++j) { const f32x4 g = *reinterpret_cast<const f32x4*>(gt + 4 * lane + 256 * j), a = *reinterpret_cast<const f32x4*>(P.ga + 4 * lane + 256 * j);
            xv[j] = xv[j] + g * (yv[j] * rs * a); }
    }
    if (P.xout_lat) { float* xo = r < RL ? P.xout_lat + (size_t)r * DM : P.xout_ctx + (size_t)(r - RL) * DM;
#pragma unroll
        for (int j = 0; j < 4; ++j) *reinterpret_cast<f32x4*>(xo + 4 * lane + 256 * j) = xv[j]; }
    if (P.H) {
        float ss = 0.f;
#pragma unroll
        for (int j = 0; j < 4; ++j) ss += xv[j][0] * xv[j][0] + xv[j][1] * xv[j][1] + xv[j][2] * xv[j][2] + xv[j][3] * xv[j][3];
        const float rs = __builtin_amdgcn_rsqf(wave_sum(ss, lane) * (1.f / DM) + EPS);
        const float* sh = P.shsc + (size_t)idx * 6144; bf16_t* hr = P.H + (size_t)r * DM;
        f32x4 hv[4];
#pragma unroll
        for (int j = 0; j < 4; ++j) { const f32x4 g = *reinterpret_cast<const f32x4*>(P.gb + 4 * lane + 256 * j), s = *reinterpret_cast<const f32x4*>(sh + 4 * lane + 256 * j), c = *reinterpret_cast<const f32x4*>(sh + 1024 + 4 * lane + 256 * j);
            hv[j] = xv[j] * rs * g * (c + 1.f) + s;
            if (P.h8) { *reinterpret_cast<unsigned*>((unsigned char*)P.H + (size_t)r * DM + 4 * lane + 256 * j) = pk4_fp8(hv[j][0] * F8_SH, hv[j][1] * F8_SH, hv[j][2] * F8_SH, hv[j][3] * F8_SH); }
            else { u32x2 w; w.x = cvtpk(hv[j][0], hv[j][1]); w.y = cvtpk(hv[j][2], hv[j][3]); *reinterpret_cast<u32x2*>(hr + 4 * lane + 256 * j) = w; } }
        if (P.router) {
            float lg[8];
#pragma unroll
            for (int e = 0; e < 8; ++e) { float a = 0.f;
#pragma unroll
                for (int j = 0; j < 4; ++j) { const f32x4 w = *reinterpret_cast<const LAS f32x4*>(rwT + e * 1024 + 4 * lane + 256 * j); a += hv[j][0] * w[0] + hv[j][1] * w[1] + hv[j][2] * w[2] + hv[j][3] * w[3]; }
                lg[e] = wave_sum(a, lane); }
            int i0 = 0; float v0 = lg[0];
#pragma unroll
            for (int e = 1; e < 8; ++e) if (lg[e] > v0) { v0 = lg[e]; i0 = e; }
            int i1 = -1; float v1 = -3.4e38f;
#pragma unroll
            for (int e = 0; e < 8; ++e) if (e != i0 && lg[e] > v1) { v1 = lg[e]; i1 = e; }
            const float w0 = 1.f / (1.f + __expf(v1 - v0)), w1 = 1.f - w0;
            if (lane == 0) { const unsigned lp0 = __hip_atomic_fetch_add(lcnt + i0, 1u, __ATOMIC_RELAXED, __HIP_MEMORY_SCOPE_WORKGROUP), lp1 = __hip_atomic_fetch_add(lcnt + i1, 1u, __ATOMIC_RELAXED, __HIP_MEMORY_SCOPE_WORKGROUP);
                LAS int* rc = rec + li * 6; rc[0] = i0; rc[1] = (int)lp0; rc[2] = i1; rc[3] = (int)lp1; rc[4] = __float_as_int(w0); rc[5] = __float_as_int(w1); }
        }
    }
}
__device__ __forceinline__ void thin_phase(Frame& F, const ThinP& P) {
    const int lane = opaque(F.lane);
    const int nlat = P.nrows < RL ? P.nrows : RL, nctx = P.nrows - nlat;
    const int chL = (nlat + F.G - 1) / F.G, chC = (nctx + F.G - 1) / F.G;
    const int r0L = F.vcu * chL, r0C = F.vcu * chC;
    const int nl = r0L >= nlat ? 0 : (r0L + chL <= nlat ? chL : nlat - r0L), nc = r0C >= nctx ? 0 : (r0C + chC <= nctx ? chC : nctx - r0C), nrw = nl + nc;
#define TROW(li_) ((li_) < nl ? r0L + (li_) : RL + r0C + ((li_) - nl))
    LAS float* rwT = (LAS float*)F.lds;
    LAS int* rec = (LAS int*)(F.lds + 32768);
    LAS unsigned* lcnt = (LAS unsigned*)(F.lds + 65536);
    unsigned cb1 = 0, cb2 = 0, cb3 = 0, cb4 = 0, cb5 = 0, cb6 = 0, cb7 = 0;
    if (P.ymode == 2) { unsigned a = 0;
        a += (xb_ld(P.cnt + 0) + 255u) & ~255u; cb1 = a; a += (xb_ld(P.cnt + 1) + 255u) & ~255u; cb2 = a; a += (xb_ld(P.cnt + 2) + 255u) & ~255u; cb3 = a;
        a += (xb_ld(P.cnt + 3) + 255u) & ~255u; cb4 = a; a += (xb_ld(P.cnt + 4) + 255u) & ~255u; cb5 = a; a += (xb_ld(P.cnt + 5) + 255u) & ~255u; cb6 = a;
        a += (xb_ld(P.cnt + 6) + 255u) & ~255u; cb7 = a; }
    if (P.router) {
        for (int i = F.tid; i < 8192; i += 512) { const int col = i >> 3, e = i & 7; rwT[e * 1024 + col] = P.router[i]; }
        if (F.tid < 16) lcnt[F.tid] = 0u;
        __syncthreads();
    }
    LAS int* rtl = (LAS int*)(F.lds + 98304) + F.wave * 6 * 64;
    if (P.ymode == 2) { const int li_ = F.wave + 8 * lane;
        if (li_ < nrw) { const int* rt = P.route + (size_t)TROW(li_) * 8; const u32x4 a = *reinterpret_cast<const u32x4*>(rt); const u32x2 b = *reinterpret_cast<const u32x2*>(rt + 4);
            LAS int* d = rtl + lane * 6; d[0] = (int)a.x; d[1] = (int)a.y; d[2] = (int)a.z; d[3] = (int)a.w; d[4] = (int)b.x; d[5] = (int)b.y; }
        LDS_WAIT(); }
    TH_DECL(A_); TH_DECL(B_);
    int li = F.wave;
    if (li < nrw) TH_LOAD(A_, TROW(li), 0);
    for (int it = 0; li < nrw; li += 16, it += 2) {
        const bool hb = li + 8 < nrw;
        if (hb) TH_LOAD(B_, TROW(li + 8), it + 1);
        thin_proc(P, TH_ARGS(A_), TROW(li), li, lane, rwT, rec, lcnt);
        if (li + 16 < nrw) TH_LOAD(A_, TROW(li + 16), it + 2);
        if (hb) thin_proc(P, TH_ARGS(B_), TROW(li + 8), li + 8, lane, rwT, rec, lcnt);
    }
    if (P.router) {
        __syncthreads();
        if (F.tid < 8) lcnt[8 + F.tid] = __hip_atomic_fetch_add(P.cnt + F.tid, lcnt[F.tid], __ATOMIC_RELAXED, __HIP_MEMORY_SCOPE_AGENT);
        __syncthreads();
        for (int i = F.tid; i < nrw; i += 512) { const LAS int* rc = rec + i * 6; int* rt = P.route + (size_t)TROW(i) * 8;
            const int e0 = rc[0], e1 = rc[2];
            rt[0] = e0; rt[1] = rc[1] + (int)lcnt[8 + e0]; rt[2] = e1; rt[3] = rc[3] + (int)lcnt[8 + e1]; rt[4] = rc[4]; rt[5] = rc[5]; }
        VM_WAIT();
        for (int lb = F.wave; lb < nrw; lb += 32) {
            u32x4 v[4]; size_t s0[4], s1[4];
#pragma unroll
            for (int q = 0; q < 4; ++q) { const int lq = lb + 8 * q; const int r = TROW(lq); if (lq < nrw) { const LAS int* rc = rec + lq * 6; const int e0 = rc[0], e1 = rc[2];
                s0[q] = (size_t)e0 * RT + (size_t)(rc[1] + (int)lcnt[8 + e0]); s1[q] = (size_t)e1 * RT + (size_t)(rc[3] + (int)lcnt[8 + e1]);
                v[q] = *(reinterpret_cast<const u32x4*>((const unsigned char*)P.H + (size_t)r * DM) + lane); } }
#pragma unroll
            for (int q = 0; q < 4; ++q) { if (lb + 8 * q < nrw) {
                *(reinterpret_cast<u32x4*>(P.HSv + s0[q] * DM) + lane) = v[q]; *(reinterpret_cast<u32x4*>(P.HSv + s1[q] * DM) + lane) = v[q]; } }
        }
        __syncthreads();
    }
#undef TROW
}

constexpr int NPHASE = 2 + DEPTH * 9;
__global__ void __launch_bounds__(512, 2) dit_fwd(Args args) {
    extern __shared__ __attribute__((aligned(16))) unsigned char lds[];
    Frame F;
    F.lds = (LAS unsigned char*)lds; F.ldsg = lds; F.MISC = (volatile LAS unsigned*)(F.lds + MISC_OFF);
    F.tid = threadIdx.x; F.lane = F.tid & 63; F.wave = __builtin_amdgcn_readfirstlane(F.tid >> 6);
    F.G = gridDim.x; { const int bx = blockIdx.x; F.vcu = (F.G % 8 == 0) ? (bx % 8) * (F.G / 8) + bx / 8 : bx; }
    F.ctl = (unsigned*)(args.ws + WS_CTL);
    for (int u = F.tid; u < (LDS_BYTES - RING_BYTES) / 4; u += 512) ((LAS unsigned*)(F.lds + RING_BYTES))[u] = 0u;
    __syncthreads();
    XcdBarrier bar = xcd_barrier_post(F.ctl + CW_BAR, F.MISC + 8);
    const int lo = args.ph_lo, hi = args.ph_hi;
    int ph = 0;
#define IN() (lo <= ph && ph < hi)
    unsigned long long wait_acc = 0;
#define SEAM() do { if (lo <= ph && ph + 1 < hi) { if (WAITPROBE) { const unsigned long long t0_ = __builtin_amdgcn_s_memrealtime(); xcd_barrier(bar); const unsigned long long dt_ = __builtin_amdgcn_s_memrealtime() - t0_; const int k_ = ph < 2 ? 9 + ph : (ph - 2) % 9; if ((WAITSEL >> k_) & 1u) wait_acc += dt_; } else xcd_barrier(bar); } ++ph; } while (0)
    GAS unsigned char* wsg = (GAS unsigned char*)args.ws;
#define WSP ((unsigned char*)wsg)
#define pMOD    ((float*)(WSP + WS_MOD))
#define pROPECS ((f32x2*)(WSP + WS_ROPE))
#define pWP     ((bf16_t*)(WSP + WS_WP))
#define pROUTE  ((int*)(WSP + WS_ROUTE))
#define pCS     ((bf16_t*)(WSP + WS_CS))
#define pCSC    ((bf16_t*)(WSP + WS_CSC))
#define pX      ((float*)(WSP + WS_X))
#define pH      ((bf16_t*)(WSP + WS_H))
#define pYO     ((bf16_t*)(WSP + WS_YO))
#define pZ      ((bf16_t*)(WSP + WS_Z))
#define pY      ((bf16_t*)(WSP + WS_Y))
#define pPQT    ((bf16_t*)(WSP + WS_PQT))
#define pPQTC   ((bf16_t*)(WSP + WS_PQTC))
#define pOB     ((bf16_t*)(WSP + WS_O))
#define pA2     ((bf16_t*)(WSP + WS_A2))
#define pA2M    ((bf16_t*)(WSP + WS_A2M))
#define pHS     ((bf16_t*)(WSP + WS_HS))
    const int vcu0 = F.vcu;
#define REFRAME() do { F.tid = opaque(threadIdx.x); F.lane = F.tid & 63; F.wave = __builtin_amdgcn_readfirstlane(F.tid >> 6); F.G = sopaque((int)gridDim.x); F.vcu = sopaque(vcu0); \
        wsg = gptr(args.ws); F.ctl = (unsigned*)(WSP + WS_CTL); } while (0)
    for (int rep0 = 0; rep0 < REP_P0; ++rep0)
    if (IN() && PH_ON(0)) { REFRAME();
        const int gw = F.vcu * 8 + F.wave, NGW = F.G * 8, gt = F.vcu * 512 + F.tid, NGT = F.G * 512;
        LAS float* ctab = (LAS float*)F.lds;
        LAS float* svec = (LAS float*)(F.lds + 16384);
        if (F.tid == 0) *(LAS unsigned*)(F.lds + 126976) = 0u;
        for (int i = F.tid; i < 4096; i += 512) ctab[i] = cospif((float)i * (1.f / 2048.f));
        for (int i = F.tid; i < 9 * 1024; i += 512) { const float v = i < 8192 ? args.c[i] : args.c_ctx[i - 8192]; svec[i] = v / (1.f + __expf(-v)); }
        __syncthreads();
        for (int i = gt; i < 4096 * 1024; i += NGT) { const int k = i >> 10, l0 = (i & 1023) * 8; float v[8];
#pragma unroll
            for (int e = 0; e < 8; ++e) { const int col = l0 + e, l = col & 4095; const int ph_ = (k * l) & 4095; v[e] = col < 4096 ? ctab[ph_] : -ctab[(ph_ - 1024) & 4095]; }
            if (F8_FOUR) *reinterpret_cast<u32x2*>((unsigned char*)pCS + (size_t)k * 8192 + l0) = (u32x2){pk4_fp8(v[0] * F8_SCS, v[1] * F8_SCS, v[2] * F8_SCS, v[3] * F8_SCS), pk4_fp8(v[4] * F8_SCS, v[5] * F8_SCS, v[6] * F8_SCS, v[7] * F8_SCS)};
            else *reinterpret_cast<u32x4*>(pCS + (size_t)k * 8192 + l0) = (u32x4){pk2(v[0], v[1]), pk2(v[2], v[3]), pk2(v[4], v[5]), pk2(v[6], v[7])}; }
        for (int i = gt; i < 256 * 64; i += NGT) { const int k = i >> 6, l0 = (i & 63) * 8; float v[8];
#pragma unroll
            for (int e = 0; e < 8; ++e) { const int col = l0 + e, l = col & 255; const int ph_ = (k * l * 16) & 4095; v[e] = col < 256 ? ctab[ph_] : -ctab[(ph_ - 1024) & 4095]; }
            if (F8_FOUR) *reinterpret_cast<u32x2*>((unsigned char*)pCSC + (size_t)k * 8192 + l0) = (u32x2){pk4_fp8(v[0] * F8_SCS, v[1] * F8_SCS, v[2] * F8_SCS, v[3] * F8_SCS), pk4_fp8(v[4] * F8_SCS, v[5] * F8_SCS, v[6] * F8_SCS, v[7] * F8_SCS)};
            else *reinterpret_cast<u32x4*>(pCSC + (size_t)k * 8192 + l0) = (u32x4){pk2(v[0], v[1]), pk2(v[2], v[3]), pk2(v[4], v[5]), pk2(v[6], v[7])}; }
        for (int i = gt; i < 256 * 128; i += NGT) { const int row = i >> 7, c = i & 127, m = row & 127; const int ph_ = (m * c * 32) & 4095;
            const float v = row < 128 ? ctab[ph_] : ctab[(ph_ - 1024) & 4095]; pWP[i] = (bf16_t)f2bf(v); }
        for (int i = gt; i < 64 * 16; i += NGT) { const int pos = i >> 4, k = i & 15; const float inv = __powf(10000.f, -(float)(2 * k) / 32.f); float s, c; sincosf((float)pos * inv, &s, &c); pROPECS[i] = (f32x2){c, s}; }
        for (int task = F.vcu + F.wave * F.G; task < 512; task += 8 * F.G) { const int layer = task >> 7, col = (task & 127) * 48 + F.lane;
            if (F.lane < 48) {
            const float* w = args.ada_w + (size_t)layer * DM * 6144 + col;
            float a0 = 0, a1 = 0, a2 = 0, a3 = 0, a4 = 0, a5 = 0, a6 = 0, a7 = 0, a8 = 0;
            for (int k0 = 0; k0 < DM; k0 += 32) { float wv[32];
#pragma unroll
                for (int i = 0; i < 32; ++i) wv[i] = w[(size_t)(k0 + i) * 6144];
#pragma unroll
                for (int i = 0; i < 32; ++i) { const int k = k0 + i;
                    a0 += svec[k] * wv[i]; a1 += svec[1024 + k] * wv[i]; a2 += svec[2048 + k] * wv[i]; a3 += svec[3072 + k] * wv[i]; a4 += svec[4096 + k] * wv[i];
                    a5 += svec[5120 + k] * wv[i]; a6 += svec[6144 + k] * wv[i]; a7 += svec[7168 + k] * wv[i]; a8 += svec[8192 + k] * wv[i]; } }
            const float bb = args.ada_b[layer * 6144 + col]; float* mo = pMOD + (size_t)layer * 9 * 6144 + col;
            mo[0] = a0 + bb; mo[6144] = a1 + bb; mo[2 * 6144] = a2 + bb; mo[3 * 6144] = a3 + bb; mo[4 * 6144] = a4 + bb; mo[5 * 6144] = a5 + bb; mo[6 * 6144] = a6 + bb; mo[7 * 6144] = a7 + bb; mo[8 * 6144] = a8 + bb; } }
        LAS float* scr = (LAS float*)(F.lds + 57344 + F.wave * 8448);
        LAS unsigned* wcnt = (LAS unsigned*)(F.lds + 126976);
        constexpr int NITEMS = 2 * (16 * 40) + 2 * (16 * 32) + 2 * (16 * 96) + 2 * (16 * 32) + 2 * (16 * 176) + 2 * (44 * 32) + 16 * (16 * 224) + 16 * (56 * 32);
        for (;;) {
            const int n = __builtin_amdgcn_readfirstlane((int)__hip_atomic_fetch_add(wcnt, F.lane == 0 ? 1u : 0u, __ATOMIC_RELAXED, __HIP_MEMORY_SCOPE_WORKGROUP));
            const int it = ((n >> 3) * F.G + F.vcu) * 8 + (n & 7);
            if (it >= NITEMS) break;
            int r = it;
            if (transpose_job(r, args.mix_in_w, 2, DM, MIXIN, (bf16_t*)(WSP + WS_WMIXIN), false, false, scr, F.lane)) continue;
            if (transpose_job(r, args.mix_out_w, 2, DM, DM, (bf16_t*)(WSP + WS_WMIXOUT), false, false, scr, F.lane)) continue;
            if (transpose_job(r, args.diff_qkv_w, 2, DM, 3072, (bf16_t*)(WSP + WS_WQKV), false, false, scr, F.lane)) continue;
            if (transpose_job(r, args.diff_out_w, 2, DM, DM, (bf16_t*)(WSP + WS_WDOUT), false, false, scr, F.lane)) continue;
            if (transpose_job(r, args.ffn_in_w, 2, DM, 2 * FFN, (bf16_t*)(WSP + WS_WFFNIN), true, F8_DENSE, scr, F.lane)) continue;
            if (transpose_job(r, args.ffn_out_w, 2, FFN, DM, (bf16_t*)(WSP + WS_WFFNOUT), false, F8_DENSE, scr, F.lane)) continue;
            if (transpose_job(r, args.expert_in_w, 16, DM, 2 * EDIM, (bf16_t*)(WSP + WS_WEXPIN), true, true, scr, F.lane)) continue;
            transpose_job(r, args.expert_out_w, 16, EDIM, DM, (bf16_t*)(WSP + WS_WEXPOUT), false, true, scr, F.lane);
        }
        __syncthreads();
    }
    SEAM();
    if (IN() && PH_ON(1)) { REFRAME();
        ThinP P{}; P.nrows = RT; P.xin_lat = args.x; P.xin_ctx = args.ctx; P.ymode = 0; P.H = pH; P.gb = args.norm_g; P.shsc = pMOD;
        for (int rep = 0; rep < REP_P0B; ++rep) thin_phase(F, P);
        for (int rep = 0; rep < EXTRA_BARS; ++rep) xcd_barrier(bar);
    }
    SEAM();

    for (int layer = 0; layer < DEPTH; ++layer) {
        const int j = layer >> 1; const bool even = !(layer & 1), lastl = layer == DEPTH - 1;
        const float* modl = pMOD + (size_t)layer * 9 * 6144; const float* ng = args.norm_g + (size_t)layer * 4 * DM;
        const int Mrows = lastl ? RL : RT;
        if (IN() && PH_ON(2)) { REFRAME();
            pg8::Dims d{DM, DM}; SchedDense S;
            if (even) { S.init(pH, DM, (bf16_t*)(WSP + WS_WMIXIN) + (size_t)j * MIXIN * DM, DM, RT, MIXIN, DM, F.G, (int)blockIdx.x);
                EpiRope E{pZ, MIXIN, 4, 9, pROPECS, 4, 8, QK_C}; for (int rep = 0; rep < REP_PROJ; ++rep) pg8::gemm_phase(F.lds, d, S, E); }
            else { S.init(pH, DM, (bf16_t*)(WSP + WS_WQKV) + (size_t)j * 3072 * DM, DM, RT, 3072, DM, F.G, (int)blockIdx.x);
                EpiRope E{pZ, 3072, 0, 16, pROPECS, 0, 8, QK_C}; for (int rep = 0; rep < REP_PROJ; ++rep) pg8::gemm_phase(F.lds, d, S, E); }
        }
        SEAM();
        if (IN() && PH_ON(3)) { REFRAME();
            if (even) {
                if (PH_ON(16)) { pg8::Dims d{128, MIXIN}; SchedF1 S{(const char*)pWP, (const char*)pZ, F.G, F.vcu}; EpiPQt E{pPQT, pPQTC}; for (int rep = 0; rep < REP_FOUR; ++rep) pg8::gemm_phase(F.lds, d, S, E); }
            } else {
                const float* lv = args.diff_lambda + j * 256;
                const int ln = opaque(F.lane); const float s01 = wave_sum(lv[ln] * lv[64 + ln], ln), s23 = wave_sum(lv[128 + ln] * lv[192 + ln], ln);
                const float lam_init = 0.8f - 0.6f * __expf(-0.3f * (float)layer);
                const float lam = __expf(s01) - __expf(s23) + lam_init;
                const float* subg = args.diff_subln_g + j * 128;
                const int nu = lastl ? 2048 : 2048 + 128;
                for (int rep = 0; rep < REP_DIFF; ++rep)
                for (int u = F.vcu; u < (PH_ON(18) ? nu : 0); u += F.G) {
                    if (u < 2048) diff_attn_unit((char*)lds, pZ, pOB, subg, lam, 1.f - lam_init, u >> 8, (u >> 5) & 7, u & 31, false);
                    else { const int v = u - 2048; diff_attn_unit((char*)lds, pZ, pOB, subg, lam, 1.f - lam_init, v >> 4, (v >> 1) & 7, v & 1, true); }
                }
                __syncthreads();
            }
        }
        SEAM();
        if (IN() && PH_ON(4)) { REFRAME();
            if (even) { pg8::Dims d{F8_FOUR ? 4096 : 8192, F8_FOUR ? 4096 : 8192}; SchedF2 S{(const char*)pCS, (const char*)pCSC, (const char*)pPQT, (const char*)pPQTC, F.G, F.vcu}; EpiFour2 E{pY}; for (int rep = 0; rep < REP_FOUR; ++rep) pg8::gemm_phase<EpiFour2, SchedF2, F8_FOUR>(F.lds, d, S, E);
                const float* sink = args.win_sink + j * 8;
                for (int rep = 0; rep < REP_WIN; ++rep)
                for (int u = F.vcu; u < (PH_ON(17) ? 1024 + 64 : 0); u += F.G) {
                    if (u < 1024) win_attn_unit2((char*)lds, pZ, pY, sink, u >> 7, (u >> 6) & 1, u & 63, false);
                    else { const int v = u - 1024; win_attn_unit2((char*)lds, pZ, pY, sink, v >> 3, (v >> 2) & 1, v & 3, true); }
                }
                __syncthreads();
            }
        }
        if (even) SEAM(); else ++ph;
        if (IN() && PH_ON(5)) { REFRAME();
            pg8::Dims d{DM, DM}; SchedDense S;
            S.init(even ? pY : pOB, DM, (bf16_t*)(WSP + (even ? WS_WMIXOUT : WS_WDOUT)) + (size_t)j * DM * DM, DM, Mrows, DM, DM, F.G, (int)blockIdx.x);
            EpiStore E{pYO, DM, 1.f}; for (int rep = 0; rep < REP_PROJ; ++rep) pg8::gemm_phase(F.lds, d, S, E);
        }
        SEAM();
        if (IN() && PH_ON(6)) { REFRAME();
            ThinP P{}; P.nrows = Mrows; P.xin_lat = layer == 0 ? args.x : pX; P.xin_ctx = layer == 0 ? args.ctx : pX + (size_t)RL * DM;
            P.xout_lat = pX; P.xout_ctx = pX + (size_t)RL * DM; P.ymode = 1; P.Ysrc = pYO; P.gate = modl + 2048; P.ga = ng + DM;
            P.H = pH; P.h8 = !even || F8_DENSE; P.gb = ng + 2 * DM; P.shsc = modl + 3072;
            if (!even) { P.router = args.router_w + (size_t)j * DM * 8; P.route = pROUTE; P.cnt = F.ctl + CW_CNT + 16 * j; P.HSv = (unsigned char*)pHS; }
            thin_phase(F, P);
        }
        SEAM();
        unsigned c0 = 0, c1 = 0, c2 = 0, c3 = 0, c4 = 0, c5 = 0, c6 = 0, c7 = 0;
        if (!even) { unsigned* cn = F.ctl + CW_CNT + 16 * j; unsigned a = 0;
            c0 = 0; a += (rfl(xb_ld(cn + 0)) + 255u) & ~255u; c1 = a; a += (rfl(xb_ld(cn + 1)) + 255u) & ~255u; c2 = a; a += (rfl(xb_ld(cn + 2)) + 255u) & ~255u; c3 = a;
            a += (rfl(xb_ld(cn + 3)) + 255u) & ~255u; c4 = a; a += (rfl(xb_ld(cn + 4)) + 255u) & ~255u; c5 = a; a += (rfl(xb_ld(cn + 5)) + 255u) & ~255u; c6 = a;
            a += (rfl(xb_ld(cn + 6)) + 255u) & ~255u; c7 = a; a += (rfl(xb_ld(cn + 7)) + 255u) & ~255u; c0 = a; }
        ++ph;
        if (IN() && PH_ON(8)) { REFRAME();
            const bool f8 = !even || F8_DENSE; const int eb = f8 ? 1 : 2;
            pg8::Dims d{DM * eb / 2, DM * eb / 2}; SchedGroup S;
            if (even) { S.A = (const char*)pH; S.B = (const char*)(WSP + WS_WFFNIN) + (size_t)j * 2 * FFN * DM * eb; S.nRT = RT / 256; S.P1 = S.P2 = S.P3 = S.P4 = S.P5 = S.P6 = S.P7 = 1 << 30; S.nN = 2 * FFN / 256; S.gB = 0; S.aE = 0; }
            else { S.aE = (size_t)RT * DM; S.A = (const char*)pHS; S.B = (const char*)(WSP + WS_WEXPIN) + (size_t)j * NEXP * 2 * EDIM * DM; S.nRT = (int)(c0 >> 8);
                S.P1 = (int)(c1 >> 8); S.P2 = (int)(c2 >> 8); S.P3 = (int)(c3 >> 8); S.P4 = (int)(c4 >> 8); S.P5 = (int)(c5 >> 8); S.P6 = (int)(c6 >> 8); S.P7 = (int)(c7 >> 8);
                S.nN = 2 * EDIM / 256; S.gB = (size_t)2 * EDIM * DM; }
            S.nwg = S.nRT * S.nN; S.G = F.G; S.c = (int)blockIdx.x; S.nkt = DM * eb / 128; S.tA = (size_t)256 * DM * eb; S.tB = (size_t)256 * DM * eb;
            if (f8) { EpiSwiglu<true> E{(unsigned char*)(even ? pA2 : pA2M), even ? FFN : EDIM, 1.f / (F8_SH * F8_SW)}; for (int rep = 0; rep < REP_MOE; ++rep) pg8::gemm_phase<EpiSwiglu<true>, SchedGroup, true, ALIGN_SWIGLU>(F.lds, d, S, E); }
            else { EpiSwiglu<false> E{(unsigned char*)pA2, FFN, 1.f}; for (int rep = 0; rep < REP_MOE; ++rep) pg8::gemm_phase<EpiSwiglu<false>, SchedGroup, false>(F.lds, d, S, E); }
        }
        SEAM();
        if (IN() && PH_ON(9)) { REFRAME();
            const bool f8 = !even || F8_DENSE; const int eb = f8 ? 1 : 2;
            const int Kh = even ? FFN : EDIM; pg8::Dims d{Kh * eb / 2, Kh * eb / 2}; SchedGroup S;
            if (even) { S.A = (const char*)pA2; S.B = (const char*)(WSP + WS_WFFNOUT) + (size_t)j * DM * FFN * eb; S.nRT = RT / 256; S.P1 = S.P2 = S.P3 = S.P4 = S.P5 = S.P6 = S.P7 = 1 << 30; S.gB = 0; }
            else { S.A = (const char*)pA2M; S.B = (const char*)(WSP + WS_WEXPOUT) + (size_t)j * NEXP * DM * EDIM; S.nRT = (int)(c0 >> 8);
                S.P1 = (int)(c1 >> 8); S.P2 = (int)(c2 >> 8); S.P3 = (int)(c3 >> 8); S.P4 = (int)(c4 >> 8); S.P5 = (int)(c5 >> 8); S.P6 = (int)(c6 >> 8); S.P7 = (int)(c7 >> 8);
                S.gB = (size_t)DM * EDIM; }
            S.aE = 0; S.nN = DM / 256; S.nwg = S.nRT * S.nN; S.G = F.G; S.c = (int)blockIdx.x; S.nkt = Kh * eb / 128; S.tA = (size_t)256 * Kh * eb; S.tB = (size_t)256 * Kh * eb;
            if (f8) { EpiStore E{even ? pYO : pHS, DM, 1.f / (F8_SA * F8_SW)}; for (int rep = 0; rep < REP_MOE; ++rep) pg8::gemm_phase<EpiStore, SchedGroup, true>(F.lds, d, S, E); }
            else { EpiStore E{pYO, DM, 1.f}; for (int rep = 0; rep < REP_MOE; ++rep) pg8::gemm_phase<EpiStore, SchedGroup, false>(F.lds, d, S, E); }
        }
        SEAM();
        if (IN() && PH_ON(10)) { REFRAME();
            ThinP P{}; P.nrows = Mrows; P.xin_lat = pX; P.xin_ctx = pX + (size_t)RL * DM;
            P.xout_lat = lastl ? args.out : pX; P.xout_ctx = pX + (size_t)RL * DM; P.ymode = even ? 1 : 2; P.Ysrc = even ? pYO : pHS; P.gate = modl + 5120; P.ga = ng + 3 * DM;
            P.route = pROUTE; P.cnt = F.ctl + CW_CNT + 16 * j;
            if (!lastl) { P.H = pH; P.gb = ng + 4 * DM; P.shsc = modl + 9 * 6144; }
            thin_phase(F, P);
        }
        SEAM();
    }
    if (WAITPROBE) {
        unsigned* wsum = F.ctl + 48;
        if (threadIdx.x == 0) __hip_atomic_fetch_add(wsum, (unsigned)wait_acc, __ATOMIC_RELAXED, __HIP_MEMORY_SCOPE_AGENT);
        xcd_barrier(bar);
        const unsigned mean = xb_ld(wsum) / gridDim.x; const unsigned long long t0_ = __builtin_amdgcn_s_memrealtime();
        while (__builtin_amdgcn_s_memrealtime() - t0_ < (unsigned long long)mean * WAITPROBE) __builtin_amdgcn_s_sleep(8);
    }
#undef IN
#undef SEAM
#undef REFRAME
}

#ifndef MK_PER_PHASE
#define MK_PER_PHASE 0
#endif
extern "C" void kernel_launch(void* const* d_in, const int* in_sizes, int n_in, void* d_out, int out_size, void* d_ws, size_t ws_size, hipStream_t stream) {
    static int grid = 0;
    if (grid == 0) {
        if (n_in != 19 || in_sizes[0] != RL * DM || out_size != RL * DM || ws_size < WS_END) {
            fprintf(stderr, "kernel_launch: unexpected shapes / workspace (n_in %d in0 %d out %d ws %zu need %zu)\n", n_in, n_in > 0 ? in_sizes[0] : -1, out_size, ws_size, (size_t)WS_END); grid = -1; return; }
        int dev = 0, cus = 0, per_cu = 0;
        if (hipGetDevice(&dev) != hipSuccess || hipDeviceGetAttribute(&cus, hipDeviceAttributeMultiprocessorCount, dev) != hipSuccess) { grid = -1; return; }
        if (hipFuncSetAttribute((const void*)dit_fwd, hipFuncAttributeMaxDynamicSharedMemorySize, LDS_BYTES) != hipSuccess) { fprintf(stderr, "kernel_launch: hipFuncSetAttribute failed\n"); grid = -1; return; }
        if (hipOccupancyMaxActiveBlocksPerMultiprocessor(&per_cu, (const void*)dit_fwd, 512, LDS_BYTES) != hipSuccess || per_cu < 1)
            fprintf(stderr, "kernel_launch: occupancy query reports %d\n", per_cu);
        (void)hipGetLastError();
        grid = cus;
    }
    if (grid < 0) return;
    if (hipMemsetAsync((char*)d_ws + WS_CTL, 0, CTL_BYTES, stream) != hipSuccess) return;
    Args a{};
    const float** ap = (const float**)&a;
    for (int i = 0; i < 19; ++i) ap[i] = (const float*)d_in[i];
    a.out = (float*)d_out; a.ws = (unsigned char*)d_ws;
#if MK_PER_PHASE
    for (int p = 0; p < NPHASE; ++p) { a.ph_lo = p; a.ph_hi = p + 1; hipLaunchKernelGGL(dit_fwd, dim3(grid), dim3(512), LDS_BYTES, stream, a); }
#else
    a.ph_lo = 0; a.ph_hi = NPHASE;
    hipLaunchKernelGGL(dit_fwd, dim3(grid), dim3(512), LDS_BYTES, stream, a);
#endif
}
```

```cpp
#include <hip/hip_runtime.h>
#include <cstdio>
#include <cstdint>

#ifndef PHMASK
#define PHMASK 0xFFFFFFFFu
#endif
#define PH_ON(i) ((PHMASK >> (i)) & 1u)
#ifndef REP_DIFF
#define REP_DIFF 1
#endif
#ifndef REP_MOE
#define REP_MOE 1
#endif
#ifndef REP_P0
#define REP_P0 1
#endif
#ifndef REP_P0B
#define REP_P0B 1
#endif
#ifndef EXTRA_BARS
#define EXTRA_BARS 0
#endif
#ifndef REP_EPI
#define REP_EPI 1
#endif
#ifndef WAITSEL
#define WAITSEL 0xFFFFu
#endif
#ifndef WAITPROBE
#define WAITPROBE 0
#endif
#ifndef KREP
#define KREP 1
#endif
#ifndef REP_PROJ
#define REP_PROJ 1
#endif
#ifndef REP_FOUR
#define REP_FOUR 1
#endif
#ifndef REP_WIN
#define REP_WIN 1
#endif
#define LAS __attribute__((address_space(3)))
#define GAS __attribute__((address_space(1)))
typedef unsigned short bf16_t;
typedef short bf16x8 __attribute__((ext_vector_type(8)));
typedef short s16x4 __attribute__((ext_vector_type(4)));
typedef float f32x2 __attribute__((ext_vector_type(2)));
typedef float f32x4 __attribute__((ext_vector_type(4)));
typedef float f32x16 __attribute__((ext_vector_type(16)));
typedef unsigned u32x2 __attribute__((ext_vector_type(2)));
typedef unsigned u32x4 __attribute__((ext_vector_type(4)));
typedef __bf16 bf16x2_t __attribute__((ext_vector_type(2)));
typedef int v8i_t __attribute__((ext_vector_type(8)));

constexpr int DM = 1024, NB = 8, SEQ = 4096, CTX = 256, DEPTH = 4;
constexpr int RL = NB * SEQ, RC = NB * CTX, RT = RL + RC;
constexpr int MIXIN = 1280, FFN = 2816, NEXP = 8, EDIM = 3584;
constexpr int MAXSLOT = 71680;
constexpr float EPS = 1e-6f;
constexpr float LOG2E = 1.4426950408889634f;
constexpr float QK_C = 0.125f * LOG2E;

constexpr size_t MiB = 1u << 20;
constexpr size_t WS_CTL = 0, CTL_BYTES = 32 * 1024;
constexpr size_t WS_MOD = 1 * MiB;
constexpr size_t WS_ROPE = WS_MOD + 900 * 1024;
constexpr size_t WS_WP = WS_ROPE + 8 * 1024;
constexpr size_t WS_ROUTE = 2 * MiB;
constexpr size_t WS_CS = 4 * MiB;
constexpr size_t WS_CSC = 68 * MiB;
constexpr size_t WS_WMIXIN = 72 * MiB;
constexpr size_t WS_WMIXOUT = 77 * MiB;
constexpr size_t WS_WQKV = 81 * MiB;
constexpr size_t WS_WDOUT = 93 * MiB;
constexpr size_t WS_WFFNIN = 97 * MiB;
constexpr size_t WS_WFFNOUT = 119 * MiB;
constexpr size_t WS_WEXPIN = 130 * MiB;
constexpr size_t WS_WEXPOUT = 354 * MiB;
constexpr size_t WS_X = 466 * MiB;
constexpr size_t WS_H = 602 * MiB;
constexpr size_t WS_YO = 670 * MiB;
constexpr size_t WS_RA = 738 * MiB;
constexpr size_t WS_Z = WS_RA;
constexpr size_t WS_Y = WS_RA + 85 * MiB;
constexpr size_t WS_PQT = WS_RA + 153 * MiB;
constexpr size_t WS_O = WS_RA + 204 * MiB;
constexpr size_t WS_RB = 1010 * MiB;
constexpr size_t WS_A2 = WS_RB;
constexpr size_t WS_PQTC = WS_RB + 190 * MiB;
constexpr size_t WS_A2M = WS_H;
constexpr size_t WS_HS = 1092 * MiB;
constexpr size_t WS_END = 1364 * MiB;
static_assert(WS_A2M + (size_t)MAXSLOT * EDIM * 2 <= WS_HS, "A2m overlay");
static_assert(WS_HS + (size_t)NEXP * RT * DM <= WS_END && WS_HS + (size_t)MAXSLOT * DM * 2 <= WS_END && WS_PQTC + 64 * MiB <= WS_END, "ws end");

constexpr int CW_TMO = 0;
constexpr int CW_CNT = 64;
constexpr int CW_BAR = 4096;

constexpr int RING_BYTES = 131072;
constexpr int MISC_OFF = RING_BYTES + 320;
constexpr int LDS_BYTES = 147456;

__device__ __forceinline__ unsigned cvtpk(float lo, float hi) { f32x2 v = {lo, hi}; bf16x2_t b = __builtin_convertvector(v, bf16x2_t); return __builtin_bit_cast(unsigned, b); }
#ifndef F8_DENSE
#define F8_DENSE false
#endif
#ifndef F8_FOUR
#define F8_FOUR false
#endif
constexpr float F8_SCS = 256.f, F8_SPQ = 8.f;
constexpr float F8_SH = 4.f, F8_SW = 64.f, F8_SA = 4.f;
__device__ __forceinline__ float f8clamp(float v) { return __builtin_amdgcn_fmed3f(v, -448.f, 448.f); }
__device__ __forceinline__ unsigned pk4_fp8(float a, float b, float c, float d) {
    unsigned w = 0; w = __builtin_amdgcn_cvt_pk_fp8_f32(f8clamp(a), f8clamp(b), w, false); w = __builtin_amdgcn_cvt_pk_fp8_f32(f8clamp(c), f8clamp(d), w, true); return w; }
__device__ __forceinline__ float bf_lo(unsigned u) { return __uint_as_float(u << 16); }
__device__ __forceinline__ float bf_hi(unsigned u) { return __uint_as_float(u & 0xffff0000u); }
__device__ __forceinline__ float wave_sum(float v, int lane) {
#pragma unroll
    for (int o = 1; o < 64; o <<= 1) v += __int_as_float(__builtin_amdgcn_ds_bpermute((lane ^ o) << 2, __float_as_int(v)));
    return v;
}
__device__ __forceinline__ unsigned rfl(unsigned v) { return (unsigned)__builtin_amdgcn_readfirstlane((int)v); }
__device__ __forceinline__ const char* uptr(const char* p) {
    unsigned lo = (unsigned)__builtin_amdgcn_readfirstlane((int)(unsigned)(uintptr_t)p), hi = (unsigned)__builtin_amdgcn_readfirstlane((int)(unsigned)((uintptr_t)p >> 32));
    asm volatile("" : "+s"(lo), "+s"(hi));
    return (const char*)(((uintptr_t)hi << 32) | lo);
}
__device__ __forceinline__ GAS unsigned char* gptr(const void* p) {
    unsigned lo = (unsigned)__builtin_amdgcn_readfirstlane((int)(unsigned)(uintptr_t)p), hi = (unsigned)__builtin_amdgcn_readfirstlane((int)(unsigned)((uintptr_t)p >> 32));
    asm volatile("" : "+s"(lo), "+s"(hi));
    return (GAS unsigned char*)(((uintptr_t)hi << 32) | lo);
}
__device__ __forceinline__ int sopaque(int v) { v = __builtin_amdgcn_readfirstlane(v); asm volatile("" : "+s"(v)); return v; }
__device__ __forceinline__ int opaque(int v) { asm volatile("" : "+v"(v)); return v; }
#define LDS_WAIT() asm volatile("s_waitcnt lgkmcnt(0)" ::: "memory")
#define VM_WAIT() asm volatile("s_waitcnt vmcnt(0)" ::: "memory")
#define SBAR() __builtin_amdgcn_sched_barrier(0)

namespace pg8 {
constexpr int BM = 256, BK = 64, HALF = 128, HTB = HALF * BK * 2, STAGE_BYTES = 8 * HTB, NXCD = 8, WGM = 8;
__host__ __device__ __forceinline__ int lds_byte(int r, int c) { const int st = (r >> 4) * 2 + (c >> 5), rr = r & 15, cc = c & 31, ob = rr * 64 + cc * 2; return st * 1024 + (ob ^ (((ob >> 9) & 1) << 5)); }
__host__ __device__ __forceinline__ void stage_rc(int b, int& R, int& C) { const int st = b / 1024, sb = b % 1024, swz = sb ^ (((sb >> 9) & 1) << 5); R = (st >> 1) * 16 + swz / 64; C = (st & 1) * 32 + (swz % 64) / 2; }
__host__ __device__ __forceinline__ int perm32(int rho) { const int n = rho >> 4, i = rho & 15; return 8 * (i >> 2) + 4 * n + (i & 3); }

struct Unit { int pm, pn, e, nkt; };
struct Dims { int lda, ldb; };

__device__ __forceinline__ int xcd_remap(int wgid, int nwg) {
    const int q = nwg / NXCD, r = nwg % NXCD, xcd = wgid % NXCD, off = wgid / NXCD;
    return (xcd < r ? xcd * (q + 1) : r * (q + 1) + (xcd - r) * q) + off;
}

#ifndef ALIGN_SWIGLU
#define ALIGN_SWIGLU true
#endif
#ifndef ALIGN_DEFAULT
#define ALIGN_DEFAULT true
#endif
template <class Epi, class Sched, bool F8 = false, bool ALIGN_EPI = ALIGN_DEFAULT>
__device__ __forceinline__ void gemm_phase(LAS unsigned char* lds, const Dims g, const Sched& S, const Epi& E) {
    const int tid = opaque(threadIdx.x), wid = __builtin_amdgcn_readfirstlane(tid >> 6), lane = tid & 63, wr = wid >> 2, wc = wid & 3, fr = lane & 15, fq = lane >> 4;
    unsigned voffA[2], voffB[2];
#pragma unroll
    for (int i = 0; i < 2; ++i) { int R, C; stage_rc(tid * 16 + i * 8192, R, C); const int Rb = Epi::PERM ? ((R & ~31) + perm32(R & 31)) : R;
        voffA[i] = (unsigned)(R * g.lda + C) * 2u; voffB[i] = (unsigned)(Rb * g.ldb + C) * 2u; }
    const size_t kstep = (size_t)(BK * 2);
    const size_t hstepA = (size_t)HALF * g.lda * 2, hstepB = (size_t)HALF * g.ldb * 2;
    const unsigned ldsw = (unsigned)wid * 1024u;
    const int aoff = lds_byte(wr * 64 + fr, fq * 8), boff = lds_byte(wc * 32 + fr, fq * 8);
#define PG8_SA(b, h) (((b) * 2 + (h)) * HTB)
#define PG8_SB(b, h) ((4 + (b) * 2 + (h)) * HTB)
#define PG8_STAGE(bufoff, gbase, voff) do { _Pragma("unroll") for (int _i = 0; _i < 2; ++_i) \
        __builtin_amdgcn_global_load_lds((const unsigned*)((const char*)(gbase) + (voff)[_i]), (LAS unsigned*)(lds + (bufoff) + ldsw + _i * 8192), 16, 0, 0); } while (0)
#define PG8_LDA(dst, b, h) do { _Pragma("unroll") for (int m = 0; m < 4; ++m) _Pragma("unroll") for (int k = 0; k < 2; ++k) dst[m][k] = *(const LAS bf16x8*)(lds + PG8_SA(b, h) + aoff + m * 2048 + k * 1024); } while (0)
#define PG8_LDB(dst, b, h) do { _Pragma("unroll") for (int n = 0; n < 2; ++n) _Pragma("unroll") for (int k = 0; k < 2; ++k) dst[n][k] = *(const LAS bf16x8*)(lds + PG8_SB(b, h) + boff + n * 2048 + k * 1024); } while (0)
#define PG8_V8(x) __builtin_bit_cast(v8i_t, (x))
#define PG8_MMA(ai, bj, At, Bt) do { __builtin_amdgcn_s_setprio(1); _Pragma("unroll") for (int m = 0; m < 4; ++m) _Pragma("unroll") for (int n = 0; n < 2; ++n) { \
        if constexpr (F8) { struct P2 { bf16x8 a, b; }; const v8i_t a8_ = PG8_V8((P2{Bt[n][0], Bt[n][1]})), b8_ = PG8_V8((P2{At[m][0], At[m][1]})); \
            asm volatile("v_mfma_f32_16x16x128_f8f6f4 %0, %1, %2, %0" : "+v"(acc[ai][bj][m][n]) : "v"(a8_), "v"(b8_)); }   \
        else { _Pragma("unroll") for (int k = 0; k < 2; ++k) acc[ai][bj][m][n] = __builtin_amdgcn_mfma_f32_16x16x32_bf16(Bt[n][k], At[m][k], acc[ai][bj][m][n], 0, 0, 0); } } \
        __builtin_amdgcn_s_setprio(0); } while (0)
#define PG8_WAIT_V(n) asm volatile("s_waitcnt vmcnt(" #n ")" ::: "memory")
#define PG8_WAIT_L(n) asm volatile("s_waitcnt lgkmcnt(" #n ")" ::: "memory")
#define PG8_BAR __builtin_amdgcn_s_barrier()
#define PG8_SCHED __builtin_amdgcn_sched_barrier(0)
    Unit cur, nxt; int ui = 0;
    if (!S.next(0, cur)) return;
    f32x4 acc[2][2][4][2];
#pragma unroll
    for (int a = 0; a < 2; ++a)
#pragma unroll
        for (int b = 0; b < 2; ++b)
#pragma unroll
            for (int m = 0; m < 4; ++m)
#pragma unroll
                for (int n = 0; n < 2; ++n) acc[a][b][m][n] = (f32x4){0.f, 0.f, 0.f, 0.f};
    bf16x8 At[4][2], B0[2][2], B1[2][2];
    const char* cA = uptr(S.aptr(cur)); const char* cB = uptr(S.bptr(cur));
    PG8_STAGE(PG8_SB(0, 0), cB, voffB); PG8_STAGE(PG8_SB(0, 1), cB + hstepB, voffB); PG8_STAGE(PG8_SA(0, 0), cA, voffA); PG8_STAGE(PG8_SA(0, 1), cA + hstepA, voffA);
    if (wr == 1) PG8_BAR;
    PG8_WAIT_V(2); PG8_BAR;
    PG8_STAGE(PG8_SB(1, 0), cB + kstep, voffB); PG8_STAGE(PG8_SA(1, 0), cA + kstep, voffA); PG8_STAGE(PG8_SB(1, 1), cB + hstepB + kstep, voffB);
    PG8_WAIT_V(6); PG8_BAR;
    for (;;) {
        const bool has_next = S.next(ui + 1, nxt);
        const char* nA = uptr(has_next ? S.aptr(nxt) : cA); const char* nB = uptr(has_next ? S.bptr(nxt) : cB);
        const int nt = sopaque(cur.nkt);
        for (int t = 0; t < KREP * nt; t += 2) {
            const bool last = (t == KREP * nt - 2);
            const char* a1 = cA + (size_t)(KREP == 1 ? t + 1 : (t + 1) % nt) * kstep;
            const char* a2 = last ? nA : cA + (size_t)(KREP == 1 ? t + 2 : (t + 2) % nt) * kstep; const char* b2 = last ? nB : cB + (size_t)(KREP == 1 ? t + 2 : (t + 2) % nt) * kstep;
            const char* a3 = a2 + kstep; const char* b3 = b2 + kstep;
            PG8_LDB(B0, 0, 0); PG8_LDB(B1, 0, 1); PG8_SCHED; PG8_LDA(At, 0, 0); PG8_STAGE(PG8_SA(1, 1), a1 + hstepA, voffA);
            PG8_WAIT_V(8); PG8_WAIT_L(0); PG8_BAR; PG8_MMA(0, 0, At, B0); PG8_MMA(0, 1, At, B1); PG8_BAR; PG8_SCHED;
            PG8_LDA(At, 0, 1); PG8_STAGE(PG8_SB(0, 0), b2, voffB); PG8_STAGE(PG8_SB(0, 1), b2 + hstepB, voffB); PG8_STAGE(PG8_SA(0, 0), a2, voffA);
            PG8_WAIT_V(8); PG8_WAIT_L(0); PG8_BAR; PG8_MMA(1, 0, At, B0); PG8_MMA(1, 1, At, B1); PG8_BAR; PG8_SCHED;
            PG8_LDB(B0, 1, 0); PG8_LDB(B1, 1, 1); PG8_SCHED; PG8_LDA(At, 1, 0); PG8_STAGE(PG8_SA(0, 1), a2 + hstepA, voffA);
            PG8_WAIT_V(8); PG8_WAIT_L(0); PG8_BAR; PG8_MMA(0, 0, At, B0); PG8_MMA(0, 1, At, B1); PG8_BAR; PG8_SCHED;
            PG8_LDA(At, 1, 1); PG8_STAGE(PG8_SB(1, 0), b3, voffB); PG8_STAGE(PG8_SB(1, 1), b3 + hstepB, voffB); PG8_STAGE(PG8_SA(1, 0), a3, voffA);
            PG8_WAIT_V(8); PG8_WAIT_L(0); PG8_BAR; PG8_MMA(1, 0, At, B0); PG8_MMA(1, 1, At, B1); PG8_BAR; PG8_SCHED;
        }
        if constexpr (ALIGN_EPI) { if (wr == 0) PG8_BAR; }
        if constexpr (F8) asm volatile("s_nop 15\n\ts_nop 15" ::: "memory");
        for (int repe = 0; repe < REP_EPI; ++repe) { const int l2 = opaque(threadIdx.x) & 63; E(acc, cur, wr, wc, l2 & 15, l2 >> 4); }
        if (!has_next) break;
#pragma unroll
        for (int a = 0; a < 2; ++a)
#pragma unroll
            for (int b = 0; b < 2; ++b)
#pragma unroll
                for (int m = 0; m < 4; ++m)
#pragma unroll
                    for (int n = 0; n < 2; ++n) acc[a][b][m][n] = (f32x4){0.f, 0.f, 0.f, 0.f};
        cur = nxt; cA = nA; cB = nB; ++ui;
        if constexpr (ALIGN_EPI) { if (wr == 1) PG8_BAR; }
    }
    PG8_WAIT_V(0);
    if constexpr (!ALIGN_EPI) { if (wr == 0) PG8_BAR; }
    PG8_BAR;
#undef PG8_SA
#undef PG8_SB
#undef PG8_STAGE
#undef PG8_LDA
#undef PG8_LDB
#undef PG8_MMA
#undef PG8_V8
#undef PG8_WAIT_V
#undef PG8_WAIT_L
#undef PG8_BAR
#undef PG8_SCHED
}
}
using pg8::Unit;

struct EpiStore {
    static constexpr bool PERM = true;
    bf16_t* O; int ldc; float scale;
    __device__ __forceinline__ void operator()(const f32x4 (&acc)[2][2][4][2], const Unit& u, int wr, int wc, int fr, int fq) const {
        const int row0 = u.pm * 256 + wr * 64 + fr, col0 = u.pn * 256 + wc * 32 + 8 * fq;
#pragma unroll
        for (int ai = 0; ai < 2; ++ai)
#pragma unroll
            for (int m = 0; m < 4; ++m) { bf16_t* rowp = O + (size_t)(row0 + ai * 128 + m * 16) * ldc + col0;
#pragma unroll
                for (int bj = 0; bj < 2; ++bj) { const f32x4 v0 = acc[ai][bj][m][0] * (scale * (1.f / KREP)), v1 = acc[ai][bj][m][1] * (scale * (1.f / KREP));
                    u32x4 w; w.x = cvtpk(v0[0], v0[1]); w.y = cvtpk(v0[2], v0[3]); w.z = cvtpk(v1[0], v1[1]); w.w = cvtpk(v1[2], v1[3]);
                    *(u32x4*)(rowp + bj * 128) = w; } }
    }
};
template <bool F8OUT> struct EpiSwiglu {
    static constexpr bool PERM = true;
    unsigned char* O; int ldc; float scale;
    __device__ __forceinline__ void operator()(const f32x4 (&acc)[2][2][4][2], const Unit& u, int wr, int wc, int fr, int fq) const {
        const int row0 = u.pm * 256 + wr * 64 + fr, col0 = u.pn * 128 + wc * 32 + 8 * fq;
        const float us = F8OUT ? scale * F8_SA : scale;
        const float k1 = -scale * LOG2E * (1.f / KREP), ik2 = 1.f / (scale * us * (1.f / KREP) * (1.f / KREP));
#pragma unroll
        for (int ai = 0; ai < 2; ++ai)
#pragma unroll
            for (int m = 0; m < 4; ++m) { unsigned char* rowp = O + ((size_t)(row0 + ai * 128 + m * 16) * ldc + col0) * (F8OUT ? 1 : 2);
                float r[8];
#pragma unroll
                for (int n = 0; n < 2; ++n) { const f32x4 g = acc[ai][0][m][n], u = acc[ai][1][m][n]; const f32x4 t = g * k1;
                    f32x4 e; e[0] = __builtin_amdgcn_exp2f(t[0]); e[1] = __builtin_amdgcn_exp2f(t[1]); e[2] = __builtin_amdgcn_exp2f(t[2]); e[3] = __builtin_amdgcn_exp2f(t[3]);
                    const f32x4 d = e * ik2 + ik2;
                    f32x4 q; q[0] = __builtin_amdgcn_rcpf(d[0]); q[1] = __builtin_amdgcn_rcpf(d[1]); q[2] = __builtin_amdgcn_rcpf(d[2]); q[3] = __builtin_amdgcn_rcpf(d[3]);
                    const f32x4 o = (g * u) * q; r[n * 4 + 0] = o[0]; r[n * 4 + 1] = o[1]; r[n * 4 + 2] = o[2]; r[n * 4 + 3] = o[3]; }
                if constexpr (F8OUT) { u32x2 w; w.x = pk4_fp8(r[0], r[1], r[2], r[3]); w.y = pk4_fp8(r[4], r[5], r[6], r[7]); *(u32x2*)rowp = w; }
                else { u32x4 w; w.x = cvtpk(r[0], r[1]); w.y = cvtpk(r[2], r[3]); w.z = cvtpk(r[4], r[5]); w.w = cvtpk(r[6], r[7]); *(u32x4*)rowp = w; } }
    }
};
struct EpiRope {
    static constexpr bool PERM = false;
    bf16_t* O; int ldc; int rlo, rhi; const f32x2* cs;
    int qlo, qhi; float qscale;
    __device__ __forceinline__ void operator()(const f32x4 (&acc)[2][2][4][2], const Unit& u, int wr, int wc, int fr, int fq) const {
        const int row0 = u.pm * 256 + wr * 64 + fr, col0 = u.pn * 256 + wc * 32 + 4 * fq;
        const bool lat = u.pm < 128;
#pragma unroll
        for (int ai = 0; ai < 2; ++ai)
#pragma unroll
            for (int m = 0; m < 4; ++m) { const int row = row0 + ai * 128 + m * 16; bf16_t* rowp = O + (size_t)row * ldc + col0;
                const int t = row & 4095, pos = (wc & 1) ? (t & 63) : (t >> 6);
                const f32x2* c4 = cs + pos * 16 + 4 * fq;
                const f32x2 c0 = c4[0], c1 = c4[1], c2 = c4[2], c3 = c4[3];
#pragma unroll
                for (int bj = 0; bj < 2; ++bj) { f32x4 p1 = acc[ai][bj][m][0] * (1.f / KREP), p2 = acc[ai][bj][m][1] * (1.f / KREP);
                    const int blk = u.pn * 2 + bj;
                    if (lat && blk >= rlo && blk < rhi) {
                        const f32x4 cv = {c0.x, c1.x, c2.x, c3.x}, sv = {c0.y, c1.y, c2.y, c3.y};
                        const f32x4 o1 = p1 * cv - p2 * sv, o2 = p2 * cv + p1 * sv; p1 = o1; p2 = o2; }
                    if (blk >= qlo && blk < qhi) { p1 = p1 * qscale; p2 = p2 * qscale; }
                    u32x2 w1, w2; w1.x = cvtpk(p1[0], p1[1]); w1.y = cvtpk(p1[2], p1[3]); w2.x = cvtpk(p2[0], p2[1]); w2.y = cvtpk(p2[2], p2[3]);
                    *(u32x2*)(rowp + bj * 128) = w1; *(u32x2*)(rowp + bj * 128 + 16) = w2; } }
    }
};
struct EpiPQt {
    static constexpr bool PERM = true;
    bf16_t* Plat; bf16_t* Pctx;
    __device__ __forceinline__ void operator()(const f32x4 (&acc)[2][2][4][2], const Unit& u, int wr, int wc, int fr, int fq) const {
        const bool ctx = u.e >= 32; const int bg = ctx ? u.e - 32 : u.e; const int L = ctx ? CTX : SEQ;
        constexpr int EB = F8_FOUR ? 1 : 2;
        unsigned char* base = (unsigned char*)(ctx ? Pctx : Plat) + (size_t)bg * 128 * 8192 * EB;
        const int col0 = u.pn * 256 + wc * 32 + 8 * fq;
#pragma unroll
        for (int ai = 0; ai < 2; ++ai)
#pragma unroll
            for (int m = 0; m < 4; ++m) { unsigned char* rowp = base + ((size_t)(wr * 64 + m * 16 + fr) * 8192 + ai * L + col0) * EB;
#pragma unroll
                for (int bj = 0; bj < 2; ++bj) { const f32x4 v0 = acc[ai][bj][m][0] * (1.f / KREP), v1 = acc[ai][bj][m][1] * (1.f / KREP);
                    if constexpr (F8_FOUR) { u32x2 w; w.x = pk4_fp8(v0[0] * F8_SPQ, v0[1] * F8_SPQ, v0[2] * F8_SPQ, v0[3] * F8_SPQ); w.y = pk4_fp8(v1[0] * F8_SPQ, v1[1] * F8_SPQ, v1[2] * F8_SPQ, v1[3] * F8_SPQ); *(u32x2*)(rowp + bj * 128) = w; }
                    else { u32x4 w; w.x = cvtpk(v0[0], v0[1]); w.y = cvtpk(v0[2], v0[3]); w.z = cvtpk(v1[0], v1[1]); w.w = cvtpk(v1[2], v1[3]); *(u32x4*)(rowp + bj * 128 * 2) = w; } } }
    }
};
struct EpiFour2 {
    static constexpr bool PERM = true;
    bf16_t* O;
    __device__ __forceinline__ void operator()(const f32x4 (&acc)[2][2][4][2], const Unit& u, int wr, int wc, int fr, int fq) const {
        EpiStore s{O, DM, (u.pm < 128 ? 0.0013810679320049757f   : 0.005524271728019903f  ) * (F8_FOUR ? 1.f / (F8_SCS * F8_SPQ) : 1.f)};
        s(acc, u, wr, wc, fr, fq);
    }
};

struct SchedDense {
    const char* A; const char* B; int nM, nN, nwg, G, c, nkt; size_t tA, tB;
    __device__ __forceinline__ void init(const void* A_, int lda, const void* B_, int ldb, int M, int N, int K, int G_, int c_) {
        A = (const char*)A_; B = (const char*)B_; nM = M / 256; nN = N / 256; nwg = nM * nN; G = G_; c = c_; nkt = K / 64; tA = (size_t)256 * lda * 2; tB = (size_t)256 * ldb * 2; }
    __device__ __forceinline__ bool next(int i, Unit& u) const {
        const long L = (long)i * G + c; if (L >= nwg) return false;
        const int wgid = pg8::xcd_remap((int)L, nwg);
        const int nig = pg8::WGM * nN, gid = wgid / nig, fm = gid * pg8::WGM, gsz = (nM - fm) < pg8::WGM ? (nM - fm) : pg8::WGM;
        u.pm = fm + ((wgid % nig) % gsz); u.pn = (wgid % nig) / gsz; u.e = 0; u.nkt = nkt; return true;
    }
    __device__ __forceinline__ const char* aptr(const Unit& u) const { return A + (size_t)u.pm * tA; }
    __device__ __forceinline__ const char* bptr(const Unit& u) const { return B + (size_t)u.pn * tB; }
};
struct SchedGroup {
    const char* A; const char* B; int P1, P2, P3, P4, P5, P6, P7, nRT, nN, nwg, G, c, nkt; size_t tA, tB, gB, aE;
    __device__ __forceinline__ bool next(int i, Unit& u) const {
        const long L = (long)i * G + c; if (L >= nwg) return false;
        const int wgid = pg8::xcd_remap((int)L, nwg);
        const int nig = pg8::WGM * nN, gid = wgid / nig, fm = gid * pg8::WGM, gsz = (nRT - fm) < pg8::WGM ? (nRT - fm) : pg8::WGM;
        const int rt = fm + ((wgid % nig) % gsz);
        u.pm = rt; u.pn = (wgid % nig) / gsz; u.nkt = nkt;
        u.e = (rt >= P1) + (rt >= P2) + (rt >= P3) + (rt >= P4) + (rt >= P5) + (rt >= P6) + (rt >= P7); return true;
    }
    __device__ __forceinline__ const char* aptr(const Unit& u) const {
        if (aE == 0) return A + (size_t)u.pm * tA;
        const int pe = u.e == 0 ? 0 : u.e == 1 ? P1 : u.e == 2 ? P2 : u.e == 3 ? P3 : u.e == 4 ? P4 : u.e == 5 ? P5 : u.e == 6 ? P6 : P7;
        return A + (size_t)u.e * aE + (size_t)(u.pm - pe) * tA; }
    __device__ __forceinline__ const char* bptr(const Unit& u) const { return B + (size_t)u.e * gB + (size_t)u.pn * tB; }
};
struct SchedF1 {
    const char* Wp; const char* Z; int G, c;
    __device__ __forceinline__ bool next(int i, Unit& u) const {
        const int L = i * G + c; if (L >= 544) return false;
        u.pm = 0; u.nkt = 2;
        if (L < 512) { u.e = L >> 4; u.pn = L & 15; } else { u.e = 32 + (L - 512); u.pn = 0; }
        return true;
    }
    __device__ __forceinline__ const char* aptr(const Unit&) const { return Wp; }
    __device__ __forceinline__ const char* bptr(const Unit& u) const {
        const bool ctx = u.e >= 32; const int bg = ctx ? u.e - 32 : u.e, b = bg >> 2, gq = bg & 3;
        const size_t row0 = ctx ? (size_t)RL + b * CTX : (size_t)b * SEQ + u.pn * 256;
        return Z + (row0 * MIXIN + gq * 128) * 2; }
};
struct SchedF2 {
    const char* CSl; const char* CSc; const char* Plat; const char* Pctx; int G, vcu;
    static constexpr size_t EB = F8_FOUR ? 1 : 2;
    __device__ __forceinline__ bool next(int i, Unit& u) const {
        const int L = i * G + vcu; if (L >= 272) return false;
        if (L < 256) { const int b = L >> 5, mt = (L & 31) >> 1; u.pm = b * 16 + mt; u.pn = L & 1; u.e = b; u.nkt = F8_FOUR ? 64 : 128; }
        else { const int b = (L - 256) >> 1; u.pm = 128 + b; u.pn = L & 1; u.e = 8 + b; u.nkt = F8_FOUR ? 4 : 8; }
        return true;
    }
    __device__ __forceinline__ const char* aptr(const Unit& u) const { return u.e < 8 ? CSl + (size_t)(u.pm & 15) * 256 * 8192 * EB : CSc; }
    __device__ __forceinline__ const char* bptr(const Unit& u) const { return (u.e < 8 ? Plat + (size_t)u.e * 512 * 8192 * EB : Pctx + (size_t)(u.e - 8) * 512 * 8192 * EB) + (size_t)u.pn * 256 * 8192 * EB; }
};

#define XB_TMO      128
#define XB_XCNT(j)  (256  + 64 * (j))
#define XB_XSUB(j)  (1280 + 64 * (j))
#define XB_XGEN(j)  (2304 + 64 * (j))
#define XB_TOP      3328
#define XB_TOPGEN   3392
#define XCD_BAR_WORDS 3456
#define XB_SPIN_CAP (1u << 21)
__device__ __forceinline__ unsigned xb_ld(unsigned* p)              { return __hip_atomic_load(p, __ATOMIC_RELAXED, __HIP_MEMORY_SCOPE_AGENT); }
__device__ __forceinline__ unsigned xb_add(unsigned* p, unsigned v) { return __hip_atomic_fetch_add(p, v, __ATOMIC_RELAXED, __HIP_MEMORY_SCOPE_AGENT); }
__device__ __forceinline__ unsigned xb_xcc_id() { return (unsigned)__builtin_amdgcn_s_getreg((3 << 11) | 20) & 0xFu; }
#define XB_SPIN(cond, bar) do { unsigned _sp = 0; while (cond) { __builtin_amdgcn_s_sleep(1); \
    if ((++_sp & 255u) == 0u) { if (xb_ld(&(bar)[XB_TMO])) break; if (_sp > XB_SPIN_CAP) { atomicAdd(&(bar)[XB_TMO], 1u); break; } } } } while (0)
struct XcdBarrier { unsigned* bar; unsigned x; volatile LAS unsigned* st; };
__device__ __forceinline__ XcdBarrier xcd_barrier_post(unsigned* bar, volatile LAS unsigned* st) {
    XcdBarrier b; b.bar = bar; b.x = xb_xcc_id(); b.st = st;
    if (threadIdx.x == 0) (void)xb_add(&bar[XB_XCNT(b.x)], 1u);
    return b;
}
__device__ __forceinline__ void xcd_barrier_complete(unsigned* bar, unsigned x, unsigned& nloc, unsigned& nx) {
    const unsigned G = gridDim.x * gridDim.y * gridDim.z;
    unsigned sum, cnt, mine, sp = 0u;
    for (;;) {
        sum = 0u; cnt = 0u; mine = 0u;
#pragma unroll
        for (unsigned j = 0; j < 16; ++j) { const unsigned c = xb_ld(&bar[XB_XCNT(j)]); sum += c; cnt += (c > 0u) ? 1u : 0u; mine = (j == x) ? c : mine; }
        if (sum == G) break;
        __builtin_amdgcn_s_sleep(1);
        if ((++sp & 255u) == 0u) { if (xb_ld(&bar[XB_TMO])) break; if (sp > XB_SPIN_CAP) { atomicAdd(&bar[XB_TMO], 1u); break; } }
    }
    nloc = mine > 0u ? mine : 1u; nx = cnt > 0u ? cnt : 1u;
}
__device__ __forceinline__ void xcd_barrier(const XcdBarrier& b) {
    asm volatile("s_waitcnt vmcnt(0)" ::: "memory");
    __syncthreads();
    if (threadIdx.x == 0) {
        unsigned* bar = (unsigned*)uptr((const char*)b.bar);
        __builtin_amdgcn_s_waitcnt(0);
        unsigned nloc = b.st[0], nx = b.st[1];
        if (nloc == 0u) { xcd_barrier_complete(bar, b.x, nloc, nx); b.st[0] = nloc; b.st[1] = nx; }
        const unsigned old = xb_add(&bar[XB_XSUB(b.x)], 1u);
        const unsigned gen = old / nloc;
        if (old + 1u == (gen + 1u) * nloc) {
            __builtin_amdgcn_fence(__ATOMIC_RELEASE, "agent");
            asm volatile("s_waitcnt vmcnt(0)" ::: "memory");
            const unsigned og = xb_add(&bar[XB_TOP], 1u);
            const unsigned tg = og / nx;
            if (og + 1u == (tg + 1u) * nx) xb_add(&bar[XB_TOPGEN], 1u);
            else XB_SPIN(xb_ld(&bar[XB_TOPGEN]) == tg, bar);
            __builtin_amdgcn_fence(__ATOMIC_ACQUIRE, "agent");
            xb_add(&bar[XB_XGEN(b.x)], 1u);
            asm volatile("s_waitcnt vmcnt(0)" ::: "memory");
        } else {
            XB_SPIN(xb_ld(&bar[XB_XGEN(b.x)]) == gen, bar);
            __builtin_amdgcn_fence(__ATOMIC_ACQUIRE, "agent");
            asm volatile("s_waitcnt vmcnt(0)" ::: "memory");
        }
    }
    __syncthreads();
}

__device__ __forceinline__ int crow(int r, int hi) { return (r & 3) + 8 * (r >> 2) + 4 * hi; }
template <int KW> __device__ __forceinline__ int kswz(int row, int colB) { return KW == 128 ? row * 256 + (colB ^ ((row & 7) << 4)) : row * 128 + (colB ^ (((row >> 1) & 7) << 4)); }
template <int DV> __device__ __forceinline__ int v_st(int k, int c) { const int kk = (k & ~0xC) | ((k & 4) << 1) | ((k & 8) >> 1); return ((kk >> 3) * (DV / 32) + (c >> 5)) * 512 + ((kk & 7) * 32 + (c & 31)) * 2; }
__device__ __forceinline__ int v_rd_base(int lane) { return ((lane & 3) << 3) | (((lane >> 2) & 3) << 6) | (((lane >> 4) & 1) << 5) | (((lane >> 5) & 1) << 8); }
template <int OFF> __device__ __forceinline__ s16x4 tr_read(int vb) { s16x4 r; asm volatile("ds_read_b64_tr_b16 %0, %1 offset:%2" : "=&v"(r) : "v"(vb), "i"(OFF) : "memory"); return r; }
template <int DV, int D0> __device__ __forceinline__ void pv_one(f32x16& od, int vb, bf16x8 pa0, bf16x8 pa1, bf16x8 pa2, bf16x8 pa3) {
    constexpr int KS = (DV / 32) * 1024, HF = (DV / 32) * 512;
    const s16x4 l0 = tr_read<D0 * 512 + 0 * KS>(vb), h0 = tr_read<D0 * 512 + 0 * KS + HF>(vb), l1 = tr_read<D0 * 512 + 1 * KS>(vb), h1 = tr_read<D0 * 512 + 1 * KS + HF>(vb);
    const s16x4 l2 = tr_read<D0 * 512 + 2 * KS>(vb), h2 = tr_read<D0 * 512 + 2 * KS + HF>(vb), l3 = tr_read<D0 * 512 + 3 * KS>(vb), h3 = tr_read<D0 * 512 + 3 * KS + HF>(vb);
    asm volatile("s_waitcnt lgkmcnt(0)" ::: "memory"); SBAR();
#define PKV(L, H) (bf16x8){L[0], L[1], L[2], L[3], H[0], H[1], H[2], H[3]}
    od = __builtin_amdgcn_mfma_f32_32x32x16_bf16(pa0, PKV(l0, h0), od, 0, 0, 0);
    od = __builtin_amdgcn_mfma_f32_32x32x16_bf16(pa1, PKV(l1, h1), od, 0, 0, 0);
    od = __builtin_amdgcn_mfma_f32_32x32x16_bf16(pa2, PKV(l2, h2), od, 0, 0, 0);
    od = __builtin_amdgcn_mfma_f32_32x32x16_bf16(pa3, PKV(l3, h3), od, 0, 0, 0);
#undef PKV
}
#define PV_RD(D0, L, H) do { L[0] = tr_read<(D0) * 512 + 0 * KS>(vb); H[0] = tr_read<(D0) * 512 + 0 * KS + HF>(vb); L[1] = tr_read<(D0) * 512 + 1 * KS>(vb); H[1] = tr_read<(D0) * 512 + 1 * KS + HF>(vb); \
    L[2] = tr_read<(D0) * 512 + 2 * KS>(vb); H[2] = tr_read<(D0) * 512 + 2 * KS + HF>(vb); L[3] = tr_read<(D0) * 512 + 3 * KS>(vb); H[3] = tr_read<(D0) * 512 + 3 * KS + HF>(vb); } while (0)
#define PV_MM(od, L, H) do { od = __builtin_amdgcn_mfma_f32_32x32x16_bf16(pa0, PKV(L[0], H[0]), od, 0, 0, 0); od = __builtin_amdgcn_mfma_f32_32x32x16_bf16(pa1, PKV(L[1], H[1]), od, 0, 0, 0); \
    od = __builtin_amdgcn_mfma_f32_32x32x16_bf16(pa2, PKV(L[2], H[2]), od, 0, 0, 0); od = __builtin_amdgcn_mfma_f32_32x32x16_bf16(pa3, PKV(L[3], H[3]), od, 0, 0, 0); } while (0)
#define PKV(L, H) (bf16x8){L[0], L[1], L[2], L[3], H[0], H[1], H[2], H[3]}
template <int DV> __device__ __forceinline__ void pv_all(f32x16* o, int vb, bf16x8 pa0, bf16x8 pa1, bf16x8 pa2, bf16x8 pa3) {
    constexpr int KS = (DV / 32) * 1024, HF = (DV / 32) * 512;
    s16x4 la[4], ha[4], lb[4], hb[4];
    PV_RD(0, la, ha);
    PV_RD(1, lb, hb); asm volatile("s_waitcnt lgkmcnt(8)" ::: "memory"); SBAR(); PV_MM(o[0], la, ha);
    if constexpr (DV == 128) {
        PV_RD(2, la, ha); asm volatile("s_waitcnt lgkmcnt(8)" ::: "memory"); SBAR(); PV_MM(o[1], lb, hb);
        PV_RD(3, lb, hb); asm volatile("s_waitcnt lgkmcnt(8)" ::: "memory"); SBAR(); PV_MM(o[2], la, ha);
        asm volatile("s_waitcnt lgkmcnt(0)" ::: "memory"); SBAR(); PV_MM(o[3], lb, hb);
    } else {
        asm volatile("s_waitcnt lgkmcnt(0)" ::: "memory"); SBAR(); PV_MM(o[1], lb, hb);
    }
}
#undef PV_RD
#undef PV_MM
#undef PKV
template <int KW> __device__ __forceinline__ void qkt64(f32x16& p0, f32x16& p1, const char* Ks, const bf16x8* qr, int kcb, int r32, int hi) {
    bf16x8 kb0[4], kb1[4];
#pragma unroll
    for (int d0 = 0; d0 < 4; ++d0) { const int cb = kcb + (d0 * 16 + hi * 8) * 2;
        kb0[d0] = *reinterpret_cast<const bf16x8*>(Ks + kswz<KW>(r32, cb));
        kb1[d0] = *reinterpret_cast<const bf16x8*>(Ks + kswz<KW>(32 + r32, cb)); }
    p0 = f32x16{}; p1 = f32x16{};
#pragma unroll
    for (int d0 = 0; d0 < 4; ++d0) {
        p0 = __builtin_amdgcn_mfma_f32_32x32x16_bf16(kb0[d0], qr[d0], p0, 0, 0, 0);
        p1 = __builtin_amdgcn_mfma_f32_32x32x16_bf16(kb1[d0], qr[d0], p1, 0, 0, 0); }
}
template <int KW> __device__ __forceinline__ void qkt64n(f32x16& p0, f32x16& p1, const char* Ks, const bf16x8* qr, int kcb, int r32, int hi, const f32x16& cinit) {
#pragma unroll
    for (int d0 = 0; d0 < 4; ++d0) { const int cb = kcb + (d0 * 16 + hi * 8) * 2;
        const bf16x8 b0 = *reinterpret_cast<const bf16x8*>(Ks + kswz<KW>(r32, cb));
        const bf16x8 b1 = *reinterpret_cast<const bf16x8*>(Ks + kswz<KW>(32 + r32, cb));
        if (d0 == 0) { p0 = __builtin_amdgcn_mfma_f32_32x32x16_bf16(b0, qr[0], cinit, 0, 0, 0); p1 = __builtin_amdgcn_mfma_f32_32x32x16_bf16(b1, qr[0], cinit, 0, 0, 0); }
        else { p0 = __builtin_amdgcn_mfma_f32_32x32x16_bf16(b0, qr[d0], p0, 0, 0, 0); p1 = __builtin_amdgcn_mfma_f32_32x32x16_bf16(b1, qr[d0], p1, 0, 0, 0); } }
}
template <int ND> __device__ __forceinline__ void softmax_step(f32x16& p0, f32x16& p1, float& m_reg, float& l_reg, f32x16* o, float* al_l, int r32, int hi,
                                                              bf16x8& pa0, bf16x8& pa1, bf16x8& pa2, bf16x8& pa3) {
    float pmax = p0[0];
#pragma unroll
    for (int r = 1; r < 16; ++r) pmax = fmaxf(pmax, p0[r]);
#pragma unroll
    for (int r = 0; r < 16; ++r) pmax = fmaxf(pmax, p1[r]);
    { auto rr = __builtin_amdgcn_permlane32_swap(__float_as_uint(pmax), __float_as_uint(pmax), false, false); pmax = fmaxf(__uint_as_float(rr[0]), __uint_as_float(rr[1])); }
    const float mn = fmaxf(m_reg, pmax);
    const float alpha = __builtin_amdgcn_exp2f((m_reg - mn) * QK_C); m_reg = mn;
    const float mnC = -mn * QK_C;
#pragma unroll
    for (int r = 0; r < 16; ++r) { p0[r] = __builtin_amdgcn_exp2f(fmaf(p0[r], QK_C, mnC)); p1[r] = __builtin_amdgcn_exp2f(fmaf(p1[r], QK_C, mnC)); }
    float ps = 0.f;
#pragma unroll
    for (int r = 0; r < 16; ++r) ps += p0[r] + p1[r];
    { auto rr = __builtin_amdgcn_permlane32_swap(__float_as_uint(ps), __float_as_uint(ps), false, false); ps = __uint_as_float(rr[0]) + __uint_as_float(rr[1]); }
    l_reg = l_reg * alpha + ps;
    if (__any(alpha < 1.f)) { if (hi == 0) al_l[r32] = alpha; LDS_WAIT();
#pragma unroll
        for (int d = 0; d < ND; ++d)
#pragma unroll
            for (int r = 0; r < 16; ++r) o[d][r] *= al_l[crow(r, hi)];
    }
#define PK4(P, BASE, OUT) do { unsigned a0 = cvtpk(P[BASE + 0], P[BASE + 1]), a1 = cvtpk(P[BASE + 2], P[BASE + 3]);   \
    unsigned b0 = cvtpk(P[BASE + 4], P[BASE + 5]), b1 = cvtpk(P[BASE + 6], P[BASE + 7]);                              \
    auto r0 = __builtin_amdgcn_permlane32_swap(a0, b0, false, false); auto r1 = __builtin_amdgcn_permlane32_swap(a1, b1, false, false); \
    u32x4 w = {r0[0], r1[0], r0[1], r1[1]}; OUT = *reinterpret_cast<bf16x8*>(&w); } while (0)
    PK4(p0, 0, pa0); PK4(p0, 8, pa1); PK4(p1, 0, pa2); PK4(p1, 8, pa3);
#undef PK4
}

constexpr int AT_K = 0, AT_V = 16384, AT_WS = 32768, AT_XCH = 36864;

__device__ __forceinline__ void win_attn_unit(char* lds, const bf16_t* Z, bf16_t* Y, const float* sink, int b, int kvh, int qc, bool ctxq) {
    const int tid = opaque(threadIdx.x), wid = __builtin_amdgcn_readfirstlane(tid >> 6), lane = tid & 63, r32 = lane & 31, hi = lane >> 5;
    const int head = kvh * 4 + (wid >> 1), qsub = wid & 1;
    const int q0 = qc * 64;
    const size_t qrow0 = (ctxq ? (size_t)RL + b * CTX : (size_t)b * SEQ) + q0 + qsub * 32;
    float* wsf = (float*)(lds + AT_WS) + wid * 128; float* al_l = wsf; float* li_l = wsf + 32;
    bf16x8 qr[4];
    { const bf16_t* qp = Z + (qrow0 + r32) * MIXIN + 512 + head * 64 + hi * 8;
#pragma unroll
      for (int d0 = 0; d0 < 4; ++d0) qr[d0] = *reinterpret_cast<const bf16x8*>(qp + d0 * 16); }
    float m_reg = -1e30f, l_reg = 0.f; f32x16 o[2] = {};
    const int srow = tid >> 3, scol = (tid & 7) * 8;
    const int vb = (int)(uintptr_t)(lds + AT_V) + v_rd_base(lane);
    const int qrel = qsub * 32 + r32;
    const int NT = ctxq ? 4 : 9;
    for (int t = 0; t < NT; ++t) {
        size_t krow; int mode = 0;
        if (t < 4) krow = (size_t)RL + b * CTX + t * 64;
        else { const int p0 = q0 - 128 + (t - 4) * 64; if (p0 < 0 || p0 >= SEQ) continue; krow = (size_t)b * SEQ + p0; mode = (t == 4) ? 1 : (t == 8) ? 2 : 0; }
        __syncthreads();
        { const bf16_t* kp = Z + (krow + srow) * MIXIN + 1024 + kvh * 64 + scol;
          const bf16x8 kv = *reinterpret_cast<const bf16x8*>(kp), vv = *reinterpret_cast<const bf16x8*>(kp + 128);
          *reinterpret_cast<bf16x8*>(lds + AT_K + kswz<64>(srow, scol * 2)) = kv;
          *reinterpret_cast<bf16x8*>(lds + AT_V + v_st<64>(srow, scol)) = vv; }
        __syncthreads();
        f32x16 p0, p1; qkt64<64>(p0, p1, lds + AT_K, qr, 0, r32, hi);
        if (mode == 1) {
#pragma unroll
            for (int r = 0; r < 16; ++r) { const int kk = crow(r, hi); if (kk < qrel) p0[r] = -1e30f; if (kk + 32 < qrel) p1[r] = -1e30f; } }
        else if (mode == 2) {
#pragma unroll
            for (int r = 0; r < 16; ++r) { const int kk = crow(r, hi); if (kk > qrel) p0[r] = -1e30f; if (kk + 32 > qrel) p1[r] = -1e30f; } }
        bf16x8 pa0, pa1, pa2, pa3;
        softmax_step<2>(p0, p1, m_reg, l_reg, o, al_l, r32, hi, pa0, pa1, pa2, pa3);
        pv_one<64, 0>(o[0], vb, pa0, pa1, pa2, pa3); pv_one<64, 1>(o[1], vb, pa0, pa1, pa2, pa3);
    }
    l_reg += __builtin_amdgcn_exp2f(sink[head] * LOG2E - m_reg * QK_C);
    if (hi == 0) li_l[r32] = l_reg; LDS_WAIT();
    bf16_t* yp = Y + qrow0 * DM + 512 + head * 64;
#pragma unroll
    for (int r = 0; r < 16; ++r) { const int orow = crow(r, hi); const float rl = __builtin_amdgcn_rcpf(li_l[orow]);
#pragma unroll
        for (int d0 = 0; d0 < 2; ++d0) { const unsigned w = cvtpk(o[d0][r] * rl, 0.f); yp[(size_t)orow * DM + d0 * 32 + r32] = (bf16_t)(w & 0xffffu); } }
}

constexpr float DA_THR = 8.f;
constexpr float DA_THRL = DA_THR * LOG2E;
template <bool FIRST> __device__ __forceinline__ void da_partialSM(f32x16& p0, f32x16& p1, float& mhat, f32x16& negm, float& alpha) {
    float pmax = fmaxf(p0[0], p0[1]), pmb = fmaxf(p1[0], p1[1]);
#pragma unroll
    for (int r = 2; r < 16; r += 2) { pmax = fmaxf(fmaxf(pmax, p0[r]), p0[r + 1]); pmb = fmaxf(fmaxf(pmb, p1[r]), p1[r + 1]); }
    pmax = fmaxf(pmax, pmb);
    { auto rr = __builtin_amdgcn_permlane32_swap(__float_as_uint(pmax), __float_as_uint(pmax), false, false); pmax = fmaxf(__uint_as_float(rr[0]), __uint_as_float(rr[1])); }
    alpha = 1.f;
    if (FIRST || !__builtin_expect(__all(pmax <= DA_THRL), 1)) {
        const float dl = FIRST ? pmax : fmaxf(pmax, 0.f);
        mhat += dl; alpha = __builtin_amdgcn_exp2f(-dl);
#pragma unroll
        for (int r = 0; r < 16; ++r) { p0[r] -= dl; p1[r] -= dl; negm[r] = -mhat; }
    }
#pragma unroll
    for (int r = 0; r < 16; ++r) p0[r] = __builtin_amdgcn_exp2f(p0[r]);
}
__device__ __forceinline__ void da_finishSM(f32x16& p0, f32x16& p1, float alpha, float& l_reg, bf16x8& pa0, bf16x8& pa1, bf16x8& pa2, bf16x8& pa3) {
#pragma unroll
    for (int r = 0; r < 16; ++r) p1[r] = __builtin_amdgcn_exp2f(p1[r]);
    float s0 = p0[0], s1 = p0[1], s2 = p0[2], s3 = p0[3];
#pragma unroll
    for (int r = 4; r < 16; r += 4) { s0 += p0[r]; s1 += p0[r + 1]; s2 += p0[r + 2]; s3 += p0[r + 3]; }
#pragma unroll
    for (int r = 0; r < 16; r += 4) { s0 += p1[r]; s1 += p1[r + 1]; s2 += p1[r + 2]; s3 += p1[r + 3]; }
    float ps = (s0 + s1) + (s2 + s3);
    { auto rr = __builtin_amdgcn_permlane32_swap(__float_as_uint(ps), __float_as_uint(ps), false, false); ps = __uint_as_float(rr[0]) + __uint_as_float(rr[1]); }
    l_reg = l_reg * alpha + ps;
#define PK4(P, BASE, OUT) do { unsigned a0 = cvtpk(P[BASE + 0], P[BASE + 1]), a1 = cvtpk(P[BASE + 2], P[BASE + 3]);   \
    unsigned b0 = cvtpk(P[BASE + 4], P[BASE + 5]), b1 = cvtpk(P[BASE + 6], P[BASE + 7]);                              \
    auto r0 = __builtin_amdgcn_permlane32_swap(a0, b0, false, false); auto r1 = __builtin_amdgcn_permlane32_swap(a1, b1, false, false); \
    u32x4 w = {r0[0], r1[0], r0[1], r1[1]}; OUT = *reinterpret_cast<bf16x8*>(&w); } while (0)
    PK4(p0, 0, pa0); PK4(p0, 8, pa1); PK4(p1, 0, pa2); PK4(p1, 8, pa3);
#undef PK4
}
__device__ __forceinline__ void da_pv(f32x16* o, int vb, bf16x8 pa0, bf16x8 pa1, bf16x8 pa2, bf16x8 pa3) {
    pv_all<128>(o, vb, pa0, pa1, pa2, pa3);
}
constexpr int DA_V = 0, DA_K = 49152, DA_WS = 81920, DA_XCH = 0;
__device__ __forceinline__ void diff_attn_unit(char* lds, const bf16_t* QKV, bf16_t* O, const float* subg, float lam, float oscale, int b, int h, int qb, bool ctxq) {
    const int tid = opaque(threadIdx.x), wid = __builtin_amdgcn_readfirstlane(tid >> 6), lane = tid & 63, r32 = lane & 31, hi = lane >> 5;
    const int comp = wid >> 2, qsub = wid & 3;
    const size_t qrow0 = (ctxq ? (size_t)RL + b * CTX : (size_t)b * SEQ) + qb * 128 + qsub * 32;
    char* V_lds = lds + DA_V; char* K_lds = lds + DA_K;
    float* wsf = (float*)(lds + DA_WS) + wid * 128; float* al_l = wsf; float* li_l = wsf + 32;
    __syncthreads();
    bf16x8 qr[4];
    { const bf16_t* qp = QKV + (qrow0 + r32) * 3072 + (2 * h + comp) * 64 + hi * 8;
#pragma unroll
      for (int d0 = 0; d0 < 4; ++d0) qr[d0] = *reinterpret_cast<const bf16x8*>(qp + d0 * 16); }
    float m_reg = 0.f, l_reg = 0.f; f32x16 o[4] = {}; f32x16 negm = {};
    const int sr = tid >> 4, sc = (tid & 15) * 8, vst0 = v_st<128>(sr, sc), vst1 = v_st<128>(32 + sr, sc);
    const int vb0 = (int)(uintptr_t)V_lds + v_rd_base(lane);
    const int kcb = comp * 128;
    const bf16_t* kvp = QKV + (size_t)sr * 3072 + 1024 + h * 128 + sc;
    const size_t rowc = (size_t)RL + b * CTX, rowl = (size_t)b * SEQ;
    const int NT = ctxq ? 4 : 68;
    bf16x8 ks0, ks1, vs0, vs1;
#define KROW(t) ((t) < 4 ? rowc + (size_t)(t) * 64 : rowl + (size_t)((t) - 4) * 64)
#define LOADK(t) do { const bf16_t* p_ = kvp + KROW(t) * 3072; ks0 = *reinterpret_cast<const bf16x8*>(p_); ks1 = *reinterpret_cast<const bf16x8*>(p_ + 32 * 3072); } while (0)
#define LOADV(t) do { const bf16_t* p_ = kvp + KROW(t) * 3072 + 1024; vs0 = *reinterpret_cast<const bf16x8*>(p_); vs1 = *reinterpret_cast<const bf16x8*>(p_ + 32 * 3072); } while (0)
#define WRITEK(bf) do { *reinterpret_cast<bf16x8*>(K_lds + (bf) * 16384 + kswz<128>(sr, sc * 2)) = ks0; *reinterpret_cast<bf16x8*>(K_lds + (bf) * 16384 + kswz<128>(32 + sr, sc * 2)) = ks1; } while (0)
#define WRITEV(bf) do { *reinterpret_cast<bf16x8*>(V_lds + (bf) * 16384 + vst0) = vs0; *reinterpret_cast<bf16x8*>(V_lds + (bf) * 16384 + vst1) = vs1; } while (0)
#define RESC(a) do { if (__any((a) < 1.f)) { if (hi == 0) al_l[r32] = (a); LDS_WAIT(); \
    _Pragma("unroll") for (int d = 0; d < 4; ++d) _Pragma("unroll") for (int r = 0; r < 16; ++r) o[d][r] *= al_l[crow(r, hi)]; } } while (0)
#define QKT(P0, P1, kb) do { SBAR(); qkt64n<128>(P0, P1, K_lds + (kb) * 16384, qr, kcb, r32, hi, negm); } while (0)
#define FIN(P0, P1, al) do { da_finishSM(P0, P1, al, l_reg, pa0, pa1, pa2, pa3); SBAR(); } while (0)
#define PVT(vi) da_pv(o, vb0 + (vi) * 16384, pa0, pa1, pa2, pa3)
    f32x16 pA0, pA1, pB0, pB1; float alA = 1.f, alB = 1.f; bf16x8 pa0, pa1, pa2, pa3;
    int vm2 = 1, vm1 = 2, vc = 0;
#define VROT() do { const int t_ = vm2; vm2 = vm1; vm1 = vc; vc = t_; } while (0)
    const bool grpB = comp != 0;
    LOADK(0); VM_WAIT(); WRITEK(0); LOADK(1); LOADV(0); __syncthreads();
    QKT(pA0, pA1, 0);
    if (!grpB) da_partialSM<true>(pA0, pA1, m_reg, negm, alA);
    VM_WAIT(); WRITEK(1); WRITEV(vc); LOADK(2); LOADV(1); VROT();
    __syncthreads();
    if (grpB) da_partialSM<true>(pA0, pA1, m_reg, negm, alA);
    QKT(pB0, pB1, 1); FIN(pA0, pA1, alA);
    if (!grpB) { PVT(vm1); da_partialSM<false>(pB0, pB1, m_reg, negm, alB); RESC(alB); }
    VM_WAIT(); WRITEK(0); WRITEV(vc); LOADK(3); LOADV(2); VROT();
    __syncthreads();
    for (int j = 2; j + 1 < NT; j += 2) {
        if (grpB) { PVT(vm2); da_partialSM<false>(pB0, pB1, m_reg, negm, alB); RESC(alB); }
        QKT(pA0, pA1, 0); FIN(pB0, pB1, alB);
        if (!grpB) { PVT(vm1); da_partialSM<false>(pA0, pA1, m_reg, negm, alA); RESC(alA); }
        VM_WAIT(); WRITEK(1); WRITEV(vc); if (j + 2 < NT) LOADK(j + 2); LOADV(j + 1); VROT();
        __syncthreads();
        if (grpB) { PVT(vm2); da_partialSM<false>(pA0, pA1, m_reg, negm, alA); RESC(alA); }
        QKT(pB0, pB1, 1); FIN(pA0, pA1, alA);
        if (!grpB) { PVT(vm1); da_partialSM<false>(pB0, pB1, m_reg, negm, alB); RESC(alB); }
        VM_WAIT(); if (j + 2 < NT) { WRITEK(0); } WRITEV(vc); if (j + 3 < NT) LOADK(j + 3); if (j + 2 < NT) LOADV(j + 2); VROT();
        __syncthreads();
    }
    if (grpB) { PVT(vm2); da_partialSM<false>(pB0, pB1, m_reg, negm, alB); RESC(alB); }
    FIN(pB0, pB1, alB); PVT(vm1);
#undef LOADK
#undef LOADV
#undef WRITEK
#undef WRITEV
#undef QKT
#undef FIN
#undef PVT
#undef VROT
#define SLOAD(a, b)
#define SWRITE(a, b)
#define SWAIT()
#undef KROW
#undef SLOAD
#undef SWRITE
#undef SWAIT
#undef RESC
    if (hi == 0) li_l[r32] = l_reg; LDS_WAIT();
    float rl[16];
#pragma unroll
    for (int r = 0; r < 16; ++r) rl[r] = __builtin_amdgcn_rcpf(li_l[crow(r, hi)]);
    __syncthreads();
    float* xch = (float*)(lds + DA_XCH) + qsub * (32 * 132);
    if (comp == 1) {
#pragma unroll
        for (int d0 = 0; d0 < 4; ++d0)
#pragma unroll
            for (int r = 0; r < 16; ++r) xch[crow(r, hi) * 132 + d0 * 32 + r32] = o[d0][r] * rl[r];
    }
    __syncthreads();
    if (comp == 0) {
#pragma unroll
        for (int d0 = 0; d0 < 4; ++d0)
#pragma unroll
            for (int r = 0; r < 16; ++r) { const int idx = crow(r, hi) * 132 + d0 * 32 + r32; const float v = o[d0][r] * rl[r] - lam * xch[idx]; xch[idx] = v; }
        LDS_WAIT();
        const int row = lane >> 1, hf = lane & 1; const float* rp = xch + row * 132 + hf * 64;
        f32x4 v[16]; float ss = 0.f;
#pragma unroll
        for (int j = 0; j < 16; ++j) { v[j] = *reinterpret_cast<const f32x4*>(rp + 4 * j); ss += v[j][0] * v[j][0] + v[j][1] * v[j][1] + v[j][2] * v[j][2] + v[j][3] * v[j][3]; }
        ss += __int_as_float(__builtin_amdgcn_ds_bpermute((lane ^ 1) << 2, __float_as_int(ss)));
        const float rs = __builtin_amdgcn_rsqf(ss * (1.f / 128.f) + EPS) * oscale;
        bf16_t* op = O + (qrow0 + row) * DM + h * 128 + hf * 64;
#pragma unroll
        for (int j = 0; j < 16; j += 2) { const f32x4 g0 = *reinterpret_cast<const f32x4*>(subg + hf * 64 + 4 * j), g1 = *reinterpret_cast<const f32x4*>(subg + hf * 64 + 4 * j + 4);
            const f32x4 a = v[j] * g0 * rs, c = v[j + 1] * g1 * rs;
            u32x4 w; w.x = cvtpk(a[0], a[1]); w.y = cvtpk(a[2], a[3]); w.z = cvtpk(c[0], c[1]); w.w = cvtpk(c[2], c[3]);
            *reinterpret_cast<u32x4*>(op + 4 * j) = w; }
    }
}

constexpr int WA_V = 0, WA_K = 16384, WA_WS = 32768, WA_ST = 36864;
__device__ __forceinline__ void wa_mask(f32x16& p0, f32x16& p1, int mode, int qrel, int hi) {
    if (mode == 1) {
#pragma unroll
        for (int r = 0; r < 16; ++r) { const int kk = crow(r, hi); if (kk < qrel) p0[r] = -1e30f; if (kk + 32 < qrel) p1[r] = -1e30f; } }
    else if (mode == 2) {
#pragma unroll
        for (int r = 0; r < 16; ++r) { const int kk = crow(r, hi); if (kk > qrel) p0[r] = -1e30f; if (kk + 32 > qrel) p1[r] = -1e30f; } }
    else if (mode == 3) {
#pragma unroll
        for (int r = 0; r < 16; ++r) { p0[r] = -1e30f; p1[r] = -1e30f; } }
}
__device__ __forceinline__ void win_attn_unit2(char* lds, const bf16_t* Z, bf16_t* Y, const float* sink, int b, int kvh, int qc, bool ctxq) {
    const int tid = opaque(threadIdx.x), wid = __builtin_amdgcn_readfirstlane(tid >> 6), lane = tid & 63, r32 = lane & 31, hi = lane >> 5;
    const int head = kvh * 4 + (wid >> 1), qsub = wid & 1, q0 = qc * 64;
    const size_t rowc = (size_t)RL + b * CTX, rowl = (size_t)b * SEQ;
    const size_t qrow0 = (ctxq ? rowc : rowl) + q0 + qsub * 32;
    char* V_lds = lds + WA_V; char* K_lds = lds + WA_K;
    float* wsf = (float*)(lds + WA_WS) + wid * 128; float* al_l = wsf; float* li_l = wsf + 32;
    __syncthreads();
    bf16x8 qr[4];
    { const bf16_t* qp = Z + (qrow0 + r32) * MIXIN + 512 + head * 64 + hi * 8;
#pragma unroll
      for (int d0 = 0; d0 < 4; ++d0) qr[d0] = *reinterpret_cast<const bf16x8*>(qp + d0 * 16); }
    float m_reg = 0.f, l_reg = 0.f; f32x16 o[2] = {}; f32x16 negm = {};
    const int srow = tid >> 3, scol = (tid & 7) * 8, vst = v_st<64>(srow, scol), kst = kswz<64>(srow, scol * 2);
    const int vb0 = (int)(uintptr_t)V_lds + v_rd_base(lane);
    const bf16_t* kvp = Z + (size_t)srow * MIXIN + 1024 + kvh * 64 + scol;
    const int skip_lo = ctxq ? 0 : (q0 == 0 ? 2 : q0 == 64 ? 1 : 0);
    const int nloc = ctxq ? 0 : 5 - skip_lo - (q0 == SEQ - 64 ? 2 : q0 == SEQ - 128 ? 1 : 0);
    const int NTr = 4 + nloc, NT = (NTr + 1) & ~1;
    const int qrel = qsub * 32 + r32;
    struct { bf16x8 vs, ks; } sr_;
#define KROW(t) ((t) < 4 ? rowc + (size_t)(t) * 64 : (t) < NTr ? rowl + (size_t)(q0 - 128 + ((t) - 4 + skip_lo) * 64) : rowc)
#define TMODE(t) ((t) < 4 ? 0 : (t) >= NTr ? 3 : ((t) - 4 + skip_lo) == 0 ? 1 : ((t) - 4 + skip_lo) == 4 ? 2 : 0)
#define SLOAD(t) do { const bf16_t* p_ = kvp + KROW(t) * MIXIN; sr_.ks = *reinterpret_cast<const bf16x8*>(p_); sr_.vs = *reinterpret_cast<const bf16x8*>(p_ + 128); } while (0)
#define SWRITE(bf) do { *reinterpret_cast<bf16x8*>(V_lds + (bf) * 8192 + vst) = sr_.vs; *reinterpret_cast<bf16x8*>(K_lds + (bf) * 8192 + kst) = sr_.ks; } while (0)
#define SWAIT() asm volatile("s_waitcnt vmcnt(0)" ::: "memory")
#define RESC(a) do { if (__any((a) < 1.f)) { if (hi == 0) al_l[r32] = (a); LDS_WAIT(); \
    _Pragma("unroll") for (int d = 0; d < 2; ++d) _Pragma("unroll") for (int r = 0; r < 16; ++r) o[d][r] *= al_l[crow(r, hi)]; } } while (0)
#define WPV(vb) pv_all<64>(o, (vb), pa0, pa1, pa2, pa3)
    f32x16 pA0, pA1, pB0, pB1; float alA, alB; bf16x8 pa0, pa1, pa2, pa3;
    SLOAD(0); VM_WAIT(); SWRITE(0); __syncthreads();
    qkt64n<64>(pA0, pA1, K_lds, qr, 0, r32, hi, negm); da_partialSM<true>(pA0, pA1, m_reg, negm, alA);
    SLOAD(1);
    SWAIT(); SWRITE(1); __syncthreads();
    for (int j = 1; j + 1 < NT; j += 2) {
        SBAR(); qkt64n<64>(pB0, pB1, K_lds + 8192, qr, 0, r32, hi, negm);
        da_finishSM(pA0, pA1, alA, l_reg, pa0, pa1, pa2, pa3); SBAR();
        SLOAD(j + 1); SBAR();
        WPV(vb0); wa_mask(pB0, pB1, TMODE(j), qrel, hi); da_partialSM<false>(pB0, pB1, m_reg, negm, alB);
        __syncthreads(); SWAIT(); SWRITE(0);
        RESC(alB); __syncthreads();
        SBAR(); qkt64n<64>(pA0, pA1, K_lds, qr, 0, r32, hi, negm);
        da_finishSM(pB0, pB1, alB, l_reg, pa0, pa1, pa2, pa3); SBAR();
        SLOAD(j + 2); SBAR();
        WPV(vb0 + 8192); wa_mask(pA0, pA1, TMODE(j + 1), qrel, hi); da_partialSM<false>(pA0, pA1, m_reg, negm, alA);
        __syncthreads(); SWAIT(); SWRITE(1);
        RESC(alA); __syncthreads();
    }
    SBAR(); qkt64n<64>(pB0, pB1, K_lds + 8192, qr, 0, r32, hi, negm);
    da_finishSM(pA0, pA1, alA, l_reg, pa0, pa1, pa2, pa3); SBAR();
    WPV(vb0); wa_mask(pB0, pB1, TMODE(NT - 1), qrel, hi); da_partialSM<false>(pB0, pB1, m_reg, negm, alB);
    __syncthreads(); RESC(alB);
    da_finishSM(pB0, pB1, alB, l_reg, pa0, pa1, pa2, pa3); SBAR();
    WPV(vb0 + 8192);
#undef KROW
#undef TMODE
#undef SLOAD
#undef SWRITE
#undef SWAIT
#undef RESC
#undef WPV
    l_reg += __builtin_amdgcn_exp2f(sink[head] * LOG2E - m_reg);
    if (hi == 0) li_l[r32] = l_reg; LDS_WAIT();
    bf16_t* stg = (bf16_t*)(lds + WA_ST) + wid * 2048;
#pragma unroll
    for (int r = 0; r < 16; ++r) { const int orow = crow(r, hi); const float rl = __builtin_amdgcn_rcpf(li_l[orow]);
#pragma unroll
        for (int d0 = 0; d0 < 2; ++d0) stg[orow * 64 + d0 * 32 + r32] = (bf16_t)(cvtpk(o[d0][r] * rl, 0.f) & 0xffffu); }
    LDS_WAIT();
    bf16_t* yp = Y + qrow0 * DM + 512 + head * 64;
#pragma unroll
    for (int i = 0; i < 4; ++i) { const int row = i * 8 + (lane >> 3), ch = lane & 7; const u32x4 v = *reinterpret_cast<const u32x4*>(stg + row * 64 + ch * 8); *reinterpret_cast<u32x4*>(yp + (size_t)row * DM + ch * 8) = v; }
}

struct Args {
    const float *x, *c, *ctx, *c_ctx, *ada_w, *ada_b, *norm_g, *mix_in_w, *mix_out_w, *win_sink, *diff_qkv_w, *diff_out_w, *diff_lambda, *diff_subln_g,
                *ffn_in_w, *ffn_out_w, *router_w, *expert_in_w, *expert_out_w;
    float* out; unsigned char* ws; int ph_lo, ph_hi;
};
struct Frame {
    LAS unsigned char* lds; unsigned char* ldsg; volatile LAS unsigned* MISC; unsigned* ctl;
    int tid, lane, wave, vcu, G;
};

__device__ __forceinline__ unsigned f2bf(float f) { unsigned u = __builtin_bit_cast(unsigned, f); return (u + 0x7fffu + ((u >> 16) & 1u)) >> 16; }
__device__ __forceinline__ unsigned pk2(float lo, float hi) { return f2bf(lo) | (f2bf(hi) << 16); }
__device__ __forceinline__ void transpose_item(const float* W, int K, int N, bf16_t* WT, int n0, int c0, int k0, LAS float* scr, int lane) {
#pragma unroll 8
    for (int i = 0; i < 32; ++i) { const int kk = 2 * i + (lane >> 5); scr[kk * 33 + (lane & 31)] = W[(size_t)(k0 + kk) * N + c0 + (lane & 31)]; }
    LDS_WAIT(); asm volatile("" ::: "memory");
    const int c = lane & 7;
#pragma unroll
    for (int j = 0; j < 4; ++j) { const int n = (lane >> 3) + 8 * j; const LAS float* s = scr + (8 * c) * 33 + n;
        u32x4 o; o.x = pk2(s[0 * 33], s[1 * 33]); o.y = pk2(s[2 * 33], s[3 * 33]); o.z = pk2(s[4 * 33], s[5 * 33]); o.w = pk2(s[6 * 33], s[7 * 33]);
        *(u32x4*)(WT + (size_t)(n0 + n) * K + k0 + 8 * c) = o; }
    LDS_WAIT(); asm volatile("" ::: "memory");
}
__device__ __forceinline__ void transpose_item_f8(const float* W, int K, int N, unsigned char* WT, int n0, int c0, int k0, LAS float* scr, int lane) {
#pragma unroll 8
    for (int i = 0; i < 32; ++i) { const int kk = 2 * i + (lane >> 5); scr[kk * 33 + (lane & 31)] = W[(size_t)(k0 + kk) * N + c0 + (lane & 31)] * F8_SW; }
    LDS_WAIT(); asm volatile("" ::: "memory");
    const int c = lane & 7;
#pragma unroll
    for (int j = 0; j < 4; ++j) { const int n = (lane >> 3) + 8 * j; const LAS float* s = scr + (8 * c) * 33 + n;
        u32x2 o; o.x = pk4_fp8(s[0 * 33], s[1 * 33], s[2 * 33], s[3 * 33]); o.y = pk4_fp8(s[4 * 33], s[5 * 33], s[6 * 33], s[7 * 33]);
        *(u32x2*)(WT + (size_t)(n0 + n) * K + k0 + 8 * c) = o; }
    LDS_WAIT(); asm volatile("" ::: "memory");
}
__device__ __forceinline__ bool transpose_job(int& r, const float* W, int nb, int K, int N, void* WT, bool glu, bool f8, LAS float* scr, int lane) {
    const int nblk = N / 32, per = (K / 64) * nblk, tot = nb * per;
    if (r >= tot) { r -= tot; return false; }
    const int mtx = r / per, it = r % per, kb = it / nblk, nbk = it % nblk, n0 = 32 * nbk;
    int c0 = n0;
    if (glu) { const int tile = n0 >> 8, w = n0 & 255; c0 = (w < 128) ? tile * 128 + w : (N >> 1) + tile * 128 + (w - 128); }
    if (f8) transpose_item_f8(W + (size_t)mtx * K * N, K, N, (unsigned char*)WT + (size_t)mtx * K * N, n0, c0, 64 * kb, scr, lane);
    else transpose_item(W + (size_t)mtx * K * N, K, N, (bf16_t*)WT + (size_t)mtx * K * N, n0, c0, 64 * kb, scr, lane);
    return true;
}

struct ThinP {
    int nrows;
    const float* xin_lat; const float* xin_ctx;
    float* xout_lat; float* xout_ctx;
    int ymode;
    const bf16_t* Ysrc; const float* gate; const float* ga;
    bool h8;
    bf16_t* H; const float* gb; const float* shsc;
    const float* router; int* route; unsigned* cnt;
    unsigned char* HSv;
};
#define TH_DECL(PFX) f32x4 PFX##x0 = {}, PFX##x1 = {}, PFX##x2 = {}, PFX##x3 = {}; u32x2 PFX##ya0 = {}, PFX##ya1 = {}, PFX##ya2 = {}, PFX##ya3 = {}, PFX##yb0 = {}, PFX##yb1 = {}, PFX##yb2 = {}, PFX##yb3 = {}; float PFX##w0 = 0.f, PFX##w1 = 0.f
#define TH_LOAD(PFX, r_, it_) do { const int rr_ = (r_); \
    const float* xr_ = (rr_ < RL ? P.xin_lat + (size_t)rr_ * DM : P.xin_ctx + (size_t)(rr_ - RL) * DM) + 4 * lane; \
    PFX##x0 = *reinterpret_cast<const f32x4*>(xr_); PFX##x1 = *reinterpret_cast<const f32x4*>(xr_ + 256); PFX##x2 = *reinterpret_cast<const f32x4*>(xr_ + 512); PFX##x3 = *reinterpret_cast<const f32x4*>(xr_ + 768); \
    const bf16_t* ya_ = P.Ysrc; const bf16_t* yb_ = P.Ysrc; \
    if (P.ymode == 1) ya_ = P.Ysrc + (size_t)rr_ * DM; \
    else if (P.ymode == 2) { const LAS int* rt_ = rtl + (it_) * 6; \
        const int e0_ = rt_[0], p0_ = rt_[1], e1_ = rt_[2], p1_ = rt_[3]; PFX##w0 = __int_as_float(rt_[4]); PFX##w1 = __int_as_float(rt_[5]); \
        const unsigned b0_ = e0_ == 0 ? 0u : e0_ == 1 ? cb1 : e0_ == 2 ? cb2 : e0_ == 3 ? cb3 : e0_ == 4 ? cb4 : e0_ == 5 ? cb5 : e0_ == 6 ? cb6 : cb7; \
        const unsigned b1_ = e1_ == 0 ? 0u : e1_ == 1 ? cb1 : e1_ == 2 ? cb2 : e1_ == 3 ? cb3 : e1_ == 4 ? cb4 : e1_ == 5 ? cb5 : e1_ == 6 ? cb6 : cb7; \
        ya_ = P.Ysrc + (size_t)(b0_ + p0_) * DM; yb_ = P.Ysrc + (size_t)(b1_ + p1_) * DM; } \
    if (P.ymode) { ya_ += 4 * lane; PFX##ya0 = *reinterpret_cast<const u32x2*>(ya_); PFX##ya1 = *reinterpret_cast<const u32x2*>(ya_ + 256); PFX##ya2 = *reinterpret_cast<const u32x2*>(ya_ + 512); PFX##ya3 = *reinterpret_cast<const u32x2*>(ya_ + 768); } \
    if (P.ymode == 2) { yb_ += 4 * lane; PFX##yb0 = *reinterpret_cast<const u32x2*>(yb_); PFX##yb1 = *reinterpret_cast<const u32x2*>(yb_ + 256); PFX##yb2 = *reinterpret_cast<const u32x2*>(yb_ + 512); PFX##yb3 = *reinterpret_cast<const u32x2*>(yb_ + 768); } \
    } while (0)
#define TH_ARGS(PFX) PFX##x0, PFX##x1, PFX##x2, PFX##x3, PFX##ya0, PFX##ya1, PFX##ya2, PFX##ya3, PFX##yb0, PFX##yb1, PFX##yb2, PFX##yb3, PFX##w0, PFX##w1
__device__ __forceinline__ void thin_proc(const ThinP& P, f32x4 x0, f32x4 x1, f32x4 x2, f32x4 x3, u32x2 ya0, u32x2 ya1, u32x2 ya2, u32x2 ya3, u32x2 yb0, u32x2 yb1, u32x2 yb2, u32x2 yb3, float yw0, float yw1,
                                          f32x4 GA0, f32x4 GA1, f32x4 GA2, f32x4 GA3, f32x4 GB0, f32x4 GB1, f32x4 GB2, f32x4 GB3, f32x4 SH0, f32x4 SH1, f32x4 SH2, f32x4 SH3,
                                          int r, int li, int lane, LAS float* rwT, LAS int* rec, LAS unsigned* lcnt) {
    const int idx = r < RL ? (r >> 12) : 8;
    f32x4 xv[4] = {x0, x1, x2, x3};
    if (P.ymode) {
        f32x4 yv[4];
#define BF4(w) ((f32x4){bf_lo((w).x), bf_hi((w).x), bf_lo((w).y), bf_hi((w).y)})
        if (P.ymode == 1) { yv[0] = BF4(ya0); yv[1] = BF4(ya1); yv[2] = BF4(ya2); yv[3] = BF4(ya3); }
        else { yv[0] = BF4(ya0) * yw0 + BF4(yb0) * yw1; yv[1] = BF4(ya1) * yw0 + BF4(yb1) * yw1; yv[2] = BF4(ya2) * yw0 + BF4(yb2) * yw1; yv[3] = BF4(ya3) * yw0 + BF4(yb3) * yw1; }
#undef BF4
        float ss = 0.f;
#pragma unroll
        for (int j = 0; j < 4; ++j) ss += yv[j][0] * yv[j][0] + yv[j][1] * yv[j][1] + yv[j][2] * yv[j][2] + yv[j][3] * yv[j][3];
        const float rs = __builtin_amdgcn_rsqf(wave_sum(ss, lane) * (1.f / DM) + EPS);
        xv[0] = xv[0] + GA0 * (yv[0] * rs); xv[1] = xv[1] + GA1 * (yv[1] * rs); xv[2] = xv[2] + GA2 * (yv[2] * rs); xv[3] = xv[3] + GA3 * (yv[3] * rs);
    }
    if (P.xout_lat) { float* xo = r < RL ? P.xout_lat + (size_t)r * DM : P.xout_ctx + (size_t)(r - RL) * DM;
#pragma unroll
        for (int j = 0; j < 4; ++j) *reinterpret_cast<f32x4*>(xo + 4 * lane + 256 * j) = xv[j]; }
    if (P.H) {
        float ss = 0.f;
#pragma unroll
        for (int j = 0; j < 4; ++j) ss += xv[j][0] * xv[j][0] + xv[j][1] * xv[j][1] + xv[j][2] * xv[j][2] + xv[j][3] * xv[j][3];
        const float rs = __builtin_amdgcn_rsqf(wave_sum(ss, lane) * (1.f / DM) + EPS);
        bf16_t* hr = P.H + (size_t)r * DM;
        f32x4 hv[4] = {xv[0] * rs * GB0 + SH0, xv[1] * rs * GB1 + SH1, xv[2] * rs * GB2 + SH2, xv[3] * rs * GB3 + SH3};
#pragma unroll
        for (int j = 0; j < 4; ++j) {
            if (P.h8) { *reinterpret_cast<unsigned*>((unsigned char*)P.H + (size_t)r * DM + 4 * lane + 256 * j) = pk4_fp8(hv[j][0] * F8_SH, hv[j][1] * F8_SH, hv[j][2] * F8_SH, hv[j][3] * F8_SH); }
            else { u32x2 w; w.x = cvtpk(hv[j][0], hv[j][1]); w.y = cvtpk(hv[j][2], hv[j][3]); *reinterpret_cast<u32x2*>(hr + 4 * lane + 256 * j) = w; } }
        if (P.router) {
            float lg[8];
#pragma unroll
            for (int e = 0; e < 8; ++e) { float a = 0.f;
#pragma unroll
                for (int j = 0; j < 4; ++j) { const f32x4 w = *reinterpret_cast<const LAS f32x4*>(rwT + e * 1024 + 4 * lane + 256 * j); a += hv[j][0] * w[0] + hv[j][1] * w[1] + hv[j][2] * w[2] + hv[j][3] * w[3]; }
                lg[e] = wave_sum(a, lane); }
            int i0 = 0; float v0 = lg[0];
#pragma unroll
            for (int e = 1; e < 8; ++e) if (lg[e] > v0) { v0 = lg[e]; i0 = e; }
            int i1 = -1; float v1 = -3.4e38f;
#pragma unroll
            for (int e = 0; e < 8; ++e) if (e != i0 && lg[e] > v1) { v1 = lg[e]; i1 = e; }
            const float w0 = 1.f / (1.f + __expf(v1 - v0)), w1 = 1.f - w0;
            if (lane == 0) { const unsigned lp0 = __hip_atomic_fetch_add(lcnt + i0, 1u, __ATOMIC_RELAXED, __HIP_MEMORY_SCOPE_WORKGROUP), lp1 = __hip_atomic_fetch_add(lcnt + i1, 1u, __ATOMIC_RELAXED, __HIP_MEMORY_SCOPE_WORKGROUP);
                LAS int* rc = rec + li * 6; rc[0] = i0; rc[1] = (int)lp0; rc[2] = i1; rc[3] = (int)lp1; rc[4] = __float_as_int(w0); rc[5] = __float_as_int(w1); }
        }
    }
}
__device__ __forceinline__ void thin_phase(Frame& F, const ThinP& P) {
    const int lane = opaque(F.lane);
    const int nlat = P.nrows < RL ? P.nrows : RL, nctx = P.nrows - nlat;
    const int chL = (nlat + F.G - 1) / F.G, chC = (nctx + F.G - 1) / F.G;
    const int r0L = F.vcu * chL, r0C = F.vcu * chC;
    const int nl = r0L >= nlat ? 0 : (r0L + chL <= nlat ? chL : nlat - r0L), nc = r0C >= nctx ? 0 : (r0C + chC <= nctx ? chC : nctx - r0C), nrw = nl + nc;
#define TROW(li_) ((li_) < nl ? r0L + (li_) : RL + r0C + ((li_) - nl))
    LAS float* rwT = (LAS float*)F.lds;
    LAS int* rec = (LAS int*)(F.lds + 32768);
    LAS unsigned* lcnt = (LAS unsigned*)(F.lds + 65536);
    unsigned cb1 = 0, cb2 = 0, cb3 = 0, cb4 = 0, cb5 = 0, cb6 = 0, cb7 = 0;
    if (P.ymode == 2) { unsigned a = 0;
        a += (xb_ld(P.cnt + 0) + 255u) & ~255u; cb1 = a; a += (xb_ld(P.cnt + 1) + 255u) & ~255u; cb2 = a; a += (xb_ld(P.cnt + 2) + 255u) & ~255u; cb3 = a;
        a += (xb_ld(P.cnt + 3) + 255u) & ~255u; cb4 = a; a += (xb_ld(P.cnt + 4) + 255u) & ~255u; cb5 = a; a += (xb_ld(P.cnt + 5) + 255u) & ~255u; cb6 = a;
        a += (xb_ld(P.cnt + 6) + 255u) & ~255u; cb7 = a; }
    if (P.router) {
        for (int i = F.tid; i < 8192; i += 512) { const int col = i >> 3, e = i & 7; rwT[e * 1024 + col] = P.router[i]; }
        if (F.tid < 16) lcnt[F.tid] = 0u;
        __syncthreads();
    }
    LAS int* rtl = (LAS int*)(F.lds + 98304) + F.wave * 6 * 64;
    if (P.ymode == 2) { const int li_ = F.wave + 8 * lane;
        if (li_ < nrw) { const int* rt = P.route + (size_t)TROW(li_) * 8; const u32x4 a = *reinterpret_cast<const u32x4*>(rt); const u32x2 b = *reinterpret_cast<const u32x2*>(rt + 4);
            LAS int* d = rtl + lane * 6; d[0] = (int)a.x; d[1] = (int)a.y; d[2] = (int)a.z; d[3] = (int)a.w; d[4] = (int)b.x; d[5] = (int)b.y; }
        LDS_WAIT(); }
    f32x4 GA0 = {}, GA1 = {}, GA2 = {}, GA3 = {}, GB0 = {}, GB1 = {}, GB2 = {}, GB3 = {}, SH0 = {}, SH1 = {}, SH2 = {}, SH3 = {}; int cur_idx = -1;
#define TH_VEC(r_) do { const int ix_ = (r_) < RL ? ((r_) >> 12) : 8; if (ix_ != cur_idx) { cur_idx = ix_; \
        if (P.ymode) { const float* gt_ = P.gate + (size_t)ix_ * 6144 + 4 * lane; const float* ga_ = P.ga + 4 * lane; \
            GA0 = *reinterpret_cast<const f32x4*>(gt_) * *reinterpret_cast<const f32x4*>(ga_); GA1 = *reinterpret_cast<const f32x4*>(gt_ + 256) * *reinterpret_cast<const f32x4*>(ga_ + 256); \
            GA2 = *reinterpret_cast<const f32x4*>(gt_ + 512) * *reinterpret_cast<const f32x4*>(ga_ + 512); GA3 = *reinterpret_cast<const f32x4*>(gt_ + 768) * *reinterpret_cast<const f32x4*>(ga_ + 768); } \
        if (P.H) { const float* sh_ = P.shsc + (size_t)ix_ * 6144 + 4 * lane; const float* gb_ = P.gb + 4 * lane; \
            GB0 = *reinterpret_cast<const f32x4*>(gb_) * (*reinterpret_cast<const f32x4*>(sh_ + 1024) + 1.f); GB1 = *reinterpret_cast<const f32x4*>(gb_ + 256) * (*reinterpret_cast<const f32x4*>(sh_ + 1280) + 1.f); \
            GB2 = *reinterpret_cast<const f32x4*>(gb_ + 512) * (*reinterpret_cast<const f32x4*>(sh_ + 1536) + 1.f); GB3 = *reinterpret_cast<const f32x4*>(gb_ + 768) * (*reinterpret_cast<const f32x4*>(sh_ + 1792) + 1.f); \
            SH0 = *reinterpret_cast<const f32x4*>(sh_); SH1 = *reinterpret_cast<const f32x4*>(sh_ + 256); SH2 = *reinterpret_cast<const f32x4*>(sh_ + 512); SH3 = *reinterpret_cast<const f32x4*>(sh_ + 768); } } } while (0)
#define TH_VARGS GA0, GA1, GA2, GA3, GB0, GB1, GB2, GB3, SH0, SH1, SH2, SH3
    TH_DECL(A_); TH_DECL(B_);
    int li = F.wave;
    if (li < nrw) TH_LOAD(A_, TROW(li), 0);
    for (int it = 0; li < nrw; li += 16, it += 2) {
        const bool hb = li + 8 < nrw;
        if (hb) TH_LOAD(B_, TROW(li + 8), it + 1);
        TH_VEC(TROW(li)); thin_proc(P, TH_ARGS(A_), TH_VARGS, TROW(li), li, lane, rwT, rec, lcnt);
        if (li + 16 < nrw) TH_LOAD(A_, TROW(li + 16), it + 2);
        if (hb) { TH_VEC(TROW(li + 8)); thin_proc(P, TH_ARGS(B_), TH_VARGS, TROW(li + 8), li + 8, lane, rwT, rec, lcnt); }
    }
    if (P.router) {
        __syncthreads();
        if (F.tid < 8) lcnt[8 + F.tid] = __hip_atomic_fetch_add(P.cnt + F.tid, lcnt[F.tid], __ATOMIC_RELAXED, __HIP_MEMORY_SCOPE_AGENT);
        __syncthreads();
        for (int i = F.tid; i < nrw; i += 512) { const LAS int* rc = rec + i * 6; int* rt = P.route + (size_t)TROW(i) * 8;
            const int e0 = rc[0], e1 = rc[2];
            rt[0] = e0; rt[1] = rc[1] + (int)lcnt[8 + e0]; rt[2] = e1; rt[3] = rc[3] + (int)lcnt[8 + e1]; rt[4] = rc[4]; rt[5] = rc[5]; }
        VM_WAIT();
        for (int lb = F.wave; lb < nrw; lb += 32) {
            u32x4 v[4]; size_t s0[4], s1[4];
#pragma unroll
            for (int q = 0; q < 4; ++q) { const int lq = lb + 8 * q; const int r = TROW(lq); if (lq < nrw) { const LAS int* rc = rec + lq * 6; const int e0 = rc[0], e1 = rc[2];
                s0[q] = (size_t)e0 * RT + (size_t)(rc[1] + (int)lcnt[8 + e0]); s1[q] = (size_t)e1 * RT + (size_t)(rc[3] + (int)lcnt[8 + e1]);
                v[q] = *(reinterpret_cast<const u32x4*>((const unsigned char*)P.H + (size_t)r * DM) + lane); } }
#pragma unroll
            for (int q = 0; q < 4; ++q) { if (lb + 8 * q < nrw) {
                *(reinterpret_cast<u32x4*>(P.HSv + s0[q] * DM) + lane) = v[q]; *(reinterpret_cast<u32x4*>(P.HSv + s1[q] * DM) + lane) = v[q]; } }
        }
        __syncthreads();
    }
#undef TROW
#undef TH_VEC
#undef TH_VARGS
}

constexpr int NPHASE = 2 + DEPTH * 9;
__global__ void __launch_bounds__(512, 2) dit_fwd(Args args) {
    extern __shared__ __attribute__((aligned(16))) unsigned char lds[];
    Frame F;
    F.lds = (LAS unsigned char*)lds; F.ldsg = lds; F.MISC = (volatile LAS unsigned*)(F.lds + MISC_OFF);
    F.tid = threadIdx.x; F.lane = F.tid & 63; F.wave = __builtin_amdgcn_readfirstlane(F.tid >> 6);
    F.G = gridDim.x; { const int bx = blockIdx.x; F.vcu = (F.G % 8 == 0) ? (bx % 8) * (F.G / 8) + bx / 8 : bx; }
    F.ctl = (unsigned*)(args.ws + WS_CTL);
    for (int u = F.tid; u < (LDS_BYTES - RING_BYTES) / 4; u += 512) ((LAS unsigned*)(F.lds + RING_BYTES))[u] = 0u;
    __syncthreads();
    XcdBarrier bar = xcd_barrier_post(F.ctl + CW_BAR, F.MISC + 8);
    const int lo = args.ph_lo, hi = args.ph_hi;
    int ph = 0;
#define IN() (lo <= ph && ph < hi)
    unsigned long long wait_acc = 0;
#define SEAM() do { if (lo <= ph && ph + 1 < hi) { if (WAITPROBE) { const unsigned long long t0_ = __builtin_amdgcn_s_memrealtime(); xcd_barrier(bar); const unsigned long long dt_ = __builtin_amdgcn_s_memrealtime() - t0_; const int k_ = ph < 2 ? 9 + ph : (ph - 2) % 9; if ((WAITSEL >> k_) & 1u) wait_acc += dt_; } else xcd_barrier(bar); } ++ph; } while (0)
    GAS unsigned char* wsg = (GAS unsigned char*)args.ws;
#define WSP ((unsigned char*)wsg)
#define pMOD    ((float*)(WSP + WS_MOD))
#define pROPECS ((f32x2*)(WSP + WS_ROPE))
#define pWP     ((bf16_t*)(WSP + WS_WP))
#define pROUTE  ((int*)(WSP + WS_ROUTE))
#define pCS     ((bf16_t*)(WSP + WS_CS))
#define pCSC    ((bf16_t*)(WSP + WS_CSC))
#define pX      ((float*)(WSP + WS_X))
#define pH      ((bf16_t*)(WSP + WS_H))
#define pYO     ((bf16_t*)(WSP + WS_YO))
#define pZ      ((bf16_t*)(WSP + WS_Z))
#define pY      ((bf16_t*)(WSP + WS_Y))
#define pPQT    ((bf16_t*)(WSP + WS_PQT))
#define pPQTC   ((bf16_t*)(WSP + WS_PQTC))
#define pOB     ((bf16_t*)(WSP + WS_O))
#define pA2     ((bf16_t*)(WSP + WS_A2))
#define pA2M    ((bf16_t*)(WSP + WS_A2M))
#define pHS     ((bf16_t*)(WSP + WS_HS))
    const int vcu0 = F.vcu;
#define REFRAME() do { F.tid = opaque(threadIdx.x); F.lane = F.tid & 63; F.wave = __builtin_amdgcn_readfirstlane(F.tid >> 6); F.G = sopaque((int)gridDim.x); F.vcu = sopaque(vcu0); \
        wsg = gptr(args.ws); F.ctl = (unsigned*)(WSP + WS_CTL); } while (0)
    for (int rep0 = 0; rep0 < REP_P0; ++rep0)
    if (IN() && PH_ON(0)) { REFRAME();
        const int gw = F.vcu * 8 + F.wave, NGW = F.G * 8, gt = F.vcu * 512 + F.tid, NGT = F.G * 512;
        LAS float* ctab = (LAS float*)F.lds;
        LAS float* svec = (LAS float*)(F.lds + 16384);
        if (F.tid == 0) *(LAS unsigned*)(F.lds + 126976) = 0u;
        for (int i = F.tid; i < 4096; i += 512) ctab[i] = cospif((float)i * (1.f / 2048.f));
        for (int i = F.tid; i < 9 * 1024; i += 512) { const float v = i < 8192 ? args.c[i] : args.c_ctx[i - 8192]; svec[i] = v / (1.f + __expf(-v)); }
        __syncthreads();
        for (int i = gt; i < 4096 * 1024; i += NGT) { const int k = i >> 10, l0 = (i & 1023) * 8; float v[8];
#pragma unroll
            for (int e = 0; e < 8; ++e) { const int col = l0 + e, l = col & 4095; const int ph_ = (k * l) & 4095; v[e] = col < 4096 ? ctab[ph_] : -ctab[(ph_ - 1024) & 4095]; }
            if (F8_FOUR) *reinterpret_cast<u32x2*>((unsigned char*)pCS + (size_t)k * 8192 + l0) = (u32x2){pk4_fp8(v[0] * F8_SCS, v[1] * F8_SCS, v[2] * F8_SCS, v[3] * F8_SCS), pk4_fp8(v[4] * F8_SCS, v[5] * F8_SCS, v[6] * F8_SCS, v[7] * F8_SCS)};
            else *reinterpret_cast<u32x4*>(pCS + (size_t)k * 8192 + l0) = (u32x4){pk2(v[0], v[1]), pk2(v[2], v[3]), pk2(v[4], v[5]), pk2(v[6], v[7])}; }
        for (int i = gt; i < 256 * 64; i += NGT) { const int k = i >> 6, l0 = (i & 63) * 8; float v[8];
#pragma unroll
            for (int e = 0; e < 8; ++e) { const int col = l0 + e, l = col & 255; const int ph_ = (k * l * 16) & 4095; v[e] = col < 256 ? ctab[ph_] : -ctab[(ph_ - 1024) & 4095]; }
            if (F8_FOUR) *reinterpret_cast<u32x2*>((unsigned char*)pCSC + (size_t)k * 8192 + l0) = (u32x2){pk4_fp8(v[0] * F8_SCS, v[1] * F8_SCS, v[2] * F8_SCS, v[3] * F8_SCS), pk4_fp8(v[4] * F8_SCS, v[5] * F8_SCS, v[6] * F8_SCS, v[7] * F8_SCS)};
            else *reinterpret_cast<u32x4*>(pCSC + (size_t)k * 8192 + l0) = (u32x4){pk2(v[0], v[1]), pk2(v[2], v[3]), pk2(v[4], v[5]), pk2(v[6], v[7])}; }
        for (int i = gt; i < 256 * 128; i += NGT) { const int row = i >> 7, c = i & 127, m = row & 127; const int ph_ = (m * c * 32) & 4095;
            const float v = row < 128 ? ctab[ph_] : ctab[(ph_ - 1024) & 4095]; pWP[i] = (bf16_t)f2bf(v); }
        for (int i = gt; i < 64 * 16; i += NGT) { const int pos = i >> 4, k = i & 15; const float inv = __powf(10000.f, -(float)(2 * k) / 32.f); float s, c; sincosf((float)pos * inv, &s, &c); pROPECS[i] = (f32x2){c, s}; }
        for (int task = F.vcu + F.wave * F.G; task < 512; task += 8 * F.G) { const int layer = task >> 7, col = (task & 127) * 48 + F.lane;
            if (F.lane < 48) {
            const float* w = args.ada_w + (size_t)layer * DM * 6144 + col;
            float a0 = 0, a1 = 0, a2 = 0, a3 = 0, a4 = 0, a5 = 0, a6 = 0, a7 = 0, a8 = 0;
            for (int k0 = 0; k0 < DM; k0 += 32) { float wv[32];
#pragma unroll
                for (int i = 0; i < 32; ++i) wv[i] = w[(size_t)(k0 + i) * 6144];
#pragma unroll
                for (int i = 0; i < 32; ++i) { const int k = k0 + i;
                    a0 += svec[k] * wv[i]; a1 += svec[1024 + k] * wv[i]; a2 += svec[2048 + k] * wv[i]; a3 += svec[3072 + k] * wv[i]; a4 += svec[4096 + k] * wv[i];
                    a5 += svec[5120 + k] * wv[i]; a6 += svec[6144 + k] * wv[i]; a7 += svec[7168 + k] * wv[i]; a8 += svec[8192 + k] * wv[i]; } }
            const float bb = args.ada_b[layer * 6144 + col]; float* mo = pMOD + (size_t)layer * 9 * 6144 + col;
            mo[0] = a0 + bb; mo[6144] = a1 + bb; mo[2 * 6144] = a2 + bb; mo[3 * 6144] = a3 + bb; mo[4 * 6144] = a4 + bb; mo[5 * 6144] = a5 + bb; mo[6 * 6144] = a6 + bb; mo[7 * 6144] = a7 + bb; mo[8 * 6144] = a8 + bb; } }
        LAS float* scr = (LAS float*)(F.lds + 57344 + F.wave * 8448);
        LAS unsigned* wcnt = (LAS unsigned*)(F.lds + 126976);
        constexpr int NITEMS = 2 * (16 * 40) + 2 * (16 * 32) + 2 * (16 * 96) + 2 * (16 * 32) + 2 * (16 * 176) + 2 * (44 * 32) + 16 * (16 * 224) + 16 * (56 * 32);
        for (;;) {
            const int n = __builtin_amdgcn_readfirstlane((int)__hip_atomic_fetch_add(wcnt, F.lane == 0 ? 1u : 0u, __ATOMIC_RELAXED, __HIP_MEMORY_SCOPE_WORKGROUP));
            const int it = ((n >> 3) * F.G + F.vcu) * 8 + (n & 7);
            if (it >= NITEMS) break;
            int r = it;
            if (transpose_job(r, args.mix_in_w, 2, DM, MIXIN, (bf16_t*)(WSP + WS_WMIXIN), false, false, scr, F.lane)) continue;
            if (transpose_job(r, args.mix_out_w, 2, DM, DM, (bf16_t*)(WSP + WS_WMIXOUT), false, false, scr, F.lane)) continue;
            if (transpose_job(r, args.diff_qkv_w, 2, DM, 3072, (bf16_t*)(WSP + WS_WQKV), false, false, scr, F.lane)) continue;
            if (transpose_job(r, args.diff_out_w, 2, DM, DM, (bf16_t*)(WSP + WS_WDOUT), false, false, scr, F.lane)) continue;
            if (transpose_job(r, args.ffn_in_w, 2, DM, 2 * FFN, (bf16_t*)(WSP + WS_WFFNIN), true, F8_DENSE, scr, F.lane)) continue;
            if (transpose_job(r, args.ffn_out_w, 2, FFN, DM, (bf16_t*)(WSP + WS_WFFNOUT), false, F8_DENSE, scr, F.lane)) continue;
            if (transpose_job(r, args.expert_in_w, 16, DM, 2 * EDIM, (bf16_t*)(WSP + WS_WEXPIN), true, true, scr, F.lane)) continue;
            transpose_job(r, args.expert_out_w, 16, EDIM, DM, (bf16_t*)(WSP + WS_WEXPOUT), false, true, scr, F.lane);
        }
        __syncthreads();
    }
    SEAM();
    if (IN() && PH_ON(1)) { REFRAME();
        ThinP P{}; P.nrows = RT; P.xin_lat = args.x; P.xin_ctx = args.ctx; P.ymode = 0; P.H = pH; P.gb = args.norm_g; P.shsc = pMOD;
        for (int rep = 0; rep < REP_P0B; ++rep) thin_phase(F, P);
        for (int rep = 0; rep < EXTRA_BARS; ++rep) xcd_barrier(bar);
    }
    SEAM();

    for (int layer = 0; layer < DEPTH; ++layer) {
        const int j = layer >> 1; const bool even = !(layer & 1), lastl = layer == DEPTH - 1;
        const float* modl = pMOD + (size_t)layer * 9 * 6144; const float* ng = args.norm_g + (size_t)layer * 4 * DM;
        const int Mrows = lastl ? RL : RT;
        if (IN() && PH_ON(2)) { REFRAME();
            pg8::Dims d{DM, DM}; SchedDense S;
            if (even) { S.init(pH, DM, (bf16_t*)(WSP + WS_WMIXIN) + (size_t)j * MIXIN * DM, DM, RT, MIXIN, DM, F.G, (int)blockIdx.x);
                EpiRope E{pZ, MIXIN, 4, 9, pROPECS, 4, 8, QK_C}; for (int rep = 0; rep < REP_PROJ; ++rep) pg8::gemm_phase(F.lds, d, S, E); }
            else { S.init(pH, DM, (bf16_t*)(WSP + WS_WQKV) + (size_t)j * 3072 * DM, DM, RT, 3072, DM, F.G, (int)blockIdx.x);
                EpiRope E{pZ, 3072, 0, 16, pROPECS, 0, 8, QK_C}; for (int rep = 0; rep < REP_PROJ; ++rep) pg8::gemm_phase(F.lds, d, S, E); }
        }
        SEAM();
        if (IN() && PH_ON(3)) { REFRAME();
            if (even) {
                if (PH_ON(16)) { pg8::Dims d{128, MIXIN}; SchedF1 S{(const char*)pWP, (const char*)pZ, F.G, F.vcu}; EpiPQt E{pPQT, pPQTC}; for (int rep = 0; rep < REP_FOUR; ++rep) pg8::gemm_phase(F.lds, d, S, E); }
            } else {
                const float* lv = args.diff_lambda + j * 256;
                const int ln = opaque(F.lane); const float s01 = wave_sum(lv[ln] * lv[64 + ln], ln), s23 = wave_sum(lv[128 + ln] * lv[192 + ln], ln);
                const float lam_init = 0.8f - 0.6f * __expf(-0.3f * (float)layer);
                const float lam = __expf(s01) - __expf(s23) + lam_init;
                const float* subg = args.diff_subln_g + j * 128;
                const int nu = lastl ? 2048 : 2048 + 128;
                for (int rep = 0; rep < REP_DIFF; ++rep)
                for (int u = F.vcu; u < (PH_ON(18) ? nu : 0); u += F.G) {
                    if (u < 2048) diff_attn_unit((char*)lds, pZ, pOB, subg, lam, 1.f - lam_init, u >> 8, (u >> 5) & 7, u & 31, false);
                    else { const int v = u - 2048; diff_attn_unit((char*)lds, pZ, pOB, subg, lam, 1.f - lam_init, v >> 4, (v >> 1) & 7, v & 1, true); }
                }
                __syncthreads();
            }
        }
        SEAM();
        if (IN() && PH_ON(4)) { REFRAME();
            if (even) { pg8::Dims d{F8_FOUR ? 4096 : 8192, F8_FOUR ? 4096 : 8192}; SchedF2 S{(const char*)pCS, (const char*)pCSC, (const char*)pPQT, (const char*)pPQTC, F.G, F.vcu}; EpiFour2 E{pY}; for (int rep = 0; rep < REP_FOUR; ++rep) pg8::gemm_phase<EpiFour2, SchedF2, F8_FOUR>(F.lds, d, S, E);
                const float* sink = args.win_sink + j * 8;
                for (int rep = 0; rep < REP_WIN; ++rep)
                for (int u = F.vcu; u < (PH_ON(17) ? 1024 + 64 : 0); u += F.G) {
                    if (u < 1024) win_attn_unit2((char*)lds, pZ, pY, sink, u >> 7, (u >> 6) & 1, u & 63, false);
                    else { const int v = u - 1024; win_attn_unit2((char*)lds, pZ, pY, sink, v >> 3, (v >> 2) & 1, v & 3, true); }
                }
                __syncthreads();
            }
        }
        if (even) SEAM(); else ++ph;
        if (IN() && PH_ON(5)) { REFRAME();
            pg8::Dims d{DM, DM}; SchedDense S;
            S.init(even ? pY : pOB, DM, (bf16_t*)(WSP + (even ? WS_WMIXOUT : WS_WDOUT)) + (size_t)j * DM * DM, DM, Mrows, DM, DM, F.G, (int)blockIdx.x);
            EpiStore E{pYO, DM, 1.f}; for (int rep = 0; rep < REP_PROJ; ++rep) pg8::gemm_phase(F.lds, d, S, E);
        }
        SEAM();
        if (IN() && PH_ON(6)) { REFRAME();
            ThinP P{}; P.nrows = Mrows; P.xin_lat = layer == 0 ? args.x : pX; P.xin_ctx = layer == 0 ? args.ctx : pX + (size_t)RL * DM;
            P.xout_lat = pX; P.xout_ctx = pX + (size_t)RL * DM; P.ymode = 1; P.Ysrc = pYO; P.gate = modl + 2048; P.ga = ng + DM;
            P.H = pH; P.h8 = !even || F8_DENSE; P.gb = ng + 2 * DM; P.shsc = modl + 3072;
            if (!even) { P.router = args.router_w + (size_t)j * DM * 8; P.route = pROUTE; P.cnt = F.ctl + CW_CNT + 16 * j; P.HSv = (unsigned char*)pHS; }
            thin_phase(F, P);
        }
        SEAM();
        unsigned c0 = 0, c1 = 0, c2 = 0, c3 = 0, c4 = 0, c5 = 0, c6 = 0, c7 = 0;
        if (!even) { unsigned* cn = F.ctl + CW_CNT + 16 * j; unsigned a = 0;
            c0 = 0; a += (rfl(xb_ld(cn + 0)) + 255u) & ~255u; c1 = a; a += (rfl(xb_ld(cn + 1)) + 255u) & ~255u; c2 = a; a += (rfl(xb_ld(cn + 2)) + 255u) & ~255u; c3 = a;
            a += (rfl(xb_ld(cn + 3)) + 255u) & ~255u; c4 = a; a += (rfl(xb_ld(cn + 4)) + 255u) & ~255u; c5 = a; a += (rfl(xb_ld(cn + 5)) + 255u) & ~255u; c6 = a;
            a += (rfl(xb_ld(cn + 6)) + 255u) & ~255u; c7 = a; a += (rfl(xb_ld(cn + 7)) + 255u) & ~255u; c0 = a; }
        ++ph;
        if (IN() && PH_ON(8)) { REFRAME();
            const bool f8 = !even || F8_DENSE; const int eb = f8 ? 1 : 2;
            pg8::Dims d{DM * eb / 2, DM * eb / 2}; SchedGroup S;
            if (even) { S.A = (const char*)pH; S.B = (const char*)(WSP + WS_WFFNIN) + (size_t)j * 2 * FFN * DM * eb; S.nRT = RT / 256; S.P1 = S.P2 = S.P3 = S.P4 = S.P5 = S.P6 = S.P7 = 1 << 30; S.nN = 2 * FFN / 256; S.gB = 0; S.aE = 0; }
            else { S.aE = (size_t)RT * DM; S.A = (const char*)pHS; S.B = (const char*)(WSP + WS_WEXPIN) + (size_t)j * NEXP * 2 * EDIM * DM; S.nRT = (int)(c0 >> 8);
                S.P1 = (int)(c1 >> 8); S.P2 = (int)(c2 >> 8); S.P3 = (int)(c3 >> 8); S.P4 = (int)(c4 >> 8); S.P5 = (int)(c5 >> 8); S.P6 = (int)(c6 >> 8); S.P7 = (int)(c7 >> 8);
                S.nN = 2 * EDIM / 256; S.gB = (size_t)2 * EDIM * DM; }
            S.nwg = S.nRT * S.nN; S.G = F.G; S.c = (int)blockIdx.x; S.nkt = DM * eb / 128; S.tA = (size_t)256 * DM * eb; S.tB = (size_t)256 * DM * eb;
            if (f8) { EpiSwiglu<true> E{(unsigned char*)(even ? pA2 : pA2M), even ? FFN : EDIM, 1.f / (F8_SH * F8_SW)}; for (int rep = 0; rep < REP_MOE; ++rep) pg8::gemm_phase<EpiSwiglu<true>, SchedGroup, true, ALIGN_SWIGLU>(F.lds, d, S, E); }
            else { EpiSwiglu<false> E{(unsigned char*)pA2, FFN, 1.f}; for (int rep = 0; rep < REP_MOE; ++rep) pg8::gemm_phase<EpiSwiglu<false>, SchedGroup, false>(F.lds, d, S, E); }
        }
        SEAM();
        if (IN() && PH_ON(9)) { REFRAME();
            const bool f8 = !even || F8_DENSE; const int eb = f8 ? 1 : 2;
            const int Kh = even ? FFN : EDIM; pg8::Dims d{Kh * eb / 2, Kh * eb / 2}; SchedGroup S;
            if (even) { S.A = (const char*)pA2; S.B = (const char*)(WSP + WS_WFFNOUT) + (size_t)j * DM * FFN * eb; S.nRT = RT / 256; S.P1 = S.P2 = S.P3 = S.P4 = S.P5 = S.P6 = S.P7 = 1 << 30; S.gB = 0; }
            else { S.A = (const char*)pA2M; S.B = (const char*)(WSP + WS_WEXPOUT) + (size_t)j * NEXP * DM * EDIM; S.nRT = (int)(c0 >> 8);
                S.P1 = (int)(c1 >> 8); S.P2 = (int)(c2 >> 8); S.P3 = (int)(c3 >> 8); S.P4 = (int)(c4 >> 8); S.P5 = (int)(c5 >> 8); S.P6 = (int)(c6 >> 8); S.P7 = (int)(c7 >> 8);
                S.gB = (size_t)DM * EDIM; }
            S.aE = 0; S.nN = DM / 256; S.nwg = S.nRT * S.nN; S.G = F.G; S.c = (int)blockIdx.x; S.nkt = Kh * eb / 128; S.tA = (size_t)256 * Kh * eb; S.tB = (size_t)256 * Kh * eb;
            if (f8) { EpiStore E{even ? pYO : pHS, DM, 1.f / (F8_SA * F8_SW)}; for (int rep = 0; rep < REP_MOE; ++rep) pg8::gemm_phase<EpiStore, SchedGroup, true>(F.lds, d, S, E); }
            else { EpiStore E{pYO, DM, 1.f}; for (int rep = 0; rep < REP_MOE; ++rep) pg8::gemm_phase<EpiStore, SchedGroup, false>(F.lds, d, S, E); }
        }
        SEAM();
        if (IN() && PH_ON(10)) { REFRAME();
            ThinP P{}; P.nrows = Mrows; P.xin_lat = pX; P.xin_ctx = pX + (size_t)RL * DM;
            P.xout_lat = lastl ? args.out : pX; P.xout_ctx = pX + (size_t)RL * DM; P.ymode = even ? 1 : 2; P.Ysrc = even ? pYO : pHS; P.gate = modl + 5120; P.ga = ng + 3 * DM;
            P.route = pROUTE; P.cnt = F.ctl + CW_CNT + 16 * j;
            if (!lastl) { P.H = pH; P.gb = ng + 4 * DM; P.shsc = modl + 9 * 6144; }
            thin_phase(F, P);
        }
        SEAM();
    }
    if (WAITPROBE) {
        unsigned* wsum = F.ctl + 48;
        if (threadIdx.x == 0) __hip_atomic_fetch_add(wsum, (unsigned)wait_acc, __ATOMIC_RELAXED, __HIP_MEMORY_SCOPE_AGENT);
        xcd_barrier(bar);
        const unsigned mean = xb_ld(wsum) / gridDim.x; const unsigned long long t0_ = __builtin_amdgcn_s_memrealtime();
        while (__builtin_amdgcn_s_memrealtime() - t0_ < (unsigned long long)mean * WAITPROBE) __builtin_amdgcn_s_sleep(8);
    }
#undef IN
#undef SEAM
#undef REFRAME
}

#ifndef MK_PER_PHASE
#define MK_PER_PHASE 0
#endif
extern "C" void kernel_launch(void* const* d_in, const int* in_sizes, int n_in, void* d_out, int out_size, void* d_ws, size_t ws_size, hipStream_t stream) {
    static int grid = 0;
    if (grid == 0) {
        if (n_in != 19 || in_sizes[0] != RL * DM || out_size != RL * DM || ws_size < WS_END) {
            fprintf(stderr, "kernel_launch: unexpected shapes / workspace (n_in %d in0 %d out %d ws %zu need %zu)\n", n_in, n_in > 0 ? in_sizes[0] : -1, out_size, ws_size, (size_t)WS_END); grid = -1; return; }
        int dev = 0, cus = 0, per_cu = 0;
        if (hipGetDevice(&dev) != hipSuccess || hipDeviceGetAttribute(&cus, hipDeviceAttributeMultiprocessorCount, dev) != hipSuccess) { grid = -1; return; }
        if (hipFuncSetAttribute((const void*)dit_fwd, hipFuncAttributeMaxDynamicSharedMemorySize, LDS_BYTES) != hipSuccess) { fprintf(stderr, "kernel_launch: hipFuncSetAttribute failed\n"); grid = -1; return; }
        if (hipOccupancyMaxActiveBlocksPerMultiprocessor(&per_cu, (const void*)dit_fwd, 512, LDS_BYTES) != hipSuccess || per_cu < 1)
            fprintf(stderr, "kernel_launch: occupancy query reports %d\n", per_cu);
        (void)hipGetLastError();
        grid = cus;
    }
    if (grid < 0) return;
    if (hipMemsetAsync((char*)d_ws + WS_CTL, 0, CTL_BYTES, stream) != hipSuccess) return;
    Args a{};
    const float** ap = (const float**)&a;
    for (int i = 0; i < 19; ++i) ap[i] = (const float*)d_in[i];
    a.out = (float*)d_out; a.ws = (unsigned char*)d_ws;
#if MK_PER_PHASE
    for (int p = 0; p < NPHASE; ++p) { a.ph_lo = p; a.ph_hi = p + 1; hipLaunchKernelGGL(dit_fwd, dim3(grid), dim3(512), LDS_BYTES, stream, a); }
#else
    a.ph_lo = 0; a.ph_hi = NPHASE;
    hipLaunchKernelGGL(dit_fwd, dim3(grid), dim3(512), LDS_BYTES, stream, a);
#endif
}
```

```cpp
#include <hip/hip_runtime.h>
#include <cstdio>
#include <cstdint>

#ifndef PHMASK
#define PHMASK 0xFFFFFFFFu
#endif
#define PH_ON(i) ((PHMASK >> (i)) & 1u)
#ifndef REP_DIFF
#define REP_DIFF 1
#endif
#ifndef REP_MOE
#define REP_MOE 1
#endif
#ifndef REP_P0
#define REP_P0 1
#endif
#ifndef REP_P0B
#define REP_P0B 1
#endif
#ifndef EXTRA_BARS
#define EXTRA_BARS 0
#endif
#ifndef REP_EPI
#define REP_EPI 1
#endif
#ifndef WAITSEL
#define WAITSEL 0xFFFFu
#endif
#ifndef WAITPROBE
#define WAITPROBE 0
#endif
#ifndef KREP
#define KREP 1
#endif
#ifndef REP_PROJ
#define REP_PROJ 1
#endif
#ifndef REP_FOUR
#define REP_FOUR 1
#endif
#ifndef REP_WIN
#define REP_WIN 1
#endif
#define LAS __attribute__((address_space(3)))
#define GAS __attribute__((address_space(1)))
typedef unsigned short bf16_t;
typedef short bf16x8 __attribute__((ext_vector_type(8)));
typedef short s16x4 __attribute__((ext_vector_type(4)));
typedef float f32x2 __attribute__((ext_vector_type(2)));
typedef float f32x4 __attribute__((ext_vector_type(4)));
typedef float f32x16 __attribute__((ext_vector_type(16)));
typedef unsigned u32x2 __attribute__((ext_vector_type(2)));
typedef unsigned u32x4 __attribute__((ext_vector_type(4)));
typedef __bf16 bf16x2_t __attribute__((ext_vector_type(2)));
typedef int v8i_t __attribute__((ext_vector_type(8)));

constexpr int DM = 1024, NB = 8, SEQ = 4096, CTX = 256, DEPTH = 4;
constexpr int RL = NB * SEQ, RC = NB * CTX, RT = RL + RC;
constexpr int MIXIN = 1280, FFN = 2816, NEXP = 8, EDIM = 3584;
constexpr int MAXSLOT = 71680;
constexpr float EPS = 1e-6f;
constexpr float LOG2E = 1.4426950408889634f;
constexpr float QK_C = 0.125f * LOG2E;

constexpr size_t MiB = 1u << 20;
constexpr size_t WS_CTL = 0, CTL_BYTES = 32 * 1024;
constexpr size_t WS_MOD = 1 * MiB;
constexpr size_t WS_ROPE = WS_MOD + 900 * 1024;
constexpr size_t WS_WP = WS_ROPE + 8 * 1024;
constexpr size_t WS_ROUTE = 2 * MiB;
constexpr size_t WS_CS = 4 * MiB;
constexpr size_t WS_CSC = 68 * MiB;
constexpr size_t WS_WMIXIN = 72 * MiB;
constexpr size_t WS_WMIXOUT = 77 * MiB;
constexpr size_t WS_WQKV = 81 * MiB;
constexpr size_t WS_WDOUT = 93 * MiB;
constexpr size_t WS_WFFNIN = 97 * MiB;
constexpr size_t WS_WFFNOUT = 119 * MiB;
constexpr size_t WS_WEXPIN = 130 * MiB;
constexpr size_t WS_WEXPOUT = 354 * MiB;
constexpr size_t WS_X = 466 * MiB;
constexpr size_t WS_H = 602 * MiB;
constexpr size_t WS_YO = 670 * MiB;
constexpr size_t WS_RA = 738 * MiB;
constexpr size_t WS_Z = WS_RA;
constexpr size_t WS_Y = WS_RA + 85 * MiB;
constexpr size_t WS_PQT = WS_RA + 153 * MiB;
constexpr size_t WS_O = WS_RA + 204 * MiB;
constexpr size_t WS_RB = 1010 * MiB;
constexpr size_t WS_A2 = WS_RB;
constexpr size_t WS_PQTC = WS_RB + 190 * MiB;
constexpr size_t WS_A2M = WS_H;
constexpr size_t WS_HS = 1092 * MiB;
constexpr size_t WS_END = 1364 * MiB;
static_assert(WS_A2M + (size_t)MAXSLOT * EDIM * 2 <= WS_HS, "A2m overlay");
static_assert(WS_HS + (size_t)NEXP * RT * DM <= WS_END && WS_HS + (size_t)MAXSLOT * DM * 2 <= WS_END && WS_PQTC + 64 * MiB <= WS_END, "ws end");

constexpr int CW_TMO = 0;
constexpr int CW_CNT = 64;
constexpr int CW_BAR = 4096;

constexpr int RING_BYTES = 131072;
constexpr int MISC_OFF = RING_BYTES + 320;
constexpr int LDS_BYTES = 147456;

__device__ __forceinline__ unsigned cvtpk(float lo, float hi) { f32x2 v = {lo, hi}; bf16x2_t b = __builtin_convertvector(v, bf16x2_t); return __builtin_bit_cast(unsigned, b); }
#ifndef F8_DENSE
#define F8_DENSE false
#endif
#ifndef F8_FOUR
#define F8_FOUR false
#endif
constexpr float F8_SCS = 256.f, F8_SPQ = 8.f;
constexpr float F8_SH = 4.f, F8_SW = 64.f, F8_SA = 4.f;
__device__ __forceinline__ float f8clamp(float v) { return __builtin_amdgcn_fmed3f(v, -448.f, 448.f); }
__device__ __forceinline__ unsigned pk4_fp8(float a, float b, float c, float d) {
    unsigned w = 0; w = __builtin_amdgcn_cvt_pk_fp8_f32(f8clamp(a), f8clamp(b), w, false); w = __builtin_amdgcn_cvt_pk_fp8_f32(f8clamp(c), f8clamp(d), w, true); return w; }
__device__ __forceinline__ float bf_lo(unsigned u) { return __uint_as_float(u << 16); }
__device__ __forceinline__ float bf_hi(unsigned u) { return __uint_as_float(u & 0xffff0000u); }
__device__ __forceinline__ float wave_sum(float v, int lane) {
#pragma unroll
    for (int o = 1; o < 64; o <<= 1) v += __int_as_float(__builtin_amdgcn_ds_bpermute((lane ^ o) << 2, __float_as_int(v)));
    return v;
}
__device__ __forceinline__ unsigned rfl(unsigned v) { return (unsigned)__builtin_amdgcn_readfirstlane((int)v); }
__device__ __forceinline__ const char* uptr(const char* p) {
    unsigned lo = (unsigned)__builtin_amdgcn_readfirstlane((int)(unsigned)(uintptr_t)p), hi = (unsigned)__builtin_amdgcn_readfirstlane((int)(unsigned)((uintptr_t)p >> 32));
    asm volatile("" : "+s"(lo), "+s"(hi));
    return (const char*)(((uintptr_t)hi << 32) | lo);
}
__device__ __forceinline__ GAS unsigned char* gptr(const void* p) {
    unsigned lo = (unsigned)__builtin_amdgcn_readfirstlane((int)(unsigned)(uintptr_t)p), hi = (unsigned)__builtin_amdgcn_readfirstlane((int)(unsigned)((uintptr_t)p >> 32));
    asm volatile("" : "+s"(lo), "+s"(hi));
    return (GAS unsigned char*)(((uintptr_t)hi << 32) | lo);
}
__device__ __forceinline__ int sopaque(int v) { v = __builtin_amdgcn_readfirstlane(v); asm volatile("" : "+s"(v)); return v; }
__device__ __forceinline__ int opaque(int v) { asm volatile("" : "+v"(v)); return v; }
#define LDS_WAIT() asm volatile("s_waitcnt lgkmcnt(0)" ::: "memory")
#define VM_WAIT() asm volatile("s_waitcnt vmcnt(0)" ::: "memory")
#define SBAR() __builtin_amdgcn_sched_barrier(0)

namespace pg8 {
constexpr int BM = 256, BK = 64, HALF = 128, HTB = HALF * BK * 2, STAGE_BYTES = 8 * HTB, NXCD = 8, WGM = 8;
__host__ __device__ __forceinline__ int lds_byte(int r, int c) { const int st = (r >> 4) * 2 + (c >> 5), rr = r & 15, cc = c & 31, ob = rr * 64 + cc * 2; return st * 1024 + (ob ^ (((ob >> 9) & 1) << 5)); }
__host__ __device__ __forceinline__ void stage_rc(int b, int& R, int& C) { const int st = b / 1024, sb = b % 1024, swz = sb ^ (((sb >> 9) & 1) << 5); R = (st >> 1) * 16 + swz / 64; C = (st & 1) * 32 + (swz % 64) / 2; }
__host__ __device__ __forceinline__ int perm32(int rho) { const int n = rho >> 4, i = rho & 15; return 8 * (i >> 2) + 4 * n + (i & 3); }

struct Unit { int pm, pn, e, nkt; };
struct Dims { int lda, ldb; };

__device__ __forceinline__ int xcd_remap(int wgid, int nwg) {
    const int q = nwg / NXCD, r = nwg % NXCD, xcd = wgid % NXCD, off = wgid / NXCD;
    return (xcd < r ? xcd * (q + 1) : r * (q + 1) + (xcd - r) * q) + off;
}

#ifndef ALIGN_SWIGLU
#define ALIGN_SWIGLU true
#endif
#ifndef ALIGN_DEFAULT
#define ALIGN_DEFAULT true
#endif
template <class Epi, class Sched, bool F8 = false, bool ALIGN_EPI = ALIGN_DEFAULT>
__device__ __forceinline__ void gemm_phase(LAS unsigned char* lds, const Dims g, const Sched& S, const Epi& E) {
    const int tid = opaque(threadIdx.x), wid = __builtin_amdgcn_readfirstlane(tid >> 6), lane = tid & 63, wr = wid >> 2, wc = wid & 3, fr = lane & 15, fq = lane >> 4;
    unsigned voffA[2], voffB[2];
#pragma unroll
    for (int i = 0; i < 2; ++i) { int R, C; stage_rc(tid * 16 + i * 8192, R, C); const int Rb = Epi::PERM ? ((R & ~31) + perm32(R & 31)) : R;
        voffA[i] = (unsigned)(R * g.lda + C) * 2u; voffB[i] = (unsigned)(Rb * g.ldb + C) * 2u; }
    const size_t kstep = (size_t)(BK * 2);
    const size_t hstepA = (size_t)HALF * g.lda * 2, hstepB = (size_t)HALF * g.ldb * 2;
    const unsigned ldsw = (unsigned)wid * 1024u;
    const int aoff = lds_byte(wr * 64 + fr, fq * 8), boff = lds_byte(wc * 32 + fr, fq * 8);
#define PG8_SA(b, h) (((b) * 2 + (h)) * HTB)
#define PG8_SB(b, h) ((4 + (b) * 2 + (h)) * HTB)
#define PG8_STAGE(bufoff, gbase, voff) do { _Pragma("unroll") for (int _i = 0; _i < 2; ++_i) \
        __builtin_amdgcn_global_load_lds((const unsigned*)((const char*)(gbase) + (voff)[_i]), (LAS unsigned*)(lds + (bufoff) + ldsw + _i * 8192), 16, 0, 0); } while (0)
#define PG8_LDA(dst, b, h) do { _Pragma("unroll") for (int m = 0; m < 4; ++m) _Pragma("unroll") for (int k = 0; k < 2; ++k) dst[m][k] = *(const LAS bf16x8*)(lds + PG8_SA(b, h) + aoff + m * 2048 + k * 1024); } while (0)
#define PG8_LDB(dst, b, h) do { _Pragma("unroll") for (int n = 0; n < 2; ++n) _Pragma("unroll") for (int k = 0; k < 2; ++k) dst[n][k] = *(const LAS bf16x8*)(lds + PG8_SB(b, h) + boff + n * 2048 + k * 1024); } while (0)
#define PG8_V8(x) __builtin_bit_cast(v8i_t, (x))
#define PG8_MMA(ai, bj, At, Bt) do { __builtin_amdgcn_s_setprio(1); _Pragma("unroll") for (int m = 0; m < 4; ++m) _Pragma("unroll") for (int n = 0; n < 2; ++n) { \
        if constexpr (F8) { struct P2 { bf16x8 a, b; }; const v8i_t a8_ = PG8_V8((P2{Bt[n][0], Bt[n][1]})), b8_ = PG8_V8((P2{At[m][0], At[m][1]})); \
            asm volatile("v_mfma_f32_16x16x128_f8f6f4 %0, %1, %2, %0" : "+v"(acc[ai][bj][m][n]) : "v"(a8_), "v"(b8_)); }   \
        else { _Pragma("unroll") for (int k = 0; k < 2; ++k) acc[ai][bj][m][n] = __builtin_amdgcn_mfma_f32_16x16x32_bf16(Bt[n][k], At[m][k], acc[ai][bj][m][n], 0, 0, 0); } } \
        __builtin_amdgcn_s_setprio(0); } while (0)
#define PG8_WAIT_V(n) asm volatile("s_waitcnt vmcnt(" #n ")" ::: "memory")
#define PG8_WAIT_L(n) asm volatile("s_waitcnt lgkmcnt(" #n ")" ::: "memory")
#define PG8_BAR __builtin_amdgcn_s_barrier()
#define PG8_SCHED __builtin_amdgcn_sched_barrier(0)
    Unit cur, nxt; int ui = 0;
    if (!S.next(0, cur)) return;
    f32x4 acc[2][2][4][2];
#pragma unroll
    for (int a = 0; a < 2; ++a)
#pragma unroll
        for (int b = 0; b < 2; ++b)
#pragma unroll
            for (int m = 0; m < 4; ++m)
#pragma unroll
                for (int n = 0; n < 2; ++n) acc[a][b][m][n] = (f32x4){0.f, 0.f, 0.f, 0.f};
    bf16x8 At[4][2], B0[2][2], B1[2][2];
    const char* cA = uptr(S.aptr(cur)); const char* cB = uptr(S.bptr(cur));
    PG8_STAGE(PG8_SB(0, 0), cB, voffB); PG8_STAGE(PG8_SB(0, 1), cB + hstepB, voffB); PG8_STAGE(PG8_SA(0, 0), cA, voffA); PG8_STAGE(PG8_SA(0, 1), cA + hstepA, voffA);
    if (wr == 1) PG8_BAR;
    PG8_WAIT_V(2); PG8_BAR;
    PG8_STAGE(PG8_SB(1, 0), cB + kstep, voffB); PG8_STAGE(PG8_SA(1, 0), cA + kstep, voffA); PG8_STAGE(PG8_SB(1, 1), cB + hstepB + kstep, voffB);
    PG8_WAIT_V(6); PG8_BAR;
    for (;;) {
        const bool has_next = S.next(ui + 1, nxt);
        const char* nA = uptr(has_next ? S.aptr(nxt) : cA); const char* nB = uptr(has_next ? S.bptr(nxt) : cB);
        const int nt = sopaque(cur.nkt);
        for (int t = 0; t < KREP * nt; t += 2) {
            const bool last = (t == KREP * nt - 2);
            const char* a1 = cA + (size_t)(KREP == 1 ? t + 1 : (t + 1) % nt) * kstep;
            const char* a2 = last ? nA : cA + (size_t)(KREP == 1 ? t + 2 : (t + 2) % nt) * kstep; const char* b2 = last ? nB : cB + (size_t)(KREP == 1 ? t + 2 : (t + 2) % nt) * kstep;
            const char* a3 = a2 + kstep; const char* b3 = b2 + kstep;
            PG8_LDB(B0, 0, 0); PG8_LDB(B1, 0, 1); PG8_SCHED; PG8_LDA(At, 0, 0); PG8_STAGE(PG8_SA(1, 1), a1 + hstepA, voffA);
            PG8_WAIT_V(8); PG8_WAIT_L(0); PG8_BAR; PG8_MMA(0, 0, At, B0); PG8_MMA(0, 1, At, B1); PG8_BAR; PG8_SCHED;
            PG8_LDA(At, 0, 1); PG8_STAGE(PG8_SB(0, 0), b2, voffB); PG8_STAGE(PG8_SB(0, 1), b2 + hstepB, voffB); PG8_STAGE(PG8_SA(0, 0), a2, voffA);
            PG8_WAIT_V(8); PG8_WAIT_L(0); PG8_BAR; PG8_MMA(1, 0, At, B0); PG8_MMA(1, 1, At, B1); PG8_BAR; PG8_SCHED;
            PG8_LDB(B0, 1, 0); PG8_LDB(B1, 1, 1); PG8_SCHED; PG8_LDA(At, 1, 0); PG8_STAGE(PG8_SA(0, 1), a2 + hstepA, voffA);
            PG8_WAIT_V(8); PG8_WAIT_L(0); PG8_BAR; PG8_MMA(0, 0, At, B0); PG8_MMA(0, 1, At, B1); PG8_BAR; PG8_SCHED;
            PG8_LDA(At, 1, 1); PG8_STAGE(PG8_SB(1, 0), b3, voffB); PG8_STAGE(PG8_SB(1, 1), b3 + hstepB, voffB); PG8_STAGE(PG8_SA(1, 0), a3, voffA);
            PG8_WAIT_V(8); PG8_WAIT_L(0); PG8_BAR; PG8_MMA(1, 0, At, B0); PG8_MMA(1, 1, At, B1); PG8_BAR; PG8_SCHED;
        }
        if constexpr (ALIGN_EPI) { if (wr == 0) PG8_BAR; }
        if constexpr (F8) asm volatile("s_nop 15\n\ts_nop 15" ::: "memory");
        for (int repe = 0; repe < REP_EPI; ++repe) { const int l2 = opaque(threadIdx.x) & 63; E(acc, cur, wr, wc, l2 & 15, l2 >> 4); }
        if (!has_next) break;
#pragma unroll
        for (int a = 0; a < 2; ++a)
#pragma unroll
            for (int b = 0; b < 2; ++b)
#pragma unroll
                for (int m = 0; m < 4; ++m)
#pragma unroll
                    for (int n = 0; n < 2; ++n) acc[a][b][m][n] = (f32x4){0.f, 0.f, 0.f, 0.f};
        cur = nxt; cA = nA; cB = nB; ++ui;
        if constexpr (ALIGN_EPI) { if (wr == 1) PG8_BAR; }
    }
    PG8_WAIT_V(0);
    if constexpr (!ALIGN_EPI) { if (wr == 0) PG8_BAR; }
    PG8_BAR;
#undef PG8_SA
#undef PG8_SB
#undef PG8_STAGE
#undef PG8_LDA
#undef PG8_LDB
#undef PG8_MMA
#undef PG8_V8
#undef PG8_WAIT_V
#undef PG8_WAIT_L
#undef PG8_BAR
#undef PG8_SCHED
}
}
using pg8::Unit;

struct EpiStore {
    static constexpr bool PERM = true;
    bf16_t* O; int ldc; float scale;
    __device__ __forceinline__ void operator()(const f32x4 (&acc)[2][2][4][2], const Unit& u, int wr, int wc, int fr, int fq) const {
        const int row0 = u.pm * 256 + wr * 64 + fr, col0 = u.pn * 256 + wc * 32 + 8 * fq;
#pragma unroll
        for (int ai = 0; ai < 2; ++ai)
#pragma unroll
            for (int m = 0; m < 4; ++m) { bf16_t* rowp = O + (size_t)(row0 + ai * 128 + m * 16) * ldc + col0;
#pragma unroll
                for (int bj = 0; bj < 2; ++bj) { const f32x4 v0 = acc[ai][bj][m][0] * (scale * (1.f / KREP)), v1 = acc[ai][bj][m][1] * (scale * (1.f / KREP));
                    u32x4 w; w.x = cvtpk(v0[0], v0[1]); w.y = cvtpk(v0[2], v0[3]); w.z = cvtpk(v1[0], v1[1]); w.w = cvtpk(v1[2], v1[3]);
                    *(u32x4*)(rowp + bj * 128) = w; } }
    }
};
template <bool F8OUT> struct EpiSwiglu {
    static constexpr bool PERM = true;
    unsigned char* O; int ldc; float scale;
    __device__ __forceinline__ void operator()(const f32x4 (&acc)[2][2][4][2], const Unit& u, int wr, int wc, int fr, int fq) const {
        const int row0 = u.pm * 256 + wr * 64 + fr, col0 = u.pn * 128 + wc * 32 + 8 * fq;
        const float us = F8OUT ? scale * F8_SA : scale;
        const float k1 = -scale * LOG2E * (1.f / KREP), ik2 = 1.f / (scale * us * (1.f / KREP) * (1.f / KREP));
#pragma unroll
        for (int ai = 0; ai < 2; ++ai)
#pragma unroll
            for (int m = 0; m < 4; ++m) { unsigned char* rowp = O + ((size_t)(row0 + ai * 128 + m * 16) * ldc + col0) * (F8OUT ? 1 : 2);
                float r[8];
#pragma unroll
                for (int n = 0; n < 2; ++n) { const f32x4 g = acc[ai][0][m][n], u = acc[ai][1][m][n]; const f32x4 t = g * k1;
                    f32x4 e; e[0] = __builtin_amdgcn_exp2f(t[0]); e[1] = __builtin_amdgcn_exp2f(t[1]); e[2] = __builtin_amdgcn_exp2f(t[2]); e[3] = __builtin_amdgcn_exp2f(t[3]);
                    const f32x4 d = e * ik2 + ik2;
                    f32x4 q; q[0] = __builtin_amdgcn_rcpf(d[0]); q[1] = __builtin_amdgcn_rcpf(d[1]); q[2] = __builtin_amdgcn_rcpf(d[2]); q[3] = __builtin_amdgcn_rcpf(d[3]);
                    const f32x4 o = (g * u) * q; r[n * 4 + 0] = o[0]; r[n * 4 + 1] = o[1]; r[n * 4 + 2] = o[2]; r[n * 4 + 3] = o[3]; }
                if constexpr (F8OUT) { u32x2 w; w.x = pk4_fp8(r[0], r[1], r[2], r[3]); w.y = pk4_fp8(r[4], r[5], r[6], r[7]); *(u32x2*)rowp = w; }
                else { u32x4 w; w.x = cvtpk(r[0], r[1]); w.y = cvtpk(r[2], r[3]); w.z = cvtpk(r[4], r[5]); w.w = cvtpk(r[6], r[7]); *(u32x4*)rowp = w; } }
    }
};
struct EpiRope {
    static constexpr bool PERM = false;
    bf16_t* O; int ldc; int rlo, rhi; const f32x2* cs;
    int qlo, qhi; float qscale;
    __device__ __forceinline__ void operator()(const f32x4 (&acc)[2][2][4][2], const Unit& u, int wr, int wc, int fr, int fq) const {
        const int row0 = u.pm * 256 + wr * 64 + fr, col0 = u.pn * 256 + wc * 32 + 4 * fq;
        const bool lat = u.pm < 128;
#pragma unroll
        for (int ai = 0; ai < 2; ++ai)
#pragma unroll
            for (int m = 0; m < 4; ++m) { const int row = row0 + ai * 128 + m * 16; bf16_t* rowp = O + (size_t)row * ldc + col0;
                const int t = row & 4095, pos = (wc & 1) ? (t & 63) : (t >> 6);
                const f32x2* c4 = cs + pos * 16 + 4 * fq;
                const f32x2 c0 = c4[0], c1 = c4[1], c2 = c4[2], c3 = c4[3];
#pragma unroll
                for (int bj = 0; bj < 2; ++bj) { f32x4 p1 = acc[ai][bj][m][0] * (1.f / KREP), p2 = acc[ai][bj][m][1] * (1.f / KREP);
                    const int blk = u.pn * 2 + bj;
                    if (lat && blk >= rlo && blk < rhi) {
                        const f32x4 cv = {c0.x, c1.x, c2.x, c3.x}, sv = {c0.y, c1.y, c2.y, c3.y};
                        const f32x4 o1 = p1 * cv - p2 * sv, o2 = p2 * cv + p1 * sv; p1 = o1; p2 = o2; }
                    if (blk >= qlo && blk < qhi) { p1 = p1 * qscale; p2 = p2 * qscale; }
                    u32x2 w1, w2; w1.x = cvtpk(p1[0], p1[1]); w1.y = cvtpk(p1[2], p1[3]); w2.x = cvtpk(p2[0], p2[1]); w2.y = cvtpk(p2[2], p2[3]);
                    *(u32x2*)(rowp + bj * 128) = w1; *(u32x2*)(rowp + bj * 128 + 16) = w2; } }
    }
};
struct EpiPQt {
    static constexpr bool PERM = true;
    bf16_t* Plat; bf16_t* Pctx;
    __device__ __forceinline__ void operator()(const f32x4 (&acc)[2][2][4][2], const Unit& u, int wr, int wc, int fr, int fq) const {
        const bool ctx = u.e >= 32; const int bg = ctx ? u.e - 32 : u.e; const int L = ctx ? CTX : SEQ;
        constexpr int EB = F8_FOUR ? 1 : 2;
        unsigned char* base = (unsigned char*)(ctx ? Pctx : Plat) + (size_t)bg * 128 * 8192 * EB;
        const int col0 = u.pn * 256 + wc * 32 + 8 * fq;
#pragma unroll
        for (int ai = 0; ai < 2; ++ai)
#pragma unroll
            for (int m = 0; m < 4; ++m) { unsigned char* rowp = base + ((size_t)(wr * 64 + m * 16 + fr) * 8192 + ai * L + col0) * EB;
#pragma unroll
                for (int bj = 0; bj < 2; ++bj) { const f32x4 v0 = acc[ai][bj][m][0] * (1.f / KREP), v1 = acc[ai][bj][m][1] * (1.f / KREP);
                    if constexpr (F8_FOUR) { u32x2 w; w.x = pk4_fp8(v0[0] * F8_SPQ, v0[1] * F8_SPQ, v0[2] * F8_SPQ, v0[3] * F8_SPQ); w.y = pk4_fp8(v1[0] * F8_SPQ, v1[1] * F8_SPQ, v1[2] * F8_SPQ, v1[3] * F8_SPQ); *(u32x2*)(rowp + bj * 128) = w; }
                    else { u32x4 w; w.x = cvtpk(v0[0], v0[1]); w.y = cvtpk(v0[2], v0[3]); w.z = cvtpk(v1[0], v1[1]); w.w = cvtpk(v1[2], v1[3]); *(u32x4*)(rowp + bj * 128 * 2) = w; } } }
    }
};
struct EpiFour2 {
    static constexpr bool PERM = true;
    bf16_t* O;
    __device__ __forceinline__ void operator()(const f32x4 (&acc)[2][2][4][2], const Unit& u, int wr, int wc, int fr, int fq) const {
        EpiStore s{O, DM, (u.pm < 128 ? 0.0013810679320049757f   : 0.005524271728019903f  ) * (F8_FOUR ? 1.f / (F8_SCS * F8_SPQ) : 1.f)};
        s(acc, u, wr, wc, fr, fq);
    }
};

struct SchedDense {
    const char* A; const char* B; int nM, nN, nwg, G, c, nkt; size_t tA, tB;
    __device__ __forceinline__ void init(const void* A_, int lda, const void* B_, int ldb, int M, int N, int K, int G_, int c_) {
        A = (const char*)A_; B = (const char*)B_; nM = M / 256; nN = N / 256; nwg = nM * nN; G = G_; c = c_; nkt = K / 64; tA = (size_t)256 * lda * 2; tB = (size_t)256 * ldb * 2; }
    __device__ __forceinline__ bool next(int i, Unit& u) const {
        const long L = (long)i * G + c; if (L >= nwg) return false;
        const int wgid = pg8::xcd_remap((int)L, nwg);
        const int nig = pg8::WGM * nN, gid = wgid / nig, fm = gid * pg8::WGM, gsz = (nM - fm) < pg8::WGM ? (nM - fm) : pg8::WGM;
        u.pm = fm + ((wgid % nig) % gsz); u.pn = (wgid % nig) / gsz; u.e = 0; u.nkt = nkt; return true;
    }
    __device__ __forceinline__ const char* aptr(const Unit& u) const { return A + (size_t)u.pm * tA; }
    __device__ __forceinline__ const char* bptr(const Unit& u) const { return B + (size_t)u.pn * tB; }
};
struct SchedGroup {
    const char* A; const char* B; int P1, P2, P3, P4, P5, P6, P7, nRT, nN, nwg, G, c, nkt; size_t tA, tB, gB, aE;
    __device__ __forceinline__ bool next(int i, Unit& u) const {
        const long L = (long)i * G + c; if (L >= nwg) return false;
        const int wgid = pg8::xcd_remap((int)L, nwg);
        const int nig = pg8::WGM * nN, gid = wgid / nig, fm = gid * pg8::WGM, gsz = (nRT - fm) < pg8::WGM ? (nRT - fm) : pg8::WGM;
        const int rt = fm + ((wgid % nig) % gsz);
        u.pm = rt; u.pn = (wgid % nig) / gsz; u.nkt = nkt;
        u.e = (rt >= P1) + (rt >= P2) + (rt >= P3) + (rt >= P4) + (rt >= P5) + (rt >= P6) + (rt >= P7); return true;
    }
    __device__ __forceinline__ const char* aptr(const Unit& u) const {
        if (aE == 0) return A + (size_t)u.pm * tA;
        const int pe = u.e == 0 ? 0 : u.e == 1 ? P1 : u.e == 2 ? P2 : u.e == 3 ? P3 : u.e == 4 ? P4 : u.e == 5 ? P5 : u.e == 6 ? P6 : P7;
        return A + (size_t)u.e * aE + (size_t)(u.pm - pe) * tA; }
    __device__ __forceinline__ const char* bptr(const Unit& u) const { return B + (size_t)u.e * gB + (size_t)u.pn * tB; }
};
struct SchedF1 {
    const char* Wp; const char* Z; int G, c;
    __device__ __forceinline__ bool next(int i, Unit& u) const {
        const int L = i * G + c; if (L >= 544) return false;
        u.pm = 0; u.nkt = 2;
        if (L < 512) { u.e = L >> 4; u.pn = L & 15; } else { u.e = 32 + (L - 512); u.pn = 0; }
        return true;
    }
    __device__ __forceinline__ const char* aptr(const Unit&) const { return Wp; }
    __device__ __forceinline__ const char* bptr(const Unit& u) const {
        const bool ctx = u.e >= 32; const int bg = ctx ? u.e - 32 : u.e, b = bg >> 2, gq = bg & 3;
        const size_t row0 = ctx ? (size_t)RL + b * CTX : (size_t)b * SEQ + u.pn * 256;
        return Z + (row0 * MIXIN + gq * 128) * 2; }
};
struct SchedF2 {
    const char* CSl; const char* CSc; const char* Plat; const char* Pctx; int G, vcu;
    static constexpr size_t EB = F8_FOUR ? 1 : 2;
    __device__ __forceinline__ bool next(int i, Unit& u) const {
        const int L = i * G + vcu; if (L >= 272) return false;
        if (L < 256) { const int b = L >> 5, mt = (L & 31) >> 1; u.pm = b * 16 + mt; u.pn = L & 1; u.e = b; u.nkt = F8_FOUR ? 64 : 128; }
        else { const int b = (L - 256) >> 1; u.pm = 128 + b; u.pn = L & 1; u.e = 8 + b; u.nkt = F8_FOUR ? 4 : 8; }
        return true;
    }
    __device__ __forceinline__ const char* aptr(const Unit& u) const { return u.e < 8 ? CSl + (size_t)(u.pm & 15) * 256 * 8192 * EB : CSc; }
    __device__ __forceinline__ const char* bptr(const Unit& u) const { return (u.e < 8 ? Plat + (size_t)u.e * 512 * 8192 * EB : Pctx + (size_t)(u.e - 8) * 512 * 8192 * EB) + (size_t)u.pn * 256 * 8192 * EB; }
};

#define XB_TMO      128
#define XB_XCNT(j)  (256  + 64 * (j))
#define XB_XSUB(j)  (1280 + 64 * (j))
#define XB_XGEN(j)  (2304 + 64 * (j))
#define XB_TOP      3328
#define XB_TOPGEN   3392
#define XCD_BAR_WORDS 3456
#define XB_SPIN_CAP (1u << 21)
__device__ __forceinline__ unsigned xb_ld(unsigned* p)              { return __hip_atomic_load(p, __ATOMIC_RELAXED, __HIP_MEMORY_SCOPE_AGENT); }
__device__ __forceinline__ unsigned xb_add(unsigned* p, unsigned v) { return __hip_atomic_fetch_add(p, v, __ATOMIC_RELAXED, __HIP_MEMORY_SCOPE_AGENT); }
__device__ __forceinline__ unsigned xb_xcc_id() { return (unsigned)__builtin_amdgcn_s_getreg((3 << 11) | 20) & 0xFu; }
#define XB_SPIN(cond, bar) do { unsigned _sp = 0; while (cond) { __builtin_amdgcn_s_sleep(1); \
    if ((++_sp & 255u) == 0u) { if (xb_ld(&(bar)[XB_TMO])) break; if (_sp > XB_SPIN_CAP) { atomicAdd(&(bar)[XB_TMO], 1u); break; } } } } while (0)
struct XcdBarrier { unsigned* bar; unsigned x; volatile LAS unsigned* st; };
__device__ __forceinline__ XcdBarrier xcd_barrier_post(unsigned* bar, volatile LAS unsigned* st) {
    XcdBarrier b; b.bar = bar; b.x = xb_xcc_id(); b.st = st;
    if (threadIdx.x == 0) (void)xb_add(&bar[XB_XCNT(b.x)], 1u);
    return b;
}
__device__ __forceinline__ void xcd_barrier_complete(unsigned* bar, unsigned x, unsigned& nloc, unsigned& nx) {
    const unsigned G = gridDim.x * gridDim.y * gridDim.z;
    unsigned sum, cnt, mine, sp = 0u;
    for (;;) {
        sum = 0u; cnt = 0u; mine = 0u;
#pragma unroll
        for (unsigned j = 0; j < 16; ++j) { const unsigned c = xb_ld(&bar[XB_XCNT(j)]); sum += c; cnt += (c > 0u) ? 1u : 0u; mine = (j == x) ? c : mine; }
        if (sum == G) break;
        __builtin_amdgcn_s_sleep(1);
        if ((++sp & 255u) == 0u) { if (xb_ld(&bar[XB_TMO])) break; if (sp > XB_SPIN_CAP) { atomicAdd(&bar[XB_TMO], 1u); break; } }
    }
    nloc = mine > 0u ? mine : 1u; nx = cnt > 0u ? cnt : 1u;
}
__device__ __forceinline__ void xcd_barrier(const XcdBarrier& b) {
    asm volatile("s_waitcnt vmcnt(0)" ::: "memory");
    __syncthreads();
    if (threadIdx.x == 0) {
        unsigned* bar = (unsigned*)uptr((const char*)b.bar);
        __builtin_amdgcn_s_waitcnt(0);
        unsigned nloc = b.st[0], nx = b.st[1];
        if (nloc == 0u) { xcd_barrier_complete(bar, b.x, nloc, nx); b.st[0] = nloc; b.st[1] = nx; }
        const unsigned old = xb_add(&bar[XB_XSUB(b.x)], 1u);
        const unsigned gen = old / nloc;
        if (old + 1u == (gen + 1u) * nloc) {
            __builtin_amdgcn_fence(__ATOMIC_RELEASE, "agent");
            asm volatile("s_waitcnt vmcnt(0)" ::: "memory");
            const unsigned og = xb_add(&bar[XB_TOP], 1u);
            const unsigned tg = og / nx;
            if (og + 1u == (tg + 1u) * nx) xb_add(&bar[XB_TOPGEN], 1u);
            else XB_SPIN(xb_ld(&bar[XB_TOPGEN]) == tg, bar);
            __builtin_amdgcn_fence(__ATOMIC_ACQUIRE, "agent");
            xb_add(&bar[XB_XGEN(b.x)], 1u);
            asm volatile("s_waitcnt vmcnt(0)" ::: "memory");
        } else {
            XB_SPIN(xb_ld(&bar[XB_XGEN(b.x)]) == gen, bar);
            __builtin_amdgcn_fence(__ATOMIC_ACQUIRE, "agent");
            asm volatile("s_waitcnt vmcnt(0)" ::: "memory");
        }
    }
    __syncthreads();
}

__device__ __forceinline__ int crow(int r, int hi) { return (r & 3) + 8 * (r >> 2) + 4 * hi; }
template <int KW> __device__ __forceinline__ int kswz(int row, int colB) { return KW == 128 ? row * 256 + (colB ^ ((row & 7) << 4)) : row * 128 + (colB ^ (((row >> 1) & 7) << 4)); }
template <int DV> __device__ __forceinline__ int v_st(int k, int c) { const int kk = (k & ~0xC) | ((k & 4) << 1) | ((k & 8) >> 1); return ((kk >> 3) * (DV / 32) + (c >> 5)) * 512 + ((kk & 7) * 32 + (c & 31)) * 2; }
__device__ __forceinline__ int v_rd_base(int lane) { return ((lane & 3) << 3) | (((lane >> 2) & 3) << 6) | (((lane >> 4) & 1) << 5) | (((lane >> 5) & 1) << 8); }
template <int OFF> __device__ __forceinline__ s16x4 tr_read(int vb) { s16x4 r; asm volatile("ds_read_b64_tr_b16 %0, %1 offset:%2" : "=&v"(r) : "v"(vb), "i"(OFF) : "memory"); return r; }
template <int DV, int D0> __device__ __forceinline__ void pv_one(f32x16& od, int vb, bf16x8 pa0, bf16x8 pa1, bf16x8 pa2, bf16x8 pa3) {
    constexpr int KS = (DV / 32) * 1024, HF = (DV / 32) * 512;
    const s16x4 l0 = tr_read<D0 * 512 + 0 * KS>(vb), h0 = tr_read<D0 * 512 + 0 * KS + HF>(vb), l1 = tr_read<D0 * 512 + 1 * KS>(vb), h1 = tr_read<D0 * 512 + 1 * KS + HF>(vb);
    const s16x4 l2 = tr_read<D0 * 512 + 2 * KS>(vb), h2 = tr_read<D0 * 512 + 2 * KS + HF>(vb), l3 = tr_read<D0 * 512 + 3 * KS>(vb), h3 = tr_read<D0 * 512 + 3 * KS + HF>(vb);
    asm volatile("s_waitcnt lgkmcnt(0)" ::: "memory"); SBAR();
#define PKV(L, H) (bf16x8){L[0], L[1], L[2], L[3], H[0], H[1], H[2], H[3]}
    od = __builtin_amdgcn_mfma_f32_32x32x16_bf16(pa0, PKV(l0, h0), od, 0, 0, 0);
    od = __builtin_amdgcn_mfma_f32_32x32x16_bf16(pa1, PKV(l1, h1), od, 0, 0, 0);
    od = __builtin_amdgcn_mfma_f32_32x32x16_bf16(pa2, PKV(l2, h2), od, 0, 0, 0);
    od = __builtin_amdgcn_mfma_f32_32x32x16_bf16(pa3, PKV(l3, h3), od, 0, 0, 0);
#undef PKV
}
#define PV_RD(D0, L, H) do { L[0] = tr_read<(D0) * 512 + 0 * KS>(vb); H[0] = tr_read<(D0) * 512 + 0 * KS + HF>(vb); L[1] = tr_read<(D0) * 512 + 1 * KS>(vb); H[1] = tr_read<(D0) * 512 + 1 * KS + HF>(vb); \
    L[2] = tr_read<(D0) * 512 + 2 * KS>(vb); H[2] = tr_read<(D0) * 512 + 2 * KS + HF>(vb); L[3] = tr_read<(D0) * 512 + 3 * KS>(vb); H[3] = tr_read<(D0) * 512 + 3 * KS + HF>(vb); } while (0)
#define PV_MM(od, L, H) do { od = __builtin_amdgcn_mfma_f32_32x32x16_bf16(pa0, PKV(L[0], H[0]), od, 0, 0, 0); od = __builtin_amdgcn_mfma_f32_32x32x16_bf16(pa1, PKV(L[1], H[1]), od, 0, 0, 0); \
    od = __builtin_amdgcn_mfma_f32_32x32x16_bf16(pa2, PKV(L[2], H[2]), od, 0, 0, 0); od = __builtin_amdgcn_mfma_f32_32x32x16_bf16(pa3, PKV(L[3], H[3]), od, 0, 0, 0); } while (0)
#define PKV(L, H) (bf16x8){L[0], L[1], L[2], L[3], H[0], H[1], H[2], H[3]}
template <int DV> __device__ __forceinline__ void pv_all(f32x16* o, int vb, bf16x8 pa0, bf16x8 pa1, bf16x8 pa2, bf16x8 pa3) {
    constexpr int KS = (DV / 32) * 1024, HF = (DV / 32) * 512;
    s16x4 la[4], ha[4], lb[4], hb[4];
    PV_RD(0, la, ha);
    PV_RD(1, lb, hb); asm volatile("s_waitcnt lgkmcnt(8)" ::: "memory"); SBAR(); PV_MM(o[0], la, ha);
    if constexpr (DV == 128) {
        PV_RD(2, la, ha); asm volatile("s_waitcnt lgkmcnt(8)" ::: "memory"); SBAR(); PV_MM(o[1], lb, hb);
        PV_RD(3, lb, hb); asm volatile("s_waitcnt lgkmcnt(8)" ::: "memory"); SBAR(); PV_MM(o[2], la, ha);
        asm volatile("s_waitcnt lgkmcnt(0)" ::: "memory"); SBAR(); PV_MM(o[3], lb, hb);
    } else {
        asm volatile("s_waitcnt lgkmcnt(0)" ::: "memory"); SBAR(); PV_MM(o[1], lb, hb);
    }
}
#undef PV_RD
#undef PV_MM
#undef PKV
template <int KW> __device__ __forceinline__ void qkt64(f32x16& p0, f32x16& p1, const char* Ks, const bf16x8* qr, int kcb, int r32, int hi) {
    bf16x8 kb0[4], kb1[4];
#pragma unroll
    for (int d0 = 0; d0 < 4; ++d0) { const int cb = kcb + (d0 * 16 + hi * 8) * 2;
        kb0[d0] = *reinterpret_cast<const bf16x8*>(Ks + kswz<KW>(r32, cb));
        kb1[d0] = *reinterpret_cast<const bf16x8*>(Ks + kswz<KW>(32 + r32, cb)); }
    p0 = f32x16{}; p1 = f32x16{};
#pragma unroll
    for (int d0 = 0; d0 < 4; ++d0) {
        p0 = __builtin_amdgcn_mfma_f32_32x32x16_bf16(kb0[d0], qr[d0], p0, 0, 0, 0);
        p1 = __builtin_amdgcn_mfma_f32_32x32x16_bf16(kb1[d0], qr[d0], p1, 0, 0, 0); }
}
template <int KW> __device__ __forceinline__ void qkt64n(f32x16& p0, f32x16& p1, const char* Ks, const bf16x8* qr, int kcb, int r32, int hi, const f32x16& cinit) {
#pragma unroll
    for (int d0 = 0; d0 < 4; ++d0) { const int cb = kcb + (d0 * 16 + hi * 8) * 2;
        const bf16x8 b0 = *reinterpret_cast<const bf16x8*>(Ks + kswz<KW>(r32, cb));
        const bf16x8 b1 = *reinterpret_cast<const bf16x8*>(Ks + kswz<KW>(32 + r32, cb));
        if (d0 == 0) { p0 = __builtin_amdgcn_mfma_f32_32x32x16_bf16(b0, qr[0], cinit, 0, 0, 0); p1 = __builtin_amdgcn_mfma_f32_32x32x16_bf16(b1, qr[0], cinit, 0, 0, 0); }
        else { p0 = __builtin_amdgcn_mfma_f32_32x32x16_bf16(b0, qr[d0], p0, 0, 0, 0); p1 = __builtin_amdgcn_mfma_f32_32x32x16_bf16(b1, qr[d0], p1, 0, 0, 0); } }
}
template <int ND> __device__ __forceinline__ void softmax_step(f32x16& p0, f32x16& p1, float& m_reg, float& l_reg, f32x16* o, float* al_l, int r32, int hi,
                                                              bf16x8& pa0, bf16x8& pa1, bf16x8& pa2, bf16x8& pa3) {
    float pmax = p0[0];
#pragma unroll
    for (int r = 1; r < 16; ++r) pmax = fmaxf(pmax, p0[r]);
#pragma unroll
    for (int r = 0; r < 16; ++r) pmax = fmaxf(pmax, p1[r]);
    { auto rr = __builtin_amdgcn_permlane32_swap(__float_as_uint(pmax), __float_as_uint(pmax), false, false); pmax = fmaxf(__uint_as_float(rr[0]), __uint_as_float(rr[1])); }
    const float mn = fmaxf(m_reg, pmax);
    const float alpha = __builtin_amdgcn_exp2f((m_reg - mn) * QK_C); m_reg = mn;
    const float mnC = -mn * QK_C;
#pragma unroll
    for (int r = 0; r < 16; ++r) { p0[r] = __builtin_amdgcn_exp2f(fmaf(p0[r], QK_C, mnC)); p1[r] = __builtin_amdgcn_exp2f(fmaf(p1[r], QK_C, mnC)); }
    float ps = 0.f;
#pragma unroll
    for (int r = 0; r < 16; ++r) ps += p0[r] + p1[r];
    { auto rr = __builtin_amdgcn_permlane32_swap(__float_as_uint(ps), __float_as_uint(ps), false, false); ps = __uint_as_float(rr[0]) + __uint_as_float(rr[1]); }
    l_reg = l_reg * alpha + ps;
    if (__any(alpha < 1.f)) { if (hi == 0) al_l[r32] = alpha; LDS_WAIT();
#pragma unroll
        for (int d = 0; d < ND; ++d)
#pragma unroll
            for (int r = 0; r < 16; ++r) o[d][r] *= al_l[crow(r, hi)];
    }
#define PK4(P, BASE, OUT) do { unsigned a0 = cvtpk(P[BASE + 0], P[BASE + 1]), a1 = cvtpk(P[BASE + 2], P[BASE + 3]);   \
    unsigned b0 = cvtpk(P[BASE + 4], P[BASE + 5]), b1 = cvtpk(P[BASE + 6], P[BASE + 7]);                              \
    auto r0 = __builtin_amdgcn_permlane32_swap(a0, b0, false, false); auto r1 = __builtin_amdgcn_permlane32_swap(a1, b1, false, false); \
    u32x4 w = {r0[0], r1[0], r0[1], r1[1]}; OUT = *reinterpret_cast<bf16x8*>(&w); } while (0)
    PK4(p0, 0, pa0); PK4(p0, 8, pa1); PK4(p1, 0, pa2); PK4(p1, 8, pa3);
#undef PK4
}

constexpr int AT_K = 0, AT_V = 16384, AT_WS = 32768, AT_XCH = 36864;

__device__ __forceinline__ void win_attn_unit(char* lds, const bf16_t* Z, bf16_t* Y, const float* sink, int b, int kvh, int qc, bool ctxq) {
    const int tid = opaque(threadIdx.x), wid = __builtin_amdgcn_readfirstlane(tid >> 6), lane = tid & 63, r32 = lane & 31, hi = lane >> 5;
    const int head = kvh * 4 + (wid >> 1), qsub = wid & 1;
    const int q0 = qc * 64;
    const size_t qrow0 = (ctxq ? (size_t)RL + b * CTX : (size_t)b * SEQ) + q0 + qsub * 32;
    float* wsf = (float*)(lds + AT_WS) + wid * 128; float* al_l = wsf; float* li_l = wsf + 32;
    bf16x8 qr[4];
    { const bf16_t* qp = Z + (qrow0 + r32) * MIXIN + 512 + head * 64 + hi * 8;
#pragma unroll
      for (int d0 = 0; d0 < 4; ++d0) qr[d0] = *reinterpret_cast<const bf16x8*>(qp + d0 * 16); }
    float m_reg = -1e30f, l_reg = 0.f; f32x16 o[2] = {};
    const int srow = tid >> 3, scol = (tid & 7) * 8;
    const int vb = (int)(uintptr_t)(lds + AT_V) + v_rd_base(lane);
    const int qrel = qsub * 32 + r32;
    const int NT = ctxq ? 4 : 9;
    for (int t = 0; t < NT; ++t) {
        size_t krow; int mode = 0;
        if (t < 4) krow = (size_t)RL + b * CTX + t * 64;
        else { const int p0 = q0 - 128 + (t - 4) * 64; if (p0 < 0 || p0 >= SEQ) continue; krow = (size_t)b * SEQ + p0; mode = (t == 4) ? 1 : (t == 8) ? 2 : 0; }
        __syncthreads();
        { const bf16_t* kp = Z + (krow + srow) * MIXIN + 1024 + kvh * 64 + scol;
          const bf16x8 kv = *reinterpret_cast<const bf16x8*>(kp), vv = *reinterpret_cast<const bf16x8*>(kp + 128);
          *reinterpret_cast<bf16x8*>(lds + AT_K + kswz<64>(srow, scol * 2)) = kv;
          *reinterpret_cast<bf16x8*>(lds + AT_V + v_st<64>(srow, scol)) = vv; }
        __syncthreads();
        f32x16 p0, p1; qkt64<64>(p0, p1, lds + AT_K, qr, 0, r32, hi);
        if (mode == 1) {
#pragma unroll
            for (int r = 0; r < 16; ++r) { const int kk = crow(r, hi); if (kk < qrel) p0[r] = -1e30f; if (kk + 32 < qrel) p1[r] = -1e30f; } }
        else if (mode == 2) {
#pragma unroll
            for (int r = 0; r < 16; ++r) { const int kk = crow(r, hi); if (kk > qrel) p0[r] = -1e30f; if (kk + 32 > qrel) p1[r] = -1e30f; } }
        bf16x8 pa0, pa1, pa2, pa3;
        softmax_step<2>(p0, p1, m_reg, l_reg, o, al_l, r32, hi, pa0, pa1, pa2, pa3);
        pv_one<64, 0>(o[0], vb, pa0, pa1, pa2, pa3); pv_one<64, 1>(o[1], vb, pa0, pa1, pa2, pa3);
    }
    l_reg += __builtin_amdgcn_exp2f(sink[head] * LOG2E - m_reg * QK_C);
    if (hi == 0) li_l[r32] = l_reg; LDS_WAIT();
    bf16_t* yp = Y + qrow0 * DM + 512 + head * 64;
#pragma unroll
    for (int r = 0; r < 16; ++r) { const int orow = crow(r, hi); const float rl = __builtin_amdgcn_rcpf(li_l[orow]);
#pragma unroll
        for (int d0 = 0; d0 < 2; ++d0) { const unsigned w = cvtpk(o[d0][r] * rl, 0.f); yp[(size_t)orow * DM + d0 * 32 + r32] = (bf16_t)(w & 0xffffu); } }
}

constexpr float DA_THR = 8.f;
constexpr float DA_THRL = DA_THR * LOG2E;
template <bool FIRST> __device__ __forceinline__ void da_partialSM(f32x16& p0, f32x16& p1, float& mhat, f32x16& negm, float& alpha) {
    float pmax = fmaxf(p0[0], p0[1]), pmb = fmaxf(p1[0], p1[1]);
#pragma unroll
    for (int r = 2; r < 16; r += 2) { pmax = fmaxf(fmaxf(pmax, p0[r]), p0[r + 1]); pmb = fmaxf(fmaxf(pmb, p1[r]), p1[r + 1]); }
    pmax = fmaxf(pmax, pmb);
    { auto rr = __builtin_amdgcn_permlane32_swap(__float_as_uint(pmax), __float_as_uint(pmax), false, false); pmax = fmaxf(__uint_as_float(rr[0]), __uint_as_float(rr[1])); }
    alpha = 1.f;
    if (FIRST || !__builtin_expect(__all(pmax <= DA_THRL), 1)) {
        const float dl = FIRST ? pmax : fmaxf(pmax, 0.f);
        mhat += dl; alpha = __builtin_amdgcn_exp2f(-dl);
#pragma unroll
        for (int r = 0; r < 16; ++r) { p0[r] -= dl; p1[r] -= dl; negm[r] = -mhat; }
    }
#pragma unroll
    for (int r = 0; r < 16; ++r) p0[r] = __builtin_amdgcn_exp2f(p0[r]);
}
__device__ __forceinline__ void da_finishSM(f32x16& p0, f32x16& p1, float alpha, float& l_reg, bf16x8& pa0, bf16x8& pa1, bf16x8& pa2, bf16x8& pa3) {
#pragma unroll
    for (int r = 0; r < 16; ++r) p1[r] = __builtin_amdgcn_exp2f(p1[r]);
    float s0 = p0[0], s1 = p0[1], s2 = p0[2], s3 = p0[3];
#pragma unroll
    for (int r = 4; r < 16; r += 4) { s0 += p0[r]; s1 += p0[r + 1]; s2 += p0[r + 2]; s3 += p0[r + 3]; }
#pragma unroll
    for (int r = 0; r < 16; r += 4) { s0 += p1[r]; s1 += p1[r + 1]; s2 += p1[r + 2]; s3 += p1[r + 3]; }
    float ps = (s0 + s1) + (s2 + s3);
    { auto rr = __builtin_amdgcn_permlane32_swap(__float_as_uint(ps), __float_as_uint(ps), false, false); ps = __uint_as_float(rr[0]) + __uint_as_float(rr[1]); }
    l_reg = l_reg * alpha + ps;
#define PK4(P, BASE, OUT) do { unsigned a0 = cvtpk(P[BASE + 0], P[BASE + 1]), a1 = cvtpk(P[BASE + 2], P[BASE + 3]);   \
    unsigned b0 = cvtpk(P[BASE + 4], P[BASE + 5]), b1 = cvtpk(P[BASE + 6], P[BASE + 7]);                              \
    auto r0 = __builtin_amdgcn_permlane32_swap(a0, b0, false, false); auto r1 = __builtin_amdgcn_permlane32_swap(a1, b1, false, false); \
    u32x4 w = {r0[0], r1[0], r0[1], r1[1]}; OUT = *reinterpret_cast<bf16x8*>(&w); } while (0)
    PK4(p0, 0, pa0); PK4(p0, 8, pa1); PK4(p1, 0, pa2); PK4(p1, 8, pa3);
#undef PK4
}
__device__ __forceinline__ void da_pv(f32x16* o, int vb, bf16x8 pa0, bf16x8 pa1, bf16x8 pa2, bf16x8 pa3) {
    pv_all<128>(o, vb, pa0, pa1, pa2, pa3);
}
constexpr int DA_V = 0, DA_K = 49152, DA_WS = 81920, DA_XCH = 0;
__device__ __forceinline__ void diff_attn_unit(char* lds, const bf16_t* QKV, bf16_t* O, const float* subg, float lam, float oscale, int b, int h, int qb, bool ctxq) {
    const int tid = opaque(threadIdx.x), wid = __builtin_amdgcn_readfirstlane(tid >> 6), lane = tid & 63, r32 = lane & 31, hi = lane >> 5;
    const int comp = wid >> 2, qsub = wid & 3;
    const size_t qrow0 = (ctxq ? (size_t)RL + b * CTX : (size_t)b * SEQ) + qb * 128 + qsub * 32;
    char* V_lds = lds + DA_V; char* K_lds = lds + DA_K;
    float* wsf = (float*)(lds + DA_WS) + wid * 128; float* al_l = wsf; float* li_l = wsf + 32;
    __syncthreads();
    bf16x8 qr[4];
    { const bf16_t* qp = QKV + (qrow0 + r32) * 3072 + (2 * h + comp) * 64 + hi * 8;
#pragma unroll
      for (int d0 = 0; d0 < 4; ++d0) qr[d0] = *reinterpret_cast<const bf16x8*>(qp + d0 * 16); }
    float m_reg = 0.f, l_reg = 0.f; f32x16 o[4] = {}; f32x16 negm = {};
    const int sr = tid >> 4, sc = (tid & 15) * 8, vst0 = v_st<128>(sr, sc), vst1 = v_st<128>(32 + sr, sc);
    const int vb0 = (int)(uintptr_t)V_lds + v_rd_base(lane);
    const int kcb = comp * 128;
    const bf16_t* kvp = QKV + (size_t)sr * 3072 + 1024 + h * 128 + sc;
    const size_t rowc = (size_t)RL + b * CTX, rowl = (size_t)b * SEQ;
    const int NT = ctxq ? 4 : 68;
    bf16x8 ks0, ks1, vs0, vs1;
#define KROW(t) ((t) < 4 ? rowc + (size_t)(t) * 64 : rowl + (size_t)((t) - 4) * 64)
#define LOADK(t) do { const bf16_t* p_ = kvp + KROW(t) * 3072; ks0 = *reinterpret_cast<const bf16x8*>(p_); ks1 = *reinterpret_cast<const bf16x8*>(p_ + 32 * 3072); } while (0)
#define LOADV(t) do { const bf16_t* p_ = kvp + KROW(t) * 3072 + 1024; vs0 = *reinterpret_cast<const bf16x8*>(p_); vs1 = *reinterpret_cast<const bf16x8*>(p_ + 32 * 3072); } while (0)
#define WRITEK(bf) do { *reinterpret_cast<bf16x8*>(K_lds + (bf) * 16384 + kswz<128>(sr, sc * 2)) = ks0; *reinterpret_cast<bf16x8*>(K_lds + (bf) * 16384 + kswz<128>(32 + sr, sc * 2)) = ks1; } while (0)
#define WRITEV(bf) do { *reinterpret_cast<bf16x8*>(V_lds + (bf) * 16384 + vst0) = vs0; *reinterpret_cast<bf16x8*>(V_lds + (bf) * 16384 + vst1) = vs1; } while (0)
#define RESC(a) do { if (__any((a) < 1.f)) { if (hi == 0) al_l[r32] = (a); LDS_WAIT(); \
    _Pragma("unroll") for (int d = 0; d < 4; ++d) _Pragma("unroll") for (int r = 0; r < 16; ++r) o[d][r] *= al_l[crow(r, hi)]; } } while (0)
#define QKT(P0, P1, kb) do { SBAR(); qkt64n<128>(P0, P1, K_lds + (kb) * 16384, qr, kcb, r32, hi, negm); } while (0)
#define FIN(P0, P1, al) do { da_finishSM(P0, P1, al, l_reg, pa0, pa1, pa2, pa3); SBAR(); } while (0)
#define PVT(vi) da_pv(o, vb0 + (vi) * 16384, pa0, pa1, pa2, pa3)
    f32x16 pA0, pA1, pB0, pB1; float alA = 1.f, alB = 1.f; bf16x8 pa0, pa1, pa2, pa3;
    int vm2 = 1, vm1 = 2, vc = 0;
#define VROT() do { const int t_ = vm2; vm2 = vm1; vm1 = vc; vc = t_; } while (0)
    const bool grpB = comp != 0;
    LOADK(0); VM_WAIT(); WRITEK(0); LOADK(1); LOADV(0); __syncthreads();
    QKT(pA0, pA1, 0);
    if (!grpB) da_partialSM<true>(pA0, pA1, m_reg, negm, alA);
    VM_WAIT(); WRITEK(1); WRITEV(vc); LOADK(2); LOADV(1); VROT();
    __syncthreads();
    if (grpB) da_partialSM<true>(pA0, pA1, m_reg, negm, alA);
    QKT(pB0, pB1, 1); FIN(pA0, pA1, alA);
    if (!grpB) { PVT(vm1); da_partialSM<false>(pB0, pB1, m_reg, negm, alB); RESC(alB); }
    VM_WAIT(); WRITEK(0); WRITEV(vc); LOADK(3); LOADV(2); VROT();
    __syncthreads();
    for (int j = 2; j + 1 < NT; j += 2) {
        if (grpB) { PVT(vm2); da_partialSM<false>(pB0, pB1, m_reg, negm, alB); RESC(alB); }
        QKT(pA0, pA1, 0); FIN(pB0, pB1, alB);
        if (!grpB) { PVT(vm1); da_partialSM<false>(pA0, pA1, m_reg, negm, alA); RESC(alA); }
        VM_WAIT(); WRITEK(1); WRITEV(vc); if (j + 2 < NT) LOADK(j + 2); LOADV(j + 1); VROT();
        __syncthreads();
        if (grpB) { PVT(vm2); da_partialSM<false>(pA0, pA1, m_reg, negm, alA); RESC(alA); }
        QKT(pB0, pB1, 1); FIN(pA0, pA1, alA);
        if (!grpB) { PVT(vm1); da_partialSM<false>(pB0, pB1, m_reg, negm, alB); RESC(alB); }
        VM_WAIT(); if (j + 2 < NT) { WRITEK(0); } WRITEV(vc); if (j + 3 < NT) LOADK(j + 3); if (j + 2 < NT) LOADV(j + 2); VROT();
        __syncthreads();
    }
    if (grpB) { PVT(vm2); da_partialSM<false>(pB0, pB1, m_reg, negm, alB); RESC(alB); }
    FIN(pB0, pB1, alB); PVT(vm1);
#undef LOADK
#undef LOADV
#undef WRITEK
#undef WRITEV
#undef QKT
#undef FIN
#undef PVT
#undef VROT
#define SLOAD(a, b)
#define SWRITE(a, b)
#define SWAIT()
#undef KROW
#undef SLOAD
#undef SWRITE
#undef SWAIT
#undef RESC
    if (hi == 0) li_l[r32] = l_reg; LDS_WAIT();
    float rl[16];
#pragma unroll
    for (int r = 0; r < 16; ++r) rl[r] = __builtin_amdgcn_rcpf(li_l[crow(r, hi)]);
    __syncthreads();
    float* xch = (float*)(lds + DA_XCH) + qsub * (32 * 132);
    if (comp == 1) {
#pragma unroll
        for (int d0 = 0; d0 < 4; ++d0)
#pragma unroll
            for (int r = 0; r < 16; ++r) xch[crow(r, hi) * 132 + d0 * 32 + r32] = o[d0][r] * rl[r];
    }
    __syncthreads();
    if (comp == 0) {
#pragma unroll
        for (int d0 = 0; d0 < 4; ++d0)
#pragma unroll
            for (int r = 0; r < 16; ++r) { const int idx = crow(r, hi) * 132 + d0 * 32 + r32; const float v = o[d0][r] * rl[r] - lam * xch[idx]; xch[idx] = v; }
        LDS_WAIT();
        const int row = lane >> 1, hf = lane & 1; const float* rp = xch + row * 132 + hf * 64;
        f32x4 v[16]; float ss = 0.f;
#pragma unroll
        for (int j = 0; j < 16; ++j) { v[j] = *reinterpret_cast<const f32x4*>(rp + 4 * j); ss += v[j][0] * v[j][0] + v[j][1] * v[j][1] + v[j][2] * v[j][2] + v[j][3] * v[j][3]; }
        ss += __int_as_float(__builtin_amdgcn_ds_bpermute((lane ^ 1) << 2, __float_as_int(ss)));
        const float rs = __builtin_amdgcn_rsqf(ss * (1.f / 128.f) + EPS) * oscale;
        bf16_t* op = O + (qrow0 + row) * DM + h * 128 + hf * 64;
#pragma unroll
        for (int j = 0; j < 16; j += 2) { const f32x4 g0 = *reinterpret_cast<const f32x4*>(subg + hf * 64 + 4 * j), g1 = *reinterpret_cast<const f32x4*>(subg + hf * 64 + 4 * j + 4);
            const f32x4 a = v[j] * g0 * rs, c = v[j + 1] * g1 * rs;
            u32x4 w; w.x = cvtpk(a[0], a[1]); w.y = cvtpk(a[2], a[3]); w.z = cvtpk(c[0], c[1]); w.w = cvtpk(c[2], c[3]);
            *reinterpret_cast<u32x4*>(op + 4 * j) = w; }
    }
}

constexpr int WA_V = 0, WA_K = 16384, WA_WS = 32768, WA_ST = 36864;
__device__ __forceinline__ void wa_mask(f32x16& p0, f32x16& p1, int mode, int qrel, int hi) {
    if (mode == 1) {
#pragma unroll
        for (int r = 0; r < 16; ++r) { const int kk = crow(r, hi); if (kk < qrel) p0[r] = -1e30f; if (kk + 32 < qrel) p1[r] = -1e30f; } }
    else if (mode == 2) {
#pragma unroll
        for (int r = 0; r < 16; ++r) { const int kk = crow(r, hi); if (kk > qrel) p0[r] = -1e30f; if (kk + 32 > qrel) p1[r] = -1e30f; } }
    else if (mode == 3) {
#pragma unroll
        for (int r = 0; r < 16; ++r) { p0[r] = -1e30f; p1[r] = -1e30f; } }
}
__device__ __forceinline__ void win_attn_unit2(char* lds, const bf16_t* Z, bf16_t* Y, const float* sink, int b, int kvh, int qc, bool ctxq) {
    const int tid = opaque(threadIdx.x), wid = __builtin_amdgcn_readfirstlane(tid >> 6), lane = tid & 63, r32 = lane & 31, hi = lane >> 5;
    const int head = kvh * 4 + (wid >> 1), qsub = wid & 1, q0 = qc * 64;
    const size_t rowc = (size_t)RL + b * CTX, rowl = (size_t)b * SEQ;
    const size_t qrow0 = (ctxq ? rowc : rowl) + q0 + qsub * 32;
    char* V_lds = lds + WA_V; char* K_lds = lds + WA_K;
    float* wsf = (float*)(lds + WA_WS) + wid * 128; float* al_l = wsf; float* li_l = wsf + 32;
    __syncthreads();
    bf16x8 qr[4];
    { const bf16_t* qp = Z + (qrow0 + r32) * MIXIN + 512 + head * 64 + hi * 8;
#pragma unroll
      for (int d0 = 0; d0 < 4; ++d0) qr[d0] = *reinterpret_cast<const bf16x8*>(qp + d0 * 16); }
    float m_reg = 0.f, l_reg = 0.f; f32x16 o[2] = {}; f32x16 negm = {};
    const int srow = tid >> 3, scol = (tid & 7) * 8, vst = v_st<64>(srow, scol), kst = kswz<64>(srow, scol * 2);
    const int vb0 = (int)(uintptr_t)V_lds + v_rd_base(lane);
    const bf16_t* kvp = Z + (size_t)srow * MIXIN + 1024 + kvh * 64 + scol;
    const int skip_lo = ctxq ? 0 : (q0 == 0 ? 2 : q0 == 64 ? 1 : 0);
    const int nloc = ctxq ? 0 : 5 - skip_lo - (q0 == SEQ - 64 ? 2 : q0 == SEQ - 128 ? 1 : 0);
    const int NTr = 4 + nloc, NT = (NTr + 1) & ~1;
    const int qrel = qsub * 32 + r32;
    struct { bf16x8 vs, ks; } sr_;
#define KROW(t) ((t) < 4 ? rowc + (size_t)(t) * 64 : (t) < NTr ? rowl + (size_t)(q0 - 128 + ((t) - 4 + skip_lo) * 64) : rowc)
#define TMODE(t) ((t) < 4 ? 0 : (t) >= NTr ? 3 : ((t) - 4 + skip_lo) == 0 ? 1 : ((t) - 4 + skip_lo) == 4 ? 2 : 0)
#define SLOAD(t) do { const bf16_t* p_ = kvp + KROW(t) * MIXIN; sr_.ks = *reinterpret_cast<const bf16x8*>(p_); sr_.vs = *reinterpret_cast<const bf16x8*>(p_ + 128); } while (0)
#define SWRITE(bf) do { *reinterpret_cast<bf16x8*>(V_lds + (bf) * 8192 + vst) = sr_.vs; *reinterpret_cast<bf16x8*>(K_lds + (bf) * 8192 + kst) = sr_.ks; } while (0)
#define SWAIT() asm volatile("s_waitcnt vmcnt(0)" ::: "memory")
#define RESC(a) do { if (__any((a) < 1.f)) { if (hi == 0) al_l[r32] = (a); LDS_WAIT(); \
    _Pragma("unroll") for (int d = 0; d < 2; ++d) _Pragma("unroll") for (int r = 0; r < 16; ++r) o[d][r] *= al_l[crow(r, hi)]; } } while (0)
#define WPV(vb) pv_all<64>(o, (vb), pa0, pa1, pa2, pa3)
    f32x16 pA0, pA1, pB0, pB1; float alA, alB; bf16x8 pa0, pa1, pa2, pa3;
    SLOAD(0); VM_WAIT(); SWRITE(0); __syncthreads();
    qkt64n<64>(pA0, pA1, K_lds, qr, 0, r32, hi, negm); da_partialSM<true>(pA0, pA1, m_reg, negm, alA);
    SLOAD(1);
    SWAIT(); SWRITE(1); __syncthreads();
    for (int j = 1; j + 1 < NT; j += 2) {
        SBAR(); qkt64n<64>(pB0, pB1, K_lds + 8192, qr, 0, r32, hi, negm);
        da_finishSM(pA0, pA1, alA, l_reg, pa0, pa1, pa2, pa3); SBAR();
        SLOAD(j + 1); SBAR();
        WPV(vb0); wa_mask(pB0, pB1, TMODE(j), qrel, hi); da_partialSM<false>(pB0, pB1, m_reg, negm, alB);
        __syncthreads(); SWAIT(); SWRITE(0);
        RESC(alB); __syncthreads();
        SBAR(); qkt64n<64>(pA0, pA1, K_lds, qr, 0, r32, hi, negm);
        da_finishSM(pB0, pB1, alB, l_reg, pa0, pa1, pa2, pa3); SBAR();
        SLOAD(j + 2); SBAR();
        WPV(vb0 + 8192); wa_mask(pA0, pA1, TMODE(j + 1), qrel, hi); da_partialSM<false>(pA0, pA1, m_reg, negm, alA);
        __syncthreads(); SWAIT(); SWRITE(1);
        RESC(alA); __syncthreads();
    }
    SBAR(); qkt64n<64>(pB0, pB1, K_lds + 8192, qr, 0, r32, hi, negm);
    da_finishSM(pA0, pA1, alA, l_reg, pa0, pa1, pa2, pa3); SBAR();
    WPV(vb0); wa_mask(pB0, pB1, TMODE(NT - 1), qrel, hi); da_partialSM<false>(pB0, pB1, m_reg, negm, alB);
    __syncthreads(); RESC(alB);
    da_finishSM(pB0, pB1, alB, l_reg, pa0, pa1, pa2, pa3); SBAR();
    WPV(vb0 + 8192);
#undef KROW
#undef TMODE
#undef SLOAD
#undef SWRITE
#undef SWAIT
#undef RESC
#undef WPV
    l_reg += __builtin_amdgcn_exp2f(sink[head] * LOG2E - m_reg);
    if (hi == 0) li_l[r32] = l_reg; LDS_WAIT();
    bf16_t* stg = (bf16_t*)(lds + WA_ST) + wid * 2048;
#pragma unroll
    for (int r = 0; r < 16; ++r) { const int orow = crow(r, hi); const float rl = __builtin_amdgcn_rcpf(li_l[orow]);
#pragma unroll
        for (int d0 = 0; d0 < 2; ++d0) stg[orow * 64 + d0 * 32 + r32] = (bf16_t)(cvtpk(o[d0][r] * rl, 0.f) & 0xffffu); }
    LDS_WAIT();
    bf16_t* yp = Y + qrow0 * DM + 512 + head * 64;
#pragma unroll
    for (int i = 0; i < 4; ++i) { const int row = i * 8 + (lane >> 3), ch = lane & 7; const u32x4 v = *reinterpret_cast<const u32x4*>(stg + row * 64 + ch * 8); *reinterpret_cast<u32x4*>(yp + (size_t)row * DM + ch * 8) = v; }
}

struct Args {
    const float *x, *c, *ctx, *c_ctx, *ada_w, *ada_b, *norm_g, *mix_in_w, *mix_out_w, *win_sink, *diff_qkv_w, *diff_out_w, *diff_lambda, *diff_subln_g,
                *ffn_in_w, *ffn_out_w, *router_w, *expert_in_w, *expert_out_w;
    float* out; unsigned char* ws; int ph_lo, ph_hi;
};
struct Frame {
    LAS unsigned char* lds; unsigned char* ldsg; volatile LAS unsigned* MISC; unsigned* ctl;
    int tid, lane, wave, vcu, G;
};

__device__ __forceinline__ unsigned f2bf(float f) { unsigned u = __builtin_bit_cast(unsigned, f); return (u + 0x7fffu + ((u >> 16) & 1u)) >> 16; }
__device__ __forceinline__ unsigned pk2(float lo, float hi) { return f2bf(lo) | (f2bf(hi) << 16); }
__device__ __forceinline__ void transpose_item(const float* W, int K, int N, bf16_t* WT, int n0, int c0, int k0, LAS float* scr, int lane) {
#pragma unroll 8
    for (int i = 0; i < 32; ++i) { const int kk = 2 * i + (lane >> 5); scr[kk * 33 + (lane & 31)] = W[(size_t)(k0 + kk) * N + c0 + (lane & 31)]; }
    LDS_WAIT(); asm volatile("" ::: "memory");
    const int c = lane & 7;
#pragma unroll
    for (int j = 0; j < 4; ++j) { const int n = (lane >> 3) + 8 * j; const LAS float* s = scr + (8 * c) * 33 + n;
        u32x4 o; o.x = pk2(s[0 * 33], s[1 * 33]); o.y = pk2(s[2 * 33], s[3 * 33]); o.z = pk2(s[4 * 33], s[5 * 33]); o.w = pk2(s[6 * 33], s[7 * 33]);
        *(u32x4*)(WT + (size_t)(n0 + n) * K + k0 + 8 * c) = o; }
    LDS_WAIT(); asm volatile("" ::: "memory");
}
__device__ __forceinline__ void transpose_item_f8(const float* W, int K, int N, unsigned char* WT, int n0, int c0, int k0, LAS float* scr, int lane) {
#pragma unroll 8
    for (int i = 0; i < 32; ++i) { const int kk = 2 * i + (lane >> 5); scr[kk * 33 + (lane & 31)] = W[(size_t)(k0 + kk) * N + c0 + (lane & 31)] * F8_SW; }
    LDS_WAIT(); asm volatile("" ::: "memory");
    const int c = lane & 7;
#pragma unroll
    for (int j = 0; j < 4; ++j) { const int n = (lane >> 3) + 8 * j; const LAS float* s = scr + (8 * c) * 33 + n;
        u32x2 o; o.x = pk4_fp8(s[0 * 33], s[1 * 33], s[2 * 33], s[3 * 33]); o.y = pk4_fp8(s[4 * 33], s[5 * 33], s[6 * 33], s[7 * 33]);
        *(u32x2*)(WT + (size_t)(n0 + n) * K + k0 + 8 * c) = o; }
    LDS_WAIT(); asm volatile("" ::: "memory");
}
__device__ __forceinline__ bool transpose_job(int& r, const float* W, int nb, int K, int N, void* WT, bool glu, bool f8, LAS float* scr, int lane) {
    const int nblk = N / 32, per = (K / 64) * nblk, tot = nb * per;
    if (r >= tot) { r -= tot; return false; }
    const int mtx = r / per, it = r % per, kb = it / nblk, nbk = it % nblk, n0 = 32 * nbk;
    int c0 = n0;
    if (glu) { const int tile = n0 >> 8, w = n0 & 255; c0 = (w < 128) ? tile * 128 + w : (N >> 1) + tile * 128 + (w - 128); }
    if (f8) transpose_item_f8(W + (size_t)mtx * K * N, K, N, (unsigned char*)WT + (size_t)mtx * K * N, n0, c0, 64 * kb, scr, lane);
    else transpose_item(W + (size_t)mtx * K * N, K, N, (bf16_t*)WT + (size_t)mtx * K * N, n0, c0, 64 * kb, scr, lane);
    return true;
}

struct ThinP {
    int nrows;
    const float* xin_lat; const float* xin_ctx;
    float* xout_lat; float* xout_ctx;
    int ymode;
    const bf16_t* Ysrc; const float* gate; const float* ga;
    bool h8;
    bf16_t* H; const float* gb; const float* shsc;
    const float* router; int* route; unsigned* cnt;
    unsigned char* HSv;
};
#define TH_DECL(PFX) f32x4 PFX##x0 = {}, PFX##x1 = {}, PFX##x2 = {}, PFX##x3 = {}; u32x2 PFX##ya0 = {}, PFX##ya1 = {}, PFX##ya2 = {}, PFX##ya3 = {}, PFX##yb0 = {}, PFX##yb1 = {}, PFX##yb2 = {}, PFX##yb3 = {}; float PFX##w0 = 0.f, PFX##w1 = 0.f
#define TH_LOAD(PFX, r_, it_) do { const int rr_ = (r_); \
    const float* xr_ = (rr_ < RL ? P.xin_lat + (size_t)rr_ * DM : P.xin_ctx + (size_t)(rr_ - RL) * DM) + 4 * lane; \
    PFX##x0 = __builtin_nontemporal_load(reinterpret_cast<const f32x4*>(xr_)); PFX##x1 = __builtin_nontemporal_load(reinterpret_cast<const f32x4*>(xr_ + 256)); PFX##x2 = __builtin_nontemporal_load(reinterpret_cast<const f32x4*>(xr_ + 512)); PFX##x3 = __builtin_nontemporal_load(reinterpret_cast<const f32x4*>(xr_ + 768)); \
    const bf16_t* ya_ = P.Ysrc; const bf16_t* yb_ = P.Ysrc; \
    if (P.ymode == 1) ya_ = P.Ysrc + (size_t)rr_ * DM; \
    else if (P.ymode == 2) { const LAS int* rt_ = rtl + (it_) * 6; \
        const int e0_ = rt_[0], p0_ = rt_[1], e1_ = rt_[2], p1_ = rt_[3]; PFX##w0 = __int_as_float(rt_[4]); PFX##w1 = __int_as_float(rt_[5]); \
        const unsigned b0_ = e0_ == 0 ? 0u : e0_ == 1 ? cb1 : e0_ == 2 ? cb2 : e0_ == 3 ? cb3 : e0_ == 4 ? cb4 : e0_ == 5 ? cb5 : e0_ == 6 ? cb6 : cb7; \
        const unsigned b1_ = e1_ == 0 ? 0u : e1_ == 1 ? cb1 : e1_ == 2 ? cb2 : e1_ == 3 ? cb3 : e1_ == 4 ? cb4 : e1_ == 5 ? cb5 : e1_ == 6 ? cb6 : cb7; \
        ya_ = P.Ysrc + (size_t)(b0_ + p0_) * DM; yb_ = P.Ysrc + (size_t)(b1_ + p1_) * DM; } \
    if (P.ymode) { ya_ += 4 * lane; PFX##ya0 = __builtin_nontemporal_load(reinterpret_cast<const u32x2*>(ya_)); PFX##ya1 = __builtin_nontemporal_load(reinterpret_cast<const u32x2*>(ya_ + 256)); PFX##ya2 = __builtin_nontemporal_load(reinterpret_cast<const u32x2*>(ya_ + 512)); PFX##ya3 = __builtin_nontemporal_load(reinterpret_cast<const u32x2*>(ya_ + 768)); } \
    if (P.ymode == 2) { yb_ += 4 * lane; PFX##yb0 = __builtin_nontemporal_load(reinterpret_cast<const u32x2*>(yb_)); PFX##yb1 = __builtin_nontemporal_load(reinterpret_cast<const u32x2*>(yb_ + 256)); PFX##yb2 = __builtin_nontemporal_load(reinterpret_cast<const u32x2*>(yb_ + 512)); PFX##yb3 = __builtin_nontemporal_load(reinterpret_cast<const u32x2*>(yb_ + 768)); } \
    } while (0)
#define TH_ARGS(PFX) PFX##x0, PFX##x1, PFX##x2, PFX##x3, PFX##ya0, PFX##ya1, PFX##ya2, PFX##ya3, PFX##yb0, PFX##yb1, PFX##yb2, PFX##yb3, PFX##w0, PFX##w1
__device__ __forceinline__ void thin_proc(const ThinP& P, f32x4 x0, f32x4 x1, f32x4 x2, f32x4 x3, u32x2 ya0, u32x2 ya1, u32x2 ya2, u32x2 ya3, u32x2 yb0, u32x2 yb1, u32x2 yb2, u32x2 yb3, float yw0, float yw1,
                                          f32x4 GA0, f32x4 GA1, f32x4 GA2, f32x4 GA3, f32x4 GB0, f32x4 GB1, f32x4 GB2, f32x4 GB3, f32x4 SH0, f32x4 SH1, f32x4 SH2, f32x4 SH3,
                                          int r, int li, int lane, LAS float* rwT, LAS int* rec, LAS unsigned* lcnt) {
    const int idx = r < RL ? (r >> 12) : 8;
    f32x4 xv[4] = {x0, x1, x2, x3};
    if (P.ymode) {
        f32x4 yv[4];
#define BF4(w) ((f32x4){bf_lo((w).x), bf_hi((w).x), bf_lo((w).y), bf_hi((w).y)})
        if (P.ymode == 1) { yv[0] = BF4(ya0); yv[1] = BF4(ya1); yv[2] = BF4(ya2); yv[3] = BF4(ya3); }
        else { yv[0] = BF4(ya0) * yw0 + BF4(yb0) * yw1; yv[1] = BF4(ya1) * yw0 + BF4(yb1) * yw1; yv[2] = BF4(ya2) * yw0 + BF4(yb2) * yw1; yv[3] = BF4(ya3) * yw0 + BF4(yb3) * yw1; }
#undef BF4
        float ss = 0.f;
#pragma unroll
        for (int j = 0; j < 4; ++j) ss += yv[j][0] * yv[j][0] + yv[j][1] * yv[j][1] + yv[j][2] * yv[j][2] + yv[j][3] * yv[j][3];
        const float rs = __builtin_amdgcn_rsqf(wave_sum(ss, lane) * (1.f / DM) + EPS);
        xv[0] = xv[0] + GA0 * (yv[0] * rs); xv[1] = xv[1] + GA1 * (yv[1] * rs); xv[2] = xv[2] + GA2 * (yv[2] * rs); xv[3] = xv[3] + GA3 * (yv[3] * rs);
    }
    if (P.xout_lat) { float* xo = r < RL ? P.xout_lat + (size_t)r * DM : P.xout_ctx + (size_t)(r - RL) * DM;
#pragma unroll
        for (int j = 0; j < 4; ++j) __builtin_nontemporal_store(xv[j], reinterpret_cast<f32x4*>(xo + 4 * lane + 256 * j)); }
    if (P.H) {
        float ss = 0.f;
#pragma unroll
        for (int j = 0; j < 4; ++j) ss += xv[j][0] * xv[j][0] + xv[j][1] * xv[j][1] + xv[j][2] * xv[j][2] + xv[j][3] * xv[j][3];
        const float rs = __builtin_amdgcn_rsqf(wave_sum(ss, lane) * (1.f / DM) + EPS);
        bf16_t* hr = P.H + (size_t)r * DM;
        f32x4 hv[4] = {xv[0] * rs * GB0 + SH0, xv[1] * rs * GB1 + SH1, xv[2] * rs * GB2 + SH2, xv[3] * rs * GB3 + SH3};
#pragma unroll
        for (int j = 0; j < 4; ++j) {
            if (P.h8) { *reinterpret_cast<unsigned*>((unsigned char*)P.H + (size_t)r * DM + 4 * lane + 256 * j) = pk4_fp8(hv[j][0] * F8_SH, hv[j][1] * F8_SH, hv[j][2] * F8_SH, hv[j][3] * F8_SH); }
            else { u32x2 w; w.x = cvtpk(hv[j][0], hv[j][1]); w.y = cvtpk(hv[j][2], hv[j][3]); *reinterpret_cast<u32x2*>(hr + 4 * lane + 256 * j) = w; } }
        if (P.router) {
            float lg[8];
#pragma unroll
            for (int e = 0; e < 8; ++e) { float a = 0.f;
#pragma unroll
                for (int j = 0; j < 4; ++j) { const f32x4 w = *reinterpret_cast<const LAS f32x4*>(rwT + e * 1024 + 4 * lane + 256 * j); a += hv[j][0] * w[0] + hv[j][1] * w[1] + hv[j][2] * w[2] + hv[j][3] * w[3]; }
                lg[e] = wave_sum(a, lane); }
            int i0 = 0; float v0 = lg[0];
#pragma unroll
            for (int e = 1; e < 8; ++e) if (lg[e] > v0) { v0 = lg[e]; i0 = e; }
            int i1 = -1; float v1 = -3.4e38f;
#pragma unroll
            for (int e = 0; e < 8; ++e) if (e != i0 && lg[e] > v1) { v1 = lg[e]; i1 = e; }
            const float w0 = 1.f / (1.f + __expf(v1 - v0)), w1 = 1.f - w0;
            if (lane == 0) { const unsigned lp0 = __hip_atomic_fetch_add(lcnt + i0, 1u, __ATOMIC_RELAXED, __HIP_MEMORY_SCOPE_WORKGROUP), lp1 = __hip_atomic_fetch_add(lcnt + i1, 1u, __ATOMIC_RELAXED, __HIP_MEMORY_SCOPE_WORKGROUP);
                LAS int* rc = rec + li * 6; rc[0] = i0; rc[1] = (int)lp0; rc[2] = i1; rc[3] = (int)lp1; rc[4] = __float_as_int(w0); rc[5] = __float_as_int(w1); }
        }
    }
}
__device__ __forceinline__ void thin_phase(Frame& F, const ThinP& P) {
    const int lane = opaque(F.lane);
    const int nlat = P.nrows < RL ? P.nrows : RL, nctx = P.nrows - nlat;
    const int chL = (nlat + F.G - 1) / F.G, chC = (nctx + F.G - 1) / F.G;
    const int r0L = F.vcu * chL, r0C = F.vcu * chC;
    const int nl = r0L >= nlat ? 0 : (r0L + chL <= nlat ? chL : nlat - r0L), nc = r0C >= nctx ? 0 : (r0C + chC <= nctx ? chC : nctx - r0C), nrw = nl + nc;
#define TROW(li_) ((li_) < nl ? r0L + (li_) : RL + r0C + ((li_) - nl))
    LAS float* rwT = (LAS float*)F.lds;
    LAS int* rec = (LAS int*)(F.lds + 32768);
    LAS unsigned* lcnt = (LAS unsigned*)(F.lds + 65536);
    unsigned cb1 = 0, cb2 = 0, cb3 = 0, cb4 = 0, cb5 = 0, cb6 = 0, cb7 = 0;
    if (P.ymode == 2) { unsigned a = 0;
        a += (xb_ld(P.cnt + 0) + 255u) & ~255u; cb1 = a; a += (xb_ld(P.cnt + 1) + 255u) & ~255u; cb2 = a; a += (xb_ld(P.cnt + 2) + 255u) & ~255u; cb3 = a;
        a += (xb_ld(P.cnt + 3) + 255u) & ~255u; cb4 = a; a += (xb_ld(P.cnt + 4) + 255u) & ~255u; cb5 = a; a += (xb_ld(P.cnt + 5) + 255u) & ~255u; cb6 = a;
        a += (xb_ld(P.cnt + 6) + 255u) & ~255u; cb7 = a; }
    if (P.router) {
        for (int i = F.tid; i < 8192; i += 512) { const int col = i >> 3, e = i & 7; rwT[e * 1024 + col] = P.router[i]; }
        if (F.tid < 16) lcnt[F.tid] = 0u;
        __syncthreads();
    }
    LAS int* rtl = (LAS int*)(F.lds + 98304) + F.wave * 6 * 64;
    if (P.ymode == 2) { const int li_ = F.wave + 8 * lane;
        if (li_ < nrw) { const int* rt = P.route + (size_t)TROW(li_) * 8; const u32x4 a = *reinterpret_cast<const u32x4*>(rt); const u32x2 b = *reinterpret_cast<const u32x2*>(rt + 4);
            LAS int* d = rtl + lane * 6; d[0] = (int)a.x; d[1] = (int)a.y; d[2] = (int)a.z; d[3] = (int)a.w; d[4] = (int)b.x; d[5] = (int)b.y; }
        LDS_WAIT(); }
    f32x4 GA0 = {}, GA1 = {}, GA2 = {}, GA3 = {}, GB0 = {}, GB1 = {}, GB2 = {}, GB3 = {}, SH0 = {}, SH1 = {}, SH2 = {}, SH3 = {}; int cur_idx = -1;
#define TH_VEC(r_) do { const int ix_ = (r_) < RL ? ((r_) >> 12) : 8; if (ix_ != cur_idx) { cur_idx = ix_; \
        if (P.ymode) { const float* gt_ = P.gate + (size_t)ix_ * 6144 + 4 * lane; const float* ga_ = P.ga + 4 * lane; \
            GA0 = *reinterpret_cast<const f32x4*>(gt_) * *reinterpret_cast<const f32x4*>(ga_); GA1 = *reinterpret_cast<const f32x4*>(gt_ + 256) * *reinterpret_cast<const f32x4*>(ga_ + 256); \
            GA2 = *reinterpret_cast<const f32x4*>(gt_ + 512) * *reinterpret_cast<const f32x4*>(ga_ + 512); GA3 = *reinterpret_cast<const f32x4*>(gt_ + 768) * *reinterpret_cast<const f32x4*>(ga_ + 768); } \
        if (P.H) { const float* sh_ = P.shsc + (size_t)ix_ * 6144 + 4 * lane; const float* gb_ = P.gb + 4 * lane; \
            GB0 = *reinterpret_cast<const f32x4*>(gb_) * (*reinterpret_cast<const f32x4*>(sh_ + 1024) + 1.f); GB1 = *reinterpret_cast<const f32x4*>(gb_ + 256) * (*reinterpret_cast<const f32x4*>(sh_ + 1280) + 1.f); \
            GB2 = *reinterpret_cast<const f32x4*>(gb_ + 512) * (*reinterpret_cast<const f32x4*>(sh_ + 1536) + 1.f); GB3 = *reinterpret_cast<const f32x4*>(gb_ + 768) * (*reinterpret_cast<const f32x4*>(sh_ + 1792) + 1.f); \
            SH0 = *reinterpret_cast<const f32x4*>(sh_); SH1 = *reinterpret_cast<const f32x4*>(sh_ + 256); SH2 = *reinterpret_cast<const f32x4*>(sh_ + 512); SH3 = *reinterpret_cast<const f32x4*>(sh_ + 768); } } } while (0)
#define TH_VARGS GA0, GA1, GA2, GA3, GB0, GB1, GB2, GB3, SH0, SH1, SH2, SH3
    TH_DECL(A_); TH_DECL(B_);
    int li = F.wave;
    if (li < nrw) TH_LOAD(A_, TROW(li), 0);
    for (int it = 0; li < nrw; li += 16, it += 2) {
        const bool hb = li + 8 < nrw;
        if (hb) TH_LOAD(B_, TROW(li + 8), it + 1);
        TH_VEC(TROW(li)); thin_proc(P, TH_ARGS(A_), TH_VARGS, TROW(li), li, lane, rwT, rec, lcnt);
        if (li + 16 < nrw) TH_LOAD(A_, TROW(li + 16), it + 2);
        if (hb) { TH_VEC(TROW(li + 8)); thin_proc(P, TH_ARGS(B_), TH_VARGS, TROW(li + 8), li + 8, lane, rwT, rec, lcnt); }
    }
    if (P.router) {
        __syncthreads();
        if (F.tid < 8) lcnt[8 + F.tid] = __hip_atomic_fetch_add(P.cnt + F.tid, lcnt[F.tid], __ATOMIC_RELAXED, __HIP_MEMORY_SCOPE_AGENT);
        __syncthreads();
        for (int i = F.tid; i < nrw; i += 512) { const LAS int* rc = rec + i * 6; int* rt = P.route + (size_t)TROW(i) * 8;
            const int e0 = rc[0], e1 = rc[2];
            rt[0] = e0; rt[1] = rc[1] + (int)lcnt[8 + e0]; rt[2] = e1; rt[3] = rc[3] + (int)lcnt[8 + e1]; rt[4] = rc[4]; rt[5] = rc[5]; }
        VM_WAIT();
        for (int lb = F.wave; lb < nrw; lb += 32) {
            u32x4 v[4]; size_t s0[4], s1[4];
#pragma unroll
            for (int q = 0; q < 4; ++q) { const int lq = lb + 8 * q; const int r = TROW(lq); if (lq < nrw) { const LAS int* rc = rec + lq * 6; const int e0 = rc[0], e1 = rc[2];
                s0[q] = (size_t)e0 * RT + (size_t)(rc[1] + (int)lcnt[8 + e0]); s1[q] = (size_t)e1 * RT + (size_t)(rc[3] + (int)lcnt[8 + e1]);
                v[q] = *(reinterpret_cast<const u32x4*>((const unsigned char*)P.H + (size_t)r * DM) + lane); } }
#pragma unroll
            for (int q = 0; q < 4; ++q) { if (lb + 8 * q < nrw) {
                *(reinterpret_cast<u32x4*>(P.HSv + s0[q] * DM) + lane) = v[q]; *(reinterpret_cast<u32x4*>(P.HSv + s1[q] * DM) + lane) = v[q]; } }
        }
        __syncthreads();
    }
#undef TROW
#undef TH_VEC
#undef TH_VARGS
}

constexpr int NPHASE = 2 + DEPTH * 9;
__global__ void __launch_bounds__(512, 2) dit_fwd(Args args) {
    extern __shared__ __attribute__((aligned(16))) unsigned char lds[];
    Frame F;
    F.lds = (LAS unsigned char*)lds; F.ldsg = lds; F.MISC = (volatile LAS unsigned*)(F.lds + MISC_OFF);
    F.tid = threadIdx.x; F.lane = F.tid & 63; F.wave = __builtin_amdgcn_readfirstlane(F.tid >> 6);
    F.G = gridDim.x; { const int bx = blockIdx.x; F.vcu = (F.G % 8 == 0) ? (bx % 8) * (F.G / 8) + bx / 8 : bx; }
    F.ctl = (unsigned*)(args.ws + WS_CTL);
    for (int u = F.tid; u < (LDS_BYTES - RING_BYTES) / 4; u += 512) ((LAS unsigned*)(F.lds + RING_BYTES))[u] = 0u;
    __syncthreads();
    XcdBarrier bar = xcd_barrier_post(F.ctl + CW_BAR, F.MISC + 8);
    const int lo = args.ph_lo, hi = args.ph_hi;
    int ph = 0;
#define IN() (lo <= ph && ph < hi)
    unsigned long long wait_acc = 0;
#define SEAM() do { if (lo <= ph && ph + 1 < hi) { if (WAITPROBE) { const unsigned long long t0_ = __builtin_amdgcn_s_memrealtime(); xcd_barrier(bar); const unsigned long long dt_ = __builtin_amdgcn_s_memrealtime() - t0_; const int k_ = ph < 2 ? 9 + ph : (ph - 2) % 9; if ((WAITSEL >> k_) & 1u) wait_acc += dt_; } else xcd_barrier(bar); } ++ph; } while (0)
    GAS unsigned char* wsg = (GAS unsigned char*)args.ws;
#define WSP ((unsigned char*)wsg)
#define pMOD    ((float*)(WSP + WS_MOD))
#define pROPECS ((f32x2*)(WSP + WS_ROPE))
#define pWP     ((bf16_t*)(WSP + WS_WP))
#define pROUTE  ((int*)(WSP + WS_ROUTE))
#define pCS     ((bf16_t*)(WSP + WS_CS))
#define pCSC    ((bf16_t*)(WSP + WS_CSC))
#define pX      ((float*)(WSP + WS_X))
#define pH      ((bf16_t*)(WSP + WS_H))
#define pYO     ((bf16_t*)(WSP + WS_YO))
#define pZ      ((bf16_t*)(WSP + WS_Z))
#define pY      ((bf16_t*)(WSP + WS_Y))
#define pPQT    ((bf16_t*)(WSP + WS_PQT))
#define pPQTC   ((bf16_t*)(WSP + WS_PQTC))
#define pOB     ((bf16_t*)(WSP + WS_O))
#define pA2     ((bf16_t*)(WSP + WS_A2))
#define pA2M    ((bf16_t*)(WSP + WS_A2M))
#define pHS     ((bf16_t*)(WSP + WS_HS))
    const int vcu0 = F.vcu;
#define REFRAME() do { F.tid = opaque(threadIdx.x); F.lane = F.tid & 63; F.wave = __builtin_amdgcn_readfirstlane(F.tid >> 6); F.G = sopaque((int)gridDim.x); F.vcu = sopaque(vcu0); \
        wsg = gptr(args.ws); F.ctl = (unsigned*)(WSP + WS_CTL); } while (0)
    for (int rep0 = 0; rep0 < REP_P0; ++rep0)
    if (IN() && PH_ON(0)) { REFRAME();
        const int gw = F.vcu * 8 + F.wave, NGW = F.G * 8, gt = F.vcu * 512 + F.tid, NGT = F.G * 512;
        LAS float* ctab = (LAS float*)F.lds;
        LAS float* svec = (LAS float*)(F.lds + 16384);
        if (F.tid == 0) *(LAS unsigned*)(F.lds + 126976) = 0u;
        for (int i = F.tid; i < 4096; i += 512) ctab[i] = cospif((float)i * (1.f / 2048.f));
        for (int i = F.tid; i < 9 * 1024; i += 512) { const float v = i < 8192 ? args.c[i] : args.c_ctx[i - 8192]; svec[i] = v / (1.f + __expf(-v)); }
        __syncthreads();
        for (int i = gt; i < 4096 * 1024; i += NGT) { const int k = i >> 10, l0 = (i & 1023) * 8; float v[8];
#pragma unroll
            for (int e = 0; e < 8; ++e) { const int col = l0 + e, l = col & 4095; const int ph_ = (k * l) & 4095; v[e] = col < 4096 ? ctab[ph_] : -ctab[(ph_ - 1024) & 4095]; }
            if (F8_FOUR) *reinterpret_cast<u32x2*>((unsigned char*)pCS + (size_t)k * 8192 + l0) = (u32x2){pk4_fp8(v[0] * F8_SCS, v[1] * F8_SCS, v[2] * F8_SCS, v[3] * F8_SCS), pk4_fp8(v[4] * F8_SCS, v[5] * F8_SCS, v[6] * F8_SCS, v[7] * F8_SCS)};
            else *reinterpret_cast<u32x4*>(pCS + (size_t)k * 8192 + l0) = (u32x4){pk2(v[0], v[1]), pk2(v[2], v[3]), pk2(v[4], v[5]), pk2(v[6], v[7])}; }
        for (int i = gt; i < 256 * 64; i += NGT) { const int k = i >> 6, l0 = (i & 63) * 8; float v[8];
#pragma unroll
            for (int e = 0; e < 8; ++e) { const int col = l0 + e, l = col & 255; const int ph_ = (k * l * 16) & 4095; v[e] = col < 256 ? ctab[ph_] : -ctab[(ph_ - 1024) & 4095]; }
            if (F8_FOUR) *reinterpret_cast<u32x2*>((unsigned char*)pCSC + (size_t)k * 8192 + l0) = (u32x2){pk4_fp8(v[0] * F8_SCS, v[1] * F8_SCS, v[2] * F8_SCS, v[3] * F8_SCS), pk4_fp8(v[4] * F8_SCS, v[5] * F8_SCS, v[6] * F8_SCS, v[7] * F8_SCS)};
            else *reinterpret_cast<u32x4*>(pCSC + (size_t)k * 8192 + l0) = (u32x4){pk2(v[0], v[1]), pk2(v[2], v[3]), pk2(v[4], v[5]), pk2(v[6], v[7])}; }
        for (int i = gt; i < 256 * 128; i += NGT) { const int row = i >> 7, c = i & 127, m = row & 127; const int ph_ = (m * c * 32) & 4095;
            const float v = row < 128 ? ctab[ph_] : ctab[(ph_ - 1024) & 4095]; pWP[i] = (bf16_t)f2bf(v); }
        for (int i = gt; i < 64 * 16; i += NGT) { const int pos = i >> 4, k = i & 15; const float inv = __powf(10000.f, -(float)(2 * k) / 32.f); float s, c; sincosf((float)pos * inv, &s, &c); pROPECS[i] = (f32x2){c, s}; }
        for (int task = F.vcu + F.wave * F.G; task < 512; task += 8 * F.G) { const int layer = task >> 7, col = (task & 127) * 48 + F.lane;
            if (F.lane < 48) {
            const float* w = args.ada_w + (size_t)layer * DM * 6144 + col;
            float a0 = 0, a1 = 0, a2 = 0, a3 = 0, a4 = 0, a5 = 0, a6 = 0, a7 = 0, a8 = 0;
            for (int k0 = 0; k0 < DM; k0 += 32) { float wv[32];
#pragma unroll
                for (int i = 0; i < 32; ++i) wv[i] = w[(size_t)(k0 + i) * 6144];
#pragma unroll
                for (int i = 0; i < 32; ++i) { const int k = k0 + i;
                    a0 += svec[k] * wv[i]; a1 += svec[1024 + k] * wv[i]; a2 += svec[2048 + k] * wv[i]; a3 += svec[3072 + k] * wv[i]; a4 += svec[4096 + k] * wv[i];
                    a5 += svec[5120 + k] * wv[i]; a6 += svec[6144 + k] * wv[i]; a7 += svec[7168 + k] * wv[i]; a8 += svec[8192 + k] * wv[i]; } }
            const float bb = args.ada_b[layer * 6144 + col]; float* mo = pMOD + (size_t)layer * 9 * 6144 + col;
            mo[0] = a0 + bb; mo[6144] = a1 + bb; mo[2 * 6144] = a2 + bb; mo[3 * 6144] = a3 + bb; mo[4 * 6144] = a4 + bb; mo[5 * 6144] = a5 + bb; mo[6 * 6144] = a6 + bb; mo[7 * 6144] = a7 + bb; mo[8 * 6144] = a8 + bb; } }
        LAS float* scr = (LAS float*)(F.lds + 57344 + F.wave * 8448);
        LAS unsigned* wcnt = (LAS unsigned*)(F.lds + 126976);
        constexpr int NITEMS = 2 * (16 * 40) + 2 * (16 * 32) + 2 * (16 * 96) + 2 * (16 * 32) + 2 * (16 * 176) + 2 * (44 * 32) + 16 * (16 * 224) + 16 * (56 * 32);
        for (;;) {
            const int n = __builtin_amdgcn_readfirstlane((int)__hip_atomic_fetch_add(wcnt, F.lane == 0 ? 1u : 0u, __ATOMIC_RELAXED, __HIP_MEMORY_SCOPE_WORKGROUP));
            const int it = ((n >> 3) * F.G + F.vcu) * 8 + (n & 7);
            if (it >= NITEMS) break;
            int r = it;
            if (transpose_job(r, args.mix_in_w, 2, DM, MIXIN, (bf16_t*)(WSP + WS_WMIXIN), false, false, scr, F.lane)) continue;
            if (transpose_job(r, args.mix_out_w, 2, DM, DM, (bf16_t*)(WSP + WS_WMIXOUT), false, false, scr, F.lane)) continue;
            if (transpose_job(r, args.diff_qkv_w, 2, DM, 3072, (bf16_t*)(WSP + WS_WQKV), false, false, scr, F.lane)) continue;
            if (transpose_job(r, args.diff_out_w, 2, DM, DM, (bf16_t*)(WSP + WS_WDOUT), false, false, scr, F.lane)) continue;
            if (transpose_job(r, args.ffn_in_w, 2, DM, 2 * FFN, (bf16_t*)(WSP + WS_WFFNIN), true, F8_DENSE, scr, F.lane)) continue;
            if (transpose_job(r, args.ffn_out_w, 2, FFN, DM, (bf16_t*)(WSP + WS_WFFNOUT), false, F8_DENSE, scr, F.lane)) continue;
            if (transpose_job(r, args.expert_in_w, 16, DM, 2 * EDIM, (bf16_t*)(WSP + WS_WEXPIN), true, true, scr, F.lane)) continue;
            transpose_job(r, args.expert_out_w, 16, EDIM, DM, (bf16_t*)(WSP + WS_WEXPOUT), false, true, scr, F.lane);
        }
        __syncthreads();
    }
    SEAM();
    if (IN() && PH_ON(1)) { REFRAME();
        ThinP P{}; P.nrows = RT; P.xin_lat = args.x; P.xin_ctx = args.ctx; P.ymode = 0; P.H = pH; P.gb = args.norm_g; P.shsc = pMOD;
        for (int rep = 0; rep < REP_P0B; ++rep) thin_phase(F, P);
        for (int rep = 0; rep < EXTRA_BARS; ++rep) xcd_barrier(bar);
    }
    SEAM();

    for (int layer = 0; layer < DEPTH; ++layer) {
        const int j = layer >> 1; const bool even = !(layer & 1), lastl = layer == DEPTH - 1;
        const float* modl = pMOD + (size_t)layer * 9 * 6144; const float* ng = args.norm_g + (size_t)layer * 4 * DM;
        const int Mrows = lastl ? RL : RT;
        if (IN() && PH_ON(2)) { REFRAME();
            pg8::Dims d{DM, DM}; SchedDense S;
            if (even) { S.init(pH, DM, (bf16_t*)(WSP + WS_WMIXIN) + (size_t)j * MIXIN * DM, DM, RT, MIXIN, DM, F.G, (int)blockIdx.x);
                EpiRope E{pZ, MIXIN, 4, 9, pROPECS, 4, 8, QK_C}; for (int rep = 0; rep < REP_PROJ; ++rep) pg8::gemm_phase(F.lds, d, S, E); }
            else { S.init(pH, DM, (bf16_t*)(WSP + WS_WQKV) + (size_t)j * 3072 * DM, DM, RT, 3072, DM, F.G, (int)blockIdx.x);
                EpiRope E{pZ, 3072, 0, 16, pROPECS, 0, 8, QK_C}; for (int rep = 0; rep < REP_PROJ; ++rep) pg8::gemm_phase(F.lds, d, S, E); }
        }
        SEAM();
        if (IN() && PH_ON(3)) { REFRAME();
            if (even) {
                if (PH_ON(16)) { pg8::Dims d{128, MIXIN}; SchedF1 S{(const char*)pWP, (const char*)pZ, F.G, F.vcu}; EpiPQt E{pPQT, pPQTC}; for (int rep = 0; rep < REP_FOUR; ++rep) pg8::gemm_phase(F.lds, d, S, E); }
            } else {
                const float* lv = args.diff_lambda + j * 256;
                const int ln = opaque(F.lane); const float s01 = wave_sum(lv[ln] * lv[64 + ln], ln), s23 = wave_sum(lv[128 + ln] * lv[192 + ln], ln);
                const float lam_init = 0.8f - 0.6f * __expf(-0.3f * (float)layer);
                const float lam = __expf(s01) - __expf(s23) + lam_init;
                const float* subg = args.diff_subln_g + j * 128;
                const int nu = lastl ? 2048 : 2048 + 128;
                for (int rep = 0; rep < REP_DIFF; ++rep)
                for (int u = F.vcu; u < (PH_ON(18) ? nu : 0); u += F.G) {
                    if (u < 2048) diff_attn_unit((char*)lds, pZ, pOB, subg, lam, 1.f - lam_init, u >> 8, (u >> 5) & 7, u & 31, false);
                    else { const int v = u - 2048; diff_attn_unit((char*)lds, pZ, pOB, subg, lam, 1.f - lam_init, v >> 4, (v >> 1) & 7, v & 1, true); }
                }
                __syncthreads();
            }
        }
        SEAM();
        if (IN() && PH_ON(4)) { REFRAME();
            if (even) { pg8::Dims d{F8_FOUR ? 4096 : 8192, F8_FOUR ? 4096 : 8192}; SchedF2 S{(const char*)pCS, (const char*)pCSC, (const char*)pPQT, (const char*)pPQTC, F.G, F.vcu}; EpiFour2 E{pY}; for (int rep = 0; rep < REP_FOUR; ++rep) pg8::gemm_phase<EpiFour2, SchedF2, F8_FOUR>(F.lds, d, S, E);
                const float* sink = args.win_sink + j * 8;
                for (int rep = 0; rep < REP_WIN; ++rep)
                for (int u = F.vcu; u < (PH_ON(17) ? 1024 + 64 : 0); u += F.G) {
                    if (u < 1024) win_attn_unit2((char*)lds, pZ, pY, sink, u >> 7, (u >> 6) & 1, u & 63, false);
                    else { const int v = u - 1024; win_attn_unit2((char*)lds, pZ, pY, sink, v >> 3, (v >> 2) & 1, v & 3, true); }
                }
                __syncthreads();
            }
        }
        if (even) SEAM(); else ++ph;
        if (IN() && PH_ON(5)) { REFRAME();
            pg8::Dims d{DM, DM}; SchedDense S;
            S.init(even ? pY : pOB, DM, (bf16_t*)(WSP + (even ? WS_WMIXOUT : WS_WDOUT)) + (size_t)j * DM * DM, DM, Mrows, DM, DM, F.G, (int)blockIdx.x);
            EpiStore E{pYO, DM, 1.f}; for (int rep = 0; rep < REP_PROJ; ++rep) pg8::gemm_phase(F.lds, d, S, E);
        }
        SEAM();
        if (IN() && PH_ON(6)) { REFRAME();
            ThinP P{}; P.nrows = Mrows; P.xin_lat = layer == 0 ? args.x : pX; P.xin_ctx = layer == 0 ? args.ctx : pX + (size_t)RL * DM;
            P.xout_lat = pX; P.xout_ctx = pX + (size_t)RL * DM; P.ymode = 1; P.Ysrc = pYO; P.gate = modl + 2048; P.ga = ng + DM;
            P.H = pH; P.h8 = !even || F8_DENSE; P.gb = ng + 2 * DM; P.shsc = modl + 3072;
            if (!even) { P.router = args.router_w + (size_t)j * DM * 8; P.route = pROUTE; P.cnt = F.ctl + CW_CNT + 16 * j; P.HSv = (unsigned char*)pHS; }
            thin_phase(F, P);
        }
        SEAM();
        unsigned c0 = 0, c1 = 0, c2 = 0, c3 = 0, c4 = 0, c5 = 0, c6 = 0, c7 = 0;
        if (!even) { unsigned* cn = F.ctl + CW_CNT + 16 * j; unsigned a = 0;
            c0 = 0; a += (rfl(xb_ld(cn + 0)) + 255u) & ~255u; c1 = a; a += (rfl(xb_ld(cn + 1)) + 255u) & ~255u; c2 = a; a += (rfl(xb_ld(cn + 2)) + 255u) & ~255u; c3 = a;
            a += (rfl(xb_ld(cn + 3)) + 255u) & ~255u; c4 = a; a += (rfl(xb_ld(cn + 4)) + 255u) & ~255u; c5 = a; a += (rfl(xb_ld(cn + 5)) + 255u) & ~255u; c6 = a;
            a += (rfl(xb_ld(cn + 6)) + 255u) & ~255u; c7 = a; a += (rfl(xb_ld(cn + 7)) + 255u) & ~255u; c0 = a; }
        ++ph;
        if (IN() && PH_ON(8)) { REFRAME();
            const bool f8 = !even || F8_DENSE; const int eb = f8 ? 1 : 2;
            pg8::Dims d{DM * eb / 2, DM * eb / 2}; SchedGroup S;
            if (even) { S.A = (const char*)pH; S.B = (const char*)(WSP + WS_WFFNIN) + (size_t)j * 2 * FFN * DM * eb; S.nRT = RT / 256; S.P1 = S.P2 = S.P3 = S.P4 = S.P5 = S.P6 = S.P7 = 1 << 30; S.nN = 2 * FFN / 256; S.gB = 0; S.aE = 0; }
            else { S.aE = (size_t)RT * DM; S.A = (const char*)pHS; S.B = (const char*)(WSP + WS_WEXPIN) + (size_t)j * NEXP * 2 * EDIM * DM; S.nRT = (int)(c0 >> 8);
                S.P1 = (int)(c1 >> 8); S.P2 = (int)(c2 >> 8); S.P3 = (int)(c3 >> 8); S.P4 = (int)(c4 >> 8); S.P5 = (int)(c5 >> 8); S.P6 = (int)(c6 >> 8); S.P7 = (int)(c7 >> 8);
                S.nN = 2 * EDIM / 256; S.gB = (size_t)2 * EDIM * DM; }
            S.nwg = S.nRT * S.nN; S.G = F.G; S.c = (int)blockIdx.x; S.nkt = DM * eb / 128; S.tA = (size_t)256 * DM * eb; S.tB = (size_t)256 * DM * eb;
            if (f8) { EpiSwiglu<true> E{(unsigned char*)(even ? pA2 : pA2M), even ? FFN : EDIM, 1.f / (F8_SH * F8_SW)}; for (int rep = 0; rep < REP_MOE; ++rep) pg8::gemm_phase<EpiSwiglu<true>, SchedGroup, true, ALIGN_SWIGLU>(F.lds, d, S, E); }
            else { EpiSwiglu<false> E{(unsigned char*)pA2, FFN, 1.f}; for (int rep = 0; rep < REP_MOE; ++rep) pg8::gemm_phase<EpiSwiglu<false>, SchedGroup, false>(F.lds, d, S, E); }
        }
        SEAM();
        if (IN() && PH_ON(9)) { REFRAME();
            const bool f8 = !even || F8_DENSE; const int eb = f8 ? 1 : 2;
            const int Kh = even ? FFN : EDIM; pg8::Dims d{Kh * eb / 2, Kh * eb / 2}; SchedGroup S;
            if (even) { S.A = (const char*)pA2; S.B = (const char*)(WSP + WS_WFFNOUT) + (size_t)j * DM * FFN * eb; S.nRT = RT / 256; S.P1 = S.P2 = S.P3 = S.P4 = S.P5 = S.P6 = S.P7 = 1 << 30; S.gB = 0; }
            else { S.A = (const char*)pA2M; S.B = (const char*)(WSP + WS_WEXPOUT) + (size_t)j * NEXP * DM * EDIM; S.nRT = (int)(c0 >> 8);
                S.P1 = (int)(c1 >> 8); S.P2 = (int)(c2 >> 8); S.P3 = (int)(c3 >> 8); S.P4 = (int)(c4 >> 8); S.P5 = (int)(c5 >> 8); S.P6 = (int)(c6 >> 8); S.P7 = (int)(c7 >> 8);
                S.gB = (size_t)DM * EDIM; }
            S.aE = 0; S.nN = DM / 256; S.nwg = S.nRT * S.nN; S.G = F.G; S.c = (int)blockIdx.x; S.nkt = Kh * eb / 128; S.tA = (size_t)256 * Kh * eb; S.tB = (size_t)256 * Kh * eb;
            if (f8) { EpiStore E{even ? pYO : pHS, DM, 1.f / (F8_SA * F8_SW)}; for (int rep = 0; rep < REP_MOE; ++rep) pg8::gemm_phase<EpiStore, SchedGroup, true>(F.lds, d, S, E); }
            else { EpiStore E{pYO, DM, 1.f}; for (int rep = 0; rep < REP_MOE; ++rep) pg8::gemm_phase<EpiStore, SchedGroup, false>(F.lds, d, S, E); }
        }
        SEAM();
        if (IN() && PH_ON(10)) { REFRAME();
            ThinP P{}; P.nrows = Mrows; P.xin_lat = pX; P.xin_ctx = pX + (size_t)RL * DM;
            P.xout_lat = lastl ? args.out : pX; P.xout_ctx = pX + (size_t)RL * DM; P.ymode = even ? 1 : 2; P.Ysrc = even ? pYO : pHS; P.gate = modl + 5120; P.ga = ng + 3 * DM;
            P.route = pROUTE; P.cnt = F.ctl + CW_CNT + 16 * j;
            if (!lastl) { P.H = pH; P.gb = ng + 4 * DM; P.shsc = modl + 9 * 6144; }
            thin_phase(F, P);
        }
        SEAM();
    }
    if (WAITPROBE) {
        unsigned* wsum = F.ctl + 48;
        if (threadIdx.x == 0) __hip_atomic_fetch_add(wsum, (unsigned)wait_acc, __ATOMIC_RELAXED, __HIP_MEMORY_SCOPE_AGENT);
        xcd_barrier(bar);
        const unsigned mean = xb_ld(wsum) / gridDim.x; const unsigned long long t0_ = __builtin_amdgcn_s_memrealtime();
        while (__builtin_amdgcn_s_memrealtime() - t0_ < (unsigned long long)mean * WAITPROBE) __builtin_amdgcn_s_sleep(8);
    }
#undef IN
#undef SEAM
#undef REFRAME
}

#ifndef MK_PER_PHASE
#define MK_PER_PHASE 0
#endif
extern "C" void kernel_launch(void* const* d_in, const int* in_sizes, int n_in, void* d_out, int out_size, void* d_ws, size_t ws_size, hipStream_t stream) {
    static int grid = 0;
    if (grid == 0) {
        if (n_in != 19 || in_sizes[0] != RL * DM || out_size != RL * DM || ws_size < WS_END) {
            fprintf(stderr, "kernel_launch: unexpected shapes / workspace (n_in %d in0 %d out %d ws %zu need %zu)\n", n_in, n_in > 0 ? in_sizes[0] : -1, out_size, ws_size, (size_t)WS_END); grid = -1; return; }
        int dev = 0, cus = 0, per_cu = 0;
        if (hipGetDevice(&dev) != hipSuccess || hipDeviceGetAttribute(&cus, hipDeviceAttributeMultiprocessorCount, dev) != hipSuccess) { grid = -1; return; }
        if (hipFuncSetAttribute((const void*)dit_fwd, hipFuncAttributeMaxDynamicSharedMemorySize, LDS_BYTES) != hipSuccess) { fprintf(stderr, "kernel_launch: hipFuncSetAttribute failed\n"); grid = -1; return; }
        if (hipOccupancyMaxActiveBlocksPerMultiprocessor(&per_cu, (const void*)dit_fwd, 512, LDS_BYTES) != hipSuccess || per_cu < 1)
            fprintf(stderr, "kernel_launch: occupancy query reports %d\n", per_cu);
        (void)hipGetLastError();
        grid = cus;
    }
    if (grid < 0) return;
    if (hipMemsetAsync((char*)d_ws + WS_CTL, 0, CTL_BYTES, stream) != hipSuccess) return;
    Args a{};
    const float** ap = (const float**)&a;
    for (int i = 0; i < 19; ++i) ap[i] = (const float*)d_in[i];
    a.out = (float*)d_out; a.ws = (unsigned char*)d_ws;
#if MK_PER_PHASE
    for (int p = 0; p < NPHASE; ++p) { a.ph_lo = p; a.ph_hi = p + 1; hipLaunchKernelGGL(dit_fwd, dim3(grid), dim3(512), LDS_BYTES, stream, a); }
#else
    a.ph_lo = 0; a.ph_hi = NPHASE;
    hipLaunchKernelGGL(dit_fwd, dim3(grid), dim3(512), LDS_BYTES, stream, a);
#endif
}
```

```cpp
#include <hip/hip_runtime.h>
#include <cstdio>
#include <cstdint>

#ifndef PHMASK
#define PHMASK 0xFFFFFFFFu
#endif
#define PH_ON(i) ((PHMASK >> (i)) & 1u)
#ifndef REP_DIFF
#define REP_DIFF 1
#endif
#ifndef REP_MOE
#define REP_MOE 1
#endif
#ifndef REP_P0
#define REP_P0 1
#endif
#ifndef REP_P0B
#define REP_P0B 1
#endif
#ifndef EXTRA_BARS
#define EXTRA_BARS 0
#endif
#ifndef REP_EPI
#define REP_EPI 1
#endif
#ifndef WAITSEL
#define WAITSEL 0xFFFFu
#endif
#ifndef WAITPROBE
#define WAITPROBE 0
#endif
#ifndef KREP
#define KREP 1
#endif
#ifndef REP_PROJ
#define REP_PROJ 1
#endif
#ifndef REP_FOUR
#define REP_FOUR 1
#endif
#ifndef REP_WIN
#define REP_WIN 1
#endif
#define LAS __attribute__((address_space(3)))
#define GAS __attribute__((address_space(1)))
typedef unsigned short bf16_t;
typedef short bf16x8 __attribute__((ext_vector_type(8)));
typedef short s16x4 __attribute__((ext_vector_type(4)));
typedef float f32x2 __attribute__((ext_vector_type(2)));
typedef float f32x4 __attribute__((ext_vector_type(4)));
typedef float f32x16 __attribute__((ext_vector_type(16)));
typedef unsigned u32x2 __attribute__((ext_vector_type(2)));
typedef unsigned u32x4 __attribute__((ext_vector_type(4)));
typedef __bf16 bf16x2_t __attribute__((ext_vector_type(2)));
typedef int v8i_t __attribute__((ext_vector_type(8)));

constexpr int DM = 1024, NB = 8, SEQ = 4096, CTX = 256, DEPTH = 4;
constexpr int RL = NB * SEQ, RC = NB * CTX, RT = RL + RC;
constexpr int MIXIN = 1280, FFN = 2816, NEXP = 8, EDIM = 3584;
constexpr int MAXSLOT = 71680;
constexpr float EPS = 1e-6f;
constexpr float LOG2E = 1.4426950408889634f;
constexpr float QK_C = 0.125f * LOG2E;

constexpr size_t MiB = 1u << 20;
constexpr size_t WS_CTL = 0, CTL_BYTES = 32 * 1024;
constexpr size_t WS_MOD = 1 * MiB;
constexpr size_t WS_ROPE = WS_MOD + 900 * 1024;
constexpr size_t WS_WP = WS_ROPE + 8 * 1024;
constexpr size_t WS_ROUTE = 2 * MiB;
constexpr size_t WS_CS = 4 * MiB;
constexpr size_t WS_CSC = 68 * MiB;
constexpr size_t WS_WMIXIN = 72 * MiB;
constexpr size_t WS_WMIXOUT = 77 * MiB;
constexpr size_t WS_WQKV = 81 * MiB;
constexpr size_t WS_WDOUT = 93 * MiB;
constexpr size_t WS_WFFNIN = 97 * MiB;
constexpr size_t WS_WFFNOUT = 119 * MiB;
constexpr size_t WS_WEXPIN = 130 * MiB;
constexpr size_t WS_WEXPOUT = 354 * MiB;
constexpr size_t WS_X = 466 * MiB;
constexpr size_t WS_H = 602 * MiB;
constexpr size_t WS_YO = 670 * MiB;
constexpr size_t WS_RA = 738 * MiB;
constexpr size_t WS_Z = WS_RA;
constexpr size_t WS_Y = WS_RA + 85 * MiB;
constexpr size_t WS_PQT = WS_RA + 153 * MiB;
constexpr size_t WS_O = WS_RA + 204 * MiB;
constexpr size_t WS_RB = 1010 * MiB;
constexpr size_t WS_A2 = WS_RB;
constexpr size_t WS_PQTC = WS_RB + 190 * MiB;
constexpr size_t WS_A2M = WS_H;
constexpr size_t WS_HS = 1092 * MiB;
constexpr size_t WS_END = 1364 * MiB;
static_assert(WS_A2M + (size_t)MAXSLOT * EDIM * 2 <= WS_HS, "A2m overlay");
static_assert(WS_HS + (size_t)NEXP * RT * DM <= WS_END && WS_HS + (size_t)MAXSLOT * DM * 2 <= WS_END && WS_PQTC + 64 * MiB <= WS_END, "ws end");

constexpr int CW_TMO = 0;
constexpr int CW_CNT = 64;
constexpr int CW_BAR = 4096;

constexpr int RING_BYTES = 131072;
constexpr int MISC_OFF = RING_BYTES + 320;
constexpr int LDS_BYTES = 147456;

__device__ __forceinline__ unsigned cvtpk(float lo, float hi) { f32x2 v = {lo, hi}; bf16x2_t b = __builtin_convertvector(v, bf16x2_t); return __builtin_bit_cast(unsigned, b); }
#ifndef F8_DENSE
#define F8_DENSE false
#endif
#ifndef F8_FOUR
#define F8_FOUR false
#endif
constexpr float F8_SCS = 256.f, F8_SPQ = 8.f;
constexpr float F8_SH = 4.f, F8_SW = 64.f, F8_SA = 4.f;
__device__ __forceinline__ float f8clamp(float v) { return __builtin_amdgcn_fmed3f(v, -448.f, 448.f); }
__device__ __forceinline__ unsigned pk4_fp8(float a, float b, float c, float d) {
    unsigned w = 0; w = __builtin_amdgcn_cvt_pk_fp8_f32(f8clamp(a), f8clamp(b), w, false); w = __builtin_amdgcn_cvt_pk_fp8_f32(f8clamp(c), f8clamp(d), w, true); return w; }
__device__ __forceinline__ float bf_lo(unsigned u) { return __uint_as_float(u << 16); }
__device__ __forceinline__ float bf_hi(unsigned u) { return __uint_as_float(u & 0xffff0000u); }
__device__ __forceinline__ float wave_sum(float v, int lane) {
#pragma unroll
    for (int o = 1; o < 64; o <<= 1) v += __int_as_float(__builtin_amdgcn_ds_bpermute((lane ^ o) << 2, __float_as_int(v)));
    return v;
}
__device__ __forceinline__ unsigned rfl(unsigned v) { return (unsigned)__builtin_amdgcn_readfirstlane((int)v); }
__device__ __forceinline__ const char* uptr(const char* p) {
    unsigned lo = (unsigned)__builtin_amdgcn_readfirstlane((int)(unsigned)(uintptr_t)p), hi = (unsigned)__builtin_amdgcn_readfirstlane((int)(unsigned)((uintptr_t)p >> 32));
    asm volatile("" : "+s"(lo), "+s"(hi));
    return (const char*)(((uintptr_t)hi << 32) | lo);
}
__device__ __forceinline__ GAS unsigned char* gptr(const void* p) {
    unsigned lo = (unsigned)__builtin_amdgcn_readfirstlane((int)(unsigned)(uintptr_t)p), hi = (unsigned)__builtin_amdgcn_readfirstlane((int)(unsigned)((uintptr_t)p >> 32));
    asm volatile("" : "+s"(lo), "+s"(hi));
    return (GAS unsigned char*)(((uintptr_t)hi << 32) | lo);
}
__device__ __forceinline__ int sopaque(int v) { v = __builtin_amdgcn_readfirstlane(v); asm volatile("" : "+s"(v)); return v; }
__device__ __forceinline__ int opaque(int v) { asm volatile("" : "+v"(v)); return v; }
#define LDS_WAIT() asm volatile("s_waitcnt lgkmcnt(0)" ::: "memory")
#define VM_WAIT() asm volatile("s_waitcnt vmcnt(0)" ::: "memory")
#define SBAR() __builtin_amdgcn_sched_barrier(0)

namespace pg8 {
constexpr int BM = 256, BK = 64, HALF = 128, HTB = HALF * BK * 2, STAGE_BYTES = 8 * HTB, NXCD = 8, WGM = 8;
__host__ __device__ __forceinline__ int lds_byte(int r, int c) { const int st = (r >> 4) * 2 + (c >> 5), rr = r & 15, cc = c & 31, ob = rr * 64 + cc * 2; return st * 1024 + (ob ^ (((ob >> 9) & 1) << 5)); }
__host__ __device__ __forceinline__ void stage_rc(int b, int& R, int& C) { const int st = b / 1024, sb = b % 1024, swz = sb ^ (((sb >> 9) & 1) << 5); R = (st >> 1) * 16 + swz / 64; C = (st & 1) * 32 + (swz % 64) / 2; }
__host__ __device__ __forceinline__ int perm32(int rho) { const int n = rho >> 4, i = rho & 15; return 8 * (i >> 2) + 4 * n + (i & 3); }

struct Unit { int pm, pn, e, nkt; };
struct Dims { int lda, ldb; };

__device__ __forceinline__ int xcd_remap(int wgid, int nwg) {
    const int q = nwg / NXCD, r = nwg % NXCD, xcd = wgid % NXCD, off = wgid / NXCD;
    return (xcd < r ? xcd * (q + 1) : r * (q + 1) + (xcd - r) * q) + off;
}

#ifndef ALIGN_SWIGLU
#define ALIGN_SWIGLU true
#endif
#ifndef ALIGN_DEFAULT
#define ALIGN_DEFAULT true
#endif
template <class Epi, class Sched, bool F8 = false, bool ALIGN_EPI = ALIGN_DEFAULT>
__device__ __forceinline__ void gemm_phase(LAS unsigned char* lds, const Dims g, const Sched& S, const Epi& E) {
    const int tid = opaque(threadIdx.x), wid = __builtin_amdgcn_readfirstlane(tid >> 6), lane = tid & 63, wr = wid >> 2, wc = wid & 3, fr = lane & 15, fq = lane >> 4;
    unsigned voffA[2], voffB[2];
#pragma unroll
    for (int i = 0; i < 2; ++i) { int R, C; stage_rc(tid * 16 + i * 8192, R, C); const int Rb = Epi::PERM ? ((R & ~31) + perm32(R & 31)) : R;
        voffA[i] = (unsigned)(R * g.lda + C) * 2u; voffB[i] = (unsigned)(Rb * g.ldb + C) * 2u; }
    const size_t kstep = (size_t)(BK * 2);
    const size_t hstepA = (size_t)HALF * g.lda * 2, hstepB = (size_t)HALF * g.ldb * 2;
    const unsigned ldsw = (unsigned)wid * 1024u;
    const int aoff = lds_byte(wr * 64 + fr, fq * 8), boff = lds_byte(wc * 32 + fr, fq * 8);
#define PG8_SA(b, h) (((b) * 2 + (h)) * HTB)
#define PG8_SB(b, h) ((4 + (b) * 2 + (h)) * HTB)
#define PG8_STAGE(bufoff, gbase, voff) do { _Pragma("unroll") for (int _i = 0; _i < 2; ++_i) \
        __builtin_amdgcn_global_load_lds((const unsigned*)((const char*)(gbase) + (voff)[_i]), (LAS unsigned*)(lds + (bufoff) + ldsw + _i * 8192), 16, 0, 0); } while (0)
#define PG8_LDA(dst, b, h) do { _Pragma("unroll") for (int m = 0; m < 4; ++m) _Pragma("unroll") for (int k = 0; k < 2; ++k) dst[m][k] = *(const LAS bf16x8*)(lds + PG8_SA(b, h) + aoff + m * 2048 + k * 1024); } while (0)
#define PG8_LDB(dst, b, h) do { _Pragma("unroll") for (int n = 0; n < 2; ++n) _Pragma("unroll") for (int k = 0; k < 2; ++k) dst[n][k] = *(const LAS bf16x8*)(lds + PG8_SB(b, h) + boff + n * 2048 + k * 1024); } while (0)
#define PG8_V8(x) __builtin_bit_cast(v8i_t, (x))
#define PG8_MMA(ai, bj, At, Bt) do { __builtin_amdgcn_s_setprio(1); _Pragma("unroll") for (int m = 0; m < 4; ++m) _Pragma("unroll") for (int n = 0; n < 2; ++n) { \
        if constexpr (F8) { struct P2 { bf16x8 a, b; }; const v8i_t a8_ = PG8_V8((P2{Bt[n][0], Bt[n][1]})), b8_ = PG8_V8((P2{At[m][0], At[m][1]})); \
            asm volatile("v_mfma_f32_16x16x128_f8f6f4 %0, %1, %2, %0" : "+v"(acc[ai][bj][m][n]) : "v"(a8_), "v"(b8_)); }   \
        else { _Pragma("unroll") for (int k = 0; k < 2; ++k) acc[ai][bj][m][n] = __builtin_amdgcn_mfma_f32_16x16x32_bf16(Bt[n][k], At[m][k], acc[ai][bj][m][n], 0, 0, 0); } } \
        __builtin_amdgcn_s_setprio(0); } while (0)
#define PG8_WAIT_V(n) asm volatile("s_waitcnt vmcnt(" #n ")" ::: "memory")
#define PG8_WAIT_L(n) asm volatile("s_waitcnt lgkmcnt(" #n ")" ::: "memory")
#define PG8_BAR __builtin_amdgcn_s_barrier()
#define PG8_SCHED __builtin_amdgcn_sched_barrier(0)
    Unit cur, nxt; int ui = 0;
    if (!S.next(0, cur)) return;
    f32x4 acc[2][2][4][2];
#pragma unroll
    for (int a = 0; a < 2; ++a)
#pragma unroll
        for (int b = 0; b < 2; ++b)
#pragma unroll
            for (int m = 0; m < 4; ++m)
#pragma unroll
                for (int n = 0; n < 2; ++n) acc[a][b][m][n] = (f32x4){0.f, 0.f, 0.f, 0.f};
    bf16x8 At[4][2], B0[2][2], B1[2][2];
    const char* cA = uptr(S.aptr(cur)); const char* cB = uptr(S.bptr(cur));
    PG8_STAGE(PG8_SB(0, 0), cB, voffB); PG8_STAGE(PG8_SB(0, 1), cB + hstepB, voffB); PG8_STAGE(PG8_SA(0, 0), cA, voffA); PG8_STAGE(PG8_SA(0, 1), cA + hstepA, voffA);
    if (wr == 1) PG8_BAR;
    PG8_WAIT_V(2); PG8_BAR;
    PG8_STAGE(PG8_SB(1, 0), cB + kstep, voffB); PG8_STAGE(PG8_SA(1, 0), cA + kstep, voffA); PG8_STAGE(PG8_SB(1, 1), cB + hstepB + kstep, voffB);
    PG8_WAIT_V(6); PG8_BAR;
    for (;;) {
        const bool has_next = S.next(ui + 1, nxt);
        const char* nA = uptr(has_next ? S.aptr(nxt) : cA); const char* nB = uptr(has_next ? S.bptr(nxt) : cB);
        const int nt = sopaque(cur.nkt);
        for (int t = 0; t < KREP * nt; t += 2) {
            const bool last = (t == KREP * nt - 2);
            const char* a1 = cA + (size_t)(KREP == 1 ? t + 1 : (t + 1) % nt) * kstep;
            const char* a2 = last ? nA : cA + (size_t)(KREP == 1 ? t + 2 : (t + 2) % nt) * kstep; const char* b2 = last ? nB : cB + (size_t)(KREP == 1 ? t + 2 : (t + 2) % nt) * kstep;
            const char* a3 = a2 + kstep; const char* b3 = b2 + kstep;
            PG8_LDB(B0, 0, 0); PG8_LDB(B1, 0, 1); PG8_SCHED; PG8_LDA(At, 0, 0); PG8_STAGE(PG8_SA(1, 1), a1 + hstepA, voffA);
            PG8_WAIT_V(8); PG8_WAIT_L(0); PG8_BAR; PG8_MMA(0, 0, At, B0); PG8_MMA(0, 1, At, B1); PG8_BAR; PG8_SCHED;
            PG8_LDA(At, 0, 1); PG8_STAGE(PG8_SB(0, 0), b2, voffB); PG8_STAGE(PG8_SB(0, 1), b2 + hstepB, voffB); PG8_STAGE(PG8_SA(0, 0), a2, voffA);
            PG8_WAIT_V(8); PG8_WAIT_L(0); PG8_BAR; PG8_MMA(1, 0, At, B0); PG8_MMA(1, 1, At, B1); PG8_BAR; PG8_SCHED;
            PG8_LDB(B0, 1, 0); PG8_LDB(B1, 1, 1); PG8_SCHED; PG8_LDA(At, 1, 0); PG8_STAGE(PG8_SA(0, 1), a2 + hstepA, voffA);
            PG8_WAIT_V(8); PG8_WAIT_L(0); PG8_BAR; PG8_MMA(0, 0, At, B0); PG8_MMA(0, 1, At, B1); PG8_BAR; PG8_SCHED;
            PG8_LDA(At, 1, 1); PG8_STAGE(PG8_SB(1, 0), b3, voffB); PG8_STAGE(PG8_SB(1, 1), b3 + hstepB, voffB); PG8_STAGE(PG8_SA(1, 0), a3, voffA);
            PG8_WAIT_V(8); PG8_WAIT_L(0); PG8_BAR; PG8_MMA(1, 0, At, B0); PG8_MMA(1, 1, At, B1); PG8_BAR; PG8_SCHED;
        }
        if constexpr (ALIGN_EPI) { if (wr == 0) PG8_BAR; }
        if constexpr (F8) asm volatile("s_nop 15\n\ts_nop 15" ::: "memory");
        for (int repe = 0; repe < REP_EPI; ++repe) { const int l2 = opaque(threadIdx.x) & 63; E(acc, cur, wr, wc, l2 & 15, l2 >> 4); }
        if (!has_next) break;
#pragma unroll
        for (int a = 0; a < 2; ++a)
#pragma unroll
            for (int b = 0; b < 2; ++b)
#pragma unroll
                for (int m = 0; m < 4; ++m)
#pragma unroll
                    for (int n = 0; n < 2; ++n) acc[a][b][m][n] = (f32x4){0.f, 0.f, 0.f, 0.f};
        cur = nxt; cA = nA; cB = nB; ++ui;
        if constexpr (ALIGN_EPI) { if (wr == 1) PG8_BAR; }
    }
    PG8_WAIT_V(0);
    if constexpr (!ALIGN_EPI) { if (wr == 0) PG8_BAR; }
    PG8_BAR;
#undef PG8_SA
#undef PG8_SB
#undef PG8_STAGE
#undef PG8_LDA
#undef PG8_LDB
#undef PG8_MMA
#undef PG8_V8
#undef PG8_WAIT_V
#undef PG8_WAIT_L
#undef PG8_BAR
#undef PG8_SCHED
}
}
using pg8::Unit;

struct EpiStore {
    static constexpr bool PERM = true;
    bf16_t* O; int ldc; float scale;
    __device__ __forceinline__ void operator()(const f32x4 (&acc)[2][2][4][2], const Unit& u, int wr, int wc, int fr, int fq) const {
        const int row0 = u.pm * 256 + wr * 64 + fr, col0 = u.pn * 256 + wc * 32 + 8 * fq;
#pragma unroll
        for (int ai = 0; ai < 2; ++ai)
#pragma unroll
            for (int m = 0; m < 4; ++m) { bf16_t* rowp = O + (size_t)(row0 + ai * 128 + m * 16) * ldc + col0;
#pragma unroll
                for (int bj = 0; bj < 2; ++bj) { const f32x4 v0 = acc[ai][bj][m][0] * (scale * (1.f / KREP)), v1 = acc[ai][bj][m][1] * (scale * (1.f / KREP));
                    u32x4 w; w.x = cvtpk(v0[0], v0[1]); w.y = cvtpk(v0[2], v0[3]); w.z = cvtpk(v1[0], v1[1]); w.w = cvtpk(v1[2], v1[3]);
                    *(u32x4*)(rowp + bj * 128) = w; } }
    }
};
template <bool F8OUT> struct EpiSwiglu {
    static constexpr bool PERM = true;
    unsigned char* O; int ldc; float scale;
    __device__ __forceinline__ void operator()(const f32x4 (&acc)[2][2][4][2], const Unit& u, int wr, int wc, int fr, int fq) const {
        const int row0 = u.pm * 256 + wr * 64 + fr, col0 = u.pn * 128 + wc * 32 + 8 * fq;
        const float us = F8OUT ? scale * F8_SA : scale;
        const float k1 = -scale * LOG2E * (1.f / KREP), ik2 = 1.f / (scale * us * (1.f / KREP) * (1.f / KREP));
#pragma unroll
        for (int ai = 0; ai < 2; ++ai)
#pragma unroll
            for (int m = 0; m < 4; ++m) { unsigned char* rowp = O + ((size_t)(row0 + ai * 128 + m * 16) * ldc + col0) * (F8OUT ? 1 : 2);
                float r[8];
#pragma unroll
                for (int n = 0; n < 2; ++n) { const f32x4 g = acc[ai][0][m][n], u = acc[ai][1][m][n]; const f32x4 t = g * k1;
                    f32x4 e; e[0] = __builtin_amdgcn_exp2f(t[0]); e[1] = __builtin_amdgcn_exp2f(t[1]); e[2] = __builtin_amdgcn_exp2f(t[2]); e[3] = __builtin_amdgcn_exp2f(t[3]);
                    const f32x4 d = e * ik2 + ik2;
                    f32x4 q; q[0] = __builtin_amdgcn_rcpf(d[0]); q[1] = __builtin_amdgcn_rcpf(d[1]); q[2] = __builtin_amdgcn_rcpf(d[2]); q[3] = __builtin_amdgcn_rcpf(d[3]);
                    const f32x4 o = (g * u) * q; r[n * 4 + 0] = o[0]; r[n * 4 + 1] = o[1]; r[n * 4 + 2] = o[2]; r[n * 4 + 3] = o[3]; }
                if constexpr (F8OUT) { u32x2 w; w.x = pk4_fp8(r[0], r[1], r[2], r[3]); w.y = pk4_fp8(r[4], r[5], r[6], r[7]); *(u32x2*)rowp = w; }
                else { u32x4 w; w.x = cvtpk(r[0], r[1]); w.y = cvtpk(r[2], r[3]); w.z = cvtpk(r[4], r[5]); w.w = cvtpk(r[6], r[7]); *(u32x4*)rowp = w; } }
    }
};
struct EpiRope {
    static constexpr bool PERM = false;
    bf16_t* O; int ldc; int rlo, rhi; const f32x2* cs;
    int qlo, qhi; float qscale;
    __device__ __forceinline__ void operator()(const f32x4 (&acc)[2][2][4][2], const Unit& u, int wr, int wc, int fr, int fq) const {
        const int row0 = u.pm * 256 + wr * 64 + fr, col0 = u.pn * 256 + wc * 32 + 4 * fq;
        const bool lat = u.pm < 128;
#pragma unroll
        for (int ai = 0; ai < 2; ++ai)
#pragma unroll
            for (int m = 0; m < 4; ++m) { const int row = row0 + ai * 128 + m * 16; bf16_t* rowp = O + (size_t)row * ldc + col0;
                const int t = row & 4095, pos = (wc & 1) ? (t & 63) : (t >> 6);
                const f32x2* c4 = cs + pos * 16 + 4 * fq;
                const f32x2 c0 = c4[0], c1 = c4[1], c2 = c4[2], c3 = c4[3];
#pragma unroll
                for (int bj = 0; bj < 2; ++bj) { f32x4 p1 = acc[ai][bj][m][0] * (1.f / KREP), p2 = acc[ai][bj][m][1] * (1.f / KREP);
                    const int blk = u.pn * 2 + bj;
                    if (lat && blk >= rlo && blk < rhi) {
                        const f32x4 cv = {c0.x, c1.x, c2.x, c3.x}, sv = {c0.y, c1.y, c2.y, c3.y};
                        const f32x4 o1 = p1 * cv - p2 * sv, o2 = p2 * cv + p1 * sv; p1 = o1; p2 = o2; }
                    if (blk >= qlo && blk < qhi) { p1 = p1 * qscale; p2 = p2 * qscale; }
                    u32x2 w1, w2; w1.x = cvtpk(p1[0], p1[1]); w1.y = cvtpk(p1[2], p1[3]); w2.x = cvtpk(p2[0], p2[1]); w2.y = cvtpk(p2[2], p2[3]);
                    *(u32x2*)(rowp + bj * 128) = w1; *(u32x2*)(rowp + bj * 128 + 16) = w2; } }
    }
};
struct EpiPQt {
    static constexpr bool PERM = true;
    bf16_t* Plat; bf16_t* Pctx;
    __device__ __forceinline__ void operator()(const f32x4 (&acc)[2][2][4][2], const Unit& u, int wr, int wc, int fr, int fq) const {
        const bool ctx = u.e >= 32; const int bg = ctx ? u.e - 32 : u.e; const int L = ctx ? CTX : SEQ;
        constexpr int EB = F8_FOUR ? 1 : 2;
        unsigned char* base = (unsigned char*)(ctx ? Pctx : Plat) + (size_t)bg * 128 * 8192 * EB;
        const int col0 = u.pn * 256 + wc * 32 + 8 * fq;
#pragma unroll
        for (int ai = 0; ai < 2; ++ai)
#pragma unroll
            for (int m = 0; m < 4; ++m) { unsigned char* rowp = base + ((size_t)(wr * 64 + m * 16 + fr) * 8192 + ai * L + col0) * EB;
#pragma unroll
                for (int bj = 0; bj < 2; ++bj) { const f32x4 v0 = acc[ai][bj][m][0] * (1.f / KREP), v1 = acc[ai][bj][m][1] * (1.f / KREP);
                    if constexpr (F8_FOUR) { u32x2 w; w.x = pk4_fp8(v0[0] * F8_SPQ, v0[1] * F8_SPQ, v0[2] * F8_SPQ, v0[3] * F8_SPQ); w.y = pk4_fp8(v1[0] * F8_SPQ, v1[1] * F8_SPQ, v1[2] * F8_SPQ, v1[3] * F8_SPQ); *(u32x2*)(rowp + bj * 128) = w; }
                    else { u32x4 w; w.x = cvtpk(v0[0], v0[1]); w.y = cvtpk(v0[2], v0[3]); w.z = cvtpk(v1[0], v1[1]); w.w = cvtpk(v1[2], v1[3]); *(u32x4*)(rowp + bj * 128 * 2) = w; } } }
    }
};
struct EpiFour2 {
    static constexpr bool PERM = true;
    bf16_t* O;
    __device__ __forceinline__ void operator()(const f32x4 (&acc)[2][2][4][2], const Unit& u, int wr, int wc, int fr, int fq) const {
        EpiStore s{O, DM, (u.pm < 128 ? 0.0013810679320049757f   : 0.005524271728019903f  ) * (F8_FOUR ? 1.f / (F8_SCS * F8_SPQ) : 1.f)};
        s(acc, u, wr, wc, fr, fq);
    }
};

struct SchedDense {
    const char* A; const char* B; int nM, nN, nwg, G, c, nkt; size_t tA, tB;
    __device__ __forceinline__ void init(const void* A_, int lda, const void* B_, int ldb, int M, int N, int K, int G_, int c_) {
        A = (const char*)A_; B = (const char*)B_; nM = M / 256; nN = N / 256; nwg = nM * nN; G = G_; c = c_; nkt = K / 64; tA = (size_t)256 * lda * 2; tB = (size_t)256 * ldb * 2; }
    __device__ __forceinline__ bool next(int i, Unit& u) const {
        const long L = (long)i * G + c; if (L >= nwg) return false;
        const int wgid = pg8::xcd_remap((int)L, nwg);
        const int nig = pg8::WGM * nN, gid = wgid / nig, fm = gid * pg8::WGM, gsz = (nM - fm) < pg8::WGM ? (nM - fm) : pg8::WGM;
        u.pm = fm + ((wgid % nig) % gsz); u.pn = (wgid % nig) / gsz; u.e = 0; u.nkt = nkt; return true;
    }
    __device__ __forceinline__ const char* aptr(const Unit& u) const { return A + (size_t)u.pm * tA; }
    __device__ __forceinline__ const char* bptr(const Unit& u) const { return B + (size_t)u.pn * tB; }
};
struct SchedGroup {
    const char* A; const char* B; int P1, P2, P3, P4, P5, P6, P7, nRT, nN, nwg, G, c, nkt; size_t tA, tB, gB, aE;
    __device__ __forceinline__ bool next(int i, Unit& u) const {
        const long L = (long)i * G + c; if (L >= nwg) return false;
        const int wgid = pg8::xcd_remap((int)L, nwg);
        const int nig = pg8::WGM * nN, gid = wgid / nig, fm = gid * pg8::WGM, gsz = (nRT - fm) < pg8::WGM ? (nRT - fm) : pg8::WGM;
        const int rt = fm + ((wgid % nig) % gsz);
        u.pm = rt; u.pn = (wgid % nig) / gsz; u.nkt = nkt;
        u.e = (rt >= P1) + (rt >= P2) + (rt >= P3) + (rt >= P4) + (rt >= P5) + (rt >= P6) + (rt >= P7); return true;
    }
    __device__ __forceinline__ const char* aptr(const Unit& u) const {
        if (aE == 0) return A + (size_t)u.pm * tA;
        const int pe = u.e == 0 ? 0 : u.e == 1 ? P1 : u.e == 2 ? P2 : u.e == 3 ? P3 : u.e == 4 ? P4 : u.e == 5 ? P5 : u.e == 6 ? P6 : P7;
        return A + (size_t)u.e * aE + (size_t)(u.pm - pe) * tA; }
    __device__ __forceinline__ const char* bptr(const Unit& u) const { return B + (size_t)u.e * gB + (size_t)u.pn * tB; }
};
struct SchedF1 {
    const char* Wp; const char* Z; int G, c;
    __device__ __forceinline__ bool next(int i, Unit& u) const {
        const int L = i * G + c; if (L >= 544) return false;
        u.pm = 0; u.nkt = 2;
        if (L < 512) { u.e = L >> 4; u.pn = L & 15; } else { u.e = 32 + (L - 512); u.pn = 0; }
        return true;
    }
    __device__ __forceinline__ const char* aptr(const Unit&) const { return Wp; }
    __device__ __forceinline__ const char* bptr(const Unit& u) const {
        const bool ctx = u.e >= 32; const int bg = ctx ? u.e - 32 : u.e, b = bg >> 2, gq = bg & 3;
        const size_t row0 = ctx ? (size_t)RL + b * CTX : (size_t)b * SEQ + u.pn * 256;
        return Z + (row0 * MIXIN + gq * 128) * 2; }
};
struct SchedF2 {
    const char* CSl; const char* CSc; const char* Plat; const char* Pctx; int G, vcu;
    static constexpr size_t EB = F8_FOUR ? 1 : 2;
    __device__ __forceinline__ bool next(int i, Unit& u) const {
        const int L = i * G + vcu; if (L >= 272) return false;
        if (L < 256) { const int b = L >> 5, mt = (L & 31) >> 1; u.pm = b * 16 + mt; u.pn = L & 1; u.e = b; u.nkt = F8_FOUR ? 64 : 128; }
        else { const int b = (L - 256) >> 1; u.pm = 128 + b; u.pn = L & 1; u.e = 8 + b; u.nkt = F8_FOUR ? 4 : 8; }
        return true;
    }
    __device__ __forceinline__ const char* aptr(const Unit& u) const { return u.e < 8 ? CSl + (size_t)(u.pm & 15) * 256 * 8192 * EB : CSc; }
    __device__ __forceinline__ const char* bptr(const Unit& u) const { return (u.e < 8 ? Plat + (size_t)u.e * 512 * 8192 * EB : Pctx + (size_t)(u.e - 8) * 512 * 8192 * EB) + (size_t)u.pn * 256 * 8192 * EB; }
};

#define XB_TMO      128
#define XB_XCNT(j)  (256  + 64 * (j))
#define XB_XSUB(j)  (1280 + 64 * (j))
#define XB_XGEN(j)  (2304 + 64 * (j))
#define XB_TOP      3328
#define XB_TOPGEN   3392
#define XCD_BAR_WORDS 3456
#define XB_SPIN_CAP (1u << 21)
__device__ __forceinline__ unsigned xb_ld(unsigned* p)              { return __hip_atomic_load(p, __ATOMIC_RELAXED, __HIP_MEMORY_SCOPE_AGENT); }
__device__ __forceinline__ unsigned xb_add(unsigned* p, unsigned v) { return __hip_atomic_fetch_add(p, v, __ATOMIC_RELAXED, __HIP_MEMORY_SCOPE_AGENT); }
__device__ __forceinline__ unsigned xb_xcc_id() { return (unsigned)__builtin_amdgcn_s_getreg((3 << 11) | 20) & 0xFu; }
#define XB_SPIN(cond, bar) do { unsigned _sp = 0; while (cond) { __builtin_amdgcn_s_sleep(1); \
    if ((++_sp & 255u) == 0u) { if (xb_ld(&(bar)[XB_TMO])) break; if (_sp > XB_SPIN_CAP) { atomicAdd(&(bar)[XB_TMO], 1u); break; } } } } while (0)
struct XcdBarrier { unsigned* bar; unsigned x; volatile LAS unsigned* st; };
__device__ __forceinline__ XcdBarrier xcd_barrier_post(unsigned* bar, volatile LAS unsigned* st) {
    XcdBarrier b; b.bar = bar; b.x = xb_xcc_id(); b.st = st;
    if (threadIdx.x == 0) (void)xb_add(&bar[XB_XCNT(b.x)], 1u);
    return b;
}
__device__ __forceinline__ void xcd_barrier_complete(unsigned* bar, unsigned x, unsigned& nloc, unsigned& nx) {
    const unsigned G = gridDim.x * gridDim.y * gridDim.z;
    unsigned sum, cnt, mine, sp = 0u;
    for (;;) {
        sum = 0u; cnt = 0u; mine = 0u;
#pragma unroll
        for (unsigned j = 0; j < 16; ++j) { const unsigned c = xb_ld(&bar[XB_XCNT(j)]); sum += c; cnt += (c > 0u) ? 1u : 0u; mine = (j == x) ? c : mine; }
        if (sum == G) break;
        __builtin_amdgcn_s_sleep(1);
        if ((++sp & 255u) == 0u) { if (xb_ld(&bar[XB_TMO])) break; if (sp > XB_SPIN_CAP) { atomicAdd(&bar[XB_TMO], 1u); break; } }
    }
    nloc = mine > 0u ? mine : 1u; nx = cnt > 0u ? cnt : 1u;
}
__device__ __forceinline__ void xcd_barrier(const XcdBarrier& b) {
    asm volatile("s_waitcnt vmcnt(0)" ::: "memory");
    __syncthreads();
    if (threadIdx.x == 0) {
        unsigned* bar = (unsigned*)uptr((const char*)b.bar);
        __builtin_amdgcn_s_waitcnt(0);
        unsigned nloc = b.st[0], nx = b.st[1];
        if (nloc == 0u) { xcd_barrier_complete(bar, b.x, nloc, nx); b.st[0] = nloc; b.st[1] = nx; }
        const unsigned old = xb_add(&bar[XB_XSUB(b.x)], 1u);
        const unsigned gen = old / nloc;
        if (old + 1u == (gen + 1u) * nloc) {
            __builtin_amdgcn_fence(__ATOMIC_RELEASE, "agent");
            asm volatile("s_waitcnt vmcnt(0)" ::: "memory");
            const unsigned og = xb_add(&bar[XB_TOP], 1u);
            const unsigned tg = og / nx;
            if (og + 1u == (tg + 1u) * nx) xb_add(&bar[XB_TOPGEN], 1u);
            else XB_SPIN(xb_ld(&bar[XB_TOPGEN]) == tg, bar);
            __builtin_amdgcn_fence(__ATOMIC_ACQUIRE, "agent");
            xb_add(&bar[XB_XGEN(b.x)], 1u);
            asm volatile("s_waitcnt vmcnt(0)" ::: "memory");
        } else {
            XB_SPIN(xb_ld(&bar[XB_XGEN(b.x)]) == gen, bar);
            __builtin_amdgcn_fence(__ATOMIC_ACQUIRE, "agent");
            asm volatile("s_waitcnt vmcnt(0)" ::: "memory");
        }
    }
    __syncthreads();
}

__device__ __forceinline__ int crow(int r, int hi) { return (r & 3) + 8 * (r >> 2) + 4 * hi; }
template <int KW> __device__ __forceinline__ int kswz(int row, int colB) { return KW == 128 ? row * 256 + (colB ^ ((row & 7) << 4)) : row * 128 + (colB ^ (((row >> 1) & 7) << 4)); }
template <int DV> __device__ __forceinline__ int v_st(int k, int c) { const int kk = (k & ~0xC) | ((k & 4) << 1) | ((k & 8) >> 1); return ((kk >> 3) * (DV / 32) + (c >> 5)) * 512 + ((kk & 7) * 32 + (c & 31)) * 2; }
__device__ __forceinline__ int v_rd_base(int lane) { return ((lane & 3) << 3) | (((lane >> 2) & 3) << 6) | (((lane >> 4) & 1) << 5) | (((lane >> 5) & 1) << 8); }
template <int OFF> __device__ __forceinline__ s16x4 tr_read(int vb) { s16x4 r; asm volatile("ds_read_b64_tr_b16 %0, %1 offset:%2" : "=&v"(r) : "v"(vb), "i"(OFF) : "memory"); return r; }
template <int DV, int D0> __device__ __forceinline__ void pv_one(f32x16& od, int vb, bf16x8 pa0, bf16x8 pa1, bf16x8 pa2, bf16x8 pa3) {
    constexpr int KS = (DV / 32) * 1024, HF = (DV / 32) * 512;
    const s16x4 l0 = tr_read<D0 * 512 + 0 * KS>(vb), h0 = tr_read<D0 * 512 + 0 * KS + HF>(vb), l1 = tr_read<D0 * 512 + 1 * KS>(vb), h1 = tr_read<D0 * 512 + 1 * KS + HF>(vb);
    const s16x4 l2 = tr_read<D0 * 512 + 2 * KS>(vb), h2 = tr_read<D0 * 512 + 2 * KS + HF>(vb), l3 = tr_read<D0 * 512 + 3 * KS>(vb), h3 = tr_read<D0 * 512 + 3 * KS + HF>(vb);
    asm volatile("s_waitcnt lgkmcnt(0)" ::: "memory"); SBAR();
#define PKV(L, H) (bf16x8){L[0], L[1], L[2], L[3], H[0], H[1], H[2], H[3]}
    od = __builtin_amdgcn_mfma_f32_32x32x16_bf16(pa0, PKV(l0, h0), od, 0, 0, 0);
    od = __builtin_amdgcn_mfma_f32_32x32x16_bf16(pa1, PKV(l1, h1), od, 0, 0, 0);
    od = __builtin_amdgcn_mfma_f32_32x32x16_bf16(pa2, PKV(l2, h2), od, 0, 0, 0);
    od = __builtin_amdgcn_mfma_f32_32x32x16_bf16(pa3, PKV(l3, h3), od, 0, 0, 0);
#undef PKV
}
#define PV_RD(D0, L, H) do { L[0] = tr_read<(D0) * 512 + 0 * KS>(vb); H[0] = tr_read<(D0) * 512 + 0 * KS + HF>(vb); L[1] = tr_read<(D0) * 512 + 1 * KS>(vb); H[1] = tr_read<(D0) * 512 + 1 * KS + HF>(vb); \
    L[2] = tr_read<(D0) * 512 + 2 * KS>(vb); H[2] = tr_read<(D0) * 512 + 2 * KS + HF>(vb); L[3] = tr_read<(D0) * 512 + 3 * KS>(vb); H[3] = tr_read<(D0) * 512 + 3 * KS + HF>(vb); } while (0)
#define PV_MM(od, L, H) do { od = __builtin_amdgcn_mfma_f32_32x32x16_bf16(pa0, PKV(L[0], H[0]), od, 0, 0, 0); od = __builtin_amdgcn_mfma_f32_32x32x16_bf16(pa1, PKV(L[1], H[1]), od, 0, 0, 0); \
    od = __builtin_amdgcn_mfma_f32_32x32x16_bf16(pa2, PKV(L[2], H[2]), od, 0, 0, 0); od = __builtin_amdgcn_mfma_f32_32x32x16_bf16(pa3, PKV(L[3], H[3]), od, 0, 0, 0); } while (0)
#define PKV(L, H) (bf16x8){L[0], L[1], L[2], L[3], H[0], H[1], H[2], H[3]}
template <int DV> __device__ __forceinline__ void pv_all(f32x16* o, int vb, bf16x8 pa0, bf16x8 pa1, bf16x8 pa2, bf16x8 pa3) {
    constexpr int KS = (DV / 32) * 1024, HF = (DV / 32) * 512;
    s16x4 la[4], ha[4], lb[4], hb[4];
    PV_RD(0, la, ha);
    PV_RD(1, lb, hb); asm volatile("s_waitcnt lgkmcnt(8)" ::: "memory"); SBAR(); PV_MM(o[0], la, ha);
    if constexpr (DV == 128) {
        PV_RD(2, la, ha); asm volatile("s_waitcnt lgkmcnt(8)" ::: "memory"); SBAR(); PV_MM(o[1], lb, hb);
        PV_RD(3, lb, hb); asm volatile("s_waitcnt lgkmcnt(8)" ::: "memory"); SBAR(); PV_MM(o[2], la, ha);
        asm volatile("s_waitcnt lgkmcnt(0)" ::: "memory"); SBAR(); PV_MM(o[3], lb, hb);
    } else {
        asm volatile("s_waitcnt lgkmcnt(0)" ::: "memory"); SBAR(); PV_MM(o[1], lb, hb);
    }
}
#undef PV_RD
#undef PV_MM
#undef PKV
template <int KW> __device__ __forceinline__ void qkt64(f32x16& p0, f32x16& p1, const char* Ks, const bf16x8* qr, int kcb, int r32, int hi) {
    bf16x8 kb0[4], kb1[4];
#pragma unroll
    for (int d0 = 0; d0 < 4; ++d0) { const int cb = kcb + (d0 * 16 + hi * 8) * 2;
        kb0[d0] = *reinterpret_cast<const bf16x8*>(Ks + kswz<KW>(r32, cb));
        kb1[d0] = *reinterpret_cast<const bf16x8*>(Ks + kswz<KW>(32 + r32, cb)); }
    p0 = f32x16{}; p1 = f32x16{};
#pragma unroll
    for (int d0 = 0; d0 < 4; ++d0) {
        p0 = __builtin_amdgcn_mfma_f32_32x32x16_bf16(kb0[d0], qr[d0], p0, 0, 0, 0);
        p1 = __builtin_amdgcn_mfma_f32_32x32x16_bf16(kb1[d0], qr[d0], p1, 0, 0, 0); }
}
template <int KW> __device__ __forceinline__ void qkt64n(f32x16& p0, f32x16& p1, const char* Ks, const bf16x8* qr, int kcb, int r32, int hi, const f32x16& cinit) {
#pragma unroll
    for (int d0 = 0; d0 < 4; ++d0) { const int cb = kcb + (d0 * 16 + hi * 8) * 2;
        const bf16x8 b0 = *reinterpret_cast<const bf16x8*>(Ks + kswz<KW>(r32, cb));
        const bf16x8 b1 = *reinterpret_cast<const bf16x8*>(Ks + kswz<KW>(32 + r32, cb));
        if (d0 == 0) { p0 = __builtin_amdgcn_mfma_f32_32x32x16_bf16(b0, qr[0], cinit, 0, 0, 0); p1 = __builtin_amdgcn_mfma_f32_32x32x16_bf16(b1, qr[0], cinit, 0, 0, 0); }
        else { p0 = __builtin_amdgcn_mfma_f32_32x32x16_bf16(b0, qr[d0], p0, 0, 0, 0); p1 = __builtin_amdgcn_mfma_f32_32x32x16_bf16(b1, qr[d0], p1, 0, 0, 0); } }
}
template <int ND> __device__ __forceinline__ void softmax_step(f32x16& p0, f32x16& p1, float& m_reg, float& l_reg, f32x16* o, float* al_l, int r32, int hi,
                                                              bf16x8& pa0, bf16x8& pa1, bf16x8& pa2, bf16x8& pa3) {
    float pmax = p0[0];
#pragma unroll
    for (int r = 1; r < 16; ++r) pmax = fmaxf(pmax, p0[r]);
#pragma unroll
    for (int r = 0; r < 16; ++r) pmax = fmaxf(pmax, p1[r]);
    { auto rr = __builtin_amdgcn_permlane32_swap(__float_as_uint(pmax), __float_as_uint(pmax), false, false); pmax = fmaxf(__uint_as_float(rr[0]), __uint_as_float(rr[1])); }
    const float mn = fmaxf(m_reg, pmax);
    const float alpha = __builtin_amdgcn_exp2f((m_reg - mn) * QK_C); m_reg = mn;
    const float mnC = -mn * QK_C;
#pragma unroll
    for (int r = 0; r < 16; ++r) { p0[r] = __builtin_amdgcn_exp2f(fmaf(p0[r], QK_C, mnC)); p1[r] = __builtin_amdgcn_exp2f(fmaf(p1[r], QK_C, mnC)); }
    float ps = 0.f;
#pragma unroll
    for (int r = 0; r < 16; ++r) ps += p0[r] + p1[r];
    { auto rr = __builtin_amdgcn_permlane32_swap(__float_as_uint(ps), __float_as_uint(ps), false, false); ps = __uint_as_float(rr[0]) + __uint_as_float(rr[1]); }
    l_reg = l_reg * alpha + ps;
    if (__any(alpha < 1.f)) { if (hi == 0) al_l[r32] = alpha; LDS_WAIT();
#pragma unroll
        for (int d = 0; d < ND; ++d)
#pragma unroll
            for (int r = 0; r < 16; ++r) o[d][r] *= al_l[crow(r, hi)];
    }
#define PK4(P, BASE, OUT) do { unsigned a0 = cvtpk(P[BASE + 0], P[BASE + 1]), a1 = cvtpk(P[BASE + 2], P[BASE + 3]);   \
    unsigned b0 = cvtpk(P[BASE + 4], P[BASE + 5]), b1 = cvtpk(P[BASE + 6], P[BASE + 7]);                              \
    auto r0 = __builtin_amdgcn_permlane32_swap(a0, b0, false, false); auto r1 = __builtin_amdgcn_permlane32_swap(a1, b1, false, false); \
    u32x4 w = {r0[0], r1[0], r0[1], r1[1]}; OUT = *reinterpret_cast<bf16x8*>(&w); } while (0)
    PK4(p0, 0, pa0); PK4(p0, 8, pa1); PK4(p1, 0, pa2); PK4(p1, 8, pa3);
#undef PK4
}

constexpr int AT_K = 0, AT_V = 16384, AT_WS = 32768, AT_XCH = 36864;

__device__ __forceinline__ void win_attn_unit(char* lds, const bf16_t* Z, bf16_t* Y, const float* sink, int b, int kvh, int qc, bool ctxq) {
    const int tid = opaque(threadIdx.x), wid = __builtin_amdgcn_readfirstlane(tid >> 6), lane = tid & 63, r32 = lane & 31, hi = lane >> 5;
    const int head = kvh * 4 + (wid >> 1), qsub = wid & 1;
    const int q0 = qc * 64;
    const size_t qrow0 = (ctxq ? (size_t)RL + b * CTX : (size_t)b * SEQ) + q0 + qsub * 32;
    float* wsf = (float*)(lds + AT_WS) + wid * 128; float* al_l = wsf; float* li_l = wsf + 32;
    bf16x8 qr[4];
    { const bf16_t* qp = Z + (qrow0 + r32) * MIXIN + 512 + head * 64 + hi * 8;
#pragma unroll
      for (int d0 = 0; d0 < 4; ++d0) qr[d0] = *reinterpret_cast<const bf16x8*>(qp + d0 * 16); }
    float m_reg = -1e30f, l_reg = 0.f; f32x16 o[2] = {};
    const int srow = tid >> 3, scol = (tid & 7) * 8;
    const int vb = (int)(uintptr_t)(lds + AT_V) + v_rd_base(lane);
    const int qrel = qsub * 32 + r32;
    const int NT = ctxq ? 4 : 9;
    for (int t = 0; t < NT; ++t) {
        size_t krow; int mode = 0;
        if (t < 4) krow = (size_t)RL + b * CTX + t * 64;
        else { const int p0 = q0 - 128 + (t - 4) * 64; if (p0 < 0 || p0 >= SEQ) continue; krow = (size_t)b * SEQ + p0; mode = (t == 4) ? 1 : (t == 8) ? 2 : 0; }
        __syncthreads();
        { const bf16_t* kp = Z + (krow + srow) * MIXIN + 1024 + kvh * 64 + scol;
          const bf16x8 kv = *reinterpret_cast<const bf16x8*>(kp), vv = *reinterpret_cast<const bf16x8*>(kp + 128);
          *reinterpret_cast<bf16x8*>(lds + AT_K + kswz<64>(srow, scol * 2)) = kv;
          *reinterpret_cast<bf16x8*>(lds + AT_V + v_st<64>(srow, scol)) = vv; }
        __syncthreads();
        f32x16 p0, p1; qkt64<64>(p0, p1, lds + AT_K, qr, 0, r32, hi);
        if (mode == 1) {
#pragma unroll
            for (int r = 0; r < 16; ++r) { const int kk = crow(r, hi); if (kk < qrel) p0[r] = -1e30f; if (kk + 32 < qrel) p1[r] = -1e30f; } }
        else if (mode == 2) {
#pragma unroll
            for (int r = 0; r < 16; ++r) { const int kk = crow(r, hi); if (kk > qrel) p0[r] = -1e30f; if (kk + 32 > qrel) p1[r] = -1e30f; } }
        bf16x8 pa0, pa1, pa2, pa3;
        softmax_step<2>(p0, p1, m_reg, l_reg, o, al_l, r32, hi, pa0, pa1, pa2, pa3);
        pv_one<64, 0>(o[0], vb, pa0, pa1, pa2, pa3); pv_one<64, 1>(o[1], vb, pa0, pa1, pa2, pa3);
    }
    l_reg += __builtin_amdgcn_exp2f(sink[head] * LOG2E - m_reg * QK_C);
    if (hi == 0) li_l[r32] = l_reg; LDS_WAIT();
    bf16_t* yp = Y + qrow0 * DM + 512 + head * 64;
#pragma unroll
    for (int r = 0; r < 16; ++r) { const int orow = crow(r, hi); const float rl = __builtin_amdgcn_rcpf(li_l[orow]);
#pragma unroll
        for (int d0 = 0; d0 < 2; ++d0) { const unsigned w = cvtpk(o[d0][r] * rl, 0.f); yp[(size_t)orow * DM + d0 * 32 + r32] = (bf16_t)(w & 0xffffu); } }
}

constexpr float DA_THR = 8.f;
constexpr float DA_THRL = DA_THR * LOG2E;
template <bool FIRST> __device__ __forceinline__ void da_partialSM(f32x16& p0, f32x16& p1, float& mhat, f32x16& negm, float& alpha) {
    float pmax = fmaxf(p0[0], p0[1]), pmb = fmaxf(p1[0], p1[1]);
#pragma unroll
    for (int r = 2; r < 16; r += 2) { pmax = fmaxf(fmaxf(pmax, p0[r]), p0[r + 1]); pmb = fmaxf(fmaxf(pmb, p1[r]), p1[r + 1]); }
    pmax = fmaxf(pmax, pmb);
    { auto rr = __builtin_amdgcn_permlane32_swap(__float_as_uint(pmax), __float_as_uint(pmax), false, false); pmax = fmaxf(__uint_as_float(rr[0]), __uint_as_float(rr[1])); }
    alpha = 1.f;
    if (FIRST || !__builtin_expect(__all(pmax <= DA_THRL), 1)) {
        const float dl = FIRST ? pmax : fmaxf(pmax, 0.f);
        mhat += dl; alpha = __builtin_amdgcn_exp2f(-dl);
#pragma unroll
        for (int r = 0; r < 16; ++r) { p0[r] -= dl; p1[r] -= dl; negm[r] = -mhat; }
    }
#pragma unroll
    for (int r = 0; r < 16; ++r) p0[r] = __builtin_amdgcn_exp2f(p0[r]);
}
__device__ __forceinline__ void da_finishSM(f32x16& p0, f32x16& p1, float alpha, float& l_reg, bf16x8& pa0, bf16x8& pa1, bf16x8& pa2, bf16x8& pa3) {
#pragma unroll
    for (int r = 0; r < 16; ++r) p1[r] = __builtin_amdgcn_exp2f(p1[r]);
    float s0 = p0[0], s1 = p0[1], s2 = p0[2], s3 = p0[3];
#pragma unroll
    for (int r = 4; r < 16; r += 4) { s0 += p0[r]; s1 += p0[r + 1]; s2 += p0[r + 2]; s3 += p0[r + 3]; }
#pragma unroll
    for (int r = 0; r < 16; r += 4) { s0 += p1[r]; s1 += p1[r + 1]; s2 += p1[r + 2]; s3 += p1[r + 3]; }
    float ps = (s0 + s1) + (s2 + s3);
    { auto rr = __builtin_amdgcn_permlane32_swap(__float_as_uint(ps), __float_as_uint(ps), false, false); ps = __uint_as_float(rr[0]) + __uint_as_float(rr[1]); }
    l_reg = l_reg * alpha + ps;
#define PK4(P, BASE, OUT) do { unsigned a0 = cvtpk(P[BASE + 0], P[BASE + 1]), a1 = cvtpk(P[BASE + 2], P[BASE + 3]);   \
    unsigned b0 = cvtpk(P[BASE + 4], P[BASE + 5]), b1 = cvtpk(P[BASE + 6], P[BASE + 7]);                              \
    auto r0 = __builtin_amdgcn_permlane32_swap(a0, b0, false, false); auto r1 = __builtin_amdgcn_permlane32_swap(a1, b1, false, false); \
    u32x4 w = {r0[0], r1[0], r0[1], r1[1]}; OUT = *reinterpret_cast<bf16x8*>(&w); } while (0)
    PK4(p0, 0, pa0); PK4(p0, 8, pa1); PK4(p1, 0, pa2); PK4(p1, 8, pa3);
#undef PK4
}
__device__ __forceinline__ void da_pv(f32x16* o, int vb, bf16x8 pa0, bf16x8 pa1, bf16x8 pa2, bf16x8 pa3) {
    pv_all<128>(o, vb, pa0, pa1, pa2, pa3);
}
constexpr int DA_V = 0, DA_K = 49152, DA_WS = 81920, DA_XCH = 0;
__device__ __forceinline__ void diff_attn_unit(char* lds, const bf16_t* QKV, bf16_t* O, const float* subg, float lam, float oscale, int b, int h, int qb, bool ctxq) {
    const int tid = opaque(threadIdx.x), wid = __builtin_amdgcn_readfirstlane(tid >> 6), lane = tid & 63, r32 = lane & 31, hi = lane >> 5;
    const int comp = wid >> 2, qsub = wid & 3;
    const size_t qrow0 = (ctxq ? (size_t)RL + b * CTX : (size_t)b * SEQ) + qb * 128 + qsub * 32;
    char* V_lds = lds + DA_V; char* K_lds = lds + DA_K;
    float* wsf = (float*)(lds + DA_WS) + wid * 128; float* al_l = wsf; float* li_l = wsf + 32;
    __syncthreads();
    bf16x8 qr[4];
    { const bf16_t* qp = QKV + (qrow0 + r32) * 3072 + (2 * h + comp) * 64 + hi * 8;
#pragma unroll
      for (int d0 = 0; d0 < 4; ++d0) qr[d0] = *reinterpret_cast<const bf16x8*>(qp + d0 * 16); }
    float m_reg = 0.f, l_reg = 0.f; f32x16 o[4] = {}; f32x16 negm = {};
    const int sr = tid >> 4, sc = (tid & 15) * 8, vst0 = v_st<128>(sr, sc), vst1 = v_st<128>(32 + sr, sc);
    const int vb0 = (int)(uintptr_t)V_lds + v_rd_base(lane);
    const int kcb = comp * 128;
    const bf16_t* kvp = QKV + (size_t)sr * 3072 + 1024 + h * 128 + sc;
    const size_t rowc = (size_t)RL + b * CTX, rowl = (size_t)b * SEQ;
    const int NT = ctxq ? 4 : 68;
    bf16x8 ks0, ks1, vs0, vs1;
#define KROW(t) ((t) < 4 ? rowc + (size_t)(t) * 64 : rowl + (size_t)((t) - 4) * 64)
#define LOADK(t) do { const bf16_t* p_ = kvp + KROW(t) * 3072; ks0 = *reinterpret_cast<const bf16x8*>(p_); ks1 = *reinterpret_cast<const bf16x8*>(p_ + 32 * 3072); } while (0)
#define LOADV(t) do { const bf16_t* p_ = kvp + KROW(t) * 3072 + 1024; vs0 = *reinterpret_cast<const bf16x8*>(p_); vs1 = *reinterpret_cast<const bf16x8*>(p_ + 32 * 3072); } while (0)
#define WRITEK(bf) do { *reinterpret_cast<bf16x8*>(K_lds + (bf) * 16384 + kswz<128>(sr, sc * 2)) = ks0; *reinterpret_cast<bf16x8*>(K_lds + (bf) * 16384 + kswz<128>(32 + sr, sc * 2)) = ks1; } while (0)
#define WRITEV(bf) do { *reinterpret_cast<bf16x8*>(V_lds + (bf) * 16384 + vst0) = vs0; *reinterpret_cast<bf16x8*>(V_lds + (bf) * 16384 + vst1) = vs1; } while (0)
#define RESC(a) do { if (__any((a) < 1.f)) { if (hi == 0) al_l[r32] = (a); LDS_WAIT(); \
    _Pragma("unroll") for (int d = 0; d < 4; ++d) _Pragma("unroll") for (int r = 0; r < 16; ++r) o[d][r] *= al_l[crow(r, hi)]; } } while (0)
#define QKT(P0, P1, kb) do { SBAR(); qkt64n<128>(P0, P1, K_lds + (kb) * 16384, qr, kcb, r32, hi, negm); } while (0)
#define FIN(P0, P1, al) do { da_finishSM(P0, P1, al, l_reg, pa0, pa1, pa2, pa3); SBAR(); } while (0)
#define PVT(vi) da_pv(o, vb0 + (vi) * 16384, pa0, pa1, pa2, pa3)
    f32x16 pA0, pA1, pB0, pB1; float alA = 1.f, alB = 1.f; bf16x8 pa0, pa1, pa2, pa3;
    int vm2 = 1, vm1 = 2, vc = 0;
#define VROT() do { const int t_ = vm2; vm2 = vm1; vm1 = vc; vc = t_; } while (0)
    const bool grpB = comp != 0;
    LOADK(0); VM_WAIT(); WRITEK(0); LOADK(1); LOADV(0); __syncthreads();
    QKT(pA0, pA1, 0);
    if (!grpB) da_partialSM<true>(pA0, pA1, m_reg, negm, alA);
    VM_WAIT(); WRITEK(1); WRITEV(vc); LOADK(2); LOADV(1); VROT();
    __syncthreads();
    if (grpB) da_partialSM<true>(pA0, pA1, m_reg, negm, alA);
    QKT(pB0, pB1, 1); FIN(pA0, pA1, alA);
    if (!grpB) { PVT(vm1); da_partialSM<false>(pB0, pB1, m_reg, negm, alB); RESC(alB); }
    VM_WAIT(); WRITEK(0); WRITEV(vc); LOADK(3); LOADV(2); VROT();
    __syncthreads();
    for (int j = 2; j + 1 < NT; j += 2) {
        if (grpB) { PVT(vm2); da_partialSM<false>(pB0, pB1, m_reg, negm, alB); RESC(alB); }
        QKT(pA0, pA1, 0); FIN(pB0, pB1, alB);
        if (!grpB) { PVT(vm1); da_partialSM<false>(pA0, pA1, m_reg, negm, alA); RESC(alA); }
        VM_WAIT(); WRITEK(1); WRITEV(vc); if (j + 2 < NT) LOADK(j + 2); LOADV(j + 1); VROT();
        __syncthreads();
        if (grpB) { PVT(vm2); da_partialSM<false>(pA0, pA1, m_reg, negm, alA); RESC(alA); }
        QKT(pB0, pB1, 1); FIN(pA0, pA1, alA);
        if (!grpB) { PVT(vm1); da_partialSM<false>(pB0, pB1, m_reg, negm, alB); RESC(alB); }
        VM_WAIT(); if (j + 2 < NT) { WRITEK(0); } WRITEV(vc); if (j + 3 < NT) LOADK(j + 3); if (j + 2 < NT) LOADV(j + 2); VROT();
        __syncthreads();
    }
    if (grpB) { PVT(vm2); da_partialSM<false>(pB0, pB1, m_reg, negm, alB); RESC(alB); }
    FIN(pB0, pB1, alB); PVT(vm1);
#undef LOADK
#undef LOADV
#undef WRITEK
#undef WRITEV
#undef QKT
#undef FIN
#undef PVT
#undef VROT
#define SLOAD(a, b)
#define SWRITE(a, b)
#define SWAIT()
#undef KROW
#undef SLOAD
#undef SWRITE
#undef SWAIT
#undef RESC
    if (hi == 0) li_l[r32] = l_reg; LDS_WAIT();
    float rl[16];
#pragma unroll
    for (int r = 0; r < 16; ++r) rl[r] = __builtin_amdgcn_rcpf(li_l[crow(r, hi)]);
    __syncthreads();
    float* xch = (float*)(lds + DA_XCH) + qsub * (32 * 132);
    if (comp == 1) {
#pragma unroll
        for (int d0 = 0; d0 < 4; ++d0)
#pragma unroll
            for (int r = 0; r < 16; ++r) xch[crow(r, hi) * 132 + d0 * 32 + r32] = o[d0][r] * rl[r];
    }
    __syncthreads();
    if (comp == 0) {
#pragma unroll
        for (int d0 = 0; d0 < 4; ++d0)
#pragma unroll
            for (int r = 0; r < 16; ++r) { const int idx = crow(r, hi) * 132 + d0 * 32 + r32; const float v = o[d0][r] * rl[r] - lam * xch[idx]; xch[idx] = v; }
        LDS_WAIT();
        const int row = lane >> 1, hf = lane & 1; const float* rp = xch + row * 132 + hf * 64;
        f32x4 v[16]; float ss = 0.f;
#pragma unroll
        for (int j = 0; j < 16; ++j) { v[j] = *reinterpret_cast<const f32x4*>(rp + 4 * j); ss += v[j][0] * v[j][0] + v[j][1] * v[j][1] + v[j][2] * v[j][2] + v[j][3] * v[j][3]; }
        ss += __int_as_float(__builtin_amdgcn_ds_bpermute((lane ^ 1) << 2, __float_as_int(ss)));
        const float rs = __builtin_amdgcn_rsqf(ss * (1.f / 128.f) + EPS) * oscale;
        bf16_t* op = O + (qrow0 + row) * DM + h * 128 + hf * 64;
#pragma unroll
        for (int j = 0; j < 16; j += 2) { const f32x4 g0 = *reinterpret_cast<const f32x4*>(subg + hf * 64 + 4 * j), g1 = *reinterpret_cast<const f32x4*>(subg + hf * 64 + 4 * j + 4);
            const f32x4 a = v[j] * g0 * rs, c = v[j + 1] * g1 * rs;
            u32x4 w; w.x = cvtpk(a[0], a[1]); w.y = cvtpk(a[2], a[3]); w.z = cvtpk(c[0], c[1]); w.w = cvtpk(c[2], c[3]);
            *reinterpret_cast<u32x4*>(op + 4 * j) = w; }
    }
}

constexpr int WA_V = 0, WA_K = 16384, WA_WS = 32768, WA_ST = 36864;
__device__ __forceinline__ void wa_mask(f32x16& p0, f32x16& p1, int mode, int qrel, int hi) {
    if (mode == 1) {
#pragma unroll
        for (int r = 0; r < 16; ++r) { const int kk = crow(r, hi); if (kk < qrel) p0[r] = -1e30f; if (kk + 32 < qrel) p1[r] = -1e30f; } }
    else if (mode == 2) {
#pragma unroll
        for (int r = 0; r < 16; ++r) { const int kk = crow(r, hi); if (kk > qrel) p0[r] = -1e30f; if (kk + 32 > qrel) p1[r] = -1e30f; } }
    else if (mode == 3) {
#pragma unroll
        for (int r = 0; r < 16; ++r) { p0[r] = -1e30f; p1[r] = -1e30f; } }
}
__device__ __forceinline__ void win_attn_unit2(char* lds, const bf16_t* Z, bf16_t* Y, const float* sink, int b, int kvh, int qc, bool ctxq) {
    const int tid = opaque(threadIdx.x), wid = __builtin_amdgcn_readfirstlane(tid >> 6), lane = tid & 63, r32 = lane & 31, hi = lane >> 5;
    const int head = kvh * 4 + (wid >> 1), qsub = wid & 1, q0 = qc * 64;
    const size_t rowc = (size_t)RL + b * CTX, rowl = (size_t)b * SEQ;
    const size_t qrow0 = (ctxq ? rowc : rowl) + q0 + qsub * 32;
    char* V_lds = lds + WA_V; char* K_lds = lds + WA_K;
    float* wsf = (float*)(lds + WA_WS) + wid * 128; float* al_l = wsf; float* li_l = wsf + 32;
    __syncthreads();
    bf16x8 qr[4];
    { const bf16_t* qp = Z + (qrow0 + r32) * MIXIN + 512 + head * 64 + hi * 8;
#pragma unroll
      for (int d0 = 0; d0 < 4; ++d0) qr[d0] = *reinterpret_cast<const bf16x8*>(qp + d0 * 16); }
    float m_reg = 0.f, l_reg = 0.f; f32x16 o[2] = {}; f32x16 negm = {};
    const int srow = tid >> 3, scol = (tid & 7) * 8, vst = v_st<64>(srow, scol), kst = kswz<64>(srow, scol * 2);
    const int vb0 = (int)(uintptr_t)V_lds + v_rd_base(lane);
    const bf16_t* kvp = Z + (size_t)srow * MIXIN + 1024 + kvh * 64 + scol;
    const int skip_lo = ctxq ? 0 : (q0 == 0 ? 2 : q0 == 64 ? 1 : 0);
    const int nloc = ctxq ? 0 : 5 - skip_lo - (q0 == SEQ - 64 ? 2 : q0 == SEQ - 128 ? 1 : 0);
    const int NTr = 4 + nloc, NT = (NTr + 1) & ~1;
    const int qrel = qsub * 32 + r32;
    struct { bf16x8 vs, ks; } sr_;
#define KROW(t) ((t) < 4 ? rowc + (size_t)(t) * 64 : (t) < NTr ? rowl + (size_t)(q0 - 128 + ((t) - 4 + skip_lo) * 64) : rowc)
#define TMODE(t) ((t) < 4 ? 0 : (t) >= NTr ? 3 : ((t) - 4 + skip_lo) == 0 ? 1 : ((t) - 4 + skip_lo) == 4 ? 2 : 0)
#define SLOAD(t) do { const bf16_t* p_ = kvp + KROW(t) * MIXIN; sr_.ks = *reinterpret_cast<const bf16x8*>(p_); sr_.vs = *reinterpret_cast<const bf16x8*>(p_ + 128); } while (0)
#define SWRITE(bf) do { *reinterpret_cast<bf16x8*>(V_lds + (bf) * 8192 + vst) = sr_.vs; *reinterpret_cast<bf16x8*>(K_lds + (bf) * 8192 + kst) = sr_.ks; } while (0)
#define SWAIT() asm volatile("s_waitcnt vmcnt(0)" ::: "memory")
#define RESC(a) do { if (__any((a) < 1.f)) { if (hi == 0) al_l[r32] = (a); LDS_WAIT(); \
    _Pragma("unroll") for (int d = 0; d < 2; ++d) _Pragma("unroll") for (int r = 0; r < 16; ++r) o[d][r] *= al_l[crow(r, hi)]; } } while (0)
#define WPV(vb) pv_all<64>(o, (vb), pa0, pa1, pa2, pa3)
    f32x16 pA0, pA1, pB0, pB1; float alA, alB; bf16x8 pa0, pa1, pa2, pa3;
    SLOAD(0); VM_WAIT(); SWRITE(0); __syncthreads();
    qkt64n<64>(pA0, pA1, K_lds, qr, 0, r32, hi, negm); da_partialSM<true>(pA0, pA1, m_reg, negm, alA);
    SLOAD(1);
    SWAIT(); SWRITE(1); __syncthreads();
    for (int j = 1; j + 1 < NT; j += 2) {
        SBAR(); qkt64n<64>(pB0, pB1, K_lds + 8192, qr, 0, r32, hi, negm);
        da_finishSM(pA0, pA1, alA, l_reg, pa0, pa1, pa2, pa3); SBAR();
        SLOAD(j + 1); SBAR();
        WPV(vb0); wa_mask(pB0, pB1, TMODE(j), qrel, hi); da_partialSM<false>(pB0, pB1, m_reg, negm, alB);
        __syncthreads(); SWAIT(); SWRITE(0);
        RESC(alB); __syncthreads();
        SBAR(); qkt64n<64>(pA0, pA1, K_lds, qr, 0, r32, hi, negm);
        da_finishSM(pB0, pB1, alB, l_reg, pa0, pa1, pa2, pa3); SBAR();
        SLOAD(j + 2); SBAR();
        WPV(vb0 + 8192); wa_mask(pA0, pA1, TMODE(j + 1), qrel, hi); da_partialSM<false>(pA0, pA1, m_reg, negm, alA);
        __syncthreads(); SWAIT(); SWRITE(1);
        RESC(alA); __syncthreads();
    }
    SBAR(); qkt64n<64>(pB0, pB1, K_lds + 8192, qr, 0, r32, hi, negm);
    da_finishSM(pA0, pA1, alA, l_reg, pa0, pa1, pa2, pa3); SBAR();
    WPV(vb0); wa_mask(pB0, pB1, TMODE(NT - 1), qrel, hi); da_partialSM<false>(pB0, pB1, m_reg, negm, alB);
    __syncthreads(); RESC(alB);
    da_finishSM(pB0, pB1, alB, l_reg, pa0, pa1, pa2, pa3); SBAR();
    WPV(vb0 + 8192);
#undef KROW
#undef TMODE
#undef SLOAD
#undef SWRITE
#undef SWAIT
#undef RESC
#undef WPV
    l_reg += __builtin_amdgcn_exp2f(sink[head] * LOG2E - m_reg);
    if (hi == 0) li_l[r32] = l_reg; LDS_WAIT();
    bf16_t* stg = (bf16_t*)(lds + WA_ST) + wid * 2048;
#pragma unroll
    for (int r = 0; r < 16; ++r) { const int orow = crow(r, hi); const float rl = __builtin_amdgcn_rcpf(li_l[orow]);
#pragma unroll
        for (int d0 = 0; d0 < 2; ++d0) stg[orow * 64 + d0 * 32 + r32] = (bf16_t)(cvtpk(o[d0][r] * rl, 0.f) & 0xffffu); }
    LDS_WAIT();
    bf16_t* yp = Y + qrow0 * DM + 512 + head * 64;
#pragma unroll
    for (int i = 0; i < 4; ++i) { const int row = i * 8 + (lane >> 3), ch = lane & 7; const u32x4 v = *reinterpret_cast<const u32x4*>(stg + row * 64 + ch * 8); *reinterpret_cast<u32x4*>(yp + (size_t)row * DM + ch * 8) = v; }
}

struct Args {
    const float *x, *c, *ctx, *c_ctx, *ada_w, *ada_b, *norm_g, *mix_in_w, *mix_out_w, *win_sink, *diff_qkv_w, *diff_out_w, *diff_lambda, *diff_subln_g,
                *ffn_in_w, *ffn_out_w, *router_w, *expert_in_w, *expert_out_w;
    float* out; unsigned char* ws; int ph_lo, ph_hi;
};
struct Frame {
    LAS unsigned char* lds; unsigned char* ldsg; volatile LAS unsigned* MISC; unsigned* ctl;
    int tid, lane, wave, vcu, G;
};

__device__ __forceinline__ unsigned f2bf(float f) { unsigned u = __builtin_bit_cast(unsigned, f); return (u + 0x7fffu + ((u >> 16) & 1u)) >> 16; }
__device__ __forceinline__ unsigned pk2(float lo, float hi) { return f2bf(lo) | (f2bf(hi) << 16); }
__device__ __forceinline__ void transpose_item(const float* W, int K, int N, bf16_t* WT, int n0, int c0, int k0, LAS float* scr, int lane) {
#pragma unroll 8
    for (int i = 0; i < 32; ++i) { const int kk = 2 * i + (lane >> 5); scr[kk * 33 + (lane & 31)] = W[(size_t)(k0 + kk) * N + c0 + (lane & 31)]; }
    LDS_WAIT(); asm volatile("" ::: "memory");
    const int c = lane & 7;
#pragma unroll
    for (int j = 0; j < 4; ++j) { const int n = (lane >> 3) + 8 * j; const LAS float* s = scr + (8 * c) * 33 + n;
        u32x4 o; o.x = pk2(s[0 * 33], s[1 * 33]); o.y = pk2(s[2 * 33], s[3 * 33]); o.z = pk2(s[4 * 33], s[5 * 33]); o.w = pk2(s[6 * 33], s[7 * 33]);
        *(u32x4*)(WT + (size_t)(n0 + n) * K + k0 + 8 * c) = o; }
    LDS_WAIT(); asm volatile("" ::: "memory");
}
__device__ __forceinline__ void transpose_item_f8(const float* W, int K, int N, unsigned char* WT, int n0, int c0, int k0, LAS float* scr, int lane) {
#pragma unroll 8
    for (int i = 0; i < 32; ++i) { const int kk = 2 * i + (lane >> 5); scr[kk * 33 + (lane & 31)] = W[(size_t)(k0 + kk) * N + c0 + (lane & 31)] * F8_SW; }
    LDS_WAIT(); asm volatile("" ::: "memory");
    const int c = lane & 7;
#pragma unroll
    for (int j = 0; j < 4; ++j) { const int n = (lane >> 3) + 8 * j; const LAS float* s = scr + (8 * c) * 33 + n;
        u32x2 o; o.x = pk4_fp8(s[0 * 33], s[1 * 33], s[2 * 33], s[3 * 33]); o.y = pk4_fp8(s[4 * 33], s[5 * 33], s[6 * 33], s[7 * 33]);
        *(u32x2*)(WT + (size_t)(n0 + n) * K + k0 + 8 * c) = o; }
    LDS_WAIT(); asm volatile("" ::: "memory");
}
__device__ __forceinline__ bool transpose_job(int& r, const float* W, int nb, int K, int N, void* WT, bool glu, bool f8, LAS float* scr, int lane) {
    const int nblk = N / 32, per = (K / 64) * nblk, tot = nb * per;
    if (r >= tot) { r -= tot; return false; }
    const int mtx = r / per, it = r % per, kb = it / nblk, nbk = it % nblk, n0 = 32 * nbk;
    int c0 = n0;
    if (glu) { const int tile = n0 >> 8, w = n0 & 255; c0 = (w < 128) ? tile * 128 + w : (N >> 1) + tile * 128 + (w - 128); }
    if (f8) transpose_item_f8(W + (size_t)mtx * K * N, K, N, (unsigned char*)WT + (size_t)mtx * K * N, n0, c0, 64 * kb, scr, lane);
    else transpose_item(W + (size_t)mtx * K * N, K, N, (bf16_t*)WT + (size_t)mtx * K * N, n0, c0, 64 * kb, scr, lane);
    return true;
}

struct ThinP {
    int nrows;
    const void* xin_lat; const void* xin_ctx;
    void* xout_lat; void* xout_ctx;
    bool xin16, xout16;
    int ymode;
    const bf16_t* Ysrc; const float* gate; const float* ga;
    bool h8;
    bf16_t* H; const float* gb; const float* shsc;
    const float* router; int* route; unsigned* cnt;
    unsigned char* HSv;
};
#define TH_DECL(PFX) f32x4 PFX##x0 = {}, PFX##x1 = {}, PFX##x2 = {}, PFX##x3 = {}; u32x2 PFX##xh0 = {}, PFX##xh1 = {}, PFX##xh2 = {}, PFX##xh3 = {}; u32x2 PFX##ya0 = {}, PFX##ya1 = {}, PFX##ya2 = {}, PFX##ya3 = {}, PFX##yb0 = {}, PFX##yb1 = {}, PFX##yb2 = {}, PFX##yb3 = {}; float PFX##w0 = 0.f, PFX##w1 = 0.f
#define TH_LOAD(PFX, r_, it_) do { const int rr_ = (r_); \
    if (P.xin16) { const bf16_t* xr_ = (rr_ < RL ? (const bf16_t*)P.xin_lat + (size_t)rr_ * DM : (const bf16_t*)P.xin_ctx + (size_t)(rr_ - RL) * DM) + 4 * lane; \
        PFX##xh0 = __builtin_nontemporal_load(reinterpret_cast<const u32x2*>(xr_)); PFX##xh1 = __builtin_nontemporal_load(reinterpret_cast<const u32x2*>(xr_ + 256)); PFX##xh2 = __builtin_nontemporal_load(reinterpret_cast<const u32x2*>(xr_ + 512)); PFX##xh3 = __builtin_nontemporal_load(reinterpret_cast<const u32x2*>(xr_ + 768)); } \
    else { const float* xr_ = (rr_ < RL ? (const float*)P.xin_lat + (size_t)rr_ * DM : (const float*)P.xin_ctx + (size_t)(rr_ - RL) * DM) + 4 * lane; \
        PFX##x0 = __builtin_nontemporal_load(reinterpret_cast<const f32x4*>(xr_)); PFX##x1 = __builtin_nontemporal_load(reinterpret_cast<const f32x4*>(xr_ + 256)); PFX##x2 = __builtin_nontemporal_load(reinterpret_cast<const f32x4*>(xr_ + 512)); PFX##x3 = __builtin_nontemporal_load(reinterpret_cast<const f32x4*>(xr_ + 768)); } \
    const bf16_t* ya_ = P.Ysrc; const bf16_t* yb_ = P.Ysrc; \
    if (P.ymode == 1) ya_ = P.Ysrc + (size_t)rr_ * DM; \
    else if (P.ymode == 2) { const LAS int* rt_ = rtl + (it_) * 6; \
        const int e0_ = rt_[0], p0_ = rt_[1], e1_ = rt_[2], p1_ = rt_[3]; PFX##w0 = __int_as_float(rt_[4]); PFX##w1 = __int_as_float(rt_[5]); \
        const unsigned b0_ = e0_ == 0 ? 0u : e0_ == 1 ? cb1 : e0_ == 2 ? cb2 : e0_ == 3 ? cb3 : e0_ == 4 ? cb4 : e0_ == 5 ? cb5 : e0_ == 6 ? cb6 : cb7; \
        const unsigned b1_ = e1_ == 0 ? 0u : e1_ == 1 ? cb1 : e1_ == 2 ? cb2 : e1_ == 3 ? cb3 : e1_ == 4 ? cb4 : e1_ == 5 ? cb5 : e1_ == 6 ? cb6 : cb7; \
        ya_ = P.Ysrc + (size_t)(b0_ + p0_) * DM; yb_ = P.Ysrc + (size_t)(b1_ + p1_) * DM; } \
    if (P.ymode) { ya_ += 4 * lane; PFX##ya0 = __builtin_nontemporal_load(reinterpret_cast<const u32x2*>(ya_)); PFX##ya1 = __builtin_nontemporal_load(reinterpret_cast<const u32x2*>(ya_ + 256)); PFX##ya2 = __builtin_nontemporal_load(reinterpret_cast<const u32x2*>(ya_ + 512)); PFX##ya3 = __builtin_nontemporal_load(reinterpret_cast<const u32x2*>(ya_ + 768)); } \
    if (P.ymode == 2) { yb_ += 4 * lane; PFX##yb0 = __builtin_nontemporal_load(reinterpret_cast<const u32x2*>(yb_)); PFX##yb1 = __builtin_nontemporal_load(reinterpret_cast<const u32x2*>(yb_ + 256)); PFX##yb2 = __builtin_nontemporal_load(reinterpret_cast<const u32x2*>(yb_ + 512)); PFX##yb3 = __builtin_nontemporal_load(reinterpret_cast<const u32x2*>(yb_ + 768)); } \
    } while (0)
#define TH_ARGS(PFX) PFX##x0, PFX##x1, PFX##x2, PFX##x3, PFX##xh0, PFX##xh1, PFX##xh2, PFX##xh3, PFX##ya0, PFX##ya1, PFX##ya2, PFX##ya3, PFX##yb0, PFX##yb1, PFX##yb2, PFX##yb3, PFX##w0, PFX##w1
__device__ __forceinline__ void thin_proc(const ThinP& P, f32x4 x0, f32x4 x1, f32x4 x2, f32x4 x3, u32x2 xh0, u32x2 xh1, u32x2 xh2, u32x2 xh3, u32x2 ya0, u32x2 ya1, u32x2 ya2, u32x2 ya3, u32x2 yb0, u32x2 yb1, u32x2 yb2, u32x2 yb3, float yw0, float yw1,
                                          f32x4 GA0, f32x4 GA1, f32x4 GA2, f32x4 GA3, f32x4 GB0, f32x4 GB1, f32x4 GB2, f32x4 GB3, f32x4 SH0, f32x4 SH1, f32x4 SH2, f32x4 SH3,
                                          int r, int li, int lane, LAS float* rwT, LAS int* rec, LAS unsigned* lcnt) {
    const int idx = r < RL ? (r >> 12) : 8;
#define BF4(w) ((f32x4){bf_lo((w).x), bf_hi((w).x), bf_lo((w).y), bf_hi((w).y)})
    f32x4 xv[4] = {x0, x1, x2, x3};
    if (P.xin16) { xv[0] = BF4(xh0); xv[1] = BF4(xh1); xv[2] = BF4(xh2); xv[3] = BF4(xh3); }
    if (P.ymode) {
        f32x4 yv[4];
        if (P.ymode == 1) { yv[0] = BF4(ya0); yv[1] = BF4(ya1); yv[2] = BF4(ya2); yv[3] = BF4(ya3); }
        else { yv[0] = BF4(ya0) * yw0 + BF4(yb0) * yw1; yv[1] = BF4(ya1) * yw0 + BF4(yb1) * yw1; yv[2] = BF4(ya2) * yw0 + BF4(yb2) * yw1; yv[3] = BF4(ya3) * yw0 + BF4(yb3) * yw1; }
#undef BF4
        float ss = 0.f;
#pragma unroll
        for (int j = 0; j < 4; ++j) ss += yv[j][0] * yv[j][0] + yv[j][1] * yv[j][1] + yv[j][2] * yv[j][2] + yv[j][3] * yv[j][3];
        const float rs = __builtin_amdgcn_rsqf(wave_sum(ss, lane) * (1.f / DM) + EPS);
        xv[0] = xv[0] + GA0 * (yv[0] * rs); xv[1] = xv[1] + GA1 * (yv[1] * rs); xv[2] = xv[2] + GA2 * (yv[2] * rs); xv[3] = xv[3] + GA3 * (yv[3] * rs);
    }
    if (P.xout_lat) {
        if (P.xout16) { bf16_t* xo = r < RL ? (bf16_t*)P.xout_lat + (size_t)r * DM : (bf16_t*)P.xout_ctx + (size_t)(r - RL) * DM;
#pragma unroll
            for (int j = 0; j < 4; ++j) { u32x2 w; w.x = cvtpk(xv[j][0], xv[j][1]); w.y = cvtpk(xv[j][2], xv[j][3]); __builtin_nontemporal_store(w, reinterpret_cast<u32x2*>(xo + 4 * lane + 256 * j)); } }
        else { float* xo = r < RL ? (float*)P.xout_lat + (size_t)r * DM : (float*)P.xout_ctx + (size_t)(r - RL) * DM;
#pragma unroll
            for (int j = 0; j < 4; ++j) __builtin_nontemporal_store(xv[j], reinterpret_cast<f32x4*>(xo + 4 * lane + 256 * j)); } }
    if (P.H) {
        float ss = 0.f;
#pragma unroll
        for (int j = 0; j < 4; ++j) ss += xv[j][0] * xv[j][0] + xv[j][1] * xv[j][1] + xv[j][2] * xv[j][2] + xv[j][3] * xv[j][3];
        const float rs = __builtin_amdgcn_rsqf(wave_sum(ss, lane) * (1.f / DM) + EPS);
        bf16_t* hr = P.H + (size_t)r * DM;
        f32x4 hv[4] = {xv[0] * rs * GB0 + SH0, xv[1] * rs * GB1 + SH1, xv[2] * rs * GB2 + SH2, xv[3] * rs * GB3 + SH3};
#pragma unroll
        for (int j = 0; j < 4; ++j) {
            if (P.h8) { *reinterpret_cast<unsigned*>((unsigned char*)P.H + (size_t)r * DM + 4 * lane + 256 * j) = pk4_fp8(hv[j][0] * F8_SH, hv[j][1] * F8_SH, hv[j][2] * F8_SH, hv[j][3] * F8_SH); }
            else { u32x2 w; w.x = cvtpk(hv[j][0], hv[j][1]); w.y = cvtpk(hv[j][2], hv[j][3]); *reinterpret_cast<u32x2*>(hr + 4 * lane + 256 * j) = w; } }
        if (P.router) {
            float lg[8];
#pragma unroll
            for (int e = 0; e < 8; ++e) { float a = 0.f;
#pragma unroll
                for (int j = 0; j < 4; ++j) { const f32x4 w = *reinterpret_cast<const LAS f32x4*>(rwT + e * 1024 + 4 * lane + 256 * j); a += hv[j][0] * w[0] + hv[j][1] * w[1] + hv[j][2] * w[2] + hv[j][3] * w[3]; }
                lg[e] = wave_sum(a, lane); }
            int i0 = 0; float v0 = lg[0];
#pragma unroll
            for (int e = 1; e < 8; ++e) if (lg[e] > v0) { v0 = lg[e]; i0 = e; }
            int i1 = -1; float v1 = -3.4e38f;
#pragma unroll
            for (int e = 0; e < 8; ++e) if (e != i0 && lg[e] > v1) { v1 = lg[e]; i1 = e; }
            const float w0 = 1.f / (1.f + __expf(v1 - v0)), w1 = 1.f - w0;
            if (lane == 0) { const unsigned lp0 = __hip_atomic_fetch_add(lcnt + i0, 1u, __ATOMIC_RELAXED, __HIP_MEMORY_SCOPE_WORKGROUP), lp1 = __hip_atomic_fetch_add(lcnt + i1, 1u, __ATOMIC_RELAXED, __HIP_MEMORY_SCOPE_WORKGROUP);
                LAS int* rc = rec + li * 6; rc[0] = i0; rc[1] = (int)lp0; rc[2] = i1; rc[3] = (int)lp1; rc[4] = __float_as_int(w0); rc[5] = __float_as_int(w1); }
        }
    }
}
__device__ __forceinline__ void thin_phase(Frame& F, const ThinP& P) {
    const int lane = opaque(F.lane);
    const int nlat = P.nrows < RL ? P.nrows : RL, nctx = P.nrows - nlat;
    const int chL = (nlat + F.G - 1) / F.G, chC = (nctx + F.G - 1) / F.G;
    const int r0L = F.vcu * chL, r0C = F.vcu * chC;
    const int nl = r0L >= nlat ? 0 : (r0L + chL <= nlat ? chL : nlat - r0L), nc = r0C >= nctx ? 0 : (r0C + chC <= nctx ? chC : nctx - r0C), nrw = nl + nc;
#define TROW(li_) ((li_) < nl ? r0L + (li_) : RL + r0C + ((li_) - nl))
    LAS float* rwT = (LAS float*)F.lds;
    LAS int* rec = (LAS int*)(F.lds + 32768);
    LAS unsigned* lcnt = (LAS unsigned*)(F.lds + 65536);
    unsigned cb1 = 0, cb2 = 0, cb3 = 0, cb4 = 0, cb5 = 0, cb6 = 0, cb7 = 0;
    if (P.ymode == 2) { unsigned a = 0;
        a += (xb_ld(P.cnt + 0) + 255u) & ~255u; cb1 = a; a += (xb_ld(P.cnt + 1) + 255u) & ~255u; cb2 = a; a += (xb_ld(P.cnt + 2) + 255u) & ~255u; cb3 = a;
        a += (xb_ld(P.cnt + 3) + 255u) & ~255u; cb4 = a; a += (xb_ld(P.cnt + 4) + 255u) & ~255u; cb5 = a; a += (xb_ld(P.cnt + 5) + 255u) & ~255u; cb6 = a;
        a += (xb_ld(P.cnt + 6) + 255u) & ~255u; cb7 = a; }
    if (P.router) {
        for (int i = F.tid; i < 8192; i += 512) { const int col = i >> 3, e = i & 7; rwT[e * 1024 + col] = P.router[i]; }
        if (F.tid < 16) lcnt[F.tid] = 0u;
        __syncthreads();
    }
    LAS int* rtl = (LAS int*)(F.lds + 98304) + F.wave * 6 * 64;
    if (P.ymode == 2) { const int li_ = F.wave + 8 * lane;
        if (li_ < nrw) { const int* rt = P.route + (size_t)TROW(li_) * 8; const u32x4 a = *reinterpret_cast<const u32x4*>(rt); const u32x2 b = *reinterpret_cast<const u32x2*>(rt + 4);
            LAS int* d = rtl + lane * 6; d[0] = (int)a.x; d[1] = (int)a.y; d[2] = (int)a.z; d[3] = (int)a.w; d[4] = (int)b.x; d[5] = (int)b.y; }
        LDS_WAIT(); }
    f32x4 GA0 = {}, GA1 = {}, GA2 = {}, GA3 = {}, GB0 = {}, GB1 = {}, GB2 = {}, GB3 = {}, SH0 = {}, SH1 = {}, SH2 = {}, SH3 = {}; int cur_idx = -1;
#define TH_VEC(r_) do { const int ix_ = (r_) < RL ? ((r_) >> 12) : 8; if (ix_ != cur_idx) { cur_idx = ix_; \
        if (P.ymode) { const float* gt_ = P.gate + (size_t)ix_ * 6144 + 4 * lane; const float* ga_ = P.ga + 4 * lane; \
            GA0 = *reinterpret_cast<const f32x4*>(gt_) * *reinterpret_cast<const f32x4*>(ga_); GA1 = *reinterpret_cast<const f32x4*>(gt_ + 256) * *reinterpret_cast<const f32x4*>(ga_ + 256); \
            GA2 = *reinterpret_cast<const f32x4*>(gt_ + 512) * *reinterpret_cast<const f32x4*>(ga_ + 512); GA3 = *reinterpret_cast<const f32x4*>(gt_ + 768) * *reinterpret_cast<const f32x4*>(ga_ + 768); } \
        if (P.H) { const float* sh_ = P.shsc + (size_t)ix_ * 6144 + 4 * lane; const float* gb_ = P.gb + 4 * lane; \
            GB0 = *reinterpret_cast<const f32x4*>(gb_) * (*reinterpret_cast<const f32x4*>(sh_ + 1024) + 1.f); GB1 = *reinterpret_cast<const f32x4*>(gb_ + 256) * (*reinterpret_cast<const f32x4*>(sh_ + 1280) + 1.f); \
            GB2 = *reinterpret_cast<const f32x4*>(gb_ + 512) * (*reinterpret_cast<const f32x4*>(sh_ + 1536) + 1.f); GB3 = *reinterpret_cast<const f32x4*>(gb_ + 768) * (*reinterpret_cast<const f32x4*>(sh_ + 1792) + 1.f); \
            SH0 = *reinterpret_cast<const f32x4*>(sh_); SH1 = *reinterpret_cast<const f32x4*>(sh_ + 256); SH2 = *reinterpret_cast<const f32x4*>(sh_ + 512); SH3 = *reinterpret_cast<const f32x4*>(sh_ + 768); } } } while (0)
#define TH_VARGS GA0, GA1, GA2, GA3, GB0, GB1, GB2, GB3, SH0, SH1, SH2, SH3
    TH_DECL(A_); TH_DECL(B_);
    int li = F.wave;
    if (li < nrw) TH_LOAD(A_, TROW(li), 0);
    for (int it = 0; li < nrw; li += 16, it += 2) {
        const bool hb = li + 8 < nrw;
        if (hb) TH_LOAD(B_, TROW(li + 8), it + 1);
        TH_VEC(TROW(li)); thin_proc(P, TH_ARGS(A_), TH_VARGS, TROW(li), li, lane, rwT, rec, lcnt);
        if (li + 16 < nrw) TH_LOAD(A_, TROW(li + 16), it + 2);
        if (hb) { TH_VEC(TROW(li + 8)); thin_proc(P, TH_ARGS(B_), TH_VARGS, TROW(li + 8), li + 8, lane, rwT, rec, lcnt); }
    }
    if (P.router) {
        __syncthreads();
        if (F.tid < 8) lcnt[8 + F.tid] = __hip_atomic_fetch_add(P.cnt + F.tid, lcnt[F.tid], __ATOMIC_RELAXED, __HIP_MEMORY_SCOPE_AGENT);
        __syncthreads();
        for (int i = F.tid; i < nrw; i += 512) { const LAS int* rc = rec + i * 6; int* rt = P.route + (size_t)TROW(i) * 8;
            const int e0 = rc[0], e1 = rc[2];
            rt[0] = e0; rt[1] = rc[1] + (int)lcnt[8 + e0]; rt[2] = e1; rt[3] = rc[3] + (int)lcnt[8 + e1]; rt[4] = rc[4]; rt[5] = rc[5]; }
        VM_WAIT();
        for (int lb = F.wave; lb < nrw; lb += 32) {
            u32x4 v[4]; size_t s0[4], s1[4];
#pragma unroll
            for (int q = 0; q < 4; ++q) { const int lq = lb + 8 * q; const int r = TROW(lq); if (lq < nrw) { const LAS int* rc = rec + lq * 6; const int e0 = rc[0], e1 = rc[2];
                s0[q] = (size_t)e0 * RT + (size_t)(rc[1] + (int)lcnt[8 + e0]); s1[q] = (size_t)e1 * RT + (size_t)(rc[3] + (int)lcnt[8 + e1]);
                v[q] = *(reinterpret_cast<const u32x4*>((const unsigned char*)P.H + (size_t)r * DM) + lane); } }
#pragma unroll
            for (int q = 0; q < 4; ++q) { if (lb + 8 * q < nrw) {
                *(reinterpret_cast<u32x4*>(P.HSv + s0[q] * DM) + lane) = v[q]; *(reinterpret_cast<u32x4*>(P.HSv + s1[q] * DM) + lane) = v[q]; } }
        }
        __syncthreads();
    }
#undef TROW
#undef TH_VEC
#undef TH_VARGS
}

constexpr int NPHASE = 2 + DEPTH * 9;
__global__ void __launch_bounds__(512, 2) dit_fwd(Args args) {
    extern __shared__ __attribute__((aligned(16))) unsigned char lds[];
    Frame F;
    F.lds = (LAS unsigned char*)lds; F.ldsg = lds; F.MISC = (volatile LAS unsigned*)(F.lds + MISC_OFF);
    F.tid = threadIdx.x; F.lane = F.tid & 63; F.wave = __builtin_amdgcn_readfirstlane(F.tid >> 6);
    F.G = gridDim.x; { const int bx = blockIdx.x; F.vcu = (F.G % 8 == 0) ? (bx % 8) * (F.G / 8) + bx / 8 : bx; }
    F.ctl = (unsigned*)(args.ws + WS_CTL);
    for (int u = F.tid; u < (LDS_BYTES - RING_BYTES) / 4; u += 512) ((LAS unsigned*)(F.lds + RING_BYTES))[u] = 0u;
    __syncthreads();
    XcdBarrier bar = xcd_barrier_post(F.ctl + CW_BAR, F.MISC + 8);
    const int lo = args.ph_lo, hi = args.ph_hi;
    int ph = 0;
#define IN() (lo <= ph && ph < hi)
    unsigned long long wait_acc = 0;
#define SEAM() do { if (lo <= ph && ph + 1 < hi) { if (WAITPROBE) { const unsigned long long t0_ = __builtin_amdgcn_s_memrealtime(); xcd_barrier(bar); const unsigned long long dt_ = __builtin_amdgcn_s_memrealtime() - t0_; const int k_ = ph < 2 ? 9 + ph : (ph - 2) % 9; if ((WAITSEL >> k_) & 1u) wait_acc += dt_; } else xcd_barrier(bar); } ++ph; } while (0)
    GAS unsigned char* wsg = (GAS unsigned char*)args.ws;
#define WSP ((unsigned char*)wsg)
#define pMOD    ((float*)(WSP + WS_MOD))
#define pROPECS ((f32x2*)(WSP + WS_ROPE))
#define pWP     ((bf16_t*)(WSP + WS_WP))
#define pROUTE  ((int*)(WSP + WS_ROUTE))
#define pCS     ((bf16_t*)(WSP + WS_CS))
#define pCSC    ((bf16_t*)(WSP + WS_CSC))
#define pX      ((bf16_t*)(WSP + WS_X))
#define pH      ((bf16_t*)(WSP + WS_H))
#define pYO     ((bf16_t*)(WSP + WS_YO))
#define pZ      ((bf16_t*)(WSP + WS_Z))
#define pY      ((bf16_t*)(WSP + WS_Y))
#define pPQT    ((bf16_t*)(WSP + WS_PQT))
#define pPQTC   ((bf16_t*)(WSP + WS_PQTC))
#define pOB     ((bf16_t*)(WSP + WS_O))
#define pA2     ((bf16_t*)(WSP + WS_A2))
#define pA2M    ((bf16_t*)(WSP + WS_A2M))
#define pHS     ((bf16_t*)(WSP + WS_HS))
    const int vcu0 = F.vcu;
#define REFRAME() do { F.tid = opaque(threadIdx.x); F.lane = F.tid & 63; F.wave = __builtin_amdgcn_readfirstlane(F.tid >> 6); F.G = sopaque((int)gridDim.x); F.vcu = sopaque(vcu0); \
        wsg = gptr(args.ws); F.ctl = (unsigned*)(WSP + WS_CTL); } while (0)
    for (int rep0 = 0; rep0 < REP_P0; ++rep0)
    if (IN() && PH_ON(0)) { REFRAME();
        const int gw = F.vcu * 8 + F.wave, NGW = F.G * 8, gt = F.vcu * 512 + F.tid, NGT = F.G * 512;
        LAS float* ctab = (LAS float*)F.lds;
        LAS float* svec = (LAS float*)(F.lds + 16384);
        if (F.tid == 0) *(LAS unsigned*)(F.lds + 126976) = 0u;
        for (int i = F.tid; i < 4096; i += 512) ctab[i] = cospif((float)i * (1.f / 2048.f));
        for (int i = F.tid; i < 9 * 1024; i += 512) { const float v = i < 8192 ? args.c[i] : args.c_ctx[i - 8192]; svec[i] = v / (1.f + __expf(-v)); }
        __syncthreads();
        for (int i = gt; i < 4096 * 1024; i += NGT) { const int k = i >> 10, l0 = (i & 1023) * 8; float v[8];
#pragma unroll
            for (int e = 0; e < 8; ++e) { const int col = l0 + e, l = col & 4095; const int ph_ = (k * l) & 4095; v[e] = col < 4096 ? ctab[ph_] : -ctab[(ph_ - 1024) & 4095]; }
            if (F8_FOUR) *reinterpret_cast<u32x2*>((unsigned char*)pCS + (size_t)k * 8192 + l0) = (u32x2){pk4_fp8(v[0] * F8_SCS, v[1] * F8_SCS, v[2] * F8_SCS, v[3] * F8_SCS), pk4_fp8(v[4] * F8_SCS, v[5] * F8_SCS, v[6] * F8_SCS, v[7] * F8_SCS)};
            else *reinterpret_cast<u32x4*>(pCS + (size_t)k * 8192 + l0) = (u32x4){pk2(v[0], v[1]), pk2(v[2], v[3]), pk2(v[4], v[5]), pk2(v[6], v[7])}; }
        for (int i = gt; i < 256 * 64; i += NGT) { const int k = i >> 6, l0 = (i & 63) * 8; float v[8];
#pragma unroll
            for (int e = 0; e < 8; ++e) { const int col = l0 + e, l = col & 255; const int ph_ = (k * l * 16) & 4095; v[e] = col < 256 ? ctab[ph_] : -ctab[(ph_ - 1024) & 4095]; }
            if (F8_FOUR) *reinterpret_cast<u32x2*>((unsigned char*)pCSC + (size_t)k * 8192 + l0) = (u32x2){pk4_fp8(v[0] * F8_SCS, v[1] * F8_SCS, v[2] * F8_SCS, v[3] * F8_SCS), pk4_fp8(v[4] * F8_SCS, v[5] * F8_SCS, v[6] * F8_SCS, v[7] * F8_SCS)};
            else *reinterpret_cast<u32x4*>(pCSC + (size_t)k * 8192 + l0) = (u32x4){pk2(v[0], v[1]), pk2(v[2], v[3]), pk2(v[4], v[5]), pk2(v[6], v[7])}; }
        for (int i = gt; i < 256 * 128; i += NGT) { const int row = i >> 7, c = i & 127, m = row & 127; const int ph_ = (m * c * 32) & 4095;
            const float v = row < 128 ? ctab[ph_] : ctab[(ph_ - 1024) & 4095]; pWP[i] = (bf16_t)f2bf(v); }
        for (int i = gt; i < 64 * 16; i += NGT) { const int pos = i >> 4, k = i & 15; const float inv = __powf(10000.f, -(float)(2 * k) / 32.f); float s, c; sincosf((float)pos * inv, &s, &c); pROPECS[i] = (f32x2){c, s}; }
        for (int task = F.vcu + F.wave * F.G; task < 512; task += 8 * F.G) { const int layer = task >> 7, col = (task & 127) * 48 + F.lane;
            if (F.lane < 48) {
            const float* w = args.ada_w + (size_t)layer * DM * 6144 + col;
            float a0 = 0, a1 = 0, a2 = 0, a3 = 0, a4 = 0, a5 = 0, a6 = 0, a7 = 0, a8 = 0;
            for (int k0 = 0; k0 < DM; k0 += 32) { float wv[32];
#pragma unroll
                for (int i = 0; i < 32; ++i) wv[i] = w[(size_t)(k0 + i) * 6144];
#pragma unroll
                for (int i = 0; i < 32; ++i) { const int k = k0 + i;
                    a0 += svec[k] * wv[i]; a1 += svec[1024 + k] * wv[i]; a2 += svec[2048 + k] * wv[i]; a3 += svec[3072 + k] * wv[i]; a4 += svec[4096 + k] * wv[i];
                    a5 += svec[5120 + k] * wv[i]; a6 += svec[6144 + k] * wv[i]; a7 += svec[7168 + k] * wv[i]; a8 += svec[8192 + k] * wv[i]; } }
            const float bb = args.ada_b[layer * 6144 + col]; float* mo = pMOD + (size_t)layer * 9 * 6144 + col;
            mo[0] = a0 + bb; mo[6144] = a1 + bb; mo[2 * 6144] = a2 + bb; mo[3 * 6144] = a3 + bb; mo[4 * 6144] = a4 + bb; mo[5 * 6144] = a5 + bb; mo[6 * 6144] = a6 + bb; mo[7 * 6144] = a7 + bb; mo[8 * 6144] = a8 + bb; } }
        LAS float* scr = (LAS float*)(F.lds + 57344 + F.wave * 8448);
        LAS unsigned* wcnt = (LAS unsigned*)(F.lds + 126976);
        constexpr int NITEMS = 2 * (16 * 40) + 2 * (16 * 32) + 2 * (16 * 96) + 2 * (16 * 32) + 2 * (16 * 176) + 2 * (44 * 32) + 16 * (16 * 224) + 16 * (56 * 32);
        for (;;) {
            const int n = __builtin_amdgcn_readfirstlane((int)__hip_atomic_fetch_add(wcnt, F.lane == 0 ? 1u : 0u, __ATOMIC_RELAXED, __HIP_MEMORY_SCOPE_WORKGROUP));
            const int it = ((n >> 3) * F.G + F.vcu) * 8 + (n & 7);
            if (it >= NITEMS) break;
            int r = it;
            if (transpose_job(r, args.mix_in_w, 2, DM, MIXIN, (bf16_t*)(WSP + WS_WMIXIN), false, false, scr, F.lane)) continue;
            if (transpose_job(r, args.mix_out_w, 2, DM, DM, (bf16_t*)(WSP + WS_WMIXOUT), false, false, scr, F.lane)) continue;
            if (transpose_job(r, args.diff_qkv_w, 2, DM, 3072, (bf16_t*)(WSP + WS_WQKV), false, false, scr, F.lane)) continue;
            if (transpose_job(r, args.diff_out_w, 2, DM, DM, (bf16_t*)(WSP + WS_WDOUT), false, false, scr, F.lane)) continue;
            if (transpose_job(r, args.ffn_in_w, 2, DM, 2 * FFN, (bf16_t*)(WSP + WS_WFFNIN), true, F8_DENSE, scr, F.lane)) continue;
            if (transpose_job(r, args.ffn_out_w, 2, FFN, DM, (bf16_t*)(WSP + WS_WFFNOUT), false, F8_DENSE, scr, F.lane)) continue;
            if (transpose_job(r, args.expert_in_w, 16, DM, 2 * EDIM, (bf16_t*)(WSP + WS_WEXPIN), true, true, scr, F.lane)) continue;
            transpose_job(r, args.expert_out_w, 16, EDIM, DM, (bf16_t*)(WSP + WS_WEXPOUT), false, true, scr, F.lane);
        }
        __syncthreads();
    }
    SEAM();
    if (IN() && PH_ON(1)) { REFRAME();
        ThinP P{}; P.nrows = RT; P.xin_lat = args.x; P.xin_ctx = args.ctx; P.ymode = 0; P.H = pH; P.gb = args.norm_g; P.shsc = pMOD;
        for (int rep = 0; rep < REP_P0B; ++rep) thin_phase(F, P);
        for (int rep = 0; rep < EXTRA_BARS; ++rep) xcd_barrier(bar);
    }
    SEAM();

    for (int layer = 0; layer < DEPTH; ++layer) {
        const int j = layer >> 1; const bool even = !(layer & 1), lastl = layer == DEPTH - 1;
        const float* modl = pMOD + (size_t)layer * 9 * 6144; const float* ng = args.norm_g + (size_t)layer * 4 * DM;
        const int Mrows = lastl ? RL : RT;
        if (IN() && PH_ON(2)) { REFRAME();
            pg8::Dims d{DM, DM}; SchedDense S;
            if (even) { S.init(pH, DM, (bf16_t*)(WSP + WS_WMIXIN) + (size_t)j * MIXIN * DM, DM, RT, MIXIN, DM, F.G, (int)blockIdx.x);
                EpiRope E{pZ, MIXIN, 4, 9, pROPECS, 4, 8, QK_C}; for (int rep = 0; rep < REP_PROJ; ++rep) pg8::gemm_phase(F.lds, d, S, E); }
            else { S.init(pH, DM, (bf16_t*)(WSP + WS_WQKV) + (size_t)j * 3072 * DM, DM, RT, 3072, DM, F.G, (int)blockIdx.x);
                EpiRope E{pZ, 3072, 0, 16, pROPECS, 0, 8, QK_C}; for (int rep = 0; rep < REP_PROJ; ++rep) pg8::gemm_phase(F.lds, d, S, E); }
        }
        SEAM();
        if (IN() && PH_ON(3)) { REFRAME();
            if (even) {
                if (PH_ON(16)) { pg8::Dims d{128, MIXIN}; SchedF1 S{(const char*)pWP, (const char*)pZ, F.G, F.vcu}; EpiPQt E{pPQT, pPQTC}; for (int rep = 0; rep < REP_FOUR; ++rep) pg8::gemm_phase(F.lds, d, S, E); }
            } else {
                const float* lv = args.diff_lambda + j * 256;
                const int ln = opaque(F.lane); const float s01 = wave_sum(lv[ln] * lv[64 + ln], ln), s23 = wave_sum(lv[128 + ln] * lv[192 + ln], ln);
                const float lam_init = 0.8f - 0.6f * __expf(-0.3f * (float)layer);
                const float lam = __expf(s01) - __expf(s23) + lam_init;
                const float* subg = args.diff_subln_g + j * 128;
                const int nu = lastl ? 2048 : 2048 + 128;
                for (int rep = 0; rep < REP_DIFF; ++rep)
                for (int u = F.vcu; u < (PH_ON(18) ? nu : 0); u += F.G) {
                    if (u < 2048) diff_attn_unit((char*)lds, pZ, pOB, subg, lam, 1.f - lam_init, u >> 8, (u >> 5) & 7, u & 31, false);
                    else { const int v = u - 2048; diff_attn_unit((char*)lds, pZ, pOB, subg, lam, 1.f - lam_init, v >> 4, (v >> 1) & 7, v & 1, true); }
                }
                __syncthreads();
            }
        }
        SEAM();
        if (IN() && PH_ON(4)) { REFRAME();
            if (even) { pg8::Dims d{F8_FOUR ? 4096 : 8192, F8_FOUR ? 4096 : 8192}; SchedF2 S{(const char*)pCS, (const char*)pCSC, (const char*)pPQT, (const char*)pPQTC, F.G, F.vcu}; EpiFour2 E{pY}; for (int rep = 0; rep < REP_FOUR; ++rep) pg8::gemm_phase<EpiFour2, SchedF2, F8_FOUR>(F.lds, d, S, E);
                const float* sink = args.win_sink + j * 8;
                for (int rep = 0; rep < REP_WIN; ++rep)
                for (int u = F.vcu; u < (PH_ON(17) ? 1024 + 64 : 0); u += F.G) {
                    if (u < 1024) win_attn_unit2((char*)lds, pZ, pY, sink, u >> 7, (u >> 6) & 1, u & 63, false);
                    else { const int v = u - 1024; win_attn_unit2((char*)lds, pZ, pY, sink, v >> 3, (v >> 2) & 1, v & 3, true); }
                }
                __syncthreads();
            }
        }
        if (even) SEAM(); else ++ph;
        if (IN() && PH_ON(5)) { REFRAME();
            pg8::Dims d{DM, DM}; SchedDense S;
            S.init(even ? pY : pOB, DM, (bf16_t*)(WSP + (even ? WS_WMIXOUT : WS_WDOUT)) + (size_t)j * DM * DM, DM, Mrows, DM, DM, F.G, (int)blockIdx.x);
            EpiStore E{pYO, DM, 1.f}; for (int rep = 0; rep < REP_PROJ; ++rep) pg8::gemm_phase(F.lds, d, S, E);
        }
        SEAM();
        if (IN() && PH_ON(6)) { REFRAME();
            ThinP P{}; P.nrows = Mrows; P.xin16 = layer != 0; P.xout16 = true;
            if (layer == 0) { P.xin_lat = args.x; P.xin_ctx = args.ctx; } else { P.xin_lat = pX; P.xin_ctx = pX + (size_t)RL * DM; }
            P.xout_lat = pX; P.xout_ctx = pX + (size_t)RL * DM; P.ymode = 1; P.Ysrc = pYO; P.gate = modl + 2048; P.ga = ng + DM;
            P.H = pH; P.h8 = !even || F8_DENSE; P.gb = ng + 2 * DM; P.shsc = modl + 3072;
            if (!even) { P.router = args.router_w + (size_t)j * DM * 8; P.route = pROUTE; P.cnt = F.ctl + CW_CNT + 16 * j; P.HSv = (unsigned char*)pHS; }
            thin_phase(F, P);
        }
        SEAM();
        unsigned c0 = 0, c1 = 0, c2 = 0, c3 = 0, c4 = 0, c5 = 0, c6 = 0, c7 = 0;
        if (!even) { unsigned* cn = F.ctl + CW_CNT + 16 * j; unsigned a = 0;
            c0 = 0; a += (rfl(xb_ld(cn + 0)) + 255u) & ~255u; c1 = a; a += (rfl(xb_ld(cn + 1)) + 255u) & ~255u; c2 = a; a += (rfl(xb_ld(cn + 2)) + 255u) & ~255u; c3 = a;
            a += (rfl(xb_ld(cn + 3)) + 255u) & ~255u; c4 = a; a += (rfl(xb_ld(cn + 4)) + 255u) & ~255u; c5 = a; a += (rfl(xb_ld(cn + 5)) + 255u) & ~255u; c6 = a;
            a += (rfl(xb_ld(cn + 6)) + 255u) & ~255u; c7 = a; a += (rfl(xb_ld(cn + 7)) + 255u) & ~255u; c0 = a; }
        ++ph;
        if (IN() && PH_ON(8)) { REFRAME();
            const bool f8 = !even || F8_DENSE; const int eb = f8 ? 1 : 2;
            pg8::Dims d{DM * eb / 2, DM * eb / 2}; SchedGroup S;
            if (even) { S.A = (const char*)pH; S.B = (const char*)(WSP + WS_WFFNIN) + (size_t)j * 2 * FFN * DM * eb; S.nRT = RT / 256; S.P1 = S.P2 = S.P3 = S.P4 = S.P5 = S.P6 = S.P7 = 1 << 30; S.nN = 2 * FFN / 256; S.gB = 0; S.aE = 0; }
            else { S.aE = (size_t)RT * DM; S.A = (const char*)pHS; S.B = (const char*)(WSP + WS_WEXPIN) + (size_t)j * NEXP * 2 * EDIM * DM; S.nRT = (int)(c0 >> 8);
                S.P1 = (int)(c1 >> 8); S.P2 = (int)(c2 >> 8); S.P3 = (int)(c3 >> 8); S.P4 = (int)(c4 >> 8); S.P5 = (int)(c5 >> 8); S.P6 = (int)(c6 >> 8); S.P7 = (int)(c7 >> 8);
                S.nN = 2 * EDIM / 256; S.gB = (size_t)2 * EDIM * DM; }
            S.nwg = S.nRT * S.nN; S.G = F.G; S.c = (int)blockIdx.x; S.nkt = DM * eb / 128; S.tA = (size_t)256 * DM * eb; S.tB = (size_t)256 * DM * eb;
            if (f8) { EpiSwiglu<true> E{(unsigned char*)(even ? pA2 : pA2M), even ? FFN : EDIM, 1.f / (F8_SH * F8_SW)}; for (int rep = 0; rep < REP_MOE; ++rep) pg8::gemm_phase<EpiSwiglu<true>, SchedGroup, true, ALIGN_SWIGLU>(F.lds, d, S, E); }
            else { EpiSwiglu<false> E{(unsigned char*)pA2, FFN, 1.f}; for (int rep = 0; rep < REP_MOE; ++rep) pg8::gemm_phase<EpiSwiglu<false>, SchedGroup, false>(F.lds, d, S, E); }
        }
        SEAM();
        if (IN() && PH_ON(9)) { REFRAME();
            const bool f8 = !even || F8_DENSE; const int eb = f8 ? 1 : 2;
            const int Kh = even ? FFN : EDIM; pg8::Dims d{Kh * eb / 2, Kh * eb / 2}; SchedGroup S;
            if (even) { S.A = (const char*)pA2; S.B = (const char*)(WSP + WS_WFFNOUT) + (size_t)j * DM * FFN * eb; S.nRT = RT / 256; S.P1 = S.P2 = S.P3 = S.P4 = S.P5 = S.P6 = S.P7 = 1 << 30; S.gB = 0; }
            else { S.A = (const char*)pA2M; S.B = (const char*)(WSP + WS_WEXPOUT) + (size_t)j * NEXP * DM * EDIM; S.nRT = (int)(c0 >> 8);
                S.P1 = (int)(c1 >> 8); S.P2 = (int)(c2 >> 8); S.P3 = (int)(c3 >> 8); S.P4 = (int)(c4 >> 8); S.P5 = (int)(c5 >> 8); S.P6 = (int)(c6 >> 8); S.P7 = (int)(c7 >> 8);
                S.gB = (size_t)DM * EDIM; }
            S.aE = 0; S.nN = DM / 256; S.nwg = S.nRT * S.nN; S.G = F.G; S.c = (int)blockIdx.x; S.nkt = Kh * eb / 128; S.tA = (size_t)256 * Kh * eb; S.tB = (size_t)256 * Kh * eb;
            if (f8) { EpiStore E{even ? pYO : pHS, DM, 1.f / (F8_SA * F8_SW)}; for (int rep = 0; rep < REP_MOE; ++rep) pg8::gemm_phase<EpiStore, SchedGroup, true>(F.lds, d, S, E); }
            else { EpiStore E{pYO, DM, 1.f}; for (int rep = 0; rep < REP_MOE; ++rep) pg8::gemm_phase<EpiStore, SchedGroup, false>(F.lds, d, S, E); }
        }
        SEAM();
        if (IN() && PH_ON(10)) { REFRAME();
            ThinP P{}; P.nrows = Mrows; P.xin16 = true; P.xout16 = !lastl; P.xin_lat = pX; P.xin_ctx = pX + (size_t)RL * DM;
            if (lastl) P.xout_lat = args.out; else P.xout_lat = pX;
            P.xout_ctx = pX + (size_t)RL * DM; P.ymode = even ? 1 : 2; P.Ysrc = even ? pYO : pHS; P.gate = modl + 5120; P.ga = ng + 3 * DM;
            P.route = pROUTE; P.cnt = F.ctl + CW_CNT + 16 * j;
            if (!lastl) { P.H = pH; P.gb = ng + 4 * DM; P.shsc = modl + 9 * 6144; }
            thin_phase(F, P);
        }
        SEAM();
    }
    if (WAITPROBE) {
        unsigned* wsum = F.ctl + 48;
        if (threadIdx.x == 0) __hip_atomic_fetch_add(wsum, (unsigned)wait_acc, __ATOMIC_RELAXED, __HIP_MEMORY_SCOPE_AGENT);
        xcd_barrier(bar);
        const unsigned mean = xb_ld(wsum) / gridDim.x; const unsigned long long t0_ = __builtin_amdgcn_s_memrealtime();
        while (__builtin_amdgcn_s_memrealtime() - t0_ < (unsigned long long)mean * WAITPROBE) __builtin_amdgcn_s_sleep(8);
    }
#undef IN
#undef SEAM
#undef REFRAME
}

#ifndef MK_PER_PHASE
#define MK_PER_PHASE 0
#endif
extern "C" void kernel_launch(void* const* d_in, const int* in_sizes, int n_in, void* d_out, int out_size, void* d_ws, size_t ws_size, hipStream_t stream) {
    static int grid = 0;
    if (grid == 0) {
        if (n_in != 19 || in_sizes[0] != RL * DM || out_size != RL * DM || ws_size < WS_END) {
            fprintf(stderr, "kernel_launch: unexpected shapes / workspace (n_in %d in0 %d out %d ws %zu need %zu)\n", n_in, n_in > 0 ? in_sizes[0] : -1, out_size, ws_size, (size_t)WS_END); grid = -1; return; }
        int dev = 0, cus = 0, per_cu = 0;
        if (hipGetDevice(&dev) != hipSuccess || hipDeviceGetAttribute(&cus, hipDeviceAttributeMultiprocessorCount, dev) != hipSuccess) { grid = -1; return; }
        if (hipFuncSetAttribute((const void*)dit_fwd, hipFuncAttributeMaxDynamicSharedMemorySize, LDS_BYTES) != hipSuccess) { fprintf(stderr, "kernel_launch: hipFuncSetAttribute failed\n"); grid = -1; return; }
        if (hipOccupancyMaxActiveBlocksPerMultiprocessor(&per_cu, (const void*)dit_fwd, 512, LDS_BYTES) != hipSuccess || per_cu < 1)
            fprintf(stderr, "kernel_launch: occupancy query reports %d\n", per_cu);
        (void)hipGetLastError();
        grid = cus;
    }
    if (grid < 0) return;
    if (hipMemsetAsync((char*)d_ws + WS_CTL, 0, CTL_BYTES, stream) != hipSuccess) return;
    Args a{};
    const float** ap = (const float**)&a;
    for (int i = 0; i < 19; ++i) ap[i] = (const float*)d_in[i];
    a.out = (float*)d_out; a.ws = (unsigned char*)d_ws;
#if MK_PER_PHASE
    for (int p = 0; p < NPHASE; ++p) { a.ph_lo = p; a.ph_hi = p + 1; hipLaunchKernelGGL(dit_fwd, dim3(grid), dim3(512), LDS_BYTES, stream, a); }
#else
    a.ph_lo = 0; a.ph_hi = NPHASE;
    hipLaunchKernelGGL(dit_fwd, dim3(grid), dim3(512), LDS_BYTES, stream, a);
#endif
}
```

```cpp
#include <hip/hip_runtime.h>
#include <cstdio>
#include <cstdint>

#ifndef PHMASK
#define PHMASK 0xFFFFFFFFu
#endif
#define PH_ON(i) ((PHMASK >> (i)) & 1u)
#ifndef REP_DIFF
#define REP_DIFF 1
#endif
#ifndef REP_MOE
#define REP_MOE 1
#endif
#ifndef REP_P0
#define REP_P0 1
#endif
#ifndef REP_P0B
#define REP_P0B 1
#endif
#ifndef EXTRA_BARS
#define EXTRA_BARS 0
#endif
#ifndef REP_EPI
#define REP_EPI 1
#endif
#ifndef WAITSEL
#define WAITSEL 0xFFFFu
#endif
#ifndef WAITPROBE
#define WAITPROBE 0
#endif
#ifndef KREP
#define KREP 1
#endif
#ifndef REP_PROJ
#define REP_PROJ 1
#endif
#ifndef REP_FOUR
#define REP_FOUR 1
#endif
#ifndef REP_WIN
#define REP_WIN 1
#endif
#define LAS __attribute__((address_space(3)))
#define GAS __attribute__((address_space(1)))
typedef unsigned short bf16_t;
typedef short bf16x8 __attribute__((ext_vector_type(8)));
typedef short s16x4 __attribute__((ext_vector_type(4)));
typedef float f32x2 __attribute__((ext_vector_type(2)));
typedef float f32x4 __attribute__((ext_vector_type(4)));
typedef float f32x16 __attribute__((ext_vector_type(16)));
typedef unsigned u32x2 __attribute__((ext_vector_type(2)));
typedef unsigned u32x4 __attribute__((ext_vector_type(4)));
typedef __bf16 bf16x2_t __attribute__((ext_vector_type(2)));
typedef int v8i_t __attribute__((ext_vector_type(8)));

constexpr int DM = 1024, NB = 8, SEQ = 4096, CTX = 256, DEPTH = 4;
constexpr int RL = NB * SEQ, RC = NB * CTX, RT = RL + RC;
constexpr int MIXIN = 1280, FFN = 2816, NEXP = 8, EDIM = 3584;
constexpr int MAXSLOT = 71680;
constexpr float EPS = 1e-6f;
constexpr float LOG2E = 1.4426950408889634f;
constexpr float QK_C = 0.125f * LOG2E;

constexpr size_t MiB = 1u << 20;
constexpr size_t WS_CTL = 0, CTL_BYTES = 32 * 1024;
constexpr size_t WS_MOD = 1 * MiB;
constexpr size_t WS_ROPE = WS_MOD + 900 * 1024;
constexpr size_t WS_WP = WS_ROPE + 8 * 1024;
constexpr size_t WS_ROUTE = 2 * MiB;
constexpr size_t WS_CS = 4 * MiB;
constexpr size_t WS_CSC = 68 * MiB;
constexpr size_t WS_WMIXIN = 72 * MiB;
constexpr size_t WS_WMIXOUT = 77 * MiB;
constexpr size_t WS_WQKV = 81 * MiB;
constexpr size_t WS_WDOUT = 93 * MiB;
constexpr size_t WS_WFFNIN = 97 * MiB;
constexpr size_t WS_WFFNOUT = 119 * MiB;
constexpr size_t WS_WEXPIN = 130 * MiB;
constexpr size_t WS_WEXPOUT = 354 * MiB;
constexpr size_t WS_X = 466 * MiB;
constexpr size_t WS_H = 602 * MiB;
constexpr size_t WS_YO = 670 * MiB;
constexpr size_t WS_RA = 738 * MiB;
constexpr size_t WS_Z = WS_RA;
constexpr size_t WS_Y = WS_RA + 85 * MiB;
constexpr size_t WS_PQT = WS_RA + 153 * MiB;
constexpr size_t WS_O = WS_RA + 204 * MiB;
constexpr size_t WS_RB = 1010 * MiB;
constexpr size_t WS_A2 = WS_RB;
constexpr size_t WS_PQTC = WS_RB + 190 * MiB;
constexpr size_t WS_A2M = WS_H;
constexpr size_t WS_HS = 1092 * MiB;
constexpr size_t WS_END = 1364 * MiB;
static_assert(WS_A2M + (size_t)MAXSLOT * EDIM * 2 <= WS_HS, "A2m overlay");
static_assert(WS_HS + (size_t)NEXP * RT * DM <= WS_END && WS_HS + (size_t)MAXSLOT * DM * 2 <= WS_END && WS_PQTC + 64 * MiB <= WS_END, "ws end");

constexpr int CW_TMO = 0;
constexpr int CW_CNT = 64;
constexpr int CW_BAR = 4096;

constexpr int RING_BYTES = 131072;
constexpr int MISC_OFF = RING_BYTES + 320;
constexpr int LDS_BYTES = 147456;

__device__ __forceinline__ unsigned cvtpk(float lo, float hi) { f32x2 v = {lo, hi}; bf16x2_t b = __builtin_convertvector(v, bf16x2_t); return __builtin_bit_cast(unsigned, b); }
#ifndef F8_DENSE
#define F8_DENSE false
#endif
#ifndef F8_FOUR
#define F8_FOUR false
#endif
static_assert(!F8_FOUR, "fp8 Fourier path retired");
constexpr int FP = 4096;
constexpr float F8_SCS = 256.f, F8_SPQ = 8.f;
constexpr float F8_SH = 4.f, F8_SW = 64.f, F8_SA = 4.f;
__device__ __forceinline__ float f8clamp(float v) { return __builtin_amdgcn_fmed3f(v, -448.f, 448.f); }
__device__ __forceinline__ unsigned pk4_fp8(float a, float b, float c, float d) {
    unsigned w = 0; w = __builtin_amdgcn_cvt_pk_fp8_f32(f8clamp(a), f8clamp(b), w, false); w = __builtin_amdgcn_cvt_pk_fp8_f32(f8clamp(c), f8clamp(d), w, true); return w; }
__device__ __forceinline__ float bf_lo(unsigned u) { return __uint_as_float(u << 16); }
__device__ __forceinline__ float bf_hi(unsigned u) { return __uint_as_float(u & 0xffff0000u); }
__device__ __forceinline__ float wave_sum(float v, int lane) {
#pragma unroll
    for (int o = 1; o < 64; o <<= 1) v += __int_as_float(__builtin_amdgcn_ds_bpermute((lane ^ o) << 2, __float_as_int(v)));
    return v;
}
__device__ __forceinline__ unsigned rfl(unsigned v) { return (unsigned)__builtin_amdgcn_readfirstlane((int)v); }
__device__ __forceinline__ const char* uptr(const char* p) {
    unsigned lo = (unsigned)__builtin_amdgcn_readfirstlane((int)(unsigned)(uintptr_t)p), hi = (unsigned)__builtin_amdgcn_readfirstlane((int)(unsigned)((uintptr_t)p >> 32));
    asm volatile("" : "+s"(lo), "+s"(hi));
    return (const char*)(((uintptr_t)hi << 32) | lo);
}
__device__ __forceinline__ GAS unsigned char* gptr(const void* p) {
    unsigned lo = (unsigned)__builtin_amdgcn_readfirstlane((int)(unsigned)(uintptr_t)p), hi = (unsigned)__builtin_amdgcn_readfirstlane((int)(unsigned)((uintptr_t)p >> 32));
    asm volatile("" : "+s"(lo), "+s"(hi));
    return (GAS unsigned char*)(((uintptr_t)hi << 32) | lo);
}
__device__ __forceinline__ int sopaque(int v) { v = __builtin_amdgcn_readfirstlane(v); asm volatile("" : "+s"(v)); return v; }
__device__ __forceinline__ int opaque(int v) { asm volatile("" : "+v"(v)); return v; }
#define LDS_WAIT() asm volatile("s_waitcnt lgkmcnt(0)" ::: "memory")
#define VM_WAIT() asm volatile("s_waitcnt vmcnt(0)" ::: "memory")
#define SBAR() __builtin_amdgcn_sched_barrier(0)

namespace pg8 {
constexpr int BM = 256, BK = 64, HALF = 128, HTB = HALF * BK * 2, STAGE_BYTES = 8 * HTB, NXCD = 8, WGM = 8;
__host__ __device__ __forceinline__ int lds_byte(int r, int c) { const int st = (r >> 4) * 2 + (c >> 5), rr = r & 15, cc = c & 31, ob = rr * 64 + cc * 2; return st * 1024 + (ob ^ (((ob >> 9) & 1) << 5)); }
__host__ __device__ __forceinline__ void stage_rc(int b, int& R, int& C) { const int st = b / 1024, sb = b % 1024, swz = sb ^ (((sb >> 9) & 1) << 5); R = (st >> 1) * 16 + swz / 64; C = (st & 1) * 32 + (swz % 64) / 2; }
__host__ __device__ __forceinline__ int perm32(int rho) { const int n = rho >> 4, i = rho & 15; return 8 * (i >> 2) + 4 * n + (i & 3); }

struct Unit { int pm, pn, e, nkt; };
struct Dims { int lda, ldb; };

__device__ __forceinline__ int xcd_remap(int wgid, int nwg) {
    const int q = nwg / NXCD, r = nwg % NXCD, xcd = wgid % NXCD, off = wgid / NXCD;
    return (xcd < r ? xcd * (q + 1) : r * (q + 1) + (xcd - r) * q) + off;
}

#ifndef ALIGN_SWIGLU
#define ALIGN_SWIGLU true
#endif
#ifndef ALIGN_DEFAULT
#define ALIGN_DEFAULT true
#endif
template <class Epi, class Sched, bool F8 = false, bool ALIGN_EPI = ALIGN_DEFAULT>
__device__ __forceinline__ void gemm_phase(LAS unsigned char* lds, const Dims g, const Sched& S, const Epi& E) {
    const int tid = opaque(threadIdx.x), wid = __builtin_amdgcn_readfirstlane(tid >> 6), lane = tid & 63, wr = wid >> 2, wc = wid & 3, fr = lane & 15, fq = lane >> 4;
    unsigned voffA[2], voffB[2];
#pragma unroll
    for (int i = 0; i < 2; ++i) { int R, C; stage_rc(tid * 16 + i * 8192, R, C); const int Rb = Epi::PERM ? ((R & ~31) + perm32(R & 31)) : R;
        voffA[i] = (unsigned)(R * g.lda + C) * 2u; voffB[i] = (unsigned)(Rb * g.ldb + C) * 2u; }
    const size_t kstep = (size_t)(BK * 2);
    const size_t hstepA = (size_t)HALF * g.lda * 2, hstepB = (size_t)HALF * g.ldb * 2;
    const unsigned ldsw = (unsigned)wid * 1024u;
    const int aoff = lds_byte(wr * 64 + fr, fq * 8), boff = lds_byte(wc * 32 + fr, fq * 8);
#define PG8_SA(b, h) (((b) * 2 + (h)) * HTB)
#define PG8_SB(b, h) ((4 + (b) * 2 + (h)) * HTB)
#define PG8_STAGE(bufoff, gbase, voff) do { _Pragma("unroll") for (int _i = 0; _i < 2; ++_i) \
        __builtin_amdgcn_global_load_lds((const unsigned*)((const char*)(gbase) + (voff)[_i]), (LAS unsigned*)(lds + (bufoff) + ldsw + _i * 8192), 16, 0, 0); } while (0)
#define PG8_LDA(dst, b, h) do { _Pragma("unroll") for (int m = 0; m < 4; ++m) _Pragma("unroll") for (int k = 0; k < 2; ++k) dst[m][k] = *(const LAS bf16x8*)(lds + PG8_SA(b, h) + aoff + m * 2048 + k * 1024); } while (0)
#define PG8_LDB(dst, b, h) do { _Pragma("unroll") for (int n = 0; n < 2; ++n) _Pragma("unroll") for (int k = 0; k < 2; ++k) dst[n][k] = *(const LAS bf16x8*)(lds + PG8_SB(b, h) + boff + n * 2048 + k * 1024); } while (0)
#define PG8_V8(x) __builtin_bit_cast(v8i_t, (x))
#define PG8_MMA(ai, bj, At, Bt) do { __builtin_amdgcn_s_setprio(1); _Pragma("unroll") for (int m = 0; m < 4; ++m) _Pragma("unroll") for (int n = 0; n < 2; ++n) { \
        if constexpr (F8) { struct P2 { bf16x8 a, b; }; const v8i_t a8_ = PG8_V8((P2{Bt[n][0], Bt[n][1]})), b8_ = PG8_V8((P2{At[m][0], At[m][1]})); \
            asm volatile("v_mfma_f32_16x16x128_f8f6f4 %0, %1, %2, %0" : "+v"(acc[ai][bj][m][n]) : "v"(a8_), "v"(b8_)); }   \
        else { _Pragma("unroll") for (int k = 0; k < 2; ++k) acc[ai][bj][m][n] = __builtin_amdgcn_mfma_f32_16x16x32_bf16(Bt[n][k], At[m][k], acc[ai][bj][m][n], 0, 0, 0); } } \
        __builtin_amdgcn_s_setprio(0); } while (0)
#define PG8_WAIT_V(n) asm volatile("s_waitcnt vmcnt(" #n ")" ::: "memory")
#define PG8_WAIT_L(n) asm volatile("s_waitcnt lgkmcnt(" #n ")" ::: "memory")
#define PG8_BAR __builtin_amdgcn_s_barrier()
#define PG8_SCHED __builtin_amdgcn_sched_barrier(0)
    Unit cur, nxt; int ui = 0;
    if (!S.next(0, cur)) return;
    constexpr bool MIR = Sched::MIRROR;
    unsigned vB2c[2] = {0u, 0u}, vB2n[2] = {0u, 0u}; const char* cB2 = nullptr; const char* nB2 = nullptr;
#define PG8_MKV2(dst, un) do { const int t2_ = opaque(threadIdx.x); _Pragma("unroll") for (int i_ = 0; i_ < 2; ++i_) { int R_, C_; stage_rc(t2_ * 16 + i_ * 8192, R_, C_); \
        const int Rb_ = Epi::PERM ? ((R_ & ~31) + perm32(R_ & 31)) : R_; dst[i_] = S.voff2(un, Rb_, C_, g.ldb); } } while (0)
    if constexpr (MIR) { PG8_MKV2(vB2c, cur); cB2 = uptr(S.bptr2(cur)); }
    f32x4 acc[2][2][4][2];
#pragma unroll
    for (int a = 0; a < 2; ++a)
#pragma unroll
        for (int b = 0; b < 2; ++b)
#pragma unroll
            for (int m = 0; m < 4; ++m)
#pragma unroll
                for (int n = 0; n < 2; ++n) acc[a][b][m][n] = (f32x4){0.f, 0.f, 0.f, 0.f};
    bf16x8 At[4][2], B0[2][2], B1[2][2];
    const char* cA = uptr(S.aptr(cur)); const char* cB = uptr(S.bptr(cur));
    PG8_STAGE(PG8_SB(0, 0), cB, voffB); if constexpr (MIR) PG8_STAGE(PG8_SB(0, 1), cB2, vB2c); else PG8_STAGE(PG8_SB(0, 1), cB + hstepB, voffB); PG8_STAGE(PG8_SA(0, 0), cA, voffA); PG8_STAGE(PG8_SA(0, 1), cA + hstepA, voffA);
    if (wr == 1) PG8_BAR;
    PG8_WAIT_V(2); PG8_BAR;
    PG8_STAGE(PG8_SB(1, 0), cB + kstep, voffB); PG8_STAGE(PG8_SA(1, 0), cA + kstep, voffA); if constexpr (MIR) PG8_STAGE(PG8_SB(1, 1), cB2 + kstep, vB2c); else PG8_STAGE(PG8_SB(1, 1), cB + hstepB + kstep, voffB);
    PG8_WAIT_V(6); PG8_BAR;
    for (;;) {
        const bool has_next = S.next(ui + 1, nxt);
        const char* nA = uptr(has_next ? S.aptr(nxt) : cA); const char* nB = uptr(has_next ? S.bptr(nxt) : cB);
        if constexpr (MIR) { if (has_next) { PG8_MKV2(vB2n, nxt); nB2 = uptr(S.bptr2(nxt)); } else { vB2n[0] = vB2c[0]; vB2n[1] = vB2c[1]; nB2 = cB2; } }
        const int nt = sopaque(cur.nkt);
        for (int t = 0; t < KREP * nt; t += 2) {
            const bool last = (t == KREP * nt - 2);
            const char* a1 = cA + (size_t)(KREP == 1 ? t + 1 : (t + 1) % nt) * kstep;
            const char* a2 = last ? nA : cA + (size_t)(KREP == 1 ? t + 2 : (t + 2) % nt) * kstep; const char* b2 = last ? nB : cB + (size_t)(KREP == 1 ? t + 2 : (t + 2) % nt) * kstep;
            const char* a3 = a2 + kstep; const char* b3 = b2 + kstep;
            const char* m2 = nullptr; unsigned vm[2] = {0u, 0u};
            if constexpr (MIR) { m2 = last ? nB2 : cB2 + (size_t)(t + 2) * kstep; vm[0] = last ? vB2n[0] : vB2c[0]; vm[1] = last ? vB2n[1] : vB2c[1]; }
            PG8_LDB(B0, 0, 0); PG8_LDB(B1, 0, 1); PG8_SCHED; PG8_LDA(At, 0, 0); PG8_STAGE(PG8_SA(1, 1), a1 + hstepA, voffA);
            PG8_WAIT_V(8); PG8_WAIT_L(0); PG8_BAR; PG8_MMA(0, 0, At, B0); PG8_MMA(0, 1, At, B1); PG8_BAR; PG8_SCHED;
            PG8_LDA(At, 0, 1); PG8_STAGE(PG8_SB(0, 0), b2, voffB); if constexpr (MIR) PG8_STAGE(PG8_SB(0, 1), m2, vm); else PG8_STAGE(PG8_SB(0, 1), b2 + hstepB, voffB); PG8_STAGE(PG8_SA(0, 0), a2, voffA);
            PG8_WAIT_V(8); PG8_WAIT_L(0); PG8_BAR; PG8_MMA(1, 0, At, B0); PG8_MMA(1, 1, At, B1); PG8_BAR; PG8_SCHED;
            PG8_LDB(B0, 1, 0); PG8_LDB(B1, 1, 1); PG8_SCHED; PG8_LDA(At, 1, 0); PG8_STAGE(PG8_SA(0, 1), a2 + hstepA, voffA);
            PG8_WAIT_V(8); PG8_WAIT_L(0); PG8_BAR; PG8_MMA(0, 0, At, B0); PG8_MMA(0, 1, At, B1); PG8_BAR; PG8_SCHED;
            PG8_LDA(At, 1, 1); PG8_STAGE(PG8_SB(1, 0), b3, voffB); if constexpr (MIR) PG8_STAGE(PG8_SB(1, 1), m2 + kstep, vm); else PG8_STAGE(PG8_SB(1, 1), b3 + hstepB, voffB); PG8_STAGE(PG8_SA(1, 0), a3, voffA);
            PG8_WAIT_V(8); PG8_WAIT_L(0); PG8_BAR; PG8_MMA(1, 0, At, B0); PG8_MMA(1, 1, At, B1); PG8_BAR; PG8_SCHED;
        }
        if constexpr (ALIGN_EPI) { if (wr == 0) PG8_BAR; }
        if constexpr (F8) asm volatile("s_nop 15\n\ts_nop 15" ::: "memory");
        for (int repe = 0; repe < REP_EPI; ++repe) { const int l2 = opaque(threadIdx.x) & 63; E(acc, cur, wr, wc, l2 & 15, l2 >> 4); }
        if (!has_next) break;
#pragma unroll
        for (int a = 0; a < 2; ++a)
#pragma unroll
            for (int b = 0; b < 2; ++b)
#pragma unroll
                for (int m = 0; m < 4; ++m)
#pragma unroll
                    for (int n = 0; n < 2; ++n) acc[a][b][m][n] = (f32x4){0.f, 0.f, 0.f, 0.f};
        cur = nxt; cA = nA; cB = nB; ++ui;
        if constexpr (MIR) { cB2 = nB2; vB2c[0] = vB2n[0]; vB2c[1] = vB2n[1]; }
        if constexpr (ALIGN_EPI) { if (wr == 1) PG8_BAR; }
    }
    PG8_WAIT_V(0);
    if constexpr (!ALIGN_EPI) { if (wr == 0) PG8_BAR; }
    PG8_BAR;
#undef PG8_MKV2
#undef PG8_SA
#undef PG8_SB
#undef PG8_STAGE
#undef PG8_LDA
#undef PG8_LDB
#undef PG8_MMA
#undef PG8_V8
#undef PG8_WAIT_V
#undef PG8_WAIT_L
#undef PG8_BAR
#undef PG8_SCHED
}
}
using pg8::Unit;

struct EpiStore {
    static constexpr bool PERM = true;
    bf16_t* O; int ldc; float scale;
    __device__ __forceinline__ void operator()(const f32x4 (&acc)[2][2][4][2], const Unit& u, int wr, int wc, int fr, int fq) const {
        const int row0 = u.pm * 256 + wr * 64 + fr, col0 = u.pn * 256 + wc * 32 + 8 * fq;
#pragma unroll
        for (int ai = 0; ai < 2; ++ai)
#pragma unroll
            for (int m = 0; m < 4; ++m) { bf16_t* rowp = O + (size_t)(row0 + ai * 128 + m * 16) * ldc + col0;
#pragma unroll
                for (int bj = 0; bj < 2; ++bj) { const f32x4 v0 = acc[ai][bj][m][0] * (scale * (1.f / KREP)), v1 = acc[ai][bj][m][1] * (scale * (1.f / KREP));
                    u32x4 w; w.x = cvtpk(v0[0], v0[1]); w.y = cvtpk(v0[2], v0[3]); w.z = cvtpk(v1[0], v1[1]); w.w = cvtpk(v1[2], v1[3]);
                    *(u32x4*)(rowp + bj * 128) = w; } }
    }
};
template <bool F8OUT> struct EpiSwiglu {
    static constexpr bool PERM = true;
    unsigned char* O; int ldc; float scale;
    __device__ __forceinline__ void operator()(const f32x4 (&acc)[2][2][4][2], const Unit& u, int wr, int wc, int fr, int fq) const {
        const int row0 = u.pm * 256 + wr * 64 + fr, col0 = u.pn * 128 + wc * 32 + 8 * fq;
        const float us = F8OUT ? scale * F8_SA : scale;
        const float k1 = -scale * LOG2E * (1.f / KREP), ik2 = 1.f / (scale * us * (1.f / KREP) * (1.f / KREP));
#pragma unroll
        for (int ai = 0; ai < 2; ++ai)
#pragma unroll
            for (int m = 0; m < 4; ++m) { unsigned char* rowp = O + ((size_t)(row0 + ai * 128 + m * 16) * ldc + col0) * (F8OUT ? 1 : 2);
                float r[8];
#pragma unroll
                for (int n = 0; n < 2; ++n) { const f32x4 g = acc[ai][0][m][n], u = acc[ai][1][m][n]; const f32x4 t = g * k1;
                    f32x4 e; e[0] = __builtin_amdgcn_exp2f(t[0]); e[1] = __builtin_amdgcn_exp2f(t[1]); e[2] = __builtin_amdgcn_exp2f(t[2]); e[3] = __builtin_amdgcn_exp2f(t[3]);
                    const f32x4 d = e * ik2 + ik2;
                    f32x4 q; q[0] = __builtin_amdgcn_rcpf(d[0]); q[1] = __builtin_amdgcn_rcpf(d[1]); q[2] = __builtin_amdgcn_rcpf(d[2]); q[3] = __builtin_amdgcn_rcpf(d[3]);
                    const f32x4 o = (g * u) * q; r[n * 4 + 0] = o[0]; r[n * 4 + 1] = o[1]; r[n * 4 + 2] = o[2]; r[n * 4 + 3] = o[3]; }
                if constexpr (F8OUT) { u32x2 w; w.x = pk4_fp8(r[0], r[1], r[2], r[3]); w.y = pk4_fp8(r[4], r[5], r[6], r[7]); *(u32x2*)rowp = w; }
                else { u32x4 w; w.x = cvtpk(r[0], r[1]); w.y = cvtpk(r[2], r[3]); w.z = cvtpk(r[4], r[5]); w.w = cvtpk(r[6], r[7]); *(u32x4*)rowp = w; } }
    }
};
struct EpiRope {
    static constexpr bool PERM = false;
    bf16_t* O; int ldc; int rlo, rhi; const f32x2* cs;
    int qlo, qhi; float qscale;
    __device__ __forceinline__ void operator()(const f32x4 (&acc)[2][2][4][2], const Unit& u, int wr, int wc, int fr, int fq) const {
        const int row0 = u.pm * 256 + wr * 64 + fr, col0 = u.pn * 256 + wc * 32 + 4 * fq;
        const bool lat = u.pm < 128;
#pragma unroll
        for (int ai = 0; ai < 2; ++ai)
#pragma unroll
            for (int m = 0; m < 4; ++m) { const int row = row0 + ai * 128 + m * 16; bf16_t* rowp = O + (size_t)row * ldc + col0;
                const int t = row & 4095, pos = (wc & 1) ? (t & 63) : (t >> 6);
                const f32x2* c4 = cs + pos * 16 + 4 * fq;
                const f32x2 c0 = c4[0], c1 = c4[1], c2 = c4[2], c3 = c4[3];
#pragma unroll
                for (int bj = 0; bj < 2; ++bj) { f32x4 p1 = acc[ai][bj][m][0] * (1.f / KREP), p2 = acc[ai][bj][m][1] * (1.f / KREP);
                    const int blk = u.pn * 2 + bj;
                    if (lat && blk >= rlo && blk < rhi) {
                        const f32x4 cv = {c0.x, c1.x, c2.x, c3.x}, sv = {c0.y, c1.y, c2.y, c3.y};
                        const f32x4 o1 = p1 * cv - p2 * sv, o2 = p2 * cv + p1 * sv; p1 = o1; p2 = o2; }
                    if (blk >= qlo && blk < qhi) { p1 = p1 * qscale; p2 = p2 * qscale; }
                    u32x2 w1, w2; w1.x = cvtpk(p1[0], p1[1]); w1.y = cvtpk(p1[2], p1[3]); w2.x = cvtpk(p2[0], p2[1]); w2.y = cvtpk(p2[2], p2[3]);
                    *(u32x2*)(rowp + bj * 128) = w1; *(u32x2*)(rowp + bj * 128 + 16) = w2; } }
    }
};
struct EpiPQt {
    static constexpr bool PERM = true;
    bf16_t* Plat; bf16_t* Pctx;
    __device__ __forceinline__ void operator()(const f32x4 (&acc)[2][2][4][2], const Unit& u, int wr, int wc, int fr, int fq) const {
        const bool ctx = u.e >= 32; const int bg = ctx ? u.e - 32 : u.e;
        bf16_t* base = (ctx ? Pctx : Plat) + (size_t)bg * 128 * FP;
        if (ctx) {
            const int col0 = wc * 32 + 8 * fq;
#pragma unroll
            for (int ai = 0; ai < 2; ++ai)
#pragma unroll
                for (int m = 0; m < 4; ++m) { bf16_t* rowp = base + (size_t)(wr * 64 + m * 16 + fr) * FP + ai * CTX + col0;
#pragma unroll
                    for (int bj = 0; bj < 2; ++bj) { const f32x4 v0 = acc[ai][bj][m][0] * (1.f / KREP), v1 = acc[ai][bj][m][1] * (1.f / KREP);
                        u32x4 w; w.x = cvtpk(v0[0], v0[1]); w.y = cvtpk(v0[2], v0[3]); w.z = cvtpk(v1[0], v1[1]); w.w = cvtpk(v1[2], v1[3]); *(u32x4*)(rowp + bj * 128) = w; } }
        } else {
            const int col0 = u.pn * 128 + wc * 32 + 8 * fq;
            const bool sp = u.pn == 0 && wc == 0 && fq == 0;
#pragma unroll
            for (int m = 0; m < 4; ++m) { bf16_t* rowp = base + (size_t)(wr * 64 + m * 16 + fr) * FP + col0;
                f32x4 p0 = (acc[0][0][m][0] + acc[0][1][m][0]) * (1.f / KREP), p1 = (acc[0][0][m][1] + acc[0][1][m][1]) * (1.f / KREP);
                f32x4 q0 = (acc[1][0][m][0] - acc[1][1][m][0]) * (1.f / KREP), q1 = (acc[1][0][m][1] - acc[1][1][m][1]) * (1.f / KREP);
                if (sp) { p0[0] = acc[0][0][m][0][0] * (1.f / KREP); q0[0] = acc[0][1][m][0][0] * (1.f / KREP); }
                u32x4 w; w.x = cvtpk(p0[0], p0[1]); w.y = cvtpk(p0[2], p0[3]); w.z = cvtpk(p1[0], p1[1]); w.w = cvtpk(p1[2], p1[3]); *(u32x4*)rowp = w;
                w.x = cvtpk(q0[0], q0[1]); w.y = cvtpk(q0[2], q0[3]); w.z = cvtpk(q1[0], q1[1]); w.w = cvtpk(q1[2], q1[3]); *(u32x4*)(rowp + 2048) = w; }
        }
    }
};
struct EpiFour2 {
    static constexpr bool PERM = true;
    bf16_t* O;
    __device__ __forceinline__ void operator()(const f32x4 (&acc)[2][2][4][2], const Unit& u, int wr, int wc, int fr, int fq) const {
        EpiStore s{O, DM, (u.pm < 128 ? 0.0013810679320049757f   : 0.005524271728019903f  )};
        s(acc, u, wr, wc, fr, fq);
    }
};

struct SchedDense {
    static constexpr bool MIRROR = false;
    const char* A; const char* B; int nM, nN, nwg, G, c, nkt; size_t tA, tB;
    __device__ __forceinline__ void init(const void* A_, int lda, const void* B_, int ldb, int M, int N, int K, int G_, int c_) {
        A = (const char*)A_; B = (const char*)B_; nM = M / 256; nN = N / 256; nwg = nM * nN; G = G_; c = c_; nkt = K / 64; tA = (size_t)256 * lda * 2; tB = (size_t)256 * ldb * 2; }
    __device__ __forceinline__ bool next(int i, Unit& u) const {
        const long L = (long)i * G + c; if (L >= nwg) return false;
        const int wgid = pg8::xcd_remap((int)L, nwg);
        const int nig = pg8::WGM * nN, gid = wgid / nig, fm = gid * pg8::WGM, gsz = (nM - fm) < pg8::WGM ? (nM - fm) : pg8::WGM;
        u.pm = fm + ((wgid % nig) % gsz); u.pn = (wgid % nig) / gsz; u.e = 0; u.nkt = nkt; return true;
    }
    __device__ __forceinline__ const char* aptr(const Unit& u) const { return A + (size_t)u.pm * tA; }
    __device__ __forceinline__ const char* bptr(const Unit& u) const { return B + (size_t)u.pn * tB; }
};
struct SchedGroup {
    static constexpr bool MIRROR = false;
    const char* A; const char* B; int P1, P2, P3, P4, P5, P6, P7, nRT, nN, nwg, G, c, nkt; size_t tA, tB, gB, aE;
    __device__ __forceinline__ bool next(int i, Unit& u) const {
        const long L = (long)i * G + c; if (L >= nwg) return false;
        const int wgid = pg8::xcd_remap((int)L, nwg);
        const int nig = pg8::WGM * nN, gid = wgid / nig, fm = gid * pg8::WGM, gsz = (nRT - fm) < pg8::WGM ? (nRT - fm) : pg8::WGM;
        const int rt = fm + ((wgid % nig) % gsz);
        u.pm = rt; u.pn = (wgid % nig) / gsz; u.nkt = nkt;
        u.e = (rt >= P1) + (rt >= P2) + (rt >= P3) + (rt >= P4) + (rt >= P5) + (rt >= P6) + (rt >= P7); return true;
    }
    __device__ __forceinline__ const char* aptr(const Unit& u) const {
        if (aE == 0) return A + (size_t)u.pm * tA;
        const int pe = u.e == 0 ? 0 : u.e == 1 ? P1 : u.e == 2 ? P2 : u.e == 3 ? P3 : u.e == 4 ? P4 : u.e == 5 ? P5 : u.e == 6 ? P6 : P7;
        return A + (size_t)u.e * aE + (size_t)(u.pm - pe) * tA; }
    __device__ __forceinline__ const char* bptr(const Unit& u) const { return B + (size_t)u.e * gB + (size_t)u.pn * tB; }
};
struct SchedF1 {
    static constexpr bool MIRROR = true;
    const char* Wp; const char* Z; int G, c;
    __device__ __forceinline__ bool next(int i, Unit& u) const {
        const int L = i * G + c; if (L >= 544) return false;
        u.pm = 0; u.nkt = 2;
        if (L < 512) { u.e = L >> 4; u.pn = L & 15; } else { u.e = 32 + (L - 512); u.pn = 0; }
        return true;
    }
    __device__ __forceinline__ const char* aptr(const Unit&) const { return Wp; }
    __device__ __forceinline__ const char* bptr(const Unit& u) const {
        const bool ctx = u.e >= 32; const int bg = ctx ? u.e - 32 : u.e, b = bg >> 2, gq = bg & 3;
        const size_t row0 = ctx ? (size_t)RL + b * CTX : (size_t)b * SEQ + u.pn * 128;
        return Z + (row0 * MIXIN + gq * 128) * 2; }
    __device__ __forceinline__ const char* bptr2(const Unit& u) const {
        const bool ctx = u.e >= 32; const int bg = ctx ? u.e - 32 : u.e, b = bg >> 2, gq = bg & 3;
        const size_t row0 = ctx ? (size_t)RL + b * CTX + 128 : (size_t)b * SEQ;
        return Z + (row0 * MIXIN + gq * 128) * 2; }
    __device__ __forceinline__ unsigned voff2(const Unit& u, int R, int C, int ldb) const {
        const int tok = u.e >= 32 ? R : (u.pn == 0 && R == 0) ? 2048 : 4096 - 128 * u.pn - R;
        return (unsigned)(tok * ldb + C) * 2u; }
};
struct SchedF2 {
    static constexpr bool MIRROR = false;
    const char* CSl; const char* CSc; const char* Plat; const char* Pctx; int G, vcu;
    static constexpr size_t EB = 2;
    __device__ __forceinline__ bool next(int i, Unit& u) const {
        const int L = i * G + vcu; if (L >= 272) return false;
        if (L < 256) { const int b = L >> 5, mt = (L & 31) >> 1; u.pm = b * 16 + mt; u.pn = L & 1; u.e = b; u.nkt = 64; }
        else { const int b = (L - 256) >> 1; u.pm = 128 + b; u.pn = L & 1; u.e = 8 + b; u.nkt = 8; }
        return true;
    }
    __device__ __forceinline__ const char* aptr(const Unit& u) const { return u.e < 8 ? CSl + (size_t)(u.pm & 15) * 256 * FP * EB : CSc; }
    __device__ __forceinline__ const char* bptr(const Unit& u) const { return (u.e < 8 ? Plat + (size_t)u.e * 512 * FP * EB : Pctx + (size_t)(u.e - 8) * 512 * FP * EB) + (size_t)u.pn * 256 * FP * EB; }
};

#define XB_TMO      128
#define XB_XCNT(j)  (256  + 64 * (j))
#define XB_XSUB(j)  (1280 + 64 * (j))
#define XB_XGEN(j)  (2304 + 64 * (j))
#define XB_TOP      3328
#define XB_TOPGEN   3392
#define XCD_BAR_WORDS 3456
#define XB_SPIN_CAP (1u << 21)
__device__ __forceinline__ unsigned xb_ld(unsigned* p)              { return __hip_atomic_load(p, __ATOMIC_RELAXED, __HIP_MEMORY_SCOPE_AGENT); }
__device__ __forceinline__ unsigned xb_add(unsigned* p, unsigned v) { return __hip_atomic_fetch_add(p, v, __ATOMIC_RELAXED, __HIP_MEMORY_SCOPE_AGENT); }
__device__ __forceinline__ unsigned xb_xcc_id() { return (unsigned)__builtin_amdgcn_s_getreg((3 << 11) | 20) & 0xFu; }
#define XB_SPIN(cond, bar) do { unsigned _sp = 0; while (cond) { __builtin_amdgcn_s_sleep(1); \
    if ((++_sp & 255u) == 0u) { if (xb_ld(&(bar)[XB_TMO])) break; if (_sp > XB_SPIN_CAP) { atomicAdd(&(bar)[XB_TMO], 1u); break; } } } } while (0)
struct XcdBarrier { unsigned* bar; unsigned x; volatile LAS unsigned* st; };
__device__ __forceinline__ XcdBarrier xcd_barrier_post(unsigned* bar, volatile LAS unsigned* st) {
    XcdBarrier b; b.bar = bar; b.x = xb_xcc_id(); b.st = st;
    if (threadIdx.x == 0) (void)xb_add(&bar[XB_XCNT(b.x)], 1u);
    return b;
}
__device__ __forceinline__ void xcd_barrier_complete(unsigned* bar, unsigned x, unsigned& nloc, unsigned& nx) {
    const unsigned G = gridDim.x * gridDim.y * gridDim.z;
    unsigned sum, cnt, mine, sp = 0u;
    for (;;) {
        sum = 0u; cnt = 0u; mine = 0u;
#pragma unroll
        for (unsigned j = 0; j < 16; ++j) { const unsigned c = xb_ld(&bar[XB_XCNT(j)]); sum += c; cnt += (c > 0u) ? 1u : 0u; mine = (j == x) ? c : mine; }
        if (sum == G) break;
        __builtin_amdgcn_s_sleep(1);
        if ((++sp & 255u) == 0u) { if (xb_ld(&bar[XB_TMO])) break; if (sp > XB_SPIN_CAP) { atomicAdd(&bar[XB_TMO], 1u); break; } }
    }
    nloc = mine > 0u ? mine : 1u; nx = cnt > 0u ? cnt : 1u;
}
__device__ __forceinline__ void xcd_barrier(const XcdBarrier& b) {
    asm volatile("s_waitcnt vmcnt(0)" ::: "memory");
    __syncthreads();
    if (threadIdx.x == 0) {
        unsigned* bar = (unsigned*)uptr((const char*)b.bar);
        __builtin_amdgcn_s_waitcnt(0);
        unsigned nloc = b.st[0], nx = b.st[1];
        if (nloc == 0u) { xcd_barrier_complete(bar, b.x, nloc, nx); b.st[0] = nloc; b.st[1] = nx; }
        const unsigned old = xb_add(&bar[XB_XSUB(b.x)], 1u);
        const unsigned gen = old / nloc;
        if (old + 1u == (gen + 1u) * nloc) {
            __builtin_amdgcn_fence(__ATOMIC_RELEASE, "agent");
            asm volatile("s_waitcnt vmcnt(0)" ::: "memory");
            const unsigned og = xb_add(&bar[XB_TOP], 1u);
            const unsigned tg = og / nx;
            if (og + 1u == (tg + 1u) * nx) xb_add(&bar[XB_TOPGEN], 1u);
            else XB_SPIN(xb_ld(&bar[XB_TOPGEN]) == tg, bar);
            __builtin_amdgcn_fence(__ATOMIC_ACQUIRE, "agent");
            xb_add(&bar[XB_XGEN(b.x)], 1u);
            asm volatile("s_waitcnt vmcnt(0)" ::: "memory");
        } else {
            XB_SPIN(xb_ld(&bar[XB_XGEN(b.x)]) == gen, bar);
            __builtin_amdgcn_fence(__ATOMIC_ACQUIRE, "agent");
            asm volatile("s_waitcnt vmcnt(0)" ::: "memory");
        }
    }
    __syncthreads();
}

__device__ __forceinline__ int crow(int r, int hi) { return (r & 3) + 8 * (r >> 2) + 4 * hi; }
template <int KW> __device__ __forceinline__ int kswz(int row, int colB) { return KW == 128 ? row * 256 + (colB ^ ((row & 7) << 4)) : row * 128 + (colB ^ (((row >> 1) & 7) << 4)); }
template <int DV> __device__ __forceinline__ int v_st(int k, int c) { const int kk = (k & ~0xC) | ((k & 4) << 1) | ((k & 8) >> 1); return ((kk >> 3) * (DV / 32) + (c >> 5)) * 512 + ((kk & 7) * 32 + (c & 31)) * 2; }
__device__ __forceinline__ int v_rd_base(int lane) { return ((lane & 3) << 3) | (((lane >> 2) & 3) << 6) | (((lane >> 4) & 1) << 5) | (((lane >> 5) & 1) << 8); }
template <int OFF> __device__ __forceinline__ s16x4 tr_read(int vb) { s16x4 r; asm volatile("ds_read_b64_tr_b16 %0, %1 offset:%2" : "=&v"(r) : "v"(vb), "i"(OFF) : "memory"); return r; }
template <int DV, int D0> __device__ __forceinline__ void pv_one(f32x16& od, int vb, bf16x8 pa0, bf16x8 pa1, bf16x8 pa2, bf16x8 pa3) {
    constexpr int KS = (DV / 32) * 1024, HF = (DV / 32) * 512;
    const s16x4 l0 = tr_read<D0 * 512 + 0 * KS>(vb), h0 = tr_read<D0 * 512 + 0 * KS + HF>(vb), l1 = tr_read<D0 * 512 + 1 * KS>(vb), h1 = tr_read<D0 * 512 + 1 * KS + HF>(vb);
    const s16x4 l2 = tr_read<D0 * 512 + 2 * KS>(vb), h2 = tr_read<D0 * 512 + 2 * KS + HF>(vb), l3 = tr_read<D0 * 512 + 3 * KS>(vb), h3 = tr_read<D0 * 512 + 3 * KS + HF>(vb);
    asm volatile("s_waitcnt lgkmcnt(0)" ::: "memory"); SBAR();
#define PKV(L, H) (bf16x8){L[0], L[1], L[2], L[3], H[0], H[1], H[2], H[3]}
    od = __builtin_amdgcn_mfma_f32_32x32x16_bf16(pa0, PKV(l0, h0), od, 0, 0, 0);
    od = __builtin_amdgcn_mfma_f32_32x32x16_bf16(pa1, PKV(l1, h1), od, 0, 0, 0);
    od = __builtin_amdgcn_mfma_f32_32x32x16_bf16(pa2, PKV(l2, h2), od, 0, 0, 0);
    od = __builtin_amdgcn_mfma_f32_32x32x16_bf16(pa3, PKV(l3, h3), od, 0, 0, 0);
#undef PKV
}
#define PV_RD(D0, L, H) do { L[0] = tr_read<(D0) * 512 + 0 * KS>(vb); H[0] = tr_read<(D0) * 512 + 0 * KS + HF>(vb); L[1] = tr_read<(D0) * 512 + 1 * KS>(vb); H[1] = tr_read<(D0) * 512 + 1 * KS + HF>(vb); \
    L[2] = tr_read<(D0) * 512 + 2 * KS>(vb); H[2] = tr_read<(D0) * 512 + 2 * KS + HF>(vb); L[3] = tr_read<(D0) * 512 + 3 * KS>(vb); H[3] = tr_read<(D0) * 512 + 3 * KS + HF>(vb); } while (0)
#define PV_MM(od, L, H) do { od = __builtin_amdgcn_mfma_f32_32x32x16_bf16(pa0, PKV(L[0], H[0]), od, 0, 0, 0); od = __builtin_amdgcn_mfma_f32_32x32x16_bf16(pa1, PKV(L[1], H[1]), od, 0, 0, 0); \
    od = __builtin_amdgcn_mfma_f32_32x32x16_bf16(pa2, PKV(L[2], H[2]), od, 0, 0, 0); od = __builtin_amdgcn_mfma_f32_32x32x16_bf16(pa3, PKV(L[3], H[3]), od, 0, 0, 0); } while (0)
#define PKV(L, H) (bf16x8){L[0], L[1], L[2], L[3], H[0], H[1], H[2], H[3]}
template <int DV> __device__ __forceinline__ void pv_all(f32x16* o, int vb, bf16x8 pa0, bf16x8 pa1, bf16x8 pa2, bf16x8 pa3) {
    constexpr int KS = (DV / 32) * 1024, HF = (DV / 32) * 512;
    s16x4 la[4], ha[4], lb[4], hb[4];
    PV_RD(0, la, ha);
    PV_RD(1, lb, hb); asm volatile("s_waitcnt lgkmcnt(8)" ::: "memory"); SBAR(); PV_MM(o[0], la, ha);
    if constexpr (DV == 128) {
        PV_RD(2, la, ha); asm volatile("s_waitcnt lgkmcnt(8)" ::: "memory"); SBAR(); PV_MM(o[1], lb, hb);
        PV_RD(3, lb, hb); asm volatile("s_waitcnt lgkmcnt(8)" ::: "memory"); SBAR(); PV_MM(o[2], la, ha);
        asm volatile("s_waitcnt lgkmcnt(0)" ::: "memory"); SBAR(); PV_MM(o[3], lb, hb);
    } else {
        asm volatile("s_waitcnt lgkmcnt(0)" ::: "memory"); SBAR(); PV_MM(o[1], lb, hb);
    }
}
#undef PV_RD
#undef PV_MM
#undef PKV
template <int KW> __device__ __forceinline__ void qkt64(f32x16& p0, f32x16& p1, const char* Ks, const bf16x8* qr, int kcb, int r32, int hi) {
    bf16x8 kb0[4], kb1[4];
#pragma unroll
    for (int d0 = 0; d0 < 4; ++d0) { const int cb = kcb + (d0 * 16 + hi * 8) * 2;
        kb0[d0] = *reinterpret_cast<const bf16x8*>(Ks + kswz<KW>(r32, cb));
        kb1[d0] = *reinterpret_cast<const bf16x8*>(Ks + kswz<KW>(32 + r32, cb)); }
    p0 = f32x16{}; p1 = f32x16{};
#pragma unroll
    for (int d0 = 0; d0 < 4; ++d0) {
        p0 = __builtin_amdgcn_mfma_f32_32x32x16_bf16(kb0[d0], qr[d0], p0, 0, 0, 0);
        p1 = __builtin_amdgcn_mfma_f32_32x32x16_bf16(kb1[d0], qr[d0], p1, 0, 0, 0); }
}
template <int KW> __device__ __forceinline__ void qkt64n(f32x16& p0, f32x16& p1, const char* Ks, const bf16x8* qr, int kcb, int r32, int hi, const f32x16& cinit) {
#pragma unroll
    for (int d0 = 0; d0 < 4; ++d0) { const int cb = kcb + (d0 * 16 + hi * 8) * 2;
        const bf16x8 b0 = *reinterpret_cast<const bf16x8*>(Ks + kswz<KW>(r32, cb));
        const bf16x8 b1 = *reinterpret_cast<const bf16x8*>(Ks + kswz<KW>(32 + r32, cb));
        if (d0 == 0) { p0 = __builtin_amdgcn_mfma_f32_32x32x16_bf16(b0, qr[0], cinit, 0, 0, 0); p1 = __builtin_amdgcn_mfma_f32_32x32x16_bf16(b1, qr[0], cinit, 0, 0, 0); }
        else { p0 = __builtin_amdgcn_mfma_f32_32x32x16_bf16(b0, qr[d0], p0, 0, 0, 0); p1 = __builtin_amdgcn_mfma_f32_32x32x16_bf16(b1, qr[d0], p1, 0, 0, 0); } }
}
template <int ND> __device__ __forceinline__ void softmax_step(f32x16& p0, f32x16& p1, float& m_reg, float& l_reg, f32x16* o, float* al_l, int r32, int hi,
                                                              bf16x8& pa0, bf16x8& pa1, bf16x8& pa2, bf16x8& pa3) {
    float pmax = p0[0];
#pragma unroll
    for (int r = 1; r < 16; ++r) pmax = fmaxf(pmax, p0[r]);
#pragma unroll
    for (int r = 0; r < 16; ++r) pmax = fmaxf(pmax, p1[r]);
    { auto rr = __builtin_amdgcn_permlane32_swap(__float_as_uint(pmax), __float_as_uint(pmax), false, false); pmax = fmaxf(__uint_as_float(rr[0]), __uint_as_float(rr[1])); }
    const float mn = fmaxf(m_reg, pmax);
    const float alpha = __builtin_amdgcn_exp2f((m_reg - mn) * QK_C); m_reg = mn;
    const float mnC = -mn * QK_C;
#pragma unroll
    for (int r = 0; r < 16; ++r) { p0[r] = __builtin_amdgcn_exp2f(fmaf(p0[r], QK_C, mnC)); p1[r] = __builtin_amdgcn_exp2f(fmaf(p1[r], QK_C, mnC)); }
    float ps = 0.f;
#pragma unroll
    for (int r = 0; r < 16; ++r) ps += p0[r] + p1[r];
    { auto rr = __builtin_amdgcn_permlane32_swap(__float_as_uint(ps), __float_as_uint(ps), false, false); ps = __uint_as_float(rr[0]) + __uint_as_float(rr[1]); }
    l_reg = l_reg * alpha + ps;
    if (__any(alpha < 1.f)) { if (hi == 0) al_l[r32] = alpha; LDS_WAIT();
#pragma unroll
        for (int d = 0; d < ND; ++d)
#pragma unroll
            for (int r = 0; r < 16; ++r) o[d][r] *= al_l[crow(r, hi)];
    }
#define PK4(P, BASE, OUT) do { unsigned a0 = cvtpk(P[BASE + 0], P[BASE + 1]), a1 = cvtpk(P[BASE + 2], P[BASE + 3]);   \
    unsigned b0 = cvtpk(P[BASE + 4], P[BASE + 5]), b1 = cvtpk(P[BASE + 6], P[BASE + 7]);                              \
    auto r0 = __builtin_amdgcn_permlane32_swap(a0, b0, false, false); auto r1 = __builtin_amdgcn_permlane32_swap(a1, b1, false, false); \
    u32x4 w = {r0[0], r1[0], r0[1], r1[1]}; OUT = *reinterpret_cast<bf16x8*>(&w); } while (0)
    PK4(p0, 0, pa0); PK4(p0, 8, pa1); PK4(p1, 0, pa2); PK4(p1, 8, pa3);
#undef PK4
}

constexpr int AT_K = 0, AT_V = 16384, AT_WS = 32768, AT_XCH = 36864;

__device__ __forceinline__ void win_attn_unit(char* lds, const bf16_t* Z, bf16_t* Y, const float* sink, int b, int kvh, int qc, bool ctxq) {
    const int tid = opaque(threadIdx.x), wid = __builtin_amdgcn_readfirstlane(tid >> 6), lane = tid & 63, r32 = lane & 31, hi = lane >> 5;
    const int head = kvh * 4 + (wid >> 1), qsub = wid & 1;
    const int q0 = qc * 64;
    const size_t qrow0 = (ctxq ? (size_t)RL + b * CTX : (size_t)b * SEQ) + q0 + qsub * 32;
    float* wsf = (float*)(lds + AT_WS) + wid * 128; float* al_l = wsf; float* li_l = wsf + 32;
    bf16x8 qr[4];
    { const bf16_t* qp = Z + (qrow0 + r32) * MIXIN + 512 + head * 64 + hi * 8;
#pragma unroll
      for (int d0 = 0; d0 < 4; ++d0) qr[d0] = *reinterpret_cast<const bf16x8*>(qp + d0 * 16); }
    float m_reg = -1e30f, l_reg = 0.f; f32x16 o[2] = {};
    const int srow = tid >> 3, scol = (tid & 7) * 8;
    const int vb = (int)(uintptr_t)(lds + AT_V) + v_rd_base(lane);
    const int qrel = qsub * 32 + r32;
    const int NT = ctxq ? 4 : 9;
    for (int t = 0; t < NT; ++t) {
        size_t krow; int mode = 0;
        if (t < 4) krow = (size_t)RL + b * CTX + t * 64;
        else { const int p0 = q0 - 128 + (t - 4) * 64; if (p0 < 0 || p0 >= SEQ) continue; krow = (size_t)b * SEQ + p0; mode = (t == 4) ? 1 : (t == 8) ? 2 : 0; }
        __syncthreads();
        { const bf16_t* kp = Z + (krow + srow) * MIXIN + 1024 + kvh * 64 + scol;
          const bf16x8 kv = *reinterpret_cast<const bf16x8*>(kp), vv = *reinterpret_cast<const bf16x8*>(kp + 128);
          *reinterpret_cast<bf16x8*>(lds + AT_K + kswz<64>(srow, scol * 2)) = kv;
          *reinterpret_cast<bf16x8*>(lds + AT_V + v_st<64>(srow, scol)) = vv; }
        __syncthreads();
        f32x16 p0, p1; qkt64<64>(p0, p1, lds + AT_K, qr, 0, r32, hi);
        if (mode == 1) {
#pragma unroll
            for (int r = 0; r < 16; ++r) { const int kk = crow(r, hi); if (kk < qrel) p0[r] = -1e30f; if (kk + 32 < qrel) p1[r] = -1e30f; } }
        else if (mode == 2) {
#pragma unroll
            for (int r = 0; r < 16; ++r) { const int kk = crow(r, hi); if (kk > qrel) p0[r] = -1e30f; if (kk + 32 > qrel) p1[r] = -1e30f; } }
        bf16x8 pa0, pa1, pa2, pa3;
        softmax_step<2>(p0, p1, m_reg, l_reg, o, al_l, r32, hi, pa0, pa1, pa2, pa3);
        pv_one<64, 0>(o[0], vb, pa0, pa1, pa2, pa3); pv_one<64, 1>(o[1], vb, pa0, pa1, pa2, pa3);
    }
    l_reg += __builtin_amdgcn_exp2f(sink[head] * LOG2E - m_reg * QK_C);
    if (hi == 0) li_l[r32] = l_reg; LDS_WAIT();
    bf16_t* yp = Y + qrow0 * DM + 512 + head * 64;
#pragma unroll
    for (int r = 0; r < 16; ++r) { const int orow = crow(r, hi); const float rl = __builtin_amdgcn_rcpf(li_l[orow]);
#pragma unroll
        for (int d0 = 0; d0 < 2; ++d0) { const unsigned w = cvtpk(o[d0][r] * rl, 0.f); yp[(size_t)orow * DM + d0 * 32 + r32] = (bf16_t)(w & 0xffffu); } }
}

constexpr float DA_THR = 8.f;
constexpr float DA_THRL = DA_THR * LOG2E;
template <bool FIRST> __device__ __forceinline__ void da_partialSM(f32x16& p0, f32x16& p1, float& mhat, f32x16& negm, float& alpha) {
    float pmax = fmaxf(p0[0], p0[1]), pmb = fmaxf(p1[0], p1[1]);
#pragma unroll
    for (int r = 2; r < 16; r += 2) { pmax = fmaxf(fmaxf(pmax, p0[r]), p0[r + 1]); pmb = fmaxf(fmaxf(pmb, p1[r]), p1[r + 1]); }
    pmax = fmaxf(pmax, pmb);
    { auto rr = __builtin_amdgcn_permlane32_swap(__float_as_uint(pmax), __float_as_uint(pmax), false, false); pmax = fmaxf(__uint_as_float(rr[0]), __uint_as_float(rr[1])); }
    alpha = 1.f;
    if (FIRST || !__builtin_expect(__all(pmax <= DA_THRL), 1)) {
        const float dl = FIRST ? pmax : fmaxf(pmax, 0.f);
        mhat += dl; alpha = __builtin_amdgcn_exp2f(-dl);
#pragma unroll
        for (int r = 0; r < 16; ++r) { p0[r] -= dl; p1[r] -= dl; negm[r] = -mhat; }
    }
#pragma unroll
    for (int r = 0; r < 16; ++r) p0[r] = __builtin_amdgcn_exp2f(p0[r]);
}
__device__ __forceinline__ void da_finishSM(f32x16& p0, f32x16& p1, float alpha, float& l_reg, bf16x8& pa0, bf16x8& pa1, bf16x8& pa2, bf16x8& pa3) {
#pragma unroll
    for (int r = 0; r < 16; ++r) p1[r] = __builtin_amdgcn_exp2f(p1[r]);
    float s0 = p0[0], s1 = p0[1], s2 = p0[2], s3 = p0[3];
#pragma unroll
    for (int r = 4; r < 16; r += 4) { s0 += p0[r]; s1 += p0[r + 1]; s2 += p0[r + 2]; s3 += p0[r + 3]; }
#pragma unroll
    for (int r = 0; r < 16; r += 4) { s0 += p1[r]; s1 += p1[r + 1]; s2 += p1[r + 2]; s3 += p1[r + 3]; }
    float ps = (s0 + s1) + (s2 + s3);
    { auto rr = __builtin_amdgcn_permlane32_swap(__float_as_uint(ps), __float_as_uint(ps), false, false); ps = __uint_as_float(rr[0]) + __uint_as_float(rr[1]); }
    l_reg = l_reg * alpha + ps;
#define PK4(P, BASE, OUT) do { unsigned a0 = cvtpk(P[BASE + 0], P[BASE + 1]), a1 = cvtpk(P[BASE + 2], P[BASE + 3]);   \
    unsigned b0 = cvtpk(P[BASE + 4], P[BASE + 5]), b1 = cvtpk(P[BASE + 6], P[BASE + 7]);                              \
    auto r0 = __builtin_amdgcn_permlane32_swap(a0, b0, false, false); auto r1 = __builtin_amdgcn_permlane32_swap(a1, b1, false, false); \
    u32x4 w = {r0[0], r1[0], r0[1], r1[1]}; OUT = *reinterpret_cast<bf16x8*>(&w); } while (0)
    PK4(p0, 0, pa0); PK4(p0, 8, pa1); PK4(p1, 0, pa2); PK4(p1, 8, pa3);
#undef PK4
}
__device__ __forceinline__ void da_pv(f32x16* o, int vb, bf16x8 pa0, bf16x8 pa1, bf16x8 pa2, bf16x8 pa3) {
    pv_all<128>(o, vb, pa0, pa1, pa2, pa3);
}
constexpr int DA_V = 0, DA_K = 49152, DA_WS = 81920, DA_XCH = 0;
__device__ __forceinline__ void diff_attn_unit(char* lds, const bf16_t* QKV, bf16_t* O, const float* subg, float lam, float oscale, int b, int h, int qb, bool ctxq) {
    const int tid = opaque(threadIdx.x), wid = __builtin_amdgcn_readfirstlane(tid >> 6), lane = tid & 63, r32 = lane & 31, hi = lane >> 5;
    const int comp = wid >> 2, qsub = wid & 3;
    const size_t qrow0 = (ctxq ? (size_t)RL + b * CTX : (size_t)b * SEQ) + qb * 128 + qsub * 32;
    char* V_lds = lds + DA_V; char* K_lds = lds + DA_K;
    float* wsf = (float*)(lds + DA_WS) + wid * 128; float* al_l = wsf; float* li_l = wsf + 32;
    __syncthreads();
    bf16x8 qr[4];
    { const bf16_t* qp = QKV + (qrow0 + r32) * 3072 + (2 * h + comp) * 64 + hi * 8;
#pragma unroll
      for (int d0 = 0; d0 < 4; ++d0) qr[d0] = *reinterpret_cast<const bf16x8*>(qp + d0 * 16); }
    float m_reg = 0.f, l_reg = 0.f; f32x16 o[4] = {}; f32x16 negm = {};
    const int sr = tid >> 4, sc = (tid & 15) * 8, vst0 = v_st<128>(sr, sc), vst1 = v_st<128>(32 + sr, sc);
    const int vb0 = (int)(uintptr_t)V_lds + v_rd_base(lane);
    const int kcb = comp * 128;
    const bf16_t* kvp = QKV + (size_t)sr * 3072 + 1024 + h * 128 + sc;
    const size_t rowc = (size_t)RL + b * CTX, rowl = (size_t)b * SEQ;
    const int NT = ctxq ? 4 : 68;
    bf16x8 ks0, ks1, vs0, vs1;
#define KROW(t) ((t) < 4 ? rowc + (size_t)(t) * 64 : rowl + (size_t)((t) - 4) * 64)
#define LOADK(t) do { const bf16_t* p_ = kvp + KROW(t) * 3072; ks0 = *reinterpret_cast<const bf16x8*>(p_); ks1 = *reinterpret_cast<const bf16x8*>(p_ + 32 * 3072); } while (0)
#define LOADV(t) do { const bf16_t* p_ = kvp + KROW(t) * 3072 + 1024; vs0 = *reinterpret_cast<const bf16x8*>(p_); vs1 = *reinterpret_cast<const bf16x8*>(p_ + 32 * 3072); } while (0)
#define WRITEK(bf) do { *reinterpret_cast<bf16x8*>(K_lds + (bf) * 16384 + kswz<128>(sr, sc * 2)) = ks0; *reinterpret_cast<bf16x8*>(K_lds + (bf) * 16384 + kswz<128>(32 + sr, sc * 2)) = ks1; } while (0)
#define WRITEV(bf) do { *reinterpret_cast<bf16x8*>(V_lds + (bf) * 16384 + vst0) = vs0; *reinterpret_cast<bf16x8*>(V_lds + (bf) * 16384 + vst1) = vs1; } while (0)
#define RESC(a) do { if (__any((a) < 1.f)) { if (hi == 0) al_l[r32] = (a); LDS_WAIT(); \
    _Pragma("unroll") for (int d = 0; d < 4; ++d) _Pragma("unroll") for (int r = 0; r < 16; ++r) o[d][r] *= al_l[crow(r, hi)]; } } while (0)
#define QKT(P0, P1, kb) do { SBAR(); qkt64n<128>(P0, P1, K_lds + (kb) * 16384, qr, kcb, r32, hi, negm); } while (0)
#define FIN(P0, P1, al) do { da_finishSM(P0, P1, al, l_reg, pa0, pa1, pa2, pa3); SBAR(); } while (0)
#define PVT(vi) da_pv(o, vb0 + (vi) * 16384, pa0, pa1, pa2, pa3)
    f32x16 pA0, pA1, pB0, pB1; float alA = 1.f, alB = 1.f; bf16x8 pa0, pa1, pa2, pa3;
    int vm2 = 1, vm1 = 2, vc = 0;
#define VROT() do { const int t_ = vm2; vm2 = vm1; vm1 = vc; vc = t_; } while (0)
    const bool grpB = comp != 0;
    LOADK(0); VM_WAIT(); WRITEK(0); LOADK(1); LOADV(0); __syncthreads();
    QKT(pA0, pA1, 0);
    if (!grpB) da_partialSM<true>(pA0, pA1, m_reg, negm, alA);
    VM_WAIT(); WRITEK(1); WRITEV(vc); LOADK(2); LOADV(1); VROT();
    __syncthreads();
    if (grpB) da_partialSM<true>(pA0, pA1, m_reg, negm, alA);
    QKT(pB0, pB1, 1); FIN(pA0, pA1, alA);
    if (!grpB) { PVT(vm1); da_partialSM<false>(pB0, pB1, m_reg, negm, alB); RESC(alB); }
    VM_WAIT(); WRITEK(0); WRITEV(vc); LOADK(3); LOADV(2); VROT();
    __syncthreads();
    for (int j = 2; j + 1 < NT; j += 2) {
        if (grpB) { PVT(vm2); da_partialSM<false>(pB0, pB1, m_reg, negm, alB); RESC(alB); }
        QKT(pA0, pA1, 0); FIN(pB0, pB1, alB);
        if (!grpB) { PVT(vm1); da_partialSM<false>(pA0, pA1, m_reg, negm, alA); RESC(alA); }
        VM_WAIT(); WRITEK(1); WRITEV(vc); if (j + 2 < NT) LOADK(j + 2); LOADV(j + 1); VROT();
        __syncthreads();
        if (grpB) { PVT(vm2); da_partialSM<false>(pA0, pA1, m_reg, negm, alA); RESC(alA); }
        QKT(pB0, pB1, 1); FIN(pA0, pA1, alA);
        if (!grpB) { PVT(vm1); da_partialSM<false>(pB0, pB1, m_reg, negm, alB); RESC(alB); }
        VM_WAIT(); if (j + 2 < NT) { WRITEK(0); } WRITEV(vc); if (j + 3 < NT) LOADK(j + 3); if (j + 2 < NT) LOADV(j + 2); VROT();
        __syncthreads();
    }
    if (grpB) { PVT(vm2); da_partialSM<false>(pB0, pB1, m_reg, negm, alB); RESC(alB); }
    FIN(pB0, pB1, alB); PVT(vm1);
#undef LOADK
#undef LOADV
#undef WRITEK
#undef WRITEV
#undef QKT
#undef FIN
#undef PVT
#undef VROT
#define SLOAD(a, b)
#define SWRITE(a, b)
#define SWAIT()
#undef KROW
#undef SLOAD
#undef SWRITE
#undef SWAIT
#undef RESC
    if (hi == 0) li_l[r32] = l_reg; LDS_WAIT();
    float rl[16];
#pragma unroll
    for (int r = 0; r < 16; ++r) rl[r] = __builtin_amdgcn_rcpf(li_l[crow(r, hi)]);
    __syncthreads();
    float* xch = (float*)(lds + DA_XCH) + qsub * (32 * 132);
    if (comp == 1) {
#pragma unroll
        for (int d0 = 0; d0 < 4; ++d0)
#pragma unroll
            for (int r = 0; r < 16; ++r) xch[crow(r, hi) * 132 + d0 * 32 + r32] = o[d0][r] * rl[r];
    }
    __syncthreads();
    if (comp == 0) {
#pragma unroll
        for (int d0 = 0; d0 < 4; ++d0)
#pragma unroll
            for (int r = 0; r < 16; ++r) { const int idx = crow(r, hi) * 132 + d0 * 32 + r32; const float v = o[d0][r] * rl[r] - lam * xch[idx]; xch[idx] = v; }
        LDS_WAIT();
        const int row = lane >> 1, hf = lane & 1; const float* rp = xch + row * 132 + hf * 64;
        f32x4 v[16]; float ss = 0.f;
#pragma unroll
        for (int j = 0; j < 16; ++j) { v[j] = *reinterpret_cast<const f32x4*>(rp + 4 * j); ss += v[j][0] * v[j][0] + v[j][1] * v[j][1] + v[j][2] * v[j][2] + v[j][3] * v[j][3]; }
        ss += __int_as_float(__builtin_amdgcn_ds_bpermute((lane ^ 1) << 2, __float_as_int(ss)));
        const float rs = __builtin_amdgcn_rsqf(ss * (1.f / 128.f) + EPS) * oscale;
        bf16_t* op = O + (qrow0 + row) * DM + h * 128 + hf * 64;
#pragma unroll
        for (int j = 0; j < 16; j += 2) { const f32x4 g0 = *reinterpret_cast<const f32x4*>(subg + hf * 64 + 4 * j), g1 = *reinterpret_cast<const f32x4*>(subg + hf * 64 + 4 * j + 4);
            const f32x4 a = v[j] * g0 * rs, c = v[j + 1] * g1 * rs;
            u32x4 w; w.x = cvtpk(a[0], a[1]); w.y = cvtpk(a[2], a[3]); w.z = cvtpk(c[0], c[1]); w.w = cvtpk(c[2], c[3]);
            *reinterpret_cast<u32x4*>(op + 4 * j) = w; }
    }
}

constexpr int WA_V = 0, WA_K = 16384, WA_WS = 32768, WA_ST = 36864;
__device__ __forceinline__ void wa_mask(f32x16& p0, f32x16& p1, int mode, int qrel, int hi) {
    if (mode == 1) {
#pragma unroll
        for (int r = 0; r < 16; ++r) { const int kk = crow(r, hi); if (kk < qrel) p0[r] = -1e30f; if (kk + 32 < qrel) p1[r] = -1e30f; } }
    else if (mode == 2) {
#pragma unroll
        for (int r = 0; r < 16; ++r) { const int kk = crow(r, hi); if (kk > qrel) p0[r] = -1e30f; if (kk + 32 > qrel) p1[r] = -1e30f; } }
    else if (mode == 3) {
#pragma unroll
        for (int r = 0; r < 16; ++r) { p0[r] = -1e30f; p1[r] = -1e30f; } }
}
__device__ __forceinline__ void win_attn_unit2(char* lds, const bf16_t* Z, bf16_t* Y, const float* sink, int b, int kvh, int qc, bool ctxq) {
    const int tid = opaque(threadIdx.x), wid = __builtin_amdgcn_readfirstlane(tid >> 6), lane = tid & 63, r32 = lane & 31, hi = lane >> 5;
    const int head = kvh * 4 + (wid >> 1), qsub = wid & 1, q0 = qc * 64;
    const size_t rowc = (size_t)RL + b * CTX, rowl = (size_t)b * SEQ;
    const size_t qrow0 = (ctxq ? rowc : rowl) + q0 + qsub * 32;
    char* V_lds = lds + WA_V; char* K_lds = lds + WA_K;
    float* wsf = (float*)(lds + WA_WS) + wid * 128; float* al_l = wsf; float* li_l = wsf + 32;
    __syncthreads();
    bf16x8 qr[4];
    { const bf16_t* qp = Z + (qrow0 + r32) * MIXIN + 512 + head * 64 + hi * 8;
#pragma unroll
      for (int d0 = 0; d0 < 4; ++d0) qr[d0] = *reinterpret_cast<const bf16x8*>(qp + d0 * 16); }
    float m_reg = 0.f, l_reg = 0.f; f32x16 o[2] = {}; f32x16 negm = {};
    const int srow = tid >> 3, scol = (tid & 7) * 8, vst = v_st<64>(srow, scol), kst = kswz<64>(srow, scol * 2);
    const int vb0 = (int)(uintptr_t)V_lds + v_rd_base(lane);
    const bf16_t* kvp = Z + (size_t)srow * MIXIN + 1024 + kvh * 64 + scol;
    const int skip_lo = ctxq ? 0 : (q0 == 0 ? 2 : q0 == 64 ? 1 : 0);
    const int nloc = ctxq ? 0 : 5 - skip_lo - (q0 == SEQ - 64 ? 2 : q0 == SEQ - 128 ? 1 : 0);
    const int NTr = 4 + nloc, NT = (NTr + 1) & ~1;
    const int qrel = qsub * 32 + r32;
    struct { bf16x8 vs, ks; } sr_;
#define KROW(t) ((t) < 4 ? rowc + (size_t)(t) * 64 : (t) < NTr ? rowl + (size_t)(q0 - 128 + ((t) - 4 + skip_lo) * 64) : rowc)
#define TMODE(t) ((t) < 4 ? 0 : (t) >= NTr ? 3 : ((t) - 4 + skip_lo) == 0 ? 1 : ((t) - 4 + skip_lo) == 4 ? 2 : 0)
#define SLOAD(t) do { const bf16_t* p_ = kvp + KROW(t) * MIXIN; sr_.ks = *reinterpret_cast<const bf16x8*>(p_); sr_.vs = *reinterpret_cast<const bf16x8*>(p_ + 128); } while (0)
#define SWRITE(bf) do { *reinterpret_cast<bf16x8*>(V_lds + (bf) * 8192 + vst) = sr_.vs; *reinterpret_cast<bf16x8*>(K_lds + (bf) * 8192 + kst) = sr_.ks; } while (0)
#define SWAIT() asm volatile("s_waitcnt vmcnt(0)" ::: "memory")
#define RESC(a) do { if (__any((a) < 1.f)) { if (hi == 0) al_l[r32] = (a); LDS_WAIT(); \
    _Pragma("unroll") for (int d = 0; d < 2; ++d) _Pragma("unroll") for (int r = 0; r < 16; ++r) o[d][r] *= al_l[crow(r, hi)]; } } while (0)
#define WPV(vb) pv_all<64>(o, (vb), pa0, pa1, pa2, pa3)
    f32x16 pA0, pA1, pB0, pB1; float alA, alB; bf16x8 pa0, pa1, pa2, pa3;
    SLOAD(0); VM_WAIT(); SWRITE(0); __syncthreads();
    qkt64n<64>(pA0, pA1, K_lds, qr, 0, r32, hi, negm); da_partialSM<true>(pA0, pA1, m_reg, negm, alA);
    SLOAD(1);
    SWAIT(); SWRITE(1); __syncthreads();
    for (int j = 1; j + 1 < NT; j += 2) {
        SBAR(); qkt64n<64>(pB0, pB1, K_lds + 8192, qr, 0, r32, hi, negm);
        da_finishSM(pA0, pA1, alA, l_reg, pa0, pa1, pa2, pa3); SBAR();
        SLOAD(j + 1); SBAR();
        WPV(vb0); wa_mask(pB0, pB1, TMODE(j), qrel, hi); da_partialSM<false>(pB0, pB1, m_reg, negm, alB);
        __syncthreads(); SWAIT(); SWRITE(0);
        RESC(alB); __syncthreads();
        SBAR(); qkt64n<64>(pA0, pA1, K_lds, qr, 0, r32, hi, negm);
        da_finishSM(pB0, pB1, alB, l_reg, pa0, pa1, pa2, pa3); SBAR();
        SLOAD(j + 2); SBAR();
        WPV(vb0 + 8192); wa_mask(pA0, pA1, TMODE(j + 1), qrel, hi); da_partialSM<false>(pA0, pA1, m_reg, negm, alA);
        __syncthreads(); SWAIT(); SWRITE(1);
        RESC(alA); __syncthreads();
    }
    SBAR(); qkt64n<64>(pB0, pB1, K_lds + 8192, qr, 0, r32, hi, negm);
    da_finishSM(pA0, pA1, alA, l_reg, pa0, pa1, pa2, pa3); SBAR();
    WPV(vb0); wa_mask(pB0, pB1, TMODE(NT - 1), qrel, hi); da_partialSM<false>(pB0, pB1, m_reg, negm, alB);
    __syncthreads(); RESC(alB);
    da_finishSM(pB0, pB1, alB, l_reg, pa0, pa1, pa2, pa3); SBAR();
    WPV(vb0 + 8192);
#undef KROW
#undef TMODE
#undef SLOAD
#undef SWRITE
#undef SWAIT
#undef RESC
#undef WPV
    l_reg += __builtin_amdgcn_exp2f(sink[head] * LOG2E - m_reg);
    if (hi == 0) li_l[r32] = l_reg; LDS_WAIT();
    bf16_t* stg = (bf16_t*)(lds + WA_ST) + wid * 2048;
#pragma unroll
    for (int r = 0; r < 16; ++r) { const int orow = crow(r, hi); const float rl = __builtin_amdgcn_rcpf(li_l[orow]);
#pragma unroll
        for (int d0 = 0; d0 < 2; ++d0) stg[orow * 64 + d0 * 32 + r32] = (bf16_t)(cvtpk(o[d0][r] * rl, 0.f) & 0xffffu); }
    LDS_WAIT();
    bf16_t* yp = Y + qrow0 * DM + 512 + head * 64;
#pragma unroll
    for (int i = 0; i < 4; ++i) { const int row = i * 8 + (lane >> 3), ch = lane & 7; const u32x4 v = *reinterpret_cast<const u32x4*>(stg + row * 64 + ch * 8); *reinterpret_cast<u32x4*>(yp + (size_t)row * DM + ch * 8) = v; }
}

struct Args {
    const float *x, *c, *ctx, *c_ctx, *ada_w, *ada_b, *norm_g, *mix_in_w, *mix_out_w, *win_sink, *diff_qkv_w, *diff_out_w, *diff_lambda, *diff_subln_g,
                *ffn_in_w, *ffn_out_w, *router_w, *expert_in_w, *expert_out_w;
    float* out; unsigned char* ws; int ph_lo, ph_hi;
};
struct Frame {
    LAS unsigned char* lds; unsigned char* ldsg; volatile LAS unsigned* MISC; unsigned* ctl;
    int tid, lane, wave, vcu, G;
};

__device__ __forceinline__ unsigned f2bf(float f) { unsigned u = __builtin_bit_cast(unsigned, f); return (u + 0x7fffu + ((u >> 16) & 1u)) >> 16; }
__device__ __forceinline__ unsigned pk2(float lo, float hi) { return f2bf(lo) | (f2bf(hi) << 16); }
__device__ __forceinline__ void transpose_item(const float* W, int K, int N, bf16_t* WT, int n0, int c0, int k0, LAS float* scr, int lane) {
#pragma unroll 8
    for (int i = 0; i < 32; ++i) { const int kk = 2 * i + (lane >> 5); scr[kk * 33 + (lane & 31)] = W[(size_t)(k0 + kk) * N + c0 + (lane & 31)]; }
    LDS_WAIT(); asm volatile("" ::: "memory");
    const int c = lane & 7;
#pragma unroll
    for (int j = 0; j < 4; ++j) { const int n = (lane >> 3) + 8 * j; const LAS float* s = scr + (8 * c) * 33 + n;
        u32x4 o; o.x = pk2(s[0 * 33], s[1 * 33]); o.y = pk2(s[2 * 33], s[3 * 33]); o.z = pk2(s[4 * 33], s[5 * 33]); o.w = pk2(s[6 * 33], s[7 * 33]);
        *(u32x4*)(WT + (size_t)(n0 + n) * K + k0 + 8 * c) = o; }
    LDS_WAIT(); asm volatile("" ::: "memory");
}
__device__ __forceinline__ void transpose_item_f8(const float* W, int K, int N, unsigned char* WT, int n0, int c0, int k0, LAS float* scr, int lane) {
#pragma unroll 8
    for (int i = 0; i < 32; ++i) { const int kk = 2 * i + (lane >> 5); scr[kk * 33 + (lane & 31)] = W[(size_t)(k0 + kk) * N + c0 + (lane & 31)] * F8_SW; }
    LDS_WAIT(); asm volatile("" ::: "memory");
    const int c = lane & 7;
#pragma unroll
    for (int j = 0; j < 4; ++j) { const int n = (lane >> 3) + 8 * j; const LAS float* s = scr + (8 * c) * 33 + n;
        u32x2 o; o.x = pk4_fp8(s[0 * 33], s[1 * 33], s[2 * 33], s[3 * 33]); o.y = pk4_fp8(s[4 * 33], s[5 * 33], s[6 * 33], s[7 * 33]);
        *(u32x2*)(WT + (size_t)(n0 + n) * K + k0 + 8 * c) = o; }
    LDS_WAIT(); asm volatile("" ::: "memory");
}
__device__ __forceinline__ bool transpose_job(int& r, const float* W, int nb, int K, int N, void* WT, bool glu, bool f8, LAS float* scr, int lane) {
    const int nblk = N / 32, per = (K / 64) * nblk, tot = nb * per;
    if (r >= tot) { r -= tot; return false; }
    const int mtx = r / per, it = r % per, kb = it / nblk, nbk = it % nblk, n0 = 32 * nbk;
    int c0 = n0;
    if (glu) { const int tile = n0 >> 8, w = n0 & 255; c0 = (w < 128) ? tile * 128 + w : (N >> 1) + tile * 128 + (w - 128); }
    if (f8) transpose_item_f8(W + (size_t)mtx * K * N, K, N, (unsigned char*)WT + (size_t)mtx * K * N, n0, c0, 64 * kb, scr, lane);
    else transpose_item(W + (size_t)mtx * K * N, K, N, (bf16_t*)WT + (size_t)mtx * K * N, n0, c0, 64 * kb, scr, lane);
    return true;
}

struct ThinP {
    int nrows;
    const void* xin_lat; const void* xin_ctx;
    void* xout_lat; void* xout_ctx;
    bool xin16, xout16;
    int ymode;
    const bf16_t* Ysrc; const float* gate; const float* ga;
    bool h8;
    bf16_t* H; const float* gb; const float* shsc;
    const float* router; int* route; unsigned* cnt;
    unsigned char* HSv;
};
#define TH_DECL(PFX) f32x4 PFX##x0 = {}, PFX##x1 = {}, PFX##x2 = {}, PFX##x3 = {}; u32x2 PFX##xh0 = {}, PFX##xh1 = {}, PFX##xh2 = {}, PFX##xh3 = {}; u32x2 PFX##ya0 = {}, PFX##ya1 = {}, PFX##ya2 = {}, PFX##ya3 = {}, PFX##yb0 = {}, PFX##yb1 = {}, PFX##yb2 = {}, PFX##yb3 = {}; float PFX##w0 = 0.f, PFX##w1 = 0.f
#define TH_LOAD(PFX, r_, it_) do { const int rr_ = (r_); \
    if (P.xin16) { const bf16_t* xr_ = (rr_ < RL ? (const bf16_t*)P.xin_lat + (size_t)rr_ * DM : (const bf16_t*)P.xin_ctx + (size_t)(rr_ - RL) * DM) + 4 * lane; \
        PFX##xh0 = __builtin_nontemporal_load(reinterpret_cast<const u32x2*>(xr_)); PFX##xh1 = __builtin_nontemporal_load(reinterpret_cast<const u32x2*>(xr_ + 256)); PFX##xh2 = __builtin_nontemporal_load(reinterpret_cast<const u32x2*>(xr_ + 512)); PFX##xh3 = __builtin_nontemporal_load(reinterpret_cast<const u32x2*>(xr_ + 768)); } \
    else { const float* xr_ = (rr_ < RL ? (const float*)P.xin_lat + (size_t)rr_ * DM : (const float*)P.xin_ctx + (size_t)(rr_ - RL) * DM) + 4 * lane; \
        PFX##x0 = __builtin_nontemporal_load(reinterpret_cast<const f32x4*>(xr_)); PFX##x1 = __builtin_nontemporal_load(reinterpret_cast<const f32x4*>(xr_ + 256)); PFX##x2 = __builtin_nontemporal_load(reinterpret_cast<const f32x4*>(xr_ + 512)); PFX##x3 = __builtin_nontemporal_load(reinterpret_cast<const f32x4*>(xr_ + 768)); } \
    const bf16_t* ya_ = P.Ysrc; const bf16_t* yb_ = P.Ysrc; \
    if (P.ymode == 1) ya_ = P.Ysrc + (size_t)rr_ * DM; \
    else if (P.ymode == 2) { const LAS int* rt_ = rtl + (it_) * 6; \
        const int e0_ = rt_[0], p0_ = rt_[1], e1_ = rt_[2], p1_ = rt_[3]; PFX##w0 = __int_as_float(rt_[4]); PFX##w1 = __int_as_float(rt_[5]); \
        const unsigned b0_ = e0_ == 0 ? 0u : e0_ == 1 ? cb1 : e0_ == 2 ? cb2 : e0_ == 3 ? cb3 : e0_ == 4 ? cb4 : e0_ == 5 ? cb5 : e0_ == 6 ? cb6 : cb7; \
        const unsigned b1_ = e1_ == 0 ? 0u : e1_ == 1 ? cb1 : e1_ == 2 ? cb2 : e1_ == 3 ? cb3 : e1_ == 4 ? cb4 : e1_ == 5 ? cb5 : e1_ == 6 ? cb6 : cb7; \
        ya_ = P.Ysrc + (size_t)(b0_ + p0_) * DM; yb_ = P.Ysrc + (size_t)(b1_ + p1_) * DM; } \
    if (P.ymode) { ya_ += 4 * lane; PFX##ya0 = __builtin_nontemporal_load(reinterpret_cast<const u32x2*>(ya_)); PFX##ya1 = __builtin_nontemporal_load(reinterpret_cast<const u32x2*>(ya_ + 256)); PFX##ya2 = __builtin_nontemporal_load(reinterpret_cast<const u32x2*>(ya_ + 512)); PFX##ya3 = __builtin_nontemporal_load(reinterpret_cast<const u32x2*>(ya_ + 768)); } \
    if (P.ymode == 2) { yb_ += 4 * lane; PFX##yb0 = __builtin_nontemporal_load(reinterpret_cast<const u32x2*>(yb_)); PFX##yb1 = __builtin_nontemporal_load(reinterpret_cast<const u32x2*>(yb_ + 256)); PFX##yb2 = __builtin_nontemporal_load(reinterpret_cast<const u32x2*>(yb_ + 512)); PFX##yb3 = __builtin_nontemporal_load(reinterpret_cast<const u32x2*>(yb_ + 768)); } \
    } while (0)
#define TH_ARGS(PFX) PFX##x0, PFX##x1, PFX##x2, PFX##x3, PFX##xh0, PFX##xh1, PFX##xh2, PFX##xh3, PFX##ya0, PFX##ya1, PFX##ya2, PFX##ya3, PFX##yb0, PFX##yb1, PFX##yb2, PFX##yb3, PFX##w0, PFX##w1
__device__ __forceinline__ void thin_proc(const ThinP& P, f32x4 x0, f32x4 x1, f32x4 x2, f32x4 x3, u32x2 xh0, u32x2 xh1, u32x2 xh2, u32x2 xh3, u32x2 ya0, u32x2 ya1, u32x2 ya2, u32x2 ya3, u32x2 yb0, u32x2 yb1, u32x2 yb2, u32x2 yb3, float yw0, float yw1,
                                          f32x4 GA0, f32x4 GA1, f32x4 GA2, f32x4 GA3, f32x4 GB0, f32x4 GB1, f32x4 GB2, f32x4 GB3, f32x4 SH0, f32x4 SH1, f32x4 SH2, f32x4 SH3,
                                          int r, int li, int lane, LAS float* rwT, LAS int* rec, LAS unsigned* lcnt) {
    const int idx = r < RL ? (r >> 12) : 8;
#define BF4(w) ((f32x4){bf_lo((w).x), bf_hi((w).x), bf_lo((w).y), bf_hi((w).y)})
    f32x4 xv[4] = {x0, x1, x2, x3};
    if (P.xin16) { xv[0] = BF4(xh0); xv[1] = BF4(xh1); xv[2] = BF4(xh2); xv[3] = BF4(xh3); }
    if (P.ymode) {
        f32x4 yv[4];
        if (P.ymode == 1) { yv[0] = BF4(ya0); yv[1] = BF4(ya1); yv[2] = BF4(ya2); yv[3] = BF4(ya3); }
        else { yv[0] = BF4(ya0) * yw0 + BF4(yb0) * yw1; yv[1] = BF4(ya1) * yw0 + BF4(yb1) * yw1; yv[2] = BF4(ya2) * yw0 + BF4(yb2) * yw1; yv[3] = BF4(ya3) * yw0 + BF4(yb3) * yw1; }
#undef BF4
        float ss = 0.f;
#pragma unroll
        for (int j = 0; j < 4; ++j) ss += yv[j][0] * yv[j][0] + yv[j][1] * yv[j][1] + yv[j][2] * yv[j][2] + yv[j][3] * yv[j][3];
        const float rs = __builtin_amdgcn_rsqf(wave_sum(ss, lane) * (1.f / DM) + EPS);
        xv[0] = xv[0] + GA0 * (yv[0] * rs); xv[1] = xv[1] + GA1 * (yv[1] * rs); xv[2] = xv[2] + GA2 * (yv[2] * rs); xv[3] = xv[3] + GA3 * (yv[3] * rs);
    }
    if (P.xout_lat) {
        if (P.xout16) { bf16_t* xo = r < RL ? (bf16_t*)P.xout_lat + (size_t)r * DM : (bf16_t*)P.xout_ctx + (size_t)(r - RL) * DM;
#pragma unroll
            for (int j = 0; j < 4; ++j) { u32x2 w; w.x = cvtpk(xv[j][0], xv[j][1]); w.y = cvtpk(xv[j][2], xv[j][3]); __builtin_nontemporal_store(w, reinterpret_cast<u32x2*>(xo + 4 * lane + 256 * j)); } }
        else { float* xo = r < RL ? (float*)P.xout_lat + (size_t)r * DM : (float*)P.xout_ctx + (size_t)(r - RL) * DM;
#pragma unroll
            for (int j = 0; j < 4; ++j) __builtin_nontemporal_store(xv[j], reinterpret_cast<f32x4*>(xo + 4 * lane + 256 * j)); } }
    if (P.H) {
        float ss = 0.f;
#pragma unroll
        for (int j = 0; j < 4; ++j) ss += xv[j][0] * xv[j][0] + xv[j][1] * xv[j][1] + xv[j][2] * xv[j][2] + xv[j][3] * xv[j][3];
        const float rs = __builtin_amdgcn_rsqf(wave_sum(ss, lane) * (1.f / DM) + EPS);
        bf16_t* hr = P.H + (size_t)r * DM;
        f32x4 hv[4] = {xv[0] * rs * GB0 + SH0, xv[1] * rs * GB1 + SH1, xv[2] * rs * GB2 + SH2, xv[3] * rs * GB3 + SH3};
#pragma unroll
        for (int j = 0; j < 4; ++j) {
            if (P.h8) { *reinterpret_cast<unsigned*>((unsigned char*)P.H + (size_t)r * DM + 4 * lane + 256 * j) = pk4_fp8(hv[j][0] * F8_SH, hv[j][1] * F8_SH, hv[j][2] * F8_SH, hv[j][3] * F8_SH); }
            else { u32x2 w; w.x = cvtpk(hv[j][0], hv[j][1]); w.y = cvtpk(hv[j][2], hv[j][3]); *reinterpret_cast<u32x2*>(hr + 4 * lane + 256 * j) = w; } }
        if (P.router) {
            float lg[8];
#pragma unroll
            for (int e = 0; e < 8; ++e) { float a = 0.f;
#pragma unroll
                for (int j = 0; j < 4; ++j) { const f32x4 w = *reinterpret_cast<const LAS f32x4*>(rwT + e * 1024 + 4 * lane + 256 * j); a += hv[j][0] * w[0] + hv[j][1] * w[1] + hv[j][2] * w[2] + hv[j][3] * w[3]; }
                lg[e] = wave_sum(a, lane); }
            int i0 = 0; float v0 = lg[0];
#pragma unroll
            for (int e = 1; e < 8; ++e) if (lg[e] > v0) { v0 = lg[e]; i0 = e; }
            int i1 = -1; float v1 = -3.4e38f;
#pragma unroll
            for (int e = 0; e < 8; ++e) if (e != i0 && lg[e] > v1) { v1 = lg[e]; i1 = e; }
            const float w0 = 1.f / (1.f + __expf(v1 - v0)), w1 = 1.f - w0;
            if (lane == 0) { const unsigned lp0 = __hip_atomic_fetch_add(lcnt + i0, 1u, __ATOMIC_RELAXED, __HIP_MEMORY_SCOPE_WORKGROUP), lp1 = __hip_atomic_fetch_add(lcnt + i1, 1u, __ATOMIC_RELAXED, __HIP_MEMORY_SCOPE_WORKGROUP);
                LAS int* rc = rec + li * 6; rc[0] = i0; rc[1] = (int)lp0; rc[2] = i1; rc[3] = (int)lp1; rc[4] = __float_as_int(w0); rc[5] = __float_as_int(w1); }
        }
    }
}
__device__ __forceinline__ void thin_phase(Frame& F, const ThinP& P) {
    const int lane = opaque(F.lane);
    const int nlat = P.nrows < RL ? P.nrows : RL, nctx = P.nrows - nlat;
    const int chL = (nlat + F.G - 1) / F.G, chC = (nctx + F.G - 1) / F.G;
    const int r0L = F.vcu * chL, r0C = F.vcu * chC;
    const int nl = r0L >= nlat ? 0 : (r0L + chL <= nlat ? chL : nlat - r0L), nc = r0C >= nctx ? 0 : (r0C + chC <= nctx ? chC : nctx - r0C), nrw = nl + nc;
#define TROW(li_) ((li_) < nl ? r0L + (li_) : RL + r0C + ((li_) - nl))
    LAS float* rwT = (LAS float*)F.lds;
    LAS int* rec = (LAS int*)(F.lds + 32768);
    LAS unsigned* lcnt = (LAS unsigned*)(F.lds + 65536);
    unsigned cb1 = 0, cb2 = 0, cb3 = 0, cb4 = 0, cb5 = 0, cb6 = 0, cb7 = 0;
    if (P.ymode == 2) { unsigned a = 0;
        a += (xb_ld(P.cnt + 0) + 255u) & ~255u; cb1 = a; a += (xb_ld(P.cnt + 1) + 255u) & ~255u; cb2 = a; a += (xb_ld(P.cnt + 2) + 255u) & ~255u; cb3 = a;
        a += (xb_ld(P.cnt + 3) + 255u) & ~255u; cb4 = a; a += (xb_ld(P.cnt + 4) + 255u) & ~255u; cb5 = a; a += (xb_ld(P.cnt + 5) + 255u) & ~255u; cb6 = a;
        a += (xb_ld(P.cnt + 6) + 255u) & ~255u; cb7 = a; }
    if (P.router) {
        for (int i = F.tid; i < 8192; i += 512) { const int col = i >> 3, e = i & 7; rwT[e * 1024 + col] = P.router[i]; }
        if (F.tid < 16) lcnt[F.tid] = 0u;
        __syncthreads();
    }
    LAS int* rtl = (LAS int*)(F.lds + 98304) + F.wave * 6 * 64;
    if (P.ymode == 2) { const int li_ = F.wave + 8 * lane;
        if (li_ < nrw) { const int* rt = P.route + (size_t)TROW(li_) * 8; const u32x4 a = *reinterpret_cast<const u32x4*>(rt); const u32x2 b = *reinterpret_cast<const u32x2*>(rt + 4);
            LAS int* d = rtl + lane * 6; d[0] = (int)a.x; d[1] = (int)a.y; d[2] = (int)a.z; d[3] = (int)a.w; d[4] = (int)b.x; d[5] = (int)b.y; }
        LDS_WAIT(); }
    f32x4 GA0 = {}, GA1 = {}, GA2 = {}, GA3 = {}, GB0 = {}, GB1 = {}, GB2 = {}, GB3 = {}, SH0 = {}, SH1 = {}, SH2 = {}, SH3 = {}; int cur_idx = -1;
#define TH_VEC(r_) do { const int ix_ = (r_) < RL ? ((r_) >> 12) : 8; if (ix_ != cur_idx) { cur_idx = ix_; \
        if (P.ymode) { const float* gt_ = P.gate + (size_t)ix_ * 6144 + 4 * lane; const float* ga_ = P.ga + 4 * lane; \
            GA0 = *reinterpret_cast<const f32x4*>(gt_) * *reinterpret_cast<const f32x4*>(ga_); GA1 = *reinterpret_cast<const f32x4*>(gt_ + 256) * *reinterpret_cast<const f32x4*>(ga_ + 256); \
            GA2 = *reinterpret_cast<const f32x4*>(gt_ + 512) * *reinterpret_cast<const f32x4*>(ga_ + 512); GA3 = *reinterpret_cast<const f32x4*>(gt_ + 768) * *reinterpret_cast<const f32x4*>(ga_ + 768); } \
        if (P.H) { const float* sh_ = P.shsc + (size_t)ix_ * 6144 + 4 * lane; const float* gb_ = P.gb + 4 * lane; \
            GB0 = *reinterpret_cast<const f32x4*>(gb_) * (*reinterpret_cast<const f32x4*>(sh_ + 1024) + 1.f); GB1 = *reinterpret_cast<const f32x4*>(gb_ + 256) * (*reinterpret_cast<const f32x4*>(sh_ + 1280) + 1.f); \
            GB2 = *reinterpret_cast<const f32x4*>(gb_ + 512) * (*reinterpret_cast<const f32x4*>(sh_ + 1536) + 1.f); GB3 = *reinterpret_cast<const f32x4*>(gb_ + 768) * (*reinterpret_cast<const f32x4*>(sh_ + 1792) + 1.f); \
            SH0 = *reinterpret_cast<const f32x4*>(sh_); SH1 = *reinterpret_cast<const f32x4*>(sh_ + 256); SH2 = *reinterpret_cast<const f32x4*>(sh_ + 512); SH3 = *reinterpret_cast<const f32x4*>(sh_ + 768); } } } while (0)
#define TH_VARGS GA0, GA1, GA2, GA3, GB0, GB1, GB2, GB3, SH0, SH1, SH2, SH3
    TH_DECL(A_); TH_DECL(B_);
    int li = F.wave;
    if (li < nrw) TH_LOAD(A_, TROW(li), 0);
    for (int it = 0; li < nrw; li += 16, it += 2) {
        const bool hb = li + 8 < nrw;
        if (hb) TH_LOAD(B_, TROW(li + 8), it + 1);
        TH_VEC(TROW(li)); thin_proc(P, TH_ARGS(A_), TH_VARGS, TROW(li), li, lane, rwT, rec, lcnt);
        if (li + 16 < nrw) TH_LOAD(A_, TROW(li + 16), it + 2);
        if (hb) { TH_VEC(TROW(li + 8)); thin_proc(P, TH_ARGS(B_), TH_VARGS, TROW(li + 8), li + 8, lane, rwT, rec, lcnt); }
    }
    if (P.router) {
        __syncthreads();
        if (F.tid < 8) lcnt[8 + F.tid] = __hip_atomic_fetch_add(P.cnt + F.tid, lcnt[F.tid], __ATOMIC_RELAXED, __HIP_MEMORY_SCOPE_AGENT);
        __syncthreads();
        for (int i = F.tid; i < nrw; i += 512) { const LAS int* rc = rec + i * 6; int* rt = P.route + (size_t)TROW(i) * 8;
            const int e0 = rc[0], e1 = rc[2];
            rt[0] = e0; rt[1] = rc[1] + (int)lcnt[8 + e0]; rt[2] = e1; rt[3] = rc[3] + (int)lcnt[8 + e1]; rt[4] = rc[4]; rt[5] = rc[5]; }
        VM_WAIT();
        for (int lb = F.wave; lb < nrw; lb += 32) {
            u32x4 v[4]; size_t s0[4], s1[4];
#pragma unroll
            for (int q = 0; q < 4; ++q) { const int lq = lb + 8 * q; const int r = TROW(lq); if (lq < nrw) { const LAS int* rc = rec + lq * 6; const int e0 = rc[0], e1 = rc[2];
                s0[q] = (size_t)e0 * RT + (size_t)(rc[1] + (int)lcnt[8 + e0]); s1[q] = (size_t)e1 * RT + (size_t)(rc[3] + (int)lcnt[8 + e1]);
                v[q] = *(reinterpret_cast<const u32x4*>((const unsigned char*)P.H + (size_t)r * DM) + lane); } }
#pragma unroll
            for (int q = 0; q < 4; ++q) { if (lb + 8 * q < nrw) {
                *(reinterpret_cast<u32x4*>(P.HSv + s0[q] * DM) + lane) = v[q]; *(reinterpret_cast<u32x4*>(P.HSv + s1[q] * DM) + lane) = v[q]; } }
        }
        __syncthreads();
    }
#undef TROW
#undef TH_VEC
#undef TH_VARGS
}

constexpr int NPHASE = 2 + DEPTH * 9;
__global__ void __launch_bounds__(512, 2) dit_fwd(Args args) {
    extern __shared__ __attribute__((aligned(16))) unsigned char lds[];
    Frame F;
    F.lds = (LAS unsigned char*)lds; F.ldsg = lds; F.MISC = (volatile LAS unsigned*)(F.lds + MISC_OFF);
    F.tid = threadIdx.x; F.lane = F.tid & 63; F.wave = __builtin_amdgcn_readfirstlane(F.tid >> 6);
    F.G = gridDim.x; { const int bx = blockIdx.x; F.vcu = (F.G % 8 == 0) ? (bx % 8) * (F.G / 8) + bx / 8 : bx; }
    F.ctl = (unsigned*)(args.ws + WS_CTL);
    for (int u = F.tid; u < (LDS_BYTES - RING_BYTES) / 4; u += 512) ((LAS unsigned*)(F.lds + RING_BYTES))[u] = 0u;
    __syncthreads();
    XcdBarrier bar = xcd_barrier_post(F.ctl + CW_BAR, F.MISC + 8);
    const int lo = args.ph_lo, hi = args.ph_hi;
    int ph = 0;
#define IN() (lo <= ph && ph < hi)
    unsigned long long wait_acc = 0;
#define SEAM() do { if (lo <= ph && ph + 1 < hi) { if (WAITPROBE) { const unsigned long long t0_ = __builtin_amdgcn_s_memrealtime(); xcd_barrier(bar); const unsigned long long dt_ = __builtin_amdgcn_s_memrealtime() - t0_; const int k_ = ph < 2 ? 9 + ph : (ph - 2) % 9; if ((WAITSEL >> k_) & 1u) wait_acc += dt_; } else xcd_barrier(bar); } ++ph; } while (0)
    GAS unsigned char* wsg = (GAS unsigned char*)args.ws;
#define WSP ((unsigned char*)wsg)
#define pMOD    ((float*)(WSP + WS_MOD))
#define pROPECS ((f32x2*)(WSP + WS_ROPE))
#define pWP     ((bf16_t*)(WSP + WS_WP))
#define pROUTE  ((int*)(WSP + WS_ROUTE))
#define pCS     ((bf16_t*)(WSP + WS_CS))
#define pCSC    ((bf16_t*)(WSP + WS_CSC))
#define pX      ((bf16_t*)(WSP + WS_X))
#define pH      ((bf16_t*)(WSP + WS_H))
#define pYO     ((bf16_t*)(WSP + WS_YO))
#define pZ      ((bf16_t*)(WSP + WS_Z))
#define pY      ((bf16_t*)(WSP + WS_Y))
#define pPQT    ((bf16_t*)(WSP + WS_PQT))
#define pPQTC   ((bf16_t*)(WSP + WS_PQTC))
#define pOB     ((bf16_t*)(WSP + WS_O))
#define pA2     ((bf16_t*)(WSP + WS_A2))
#define pA2M    ((bf16_t*)(WSP + WS_A2M))
#define pHS     ((bf16_t*)(WSP + WS_HS))
    const int vcu0 = F.vcu;
#define REFRAME() do { F.tid = opaque(threadIdx.x); F.lane = F.tid & 63; F.wave = __builtin_amdgcn_readfirstlane(F.tid >> 6); F.G = sopaque((int)gridDim.x); F.vcu = sopaque(vcu0); \
        wsg = gptr(args.ws); F.ctl = (unsigned*)(WSP + WS_CTL); } while (0)
    for (int rep0 = 0; rep0 < REP_P0; ++rep0)
    if (IN() && PH_ON(0)) { REFRAME();
        const int gw = F.vcu * 8 + F.wave, NGW = F.G * 8, gt = F.vcu * 512 + F.tid, NGT = F.G * 512;
        LAS float* ctab = (LAS float*)F.lds;
        LAS float* svec = (LAS float*)(F.lds + 16384);
        if (F.tid == 0) *(LAS unsigned*)(F.lds + 126976) = 0u;
        for (int i = F.tid; i < 4096; i += 512) ctab[i] = cospif((float)i * (1.f / 2048.f));
        for (int i = F.tid; i < 9 * 1024; i += 512) { const float v = i < 8192 ? args.c[i] : args.c_ctx[i - 8192]; svec[i] = v / (1.f + __expf(-v)); }
        __syncthreads();
        for (int i = gt; i < 4096 * 512; i += NGT) { const int k = i >> 9, l0 = (i & 511) * 8; float v[8];
#pragma unroll
            for (int e = 0; e < 8; ++e) { const int col = l0 + e; const int ph_ = (k * (col <= 2048 ? col : col - 2048)) & 4095; v[e] = col <= 2048 ? ctab[ph_] : -ctab[(ph_ - 1024) & 4095]; }
            *reinterpret_cast<u32x4*>(pCS + (size_t)k * FP + l0) = (u32x4){pk2(v[0], v[1]), pk2(v[2], v[3]), pk2(v[4], v[5]), pk2(v[6], v[7])}; }
        for (int i = gt; i < 256 * 64; i += NGT) { const int k = i >> 6, l0 = (i & 63) * 8; float v[8];
#pragma unroll
            for (int e = 0; e < 8; ++e) { const int col = l0 + e, l = col & 255; const int ph_ = (k * l * 16) & 4095; v[e] = col < 256 ? ctab[ph_] : -ctab[(ph_ - 1024) & 4095]; }
            *reinterpret_cast<u32x4*>(pCSC + (size_t)k * FP + l0) = (u32x4){pk2(v[0], v[1]), pk2(v[2], v[3]), pk2(v[4], v[5]), pk2(v[6], v[7])}; }
        for (int i = gt; i < 256 * 128; i += NGT) { const int row = i >> 7, c = i & 127, m = row & 127; const int ph_ = (m * c * 32) & 4095;
            const float v = row < 128 ? ctab[ph_] : ctab[(ph_ - 1024) & 4095]; pWP[i] = (bf16_t)f2bf(v); }
        for (int i = gt; i < 64 * 16; i += NGT) { const int pos = i >> 4, k = i & 15; const float inv = __powf(10000.f, -(float)(2 * k) / 32.f); float s, c; sincosf((float)pos * inv, &s, &c); pROPECS[i] = (f32x2){c, s}; }
        for (int task = F.vcu + F.wave * F.G; task < 512; task += 8 * F.G) { const int layer = task >> 7, col = (task & 127) * 48 + F.lane;
            if (F.lane < 48) {
            const float* w = args.ada_w + (size_t)layer * DM * 6144 + col;
            float a0 = 0, a1 = 0, a2 = 0, a3 = 0, a4 = 0, a5 = 0, a6 = 0, a7 = 0, a8 = 0;
            for (int k0 = 0; k0 < DM; k0 += 32) { float wv[32];
#pragma unroll
                for (int i = 0; i < 32; ++i) wv[i] = w[(size_t)(k0 + i) * 6144];
#pragma unroll
                for (int i = 0; i < 32; ++i) { const int k = k0 + i;
                    a0 += svec[k] * wv[i]; a1 += svec[1024 + k] * wv[i]; a2 += svec[2048 + k] * wv[i]; a3 += svec[3072 + k] * wv[i]; a4 += svec[4096 + k] * wv[i];
                    a5 += svec[5120 + k] * wv[i]; a6 += svec[6144 + k] * wv[i]; a7 += svec[7168 + k] * wv[i]; a8 += svec[8192 + k] * wv[i]; } }
            const float bb = args.ada_b[layer * 6144 + col]; float* mo = pMOD + (size_t)layer * 9 * 6144 + col;
            mo[0] = a0 + bb; mo[6144] = a1 + bb; mo[2 * 6144] = a2 + bb; mo[3 * 6144] = a3 + bb; mo[4 * 6144] = a4 + bb; mo[5 * 6144] = a5 + bb; mo[6 * 6144] = a6 + bb; mo[7 * 6144] = a7 + bb; mo[8 * 6144] = a8 + bb; } }
        LAS float* scr = (LAS float*)(F.lds + 57344 + F.wave * 8448);
        LAS unsigned* wcnt = (LAS unsigned*)(F.lds + 126976);
        constexpr int NITEMS = 2 * (16 * 40) + 2 * (16 * 32) + 2 * (16 * 96) + 2 * (16 * 32) + 2 * (16 * 176) + 2 * (44 * 32) + 16 * (16 * 224) + 16 * (56 * 32);
        for (;;) {
            const int n = __builtin_amdgcn_readfirstlane((int)__hip_atomic_fetch_add(wcnt, F.lane == 0 ? 1u : 0u, __ATOMIC_RELAXED, __HIP_MEMORY_SCOPE_WORKGROUP));
            const int it = ((n >> 3) * F.G + F.vcu) * 8 + (n & 7);
            if (it >= NITEMS) break;
            int r = it;
            if (transpose_job(r, args.mix_in_w, 2, DM, MIXIN, (bf16_t*)(WSP + WS_WMIXIN), false, false, scr, F.lane)) continue;
            if (transpose_job(r, args.mix_out_w, 2, DM, DM, (bf16_t*)(WSP + WS_WMIXOUT), false, false, scr, F.lane)) continue;
            if (transpose_job(r, args.diff_qkv_w, 2, DM, 3072, (bf16_t*)(WSP + WS_WQKV), false, false, scr, F.lane)) continue;
            if (transpose_job(r, args.diff_out_w, 2, DM, DM, (bf16_t*)(WSP + WS_WDOUT), false, false, scr, F.lane)) continue;
            if (transpose_job(r, args.ffn_in_w, 2, DM, 2 * FFN, (bf16_t*)(WSP + WS_WFFNIN), true, F8_DENSE, scr, F.lane)) continue;
            if (transpose_job(r, args.ffn_out_w, 2, FFN, DM, (bf16_t*)(WSP + WS_WFFNOUT), false, F8_DENSE, scr, F.lane)) continue;
            if (transpose_job(r, args.expert_in_w, 16, DM, 2 * EDIM, (bf16_t*)(WSP + WS_WEXPIN), true, true, scr, F.lane)) continue;
            transpose_job(r, args.expert_out_w, 16, EDIM, DM, (bf16_t*)(WSP + WS_WEXPOUT), false, true, scr, F.lane);
        }
        __syncthreads();
    }
    SEAM();
    if (IN() && PH_ON(1)) { REFRAME();
        ThinP P{}; P.nrows = RT; P.xin_lat = args.x; P.xin_ctx = args.ctx; P.ymode = 0; P.H = pH; P.gb = args.norm_g; P.shsc = pMOD;
        for (int rep = 0; rep < REP_P0B; ++rep) thin_phase(F, P);
        for (int rep = 0; rep < EXTRA_BARS; ++rep) xcd_barrier(bar);
    }
    SEAM();

    for (int layer = 0; layer < DEPTH; ++layer) {
        const int j = layer >> 1; const bool even = !(layer & 1), lastl = layer == DEPTH - 1;
        const float* modl = pMOD + (size_t)layer * 9 * 6144; const float* ng = args.norm_g + (size_t)layer * 4 * DM;
        const int Mrows = lastl ? RL : RT;
        if (IN() && PH_ON(2)) { REFRAME();
            pg8::Dims d{DM, DM}; SchedDense S;
            if (even) { S.init(pH, DM, (bf16_t*)(WSP + WS_WMIXIN) + (size_t)j * MIXIN * DM, DM, RT, MIXIN, DM, F.G, (int)blockIdx.x);
                EpiRope E{pZ, MIXIN, 4, 9, pROPECS, 4, 8, QK_C}; for (int rep = 0; rep < REP_PROJ; ++rep) pg8::gemm_phase(F.lds, d, S, E); }
            else { S.init(pH, DM, (bf16_t*)(WSP + WS_WQKV) + (size_t)j * 3072 * DM, DM, RT, 3072, DM, F.G, (int)blockIdx.x);
                EpiRope E{pZ, 3072, 0, 16, pROPECS, 0, 8, QK_C}; for (int rep = 0; rep < REP_PROJ; ++rep) pg8::gemm_phase(F.lds, d, S, E); }
        }
        SEAM();
        if (IN() && PH_ON(3)) { REFRAME();
            if (even) {
                if (PH_ON(16)) { pg8::Dims d{128, MIXIN}; SchedF1 S{(const char*)pWP, (const char*)pZ, F.G, F.vcu}; EpiPQt E{pPQT, pPQTC}; for (int rep = 0; rep < REP_FOUR; ++rep) pg8::gemm_phase(F.lds, d, S, E); }
            } else {
                const float* lv = args.diff_lambda + j * 256;
                const int ln = opaque(F.lane); const float s01 = wave_sum(lv[ln] * lv[64 + ln], ln), s23 = wave_sum(lv[128 + ln] * lv[192 + ln], ln);
                const float lam_init = 0.8f - 0.6f * __expf(-0.3f * (float)layer);
                const float lam = __expf(s01) - __expf(s23) + lam_init;
                const float* subg = args.diff_subln_g + j * 128;
                const int nu = lastl ? 2048 : 2048 + 128;
                for (int rep = 0; rep < REP_DIFF; ++rep)
                for (int u = F.vcu; u < (PH_ON(18) ? nu : 0); u += F.G) {
                    if (u < 2048) diff_attn_unit((char*)lds, pZ, pOB, subg, lam, 1.f - lam_init, u >> 8, (u >> 5) & 7, u & 31, false);
                    else { const int v = u - 2048; diff_attn_unit((char*)lds, pZ, pOB, subg, lam, 1.f - lam_init, v >> 4, (v >> 1) & 7, v & 1, true); }
                }
                __syncthreads();
            }
        }
        SEAM();
        if (IN() && PH_ON(4)) { REFRAME();
            if (even) { pg8::Dims d{FP, FP}; SchedF2 S{(const char*)pCS, (const char*)pCSC, (const char*)pPQT, (const char*)pPQTC, F.G, F.vcu}; EpiFour2 E{pY}; for (int rep = 0; rep < REP_FOUR; ++rep) pg8::gemm_phase<EpiFour2, SchedF2, false>(F.lds, d, S, E);
                const float* sink = args.win_sink + j * 8;
                for (int rep = 0; rep < REP_WIN; ++rep)
                for (int u = F.vcu; u < (PH_ON(17) ? 1024 + 64 : 0); u += F.G) {
                    if (u < 1024) win_attn_unit2((char*)lds, pZ, pY, sink, u >> 7, (u >> 6) & 1, u & 63, false);
                    else { const int v = u - 1024; win_attn_unit2((char*)lds, pZ, pY, sink, v >> 3, (v >> 2) & 1, v & 3, true); }
                }
                __syncthreads();
            }
        }
        if (even) SEAM(); else ++ph;
        if (IN() && PH_ON(5)) { REFRAME();
            pg8::Dims d{DM, DM}; SchedDense S;
            S.init(even ? pY : pOB, DM, (bf16_t*)(WSP + (even ? WS_WMIXOUT : WS_WDOUT)) + (size_t)j * DM * DM, DM, Mrows, DM, DM, F.G, (int)blockIdx.x);
            EpiStore E{pYO, DM, 1.f}; for (int rep = 0; rep < REP_PROJ; ++rep) pg8::gemm_phase(F.lds, d, S, E);
        }
        SEAM();
        if (IN() && PH_ON(6)) { REFRAME();
            ThinP P{}; P.nrows = Mrows; P.xin16 = layer != 0; P.xout16 = true;
            if (layer == 0) { P.xin_lat = args.x; P.xin_ctx = args.ctx; } else { P.xin_lat = pX; P.xin_ctx = pX + (size_t)RL * DM; }
            P.xout_lat = pX; P.xout_ctx = pX + (size_t)RL * DM; P.ymode = 1; P.Ysrc = pYO; P.gate = modl + 2048; P.ga = ng + DM;
            P.H = pH; P.h8 = !even || F8_DENSE; P.gb = ng + 2 * DM; P.shsc = modl + 3072;
            if (!even) { P.router = args.router_w + (size_t)j * DM * 8; P.route = pROUTE; P.cnt = F.ctl + CW_CNT + 16 * j; P.HSv = (unsigned char*)pHS; }
            thin_phase(F, P);
        }
        SEAM();
        unsigned c0 = 0, c1 = 0, c2 = 0, c3 = 0, c4 = 0, c5 = 0, c6 = 0, c7 = 0;
        if (!even) { unsigned* cn = F.ctl + CW_CNT + 16 * j; unsigned a = 0;
            c0 = 0; a += (rfl(xb_ld(cn + 0)) + 255u) & ~255u; c1 = a; a += (rfl(xb_ld(cn + 1)) + 255u) & ~255u; c2 = a; a += (rfl(xb_ld(cn + 2)) + 255u) & ~255u; c3 = a;
            a += (rfl(xb_ld(cn + 3)) + 255u) & ~255u; c4 = a; a += (rfl(xb_ld(cn + 4)) + 255u) & ~255u; c5 = a; a += (rfl(xb_ld(cn + 5)) + 255u) & ~255u; c6 = a;
            a += (rfl(xb_ld(cn + 6)) + 255u) & ~255u; c7 = a; a += (rfl(xb_ld(cn + 7)) + 255u) & ~255u; c0 = a; }
        ++ph;
        if (IN() && PH_ON(8)) { REFRAME();
            const bool f8 = !even || F8_DENSE; const int eb = f8 ? 1 : 2;
            pg8::Dims d{DM * eb / 2, DM * eb / 2}; SchedGroup S;
            if (even) { S.A = (const char*)pH; S.B = (const char*)(WSP + WS_WFFNIN) + (size_t)j * 2 * FFN * DM * eb; S.nRT = RT / 256; S.P1 = S.P2 = S.P3 = S.P4 = S.P5 = S.P6 = S.P7 = 1 << 30; S.nN = 2 * FFN / 256; S.gB = 0; S.aE = 0; }
            else { S.aE = (size_t)RT * DM; S.A = (const char*)pHS; S.B = (const char*)(WSP + WS_WEXPIN) + (size_t)j * NEXP * 2 * EDIM * DM; S.nRT = (int)(c0 >> 8);
                S.P1 = (int)(c1 >> 8); S.P2 = (int)(c2 >> 8); S.P3 = (int)(c3 >> 8); S.P4 = (int)(c4 >> 8); S.P5 = (int)(c5 >> 8); S.P6 = (int)(c6 >> 8); S.P7 = (int)(c7 >> 8);
                S.nN = 2 * EDIM / 256; S.gB = (size_t)2 * EDIM * DM; }
            S.nwg = S.nRT * S.nN; S.G = F.G; S.c = (int)blockIdx.x; S.nkt = DM * eb / 128; S.tA = (size_t)256 * DM * eb; S.tB = (size_t)256 * DM * eb;
            if (f8) { EpiSwiglu<true> E{(unsigned char*)(even ? pA2 : pA2M), even ? FFN : EDIM, 1.f / (F8_SH * F8_SW)}; for (int rep = 0; rep < REP_MOE; ++rep) pg8::gemm_phase<EpiSwiglu<true>, SchedGroup, true, ALIGN_SWIGLU>(F.lds, d, S, E); }
            else { EpiSwiglu<false> E{(unsigned char*)pA2, FFN, 1.f}; for (int rep = 0; rep < REP_MOE; ++rep) pg8::gemm_phase<EpiSwiglu<false>, SchedGroup, false>(F.lds, d, S, E); }
        }
        SEAM();
        if (IN() && PH_ON(9)) { REFRAME();
            const bool f8 = !even || F8_DENSE; const int eb = f8 ? 1 : 2;
            const int Kh = even ? FFN : EDIM; pg8::Dims d{Kh * eb / 2, Kh * eb / 2}; SchedGroup S;
            if (even) { S.A = (const char*)pA2; S.B = (const char*)(WSP + WS_WFFNOUT) + (size_t)j * DM * FFN * eb; S.nRT = RT / 256; S.P1 = S.P2 = S.P3 = S.P4 = S.P5 = S.P6 = S.P7 = 1 << 30; S.gB = 0; }
            else { S.A = (const char*)pA2M; S.B = (const char*)(WSP + WS_WEXPOUT) + (size_t)j * NEXP * DM * EDIM; S.nRT = (int)(c0 >> 8);
                S.P1 = (int)(c1 >> 8); S.P2 = (int)(c2 >> 8); S.P3 = (int)(c3 >> 8); S.P4 = (int)(c4 >> 8); S.P5 = (int)(c5 >> 8); S.P6 = (int)(c6 >> 8); S.P7 = (int)(c7 >> 8);
                S.gB = (size_t)DM * EDIM; }
            S.aE = 0; S.nN = DM / 256; S.nwg = S.nRT * S.nN; S.G = F.G; S.c = (int)blockIdx.x; S.nkt = Kh * eb / 128; S.tA = (size_t)256 * Kh * eb; S.tB = (size_t)256 * Kh * eb;
            if (f8) { EpiStore E{even ? pYO : pHS, DM, 1.f / (F8_SA * F8_SW)}; for (int rep = 0; rep < REP_MOE; ++rep) pg8::gemm_phase<EpiStore, SchedGroup, true>(F.lds, d, S, E); }
            else { EpiStore E{pYO, DM, 1.f}; for (int rep = 0; rep < REP_MOE; ++rep) pg8::gemm_phase<EpiStore, SchedGroup, false>(F.lds, d, S, E); }
        }
        SEAM();
        if (IN() && PH_ON(10)) { REFRAME();
            ThinP P{}; P.nrows = Mrows; P.xin16 = true; P.xout16 = !lastl; P.xin_lat = pX; P.xin_ctx = pX + (size_t)RL * DM;
            if (lastl) P.xout_lat = args.out; else P.xout_lat = pX;
            P.xout_ctx = pX + (size_t)RL * DM; P.ymode = even ? 1 : 2; P.Ysrc = even ? pYO : pHS; P.gate = modl + 5120; P.ga = ng + 3 * DM;
            P.route = pROUTE; P.cnt = F.ctl + CW_CNT + 16 * j;
            if (!lastl) { P.H = pH; P.gb = ng + 4 * DM; P.shsc = modl + 9 * 6144; }
            thin_phase(F, P);
        }
        SEAM();
    }
    if (WAITPROBE) {
        unsigned* wsum = F.ctl + 48;
        if (threadIdx.x == 0) __hip_atomic_fetch_add(wsum, (unsigned)wait_acc, __ATOMIC_RELAXED, __HIP_MEMORY_SCOPE_AGENT);
        xcd_barrier(bar);
        const unsigned mean = xb_ld(wsum) / gridDim.x; const unsigned long long t0_ = __builtin_amdgcn_s_memrealtime();
        while (__builtin_amdgcn_s_memrealtime() - t0_ < (unsigned long long)mean * WAITPROBE) __builtin_amdgcn_s_sleep(8);
    }
#undef IN
#undef SEAM
#undef REFRAME
}

#ifndef MK_PER_PHASE
#define MK_PER_PHASE 0
#endif
extern "C" void kernel_launch(void* const* d_in, const int* in_sizes, int n_in, void* d_out, int out_size, void* d_ws, size_t ws_size, hipStream_t stream) {
    static int grid = 0;
    if (grid == 0) {
        if (n_in != 19 || in_sizes[0] != RL * DM || out_size != RL * DM || ws_size < WS_END) {
            fprintf(stderr, "kernel_launch: unexpected shapes / workspace (n_in %d in0 %d out %d ws %zu need %zu)\n", n_in, n_in > 0 ? in_sizes[0] : -1, out_size, ws_size, (size_t)WS_END); grid = -1; return; }
        int dev = 0, cus = 0, per_cu = 0;
        if (hipGetDevice(&dev) != hipSuccess || hipDeviceGetAttribute(&cus, hipDeviceAttributeMultiprocessorCount, dev) != hipSuccess) { grid = -1; return; }
        if (hipFuncSetAttribute((const void*)dit_fwd, hipFuncAttributeMaxDynamicSharedMemorySize, LDS_BYTES) != hipSuccess) { fprintf(stderr, "kernel_launch: hipFuncSetAttribute failed\n"); grid = -1; return; }
        if (hipOccupancyMaxActiveBlocksPerMultiprocessor(&per_cu, (const void*)dit_fwd, 512, LDS_BYTES) != hipSuccess || per_cu < 1)
            fprintf(stderr, "kernel_launch: occupancy query reports %d\n", per_cu);
        (void)hipGetLastError();
        grid = cus;
    }
    if (grid < 0) return;
    if (hipMemsetAsync((char*)d_ws + WS_CTL, 0, CTL_BYTES, stream) != hipSuccess) return;
    Args a{};
    const float** ap = (const float**)&a;
    for (int i = 0; i < 19; ++i) ap[i] = (const float*)d_in[i];
    a.out = (float*)d_out; a.ws = (unsigned char*)d_ws;
#if MK_PER_PHASE
    for (int p = 0; p < NPHASE; ++p) { a.ph_lo = p; a.ph_hi = p + 1; hipLaunchKernelGGL(dit_fwd, dim3(grid), dim3(512), LDS_BYTES, stream, a); }
#else
    a.ph_lo = 0; a.ph_hi = NPHASE;
    hipLaunchKernelGGL(dit_fwd, dim3(grid), dim3(512), LDS_BYTES, stream, a);
#endif
}
```

```cpp
#include <hip/hip_runtime.h>
#include <cstdio>
#include <cstdint>

#ifndef PHMASK
#define PHMASK 0xFFFFFFFFu
#endif
#define PH_ON(i) ((PHMASK >> (i)) & 1u)
#ifndef REP_DIFF
#define REP_DIFF 1
#endif
#ifndef REP_MOE
#define REP_MOE 1
#endif
#ifndef REP_P0
#define REP_P0 1
#endif
#ifndef REP_P0B
#define REP_P0B 1
#endif
#ifndef EXTRA_BARS
#define EXTRA_BARS 0
#endif
#ifndef REP_EPI
#define REP_EPI 1
#endif
#ifndef WAITSEL
#define WAITSEL 0xFFFFu
#endif
#ifndef WAITPROBE
#define WAITPROBE 0
#endif
#ifndef KREP
#define KREP 1
#endif
#ifndef REP_PROJ
#define REP_PROJ 1
#endif
#ifndef REP_FOUR
#define REP_FOUR 1
#endif
#ifndef REP_WIN
#define REP_WIN 1
#endif
#ifndef PROBE_CLK
#define PROBE_CLK 0
#endif
#define LAS __attribute__((address_space(3)))
#define GAS __attribute__((address_space(1)))
typedef unsigned short bf16_t;
typedef short bf16x8 __attribute__((ext_vector_type(8)));
typedef short s16x4 __attribute__((ext_vector_type(4)));
typedef float f32x2 __attribute__((ext_vector_type(2)));
typedef float f32x4 __attribute__((ext_vector_type(4)));
typedef float f32x16 __attribute__((ext_vector_type(16)));
typedef unsigned u32x2 __attribute__((ext_vector_type(2)));
typedef unsigned u32x4 __attribute__((ext_vector_type(4)));
typedef __bf16 bf16x2_t __attribute__((ext_vector_type(2)));
typedef int v8i_t __attribute__((ext_vector_type(8)));

constexpr int DM = 1024, NB = 8, SEQ = 4096, CTX = 256, DEPTH = 4;
constexpr int RL = NB * SEQ, RC = NB * CTX, RT = RL + RC;
constexpr int MIXIN = 1280, FFN = 2816, NEXP = 8, EDIM = 3584;
constexpr int MAXSLOT = 71680;
constexpr float EPS = 1e-6f;
constexpr float LOG2E = 1.4426950408889634f;
constexpr float QK_C = 0.125f * LOG2E;

constexpr size_t MiB = 1u << 20;
constexpr size_t WS_CTL = 0, CTL_BYTES = 32 * 1024;
constexpr size_t WS_MOD = 1 * MiB;
constexpr size_t WS_ROPE = WS_MOD + 900 * 1024;
constexpr size_t WS_WP = WS_ROPE + 8 * 1024;
constexpr size_t WS_ROUTE = 2 * MiB;
constexpr size_t WS_CS = 4 * MiB;
constexpr size_t WS_CSC = 68 * MiB;
constexpr size_t WS_WMIXIN = 72 * MiB;
constexpr size_t WS_WMIXOUT = 77 * MiB;
constexpr size_t WS_WQKV = 81 * MiB;
constexpr size_t WS_WDOUT = 93 * MiB;
constexpr size_t WS_WFFNIN = 97 * MiB;
constexpr size_t WS_WFFNOUT = 119 * MiB;
constexpr size_t WS_WEXPIN = 130 * MiB;
constexpr size_t WS_WEXPOUT = 354 * MiB;
constexpr size_t WS_X = 466 * MiB;
constexpr size_t WS_H = 602 * MiB;
constexpr size_t WS_YO = 670 * MiB;
constexpr size_t WS_RA = 738 * MiB;
constexpr size_t WS_Z = WS_RA;
constexpr size_t WS_Y = WS_RA + 85 * MiB;
constexpr size_t WS_PQT = WS_RA + 153 * MiB;
constexpr size_t WS_O = WS_RA + 204 * MiB;
constexpr size_t WS_RB = 1010 * MiB;
constexpr size_t WS_A2 = WS_RB;
constexpr size_t WS_PQTC = WS_RB + 190 * MiB;
constexpr size_t WS_A2M = WS_H;
constexpr size_t WS_HS = 1092 * MiB;
constexpr size_t WS_END = 1364 * MiB;
static_assert(WS_A2M + (size_t)MAXSLOT * EDIM * 2 <= WS_HS, "A2m overlay");
static_assert(WS_HS + (size_t)NEXP * RT * DM <= WS_END && WS_HS + (size_t)MAXSLOT * DM * 2 <= WS_END && WS_PQTC + 64 * MiB <= WS_END, "ws end");

constexpr int CW_TMO = 0;
constexpr int CW_CNT = 64;
constexpr int CW_BAR = 4096;

constexpr int RING_BYTES = 131072;
constexpr int MISC_OFF = RING_BYTES + 320;
constexpr int LDS_BYTES = 147456;

__device__ __forceinline__ unsigned cvtpk(float lo, float hi) { f32x2 v = {lo, hi}; bf16x2_t b = __builtin_convertvector(v, bf16x2_t); return __builtin_bit_cast(unsigned, b); }
#ifndef F8_DENSE
#define F8_DENSE false
#endif
#ifndef F8_DDOWN
#define F8_DDOWN true
#endif
#ifndef F8_FOUR
#define F8_FOUR false
#endif
static_assert(!F8_FOUR, "fp8 Fourier path retired");
constexpr int FP = 4096;
constexpr float F8_SCS = 256.f, F8_SPQ = 8.f;
constexpr float F8_SH = 4.f, F8_SW = 64.f, F8_SA = 4.f;
__device__ __forceinline__ float f8clamp(float v) { return __builtin_amdgcn_fmed3f(v, -448.f, 448.f); }
__device__ __forceinline__ unsigned pk4_fp8(float a, float b, float c, float d) {
    unsigned w = 0; w = __builtin_amdgcn_cvt_pk_fp8_f32(f8clamp(a), f8clamp(b), w, false); w = __builtin_amdgcn_cvt_pk_fp8_f32(f8clamp(c), f8clamp(d), w, true); return w; }
__device__ __forceinline__ float bf_lo(unsigned u) { return __uint_as_float(u << 16); }
__device__ __forceinline__ float bf_hi(unsigned u) { return __uint_as_float(u & 0xffff0000u); }
__device__ __forceinline__ float wave_sum(float v, int lane) {
#pragma unroll
    for (int o = 1; o < 64; o <<= 1) v += __int_as_float(__builtin_amdgcn_ds_bpermute((lane ^ o) << 2, __float_as_int(v)));
    return v;
}
__device__ __forceinline__ unsigned rfl(unsigned v) { return (unsigned)__builtin_amdgcn_readfirstlane((int)v); }
__device__ __forceinline__ const char* uptr(const char* p) {
    unsigned lo = (unsigned)__builtin_amdgcn_readfirstlane((int)(unsigned)(uintptr_t)p), hi = (unsigned)__builtin_amdgcn_readfirstlane((int)(unsigned)((uintptr_t)p >> 32));
    asm volatile("" : "+s"(lo), "+s"(hi));
    return (const char*)(((uintptr_t)hi << 32) | lo);
}
__device__ __forceinline__ GAS unsigned char* gptr(const void* p) {
    unsigned lo = (unsigned)__builtin_amdgcn_readfirstlane((int)(unsigned)(uintptr_t)p), hi = (unsigned)__builtin_amdgcn_readfirstlane((int)(unsigned)((uintptr_t)p >> 32));
    asm volatile("" : "+s"(lo), "+s"(hi));
    return (GAS unsigned char*)(((uintptr_t)hi << 32) | lo);
}
__device__ __forceinline__ int sopaque(int v) { v = __builtin_amdgcn_readfirstlane(v); asm volatile("" : "+s"(v)); return v; }
__device__ __forceinline__ int opaque(int v) { asm volatile("" : "+v"(v)); return v; }
#define LDS_WAIT() asm volatile("s_waitcnt lgkmcnt(0)" ::: "memory")
#define VM_WAIT() asm volatile("s_waitcnt vmcnt(0)" ::: "memory")
#define SBAR() __builtin_amdgcn_sched_barrier(0)

namespace pg8 {
constexpr int BM = 256, BK = 64, HALF = 128, HTB = HALF * BK * 2, STAGE_BYTES = 8 * HTB, NXCD = 8, WGM = 8;
__host__ __device__ __forceinline__ int lds_byte(int r, int c) { const int st = (r >> 4) * 2 + (c >> 5), rr = r & 15, cc = c & 31, ob = rr * 64 + cc * 2; return st * 1024 + (ob ^ (((ob >> 9) & 1) << 5)); }
__host__ __device__ __forceinline__ void stage_rc(int b, int& R, int& C) { const int st = b / 1024, sb = b % 1024, swz = sb ^ (((sb >> 9) & 1) << 5); R = (st >> 1) * 16 + swz / 64; C = (st & 1) * 32 + (swz % 64) / 2; }
__host__ __device__ __forceinline__ int perm32(int rho) { const int n = rho >> 4, i = rho & 15; return 8 * (i >> 2) + 4 * n + (i & 3); }

struct Unit { int pm, pn, e, nkt; };
struct Dims { int lda, ldb; };

__device__ __forceinline__ int xcd_remap(int wgid, int nwg) {
    const int q = nwg / NXCD, r = nwg % NXCD, xcd = wgid % NXCD, off = wgid / NXCD;
    return (xcd < r ? xcd * (q + 1) : r * (q + 1) + (xcd - r) * q) + off;
}

#ifndef ALIGN_SWIGLU
#define ALIGN_SWIGLU true
#endif
#ifndef ALIGN_DEFAULT
#define ALIGN_DEFAULT true
#endif
template <class Epi, class Sched, bool F8 = false, bool ALIGN_EPI = ALIGN_DEFAULT>
__device__ __forceinline__ void gemm_phase(LAS unsigned char* lds, const Dims g, const Sched& S, const Epi& E) {
    const int tid = opaque(threadIdx.x), wid = __builtin_amdgcn_readfirstlane(tid >> 6), lane = tid & 63, wr = wid >> 2, wc = wid & 3, fr = lane & 15, fq = lane >> 4;
    unsigned voffA[2], voffB[2];
#pragma unroll
    for (int i = 0; i < 2; ++i) { int R, C; stage_rc(tid * 16 + i * 8192, R, C); const int Rb = Epi::PERM ? ((R & ~31) + perm32(R & 31)) : R;
        voffA[i] = (unsigned)(R * g.lda + C) * 2u; voffB[i] = (unsigned)(Rb * g.ldb + C) * 2u; }
    const size_t kstep = (size_t)(BK * 2);
    const size_t hstepA = (size_t)HALF * g.lda * 2, hstepB = (size_t)HALF * g.ldb * 2;
    const unsigned ldsw = (unsigned)wid * 1024u;
    const int aoff = lds_byte(wr * 64 + fr, fq * 8), boff = lds_byte(wc * 32 + fr, fq * 8);
#define PG8_SA(b, h) (((b) * 2 + (h)) * HTB)
#define PG8_SB(b, h) ((4 + (b) * 2 + (h)) * HTB)
#define PG8_STAGE(bufoff, gbase, voff) do { _Pragma("unroll") for (int _i = 0; _i < 2; ++_i) \
        __builtin_amdgcn_global_load_lds((const unsigned*)((const char*)(gbase) + (voff)[_i]), (LAS unsigned*)(lds + (bufoff) + ldsw + _i * 8192), 16, 0, 0); } while (0)
#define PG8_LDA(dst, b, h) do { _Pragma("unroll") for (int m = 0; m < 4; ++m) _Pragma("unroll") for (int k = 0; k < 2; ++k) dst[m][k] = *(const LAS bf16x8*)(lds + PG8_SA(b, h) + aoff + m * 2048 + k * 1024); } while (0)
#define PG8_LDB(dst, b, h) do { _Pragma("unroll") for (int n = 0; n < 2; ++n) _Pragma("unroll") for (int k = 0; k < 2; ++k) dst[n][k] = *(const LAS bf16x8*)(lds + PG8_SB(b, h) + boff + n * 2048 + k * 1024); } while (0)
#define PG8_V8(x) __builtin_bit_cast(v8i_t, (x))
#define PG8_MMA(ai, bj, At, Bt) do { __builtin_amdgcn_s_setprio(1); _Pragma("unroll") for (int m = 0; m < 4; ++m) _Pragma("unroll") for (int n = 0; n < 2; ++n) { \
        if constexpr (F8) { struct P2 { bf16x8 a, b; }; const v8i_t a8_ = PG8_V8((P2{Bt[n][0], Bt[n][1]})), b8_ = PG8_V8((P2{At[m][0], At[m][1]})); \
            asm volatile("v_mfma_f32_16x16x128_f8f6f4 %0, %1, %2, %0" : "+v"(acc[ai][bj][m][n]) : "v"(a8_), "v"(b8_)); }   \
        else { _Pragma("unroll") for (int k = 0; k < 2; ++k) acc[ai][bj][m][n] = __builtin_amdgcn_mfma_f32_16x16x32_bf16(Bt[n][k], At[m][k], acc[ai][bj][m][n], 0, 0, 0); } } \
        __builtin_amdgcn_s_setprio(0); } while (0)
#define PG8_WAIT_V(n) asm volatile("s_waitcnt vmcnt(" #n ")" ::: "memory")
#define PG8_WAIT_L(n) asm volatile("s_waitcnt lgkmcnt(" #n ")" ::: "memory")
#define PG8_BAR __builtin_amdgcn_s_barrier()
#define PG8_SCHED __builtin_amdgcn_sched_barrier(0)
    Unit cur, nxt; int ui = 0;
    if (!S.next(0, cur)) return;
    constexpr bool MIR = Sched::MIRROR;
    unsigned vB2c[2] = {0u, 0u}, vB2n[2] = {0u, 0u}; const char* cB2 = nullptr; const char* nB2 = nullptr;
#define PG8_MKV2(dst, un) do { const int t2_ = opaque(threadIdx.x); _Pragma("unroll") for (int i_ = 0; i_ < 2; ++i_) { int R_, C_; stage_rc(t2_ * 16 + i_ * 8192, R_, C_); \
        const int Rb_ = Epi::PERM ? ((R_ & ~31) + perm32(R_ & 31)) : R_; dst[i_] = S.voff2(un, Rb_, C_, g.ldb); } } while (0)
    if constexpr (MIR) { PG8_MKV2(vB2c, cur); cB2 = uptr(S.bptr2(cur)); }
    f32x4 acc[2][2][4][2];
#pragma unroll
    for (int a = 0; a < 2; ++a)
#pragma unroll
        for (int b = 0; b < 2; ++b)
#pragma unroll
            for (int m = 0; m < 4; ++m)
#pragma unroll
                for (int n = 0; n < 2; ++n) acc[a][b][m][n] = (f32x4){0.f, 0.f, 0.f, 0.f};
    bf16x8 At[4][2], B0[2][2], B1[2][2];
    const char* cA = uptr(S.aptr(cur)); const char* cB = uptr(S.bptr(cur));
    PG8_STAGE(PG8_SB(0, 0), cB, voffB); if constexpr (MIR) PG8_STAGE(PG8_SB(0, 1), cB2, vB2c); else PG8_STAGE(PG8_SB(0, 1), cB + hstepB, voffB); PG8_STAGE(PG8_SA(0, 0), cA, voffA); PG8_STAGE(PG8_SA(0, 1), cA + hstepA, voffA);
    if (wr == 1) PG8_BAR;
    PG8_WAIT_V(2); PG8_BAR;
    PG8_STAGE(PG8_SB(1, 0), cB + kstep, voffB); PG8_STAGE(PG8_SA(1, 0), cA + kstep, voffA); if constexpr (MIR) PG8_STAGE(PG8_SB(1, 1), cB2 + kstep, vB2c); else PG8_STAGE(PG8_SB(1, 1), cB + hstepB + kstep, voffB);
    PG8_WAIT_V(6); PG8_BAR;
    for (;;) {
        const bool has_next = S.next(ui + 1, nxt);
        const char* nA = uptr(has_next ? S.aptr(nxt) : cA); const char* nB = uptr(has_next ? S.bptr(nxt) : cB);
        if constexpr (MIR) { if (has_next) { PG8_MKV2(vB2n, nxt); nB2 = uptr(S.bptr2(nxt)); } else { vB2n[0] = vB2c[0]; vB2n[1] = vB2c[1]; nB2 = cB2; } }
        const int nt = sopaque(cur.nkt);
        for (int t = 0; t < KREP * nt; t += 2) {
            const bool last = (t == KREP * nt - 2);
            const char* a1 = cA + (size_t)(KREP == 1 ? t + 1 : (t + 1) % nt) * kstep;
            const char* a2 = last ? nA : cA + (size_t)(KREP == 1 ? t + 2 : (t + 2) % nt) * kstep; const char* b2 = last ? nB : cB + (size_t)(KREP == 1 ? t + 2 : (t + 2) % nt) * kstep;
            const char* a3 = a2 + kstep; const char* b3 = b2 + kstep;
            const char* m2 = nullptr; unsigned vm[2] = {0u, 0u};
            if constexpr (MIR) { m2 = last ? nB2 : cB2 + (size_t)(t + 2) * kstep; vm[0] = last ? vB2n[0] : vB2c[0]; vm[1] = last ? vB2n[1] : vB2c[1]; }
            PG8_LDB(B0, 0, 0); PG8_LDB(B1, 0, 1); PG8_SCHED; PG8_LDA(At, 0, 0); PG8_STAGE(PG8_SA(1, 1), a1 + hstepA, voffA);
            PG8_WAIT_V(8); PG8_WAIT_L(0); PG8_BAR; PG8_MMA(0, 0, At, B0); PG8_MMA(0, 1, At, B1); PG8_BAR; PG8_SCHED;
            PG8_LDA(At, 0, 1); PG8_STAGE(PG8_SB(0, 0), b2, voffB); if constexpr (MIR) PG8_STAGE(PG8_SB(0, 1), m2, vm); else PG8_STAGE(PG8_SB(0, 1), b2 + hstepB, voffB); PG8_STAGE(PG8_SA(0, 0), a2, voffA);
            PG8_WAIT_V(8); PG8_WAIT_L(0); PG8_BAR; PG8_MMA(1, 0, At, B0); PG8_MMA(1, 1, At, B1); PG8_BAR; PG8_SCHED;
            PG8_LDB(B0, 1, 0); PG8_LDB(B1, 1, 1); PG8_SCHED; PG8_LDA(At, 1, 0); PG8_STAGE(PG8_SA(0, 1), a2 + hstepA, voffA);
            PG8_WAIT_V(8); PG8_WAIT_L(0); PG8_BAR; PG8_MMA(0, 0, At, B0); PG8_MMA(0, 1, At, B1); PG8_BAR; PG8_SCHED;
            PG8_LDA(At, 1, 1); PG8_STAGE(PG8_SB(1, 0), b3, voffB); if constexpr (MIR) PG8_STAGE(PG8_SB(1, 1), m2 + kstep, vm); else PG8_STAGE(PG8_SB(1, 1), b3 + hstepB, voffB); PG8_STAGE(PG8_SA(1, 0), a3, voffA);
            PG8_WAIT_V(8); PG8_WAIT_L(0); PG8_BAR; PG8_MMA(1, 0, At, B0); PG8_MMA(1, 1, At, B1); PG8_BAR; PG8_SCHED;
        }
        if constexpr (ALIGN_EPI) { if (wr == 0) PG8_BAR; }
        if constexpr (F8) asm volatile("s_nop 15\n\ts_nop 15" ::: "memory");
        for (int repe = 0; repe < REP_EPI; ++repe) { const int l2 = opaque(threadIdx.x) & 63; E(acc, cur, wr, wc, l2 & 15, l2 >> 4); }
        if (!has_next) break;
#pragma unroll
        for (int a = 0; a < 2; ++a)
#pragma unroll
            for (int b = 0; b < 2; ++b)
#pragma unroll
                for (int m = 0; m < 4; ++m)
#pragma unroll
                    for (int n = 0; n < 2; ++n) acc[a][b][m][n] = (f32x4){0.f, 0.f, 0.f, 0.f};
        cur = nxt; cA = nA; cB = nB; ++ui;
        if constexpr (MIR) { cB2 = nB2; vB2c[0] = vB2n[0]; vB2c[1] = vB2n[1]; }
        if constexpr (ALIGN_EPI) { if (wr == 1) PG8_BAR; }
    }
    PG8_WAIT_V(0);
    if constexpr (!ALIGN_EPI) { if (wr == 0) PG8_BAR; }
    PG8_BAR;
#undef PG8_MKV2
#undef PG8_SA
#undef PG8_SB
#undef PG8_STAGE
#undef PG8_LDA
#undef PG8_LDB
#undef PG8_MMA
#undef PG8_V8
#undef PG8_WAIT_V
#undef PG8_WAIT_L
#undef PG8_BAR
#undef PG8_SCHED
}
}
using pg8::Unit;

struct EpiStore {
    static constexpr bool PERM = true;
    bf16_t* O; int ldc; float scale;
    __device__ __forceinline__ void operator()(const f32x4 (&acc)[2][2][4][2], const Unit& u, int wr, int wc, int fr, int fq) const {
        const int row0 = u.pm * 256 + wr * 64 + fr, col0 = u.pn * 256 + wc * 32 + 8 * fq;
#pragma unroll
        for (int ai = 0; ai < 2; ++ai)
#pragma unroll
            for (int m = 0; m < 4; ++m) { bf16_t* rowp = O + (size_t)(row0 + ai * 128 + m * 16) * ldc + col0;
#pragma unroll
                for (int bj = 0; bj < 2; ++bj) { const f32x4 v0 = acc[ai][bj][m][0] * (scale * (1.f / KREP)), v1 = acc[ai][bj][m][1] * (scale * (1.f / KREP));
                    u32x4 w; w.x = cvtpk(v0[0], v0[1]); w.y = cvtpk(v0[2], v0[3]); w.z = cvtpk(v1[0], v1[1]); w.w = cvtpk(v1[2], v1[3]);
                    *(u32x4*)(rowp + bj * 128) = w; } }
    }
};
template <bool F8OUT> struct EpiSwiglu {
    static constexpr bool PERM = true;
    unsigned char* O; int ldc; float scale;
    __device__ __forceinline__ void operator()(const f32x4 (&acc)[2][2][4][2], const Unit& u, int wr, int wc, int fr, int fq) const {
        const int row0 = u.pm * 256 + wr * 64 + fr, col0 = u.pn * 128 + wc * 32 + 8 * fq;
        const float us = F8OUT ? scale * F8_SA : scale;
        const float k1 = -scale * LOG2E * (1.f / KREP), ik2 = 1.f / (scale * us * (1.f / KREP) * (1.f / KREP));
#pragma unroll
        for (int ai = 0; ai < 2; ++ai)
#pragma unroll
            for (int m = 0; m < 4; ++m) { unsigned char* rowp = O + ((size_t)(row0 + ai * 128 + m * 16) * ldc + col0) * (F8OUT ? 1 : 2);
                float r[8];
#pragma unroll
                for (int n = 0; n < 2; ++n) { const f32x4 g = acc[ai][0][m][n], u = acc[ai][1][m][n]; const f32x4 t = g * k1;
                    f32x4 e; e[0] = __builtin_amdgcn_exp2f(t[0]); e[1] = __builtin_amdgcn_exp2f(t[1]); e[2] = __builtin_amdgcn_exp2f(t[2]); e[3] = __builtin_amdgcn_exp2f(t[3]);
                    const f32x4 d = e * ik2 + ik2;
                    f32x4 q; q[0] = __builtin_amdgcn_rcpf(d[0]); q[1] = __builtin_amdgcn_rcpf(d[1]); q[2] = __builtin_amdgcn_rcpf(d[2]); q[3] = __builtin_amdgcn_rcpf(d[3]);
                    const f32x4 o = (g * u) * q; r[n * 4 + 0] = o[0]; r[n * 4 + 1] = o[1]; r[n * 4 + 2] = o[2]; r[n * 4 + 3] = o[3]; }
                if constexpr (F8OUT) { u32x2 w; w.x = pk4_fp8(r[0], r[1], r[2], r[3]); w.y = pk4_fp8(r[4], r[5], r[6], r[7]); *(u32x2*)rowp = w; }
                else { u32x4 w; w.x = cvtpk(r[0], r[1]); w.y = cvtpk(r[2], r[3]); w.z = cvtpk(r[4], r[5]); w.w = cvtpk(r[6], r[7]); *(u32x4*)rowp = w; } }
    }
};
struct EpiRope {
    static constexpr bool PERM = false;
    bf16_t* O; int ldc; int rlo, rhi; const f32x2* cs;
    int qlo, qhi; float qscale;
    __device__ __forceinline__ void operator()(const f32x4 (&acc)[2][2][4][2], const Unit& u, int wr, int wc, int fr, int fq) const {
        const int row0 = u.pm * 256 + wr * 64 + fr, col0 = u.pn * 256 + wc * 32 + 4 * fq;
        const bool lat = u.pm < 128;
#pragma unroll
        for (int ai = 0; ai < 2; ++ai)
#pragma unroll
            for (int m = 0; m < 4; ++m) { const int row = row0 + ai * 128 + m * 16; bf16_t* rowp = O + (size_t)row * ldc + col0;
                const int t = row & 4095, pos = (wc & 1) ? (t & 63) : (t >> 6);
                const f32x2* c4 = cs + pos * 16 + 4 * fq;
                const f32x2 c0 = c4[0], c1 = c4[1], c2 = c4[2], c3 = c4[3];
#pragma unroll
                for (int bj = 0; bj < 2; ++bj) { f32x4 p1 = acc[ai][bj][m][0] * (1.f / KREP), p2 = acc[ai][bj][m][1] * (1.f / KREP);
                    const int blk = u.pn * 2 + bj;
                    if (lat && blk >= rlo && blk < rhi) {
                        const f32x4 cv = {c0.x, c1.x, c2.x, c3.x}, sv = {c0.y, c1.y, c2.y, c3.y};
                        const f32x4 o1 = p1 * cv - p2 * sv, o2 = p2 * cv + p1 * sv; p1 = o1; p2 = o2; }
                    if (blk >= qlo && blk < qhi) { p1 = p1 * qscale; p2 = p2 * qscale; }
                    u32x2 w1, w2; w1.x = cvtpk(p1[0], p1[1]); w1.y = cvtpk(p1[2], p1[3]); w2.x = cvtpk(p2[0], p2[1]); w2.y = cvtpk(p2[2], p2[3]);
                    *(u32x2*)(rowp + bj * 128) = w1; *(u32x2*)(rowp + bj * 128 + 16) = w2; } }
    }
};
struct EpiPQt {
    static constexpr bool PERM = true;
    bf16_t* Plat; bf16_t* Pctx;
    __device__ __forceinline__ void operator()(const f32x4 (&acc)[2][2][4][2], const Unit& u, int wr, int wc, int fr, int fq) const {
        const bool ctx = u.e >= 32; const int bg = ctx ? u.e - 32 : u.e;
        bf16_t* base = (ctx ? Pctx : Plat) + (size_t)bg * 128 * FP;
        if (ctx) {
            const int col0 = wc * 32 + 8 * fq;
#pragma unroll
            for (int ai = 0; ai < 2; ++ai)
#pragma unroll
                for (int m = 0; m < 4; ++m) { bf16_t* rowp = base + (size_t)(wr * 64 + m * 16 + fr) * FP + ai * CTX + col0;
#pragma unroll
                    for (int bj = 0; bj < 2; ++bj) { const f32x4 v0 = acc[ai][bj][m][0] * (1.f / KREP), v1 = acc[ai][bj][m][1] * (1.f / KREP);
                        u32x4 w; w.x = cvtpk(v0[0], v0[1]); w.y = cvtpk(v0[2], v0[3]); w.z = cvtpk(v1[0], v1[1]); w.w = cvtpk(v1[2], v1[3]); *(u32x4*)(rowp + bj * 128) = w; } }
        } else {
            const int col0 = u.pn * 128 + wc * 32 + 8 * fq;
            const bool sp = u.pn == 0 && wc == 0 && fq == 0;
#pragma unroll
            for (int m = 0; m < 4; ++m) { bf16_t* rowp = base + (size_t)(wr * 64 + m * 16 + fr) * FP + col0;
                f32x4 p0 = (acc[0][0][m][0] + acc[0][1][m][0]) * (1.f / KREP), p1 = (acc[0][0][m][1] + acc[0][1][m][1]) * (1.f / KREP);
                f32x4 q0 = (acc[1][0][m][0] - acc[1][1][m][0]) * (1.f / KREP), q1 = (acc[1][0][m][1] - acc[1][1][m][1]) * (1.f / KREP);
                if (sp) { p0[0] = acc[0][0][m][0][0] * (1.f / KREP); q0[0] = acc[0][1][m][0][0] * (1.f / KREP); }
                u32x4 w; w.x = cvtpk(p0[0], p0[1]); w.y = cvtpk(p0[2], p0[3]); w.z = cvtpk(p1[0], p1[1]); w.w = cvtpk(p1[2], p1[3]); *(u32x4*)rowp = w;
                w.x = cvtpk(q0[0], q0[1]); w.y = cvtpk(q0[2], q0[3]); w.z = cvtpk(q1[0], q1[1]); w.w = cvtpk(q1[2], q1[3]); *(u32x4*)(rowp + 2048) = w; }
        }
    }
};
struct EpiFour2 {
    static constexpr bool PERM = true;
    bf16_t* O;
    __device__ __forceinline__ void operator()(const f32x4 (&acc)[2][2][4][2], const Unit& u, int wr, int wc, int fr, int fq) const {
        EpiStore s{O, DM, (u.pm < 128 ? 0.0013810679320049757f   : 0.005524271728019903f  )};
        s(acc, u, wr, wc, fr, fq);
    }
};

struct SchedDense {
    static constexpr bool MIRROR = false;
    const char* A; const char* B; int nM, nN, nwg, G, c, nkt; size_t tA, tB;
    __device__ __forceinline__ void init(const void* A_, int lda, const void* B_, int ldb, int M, int N, int K, int G_, int c_) {
        A = (const char*)A_; B = (const char*)B_; nM = M / 256; nN = N / 256; nwg = nM * nN; G = G_; c = c_; nkt = K / 64; tA = (size_t)256 * lda * 2; tB = (size_t)256 * ldb * 2; }
    __device__ __forceinline__ bool next(int i, Unit& u) const {
        const long L = (long)i * G + c; if (L >= nwg) return false;
        const int wgid = pg8::xcd_remap((int)L, nwg);
        const int nig = pg8::WGM * nN, gid = wgid / nig, fm = gid * pg8::WGM, gsz = (nM - fm) < pg8::WGM ? (nM - fm) : pg8::WGM;
        u.pm = fm + ((wgid % nig) % gsz); u.pn = (wgid % nig) / gsz; u.e = 0; u.nkt = nkt; return true;
    }
    __device__ __forceinline__ const char* aptr(const Unit& u) const { return A + (size_t)u.pm * tA; }
    __device__ __forceinline__ const char* bptr(const Unit& u) const { return B + (size_t)u.pn * tB; }
};
struct SchedGroup {
    static constexpr bool MIRROR = false;
    const char* A; const char* B; int P1, P2, P3, P4, P5, P6, P7, nRT, nN, nwg, G, c, nkt; size_t tA, tB, gB, aE;
    __device__ __forceinline__ bool next(int i, Unit& u) const {
        const long L = (long)i * G + c; if (L >= nwg) return false;
        const int wgid = pg8::xcd_remap((int)L, nwg);
        const int nig = pg8::WGM * nN, gid = wgid / nig, fm = gid * pg8::WGM, gsz = (nRT - fm) < pg8::WGM ? (nRT - fm) : pg8::WGM;
        const int rt = fm + ((wgid % nig) % gsz);
        u.pm = rt; u.pn = (wgid % nig) / gsz; u.nkt = nkt;
        u.e = (rt >= P1) + (rt >= P2) + (rt >= P3) + (rt >= P4) + (rt >= P5) + (rt >= P6) + (rt >= P7); return true;
    }
    __device__ __forceinline__ const char* aptr(const Unit& u) const {
        if (aE == 0) return A + (size_t)u.pm * tA;
        const int pe = u.e == 0 ? 0 : u.e == 1 ? P1 : u.e == 2 ? P2 : u.e == 3 ? P3 : u.e == 4 ? P4 : u.e == 5 ? P5 : u.e == 6 ? P6 : P7;
        return A + (size_t)u.e * aE + (size_t)(u.pm - pe) * tA; }
    __device__ __forceinline__ const char* bptr(const Unit& u) const { return B + (size_t)u.e * gB + (size_t)u.pn * tB; }
};
struct SchedF1 {
    static constexpr bool MIRROR = true;
    const char* Wp; const char* Z; int G, c;
    __device__ __forceinline__ bool next(int i, Unit& u) const {
        const int L = i * G + c; if (L >= 544) return false;
        u.pm = 0; u.nkt = 2;
        if (L < 512) { u.e = L >> 4; u.pn = L & 15; } else { u.e = 32 + (L - 512); u.pn = 0; }
        return true;
    }
    __device__ __forceinline__ const char* aptr(const Unit&) const { return Wp; }
    __device__ __forceinline__ const char* bptr(const Unit& u) const {
        const bool ctx = u.e >= 32; const int bg = ctx ? u.e - 32 : u.e, b = bg >> 2, gq = bg & 3;
        const size_t row0 = ctx ? (size_t)RL + b * CTX : (size_t)b * SEQ + u.pn * 128;
        return Z + (row0 * MIXIN + gq * 128) * 2; }
    __device__ __forceinline__ const char* bptr2(const Unit& u) const {
        const bool ctx = u.e >= 32; const int bg = ctx ? u.e - 32 : u.e, b = bg >> 2, gq = bg & 3;
        const size_t row0 = ctx ? (size_t)RL + b * CTX + 128 : (size_t)b * SEQ;
        return Z + (row0 * MIXIN + gq * 128) * 2; }
    __device__ __forceinline__ unsigned voff2(const Unit& u, int R, int C, int ldb) const {
        const int tok = u.e >= 32 ? R : (u.pn == 0 && R == 0) ? 2048 : 4096 - 128 * u.pn - R;
        return (unsigned)(tok * ldb + C) * 2u; }
};
struct SchedF2 {
    static constexpr bool MIRROR = false;
    const char* CSl; const char* CSc; const char* Plat; const char* Pctx; int G, vcu;
    static constexpr size_t EB = 2;
    __device__ __forceinline__ bool next(int i, Unit& u) const {
        const int L = i * G + vcu; if (L >= 272) return false;
        if (L < 256) { const int b = L >> 5, mt = (L & 31) >> 1; u.pm = b * 16 + mt; u.pn = L & 1; u.e = b; u.nkt = 64; }
        else { const int b = (L - 256) >> 1; u.pm = 128 + b; u.pn = L & 1; u.e = 8 + b; u.nkt = 8; }
        return true;
    }
    __device__ __forceinline__ const char* aptr(const Unit& u) const { return u.e < 8 ? CSl + (size_t)(u.pm & 15) * 256 * FP * EB : CSc; }
    __device__ __forceinline__ const char* bptr(const Unit& u) const { return (u.e < 8 ? Plat + (size_t)u.e * 512 * FP * EB : Pctx + (size_t)(u.e - 8) * 512 * FP * EB) + (size_t)u.pn * 256 * FP * EB; }
};

#define XB_TMO      128
#define XB_XCNT(j)  (256  + 64 * (j))
#define XB_XSUB(j)  (1280 + 64 * (j))
#define XB_XGEN(j)  (2304 + 64 * (j))
#define XB_TOP      3328
#define XB_TOPGEN   3392
#define XCD_BAR_WORDS 3456
#define XB_SPIN_CAP (1u << 21)
__device__ __forceinline__ unsigned xb_ld(unsigned* p)              { return __hip_atomic_load(p, __ATOMIC_RELAXED, __HIP_MEMORY_SCOPE_AGENT); }
__device__ __forceinline__ unsigned xb_add(unsigned* p, unsigned v) { return __hip_atomic_fetch_add(p, v, __ATOMIC_RELAXED, __HIP_MEMORY_SCOPE_AGENT); }
__device__ __forceinline__ unsigned xb_xcc_id() { return (unsigned)__builtin_amdgcn_s_getreg((3 << 11) | 20) & 0xFu; }
#define XB_SPIN(cond, bar) do { unsigned _sp = 0; while (cond) { __builtin_amdgcn_s_sleep(1); \
    if ((++_sp & 255u) == 0u) { if (xb_ld(&(bar)[XB_TMO])) break; if (_sp > XB_SPIN_CAP) { atomicAdd(&(bar)[XB_TMO], 1u); break; } } } } while (0)
struct XcdBarrier { unsigned* bar; unsigned x; volatile LAS unsigned* st; };
__device__ __forceinline__ XcdBarrier xcd_barrier_post(unsigned* bar, volatile LAS unsigned* st) {
    XcdBarrier b; b.bar = bar; b.x = xb_xcc_id(); b.st = st;
    if (threadIdx.x == 0) (void)xb_add(&bar[XB_XCNT(b.x)], 1u);
    return b;
}
__device__ __forceinline__ void xcd_barrier_complete(unsigned* bar, unsigned x, unsigned& nloc, unsigned& nx) {
    const unsigned G = gridDim.x * gridDim.y * gridDim.z;
    unsigned sum, cnt, mine, sp = 0u;
    for (;;) {
        sum = 0u; cnt = 0u; mine = 0u;
#pragma unroll
        for (unsigned j = 0; j < 16; ++j) { const unsigned c = xb_ld(&bar[XB_XCNT(j)]); sum += c; cnt += (c > 0u) ? 1u : 0u; mine = (j == x) ? c : mine; }
        if (sum == G) break;
        __builtin_amdgcn_s_sleep(1);
        if ((++sp & 255u) == 0u) { if (xb_ld(&bar[XB_TMO])) break; if (sp > XB_SPIN_CAP) { atomicAdd(&bar[XB_TMO], 1u); break; } }
    }
    nloc = mine > 0u ? mine : 1u; nx = cnt > 0u ? cnt : 1u;
}
__device__ __forceinline__ void xcd_barrier(const XcdBarrier& b) {
    asm volatile("s_waitcnt vmcnt(0)" ::: "memory");
    __syncthreads();
    if (threadIdx.x == 0) {
        unsigned* bar = (unsigned*)uptr((const char*)b.bar);
        __builtin_amdgcn_s_waitcnt(0);
        unsigned nloc = b.st[0], nx = b.st[1];
        if (nloc == 0u) { xcd_barrier_complete(bar, b.x, nloc, nx); b.st[0] = nloc; b.st[1] = nx; }
        const unsigned old = xb_add(&bar[XB_XSUB(b.x)], 1u);
        const unsigned gen = old / nloc;
        if (old + 1u == (gen + 1u) * nloc) {
            __builtin_amdgcn_fence(__ATOMIC_RELEASE, "agent");
            asm volatile("s_waitcnt vmcnt(0)" ::: "memory");
            const unsigned og = xb_add(&bar[XB_TOP], 1u);
            const unsigned tg = og / nx;
            if (og + 1u == (tg + 1u) * nx) xb_add(&bar[XB_TOPGEN], 1u);
            else XB_SPIN(xb_ld(&bar[XB_TOPGEN]) == tg, bar);
            __builtin_amdgcn_fence(__ATOMIC_ACQUIRE, "agent");
            xb_add(&bar[XB_XGEN(b.x)], 1u);
            asm volatile("s_waitcnt vmcnt(0)" ::: "memory");
        } else {
            XB_SPIN(xb_ld(&bar[XB_XGEN(b.x)]) == gen, bar);
            __builtin_amdgcn_fence(__ATOMIC_ACQUIRE, "agent");
            asm volatile("s_waitcnt vmcnt(0)" ::: "memory");
        }
    }
    __syncthreads();
}

__device__ __forceinline__ int crow(int r, int hi) { return (r & 3) + 8 * (r >> 2) + 4 * hi; }
template <int KW> __device__ __forceinline__ int kswz(int row, int colB) { return KW == 128 ? row * 256 + (colB ^ ((row & 7) << 4)) : row * 128 + (colB ^ (((row >> 1) & 7) << 4)); }
template <int DV> __device__ __forceinline__ int v_st(int k, int c) { const int kk = (k & ~0xC) | ((k & 4) << 1) | ((k & 8) >> 1); return ((kk >> 3) * (DV / 32) + (c >> 5)) * 512 + ((kk & 7) * 32 + (c & 31)) * 2; }
__device__ __forceinline__ int v_rd_base(int lane) { return ((lane & 3) << 3) | (((lane >> 2) & 3) << 6) | (((lane >> 4) & 1) << 5) | (((lane >> 5) & 1) << 8); }
template <int OFF> __device__ __forceinline__ s16x4 tr_read(int vb) { s16x4 r; asm volatile("ds_read_b64_tr_b16 %0, %1 offset:%2" : "=&v"(r) : "v"(vb), "i"(OFF) : "memory"); return r; }
template <int DV, int D0> __device__ __forceinline__ void pv_one(f32x16& od, int vb, bf16x8 pa0, bf16x8 pa1, bf16x8 pa2, bf16x8 pa3) {
    constexpr int KS = (DV / 32) * 1024, HF = (DV / 32) * 512;
    const s16x4 l0 = tr_read<D0 * 512 + 0 * KS>(vb), h0 = tr_read<D0 * 512 + 0 * KS + HF>(vb), l1 = tr_read<D0 * 512 + 1 * KS>(vb), h1 = tr_read<D0 * 512 + 1 * KS + HF>(vb);
    const s16x4 l2 = tr_read<D0 * 512 + 2 * KS>(vb), h2 = tr_read<D0 * 512 + 2 * KS + HF>(vb), l3 = tr_read<D0 * 512 + 3 * KS>(vb), h3 = tr_read<D0 * 512 + 3 * KS + HF>(vb);
    asm volatile("s_waitcnt lgkmcnt(0)" ::: "memory"); SBAR();
#define PKV(L, H) (bf16x8){L[0], L[1], L[2], L[3], H[0], H[1], H[2], H[3]}
    od = __builtin_amdgcn_mfma_f32_32x32x16_bf16(pa0, PKV(l0, h0), od, 0, 0, 0);
    od = __builtin_amdgcn_mfma_f32_32x32x16_bf16(pa1, PKV(l1, h1), od, 0, 0, 0);
    od = __builtin_amdgcn_mfma_f32_32x32x16_bf16(pa2, PKV(l2, h2), od, 0, 0, 0);
    od = __builtin_amdgcn_mfma_f32_32x32x16_bf16(pa3, PKV(l3, h3), od, 0, 0, 0);
#undef PKV
}
#define PV_RD(D0, L, H) do { L[0] = tr_read<(D0) * 512 + 0 * KS>(vb); H[0] = tr_read<(D0) * 512 + 0 * KS + HF>(vb); L[1] = tr_read<(D0) * 512 + 1 * KS>(vb); H[1] = tr_read<(D0) * 512 + 1 * KS + HF>(vb); \
    L[2] = tr_read<(D0) * 512 + 2 * KS>(vb); H[2] = tr_read<(D0) * 512 + 2 * KS + HF>(vb); L[3] = tr_read<(D0) * 512 + 3 * KS>(vb); H[3] = tr_read<(D0) * 512 + 3 * KS + HF>(vb); } while (0)
#define PV_MM(od, L, H) do { od = __builtin_amdgcn_mfma_f32_32x32x16_bf16(pa0, PKV(L[0], H[0]), od, 0, 0, 0); od = __builtin_amdgcn_mfma_f32_32x32x16_bf16(pa1, PKV(L[1], H[1]), od, 0, 0, 0); \
    od = __builtin_amdgcn_mfma_f32_32x32x16_bf16(pa2, PKV(L[2], H[2]), od, 0, 0, 0); od = __builtin_amdgcn_mfma_f32_32x32x16_bf16(pa3, PKV(L[3], H[3]), od, 0, 0, 0); } while (0)
#define PKV(L, H) (bf16x8){L[0], L[1], L[2], L[3], H[0], H[1], H[2], H[3]}
template <int DV> __device__ __forceinline__ void pv_all(f32x16* o, int vb, bf16x8 pa0, bf16x8 pa1, bf16x8 pa2, bf16x8 pa3) {
    constexpr int KS = (DV / 32) * 1024, HF = (DV / 32) * 512;
    s16x4 la[4], ha[4], lb[4], hb[4];
    PV_RD(0, la, ha);
    PV_RD(1, lb, hb); asm volatile("s_waitcnt lgkmcnt(8)" ::: "memory"); SBAR(); PV_MM(o[0], la, ha);
    if constexpr (DV == 128) {
        PV_RD(2, la, ha); asm volatile("s_waitcnt lgkmcnt(8)" ::: "memory"); SBAR(); PV_MM(o[1], lb, hb);
        PV_RD(3, lb, hb); asm volatile("s_waitcnt lgkmcnt(8)" ::: "memory"); SBAR(); PV_MM(o[2], la, ha);
        asm volatile("s_waitcnt lgkmcnt(0)" ::: "memory"); SBAR(); PV_MM(o[3], lb, hb);
    } else {
        asm volatile("s_waitcnt lgkmcnt(0)" ::: "memory"); SBAR(); PV_MM(o[1], lb, hb);
    }
}
#undef PV_RD
#undef PV_MM
#undef PKV
template <int KW> __device__ __forceinline__ void qkt64(f32x16& p0, f32x16& p1, const char* Ks, const bf16x8* qr, int kcb, int r32, int hi) {
    bf16x8 kb0[4], kb1[4];
#pragma unroll
    for (int d0 = 0; d0 < 4; ++d0) { const int cb = kcb + (d0 * 16 + hi * 8) * 2;
        kb0[d0] = *reinterpret_cast<const bf16x8*>(Ks + kswz<KW>(r32, cb));
        kb1[d0] = *reinterpret_cast<const bf16x8*>(Ks + kswz<KW>(32 + r32, cb)); }
    p0 = f32x16{}; p1 = f32x16{};
#pragma unroll
    for (int d0 = 0; d0 < 4; ++d0) {
        p0 = __builtin_amdgcn_mfma_f32_32x32x16_bf16(kb0[d0], qr[d0], p0, 0, 0, 0);
        p1 = __builtin_amdgcn_mfma_f32_32x32x16_bf16(kb1[d0], qr[d0], p1, 0, 0, 0); }
}
template <int KW> __device__ __forceinline__ void qkt64n(f32x16& p0, f32x16& p1, const char* Ks, const bf16x8* qr, int kcb, int r32, int hi, const f32x16& cinit) {
#pragma unroll
    for (int d0 = 0; d0 < 4; ++d0) { const int cb = kcb + (d0 * 16 + hi * 8) * 2;
        const bf16x8 b0 = *reinterpret_cast<const bf16x8*>(Ks + kswz<KW>(r32, cb));
        const bf16x8 b1 = *reinterpret_cast<const bf16x8*>(Ks + kswz<KW>(32 + r32, cb));
        if (d0 == 0) { p0 = __builtin_amdgcn_mfma_f32_32x32x16_bf16(b0, qr[0], cinit, 0, 0, 0); p1 = __builtin_amdgcn_mfma_f32_32x32x16_bf16(b1, qr[0], cinit, 0, 0, 0); }
        else { p0 = __builtin_amdgcn_mfma_f32_32x32x16_bf16(b0, qr[d0], p0, 0, 0, 0); p1 = __builtin_amdgcn_mfma_f32_32x32x16_bf16(b1, qr[d0], p1, 0, 0, 0); } }
}
template <int ND> __device__ __forceinline__ void softmax_step(f32x16& p0, f32x16& p1, float& m_reg, float& l_reg, f32x16* o, float* al_l, int r32, int hi,
                                                              bf16x8& pa0, bf16x8& pa1, bf16x8& pa2, bf16x8& pa3) {
    float pmax = p0[0];
#pragma unroll
    for (int r = 1; r < 16; ++r) pmax = fmaxf(pmax, p0[r]);
#pragma unroll
    for (int r = 0; r < 16; ++r) pmax = fmaxf(pmax, p1[r]);
    { auto rr = __builtin_amdgcn_permlane32_swap(__float_as_uint(pmax), __float_as_uint(pmax), false, false); pmax = fmaxf(__uint_as_float(rr[0]), __uint_as_float(rr[1])); }
    const float mn = fmaxf(m_reg, pmax);
    const float alpha = __builtin_amdgcn_exp2f((m_reg - mn) * QK_C); m_reg = mn;
    const float mnC = -mn * QK_C;
#pragma unroll
    for (int r = 0; r < 16; ++r) { p0[r] = __builtin_amdgcn_exp2f(fmaf(p0[r], QK_C, mnC)); p1[r] = __builtin_amdgcn_exp2f(fmaf(p1[r], QK_C, mnC)); }
    float ps = 0.f;
#pragma unroll
    for (int r = 0; r < 16; ++r) ps += p0[r] + p1[r];
    { auto rr = __builtin_amdgcn_permlane32_swap(__float_as_uint(ps), __float_as_uint(ps), false, false); ps = __uint_as_float(rr[0]) + __uint_as_float(rr[1]); }
    l_reg = l_reg * alpha + ps;
    if (__any(alpha < 1.f)) { if (hi == 0) al_l[r32] = alpha; LDS_WAIT();
#pragma unroll
        for (int d = 0; d < ND; ++d)
#pragma unroll
            for (int r = 0; r < 16; ++r) o[d][r] *= al_l[crow(r, hi)];
    }
#define PK4(P, BASE, OUT) do { unsigned a0 = cvtpk(P[BASE + 0], P[BASE + 1]), a1 = cvtpk(P[BASE + 2], P[BASE + 3]);   \
    unsigned b0 = cvtpk(P[BASE + 4], P[BASE + 5]), b1 = cvtpk(P[BASE + 6], P[BASE + 7]);                              \
    auto r0 = __builtin_amdgcn_permlane32_swap(a0, b0, false, false); auto r1 = __builtin_amdgcn_permlane32_swap(a1, b1, false, false); \
    u32x4 w = {r0[0], r1[0], r0[1], r1[1]}; OUT = *reinterpret_cast<bf16x8*>(&w); } while (0)
    PK4(p0, 0, pa0); PK4(p0, 8, pa1); PK4(p1, 0, pa2); PK4(p1, 8, pa3);
#undef PK4
}

constexpr int AT_K = 0, AT_V = 16384, AT_WS = 32768, AT_XCH = 36864;

__device__ __forceinline__ void win_attn_unit(char* lds, const bf16_t* Z, bf16_t* Y, const float* sink, int b, int kvh, int qc, bool ctxq) {
    const int tid = opaque(threadIdx.x), wid = __builtin_amdgcn_readfirstlane(tid >> 6), lane = tid & 63, r32 = lane & 31, hi = lane >> 5;
    const int head = kvh * 4 + (wid >> 1), qsub = wid & 1;
    const int q0 = qc * 64;
    const size_t qrow0 = (ctxq ? (size_t)RL + b * CTX : (size_t)b * SEQ) + q0 + qsub * 32;
    float* wsf = (float*)(lds + AT_WS) + wid * 128; float* al_l = wsf; float* li_l = wsf + 32;
    bf16x8 qr[4];
    { const bf16_t* qp = Z + (qrow0 + r32) * MIXIN + 512 + head * 64 + hi * 8;
#pragma unroll
      for (int d0 = 0; d0 < 4; ++d0) qr[d0] = *reinterpret_cast<const bf16x8*>(qp + d0 * 16); }
    float m_reg = -1e30f, l_reg = 0.f; f32x16 o[2] = {};
    const int srow = tid >> 3, scol = (tid & 7) * 8;
    const int vb = (int)(uintptr_t)(lds + AT_V) + v_rd_base(lane);
    const int qrel = qsub * 32 + r32;
    const int NT = ctxq ? 4 : 9;
    for (int t = 0; t < NT; ++t) {
        size_t krow; int mode = 0;
        if (t < 4) krow = (size_t)RL + b * CTX + t * 64;
        else { const int p0 = q0 - 128 + (t - 4) * 64; if (p0 < 0 || p0 >= SEQ) continue; krow = (size_t)b * SEQ + p0; mode = (t == 4) ? 1 : (t == 8) ? 2 : 0; }
        __syncthreads();
        { const bf16_t* kp = Z + (krow + srow) * MIXIN + 1024 + kvh * 64 + scol;
          const bf16x8 kv = *reinterpret_cast<const bf16x8*>(kp), vv = *reinterpret_cast<const bf16x8*>(kp + 128);
          *reinterpret_cast<bf16x8*>(lds + AT_K + kswz<64>(srow, scol * 2)) = kv;
          *reinterpret_cast<bf16x8*>(lds + AT_V + v_st<64>(srow, scol)) = vv; }
        __syncthreads();
        f32x16 p0, p1; qkt64<64>(p0, p1, lds + AT_K, qr, 0, r32, hi);
        if (mode == 1) {
#pragma unroll
            for (int r = 0; r < 16; ++r) { const int kk = crow(r, hi); if (kk < qrel) p0[r] = -1e30f; if (kk + 32 < qrel) p1[r] = -1e30f; } }
        else if (mode == 2) {
#pragma unroll
            for (int r = 0; r < 16; ++r) { const int kk = crow(r, hi); if (kk > qrel) p0[r] = -1e30f; if (kk + 32 > qrel) p1[r] = -1e30f; } }
        bf16x8 pa0, pa1, pa2, pa3;
        softmax_step<2>(p0, p1, m_reg, l_reg, o, al_l, r32, hi, pa0, pa1, pa2, pa3);
        pv_one<64, 0>(o[0], vb, pa0, pa1, pa2, pa3); pv_one<64, 1>(o[1], vb, pa0, pa1, pa2, pa3);
    }
    l_reg += __builtin_amdgcn_exp2f(sink[head] * LOG2E - m_reg * QK_C);
    if (hi == 0) li_l[r32] = l_reg; LDS_WAIT();
    bf16_t* yp = Y + qrow0 * DM + 512 + head * 64;
#pragma unroll
    for (int r = 0; r < 16; ++r) { const int orow = crow(r, hi); const float rl = __builtin_amdgcn_rcpf(li_l[orow]);
#pragma unroll
        for (int d0 = 0; d0 < 2; ++d0) { const unsigned w = cvtpk(o[d0][r] * rl, 0.f); yp[(size_t)orow * DM + d0 * 32 + r32] = (bf16_t)(w & 0xffffu); } }
}

constexpr float DA_THR = 8.f;
constexpr float DA_THRL = DA_THR * LOG2E;
template <bool FIRST> __device__ __forceinline__ void da_partialSM(f32x16& p0, f32x16& p1, float& mhat, f32x16& negm, float& alpha) {
    float pmax = fmaxf(p0[0], p0[1]), pmb = fmaxf(p1[0], p1[1]);
#pragma unroll
    for (int r = 2; r < 16; r += 2) { pmax = fmaxf(fmaxf(pmax, p0[r]), p0[r + 1]); pmb = fmaxf(fmaxf(pmb, p1[r]), p1[r + 1]); }
    pmax = fmaxf(pmax, pmb);
    { auto rr = __builtin_amdgcn_permlane32_swap(__float_as_uint(pmax), __float_as_uint(pmax), false, false); pmax = fmaxf(__uint_as_float(rr[0]), __uint_as_float(rr[1])); }
    alpha = 1.f;
    if (FIRST || !__builtin_expect(__all(pmax <= DA_THRL), 1)) {
        const float dl = FIRST ? pmax : fmaxf(pmax, 0.f);
        mhat += dl; alpha = __builtin_amdgcn_exp2f(-dl);
#pragma unroll
        for (int r = 0; r < 16; ++r) { p0[r] -= dl; p1[r] -= dl; negm[r] = -mhat; }
    }
#pragma unroll
    for (int r = 0; r < 16; ++r) p0[r] = __builtin_amdgcn_exp2f(p0[r]);
}
__device__ __forceinline__ void da_finishSM(f32x16& p0, f32x16& p1, float alpha, float& l_reg, bf16x8& pa0, bf16x8& pa1, bf16x8& pa2, bf16x8& pa3) {
#pragma unroll
    for (int r = 0; r < 16; ++r) p1[r] = __builtin_amdgcn_exp2f(p1[r]);
    float s0 = p0[0], s1 = p0[1], s2 = p0[2], s3 = p0[3];
#pragma unroll
    for (int r = 4; r < 16; r += 4) { s0 += p0[r]; s1 += p0[r + 1]; s2 += p0[r + 2]; s3 += p0[r + 3]; }
#pragma unroll
    for (int r = 0; r < 16; r += 4) { s0 += p1[r]; s1 += p1[r + 1]; s2 += p1[r + 2]; s3 += p1[r + 3]; }
    float ps = (s0 + s1) + (s2 + s3);
    { auto rr = __builtin_amdgcn_permlane32_swap(__float_as_uint(ps), __float_as_uint(ps), false, false); ps = __uint_as_float(rr[0]) + __uint_as_float(rr[1]); }
    l_reg = l_reg * alpha + ps;
#define PK4(P, BASE, OUT) do { unsigned a0 = cvtpk(P[BASE + 0], P[BASE + 1]), a1 = cvtpk(P[BASE + 2], P[BASE + 3]);   \
    unsigned b0 = cvtpk(P[BASE + 4], P[BASE + 5]), b1 = cvtpk(P[BASE + 6], P[BASE + 7]);                              \
    auto r0 = __builtin_amdgcn_permlane32_swap(a0, b0, false, false); auto r1 = __builtin_amdgcn_permlane32_swap(a1, b1, false, false); \
    u32x4 w = {r0[0], r1[0], r0[1], r1[1]}; OUT = *reinterpret_cast<bf16x8*>(&w); } while (0)
    PK4(p0, 0, pa0); PK4(p0, 8, pa1); PK4(p1, 0, pa2); PK4(p1, 8, pa3);
#undef PK4
}
__device__ __forceinline__ void da_pv(f32x16* o, int vb, bf16x8 pa0, bf16x8 pa1, bf16x8 pa2, bf16x8 pa3) {
    pv_all<128>(o, vb, pa0, pa1, pa2, pa3);
}
constexpr int DA_V = 0, DA_K = 49152, DA_WS = 81920, DA_XCH = 0;
__device__ __forceinline__ void diff_attn_unit(char* lds, const bf16_t* QKV, bf16_t* O, const float* subg, float lam, float oscale, int b, int h, int qb, bool ctxq) {
    const int tid = opaque(threadIdx.x), wid = __builtin_amdgcn_readfirstlane(tid >> 6), lane = tid & 63, r32 = lane & 31, hi = lane >> 5;
    const int comp = wid >> 2, qsub = wid & 3;
    const size_t qrow0 = (ctxq ? (size_t)RL + b * CTX : (size_t)b * SEQ) + qb * 128 + qsub * 32;
    char* V_lds = lds + DA_V; char* K_lds = lds + DA_K;
    float* wsf = (float*)(lds + DA_WS) + wid * 128; float* al_l = wsf; float* li_l = wsf + 32;
    __syncthreads();
    bf16x8 qr[4];
    { const bf16_t* qp = QKV + (qrow0 + r32) * 3072 + (2 * h + comp) * 64 + hi * 8;
#pragma unroll
      for (int d0 = 0; d0 < 4; ++d0) qr[d0] = *reinterpret_cast<const bf16x8*>(qp + d0 * 16); }
    float m_reg = 0.f, l_reg = 0.f; f32x16 o[4] = {}; f32x16 negm = {};
    const int sr = tid >> 4, sc = (tid & 15) * 8, vst0 = v_st<128>(sr, sc), vst1 = v_st<128>(32 + sr, sc);
    const int vb0 = (int)(uintptr_t)V_lds + v_rd_base(lane);
    const int kcb = comp * 128;
    const bf16_t* kvp = QKV + (size_t)sr * 3072 + 1024 + h * 128 + sc;
    const size_t rowc = (size_t)RL + b * CTX, rowl = (size_t)b * SEQ;
    const int NT = ctxq ? 4 : 68;
    bf16x8 ks0, ks1, vs0, vs1;
#define KROW(t) ((t) < 4 ? rowc + (size_t)(t) * 64 : rowl + (size_t)((t) - 4) * 64)
#define LOADK(t) do { const bf16_t* p_ = kvp + KROW(t) * 3072; ks0 = *reinterpret_cast<const bf16x8*>(p_); ks1 = *reinterpret_cast<const bf16x8*>(p_ + 32 * 3072); } while (0)
#define LOADV(t) do { const bf16_t* p_ = kvp + KROW(t) * 3072 + 1024; vs0 = *reinterpret_cast<const bf16x8*>(p_); vs1 = *reinterpret_cast<const bf16x8*>(p_ + 32 * 3072); } while (0)
#define WRITEK(bf) do { *reinterpret_cast<bf16x8*>(K_lds + (bf) * 16384 + kswz<128>(sr, sc * 2)) = ks0; *reinterpret_cast<bf16x8*>(K_lds + (bf) * 16384 + kswz<128>(32 + sr, sc * 2)) = ks1; } while (0)
#define WRITEV(bf) do { *reinterpret_cast<bf16x8*>(V_lds + (bf) * 16384 + vst0) = vs0; *reinterpret_cast<bf16x8*>(V_lds + (bf) * 16384 + vst1) = vs1; } while (0)
#define RESC(a) do { if (__any((a) < 1.f)) { if (hi == 0) al_l[r32] = (a); LDS_WAIT(); \
    _Pragma("unroll") for (int d = 0; d < 4; ++d) _Pragma("unroll") for (int r = 0; r < 16; ++r) o[d][r] *= al_l[crow(r, hi)]; } } while (0)
#define QKT(P0, P1, kb) do { SBAR(); qkt64n<128>(P0, P1, K_lds + (kb) * 16384, qr, kcb, r32, hi, negm); } while (0)
#define FIN(P0, P1, al) do { da_finishSM(P0, P1, al, l_reg, pa0, pa1, pa2, pa3); SBAR(); } while (0)
#define PVT(vi) da_pv(o, vb0 + (vi) * 16384, pa0, pa1, pa2, pa3)
    f32x16 pA0, pA1, pB0, pB1; float alA = 1.f, alB = 1.f; bf16x8 pa0, pa1, pa2, pa3;
    int vm2 = 1, vm1 = 2, vc = 0;
#define VROT() do { const int t_ = vm2; vm2 = vm1; vm1 = vc; vc = t_; } while (0)
    const bool grpB = comp != 0;
    LOADK(0); VM_WAIT(); WRITEK(0); LOADK(1); LOADV(0); __syncthreads();
    QKT(pA0, pA1, 0);
    if (!grpB) da_partialSM<true>(pA0, pA1, m_reg, negm, alA);
    VM_WAIT(); WRITEK(1); WRITEV(vc); LOADK(2); LOADV(1); VROT();
    __syncthreads();
    if (grpB) da_partialSM<true>(pA0, pA1, m_reg, negm, alA);
    QKT(pB0, pB1, 1); FIN(pA0, pA1, alA);
    if (!grpB) { PVT(vm1); da_partialSM<false>(pB0, pB1, m_reg, negm, alB); RESC(alB); }
    VM_WAIT(); WRITEK(0); WRITEV(vc); LOADK(3); LOADV(2); VROT();
    __syncthreads();
    for (int j = 2; j + 1 < NT; j += 2) {
        if (grpB) { PVT(vm2); da_partialSM<false>(pB0, pB1, m_reg, negm, alB); RESC(alB); }
        QKT(pA0, pA1, 0); FIN(pB0, pB1, alB);
        if (!grpB) { PVT(vm1); da_partialSM<false>(pA0, pA1, m_reg, negm, alA); RESC(alA); }
        VM_WAIT(); WRITEK(1); WRITEV(vc); if (j + 2 < NT) LOADK(j + 2); LOADV(j + 1); VROT();
        __syncthreads();
        if (grpB) { PVT(vm2); da_partialSM<false>(pA0, pA1, m_reg, negm, alA); RESC(alA); }
        QKT(pB0, pB1, 1); FIN(pA0, pA1, alA);
        if (!grpB) { PVT(vm1); da_partialSM<false>(pB0, pB1, m_reg, negm, alB); RESC(alB); }
        VM_WAIT(); if (j + 2 < NT) { WRITEK(0); } WRITEV(vc); if (j + 3 < NT) LOADK(j + 3); if (j + 2 < NT) LOADV(j + 2); VROT();
        __syncthreads();
    }
    if (grpB) { PVT(vm2); da_partialSM<false>(pB0, pB1, m_reg, negm, alB); RESC(alB); }
    FIN(pB0, pB1, alB); PVT(vm1);
#undef LOADK
#undef LOADV
#undef WRITEK
#undef WRITEV
#undef QKT
#undef FIN
#undef PVT
#undef VROT
#define SLOAD(a, b)
#define SWRITE(a, b)
#define SWAIT()
#undef KROW
#undef SLOAD
#undef SWRITE
#undef SWAIT
#undef RESC
    if (hi == 0) li_l[r32] = l_reg; LDS_WAIT();
    float rl[16];
#pragma unroll
    for (int r = 0; r < 16; ++r) rl[r] = __builtin_amdgcn_rcpf(li_l[crow(r, hi)]);
    __syncthreads();
    float* xch = (float*)(lds + DA_XCH) + qsub * (32 * 132);
    if (comp == 1) {
#pragma unroll
        for (int d0 = 0; d0 < 4; ++d0)
#pragma unroll
            for (int r = 0; r < 16; ++r) xch[crow(r, hi) * 132 + d0 * 32 + r32] = o[d0][r] * rl[r];
    }
    __syncthreads();
    if (comp == 0) {
#pragma unroll
        for (int d0 = 0; d0 < 4; ++d0)
#pragma unroll
            for (int r = 0; r < 16; ++r) { const int idx = crow(r, hi) * 132 + d0 * 32 + r32; const float v = o[d0][r] * rl[r] - lam * xch[idx]; xch[idx] = v; }
        LDS_WAIT();
        const int row = lane >> 1, hf = lane & 1; const float* rp = xch + row * 132 + hf * 64;
        f32x4 v[16]; float ss = 0.f;
#pragma unroll
        for (int j = 0; j < 16; ++j) { v[j] = *reinterpret_cast<const f32x4*>(rp + 4 * j); ss += v[j][0] * v[j][0] + v[j][1] * v[j][1] + v[j][2] * v[j][2] + v[j][3] * v[j][3]; }
        ss += __int_as_float(__builtin_amdgcn_ds_bpermute((lane ^ 1) << 2, __float_as_int(ss)));
        const float rs = __builtin_amdgcn_rsqf(ss * (1.f / 128.f) + EPS) * oscale;
        bf16_t* op = O + (qrow0 + row) * DM + h * 128 + hf * 64;
#pragma unroll
        for (int j = 0; j < 16; j += 2) { const f32x4 g0 = *reinterpret_cast<const f32x4*>(subg + hf * 64 + 4 * j), g1 = *reinterpret_cast<const f32x4*>(subg + hf * 64 + 4 * j + 4);
            const f32x4 a = v[j] * g0 * rs, c = v[j + 1] * g1 * rs;
            u32x4 w; w.x = cvtpk(a[0], a[1]); w.y = cvtpk(a[2], a[3]); w.z = cvtpk(c[0], c[1]); w.w = cvtpk(c[2], c[3]);
            *reinterpret_cast<u32x4*>(op + 4 * j) = w; }
    }
}

constexpr int WA_V = 0, WA_K = 16384, WA_WS = 32768, WA_ST = 36864;
__device__ __forceinline__ void wa_mask(f32x16& p0, f32x16& p1, int mode, int qrel, int hi) {
    if (mode == 1) {
#pragma unroll
        for (int r = 0; r < 16; ++r) { const int kk = crow(r, hi); if (kk < qrel) p0[r] = -1e30f; if (kk + 32 < qrel) p1[r] = -1e30f; } }
    else if (mode == 2) {
#pragma unroll
        for (int r = 0; r < 16; ++r) { const int kk = crow(r, hi); if (kk > qrel) p0[r] = -1e30f; if (kk + 32 > qrel) p1[r] = -1e30f; } }
    else if (mode == 3) {
#pragma unroll
        for (int r = 0; r < 16; ++r) { p0[r] = -1e30f; p1[r] = -1e30f; } }
}
__device__ __forceinline__ void win_attn_unit2(char* lds, const bf16_t* Z, bf16_t* Y, const float* sink, int b, int kvh, int qc, bool ctxq) {
    const int tid = opaque(threadIdx.x), wid = __builtin_amdgcn_readfirstlane(tid >> 6), lane = tid & 63, r32 = lane & 31, hi = lane >> 5;
    const int head = kvh * 4 + (wid >> 1), qsub = wid & 1, q0 = qc * 64;
    const size_t rowc = (size_t)RL + b * CTX, rowl = (size_t)b * SEQ;
    const size_t qrow0 = (ctxq ? rowc : rowl) + q0 + qsub * 32;
    char* V_lds = lds + WA_V; char* K_lds = lds + WA_K;
    float* wsf = (float*)(lds + WA_WS) + wid * 128; float* al_l = wsf; float* li_l = wsf + 32;
    __syncthreads();
    bf16x8 qr[4];
    { const bf16_t* qp = Z + (qrow0 + r32) * MIXIN + 512 + head * 64 + hi * 8;
#pragma unroll
      for (int d0 = 0; d0 < 4; ++d0) qr[d0] = *reinterpret_cast<const bf16x8*>(qp + d0 * 16); }
    float m_reg = 0.f, l_reg = 0.f; f32x16 o[2] = {}; f32x16 negm = {};
    const int srow = tid >> 3, scol = (tid & 7) * 8, vst = v_st<64>(srow, scol), kst = kswz<64>(srow, scol * 2);
    const int vb0 = (int)(uintptr_t)V_lds + v_rd_base(lane);
    const bf16_t* kvp = Z + (size_t)srow * MIXIN + 1024 + kvh * 64 + scol;
    const int skip_lo = ctxq ? 0 : (q0 == 0 ? 2 : q0 == 64 ? 1 : 0);
    const int nloc = ctxq ? 0 : 5 - skip_lo - (q0 == SEQ - 64 ? 2 : q0 == SEQ - 128 ? 1 : 0);
    const int NTr = 4 + nloc, NT = (NTr + 1) & ~1;
    const int qrel = qsub * 32 + r32;
    struct { bf16x8 vs, ks; } sr_;
#define KROW(t) ((t) < 4 ? rowc + (size_t)(t) * 64 : (t) < NTr ? rowl + (size_t)(q0 - 128 + ((t) - 4 + skip_lo) * 64) : rowc)
#define TMODE(t) ((t) < 4 ? 0 : (t) >= NTr ? 3 : ((t) - 4 + skip_lo) == 0 ? 1 : ((t) - 4 + skip_lo) == 4 ? 2 : 0)
#define SLOAD(t) do { const bf16_t* p_ = kvp + KROW(t) * MIXIN; sr_.ks = *reinterpret_cast<const bf16x8*>(p_); sr_.vs = *reinterpret_cast<const bf16x8*>(p_ + 128); } while (0)
#define SWRITE(bf) do { *reinterpret_cast<bf16x8*>(V_lds + (bf) * 8192 + vst) = sr_.vs; *reinterpret_cast<bf16x8*>(K_lds + (bf) * 8192 + kst) = sr_.ks; } while (0)
#define SWAIT() asm volatile("s_waitcnt vmcnt(0)" ::: "memory")
#define RESC(a) do { if (__any((a) < 1.f)) { if (hi == 0) al_l[r32] = (a); LDS_WAIT(); \
    _Pragma("unroll") for (int d = 0; d < 2; ++d) _Pragma("unroll") for (int r = 0; r < 16; ++r) o[d][r] *= al_l[crow(r, hi)]; } } while (0)
#define WPV(vb) pv_all<64>(o, (vb), pa0, pa1, pa2, pa3)
    f32x16 pA0, pA1, pB0, pB1; float alA, alB; bf16x8 pa0, pa1, pa2, pa3;
    SLOAD(0); VM_WAIT(); SWRITE(0); __syncthreads();
    qkt64n<64>(pA0, pA1, K_lds, qr, 0, r32, hi, negm); da_partialSM<true>(pA0, pA1, m_reg, negm, alA);
    SLOAD(1);
    SWAIT(); SWRITE(1); __syncthreads();
    for (int j = 1; j + 1 < NT; j += 2) {
        SBAR(); qkt64n<64>(pB0, pB1, K_lds + 8192, qr, 0, r32, hi, negm);
        da_finishSM(pA0, pA1, alA, l_reg, pa0, pa1, pa2, pa3); SBAR();
        SLOAD(j + 1); SBAR();
        WPV(vb0); wa_mask(pB0, pB1, TMODE(j), qrel, hi); da_partialSM<false>(pB0, pB1, m_reg, negm, alB);
        __syncthreads(); SWAIT(); SWRITE(0);
        RESC(alB); __syncthreads();
        SBAR(); qkt64n<64>(pA0, pA1, K_lds, qr, 0, r32, hi, negm);
        da_finishSM(pB0, pB1, alB, l_reg, pa0, pa1, pa2, pa3); SBAR();
        SLOAD(j + 2); SBAR();
        WPV(vb0 + 8192); wa_mask(pA0, pA1, TMODE(j + 1), qrel, hi); da_partialSM<false>(pA0, pA1, m_reg, negm, alA);
        __syncthreads(); SWAIT(); SWRITE(1);
        RESC(alA); __syncthreads();
    }
    SBAR(); qkt64n<64>(pB0, pB1, K_lds + 8192, qr, 0, r32, hi, negm);
    da_finishSM(pA0, pA1, alA, l_reg, pa0, pa1, pa2, pa3); SBAR();
    WPV(vb0); wa_mask(pB0, pB1, TMODE(NT - 1), qrel, hi); da_partialSM<false>(pB0, pB1, m_reg, negm, alB);
    __syncthreads(); RESC(alB);
    da_finishSM(pB0, pB1, alB, l_reg, pa0, pa1, pa2, pa3); SBAR();
    WPV(vb0 + 8192);
#undef KROW
#undef TMODE
#undef SLOAD
#undef SWRITE
#undef SWAIT
#undef RESC
#undef WPV
    l_reg += __builtin_amdgcn_exp2f(sink[head] * LOG2E - m_reg);
    if (hi == 0) li_l[r32] = l_reg; LDS_WAIT();
    bf16_t* stg = (bf16_t*)(lds + WA_ST) + wid * 2048;
#pragma unroll
    for (int r = 0; r < 16; ++r) { const int orow = crow(r, hi); const float rl = __builtin_amdgcn_rcpf(li_l[orow]);
#pragma unroll
        for (int d0 = 0; d0 < 2; ++d0) stg[orow * 64 + d0 * 32 + r32] = (bf16_t)(cvtpk(o[d0][r] * rl, 0.f) & 0xffffu); }
    LDS_WAIT();
    bf16_t* yp = Y + qrow0 * DM + 512 + head * 64;
#pragma unroll
    for (int i = 0; i < 4; ++i) { const int row = i * 8 + (lane >> 3), ch = lane & 7; const u32x4 v = *reinterpret_cast<const u32x4*>(stg + row * 64 + ch * 8); *reinterpret_cast<u32x4*>(yp + (size_t)row * DM + ch * 8) = v; }
}

struct Args {
    const float *x, *c, *ctx, *c_ctx, *ada_w, *ada_b, *norm_g, *mix_in_w, *mix_out_w, *win_sink, *diff_qkv_w, *diff_out_w, *diff_lambda, *diff_subln_g,
                *ffn_in_w, *ffn_out_w, *router_w, *expert_in_w, *expert_out_w;
    float* out; unsigned char* ws; int ph_lo, ph_hi;
};
struct Frame {
    LAS unsigned char* lds; unsigned char* ldsg; volatile LAS unsigned* MISC; unsigned* ctl;
    int tid, lane, wave, vcu, G;
};

__device__ __forceinline__ unsigned f2bf(float f) { unsigned u = __builtin_bit_cast(unsigned, f); return (u + 0x7fffu + ((u >> 16) & 1u)) >> 16; }
__device__ __forceinline__ unsigned pk2(float lo, float hi) { return f2bf(lo) | (f2bf(hi) << 16); }
__device__ __forceinline__ void transpose_item(const float* W, int K, int N, bf16_t* WT, int n0, int c0, int k0, LAS float* scr, int lane) {
#pragma unroll 8
    for (int i = 0; i < 32; ++i) { const int kk = 2 * i + (lane >> 5); scr[kk * 33 + (lane & 31)] = W[(size_t)(k0 + kk) * N + c0 + (lane & 31)]; }
    LDS_WAIT(); asm volatile("" ::: "memory");
    const int c = lane & 7;
#pragma unroll
    for (int j = 0; j < 4; ++j) { const int n = (lane >> 3) + 8 * j; const LAS float* s = scr + (8 * c) * 33 + n;
        u32x4 o; o.x = pk2(s[0 * 33], s[1 * 33]); o.y = pk2(s[2 * 33], s[3 * 33]); o.z = pk2(s[4 * 33], s[5 * 33]); o.w = pk2(s[6 * 33], s[7 * 33]);
        *(u32x4*)(WT + (size_t)(n0 + n) * K + k0 + 8 * c) = o; }
    LDS_WAIT(); asm volatile("" ::: "memory");
}
__device__ __forceinline__ void transpose_item_f8(const float* W, int K, int N, unsigned char* WT, int n0, int c0, int k0, LAS float* scr, int lane) {
#pragma unroll 8
    for (int i = 0; i < 32; ++i) { const int kk = 2 * i + (lane >> 5); scr[kk * 33 + (lane & 31)] = W[(size_t)(k0 + kk) * N + c0 + (lane & 31)] * F8_SW; }
    LDS_WAIT(); asm volatile("" ::: "memory");
    const int c = lane & 7;
#pragma unroll
    for (int j = 0; j < 4; ++j) { const int n = (lane >> 3) + 8 * j; const LAS float* s = scr + (8 * c) * 33 + n;
        u32x2 o; o.x = pk4_fp8(s[0 * 33], s[1 * 33], s[2 * 33], s[3 * 33]); o.y = pk4_fp8(s[4 * 33], s[5 * 33], s[6 * 33], s[7 * 33]);
        *(u32x2*)(WT + (size_t)(n0 + n) * K + k0 + 8 * c) = o; }
    LDS_WAIT(); asm volatile("" ::: "memory");
}
__device__ __forceinline__ bool transpose_job(int& r, const float* W, int nb, int K, int N, void* WT, bool glu, bool f8, LAS float* scr, int lane) {
    const int nblk = N / 32, per = (K / 64) * nblk, tot = nb * per;
    if (r >= tot) { r -= tot; return false; }
    const int mtx = r / per, it = r % per, kb = it / nblk, nbk = it % nblk, n0 = 32 * nbk;
    int c0 = n0;
    if (glu) { const int tile = n0 >> 8, w = n0 & 255; c0 = (w < 128) ? tile * 128 + w : (N >> 1) + tile * 128 + (w - 128); }
    if (f8) transpose_item_f8(W + (size_t)mtx * K * N, K, N, (unsigned char*)WT + (size_t)mtx * K * N, n0, c0, 64 * kb, scr, lane);
    else transpose_item(W + (size_t)mtx * K * N, K, N, (bf16_t*)WT + (size_t)mtx * K * N, n0, c0, 64 * kb, scr, lane);
    return true;
}

struct ThinP {
    int nrows;
    const void* xin_lat; const void* xin_ctx;
    void* xout_lat; void* xout_ctx;
    bool xin16, xout16;
    int ymode;
    const bf16_t* Ysrc; const float* gate; const float* ga;
    bool h8;
    bf16_t* H; const float* gb; const float* shsc;
    const float* router; int* route; unsigned* cnt;
    unsigned char* HSv;
};
#define TH_DECL(PFX) f32x4 PFX##x0 = {}, PFX##x1 = {}, PFX##x2 = {}, PFX##x3 = {}; u32x2 PFX##xh0 = {}, PFX##xh1 = {}, PFX##xh2 = {}, PFX##xh3 = {}; u32x2 PFX##ya0 = {}, PFX##ya1 = {}, PFX##ya2 = {}, PFX##ya3 = {}, PFX##yb0 = {}, PFX##yb1 = {}, PFX##yb2 = {}, PFX##yb3 = {}; float PFX##w0 = 0.f, PFX##w1 = 0.f
#define TH_LOAD(PFX, r_, it_) do { const int rr_ = (r_); \
    if (P.xin16) { const bf16_t* xr_ = (rr_ < RL ? (const bf16_t*)P.xin_lat + (size_t)rr_ * DM : (const bf16_t*)P.xin_ctx + (size_t)(rr_ - RL) * DM) + 4 * lane; \
        PFX##xh0 = __builtin_nontemporal_load(reinterpret_cast<const u32x2*>(xr_)); PFX##xh1 = __builtin_nontemporal_load(reinterpret_cast<const u32x2*>(xr_ + 256)); PFX##xh2 = __builtin_nontemporal_load(reinterpret_cast<const u32x2*>(xr_ + 512)); PFX##xh3 = __builtin_nontemporal_load(reinterpret_cast<const u32x2*>(xr_ + 768)); } \
    else { const float* xr_ = (rr_ < RL ? (const float*)P.xin_lat + (size_t)rr_ * DM : (const float*)P.xin_ctx + (size_t)(rr_ - RL) * DM) + 4 * lane; \
        PFX##x0 = __builtin_nontemporal_load(reinterpret_cast<const f32x4*>(xr_)); PFX##x1 = __builtin_nontemporal_load(reinterpret_cast<const f32x4*>(xr_ + 256)); PFX##x2 = __builtin_nontemporal_load(reinterpret_cast<const f32x4*>(xr_ + 512)); PFX##x3 = __builtin_nontemporal_load(reinterpret_cast<const f32x4*>(xr_ + 768)); } \
    const bf16_t* ya_ = P.Ysrc; const bf16_t* yb_ = P.Ysrc; \
    if (P.ymode == 1) ya_ = P.Ysrc + (size_t)rr_ * DM; \
    else if (P.ymode == 2) { const LAS int* rt_ = rtl + (it_) * 6; \
        const int e0_ = rt_[0], p0_ = rt_[1], e1_ = rt_[2], p1_ = rt_[3]; PFX##w0 = __int_as_float(rt_[4]); PFX##w1 = __int_as_float(rt_[5]); \
        const unsigned b0_ = e0_ == 0 ? 0u : e0_ == 1 ? cb1 : e0_ == 2 ? cb2 : e0_ == 3 ? cb3 : e0_ == 4 ? cb4 : e0_ == 5 ? cb5 : e0_ == 6 ? cb6 : cb7; \
        const unsigned b1_ = e1_ == 0 ? 0u : e1_ == 1 ? cb1 : e1_ == 2 ? cb2 : e1_ == 3 ? cb3 : e1_ == 4 ? cb4 : e1_ == 5 ? cb5 : e1_ == 6 ? cb6 : cb7; \
        ya_ = P.Ysrc + (size_t)(b0_ + p0_) * DM; yb_ = P.Ysrc + (size_t)(b1_ + p1_) * DM; } \
    if (P.ymode) { ya_ += 4 * lane; PFX##ya0 = __builtin_nontemporal_load(reinterpret_cast<const u32x2*>(ya_)); PFX##ya1 = __builtin_nontemporal_load(reinterpret_cast<const u32x2*>(ya_ + 256)); PFX##ya2 = __builtin_nontemporal_load(reinterpret_cast<const u32x2*>(ya_ + 512)); PFX##ya3 = __builtin_nontemporal_load(reinterpret_cast<const u32x2*>(ya_ + 768)); } \
    if (P.ymode == 2) { yb_ += 4 * lane; PFX##yb0 = __builtin_nontemporal_load(reinterpret_cast<const u32x2*>(yb_)); PFX##yb1 = __builtin_nontemporal_load(reinterpret_cast<const u32x2*>(yb_ + 256)); PFX##yb2 = __builtin_nontemporal_load(reinterpret_cast<const u32x2*>(yb_ + 512)); PFX##yb3 = __builtin_nontemporal_load(reinterpret_cast<const u32x2*>(yb_ + 768)); } \
    } while (0)
#define TH_ARGS(PFX) PFX##x0, PFX##x1, PFX##x2, PFX##x3, PFX##xh0, PFX##xh1, PFX##xh2, PFX##xh3, PFX##ya0, PFX##ya1, PFX##ya2, PFX##ya3, PFX##yb0, PFX##yb1, PFX##yb2, PFX##yb3, PFX##w0, PFX##w1
__device__ __forceinline__ void thin_proc(const ThinP& P, f32x4 x0, f32x4 x1, f32x4 x2, f32x4 x3, u32x2 xh0, u32x2 xh1, u32x2 xh2, u32x2 xh3, u32x2 ya0, u32x2 ya1, u32x2 ya2, u32x2 ya3, u32x2 yb0, u32x2 yb1, u32x2 yb2, u32x2 yb3, float yw0, float yw1,
                                          f32x4 GA0, f32x4 GA1, f32x4 GA2, f32x4 GA3, f32x4 GB0, f32x4 GB1, f32x4 GB2, f32x4 GB3, f32x4 SH0, f32x4 SH1, f32x4 SH2, f32x4 SH3,
                                          int r, int li, int lane, LAS float* rwT, LAS int* rec, LAS unsigned* lcnt) {
    const int idx = r < RL ? (r >> 12) : 8;
#define BF4(w) ((f32x4){bf_lo((w).x), bf_hi((w).x), bf_lo((w).y), bf_hi((w).y)})
    f32x4 xv[4] = {x0, x1, x2, x3};
    if (P.xin16) { xv[0] = BF4(xh0); xv[1] = BF4(xh1); xv[2] = BF4(xh2); xv[3] = BF4(xh3); }
    if (P.ymode) {
        f32x4 yv[4];
        if (P.ymode == 1) { yv[0] = BF4(ya0); yv[1] = BF4(ya1); yv[2] = BF4(ya2); yv[3] = BF4(ya3); }
        else { yv[0] = BF4(ya0) * yw0 + BF4(yb0) * yw1; yv[1] = BF4(ya1) * yw0 + BF4(yb1) * yw1; yv[2] = BF4(ya2) * yw0 + BF4(yb2) * yw1; yv[3] = BF4(ya3) * yw0 + BF4(yb3) * yw1; }
#undef BF4
        float ss = 0.f;
#pragma unroll
        for (int j = 0; j < 4; ++j) ss += yv[j][0] * yv[j][0] + yv[j][1] * yv[j][1] + yv[j][2] * yv[j][2] + yv[j][3] * yv[j][3];
        const float rs = __builtin_amdgcn_rsqf(wave_sum(ss, lane) * (1.f / DM) + EPS);
        xv[0] = xv[0] + GA0 * (yv[0] * rs); xv[1] = xv[1] + GA1 * (yv[1] * rs); xv[2] = xv[2] + GA2 * (yv[2] * rs); xv[3] = xv[3] + GA3 * (yv[3] * rs);
    }
    if (P.xout_lat) {
        if (P.xout16) { bf16_t* xo = r < RL ? (bf16_t*)P.xout_lat + (size_t)r * DM : (bf16_t*)P.xout_ctx + (size_t)(r - RL) * DM;
#pragma unroll
            for (int j = 0; j < 4; ++j) { u32x2 w; w.x = cvtpk(xv[j][0], xv[j][1]); w.y = cvtpk(xv[j][2], xv[j][3]); __builtin_nontemporal_store(w, reinterpret_cast<u32x2*>(xo + 4 * lane + 256 * j)); } }
        else { float* xo = r < RL ? (float*)P.xout_lat + (size_t)r * DM : (float*)P.xout_ctx + (size_t)(r - RL) * DM;
#pragma unroll
            for (int j = 0; j < 4; ++j) __builtin_nontemporal_store(xv[j], reinterpret_cast<f32x4*>(xo + 4 * lane + 256 * j)); } }
    if (P.H) {
        float ss = 0.f;
#pragma unroll
        for (int j = 0; j < 4; ++j) ss += xv[j][0] * xv[j][0] + xv[j][1] * xv[j][1] + xv[j][2] * xv[j][2] + xv[j][3] * xv[j][3];
        const float rs = __builtin_amdgcn_rsqf(wave_sum(ss, lane) * (1.f / DM) + EPS);
        bf16_t* hr = P.H + (size_t)r * DM;
        f32x4 hv[4] = {xv[0] * rs * GB0 + SH0, xv[1] * rs * GB1 + SH1, xv[2] * rs * GB2 + SH2, xv[3] * rs * GB3 + SH3};
#pragma unroll
        for (int j = 0; j < 4; ++j) {
            if (P.h8) { *reinterpret_cast<unsigned*>((unsigned char*)P.H + (size_t)r * DM + 4 * lane + 256 * j) = pk4_fp8(hv[j][0] * F8_SH, hv[j][1] * F8_SH, hv[j][2] * F8_SH, hv[j][3] * F8_SH); }
            else { u32x2 w; w.x = cvtpk(hv[j][0], hv[j][1]); w.y = cvtpk(hv[j][2], hv[j][3]); *reinterpret_cast<u32x2*>(hr + 4 * lane + 256 * j) = w; } }
        if (P.router) {
            float lg[8];
#pragma unroll
            for (int e = 0; e < 8; ++e) { float a = 0.f;
#pragma unroll
                for (int j = 0; j < 4; ++j) { const f32x4 w = *reinterpret_cast<const LAS f32x4*>(rwT + e * 1024 + 4 * lane + 256 * j); a += hv[j][0] * w[0] + hv[j][1] * w[1] + hv[j][2] * w[2] + hv[j][3] * w[3]; }
                lg[e] = wave_sum(a, lane); }
            int i0 = 0; float v0 = lg[0];
#pragma unroll
            for (int e = 1; e < 8; ++e) if (lg[e] > v0) { v0 = lg[e]; i0 = e; }
            int i1 = -1; float v1 = -3.4e38f;
#pragma unroll
            for (int e = 0; e < 8; ++e) if (e != i0 && lg[e] > v1) { v1 = lg[e]; i1 = e; }
            const float w0 = 1.f / (1.f + __expf(v1 - v0)), w1 = 1.f - w0;
            if (lane == 0) { const unsigned lp0 = __hip_atomic_fetch_add(lcnt + i0, 1u, __ATOMIC_RELAXED, __HIP_MEMORY_SCOPE_WORKGROUP), lp1 = __hip_atomic_fetch_add(lcnt + i1, 1u, __ATOMIC_RELAXED, __HIP_MEMORY_SCOPE_WORKGROUP);
                LAS int* rc = rec + li * 6; rc[0] = i0; rc[1] = (int)lp0; rc[2] = i1; rc[3] = (int)lp1; rc[4] = __float_as_int(w0); rc[5] = __float_as_int(w1); }
        }
    }
}
__device__ __forceinline__ void thin_phase(Frame& F, const ThinP& P) {
    const int lane = opaque(F.lane);
    const int nlat = P.nrows < RL ? P.nrows : RL, nctx = P.nrows - nlat;
    const int chL = (nlat + F.G - 1) / F.G, chC = (nctx + F.G - 1) / F.G;
    const int r0L = F.vcu * chL, r0C = F.vcu * chC;
    const int nl = r0L >= nlat ? 0 : (r0L + chL <= nlat ? chL : nlat - r0L), nc = r0C >= nctx ? 0 : (r0C + chC <= nctx ? chC : nctx - r0C), nrw = nl + nc;
#define TROW(li_) ((li_) < nl ? r0L + (li_) : RL + r0C + ((li_) - nl))
    LAS float* rwT = (LAS float*)F.lds;
    LAS int* rec = (LAS int*)(F.lds + 32768);
    LAS unsigned* lcnt = (LAS unsigned*)(F.lds + 65536);
    unsigned cb1 = 0, cb2 = 0, cb3 = 0, cb4 = 0, cb5 = 0, cb6 = 0, cb7 = 0;
    if (P.ymode == 2) { unsigned a = 0;
        a += (xb_ld(P.cnt + 0) + 255u) & ~255u; cb1 = a; a += (xb_ld(P.cnt + 1) + 255u) & ~255u; cb2 = a; a += (xb_ld(P.cnt + 2) + 255u) & ~255u; cb3 = a;
        a += (xb_ld(P.cnt + 3) + 255u) & ~255u; cb4 = a; a += (xb_ld(P.cnt + 4) + 255u) & ~255u; cb5 = a; a += (xb_ld(P.cnt + 5) + 255u) & ~255u; cb6 = a;
        a += (xb_ld(P.cnt + 6) + 255u) & ~255u; cb7 = a; }
    if (P.router) {
        for (int i = F.tid; i < 8192; i += 512) { const int col = i >> 3, e = i & 7; rwT[e * 1024 + col] = P.router[i]; }
        if (F.tid < 16) lcnt[F.tid] = 0u;
        __syncthreads();
    }
    LAS int* rtl = (LAS int*)(F.lds + 98304) + F.wave * 6 * 64;
    if (P.ymode == 2) { const int li_ = F.wave + 8 * lane;
        if (li_ < nrw) { const int* rt = P.route + (size_t)TROW(li_) * 8; const u32x4 a = *reinterpret_cast<const u32x4*>(rt); const u32x2 b = *reinterpret_cast<const u32x2*>(rt + 4);
            LAS int* d = rtl + lane * 6; d[0] = (int)a.x; d[1] = (int)a.y; d[2] = (int)a.z; d[3] = (int)a.w; d[4] = (int)b.x; d[5] = (int)b.y; }
        LDS_WAIT(); }
    f32x4 GA0 = {}, GA1 = {}, GA2 = {}, GA3 = {}, GB0 = {}, GB1 = {}, GB2 = {}, GB3 = {}, SH0 = {}, SH1 = {}, SH2 = {}, SH3 = {}; int cur_idx = -1;
#define TH_VEC(r_) do { const int ix_ = (r_) < RL ? ((r_) >> 12) : 8; if (ix_ != cur_idx) { cur_idx = ix_; \
        if (P.ymode) { const float* gt_ = P.gate + (size_t)ix_ * 6144 + 4 * lane; const float* ga_ = P.ga + 4 * lane; \
            GA0 = *reinterpret_cast<const f32x4*>(gt_) * *reinterpret_cast<const f32x4*>(ga_); GA1 = *reinterpret_cast<const f32x4*>(gt_ + 256) * *reinterpret_cast<const f32x4*>(ga_ + 256); \
            GA2 = *reinterpret_cast<const f32x4*>(gt_ + 512) * *reinterpret_cast<const f32x4*>(ga_ + 512); GA3 = *reinterpret_cast<const f32x4*>(gt_ + 768) * *reinterpret_cast<const f32x4*>(ga_ + 768); } \
        if (P.H) { const float* sh_ = P.shsc + (size_t)ix_ * 6144 + 4 * lane; const float* gb_ = P.gb + 4 * lane; \
            GB0 = *reinterpret_cast<const f32x4*>(gb_) * (*reinterpret_cast<const f32x4*>(sh_ + 1024) + 1.f); GB1 = *reinterpret_cast<const f32x4*>(gb_ + 256) * (*reinterpret_cast<const f32x4*>(sh_ + 1280) + 1.f); \
            GB2 = *reinterpret_cast<const f32x4*>(gb_ + 512) * (*reinterpret_cast<const f32x4*>(sh_ + 1536) + 1.f); GB3 = *reinterpret_cast<const f32x4*>(gb_ + 768) * (*reinterpret_cast<const f32x4*>(sh_ + 1792) + 1.f); \
            SH0 = *reinterpret_cast<const f32x4*>(sh_); SH1 = *reinterpret_cast<const f32x4*>(sh_ + 256); SH2 = *reinterpret_cast<const f32x4*>(sh_ + 512); SH3 = *reinterpret_cast<const f32x4*>(sh_ + 768); } } } while (0)
#define TH_VARGS GA0, GA1, GA2, GA3, GB0, GB1, GB2, GB3, SH0, SH1, SH2, SH3
    TH_DECL(A_); TH_DECL(B_);
    int li = F.wave;
    if (li < nrw) TH_LOAD(A_, TROW(li), 0);
    for (int it = 0; li < nrw; li += 16, it += 2) {
        const bool hb = li + 8 < nrw;
        if (hb) TH_LOAD(B_, TROW(li + 8), it + 1);
        TH_VEC(TROW(li)); thin_proc(P, TH_ARGS(A_), TH_VARGS, TROW(li), li, lane, rwT, rec, lcnt);
        if (li + 16 < nrw) TH_LOAD(A_, TROW(li + 16), it + 2);
        if (hb) { TH_VEC(TROW(li + 8)); thin_proc(P, TH_ARGS(B_), TH_VARGS, TROW(li + 8), li + 8, lane, rwT, rec, lcnt); }
    }
    if (P.router) {
        __syncthreads();
        if (F.tid < 8) lcnt[8 + F.tid] = __hip_atomic_fetch_add(P.cnt + F.tid, lcnt[F.tid], __ATOMIC_RELAXED, __HIP_MEMORY_SCOPE_AGENT);
        __syncthreads();
        for (int i = F.tid; i < nrw; i += 512) { const LAS int* rc = rec + i * 6; int* rt = P.route + (size_t)TROW(i) * 8;
            const int e0 = rc[0], e1 = rc[2];
            rt[0] = e0; rt[1] = rc[1] + (int)lcnt[8 + e0]; rt[2] = e1; rt[3] = rc[3] + (int)lcnt[8 + e1]; rt[4] = rc[4]; rt[5] = rc[5]; }
        VM_WAIT();
        for (int lb = F.wave; lb < nrw; lb += 32) {
            u32x4 v[4]; size_t s0[4], s1[4];
#pragma unroll
            for (int q = 0; q < 4; ++q) { const int lq = lb + 8 * q; const int r = TROW(lq); if (lq < nrw) { const LAS int* rc = rec + lq * 6; const int e0 = rc[0], e1 = rc[2];
                s0[q] = (size_t)e0 * RT + (size_t)(rc[1] + (int)lcnt[8 + e0]); s1[q] = (size_t)e1 * RT + (size_t)(rc[3] + (int)lcnt[8 + e1]);
                v[q] = *(reinterpret_cast<const u32x4*>((const unsigned char*)P.H + (size_t)r * DM) + lane); } }
#pragma unroll
            for (int q = 0; q < 4; ++q) { if (lb + 8 * q < nrw) {
                *(reinterpret_cast<u32x4*>(P.HSv + s0[q] * DM) + lane) = v[q]; *(reinterpret_cast<u32x4*>(P.HSv + s1[q] * DM) + lane) = v[q]; } }
        }
        __syncthreads();
    }
#undef TROW
#undef TH_VEC
#undef TH_VARGS
}

constexpr int NPHASE = 2 + DEPTH * 9;
__global__ void __launch_bounds__(512, 2) dit_fwd(Args args) {
    extern __shared__ __attribute__((aligned(16))) unsigned char lds[];
    Frame F;
    F.lds = (LAS unsigned char*)lds; F.ldsg = lds; F.MISC = (volatile LAS unsigned*)(F.lds + MISC_OFF);
    F.tid = threadIdx.x; F.lane = F.tid & 63; F.wave = __builtin_amdgcn_readfirstlane(F.tid >> 6);
    F.G = gridDim.x; { const int bx = blockIdx.x; F.vcu = (F.G % 8 == 0) ? (bx % 8) * (F.G / 8) + bx / 8 : bx; }
    F.ctl = (unsigned*)(args.ws + WS_CTL);
    for (int u = F.tid; u < (LDS_BYTES - RING_BYTES) / 4; u += 512) ((LAS unsigned*)(F.lds + RING_BYTES))[u] = 0u;
    __syncthreads();
    XcdBarrier bar = xcd_barrier_post(F.ctl + CW_BAR, F.MISC + 8);
    const int lo = args.ph_lo, hi = args.ph_hi;
    int ph = 0;
#define IN() (lo <= ph && ph < hi)
    unsigned long long wait_acc = 0, clk_c = 0, clk_r = 0;
#define CLK_BEG(sel) unsigned long long c0_ = 0, r0_ = 0; if (PROBE_CLK == (sel)) { c0_ = __builtin_amdgcn_s_memtime(); r0_ = __builtin_amdgcn_s_memrealtime(); }
#define CLK_END(sel) if (PROBE_CLK == (sel)) { clk_c += __builtin_amdgcn_s_memtime() - c0_; clk_r += __builtin_amdgcn_s_memrealtime() - r0_; }
#define SEAM() do { if (lo <= ph && ph + 1 < hi) { if (WAITPROBE) { const unsigned long long t0_ = __builtin_amdgcn_s_memrealtime(); xcd_barrier(bar); const unsigned long long dt_ = __builtin_amdgcn_s_memrealtime() - t0_; const int k_ = ph < 2 ? 9 + ph : (ph - 2) % 9; if ((WAITSEL >> k_) & 1u) wait_acc += dt_; } else xcd_barrier(bar); } ++ph; } while (0)
    GAS unsigned char* wsg = (GAS unsigned char*)args.ws;
#define WSP ((unsigned char*)wsg)
#define pMOD    ((float*)(WSP + WS_MOD))
#define pROPECS ((f32x2*)(WSP + WS_ROPE))
#define pWP     ((bf16_t*)(WSP + WS_WP))
#define pROUTE  ((int*)(WSP + WS_ROUTE))
#define pCS     ((bf16_t*)(WSP + WS_CS))
#define pCSC    ((bf16_t*)(WSP + WS_CSC))
#define pX      ((bf16_t*)(WSP + WS_X))
#define pH      ((bf16_t*)(WSP + WS_H))
#define pYO     ((bf16_t*)(WSP + WS_YO))
#define pZ      ((bf16_t*)(WSP + WS_Z))
#define pY      ((bf16_t*)(WSP + WS_Y))
#define pPQT    ((bf16_t*)(WSP + WS_PQT))
#define pPQTC   ((bf16_t*)(WSP + WS_PQTC))
#define pOB     ((bf16_t*)(WSP + WS_O))
#define pA2     ((bf16_t*)(WSP + WS_A2))
#define pA2M    ((bf16_t*)(WSP + WS_A2M))
#define pHS     ((bf16_t*)(WSP + WS_HS))
    const int vcu0 = F.vcu;
#define REFRAME() do { F.tid = opaque(threadIdx.x); F.lane = F.tid & 63; F.wave = __builtin_amdgcn_readfirstlane(F.tid >> 6); F.G = sopaque((int)gridDim.x); F.vcu = sopaque(vcu0); \
        wsg = gptr(args.ws); F.ctl = (unsigned*)(WSP + WS_CTL); } while (0)
    for (int rep0 = 0; rep0 < REP_P0; ++rep0)
    if (IN() && PH_ON(0)) { REFRAME();
        const int gw = F.vcu * 8 + F.wave, NGW = F.G * 8, gt = F.vcu * 512 + F.tid, NGT = F.G * 512;
        LAS float* ctab = (LAS float*)F.lds;
        LAS float* svec = (LAS float*)(F.lds + 16384);
        if (F.tid == 0) *(LAS unsigned*)(F.lds + 126976) = 0u;
        for (int i = F.tid; i < 4096; i += 512) ctab[i] = cospif((float)i * (1.f / 2048.f));
        for (int i = F.tid; i < 9 * 1024; i += 512) { const float v = i < 8192 ? args.c[i] : args.c_ctx[i - 8192]; svec[i] = v / (1.f + __expf(-v)); }
        __syncthreads();
        for (int i = gt; i < 4096 * 512; i += NGT) { const int k = i >> 9, l0 = (i & 511) * 8; float v[8];
#pragma unroll
            for (int e = 0; e < 8; ++e) { const int col = l0 + e; const int ph_ = (k * (col <= 2048 ? col : col - 2048)) & 4095; v[e] = col <= 2048 ? ctab[ph_] : -ctab[(ph_ - 1024) & 4095]; }
            *reinterpret_cast<u32x4*>(pCS + (size_t)k * FP + l0) = (u32x4){pk2(v[0], v[1]), pk2(v[2], v[3]), pk2(v[4], v[5]), pk2(v[6], v[7])}; }
        for (int i = gt; i < 256 * 64; i += NGT) { const int k = i >> 6, l0 = (i & 63) * 8; float v[8];
#pragma unroll
            for (int e = 0; e < 8; ++e) { const int col = l0 + e, l = col & 255; const int ph_ = (k * l * 16) & 4095; v[e] = col < 256 ? ctab[ph_] : -ctab[(ph_ - 1024) & 4095]; }
            *reinterpret_cast<u32x4*>(pCSC + (size_t)k * FP + l0) = (u32x4){pk2(v[0], v[1]), pk2(v[2], v[3]), pk2(v[4], v[5]), pk2(v[6], v[7])}; }
        for (int i = gt; i < 256 * 128; i += NGT) { const int row = i >> 7, c = i & 127, m = row & 127; const int ph_ = (m * c * 32) & 4095;
            const float v = row < 128 ? ctab[ph_] : ctab[(ph_ - 1024) & 4095]; pWP[i] = (bf16_t)f2bf(v); }
        for (int i = gt; i < 64 * 16; i += NGT) { const int pos = i >> 4, k = i & 15; const float inv = __powf(10000.f, -(float)(2 * k) / 32.f); float s, c; sincosf((float)pos * inv, &s, &c); pROPECS[i] = (f32x2){c, s}; }
        for (int task = F.vcu + F.wave * F.G; task < 512; task += 8 * F.G) { const int layer = task >> 7, col = (task & 127) * 48 + F.lane;
            if (F.lane < 48) {
            const float* w = args.ada_w + (size_t)layer * DM * 6144 + col;
            float a0 = 0, a1 = 0, a2 = 0, a3 = 0, a4 = 0, a5 = 0, a6 = 0, a7 = 0, a8 = 0;
            for (int k0 = 0; k0 < DM; k0 += 32) { float wv[32];
#pragma unroll
                for (int i = 0; i < 32; ++i) wv[i] = w[(size_t)(k0 + i) * 6144];
#pragma unroll
                for (int i = 0; i < 32; ++i) { const int k = k0 + i;
                    a0 += svec[k] * wv[i]; a1 += svec[1024 + k] * wv[i]; a2 += svec[2048 + k] * wv[i]; a3 += svec[3072 + k] * wv[i]; a4 += svec[4096 + k] * wv[i];
                    a5 += svec[5120 + k] * wv[i]; a6 += svec[6144 + k] * wv[i]; a7 += svec[7168 + k] * wv[i]; a8 += svec[8192 + k] * wv[i]; } }
            const float bb = args.ada_b[layer * 6144 + col]; float* mo = pMOD + (size_t)layer * 9 * 6144 + col;
            mo[0] = a0 + bb; mo[6144] = a1 + bb; mo[2 * 6144] = a2 + bb; mo[3 * 6144] = a3 + bb; mo[4 * 6144] = a4 + bb; mo[5 * 6144] = a5 + bb; mo[6 * 6144] = a6 + bb; mo[7 * 6144] = a7 + bb; mo[8 * 6144] = a8 + bb; } }
        LAS float* scr = (LAS float*)(F.lds + 57344 + F.wave * 8448);
        LAS unsigned* wcnt = (LAS unsigned*)(F.lds + 126976);
        constexpr int NITEMS = 2 * (16 * 40) + 2 * (16 * 32) + 2 * (16 * 96) + 2 * (16 * 32) + 2 * (16 * 176) + 2 * (44 * 32) + 16 * (16 * 224) + 16 * (56 * 32);
        for (;;) {
            const int n = __builtin_amdgcn_readfirstlane((int)__hip_atomic_fetch_add(wcnt, F.lane == 0 ? 1u : 0u, __ATOMIC_RELAXED, __HIP_MEMORY_SCOPE_WORKGROUP));
            const int it = ((n >> 3) * F.G + F.vcu) * 8 + (n & 7);
            if (it >= NITEMS) break;
            int r = it;
            if (transpose_job(r, args.mix_in_w, 2, DM, MIXIN, (bf16_t*)(WSP + WS_WMIXIN), false, false, scr, F.lane)) continue;
            if (transpose_job(r, args.mix_out_w, 2, DM, DM, (bf16_t*)(WSP + WS_WMIXOUT), false, false, scr, F.lane)) continue;
            if (transpose_job(r, args.diff_qkv_w, 2, DM, 3072, (bf16_t*)(WSP + WS_WQKV), false, false, scr, F.lane)) continue;
            if (transpose_job(r, args.diff_out_w, 2, DM, DM, (bf16_t*)(WSP + WS_WDOUT), false, false, scr, F.lane)) continue;
            if (transpose_job(r, args.ffn_in_w, 2, DM, 2 * FFN, (bf16_t*)(WSP + WS_WFFNIN), true, F8_DENSE, scr, F.lane)) continue;
            if (transpose_job(r, args.ffn_out_w, 2, FFN, DM, (bf16_t*)(WSP + WS_WFFNOUT), false, F8_DENSE || F8_DDOWN, scr, F.lane)) continue;
            if (transpose_job(r, args.expert_in_w, 16, DM, 2 * EDIM, (bf16_t*)(WSP + WS_WEXPIN), true, true, scr, F.lane)) continue;
            transpose_job(r, args.expert_out_w, 16, EDIM, DM, (bf16_t*)(WSP + WS_WEXPOUT), false, true, scr, F.lane);
        }
        __syncthreads();
    }
    SEAM();
    if (IN() && PH_ON(1)) { REFRAME();
        ThinP P{}; P.nrows = RT; P.xin_lat = args.x; P.xin_ctx = args.ctx; P.ymode = 0; P.H = pH; P.gb = args.norm_g; P.shsc = pMOD;
        for (int rep = 0; rep < REP_P0B; ++rep) thin_phase(F, P);
        for (int rep = 0; rep < EXTRA_BARS; ++rep) xcd_barrier(bar);
    }
    SEAM();

    for (int layer = 0; layer < DEPTH; ++layer) {
        const int j = layer >> 1; const bool even = !(layer & 1), lastl = layer == DEPTH - 1;
        const float* modl = pMOD + (size_t)layer * 9 * 6144; const float* ng = args.norm_g + (size_t)layer * 4 * DM;
        const int Mrows = lastl ? RL : RT;
        if (IN() && PH_ON(2)) { REFRAME();
            pg8::Dims d{DM, DM}; SchedDense S;
            if (even) { S.init(pH, DM, (bf16_t*)(WSP + WS_WMIXIN) + (size_t)j * MIXIN * DM, DM, RT, MIXIN, DM, F.G, (int)blockIdx.x);
                EpiRope E{pZ, MIXIN, 4, 9, pROPECS, 4, 8, QK_C}; for (int rep = 0; rep < REP_PROJ; ++rep) pg8::gemm_phase(F.lds, d, S, E); }
            else { S.init(pH, DM, (bf16_t*)(WSP + WS_WQKV) + (size_t)j * 3072 * DM, DM, RT, 3072, DM, F.G, (int)blockIdx.x);
                EpiRope E{pZ, 3072, 0, 16, pROPECS, 0, 8, QK_C}; for (int rep = 0; rep < REP_PROJ; ++rep) pg8::gemm_phase(F.lds, d, S, E); }
        }
        SEAM();
        if (IN() && PH_ON(3)) { REFRAME();
            if (even) {
                if (PH_ON(16)) { pg8::Dims d{128, MIXIN}; SchedF1 S{(const char*)pWP, (const char*)pZ, F.G, F.vcu}; EpiPQt E{pPQT, pPQTC}; for (int rep = 0; rep < REP_FOUR; ++rep) pg8::gemm_phase(F.lds, d, S, E); }
            } else {
                const float* lv = args.diff_lambda + j * 256;
                const int ln = opaque(F.lane); const float s01 = wave_sum(lv[ln] * lv[64 + ln], ln), s23 = wave_sum(lv[128 + ln] * lv[192 + ln], ln);
                const float lam_init = 0.8f - 0.6f * __expf(-0.3f * (float)layer);
                const float lam = __expf(s01) - __expf(s23) + lam_init;
                const float* subg = args.diff_subln_g + j * 128;
                const int nu = lastl ? 2048 : 2048 + 128;
                CLK_BEG(1)
                for (int rep = 0; rep < REP_DIFF; ++rep)
                for (int u = F.vcu; u < (PH_ON(18) ? nu : 0); u += F.G) {
                    if (u < 2048) diff_attn_unit((char*)lds, pZ, pOB, subg, lam, 1.f - lam_init, u >> 8, (u >> 5) & 7, u & 31, false);
                    else { const int v = u - 2048; diff_attn_unit((char*)lds, pZ, pOB, subg, lam, 1.f - lam_init, v >> 4, (v >> 1) & 7, v & 1, true); }
                }
                __syncthreads();
                CLK_END(1)
            }
        }
        SEAM();
        if (IN() && PH_ON(4)) { REFRAME();
            if (even) { pg8::Dims d{FP, FP}; SchedF2 S{(const char*)pCS, (const char*)pCSC, (const char*)pPQT, (const char*)pPQTC, F.G, F.vcu}; EpiFour2 E{pY}; for (int rep = 0; rep < REP_FOUR; ++rep) pg8::gemm_phase<EpiFour2, SchedF2, false>(F.lds, d, S, E);
                const float* sink = args.win_sink + j * 8;
                for (int rep = 0; rep < REP_WIN; ++rep)
                for (int u = F.vcu; u < (PH_ON(17) ? 1024 + 64 : 0); u += F.G) {
                    if (u < 1024) win_attn_unit2((char*)lds, pZ, pY, sink, u >> 7, (u >> 6) & 1, u & 63, false);
                    else { const int v = u - 1024; win_attn_unit2((char*)lds, pZ, pY, sink, v >> 3, (v >> 2) & 1, v & 3, true); }
                }
                __syncthreads();
            }
        }
        if (even) SEAM(); else ++ph;
        if (IN() && PH_ON(5)) { REFRAME();
            pg8::Dims d{DM, DM}; SchedDense S;
            S.init(even ? pY : pOB, DM, (bf16_t*)(WSP + (even ? WS_WMIXOUT : WS_WDOUT)) + (size_t)j * DM * DM, DM, Mrows, DM, DM, F.G, (int)blockIdx.x);
            CLK_BEG(4)
            EpiStore E{pYO, DM, 1.f}; for (int rep = 0; rep < REP_PROJ; ++rep) pg8::gemm_phase(F.lds, d, S, E);
            CLK_END(4)
        }
        SEAM();
        if (IN() && PH_ON(6)) { REFRAME();
            ThinP P{}; P.nrows = Mrows; P.xin16 = layer != 0; P.xout16 = true;
            if (layer == 0) { P.xin_lat = args.x; P.xin_ctx = args.ctx; } else { P.xin_lat = pX; P.xin_ctx = pX + (size_t)RL * DM; }
            P.xout_lat = pX; P.xout_ctx = pX + (size_t)RL * DM; P.ymode = 1; P.Ysrc = pYO; P.gate = modl + 2048; P.ga = ng + DM;
            P.H = pH; P.h8 = !even || F8_DENSE; P.gb = ng + 2 * DM; P.shsc = modl + 3072;
            if (!even) { P.router = args.router_w + (size_t)j * DM * 8; P.route = pROUTE; P.cnt = F.ctl + CW_CNT + 16 * j; P.HSv = (unsigned char*)pHS; }
            thin_phase(F, P);
        }
        SEAM();
        unsigned c0 = 0, c1 = 0, c2 = 0, c3 = 0, c4 = 0, c5 = 0, c6 = 0, c7 = 0;
        if (!even) { unsigned* cn = F.ctl + CW_CNT + 16 * j; unsigned a = 0;
            c0 = 0; a += (rfl(xb_ld(cn + 0)) + 255u) & ~255u; c1 = a; a += (rfl(xb_ld(cn + 1)) + 255u) & ~255u; c2 = a; a += (rfl(xb_ld(cn + 2)) + 255u) & ~255u; c3 = a;
            a += (rfl(xb_ld(cn + 3)) + 255u) & ~255u; c4 = a; a += (rfl(xb_ld(cn + 4)) + 255u) & ~255u; c5 = a; a += (rfl(xb_ld(cn + 5)) + 255u) & ~255u; c6 = a;
            a += (rfl(xb_ld(cn + 6)) + 255u) & ~255u; c7 = a; a += (rfl(xb_ld(cn + 7)) + 255u) & ~255u; c0 = a; }
        ++ph;
        if (IN() && PH_ON(8)) { REFRAME();
            const bool f8 = !even || F8_DENSE; const int eb = f8 ? 1 : 2;
            pg8::Dims d{DM * eb / 2, DM * eb / 2}; SchedGroup S;
            if (even) { S.A = (const char*)pH; S.B = (const char*)(WSP + WS_WFFNIN) + (size_t)j * 2 * FFN * DM * eb; S.nRT = RT / 256; S.P1 = S.P2 = S.P3 = S.P4 = S.P5 = S.P6 = S.P7 = 1 << 30; S.nN = 2 * FFN / 256; S.gB = 0; S.aE = 0; }
            else { S.aE = (size_t)RT * DM; S.A = (const char*)pHS; S.B = (const char*)(WSP + WS_WEXPIN) + (size_t)j * NEXP * 2 * EDIM * DM; S.nRT = (int)(c0 >> 8);
                S.P1 = (int)(c1 >> 8); S.P2 = (int)(c2 >> 8); S.P3 = (int)(c3 >> 8); S.P4 = (int)(c4 >> 8); S.P5 = (int)(c5 >> 8); S.P6 = (int)(c6 >> 8); S.P7 = (int)(c7 >> 8);
                S.nN = 2 * EDIM / 256; S.gB = (size_t)2 * EDIM * DM; }
            S.nwg = S.nRT * S.nN; S.G = F.G; S.c = (int)blockIdx.x; S.nkt = DM * eb / 128; S.tA = (size_t)256 * DM * eb; S.tB = (size_t)256 * DM * eb;
            CLK_BEG(even ? 2 : 3)
            if (f8) { EpiSwiglu<true> E{(unsigned char*)(even ? pA2 : pA2M), even ? FFN : EDIM, 1.f / (F8_SH * F8_SW)}; for (int rep = 0; rep < REP_MOE; ++rep) pg8::gemm_phase<EpiSwiglu<true>, SchedGroup, true, ALIGN_SWIGLU>(F.lds, d, S, E); }
            else if (F8_DDOWN) { EpiSwiglu<true> E{(unsigned char*)pA2, FFN, 1.f}; for (int rep = 0; rep < REP_MOE; ++rep) pg8::gemm_phase<EpiSwiglu<true>, SchedGroup, false>(F.lds, d, S, E); }
            else { EpiSwiglu<false> E{(unsigned char*)pA2, FFN, 1.f}; for (int rep = 0; rep < REP_MOE; ++rep) pg8::gemm_phase<EpiSwiglu<false>, SchedGroup, false>(F.lds, d, S, E); }
            CLK_END(even ? 2 : 3)
        }
        SEAM();
        if (IN() && PH_ON(9)) { REFRAME();
            const bool f8 = !even || F8_DENSE || F8_DDOWN; const int eb = f8 ? 1 : 2;
            const int Kh = even ? FFN : EDIM; pg8::Dims d{Kh * eb / 2, Kh * eb / 2}; SchedGroup S;
            if (even) { S.A = (const char*)pA2; S.B = (const char*)(WSP + WS_WFFNOUT) + (size_t)j * DM * FFN * eb; S.nRT = RT / 256; S.P1 = S.P2 = S.P3 = S.P4 = S.P5 = S.P6 = S.P7 = 1 << 30; S.gB = 0; }
            else { S.A = (const char*)pA2M; S.B = (const char*)(WSP + WS_WEXPOUT) + (size_t)j * NEXP * DM * EDIM; S.nRT = (int)(c0 >> 8);
                S.P1 = (int)(c1 >> 8); S.P2 = (int)(c2 >> 8); S.P3 = (int)(c3 >> 8); S.P4 = (int)(c4 >> 8); S.P5 = (int)(c5 >> 8); S.P6 = (int)(c6 >> 8); S.P7 = (int)(c7 >> 8);
                S.gB = (size_t)DM * EDIM; }
            S.aE = 0; S.nN = DM / 256; S.nwg = S.nRT * S.nN; S.G = F.G; S.c = (int)blockIdx.x; S.nkt = Kh * eb / 128; S.tA = (size_t)256 * Kh * eb; S.tB = (size_t)256 * Kh * eb;
            if (f8) { EpiStore E{even ? pYO : pHS, DM, 1.f / (F8_SA * F8_SW)}; for (int rep = 0; rep < REP_MOE; ++rep) pg8::gemm_phase<EpiStore, SchedGroup, true>(F.lds, d, S, E); }
            else { EpiStore E{pYO, DM, 1.f}; for (int rep = 0; rep < REP_MOE; ++rep) pg8::gemm_phase<EpiStore, SchedGroup, false>(F.lds, d, S, E); }
        }
        SEAM();
        if (IN() && PH_ON(10)) { REFRAME();
            ThinP P{}; P.nrows = Mrows; P.xin16 = true; P.xout16 = !lastl; P.xin_lat = pX; P.xin_ctx = pX + (size_t)RL * DM;
            if (lastl) P.xout_lat = args.out; else P.xout_lat = pX;
            P.xout_ctx = pX + (size_t)RL * DM; P.ymode = even ? 1 : 2; P.Ysrc = even ? pYO : pHS; P.gate = modl + 5120; P.ga = ng + 3 * DM;
            P.route = pROUTE; P.cnt = F.ctl + CW_CNT + 16 * j;
            if (!lastl) { P.H = pH; P.gb = ng + 4 * DM; P.shsc = modl + 9 * 6144; }
            thin_phase(F, P);
        }
        SEAM();
    }
    if (PROBE_CLK) {
        const unsigned long long dur_ = clk_r ? clk_c * 5000ull / clk_r : 0ull, t0_ = __builtin_amdgcn_s_memrealtime();
        while (__builtin_amdgcn_s_memrealtime() - t0_ < dur_) __builtin_amdgcn_s_sleep(8);
    }
    if (WAITPROBE) {
        unsigned* wsum = F.ctl + 48;
        if (threadIdx.x == 0) __hip_atomic_fetch_add(wsum, (unsigned)wait_acc, __ATOMIC_RELAXED, __HIP_MEMORY_SCOPE_AGENT);
        xcd_barrier(bar);
        const unsigned mean = xb_ld(wsum) / gridDim.x; const unsigned long long t0_ = __builtin_amdgcn_s_memrealtime();
        while (__builtin_amdgcn_s_memrealtime() - t0_ < (unsigned long long)mean * WAITPROBE) __builtin_amdgcn_s_sleep(8);
    }
#undef IN
#undef SEAM
#undef REFRAME
}

#ifndef MK_PER_PHASE
#define MK_PER_PHASE 0
#endif
extern "C" void kernel_launch(void* const* d_in, const int* in_sizes, int n_in, void* d_out, int out_size, void* d_ws, size_t ws_size, hipStream_t stream) {
    static int grid = 0;
    if (grid == 0) {
        if (n_in != 19 || in_sizes[0] != RL * DM || out_size != RL * DM || ws_size < WS_END) {
            fprintf(stderr, "kernel_launch: unexpected shapes / workspace (n_in %d in0 %d out %d ws %zu need %zu)\n", n_in, n_in > 0 ? in_sizes[0] : -1, out_size, ws_size, (size_t)WS_END); grid = -1; return; }
        int dev = 0, cus = 0, per_cu = 0;
        if (hipGetDevice(&dev) != hipSuccess || hipDeviceGetAttribute(&cus, hipDeviceAttributeMultiprocessorCount, dev) != hipSuccess) { grid = -1; return; }
        if (hipFuncSetAttribute((const void*)dit_fwd, hipFuncAttributeMaxDynamicSharedMemorySize, LDS_BYTES) != hipSuccess) { fprintf(stderr, "kernel_launch: hipFuncSetAttribute failed\n"); grid = -1; return; }
        if (hipOccupancyMaxActiveBlocksPerMultiprocessor(&per_cu, (const void*)dit_fwd, 512, LDS_BYTES) != hipSuccess || per_cu < 1)
            fprintf(stderr, "kernel_launch: occupancy query reports %d\n", per_cu);
        (void)hipGetLastError();
        grid = cus;
    }
    if (grid < 0) return;
    if (hipMemsetAsync((char*)d_ws + WS_CTL, 0, CTL_BYTES, stream) != hipSuccess) return;
    Args a{};
    const float** ap = (const float**)&a;
    for (int i = 0; i < 19; ++i) ap[i] = (const float*)d_in[i];
    a.out = (float*)d_out; a.ws = (unsigned char*)d_ws;
#if MK_PER_PHASE
    for (int p = 0; p < NPHASE; ++p) { a.ph_lo = p; a.ph_hi = p + 1; hipLaunchKernelGGL(dit_fwd, dim3(grid), dim3(512), LDS_BYTES, stream, a); }
#else
    a.ph_lo = 0; a.ph_hi = NPHASE;
    hipLaunchKernelGGL(dit_fwd, dim3(grid), dim3(512), LDS_BYTES, stream, a);
#endif
}
```

```cpp
#include <hip/hip_runtime.h>
#include <cstdio>
#include <cstdint>

#ifndef PHMASK
#define PHMASK 0xFFFFFFFFu
#endif
#define PH_ON(i) ((PHMASK >> (i)) & 1u)
#ifndef REP_DIFF
#define REP_DIFF 1
#endif
#ifndef REP_MOE
#define REP_MOE 1
#endif
#ifndef REP_P0
#define REP_P0 1
#endif
#ifndef REP_P0B
#define REP_P0B 1
#endif
#ifndef EXTRA_BARS
#define EXTRA_BARS 0
#endif
#ifndef REP_EPI
#define REP_EPI 1
#endif
#ifndef WAITSEL
#define WAITSEL 0xFFFFu
#endif
#ifndef WAITPROBE
#define WAITPROBE 0
#endif
#ifndef KREP
#define KREP 1
#endif
#ifndef REP_PROJ
#define REP_PROJ 1
#endif
#ifndef REP_FOUR
#define REP_FOUR 1
#endif
#ifndef REP_WIN
#define REP_WIN 1
#endif
#ifndef PROBE_CLK
#define PROBE_CLK 0
#endif
#define LAS __attribute__((address_space(3)))
#define GAS __attribute__((address_space(1)))
typedef unsigned short bf16_t;
typedef short bf16x8 __attribute__((ext_vector_type(8)));
typedef short s16x4 __attribute__((ext_vector_type(4)));
typedef float f32x2 __attribute__((ext_vector_type(2)));
typedef float f32x4 __attribute__((ext_vector_type(4)));
typedef float f32x16 __attribute__((ext_vector_type(16)));
typedef unsigned u32x2 __attribute__((ext_vector_type(2)));
typedef unsigned u32x4 __attribute__((ext_vector_type(4)));
typedef __bf16 bf16x2_t __attribute__((ext_vector_type(2)));
typedef int v8i_t __attribute__((ext_vector_type(8)));

constexpr int DM = 1024, NB = 8, SEQ = 4096, CTX = 256, DEPTH = 4;
constexpr int RL = NB * SEQ, RC = NB * CTX, RT = RL + RC;
constexpr int MIXIN = 1280, FFN = 2816, NEXP = 8, EDIM = 3584;
constexpr int MAXSLOT = 71680;
constexpr float EPS = 1e-6f;
constexpr float LOG2E = 1.4426950408889634f;
constexpr float QK_C = 0.125f * LOG2E;

constexpr size_t MiB = 1u << 20;
constexpr size_t WS_CTL = 0, CTL_BYTES = 32 * 1024;
constexpr size_t WS_MOD = 1 * MiB;
constexpr size_t WS_ROPE = WS_MOD + 900 * 1024;
constexpr size_t WS_WP = WS_ROPE + 8 * 1024;
constexpr size_t WS_ROUTE = 2 * MiB;
constexpr size_t WS_CS = 4 * MiB;
constexpr size_t WS_CSC = 68 * MiB;
constexpr size_t WS_WMIXIN = 72 * MiB;
constexpr size_t WS_WMIXOUT = 77 * MiB;
constexpr size_t WS_WQKV = 81 * MiB;
constexpr size_t WS_WDOUT = 93 * MiB;
constexpr size_t WS_WFFNIN = 97 * MiB;
constexpr size_t WS_WFFNOUT = 119 * MiB;
constexpr size_t WS_WEXPIN = 130 * MiB;
constexpr size_t WS_WEXPOUT = 354 * MiB;
constexpr size_t WS_X = 466 * MiB;
constexpr size_t WS_H = 602 * MiB;
constexpr size_t WS_YO = 670 * MiB;
constexpr size_t WS_RA = 738 * MiB;
constexpr size_t WS_Z = WS_RA;
constexpr size_t WS_Y = WS_RA + 85 * MiB;
constexpr size_t WS_PQT = WS_RA + 153 * MiB;
constexpr size_t WS_O = WS_RA + 204 * MiB;
constexpr size_t WS_RB = 1010 * MiB;
constexpr size_t WS_A2 = WS_RB;
constexpr size_t WS_QK8 = WS_RB;
constexpr size_t WS_PQTC = WS_RB + 190 * MiB;
constexpr size_t WS_A2M = WS_H;
constexpr size_t WS_HS = 1092 * MiB;
constexpr size_t WS_END = 1364 * MiB;
static_assert(WS_A2M + (size_t)MAXSLOT * EDIM * 2 <= WS_HS, "A2m overlay");
static_assert(WS_HS + (size_t)NEXP * RT * DM <= WS_END && WS_HS + (size_t)MAXSLOT * DM * 2 <= WS_END && WS_PQTC + 64 * MiB <= WS_END, "ws end");

constexpr int CW_TMO = 0;
constexpr int CW_CNT = 64;
constexpr int CW_BAR = 4096;

constexpr int RING_BYTES = 131072;
constexpr int MISC_OFF = RING_BYTES + 320;
constexpr int LDS_BYTES = 147456;

__device__ __forceinline__ unsigned cvtpk(float lo, float hi) { f32x2 v = {lo, hi}; bf16x2_t b = __builtin_convertvector(v, bf16x2_t); return __builtin_bit_cast(unsigned, b); }
#ifndef F8_DENSE
#define F8_DENSE false
#endif
#ifndef F8_DDOWN
#define F8_DDOWN true
#endif
#ifndef F8_FOUR
#define F8_FOUR false
#endif
static_assert(!F8_FOUR, "fp8 Fourier path retired");
constexpr int FP = 4096;
constexpr float F8_SCS = 256.f, F8_SPQ = 8.f;
constexpr float F8_SH = 4.f, F8_SW = 64.f, F8_SA = 4.f;
__device__ __forceinline__ float f8clamp(float v) { return __builtin_amdgcn_fmed3f(v, -448.f, 448.f); }
__device__ __forceinline__ unsigned pk4_fp8(float a, float b, float c, float d) {
    unsigned w = 0; w = __builtin_amdgcn_cvt_pk_fp8_f32(f8clamp(a), f8clamp(b), w, false); w = __builtin_amdgcn_cvt_pk_fp8_f32(f8clamp(c), f8clamp(d), w, true); return w; }
__device__ __forceinline__ float bf_lo(unsigned u) { return __uint_as_float(u << 16); }
__device__ __forceinline__ float bf_hi(unsigned u) { return __uint_as_float(u & 0xffff0000u); }
__device__ __forceinline__ float wave_sum(float v, int lane) {
#pragma unroll
    for (int o = 1; o < 64; o <<= 1) v += __int_as_float(__builtin_amdgcn_ds_bpermute((lane ^ o) << 2, __float_as_int(v)));
    return v;
}
__device__ __forceinline__ unsigned rfl(unsigned v) { return (unsigned)__builtin_amdgcn_readfirstlane((int)v); }
__device__ __forceinline__ const char* uptr(const char* p) {
    unsigned lo = (unsigned)__builtin_amdgcn_readfirstlane((int)(unsigned)(uintptr_t)p), hi = (unsigned)__builtin_amdgcn_readfirstlane((int)(unsigned)((uintptr_t)p >> 32));
    asm volatile("" : "+s"(lo), "+s"(hi));
    return (const char*)(((uintptr_t)hi << 32) | lo);
}
__device__ __forceinline__ GAS unsigned char* gptr(const void* p) {
    unsigned lo = (unsigned)__builtin_amdgcn_readfirstlane((int)(unsigned)(uintptr_t)p), hi = (unsigned)__builtin_amdgcn_readfirstlane((int)(unsigned)((uintptr_t)p >> 32));
    asm volatile("" : "+s"(lo), "+s"(hi));
    return (GAS unsigned char*)(((uintptr_t)hi << 32) | lo);
}
__device__ __forceinline__ int sopaque(int v) { v = __builtin_amdgcn_readfirstlane(v); asm volatile("" : "+s"(v)); return v; }
__device__ __forceinline__ int opaque(int v) { asm volatile("" : "+v"(v)); return v; }
#define LDS_WAIT() asm volatile("s_waitcnt lgkmcnt(0)" ::: "memory")
#define VM_WAIT() asm volatile("s_waitcnt vmcnt(0)" ::: "memory")
#define SBAR() __builtin_amdgcn_sched_barrier(0)

namespace pg8 {
constexpr int BM = 256, BK = 64, HALF = 128, HTB = HALF * BK * 2, STAGE_BYTES = 8 * HTB, NXCD = 8, WGM = 8;
__host__ __device__ __forceinline__ int lds_byte(int r, int c) { const int st = (r >> 4) * 2 + (c >> 5), rr = r & 15, cc = c & 31, ob = rr * 64 + cc * 2; return st * 1024 + (ob ^ (((ob >> 9) & 1) << 5)); }
__host__ __device__ __forceinline__ void stage_rc(int b, int& R, int& C) { const int st = b / 1024, sb = b % 1024, swz = sb ^ (((sb >> 9) & 1) << 5); R = (st >> 1) * 16 + swz / 64; C = (st & 1) * 32 + (swz % 64) / 2; }
__host__ __device__ __forceinline__ int perm32(int rho) { const int n = rho >> 4, i = rho & 15; return 8 * (i >> 2) + 4 * n + (i & 3); }

struct Unit { int pm, pn, e, nkt; };
struct Dims { int lda, ldb; };

__device__ __forceinline__ int xcd_remap(int wgid, int nwg) {
    const int q = nwg / NXCD, r = nwg % NXCD, xcd = wgid % NXCD, off = wgid / NXCD;
    return (xcd < r ? xcd * (q + 1) : r * (q + 1) + (xcd - r) * q) + off;
}

#ifndef ALIGN_SWIGLU
#define ALIGN_SWIGLU true
#endif
#ifndef ALIGN_DEFAULT
#define ALIGN_DEFAULT true
#endif
template <class Epi, class Sched, bool F8 = false, bool ALIGN_EPI = ALIGN_DEFAULT>
__device__ __forceinline__ void gemm_phase(LAS unsigned char* lds, const Dims g, const Sched& S, const Epi& E) {
    const int tid = opaque(threadIdx.x), wid = __builtin_amdgcn_readfirstlane(tid >> 6), lane = tid & 63, wr = wid >> 2, wc = wid & 3, fr = lane & 15, fq = lane >> 4;
    unsigned voffA[2], voffB[2];
#pragma unroll
    for (int i = 0; i < 2; ++i) { int R, C; stage_rc(tid * 16 + i * 8192, R, C); const int Rb = Epi::PERM ? ((R & ~31) + perm32(R & 31)) : R;
        voffA[i] = (unsigned)(R * g.lda + C) * 2u; voffB[i] = (unsigned)(Rb * g.ldb + C) * 2u; }
    const size_t kstep = (size_t)(BK * 2);
    const size_t hstepA = (size_t)HALF * g.lda * 2, hstepB = (size_t)HALF * g.ldb * 2;
    const unsigned ldsw = (unsigned)wid * 1024u;
    const int aoff = lds_byte(wr * 64 + fr, fq * 8), boff = lds_byte(wc * 32 + fr, fq * 8);
#define PG8_SA(b, h) (((b) * 2 + (h)) * HTB)
#define PG8_SB(b, h) ((4 + (b) * 2 + (h)) * HTB)
#define PG8_STAGE(bufoff, gbase, voff) do { _Pragma("unroll") for (int _i = 0; _i < 2; ++_i) \
        __builtin_amdgcn_global_load_lds((const unsigned*)((const char*)(gbase) + (voff)[_i]), (LAS unsigned*)(lds + (bufoff) + ldsw + _i * 8192), 16, 0, 0); } while (0)
#define PG8_LDA(dst, b, h) do { _Pragma("unroll") for (int m = 0; m < 4; ++m) _Pragma("unroll") for (int k = 0; k < 2; ++k) dst[m][k] = *(const LAS bf16x8*)(lds + PG8_SA(b, h) + aoff + m * 2048 + k * 1024); } while (0)
#define PG8_LDB(dst, b, h) do { _Pragma("unroll") for (int n = 0; n < 2; ++n) _Pragma("unroll") for (int k = 0; k < 2; ++k) dst[n][k] = *(const LAS bf16x8*)(lds + PG8_SB(b, h) + boff + n * 2048 + k * 1024); } while (0)
#define PG8_V8(x) __builtin_bit_cast(v8i_t, (x))
#define PG8_MMA(ai, bj, At, Bt) do { __builtin_amdgcn_s_setprio(1); _Pragma("unroll") for (int m = 0; m < 4; ++m) _Pragma("unroll") for (int n = 0; n < 2; ++n) { \
        if constexpr (F8) { struct P2 { bf16x8 a, b; }; const v8i_t a8_ = PG8_V8((P2{Bt[n][0], Bt[n][1]})), b8_ = PG8_V8((P2{At[m][0], At[m][1]})); \
            asm volatile("v_mfma_f32_16x16x128_f8f6f4 %0, %1, %2, %0" : "+v"(acc[ai][bj][m][n]) : "v"(a8_), "v"(b8_)); }   \
        else { _Pragma("unroll") for (int k = 0; k < 2; ++k) acc[ai][bj][m][n] = __builtin_amdgcn_mfma_f32_16x16x32_bf16(Bt[n][k], At[m][k], acc[ai][bj][m][n], 0, 0, 0); } } \
        __builtin_amdgcn_s_setprio(0); } while (0)
#define PG8_WAIT_V(n) asm volatile("s_waitcnt vmcnt(" #n ")" ::: "memory")
#define PG8_WAIT_L(n) asm volatile("s_waitcnt lgkmcnt(" #n ")" ::: "memory")
#define PG8_BAR __builtin_amdgcn_s_barrier()
#define PG8_SCHED __builtin_amdgcn_sched_barrier(0)
    Unit cur, nxt; int ui = 0;
    if (!S.next(0, cur)) return;
    constexpr bool MIR = Sched::MIRROR;
    unsigned vB2c[2] = {0u, 0u}, vB2n[2] = {0u, 0u}; const char* cB2 = nullptr; const char* nB2 = nullptr;
#define PG8_MKV2(dst, un) do { const int t2_ = opaque(threadIdx.x); _Pragma("unroll") for (int i_ = 0; i_ < 2; ++i_) { int R_, C_; stage_rc(t2_ * 16 + i_ * 8192, R_, C_); \
        const int Rb_ = Epi::PERM ? ((R_ & ~31) + perm32(R_ & 31)) : R_; dst[i_] = S.voff2(un, Rb_, C_, g.ldb); } } while (0)
    if constexpr (MIR) { PG8_MKV2(vB2c, cur); cB2 = uptr(S.bptr2(cur)); }
    f32x4 acc[2][2][4][2];
#pragma unroll
    for (int a = 0; a < 2; ++a)
#pragma unroll
        for (int b = 0; b < 2; ++b)
#pragma unroll
            for (int m = 0; m < 4; ++m)
#pragma unroll
                for (int n = 0; n < 2; ++n) acc[a][b][m][n] = (f32x4){0.f, 0.f, 0.f, 0.f};
    bf16x8 At[4][2], B0[2][2], B1[2][2];
    const char* cA = uptr(S.aptr(cur)); const char* cB = uptr(S.bptr(cur));
    PG8_STAGE(PG8_SB(0, 0), cB, voffB); if constexpr (MIR) PG8_STAGE(PG8_SB(0, 1), cB2, vB2c); else PG8_STAGE(PG8_SB(0, 1), cB + hstepB, voffB); PG8_STAGE(PG8_SA(0, 0), cA, voffA); PG8_STAGE(PG8_SA(0, 1), cA + hstepA, voffA);
    if (wr == 1) PG8_BAR;
    PG8_WAIT_V(2); PG8_BAR;
    PG8_STAGE(PG8_SB(1, 0), cB + kstep, voffB); PG8_STAGE(PG8_SA(1, 0), cA + kstep, voffA); if constexpr (MIR) PG8_STAGE(PG8_SB(1, 1), cB2 + kstep, vB2c); else PG8_STAGE(PG8_SB(1, 1), cB + hstepB + kstep, voffB);
    PG8_WAIT_V(6); PG8_BAR;
    for (;;) {
        const bool has_next = S.next(ui + 1, nxt);
        const char* nA = uptr(has_next ? S.aptr(nxt) : cA); const char* nB = uptr(has_next ? S.bptr(nxt) : cB);
        if constexpr (MIR) { if (has_next) { PG8_MKV2(vB2n, nxt); nB2 = uptr(S.bptr2(nxt)); } else { vB2n[0] = vB2c[0]; vB2n[1] = vB2c[1]; nB2 = cB2; } }
        const int nt = sopaque(cur.nkt);
        for (int t = 0; t < KREP * nt; t += 2) {
            const bool last = (t == KREP * nt - 2);
            const char* a1 = cA + (size_t)(KREP == 1 ? t + 1 : (t + 1) % nt) * kstep;
            const char* a2 = last ? nA : cA + (size_t)(KREP == 1 ? t + 2 : (t + 2) % nt) * kstep; const char* b2 = last ? nB : cB + (size_t)(KREP == 1 ? t + 2 : (t + 2) % nt) * kstep;
            const char* a3 = a2 + kstep; const char* b3 = b2 + kstep;
            const char* m2 = nullptr; unsigned vm[2] = {0u, 0u};
            if constexpr (MIR) { m2 = last ? nB2 : cB2 + (size_t)(t + 2) * kstep; vm[0] = last ? vB2n[0] : vB2c[0]; vm[1] = last ? vB2n[1] : vB2c[1]; }
            PG8_LDB(B0, 0, 0); PG8_LDB(B1, 0, 1); PG8_SCHED; PG8_LDA(At, 0, 0); PG8_STAGE(PG8_SA(1, 1), a1 + hstepA, voffA);
            PG8_WAIT_V(8); PG8_WAIT_L(0); PG8_BAR; PG8_MMA(0, 0, At, B0); PG8_MMA(0, 1, At, B1); PG8_BAR; PG8_SCHED;
            PG8_LDA(At, 0, 1); PG8_STAGE(PG8_SB(0, 0), b2, voffB); if constexpr (MIR) PG8_STAGE(PG8_SB(0, 1), m2, vm); else PG8_STAGE(PG8_SB(0, 1), b2 + hstepB, voffB); PG8_STAGE(PG8_SA(0, 0), a2, voffA);
            PG8_WAIT_V(8); PG8_WAIT_L(0); PG8_BAR; PG8_MMA(1, 0, At, B0); PG8_MMA(1, 1, At, B1); PG8_BAR; PG8_SCHED;
            PG8_LDB(B0, 1, 0); PG8_LDB(B1, 1, 1); PG8_SCHED; PG8_LDA(At, 1, 0); PG8_STAGE(PG8_SA(0, 1), a2 + hstepA, voffA);
            PG8_WAIT_V(8); PG8_WAIT_L(0); PG8_BAR; PG8_MMA(0, 0, At, B0); PG8_MMA(0, 1, At, B1); PG8_BAR; PG8_SCHED;
            PG8_LDA(At, 1, 1); PG8_STAGE(PG8_SB(1, 0), b3, voffB); if constexpr (MIR) PG8_STAGE(PG8_SB(1, 1), m2 + kstep, vm); else PG8_STAGE(PG8_SB(1, 1), b3 + hstepB, voffB); PG8_STAGE(PG8_SA(1, 0), a3, voffA);
            PG8_WAIT_V(8); PG8_WAIT_L(0); PG8_BAR; PG8_MMA(1, 0, At, B0); PG8_MMA(1, 1, At, B1); PG8_BAR; PG8_SCHED;
        }
        if constexpr (ALIGN_EPI) { if (wr == 0) PG8_BAR; }
        if constexpr (F8) asm volatile("s_nop 15\n\ts_nop 15" ::: "memory");
        for (int repe = 0; repe < REP_EPI; ++repe) { const int l2 = opaque(threadIdx.x) & 63; E(acc, cur, wr, wc, l2 & 15, l2 >> 4); }
        if (!has_next) break;
#pragma unroll
        for (int a = 0; a < 2; ++a)
#pragma unroll
            for (int b = 0; b < 2; ++b)
#pragma unroll
                for (int m = 0; m < 4; ++m)
#pragma unroll
                    for (int n = 0; n < 2; ++n) acc[a][b][m][n] = (f32x4){0.f, 0.f, 0.f, 0.f};
        cur = nxt; cA = nA; cB = nB; ++ui;
        if constexpr (MIR) { cB2 = nB2; vB2c[0] = vB2n[0]; vB2c[1] = vB2n[1]; }
        if constexpr (ALIGN_EPI) { if (wr == 1) PG8_BAR; }
    }
    PG8_WAIT_V(0);
    if constexpr (!ALIGN_EPI) { if (wr == 0) PG8_BAR; }
    PG8_BAR;
#undef PG8_MKV2
#undef PG8_SA
#undef PG8_SB
#undef PG8_STAGE
#undef PG8_LDA
#undef PG8_LDB
#undef PG8_MMA
#undef PG8_V8
#undef PG8_WAIT_V
#undef PG8_WAIT_L
#undef PG8_BAR
#undef PG8_SCHED
}
}
using pg8::Unit;

struct EpiStore {
    static constexpr bool PERM = true;
    bf16_t* O; int ldc; float scale;
    __device__ __forceinline__ void operator()(const f32x4 (&acc)[2][2][4][2], const Unit& u, int wr, int wc, int fr, int fq) const {
        const int row0 = u.pm * 256 + wr * 64 + fr, col0 = u.pn * 256 + wc * 32 + 8 * fq;
#pragma unroll
        for (int ai = 0; ai < 2; ++ai)
#pragma unroll
            for (int m = 0; m < 4; ++m) { bf16_t* rowp = O + (size_t)(row0 + ai * 128 + m * 16) * ldc + col0;
#pragma unroll
                for (int bj = 0; bj < 2; ++bj) { const f32x4 v0 = acc[ai][bj][m][0] * (scale * (1.f / KREP)), v1 = acc[ai][bj][m][1] * (scale * (1.f / KREP));
                    u32x4 w; w.x = cvtpk(v0[0], v0[1]); w.y = cvtpk(v0[2], v0[3]); w.z = cvtpk(v1[0], v1[1]); w.w = cvtpk(v1[2], v1[3]);
                    *(u32x4*)(rowp + bj * 128) = w; } }
    }
};
template <bool F8OUT> struct EpiSwiglu {
    static constexpr bool PERM = true;
    unsigned char* O; int ldc; float scale;
    __device__ __forceinline__ void operator()(const f32x4 (&acc)[2][2][4][2], const Unit& u, int wr, int wc, int fr, int fq) const {
        const int row0 = u.pm * 256 + wr * 64 + fr, col0 = u.pn * 128 + wc * 32 + 8 * fq;
        const float us = F8OUT ? scale * F8_SA : scale;
        const float k1 = -scale * LOG2E * (1.f / KREP), ik2 = 1.f / (scale * us * (1.f / KREP) * (1.f / KREP));
#pragma unroll
        for (int ai = 0; ai < 2; ++ai)
#pragma unroll
            for (int m = 0; m < 4; ++m) { unsigned char* rowp = O + ((size_t)(row0 + ai * 128 + m * 16) * ldc + col0) * (F8OUT ? 1 : 2);
                float r[8];
#pragma unroll
                for (int n = 0; n < 2; ++n) { const f32x4 g = acc[ai][0][m][n], u = acc[ai][1][m][n]; const f32x4 t = g * k1;
                    f32x4 e; e[0] = __builtin_amdgcn_exp2f(t[0]); e[1] = __builtin_amdgcn_exp2f(t[1]); e[2] = __builtin_amdgcn_exp2f(t[2]); e[3] = __builtin_amdgcn_exp2f(t[3]);
                    const f32x4 d = e * ik2 + ik2;
                    f32x4 q; q[0] = __builtin_amdgcn_rcpf(d[0]); q[1] = __builtin_amdgcn_rcpf(d[1]); q[2] = __builtin_amdgcn_rcpf(d[2]); q[3] = __builtin_amdgcn_rcpf(d[3]);
                    const f32x4 o = (g * u) * q; r[n * 4 + 0] = o[0]; r[n * 4 + 1] = o[1]; r[n * 4 + 2] = o[2]; r[n * 4 + 3] = o[3]; }
                if constexpr (F8OUT) { u32x2 w; w.x = pk4_fp8(r[0], r[1], r[2], r[3]); w.y = pk4_fp8(r[4], r[5], r[6], r[7]); *(u32x2*)rowp = w; }
                else { u32x4 w; w.x = cvtpk(r[0], r[1]); w.y = cvtpk(r[2], r[3]); w.z = cvtpk(r[4], r[5]); w.w = cvtpk(r[6], r[7]); *(u32x4*)rowp = w; } }
    }
};
struct EpiRope {
    static constexpr bool PERM = false;
    bf16_t* O; int ldc; int rlo, rhi; const f32x2* cs;
    int qlo, qhi; float qscale;
    unsigned char* O8; int f8hi;
    __device__ __forceinline__ void operator()(const f32x4 (&acc)[2][2][4][2], const Unit& u, int wr, int wc, int fr, int fq) const {
        const int row0 = u.pm * 256 + wr * 64 + fr, col0 = u.pn * 256 + wc * 32 + 4 * fq;
        const bool lat = u.pm < 128;
#pragma unroll
        for (int ai = 0; ai < 2; ++ai)
#pragma unroll
            for (int m = 0; m < 4; ++m) { const int row = row0 + ai * 128 + m * 16; bf16_t* rowp = O + (size_t)row * ldc + col0;
                const int t = row & 4095, pos = (wc & 1) ? (t & 63) : (t >> 6);
                const f32x2* c4 = cs + pos * 16 + 4 * fq;
                const f32x2 c0 = c4[0], c1 = c4[1], c2 = c4[2], c3 = c4[3];
#pragma unroll
                for (int bj = 0; bj < 2; ++bj) { f32x4 p1 = acc[ai][bj][m][0] * (1.f / KREP), p2 = acc[ai][bj][m][1] * (1.f / KREP);
                    const int blk = u.pn * 2 + bj;
                    if (lat && blk >= rlo && blk < rhi) {
                        const f32x4 cv = {c0.x, c1.x, c2.x, c3.x}, sv = {c0.y, c1.y, c2.y, c3.y};
                        const f32x4 o1 = p1 * cv - p2 * sv, o2 = p2 * cv + p1 * sv; p1 = o1; p2 = o2; }
                    if (blk >= qlo && blk < qhi) { p1 = p1 * qscale; p2 = p2 * qscale; }
                    if (blk < f8hi) { unsigned char* r8 = O8 + (size_t)row * 2048 + col0 + bj * 128;
                        *(unsigned*)r8 = pk4_fp8(p1[0], p1[1], p1[2], p1[3]); *(unsigned*)(r8 + 16) = pk4_fp8(p2[0], p2[1], p2[2], p2[3]); }
                    else { u32x2 w1, w2; w1.x = cvtpk(p1[0], p1[1]); w1.y = cvtpk(p1[2], p1[3]); w2.x = cvtpk(p2[0], p2[1]); w2.y = cvtpk(p2[2], p2[3]);
                        *(u32x2*)(rowp + bj * 128) = w1; *(u32x2*)(rowp + bj * 128 + 16) = w2; } } }
    }
};
struct EpiPQt {
    static constexpr bool PERM = true;
    bf16_t* Plat; bf16_t* Pctx;
    __device__ __forceinline__ void operator()(const f32x4 (&acc)[2][2][4][2], const Unit& u, int wr, int wc, int fr, int fq) const {
        const bool ctx = u.e >= 32; const int bg = ctx ? u.e - 32 : u.e;
        bf16_t* base = (ctx ? Pctx : Plat) + (size_t)bg * 128 * FP;
        if (ctx) {
            const int col0 = wc * 32 + 8 * fq;
#pragma unroll
            for (int ai = 0; ai < 2; ++ai)
#pragma unroll
                for (int m = 0; m < 4; ++m) { bf16_t* rowp = base + (size_t)(wr * 64 + m * 16 + fr) * FP + ai * CTX + col0;
#pragma unroll
                    for (int bj = 0; bj < 2; ++bj) { const f32x4 v0 = acc[ai][bj][m][0] * (1.f / KREP), v1 = acc[ai][bj][m][1] * (1.f / KREP);
                        u32x4 w; w.x = cvtpk(v0[0], v0[1]); w.y = cvtpk(v0[2], v0[3]); w.z = cvtpk(v1[0], v1[1]); w.w = cvtpk(v1[2], v1[3]); *(u32x4*)(rowp + bj * 128) = w; } }
        } else {
            const int col0 = u.pn * 128 + wc * 32 + 8 * fq;
            const bool sp = u.pn == 0 && wc == 0 && fq == 0;
#pragma unroll
            for (int m = 0; m < 4; ++m) { bf16_t* rowp = base + (size_t)(wr * 64 + m * 16 + fr) * FP + col0;
                f32x4 p0 = (acc[0][0][m][0] + acc[0][1][m][0]) * (1.f / KREP), p1 = (acc[0][0][m][1] + acc[0][1][m][1]) * (1.f / KREP);
                f32x4 q0 = (acc[1][0][m][0] - acc[1][1][m][0]) * (1.f / KREP), q1 = (acc[1][0][m][1] - acc[1][1][m][1]) * (1.f / KREP);
                if (sp) { p0[0] = acc[0][0][m][0][0] * (1.f / KREP); q0[0] = acc[0][1][m][0][0] * (1.f / KREP); }
                u32x4 w; w.x = cvtpk(p0[0], p0[1]); w.y = cvtpk(p0[2], p0[3]); w.z = cvtpk(p1[0], p1[1]); w.w = cvtpk(p1[2], p1[3]); *(u32x4*)rowp = w;
                w.x = cvtpk(q0[0], q0[1]); w.y = cvtpk(q0[2], q0[3]); w.z = cvtpk(q1[0], q1[1]); w.w = cvtpk(q1[2], q1[3]); *(u32x4*)(rowp + 2048) = w; }
        }
    }
};
struct EpiFour2 {
    static constexpr bool PERM = true;
    bf16_t* O;
    __device__ __forceinline__ void operator()(const f32x4 (&acc)[2][2][4][2], const Unit& u, int wr, int wc, int fr, int fq) const {
        EpiStore s{O, DM, (u.pm < 128 ? 0.0013810679320049757f   : 0.005524271728019903f  )};
        s(acc, u, wr, wc, fr, fq);
    }
};

struct SchedDense {
    static constexpr bool MIRROR = false;
    const char* A; const char* B; int nM, nN, nwg, G, c, nkt; size_t tA, tB;
    __device__ __forceinline__ void init(const void* A_, int lda, const void* B_, int ldb, int M, int N, int K, int G_, int c_) {
        A = (const char*)A_; B = (const char*)B_; nM = M / 256; nN = N / 256; nwg = nM * nN; G = G_; c = c_; nkt = K / 64; tA = (size_t)256 * lda * 2; tB = (size_t)256 * ldb * 2; }
    __device__ __forceinline__ bool next(int i, Unit& u) const {
        const long L = (long)i * G + c; if (L >= nwg) return false;
        const int wgid = pg8::xcd_remap((int)L, nwg);
        const int nig = pg8::WGM * nN, gid = wgid / nig, fm = gid * pg8::WGM, gsz = (nM - fm) < pg8::WGM ? (nM - fm) : pg8::WGM;
        u.pm = fm + ((wgid % nig) % gsz); u.pn = (wgid % nig) / gsz; u.e = 0; u.nkt = nkt; return true;
    }
    __device__ __forceinline__ const char* aptr(const Unit& u) const { return A + (size_t)u.pm * tA; }
    __device__ __forceinline__ const char* bptr(const Unit& u) const { return B + (size_t)u.pn * tB; }
};
struct SchedGroup {
    static constexpr bool MIRROR = false;
    const char* A; const char* B; int P1, P2, P3, P4, P5, P6, P7, nRT, nN, nwg, G, c, nkt; size_t tA, tB, gB, aE;
    __device__ __forceinline__ bool next(int i, Unit& u) const {
        const long L = (long)i * G + c; if (L >= nwg) return false;
        const int wgid = pg8::xcd_remap((int)L, nwg);
        const int nig = pg8::WGM * nN, gid = wgid / nig, fm = gid * pg8::WGM, gsz = (nRT - fm) < pg8::WGM ? (nRT - fm) : pg8::WGM;
        const int rt = fm + ((wgid % nig) % gsz);
        u.pm = rt; u.pn = (wgid % nig) / gsz; u.nkt = nkt;
        u.e = (rt >= P1) + (rt >= P2) + (rt >= P3) + (rt >= P4) + (rt >= P5) + (rt >= P6) + (rt >= P7); return true;
    }
    __device__ __forceinline__ const char* aptr(const Unit& u) const {
        if (aE == 0) return A + (size_t)u.pm * tA;
        const int pe = u.e == 0 ? 0 : u.e == 1 ? P1 : u.e == 2 ? P2 : u.e == 3 ? P3 : u.e == 4 ? P4 : u.e == 5 ? P5 : u.e == 6 ? P6 : P7;
        return A + (size_t)u.e * aE + (size_t)(u.pm - pe) * tA; }
    __device__ __forceinline__ const char* bptr(const Unit& u) const { return B + (size_t)u.e * gB + (size_t)u.pn * tB; }
};
struct SchedF1 {
    static constexpr bool MIRROR = true;
    const char* Wp; const char* Z; int G, c;
    __device__ __forceinline__ bool next(int i, Unit& u) const {
        const int L = i * G + c; if (L >= 544) return false;
        u.pm = 0; u.nkt = 2;
        if (L < 512) { u.e = L >> 4; u.pn = L & 15; } else { u.e = 32 + (L - 512); u.pn = 0; }
        return true;
    }
    __device__ __forceinline__ const char* aptr(const Unit&) const { return Wp; }
    __device__ __forceinline__ const char* bptr(const Unit& u) const {
        const bool ctx = u.e >= 32; const int bg = ctx ? u.e - 32 : u.e, b = bg >> 2, gq = bg & 3;
        const size_t row0 = ctx ? (size_t)RL + b * CTX : (size_t)b * SEQ + u.pn * 128;
        return Z + (row0 * MIXIN + gq * 128) * 2; }
    __device__ __forceinline__ const char* bptr2(const Unit& u) const {
        const bool ctx = u.e >= 32; const int bg = ctx ? u.e - 32 : u.e, b = bg >> 2, gq = bg & 3;
        const size_t row0 = ctx ? (size_t)RL + b * CTX + 128 : (size_t)b * SEQ;
        return Z + (row0 * MIXIN + gq * 128) * 2; }
    __device__ __forceinline__ unsigned voff2(const Unit& u, int R, int C, int ldb) const {
        const int tok = u.e >= 32 ? R : (u.pn == 0 && R == 0) ? 2048 : 4096 - 128 * u.pn - R;
        return (unsigned)(tok * ldb + C) * 2u; }
};
struct SchedF2 {
    static constexpr bool MIRROR = false;
    const char* CSl; const char* CSc; const char* Plat; const char* Pctx; int G, vcu;
    static constexpr size_t EB = 2;
    __device__ __forceinline__ bool next(int i, Unit& u) const {
        const int L = i * G + vcu; if (L >= 272) return false;
        if (L < 256) { const int b = L >> 5, mt = (L & 31) >> 1; u.pm = b * 16 + mt; u.pn = L & 1; u.e = b; u.nkt = 64; }
        else { const int b = (L - 256) >> 1; u.pm = 128 + b; u.pn = L & 1; u.e = 8 + b; u.nkt = 8; }
        return true;
    }
    __device__ __forceinline__ const char* aptr(const Unit& u) const { return u.e < 8 ? CSl + (size_t)(u.pm & 15) * 256 * FP * EB : CSc; }
    __device__ __forceinline__ const char* bptr(const Unit& u) const { return (u.e < 8 ? Plat + (size_t)u.e * 512 * FP * EB : Pctx + (size_t)(u.e - 8) * 512 * FP * EB) + (size_t)u.pn * 256 * FP * EB; }
};

#define XB_TMO      128
#define XB_XCNT(j)  (256  + 64 * (j))
#define XB_XSUB(j)  (1280 + 64 * (j))
#define XB_XGEN(j)  (2304 + 64 * (j))
#define XB_TOP      3328
#define XB_TOPGEN   3392
#define XCD_BAR_WORDS 3456
#define XB_SPIN_CAP (1u << 21)
__device__ __forceinline__ unsigned xb_ld(unsigned* p)              { return __hip_atomic_load(p, __ATOMIC_RELAXED, __HIP_MEMORY_SCOPE_AGENT); }
__device__ __forceinline__ unsigned xb_add(unsigned* p, unsigned v) { return __hip_atomic_fetch_add(p, v, __ATOMIC_RELAXED, __HIP_MEMORY_SCOPE_AGENT); }
__device__ __forceinline__ unsigned xb_xcc_id() { return (unsigned)__builtin_amdgcn_s_getreg((3 << 11) | 20) & 0xFu; }
#define XB_SPIN(cond, bar) do { unsigned _sp = 0; while (cond) { __builtin_amdgcn_s_sleep(1); \
    if ((++_sp & 255u) == 0u) { if (xb_ld(&(bar)[XB_TMO])) break; if (_sp > XB_SPIN_CAP) { atomicAdd(&(bar)[XB_TMO], 1u); break; } } } } while (0)
struct XcdBarrier { unsigned* bar; unsigned x; volatile LAS unsigned* st; };
__device__ __forceinline__ XcdBarrier xcd_barrier_post(unsigned* bar, volatile LAS unsigned* st) {
    XcdBarrier b; b.bar = bar; b.x = xb_xcc_id(); b.st = st;
    if (threadIdx.x == 0) (void)xb_add(&bar[XB_XCNT(b.x)], 1u);
    return b;
}
__device__ __forceinline__ void xcd_barrier_complete(unsigned* bar, unsigned x, unsigned& nloc, unsigned& nx) {
    const unsigned G = gridDim.x * gridDim.y * gridDim.z;
    unsigned sum, cnt, mine, sp = 0u;
    for (;;) {
        sum = 0u; cnt = 0u; mine = 0u;
#pragma unroll
        for (unsigned j = 0; j < 16; ++j) { const unsigned c = xb_ld(&bar[XB_XCNT(j)]); sum += c; cnt += (c > 0u) ? 1u : 0u; mine = (j == x) ? c : mine; }
        if (sum == G) break;
        __builtin_amdgcn_s_sleep(1);
        if ((++sp & 255u) == 0u) { if (xb_ld(&bar[XB_TMO])) break; if (sp > XB_SPIN_CAP) { atomicAdd(&bar[XB_TMO], 1u); break; } }
    }
    nloc = mine > 0u ? mine : 1u; nx = cnt > 0u ? cnt : 1u;
}
__device__ __forceinline__ void xcd_barrier(const XcdBarrier& b) {
    asm volatile("s_waitcnt vmcnt(0)" ::: "memory");
    __syncthreads();
    if (threadIdx.x == 0) {
        unsigned* bar = (unsigned*)uptr((const char*)b.bar);
        __builtin_amdgcn_s_waitcnt(0);
        unsigned nloc = b.st[0], nx = b.st[1];
        if (nloc == 0u) { xcd_barrier_complete(bar, b.x, nloc, nx); b.st[0] = nloc; b.st[1] = nx; }
        const unsigned old = xb_add(&bar[XB_XSUB(b.x)], 1u);
        const unsigned gen = old / nloc;
        if (old + 1u == (gen + 1u) * nloc) {
            __builtin_amdgcn_fence(__ATOMIC_RELEASE, "agent");
            asm volatile("s_waitcnt vmcnt(0)" ::: "memory");
            const unsigned og = xb_add(&bar[XB_TOP], 1u);
            const unsigned tg = og / nx;
            if (og + 1u == (tg + 1u) * nx) xb_add(&bar[XB_TOPGEN], 1u);
            else XB_SPIN(xb_ld(&bar[XB_TOPGEN]) == tg, bar);
            __builtin_amdgcn_fence(__ATOMIC_ACQUIRE, "agent");
            xb_add(&bar[XB_XGEN(b.x)], 1u);
            asm volatile("s_waitcnt vmcnt(0)" ::: "memory");
        } else {
            XB_SPIN(xb_ld(&bar[XB_XGEN(b.x)]) == gen, bar);
            __builtin_amdgcn_fence(__ATOMIC_ACQUIRE, "agent");
            asm volatile("s_waitcnt vmcnt(0)" ::: "memory");
        }
    }
    __syncthreads();
}

__device__ __forceinline__ int crow(int r, int hi) { return (r & 3) + 8 * (r >> 2) + 4 * hi; }
template <int KW> __device__ __forceinline__ int kswz(int row, int colB) { return KW == 128 ? row * 256 + (colB ^ ((row & 7) << 4)) : row * 128 + (colB ^ (((row >> 1) & 7) << 4)); }
template <int DV> __device__ __forceinline__ int v_st(int k, int c) { const int kk = (k & ~0xC) | ((k & 4) << 1) | ((k & 8) >> 1); return ((kk >> 3) * (DV / 32) + (c >> 5)) * 512 + ((kk & 7) * 32 + (c & 31)) * 2; }
__device__ __forceinline__ int v_rd_base(int lane) { return ((lane & 3) << 3) | (((lane >> 2) & 3) << 6) | (((lane >> 4) & 1) << 5) | (((lane >> 5) & 1) << 8); }
template <int OFF> __device__ __forceinline__ s16x4 tr_read(int vb) { s16x4 r; asm volatile("ds_read_b64_tr_b16 %0, %1 offset:%2" : "=&v"(r) : "v"(vb), "i"(OFF) : "memory"); return r; }
template <int DV, int D0> __device__ __forceinline__ void pv_one(f32x16& od, int vb, bf16x8 pa0, bf16x8 pa1, bf16x8 pa2, bf16x8 pa3) {
    constexpr int KS = (DV / 32) * 1024, HF = (DV / 32) * 512;
    const s16x4 l0 = tr_read<D0 * 512 + 0 * KS>(vb), h0 = tr_read<D0 * 512 + 0 * KS + HF>(vb), l1 = tr_read<D0 * 512 + 1 * KS>(vb), h1 = tr_read<D0 * 512 + 1 * KS + HF>(vb);
    const s16x4 l2 = tr_read<D0 * 512 + 2 * KS>(vb), h2 = tr_read<D0 * 512 + 2 * KS + HF>(vb), l3 = tr_read<D0 * 512 + 3 * KS>(vb), h3 = tr_read<D0 * 512 + 3 * KS + HF>(vb);
    asm volatile("s_waitcnt lgkmcnt(0)" ::: "memory"); SBAR();
#define PKV(L, H) (bf16x8){L[0], L[1], L[2], L[3], H[0], H[1], H[2], H[3]}
    od = __builtin_amdgcn_mfma_f32_32x32x16_bf16(pa0, PKV(l0, h0), od, 0, 0, 0);
    od = __builtin_amdgcn_mfma_f32_32x32x16_bf16(pa1, PKV(l1, h1), od, 0, 0, 0);
    od = __builtin_amdgcn_mfma_f32_32x32x16_bf16(pa2, PKV(l2, h2), od, 0, 0, 0);
    od = __builtin_amdgcn_mfma_f32_32x32x16_bf16(pa3, PKV(l3, h3), od, 0, 0, 0);
#undef PKV
}
#define PV_RD(D0, L, H) do { L[0] = tr_read<(D0) * 512 + 0 * KS>(vb); H[0] = tr_read<(D0) * 512 + 0 * KS + HF>(vb); L[1] = tr_read<(D0) * 512 + 1 * KS>(vb); H[1] = tr_read<(D0) * 512 + 1 * KS + HF>(vb); \
    L[2] = tr_read<(D0) * 512 + 2 * KS>(vb); H[2] = tr_read<(D0) * 512 + 2 * KS + HF>(vb); L[3] = tr_read<(D0) * 512 + 3 * KS>(vb); H[3] = tr_read<(D0) * 512 + 3 * KS + HF>(vb); } while (0)
#define PV_MM(od, L, H) do { od = __builtin_amdgcn_mfma_f32_32x32x16_bf16(pa0, PKV(L[0], H[0]), od, 0, 0, 0); od = __builtin_amdgcn_mfma_f32_32x32x16_bf16(pa1, PKV(L[1], H[1]), od, 0, 0, 0); \
    od = __builtin_amdgcn_mfma_f32_32x32x16_bf16(pa2, PKV(L[2], H[2]), od, 0, 0, 0); od = __builtin_amdgcn_mfma_f32_32x32x16_bf16(pa3, PKV(L[3], H[3]), od, 0, 0, 0); } while (0)
#define PKV(L, H) (bf16x8){L[0], L[1], L[2], L[3], H[0], H[1], H[2], H[3]}
template <int DV> __device__ __forceinline__ void pv_all(f32x16* o, int vb, bf16x8 pa0, bf16x8 pa1, bf16x8 pa2, bf16x8 pa3) {
    constexpr int KS = (DV / 32) * 1024, HF = (DV / 32) * 512;
    s16x4 la[4], ha[4], lb[4], hb[4];
    PV_RD(0, la, ha);
    PV_RD(1, lb, hb); asm volatile("s_waitcnt lgkmcnt(8)" ::: "memory"); SBAR(); PV_MM(o[0], la, ha);
    if constexpr (DV == 128) {
        PV_RD(2, la, ha); asm volatile("s_waitcnt lgkmcnt(8)" ::: "memory"); SBAR(); PV_MM(o[1], lb, hb);
        PV_RD(3, lb, hb); asm volatile("s_waitcnt lgkmcnt(8)" ::: "memory"); SBAR(); PV_MM(o[2], la, ha);
        asm volatile("s_waitcnt lgkmcnt(0)" ::: "memory"); SBAR(); PV_MM(o[3], lb, hb);
    } else {
        asm volatile("s_waitcnt lgkmcnt(0)" ::: "memory"); SBAR(); PV_MM(o[1], lb, hb);
    }
}
#undef PV_RD
#undef PV_MM
#undef PKV
template <int KW> __device__ __forceinline__ void qkt64(f32x16& p0, f32x16& p1, const char* Ks, const bf16x8* qr, int kcb, int r32, int hi) {
    bf16x8 kb0[4], kb1[4];
#pragma unroll
    for (int d0 = 0; d0 < 4; ++d0) { const int cb = kcb + (d0 * 16 + hi * 8) * 2;
        kb0[d0] = *reinterpret_cast<const bf16x8*>(Ks + kswz<KW>(r32, cb));
        kb1[d0] = *reinterpret_cast<const bf16x8*>(Ks + kswz<KW>(32 + r32, cb)); }
    p0 = f32x16{}; p1 = f32x16{};
#pragma unroll
    for (int d0 = 0; d0 < 4; ++d0) {
        p0 = __builtin_amdgcn_mfma_f32_32x32x16_bf16(kb0[d0], qr[d0], p0, 0, 0, 0);
        p1 = __builtin_amdgcn_mfma_f32_32x32x16_bf16(kb1[d0], qr[d0], p1, 0, 0, 0); }
}
__device__ __forceinline__ void qkt64_f8(f32x16& p0, f32x16& p1, const char* Ks, v8i_t qf, int g0, int r32, const f32x16& cinit) {
    const int sw = r32 & 7; const char* kr = Ks + r32 * 128;
    const u32x4 a0 = *reinterpret_cast<const u32x4*>(kr + ((g0 ^ sw) << 4)), a1 = *reinterpret_cast<const u32x4*>(kr + (((g0 + 1) ^ sw) << 4));
    const u32x4 b0 = *reinterpret_cast<const u32x4*>(kr + 4096 + ((g0 ^ sw) << 4)), b1 = *reinterpret_cast<const u32x4*>(kr + 4096 + (((g0 + 1) ^ sw) << 4));
    const v8i_t A0 = {(int)a0.x, (int)a0.y, (int)a0.z, (int)a0.w, (int)a1.x, (int)a1.y, (int)a1.z, (int)a1.w}, A1 = {(int)b0.x, (int)b0.y, (int)b0.z, (int)b0.w, (int)b1.x, (int)b1.y, (int)b1.z, (int)b1.w};
    p0 = __builtin_amdgcn_mfma_scale_f32_32x32x64_f8f6f4(A0, qf, cinit, 0, 0, 0, 0, 0, 0);
    p1 = __builtin_amdgcn_mfma_scale_f32_32x32x64_f8f6f4(A1, qf, cinit, 0, 0, 0, 0, 0, 0);
}
template <int KW> __device__ __forceinline__ void qkt64n(f32x16& p0, f32x16& p1, const char* Ks, const bf16x8* qr, int kcb, int r32, int hi, const f32x16& cinit) {
#pragma unroll
    for (int d0 = 0; d0 < 4; ++d0) { const int cb = kcb + (d0 * 16 + hi * 8) * 2;
        const bf16x8 b0 = *reinterpret_cast<const bf16x8*>(Ks + kswz<KW>(r32, cb));
        const bf16x8 b1 = *reinterpret_cast<const bf16x8*>(Ks + kswz<KW>(32 + r32, cb));
        if (d0 == 0) { p0 = __builtin_amdgcn_mfma_f32_32x32x16_bf16(b0, qr[0], cinit, 0, 0, 0); p1 = __builtin_amdgcn_mfma_f32_32x32x16_bf16(b1, qr[0], cinit, 0, 0, 0); }
        else { p0 = __builtin_amdgcn_mfma_f32_32x32x16_bf16(b0, qr[d0], p0, 0, 0, 0); p1 = __builtin_amdgcn_mfma_f32_32x32x16_bf16(b1, qr[d0], p1, 0, 0, 0); } }
}
template <int ND> __device__ __forceinline__ void softmax_step(f32x16& p0, f32x16& p1, float& m_reg, float& l_reg, f32x16* o, float* al_l, int r32, int hi,
                                                              bf16x8& pa0, bf16x8& pa1, bf16x8& pa2, bf16x8& pa3) {
    float pmax = p0[0];
#pragma unroll
    for (int r = 1; r < 16; ++r) pmax = fmaxf(pmax, p0[r]);
#pragma unroll
    for (int r = 0; r < 16; ++r) pmax = fmaxf(pmax, p1[r]);
    { auto rr = __builtin_amdgcn_permlane32_swap(__float_as_uint(pmax), __float_as_uint(pmax), false, false); pmax = fmaxf(__uint_as_float(rr[0]), __uint_as_float(rr[1])); }
    const float mn = fmaxf(m_reg, pmax);
    const float alpha = __builtin_amdgcn_exp2f((m_reg - mn) * QK_C); m_reg = mn;
    const float mnC = -mn * QK_C;
#pragma unroll
    for (int r = 0; r < 16; ++r) { p0[r] = __builtin_amdgcn_exp2f(fmaf(p0[r], QK_C, mnC)); p1[r] = __builtin_amdgcn_exp2f(fmaf(p1[r], QK_C, mnC)); }
    float ps = 0.f;
#pragma unroll
    for (int r = 0; r < 16; ++r) ps += p0[r] + p1[r];
    { auto rr = __builtin_amdgcn_permlane32_swap(__float_as_uint(ps), __float_as_uint(ps), false, false); ps = __uint_as_float(rr[0]) + __uint_as_float(rr[1]); }
    l_reg = l_reg * alpha + ps;
    if (__any(alpha < 1.f)) { if (hi == 0) al_l[r32] = alpha; LDS_WAIT();
#pragma unroll
        for (int d = 0; d < ND; ++d)
#pragma unroll
            for (int r = 0; r < 16; ++r) o[d][r] *= al_l[crow(r, hi)];
    }
#define PK4(P, BASE, OUT) do { unsigned a0 = cvtpk(P[BASE + 0], P[BASE + 1]), a1 = cvtpk(P[BASE + 2], P[BASE + 3]);   \
    unsigned b0 = cvtpk(P[BASE + 4], P[BASE + 5]), b1 = cvtpk(P[BASE + 6], P[BASE + 7]);                              \
    auto r0 = __builtin_amdgcn_permlane32_swap(a0, b0, false, false); auto r1 = __builtin_amdgcn_permlane32_swap(a1, b1, false, false); \
    u32x4 w = {r0[0], r1[0], r0[1], r1[1]}; OUT = *reinterpret_cast<bf16x8*>(&w); } while (0)
    PK4(p0, 0, pa0); PK4(p0, 8, pa1); PK4(p1, 0, pa2); PK4(p1, 8, pa3);
#undef PK4
}

constexpr int AT_K = 0, AT_V = 16384, AT_WS = 32768, AT_XCH = 36864;

__device__ __forceinline__ void win_attn_unit(char* lds, const bf16_t* Z, bf16_t* Y, const float* sink, int b, int kvh, int qc, bool ctxq) {
    const int tid = opaque(threadIdx.x), wid = __builtin_amdgcn_readfirstlane(tid >> 6), lane = tid & 63, r32 = lane & 31, hi = lane >> 5;
    const int head = kvh * 4 + (wid >> 1), qsub = wid & 1;
    const int q0 = qc * 64;
    const size_t qrow0 = (ctxq ? (size_t)RL + b * CTX : (size_t)b * SEQ) + q0 + qsub * 32;
    float* wsf = (float*)(lds + AT_WS) + wid * 128; float* al_l = wsf; float* li_l = wsf + 32;
    bf16x8 qr[4];
    { const bf16_t* qp = Z + (qrow0 + r32) * MIXIN + 512 + head * 64 + hi * 8;
#pragma unroll
      for (int d0 = 0; d0 < 4; ++d0) qr[d0] = *reinterpret_cast<const bf16x8*>(qp + d0 * 16); }
    float m_reg = -1e30f, l_reg = 0.f; f32x16 o[2] = {};
    const int srow = tid >> 3, scol = (tid & 7) * 8;
    const int vb = (int)(uintptr_t)(lds + AT_V) + v_rd_base(lane);
    const int qrel = qsub * 32 + r32;
    const int NT = ctxq ? 4 : 9;
    for (int t = 0; t < NT; ++t) {
        size_t krow; int mode = 0;
        if (t < 4) krow = (size_t)RL + b * CTX + t * 64;
        else { const int p0 = q0 - 128 + (t - 4) * 64; if (p0 < 0 || p0 >= SEQ) continue; krow = (size_t)b * SEQ + p0; mode = (t == 4) ? 1 : (t == 8) ? 2 : 0; }
        __syncthreads();
        { const bf16_t* kp = Z + (krow + srow) * MIXIN + 1024 + kvh * 64 + scol;
          const bf16x8 kv = *reinterpret_cast<const bf16x8*>(kp), vv = *reinterpret_cast<const bf16x8*>(kp + 128);
          *reinterpret_cast<bf16x8*>(lds + AT_K + kswz<64>(srow, scol * 2)) = kv;
          *reinterpret_cast<bf16x8*>(lds + AT_V + v_st<64>(srow, scol)) = vv; }
        __syncthreads();
        f32x16 p0, p1; qkt64<64>(p0, p1, lds + AT_K, qr, 0, r32, hi);
        if (mode == 1) {
#pragma unroll
            for (int r = 0; r < 16; ++r) { const int kk = crow(r, hi); if (kk < qrel) p0[r] = -1e30f; if (kk + 32 < qrel) p1[r] = -1e30f; } }
        else if (mode == 2) {
#pragma unroll
            for (int r = 0; r < 16; ++r) { const int kk = crow(r, hi); if (kk > qrel) p0[r] = -1e30f; if (kk + 32 > qrel) p1[r] = -1e30f; } }
        bf16x8 pa0, pa1, pa2, pa3;
        softmax_step<2>(p0, p1, m_reg, l_reg, o, al_l, r32, hi, pa0, pa1, pa2, pa3);
        pv_one<64, 0>(o[0], vb, pa0, pa1, pa2, pa3); pv_one<64, 1>(o[1], vb, pa0, pa1, pa2, pa3);
    }
    l_reg += __builtin_amdgcn_exp2f(sink[head] * LOG2E - m_reg * QK_C);
    if (hi == 0) li_l[r32] = l_reg; LDS_WAIT();
    bf16_t* yp = Y + qrow0 * DM + 512 + head * 64;
#pragma unroll
    for (int r = 0; r < 16; ++r) { const int orow = crow(r, hi); const float rl = __builtin_amdgcn_rcpf(li_l[orow]);
#pragma unroll
        for (int d0 = 0; d0 < 2; ++d0) { const unsigned w = cvtpk(o[d0][r] * rl, 0.f); yp[(size_t)orow * DM + d0 * 32 + r32] = (bf16_t)(w & 0xffffu); } }
}

constexpr float DA_THR = 8.f;
constexpr float DA_THRL = DA_THR * LOG2E;
template <bool FIRST> __device__ __forceinline__ void da_partialSM(f32x16& p0, f32x16& p1, float& mhat, f32x16& negm, float& alpha) {
    float pmax = fmaxf(p0[0], p0[1]), pmb = fmaxf(p1[0], p1[1]);
#pragma unroll
    for (int r = 2; r < 16; r += 2) { pmax = fmaxf(fmaxf(pmax, p0[r]), p0[r + 1]); pmb = fmaxf(fmaxf(pmb, p1[r]), p1[r + 1]); }
    pmax = fmaxf(pmax, pmb);
    { auto rr = __builtin_amdgcn_permlane32_swap(__float_as_uint(pmax), __float_as_uint(pmax), false, false); pmax = fmaxf(__uint_as_float(rr[0]), __uint_as_float(rr[1])); }
    alpha = 1.f;
    if (FIRST || !__builtin_expect(__all(pmax <= DA_THRL), 1)) {
        const float dl = FIRST ? pmax : fmaxf(pmax, 0.f);
        mhat += dl; alpha = __builtin_amdgcn_exp2f(-dl);
#pragma unroll
        for (int r = 0; r < 16; ++r) { p0[r] -= dl; p1[r] -= dl; negm[r] = -mhat; }
    }
#pragma unroll
    for (int r = 0; r < 16; ++r) p0[r] = __builtin_amdgcn_exp2f(p0[r]);
}
__device__ __forceinline__ void da_finishSM(f32x16& p0, f32x16& p1, float alpha, float& l_reg, bf16x8& pa0, bf16x8& pa1, bf16x8& pa2, bf16x8& pa3) {
#pragma unroll
    for (int r = 0; r < 16; ++r) p1[r] = __builtin_amdgcn_exp2f(p1[r]);
    float s0 = p0[0], s1 = p0[1], s2 = p0[2], s3 = p0[3];
#pragma unroll
    for (int r = 4; r < 16; r += 4) { s0 += p0[r]; s1 += p0[r + 1]; s2 += p0[r + 2]; s3 += p0[r + 3]; }
#pragma unroll
    for (int r = 0; r < 16; r += 4) { s0 += p1[r]; s1 += p1[r + 1]; s2 += p1[r + 2]; s3 += p1[r + 3]; }
    float ps = (s0 + s1) + (s2 + s3);
    { auto rr = __builtin_amdgcn_permlane32_swap(__float_as_uint(ps), __float_as_uint(ps), false, false); ps = __uint_as_float(rr[0]) + __uint_as_float(rr[1]); }
    l_reg = l_reg * alpha + ps;
#define PK4(P, BASE, OUT) do { unsigned a0 = cvtpk(P[BASE + 0], P[BASE + 1]), a1 = cvtpk(P[BASE + 2], P[BASE + 3]);   \
    unsigned b0 = cvtpk(P[BASE + 4], P[BASE + 5]), b1 = cvtpk(P[BASE + 6], P[BASE + 7]);                              \
    auto r0 = __builtin_amdgcn_permlane32_swap(a0, b0, false, false); auto r1 = __builtin_amdgcn_permlane32_swap(a1, b1, false, false); \
    u32x4 w = {r0[0], r1[0], r0[1], r1[1]}; OUT = *reinterpret_cast<bf16x8*>(&w); } while (0)
    PK4(p0, 0, pa0); PK4(p0, 8, pa1); PK4(p1, 0, pa2); PK4(p1, 8, pa3);
#undef PK4
}
__device__ __forceinline__ void da_pv(f32x16* o, int vb, bf16x8 pa0, bf16x8 pa1, bf16x8 pa2, bf16x8 pa3) {
    pv_all<128>(o, vb, pa0, pa1, pa2, pa3);
}
constexpr int DA_V = 0, DA_K = 49152, DA_WS = 81920, DA_XCH = 0;
__device__ __forceinline__ void diff_attn_unit(char* lds, const bf16_t* QKV, const unsigned char* QK8, bf16_t* O, const float* subg, float lam, float oscale, int b, int h, int qb, bool ctxq) {
    const int tid = opaque(threadIdx.x), wid = __builtin_amdgcn_readfirstlane(tid >> 6), lane = tid & 63, r32 = lane & 31, hi = lane >> 5;
    const int comp = wid >> 2, qsub = wid & 3;
    const size_t qrow0 = (ctxq ? (size_t)RL + b * CTX : (size_t)b * SEQ) + qb * 128 + qsub * 32;
    char* V_lds = lds + DA_V; char* K_lds = lds + DA_K;
    float* wsf = (float*)(lds + DA_WS) + wid * 128; float* al_l = wsf; float* li_l = wsf + 32;
    __syncthreads();
    v8i_t qf;
    { const unsigned char* qp = QK8 + (qrow0 + r32) * 2048 + (2 * h + comp) * 64 + hi * 32;
      const u32x4 q0 = *reinterpret_cast<const u32x4*>(qp), q1 = *reinterpret_cast<const u32x4*>(qp + 16);
      qf = (v8i_t){(int)q0.x, (int)q0.y, (int)q0.z, (int)q0.w, (int)q1.x, (int)q1.y, (int)q1.z, (int)q1.w}; }
    float m_reg = 0.f, l_reg = 0.f; f32x16 o[4] = {}; f32x16 negm = {};
    const int sr = tid >> 4, sc = (tid & 15) * 8, vst0 = v_st<128>(sr, sc), vst1 = v_st<128>(32 + sr, sc);
    const int kkey = tid >> 3, kst = kkey * 128 + ((((tid & 7) ^ (kkey & 7))) << 4);
    const unsigned char* kp8 = QK8 + (size_t)kkey * 2048 + 1024 + h * 128 + (tid & 7) * 16;
    const int kg0 = comp * 4 + hi * 2;
    const int vb0 = (int)(uintptr_t)V_lds + v_rd_base(lane);
    const bf16_t* kvp = QKV + (size_t)sr * 3072 + 1024 + h * 128 + sc;
    const size_t rowc = (size_t)RL + b * CTX, rowl = (size_t)b * SEQ;
    const int NT = ctxq ? 4 : 68;
    u32x4 ks; bf16x8 vs0, vs1;
#define KROW(t) ((t) < 4 ? rowc + (size_t)(t) * 64 : rowl + (size_t)((t) - 4) * 64)
#define LOADK(t) do { ks = *reinterpret_cast<const u32x4*>(kp8 + KROW(t) * 2048); } while (0)
#define LOADV(t) do { const bf16_t* p_ = kvp + KROW(t) * 3072 + 1024; vs0 = *reinterpret_cast<const bf16x8*>(p_); vs1 = *reinterpret_cast<const bf16x8*>(p_ + 32 * 3072); } while (0)
#define WRITEK(bf) do { *reinterpret_cast<u32x4*>(K_lds + (bf) * 8192 + kst) = ks; } while (0)
#define WRITEV(bf) do { *reinterpret_cast<bf16x8*>(V_lds + (bf) * 16384 + vst0) = vs0; *reinterpret_cast<bf16x8*>(V_lds + (bf) * 16384 + vst1) = vs1; } while (0)
#define RESC(a) do { if (__any((a) < 1.f)) { if (hi == 0) al_l[r32] = (a); LDS_WAIT(); \
    _Pragma("unroll") for (int d = 0; d < 4; ++d) _Pragma("unroll") for (int r = 0; r < 16; ++r) o[d][r] *= al_l[crow(r, hi)]; } } while (0)
#define QKT(P0, P1, kb) do { SBAR(); qkt64_f8(P0, P1, K_lds + (kb) * 8192, qf, kg0, r32, negm); } while (0)
#define FIN(P0, P1, al) do { da_finishSM(P0, P1, al, l_reg, pa0, pa1, pa2, pa3); SBAR(); } while (0)
#define PVT(vi) da_pv(o, vb0 + (vi) * 16384, pa0, pa1, pa2, pa3)
    f32x16 pA0, pA1, pB0, pB1; float alA = 1.f, alB = 1.f; bf16x8 pa0, pa1, pa2, pa3;
    int vm2 = 1, vm1 = 2, vc = 0;
#define VROT() do { const int t_ = vm2; vm2 = vm1; vm1 = vc; vc = t_; } while (0)
    const bool grpB = comp != 0;
    LOADK(0); VM_WAIT(); WRITEK(0); LOADK(1); LOADV(0); __syncthreads();
    QKT(pA0, pA1, 0);
    if (!grpB) da_partialSM<true>(pA0, pA1, m_reg, negm, alA);
    VM_WAIT(); WRITEK(1); WRITEV(vc); LOADK(2); LOADV(1); VROT();
    __syncthreads();
    if (grpB) da_partialSM<true>(pA0, pA1, m_reg, negm, alA);
    QKT(pB0, pB1, 1); FIN(pA0, pA1, alA);
    if (!grpB) { PVT(vm1); da_partialSM<false>(pB0, pB1, m_reg, negm, alB); RESC(alB); }
    VM_WAIT(); WRITEK(0); WRITEV(vc); LOADK(3); LOADV(2); VROT();
    __syncthreads();
    for (int j = 2; j + 1 < NT; j += 2) {
        if (grpB) { PVT(vm2); da_partialSM<false>(pB0, pB1, m_reg, negm, alB); RESC(alB); }
        QKT(pA0, pA1, 0); FIN(pB0, pB1, alB);
        if (!grpB) { PVT(vm1); da_partialSM<false>(pA0, pA1, m_reg, negm, alA); RESC(alA); }
        VM_WAIT(); WRITEK(1); WRITEV(vc); if (j + 2 < NT) LOADK(j + 2); LOADV(j + 1); VROT();
        __syncthreads();
        if (grpB) { PVT(vm2); da_partialSM<false>(pA0, pA1, m_reg, negm, alA); RESC(alA); }
        QKT(pB0, pB1, 1); FIN(pA0, pA1, alA);
        if (!grpB) { PVT(vm1); da_partialSM<false>(pB0, pB1, m_reg, negm, alB); RESC(alB); }
        VM_WAIT(); if (j + 2 < NT) { WRITEK(0); } WRITEV(vc); if (j + 3 < NT) LOADK(j + 3); if (j + 2 < NT) LOADV(j + 2); VROT();
        __syncthreads();
    }
    if (grpB) { PVT(vm2); da_partialSM<false>(pB0, pB1, m_reg, negm, alB); RESC(alB); }
    FIN(pB0, pB1, alB); PVT(vm1);
#undef LOADK
#undef LOADV
#undef WRITEK
#undef WRITEV
#undef QKT
#undef FIN
#undef PVT
#undef VROT
#define SLOAD(a, b)
#define SWRITE(a, b)
#define SWAIT()
#undef KROW
#undef SLOAD
#undef SWRITE
#undef SWAIT
#undef RESC
    if (hi == 0) li_l[r32] = l_reg; LDS_WAIT();
    float rl[16];
#pragma unroll
    for (int r = 0; r < 16; ++r) rl[r] = __builtin_amdgcn_rcpf(li_l[crow(r, hi)]);
    __syncthreads();
    float* xch = (float*)(lds + DA_XCH) + qsub * (32 * 132);
    if (comp == 1) {
#pragma unroll
        for (int d0 = 0; d0 < 4; ++d0)
#pragma unroll
            for (int r = 0; r < 16; ++r) xch[crow(r, hi) * 132 + d0 * 32 + r32] = o[d0][r] * rl[r];
    }
    __syncthreads();
    if (comp == 0) {
#pragma unroll
        for (int d0 = 0; d0 < 4; ++d0)
#pragma unroll
            for (int r = 0; r < 16; ++r) { const int idx = crow(r, hi) * 132 + d0 * 32 + r32; const float v = o[d0][r] * rl[r] - lam * xch[idx]; xch[idx] = v; }
        LDS_WAIT();
        const int row = lane >> 1, hf = lane & 1; const float* rp = xch + row * 132 + hf * 64;
        f32x4 v[16]; float ss = 0.f;
#pragma unroll
        for (int j = 0; j < 16; ++j) { v[j] = *reinterpret_cast<const f32x4*>(rp + 4 * j); ss += v[j][0] * v[j][0] + v[j][1] * v[j][1] + v[j][2] * v[j][2] + v[j][3] * v[j][3]; }
        ss += __int_as_float(__builtin_amdgcn_ds_bpermute((lane ^ 1) << 2, __float_as_int(ss)));
        const float rs = __builtin_amdgcn_rsqf(ss * (1.f / 128.f) + EPS) * oscale;
        bf16_t* op = O + (qrow0 + row) * DM + h * 128 + hf * 64;
#pragma unroll
        for (int j = 0; j < 16; j += 2) { const f32x4 g0 = *reinterpret_cast<const f32x4*>(subg + hf * 64 + 4 * j), g1 = *reinterpret_cast<const f32x4*>(subg + hf * 64 + 4 * j + 4);
            const f32x4 a = v[j] * g0 * rs, c = v[j + 1] * g1 * rs;
            u32x4 w; w.x = cvtpk(a[0], a[1]); w.y = cvtpk(a[2], a[3]); w.z = cvtpk(c[0], c[1]); w.w = cvtpk(c[2], c[3]);
            *reinterpret_cast<u32x4*>(op + 4 * j) = w; }
    }
}

constexpr int WA_V = 0, WA_K = 16384, WA_WS = 32768, WA_ST = 36864;
__device__ __forceinline__ void wa_mask(f32x16& p0, f32x16& p1, int mode, int qrel, int hi) {
    if (mode == 1) {
#pragma unroll
        for (int r = 0; r < 16; ++r) { const int kk = crow(r, hi); if (kk < qrel) p0[r] = -1e30f; if (kk + 32 < qrel) p1[r] = -1e30f; } }
    else if (mode == 2) {
#pragma unroll
        for (int r = 0; r < 16; ++r) { const int kk = crow(r, hi); if (kk > qrel) p0[r] = -1e30f; if (kk + 32 > qrel) p1[r] = -1e30f; } }
    else if (mode == 3) {
#pragma unroll
        for (int r = 0; r < 16; ++r) { p0[r] = -1e30f; p1[r] = -1e30f; } }
}
__device__ __forceinline__ void win_attn_unit2(char* lds, const bf16_t* Z, bf16_t* Y, const float* sink, int b, int kvh, int qc, bool ctxq) {
    const int tid = opaque(threadIdx.x), wid = __builtin_amdgcn_readfirstlane(tid >> 6), lane = tid & 63, r32 = lane & 31, hi = lane >> 5;
    const int head = kvh * 4 + (wid >> 1), qsub = wid & 1, q0 = qc * 64;
    const size_t rowc = (size_t)RL + b * CTX, rowl = (size_t)b * SEQ;
    const size_t qrow0 = (ctxq ? rowc : rowl) + q0 + qsub * 32;
    char* V_lds = lds + WA_V; char* K_lds = lds + WA_K;
    float* wsf = (float*)(lds + WA_WS) + wid * 128; float* al_l = wsf; float* li_l = wsf + 32;
    __syncthreads();
    bf16x8 qr[4];
    { const bf16_t* qp = Z + (qrow0 + r32) * MIXIN + 512 + head * 64 + hi * 8;
#pragma unroll
      for (int d0 = 0; d0 < 4; ++d0) qr[d0] = *reinterpret_cast<const bf16x8*>(qp + d0 * 16); }
    float m_reg = 0.f, l_reg = 0.f; f32x16 o[2] = {}; f32x16 negm = {};
    const int srow = tid >> 3, scol = (tid & 7) * 8, vst = v_st<64>(srow, scol), kst = kswz<64>(srow, scol * 2);
    const int vb0 = (int)(uintptr_t)V_lds + v_rd_base(lane);
    const bf16_t* kvp = Z + (size_t)srow * MIXIN + 1024 + kvh * 64 + scol;
    const int skip_lo = ctxq ? 0 : (q0 == 0 ? 2 : q0 == 64 ? 1 : 0);
    const int nloc = ctxq ? 0 : 5 - skip_lo - (q0 == SEQ - 64 ? 2 : q0 == SEQ - 128 ? 1 : 0);
    const int NTr = 4 + nloc, NT = (NTr + 1) & ~1;
    const int qrel = qsub * 32 + r32;
    struct { bf16x8 vs, ks; } sr_;
#define KROW(t) ((t) < 4 ? rowc + (size_t)(t) * 64 : (t) < NTr ? rowl + (size_t)(q0 - 128 + ((t) - 4 + skip_lo) * 64) : rowc)
#define TMODE(t) ((t) < 4 ? 0 : (t) >= NTr ? 3 : ((t) - 4 + skip_lo) == 0 ? 1 : ((t) - 4 + skip_lo) == 4 ? 2 : 0)
#define SLOAD(t) do { const bf16_t* p_ = kvp + KROW(t) * MIXIN; sr_.ks = *reinterpret_cast<const bf16x8*>(p_); sr_.vs = *reinterpret_cast<const bf16x8*>(p_ + 128); } while (0)
#define SWRITE(bf) do { *reinterpret_cast<bf16x8*>(V_lds + (bf) * 8192 + vst) = sr_.vs; *reinterpret_cast<bf16x8*>(K_lds + (bf) * 8192 + kst) = sr_.ks; } while (0)
#define SWAIT() asm volatile("s_waitcnt vmcnt(0)" ::: "memory")
#define RESC(a) do { if (__any((a) < 1.f)) { if (hi == 0) al_l[r32] = (a); LDS_WAIT(); \
    _Pragma("unroll") for (int d = 0; d < 2; ++d) _Pragma("unroll") for (int r = 0; r < 16; ++r) o[d][r] *= al_l[crow(r, hi)]; } } while (0)
#define WPV(vb) pv_all<64>(o, (vb), pa0, pa1, pa2, pa3)
    f32x16 pA0, pA1, pB0, pB1; float alA, alB; bf16x8 pa0, pa1, pa2, pa3;
    SLOAD(0); VM_WAIT(); SWRITE(0); __syncthreads();
    qkt64n<64>(pA0, pA1, K_lds, qr, 0, r32, hi, negm); da_partialSM<true>(pA0, pA1, m_reg, negm, alA);
    SLOAD(1);
    SWAIT(); SWRITE(1); __syncthreads();
    for (int j = 1; j + 1 < NT; j += 2) {
        SBAR(); qkt64n<64>(pB0, pB1, K_lds + 8192, qr, 0, r32, hi, negm);
        da_finishSM(pA0, pA1, alA, l_reg, pa0, pa1, pa2, pa3); SBAR();
        SLOAD(j + 1); SBAR();
        WPV(vb0); wa_mask(pB0, pB1, TMODE(j), qrel, hi); da_partialSM<false>(pB0, pB1, m_reg, negm, alB);
        __syncthreads(); SWAIT(); SWRITE(0);
        RESC(alB); __syncthreads();
        SBAR(); qkt64n<64>(pA0, pA1, K_lds, qr, 0, r32, hi, negm);
        da_finishSM(pB0, pB1, alB, l_reg, pa0, pa1, pa2, pa3); SBAR();
        SLOAD(j + 2); SBAR();
        WPV(vb0 + 8192); wa_mask(pA0, pA1, TMODE(j + 1), qrel, hi); da_partialSM<false>(pA0, pA1, m_reg, negm, alA);
        __syncthreads(); SWAIT(); SWRITE(1);
        RESC(alA); __syncthreads();
    }
    SBAR(); qkt64n<64>(pB0, pB1, K_lds + 8192, qr, 0, r32, hi, negm);
    da_finishSM(pA0, pA1, alA, l_reg, pa0, pa1, pa2, pa3); SBAR();
    WPV(vb0); wa_mask(pB0, pB1, TMODE(NT - 1), qrel, hi); da_partialSM<false>(pB0, pB1, m_reg, negm, alB);
    __syncthreads(); RESC(alB);
    da_finishSM(pB0, pB1, alB, l_reg, pa0, pa1, pa2, pa3); SBAR();
    WPV(vb0 + 8192);
#undef KROW
#undef TMODE
#undef SLOAD
#undef SWRITE
#undef SWAIT
#undef RESC
#undef WPV
    l_reg += __builtin_amdgcn_exp2f(sink[head] * LOG2E - m_reg);
    if (hi == 0) li_l[r32] = l_reg; LDS_WAIT();
    bf16_t* stg = (bf16_t*)(lds + WA_ST) + wid * 2048;
#pragma unroll
    for (int r = 0; r < 16; ++r) { const int orow = crow(r, hi); const float rl = __builtin_amdgcn_rcpf(li_l[orow]);
#pragma unroll
        for (int d0 = 0; d0 < 2; ++d0) stg[orow * 64 + d0 * 32 + r32] = (bf16_t)(cvtpk(o[d0][r] * rl, 0.f) & 0xffffu); }
    LDS_WAIT();
    bf16_t* yp = Y + qrow0 * DM + 512 + head * 64;
#pragma unroll
    for (int i = 0; i < 4; ++i) { const int row = i * 8 + (lane >> 3), ch = lane & 7; const u32x4 v = *reinterpret_cast<const u32x4*>(stg + row * 64 + ch * 8); *reinterpret_cast<u32x4*>(yp + (size_t)row * DM + ch * 8) = v; }
}

struct Args {
    const float *x, *c, *ctx, *c_ctx, *ada_w, *ada_b, *norm_g, *mix_in_w, *mix_out_w, *win_sink, *diff_qkv_w, *diff_out_w, *diff_lambda, *diff_subln_g,
                *ffn_in_w, *ffn_out_w, *router_w, *expert_in_w, *expert_out_w;
    float* out; unsigned char* ws; int ph_lo, ph_hi;
};
struct Frame {
    LAS unsigned char* lds; unsigned char* ldsg; volatile LAS unsigned* MISC; unsigned* ctl;
    int tid, lane, wave, vcu, G;
};

__device__ __forceinline__ unsigned f2bf(float f) { unsigned u = __builtin_bit_cast(unsigned, f); return (u + 0x7fffu + ((u >> 16) & 1u)) >> 16; }
__device__ __forceinline__ unsigned pk2(float lo, float hi) { return f2bf(lo) | (f2bf(hi) << 16); }
__device__ __forceinline__ void transpose_item(const float* W, int K, int N, bf16_t* WT, int n0, int c0, int k0, LAS float* scr, int lane) {
#pragma unroll 8
    for (int i = 0; i < 32; ++i) { const int kk = 2 * i + (lane >> 5); scr[kk * 33 + (lane & 31)] = W[(size_t)(k0 + kk) * N + c0 + (lane & 31)]; }
    LDS_WAIT(); asm volatile("" ::: "memory");
    const int c = lane & 7;
#pragma unroll
    for (int j = 0; j < 4; ++j) { const int n = (lane >> 3) + 8 * j; const LAS float* s = scr + (8 * c) * 33 + n;
        u32x4 o; o.x = pk2(s[0 * 33], s[1 * 33]); o.y = pk2(s[2 * 33], s[3 * 33]); o.z = pk2(s[4 * 33], s[5 * 33]); o.w = pk2(s[6 * 33], s[7 * 33]);
        *(u32x4*)(WT + (size_t)(n0 + n) * K + k0 + 8 * c) = o; }
    LDS_WAIT(); asm volatile("" ::: "memory");
}
__device__ __forceinline__ void transpose_item_f8(const float* W, int K, int N, unsigned char* WT, int n0, int c0, int k0, LAS float* scr, int lane) {
#pragma unroll 8
    for (int i = 0; i < 32; ++i) { const int kk = 2 * i + (lane >> 5); scr[kk * 33 + (lane & 31)] = W[(size_t)(k0 + kk) * N + c0 + (lane & 31)] * F8_SW; }
    LDS_WAIT(); asm volatile("" ::: "memory");
    const int c = lane & 7;
#pragma unroll
    for (int j = 0; j < 4; ++j) { const int n = (lane >> 3) + 8 * j; const LAS float* s = scr + (8 * c) * 33 + n;
        u32x2 o; o.x = pk4_fp8(s[0 * 33], s[1 * 33], s[2 * 33], s[3 * 33]); o.y = pk4_fp8(s[4 * 33], s[5 * 33], s[6 * 33], s[7 * 33]);
        *(u32x2*)(WT + (size_t)(n0 + n) * K + k0 + 8 * c) = o; }
    LDS_WAIT(); asm volatile("" ::: "memory");
}
__device__ __forceinline__ bool transpose_job(int& r, const float* W, int nb, int K, int N, void* WT, bool glu, bool f8, LAS float* scr, int lane) {
    const int nblk = N / 32, per = (K / 64) * nblk, tot = nb * per;
    if (r >= tot) { r -= tot; return false; }
    const int mtx = r / per, it = r % per, kb = it / nblk, nbk = it % nblk, n0 = 32 * nbk;
    int c0 = n0;
    if (glu) { const int tile = n0 >> 8, w = n0 & 255; c0 = (w < 128) ? tile * 128 + w : (N >> 1) + tile * 128 + (w - 128); }
    if (f8) transpose_item_f8(W + (size_t)mtx * K * N, K, N, (unsigned char*)WT + (size_t)mtx * K * N, n0, c0, 64 * kb, scr, lane);
    else transpose_item(W + (size_t)mtx * K * N, K, N, (bf16_t*)WT + (size_t)mtx * K * N, n0, c0, 64 * kb, scr, lane);
    return true;
}

struct ThinP {
    int nrows;
    const void* xin_lat; const void* xin_ctx;
    void* xout_lat; void* xout_ctx;
    bool xin16, xout16;
    int ymode;
    const bf16_t* Ysrc; const float* gate; const float* ga;
    bool h8;
    bf16_t* H; const float* gb; const float* shsc;
    const float* router; int* route; unsigned* cnt;
    unsigned char* HSv;
};
#define TH_DECL(PFX) f32x4 PFX##x0 = {}, PFX##x1 = {}, PFX##x2 = {}, PFX##x3 = {}; u32x2 PFX##xh0 = {}, PFX##xh1 = {}, PFX##xh2 = {}, PFX##xh3 = {}; u32x2 PFX##ya0 = {}, PFX##ya1 = {}, PFX##ya2 = {}, PFX##ya3 = {}, PFX##yb0 = {}, PFX##yb1 = {}, PFX##yb2 = {}, PFX##yb3 = {}; float PFX##w0 = 0.f, PFX##w1 = 0.f
#define TH_LOAD(PFX, r_, it_) do { const int rr_ = (r_); \
    if (P.xin16) { const bf16_t* xr_ = (rr_ < RL ? (const bf16_t*)P.xin_lat + (size_t)rr_ * DM : (const bf16_t*)P.xin_ctx + (size_t)(rr_ - RL) * DM) + 4 * lane; \
        PFX##xh0 = __builtin_nontemporal_load(reinterpret_cast<const u32x2*>(xr_)); PFX##xh1 = __builtin_nontemporal_load(reinterpret_cast<const u32x2*>(xr_ + 256)); PFX##xh2 = __builtin_nontemporal_load(reinterpret_cast<const u32x2*>(xr_ + 512)); PFX##xh3 = __builtin_nontemporal_load(reinterpret_cast<const u32x2*>(xr_ + 768)); } \
    else { const float* xr_ = (rr_ < RL ? (const float*)P.xin_lat + (size_t)rr_ * DM : (const float*)P.xin_ctx + (size_t)(rr_ - RL) * DM) + 4 * lane; \
        PFX##x0 = __builtin_nontemporal_load(reinterpret_cast<const f32x4*>(xr_)); PFX##x1 = __builtin_nontemporal_load(reinterpret_cast<const f32x4*>(xr_ + 256)); PFX##x2 = __builtin_nontemporal_load(reinterpret_cast<const f32x4*>(xr_ + 512)); PFX##x3 = __builtin_nontemporal_load(reinterpret_cast<const f32x4*>(xr_ + 768)); } \
    const bf16_t* ya_ = P.Ysrc; const bf16_t* yb_ = P.Ysrc; \
    if (P.ymode == 1) ya_ = P.Ysrc + (size_t)rr_ * DM; \
    else if (P.ymode == 2) { const LAS int* rt_ = rtl + (it_) * 6; \
        const int e0_ = rt_[0], p0_ = rt_[1], e1_ = rt_[2], p1_ = rt_[3]; PFX##w0 = __int_as_float(rt_[4]); PFX##w1 = __int_as_float(rt_[5]); \
        const unsigned b0_ = e0_ == 0 ? 0u : e0_ == 1 ? cb1 : e0_ == 2 ? cb2 : e0_ == 3 ? cb3 : e0_ == 4 ? cb4 : e0_ == 5 ? cb5 : e0_ == 6 ? cb6 : cb7; \
        const unsigned b1_ = e1_ == 0 ? 0u : e1_ == 1 ? cb1 : e1_ == 2 ? cb2 : e1_ == 3 ? cb3 : e1_ == 4 ? cb4 : e1_ == 5 ? cb5 : e1_ == 6 ? cb6 : cb7; \
        ya_ = P.Ysrc + (size_t)(b0_ + p0_) * DM; yb_ = P.Ysrc + (size_t)(b1_ + p1_) * DM; } \
    if (P.ymode) { ya_ += 4 * lane; PFX##ya0 = __builtin_nontemporal_load(reinterpret_cast<const u32x2*>(ya_)); PFX##ya1 = __builtin_nontemporal_load(reinterpret_cast<const u32x2*>(ya_ + 256)); PFX##ya2 = __builtin_nontemporal_load(reinterpret_cast<const u32x2*>(ya_ + 512)); PFX##ya3 = __builtin_nontemporal_load(reinterpret_cast<const u32x2*>(ya_ + 768)); } \
    if (P.ymode == 2) { yb_ += 4 * lane; PFX##yb0 = __builtin_nontemporal_load(reinterpret_cast<const u32x2*>(yb_)); PFX##yb1 = __builtin_nontemporal_load(reinterpret_cast<const u32x2*>(yb_ + 256)); PFX##yb2 = __builtin_nontemporal_load(reinterpret_cast<const u32x2*>(yb_ + 512)); PFX##yb3 = __builtin_nontemporal_load(reinterpret_cast<const u32x2*>(yb_ + 768)); } \
    } while (0)
#define TH_ARGS(PFX) PFX##x0, PFX##x1, PFX##x2, PFX##x3, PFX##xh0, PFX##xh1, PFX##xh2, PFX##xh3, PFX##ya0, PFX##ya1, PFX##ya2, PFX##ya3, PFX##yb0, PFX##yb1, PFX##yb2, PFX##yb3, PFX##w0, PFX##w1
__device__ __forceinline__ void thin_proc(const ThinP& P, f32x4 x0, f32x4 x1, f32x4 x2, f32x4 x3, u32x2 xh0, u32x2 xh1, u32x2 xh2, u32x2 xh3, u32x2 ya0, u32x2 ya1, u32x2 ya2, u32x2 ya3, u32x2 yb0, u32x2 yb1, u32x2 yb2, u32x2 yb3, float yw0, float yw1,
                                          f32x4 GA0, f32x4 GA1, f32x4 GA2, f32x4 GA3, f32x4 GB0, f32x4 GB1, f32x4 GB2, f32x4 GB3, f32x4 SH0, f32x4 SH1, f32x4 SH2, f32x4 SH3,
                                          int r, int li, int lane, LAS float* rwT, LAS int* rec, LAS unsigned* lcnt) {
    const int idx = r < RL ? (r >> 12) : 8;
#define BF4(w) ((f32x4){bf_lo((w).x), bf_hi((w).x), bf_lo((w).y), bf_hi((w).y)})
    f32x4 xv[4] = {x0, x1, x2, x3};
    if (P.xin16) { xv[0] = BF4(xh0); xv[1] = BF4(xh1); xv[2] = BF4(xh2); xv[3] = BF4(xh3); }
    if (P.ymode) {
        f32x4 yv[4];
        if (P.ymode == 1) { yv[0] = BF4(ya0); yv[1] = BF4(ya1); yv[2] = BF4(ya2); yv[3] = BF4(ya3); }
        else { yv[0] = BF4(ya0) * yw0 + BF4(yb0) * yw1; yv[1] = BF4(ya1) * yw0 + BF4(yb1) * yw1; yv[2] = BF4(ya2) * yw0 + BF4(yb2) * yw1; yv[3] = BF4(ya3) * yw0 + BF4(yb3) * yw1; }
#undef BF4
        float ss = 0.f;
#pragma unroll
        for (int j = 0; j < 4; ++j) ss += yv[j][0] * yv[j][0] + yv[j][1] * yv[j][1] + yv[j][2] * yv[j][2] + yv[j][3] * yv[j][3];
        const float rs = __builtin_amdgcn_rsqf(wave_sum(ss, lane) * (1.f / DM) + EPS);
        xv[0] = xv[0] + GA0 * (yv[0] * rs); xv[1] = xv[1] + GA1 * (yv[1] * rs); xv[2] = xv[2] + GA2 * (yv[2] * rs); xv[3] = xv[3] + GA3 * (yv[3] * rs);
    }
    if (P.xout_lat) {
        if (P.xout16) { bf16_t* xo = r < RL ? (bf16_t*)P.xout_lat + (size_t)r * DM : (bf16_t*)P.xout_ctx + (size_t)(r - RL) * DM;
#pragma unroll
            for (int j = 0; j < 4; ++j) { u32x2 w; w.x = cvtpk(xv[j][0], xv[j][1]); w.y = cvtpk(xv[j][2], xv[j][3]); __builtin_nontemporal_store(w, reinterpret_cast<u32x2*>(xo + 4 * lane + 256 * j)); } }
        else { float* xo = r < RL ? (float*)P.xout_lat + (size_t)r * DM : (float*)P.xout_ctx + (size_t)(r - RL) * DM;
#pragma unroll
            for (int j = 0; j < 4; ++j) __builtin_nontemporal_store(xv[j], reinterpret_cast<f32x4*>(xo + 4 * lane + 256 * j)); } }
    if (P.H) {
        float ss = 0.f;
#pragma unroll
        for (int j = 0; j < 4; ++j) ss += xv[j][0] * xv[j][0] + xv[j][1] * xv[j][1] + xv[j][2] * xv[j][2] + xv[j][3] * xv[j][3];
        const float rs = __builtin_amdgcn_rsqf(wave_sum(ss, lane) * (1.f / DM) + EPS);
        bf16_t* hr = P.H + (size_t)r * DM;
        f32x4 hv[4] = {xv[0] * rs * GB0 + SH0, xv[1] * rs * GB1 + SH1, xv[2] * rs * GB2 + SH2, xv[3] * rs * GB3 + SH3};
#pragma unroll
        for (int j = 0; j < 4; ++j) {
            if (P.h8) { *reinterpret_cast<unsigned*>((unsigned char*)P.H + (size_t)r * DM + 4 * lane + 256 * j) = pk4_fp8(hv[j][0] * F8_SH, hv[j][1] * F8_SH, hv[j][2] * F8_SH, hv[j][3] * F8_SH); }
            else { u32x2 w; w.x = cvtpk(hv[j][0], hv[j][1]); w.y = cvtpk(hv[j][2], hv[j][3]); *reinterpret_cast<u32x2*>(hr + 4 * lane + 256 * j) = w; } }
        if (P.router) {
            float lg[8];
#pragma unroll
            for (int e = 0; e < 8; ++e) { float a = 0.f;
#pragma unroll
                for (int j = 0; j < 4; ++j) { const f32x4 w = *reinterpret_cast<const LAS f32x4*>(rwT + e * 1024 + 4 * lane + 256 * j); a += hv[j][0] * w[0] + hv[j][1] * w[1] + hv[j][2] * w[2] + hv[j][3] * w[3]; }
                lg[e] = wave_sum(a, lane); }
            int i0 = 0; float v0 = lg[0];
#pragma unroll
            for (int e = 1; e < 8; ++e) if (lg[e] > v0) { v0 = lg[e]; i0 = e; }
            int i1 = -1; float v1 = -3.4e38f;
#pragma unroll
            for (int e = 0; e < 8; ++e) if (e != i0 && lg[e] > v1) { v1 = lg[e]; i1 = e; }
            const float w0 = 1.f / (1.f + __expf(v1 - v0)), w1 = 1.f - w0;
            if (lane == 0) { const unsigned lp0 = __hip_atomic_fetch_add(lcnt + i0, 1u, __ATOMIC_RELAXED, __HIP_MEMORY_SCOPE_WORKGROUP), lp1 = __hip_atomic_fetch_add(lcnt + i1, 1u, __ATOMIC_RELAXED, __HIP_MEMORY_SCOPE_WORKGROUP);
                LAS int* rc = rec + li * 6; rc[0] = i0; rc[1] = (int)lp0; rc[2] = i1; rc[3] = (int)lp1; rc[4] = __float_as_int(w0); rc[5] = __float_as_int(w1); }
        }
    }
}
__device__ __forceinline__ void thin_phase(Frame& F, const ThinP& P) {
    const int lane = opaque(F.lane);
    const int nlat = P.nrows < RL ? P.nrows : RL, nctx = P.nrows - nlat;
    const int chL = (nlat + F.G - 1) / F.G, chC = (nctx + F.G - 1) / F.G;
    const int r0L = F.vcu * chL, r0C = F.vcu * chC;
    const int nl = r0L >= nlat ? 0 : (r0L + chL <= nlat ? chL : nlat - r0L), nc = r0C >= nctx ? 0 : (r0C + chC <= nctx ? chC : nctx - r0C), nrw = nl + nc;
#define TROW(li_) ((li_) < nl ? r0L + (li_) : RL + r0C + ((li_) - nl))
    LAS float* rwT = (LAS float*)F.lds;
    LAS int* rec = (LAS int*)(F.lds + 32768);
    LAS unsigned* lcnt = (LAS unsigned*)(F.lds + 65536);
    unsigned cb1 = 0, cb2 = 0, cb3 = 0, cb4 = 0, cb5 = 0, cb6 = 0, cb7 = 0;
    if (P.ymode == 2) { unsigned a = 0;
        a += (xb_ld(P.cnt + 0) + 255u) & ~255u; cb1 = a; a += (xb_ld(P.cnt + 1) + 255u) & ~255u; cb2 = a; a += (xb_ld(P.cnt + 2) + 255u) & ~255u; cb3 = a;
        a += (xb_ld(P.cnt + 3) + 255u) & ~255u; cb4 = a; a += (xb_ld(P.cnt + 4) + 255u) & ~255u; cb5 = a; a += (xb_ld(P.cnt + 5) + 255u) & ~255u; cb6 = a;
        a += (xb_ld(P.cnt + 6) + 255u) & ~255u; cb7 = a; }
    if (P.router) {
        for (int i = F.tid; i < 8192; i += 512) { const int col = i >> 3, e = i & 7; rwT[e * 1024 + col] = P.router[i]; }
        if (F.tid < 16) lcnt[F.tid] = 0u;
        __syncthreads();
    }
    LAS int* rtl = (LAS int*)(F.lds + 98304) + F.wave * 6 * 64;
    if (P.ymode == 2) { const int li_ = F.wave + 8 * lane;
        if (li_ < nrw) { const int* rt = P.route + (size_t)TROW(li_) * 8; const u32x4 a = *reinterpret_cast<const u32x4*>(rt); const u32x2 b = *reinterpret_cast<const u32x2*>(rt + 4);
            LAS int* d = rtl + lane * 6; d[0] = (int)a.x; d[1] = (int)a.y; d[2] = (int)a.z; d[3] = (int)a.w; d[4] = (int)b.x; d[5] = (int)b.y; }
        LDS_WAIT(); }
    f32x4 GA0 = {}, GA1 = {}, GA2 = {}, GA3 = {}, GB0 = {}, GB1 = {}, GB2 = {}, GB3 = {}, SH0 = {}, SH1 = {}, SH2 = {}, SH3 = {}; int cur_idx = -1;
#define TH_VEC(r_) do { const int ix_ = (r_) < RL ? ((r_) >> 12) : 8; if (ix_ != cur_idx) { cur_idx = ix_; \
        if (P.ymode) { const float* gt_ = P.gate + (size_t)ix_ * 6144 + 4 * lane; const float* ga_ = P.ga + 4 * lane; \
            GA0 = *reinterpret_cast<const f32x4*>(gt_) * *reinterpret_cast<const f32x4*>(ga_); GA1 = *reinterpret_cast<const f32x4*>(gt_ + 256) * *reinterpret_cast<const f32x4*>(ga_ + 256); \
            GA2 = *reinterpret_cast<const f32x4*>(gt_ + 512) * *reinterpret_cast<const f32x4*>(ga_ + 512); GA3 = *reinterpret_cast<const f32x4*>(gt_ + 768) * *reinterpret_cast<const f32x4*>(ga_ + 768); } \
        if (P.H) { const float* sh_ = P.shsc + (size_t)ix_ * 6144 + 4 * lane; const float* gb_ = P.gb + 4 * lane; \
            GB0 = *reinterpret_cast<const f32x4*>(gb_) * (*reinterpret_cast<const f32x4*>(sh_ + 1024) + 1.f); GB1 = *reinterpret_cast<const f32x4*>(gb_ + 256) * (*reinterpret_cast<const f32x4*>(sh_ + 1280) + 1.f); \
            GB2 = *reinterpret_cast<const f32x4*>(gb_ + 512) * (*reinterpret_cast<const f32x4*>(sh_ + 1536) + 1.f); GB3 = *reinterpret_cast<const f32x4*>(gb_ + 768) * (*reinterpret_cast<const f32x4*>(sh_ + 1792) + 1.f); \
            SH0 = *reinterpret_cast<const f32x4*>(sh_); SH1 = *reinterpret_cast<const f32x4*>(sh_ + 256); SH2 = *reinterpret_cast<const f32x4*>(sh_ + 512); SH3 = *reinterpret_cast<const f32x4*>(sh_ + 768); } } } while (0)
#define TH_VARGS GA0, GA1, GA2, GA3, GB0, GB1, GB2, GB3, SH0, SH1, SH2, SH3
    TH_DECL(A_); TH_DECL(B_);
    int li = F.wave;
    if (li < nrw) TH_LOAD(A_, TROW(li), 0);
    for (int it = 0; li < nrw; li += 16, it += 2) {
        const bool hb = li + 8 < nrw;
        if (hb) TH_LOAD(B_, TROW(li + 8), it + 1);
        TH_VEC(TROW(li)); thin_proc(P, TH_ARGS(A_), TH_VARGS, TROW(li), li, lane, rwT, rec, lcnt);
        if (li + 16 < nrw) TH_LOAD(A_, TROW(li + 16), it + 2);
        if (hb) { TH_VEC(TROW(li + 8)); thin_proc(P, TH_ARGS(B_), TH_VARGS, TROW(li + 8), li + 8, lane, rwT, rec, lcnt); }
    }
    if (P.router) {
        __syncthreads();
        if (F.tid < 8) lcnt[8 + F.tid] = __hip_atomic_fetch_add(P.cnt + F.tid, lcnt[F.tid], __ATOMIC_RELAXED, __HIP_MEMORY_SCOPE_AGENT);
        __syncthreads();
        for (int i = F.tid; i < nrw; i += 512) { const LAS int* rc = rec + i * 6; int* rt = P.route + (size_t)TROW(i) * 8;
            const int e0 = rc[0], e1 = rc[2];
            rt[0] = e0; rt[1] = rc[1] + (int)lcnt[8 + e0]; rt[2] = e1; rt[3] = rc[3] + (int)lcnt[8 + e1]; rt[4] = rc[4]; rt[5] = rc[5]; }
        VM_WAIT();
        for (int lb = F.wave; lb < nrw; lb += 32) {
            u32x4 v[4]; size_t s0[4], s1[4];
#pragma unroll
            for (int q = 0; q < 4; ++q) { const int lq = lb + 8 * q; const int r = TROW(lq); if (lq < nrw) { const LAS int* rc = rec + lq * 6; const int e0 = rc[0], e1 = rc[2];
                s0[q] = (size_t)e0 * RT + (size_t)(rc[1] + (int)lcnt[8 + e0]); s1[q] = (size_t)e1 * RT + (size_t)(rc[3] + (int)lcnt[8 + e1]);
                v[q] = *(reinterpret_cast<const u32x4*>((const unsigned char*)P.H + (size_t)r * DM) + lane); } }
#pragma unroll
            for (int q = 0; q < 4; ++q) { if (lb + 8 * q < nrw) {
                *(reinterpret_cast<u32x4*>(P.HSv + s0[q] * DM) + lane) = v[q]; *(reinterpret_cast<u32x4*>(P.HSv + s1[q] * DM) + lane) = v[q]; } }
        }
        __syncthreads();
    }
#undef TROW
#undef TH_VEC
#undef TH_VARGS
}

constexpr int NPHASE = 2 + DEPTH * 9;
__global__ void __launch_bounds__(512, 2) dit_fwd(Args args) {
    extern __shared__ __attribute__((aligned(16))) unsigned char lds[];
    Frame F;
    F.lds = (LAS unsigned char*)lds; F.ldsg = lds; F.MISC = (volatile LAS unsigned*)(F.lds + MISC_OFF);
    F.tid = threadIdx.x; F.lane = F.tid & 63; F.wave = __builtin_amdgcn_readfirstlane(F.tid >> 6);
    F.G = gridDim.x; { const int bx = blockIdx.x; F.vcu = (F.G % 8 == 0) ? (bx % 8) * (F.G / 8) + bx / 8 : bx; }
    F.ctl = (unsigned*)(args.ws + WS_CTL);
    for (int u = F.tid; u < (LDS_BYTES - RING_BYTES) / 4; u += 512) ((LAS unsigned*)(F.lds + RING_BYTES))[u] = 0u;
    __syncthreads();
    XcdBarrier bar = xcd_barrier_post(F.ctl + CW_BAR, F.MISC + 8);
    const int lo = args.ph_lo, hi = args.ph_hi;
    int ph = 0;
#define IN() (lo <= ph && ph < hi)
    unsigned long long wait_acc = 0, clk_c = 0, clk_r = 0;
#define CLK_BEG(sel) unsigned long long c0_ = 0, r0_ = 0; if (PROBE_CLK == (sel)) { c0_ = __builtin_amdgcn_s_memtime(); r0_ = __builtin_amdgcn_s_memrealtime(); }
#define CLK_END(sel) if (PROBE_CLK == (sel)) { clk_c += __builtin_amdgcn_s_memtime() - c0_; clk_r += __builtin_amdgcn_s_memrealtime() - r0_; }
#define SEAM() do { if (lo <= ph && ph + 1 < hi) { if (WAITPROBE) { const unsigned long long t0_ = __builtin_amdgcn_s_memrealtime(); xcd_barrier(bar); const unsigned long long dt_ = __builtin_amdgcn_s_memrealtime() - t0_; const int k_ = ph < 2 ? 9 + ph : (ph - 2) % 9; if ((WAITSEL >> k_) & 1u) wait_acc += dt_; } else xcd_barrier(bar); } ++ph; } while (0)
    GAS unsigned char* wsg = (GAS unsigned char*)args.ws;
#define WSP ((unsigned char*)wsg)
#define pMOD    ((float*)(WSP + WS_MOD))
#define pROPECS ((f32x2*)(WSP + WS_ROPE))
#define pWP     ((bf16_t*)(WSP + WS_WP))
#define pROUTE  ((int*)(WSP + WS_ROUTE))
#define pCS     ((bf16_t*)(WSP + WS_CS))
#define pCSC    ((bf16_t*)(WSP + WS_CSC))
#define pX      ((bf16_t*)(WSP + WS_X))
#define pH      ((bf16_t*)(WSP + WS_H))
#define pYO     ((bf16_t*)(WSP + WS_YO))
#define pZ      ((bf16_t*)(WSP + WS_Z))
#define pY      ((bf16_t*)(WSP + WS_Y))
#define pPQT    ((bf16_t*)(WSP + WS_PQT))
#define pPQTC   ((bf16_t*)(WSP + WS_PQTC))
#define pOB     ((bf16_t*)(WSP + WS_O))
#define pQK8    ((unsigned char*)(WSP + WS_QK8))
#define pA2     ((bf16_t*)(WSP + WS_A2))
#define pA2M    ((bf16_t*)(WSP + WS_A2M))
#define pHS     ((bf16_t*)(WSP + WS_HS))
    const int vcu0 = F.vcu;
#define REFRAME() do { F.tid = opaque(threadIdx.x); F.lane = F.tid & 63; F.wave = __builtin_amdgcn_readfirstlane(F.tid >> 6); F.G = sopaque((int)gridDim.x); F.vcu = sopaque(vcu0); \
        wsg = gptr(args.ws); F.ctl = (unsigned*)(WSP + WS_CTL); } while (0)
    for (int rep0 = 0; rep0 < REP_P0; ++rep0)
    if (IN() && PH_ON(0)) { REFRAME();
        const int gw = F.vcu * 8 + F.wave, NGW = F.G * 8, gt = F.vcu * 512 + F.tid, NGT = F.G * 512;
        LAS float* ctab = (LAS float*)F.lds;
        LAS float* svec = (LAS float*)(F.lds + 16384);
        if (F.tid == 0) *(LAS unsigned*)(F.lds + 126976) = 0u;
        for (int i = F.tid; i < 4096; i += 512) ctab[i] = cospif((float)i * (1.f / 2048.f));
        for (int i = F.tid; i < 9 * 1024; i += 512) { const float v = i < 8192 ? args.c[i] : args.c_ctx[i - 8192]; svec[i] = v / (1.f + __expf(-v)); }
        __syncthreads();
        for (int i = gt; i < 4096 * 512; i += NGT) { const int k = i >> 9, l0 = (i & 511) * 8; float v[8];
#pragma unroll
            for (int e = 0; e < 8; ++e) { const int col = l0 + e; const int ph_ = (k * (col <= 2048 ? col : col - 2048)) & 4095; v[e] = col <= 2048 ? ctab[ph_] : -ctab[(ph_ - 1024) & 4095]; }
            *reinterpret_cast<u32x4*>(pCS + (size_t)k * FP + l0) = (u32x4){pk2(v[0], v[1]), pk2(v[2], v[3]), pk2(v[4], v[5]), pk2(v[6], v[7])}; }
        for (int i = gt; i < 256 * 64; i += NGT) { const int k = i >> 6, l0 = (i & 63) * 8; float v[8];
#pragma unroll
            for (int e = 0; e < 8; ++e) { const int col = l0 + e, l = col & 255; const int ph_ = (k * l * 16) & 4095; v[e] = col < 256 ? ctab[ph_] : -ctab[(ph_ - 1024) & 4095]; }
            *reinterpret_cast<u32x4*>(pCSC + (size_t)k * FP + l0) = (u32x4){pk2(v[0], v[1]), pk2(v[2], v[3]), pk2(v[4], v[5]), pk2(v[6], v[7])}; }
        for (int i = gt; i < 256 * 128; i += NGT) { const int row = i >> 7, c = i & 127, m = row & 127; const int ph_ = (m * c * 32) & 4095;
            const float v = row < 128 ? ctab[ph_] : ctab[(ph_ - 1024) & 4095]; pWP[i] = (bf16_t)f2bf(v); }
        for (int i = gt; i < 64 * 16; i += NGT) { const int pos = i >> 4, k = i & 15; const float inv = __powf(10000.f, -(float)(2 * k) / 32.f); float s, c; sincosf((float)pos * inv, &s, &c); pROPECS[i] = (f32x2){c, s}; }
        for (int task = F.vcu + F.wave * F.G; task < 512; task += 8 * F.G) { const int layer = task >> 7, col = (task & 127) * 48 + F.lane;
            if (F.lane < 48) {
            const float* w = args.ada_w + (size_t)layer * DM * 6144 + col;
            float a0 = 0, a1 = 0, a2 = 0, a3 = 0, a4 = 0, a5 = 0, a6 = 0, a7 = 0, a8 = 0;
            for (int k0 = 0; k0 < DM; k0 += 32) { float wv[32];
#pragma unroll
                for (int i = 0; i < 32; ++i) wv[i] = w[(size_t)(k0 + i) * 6144];
#pragma unroll
                for (int i = 0; i < 32; ++i) { const int k = k0 + i;
                    a0 += svec[k] * wv[i]; a1 += svec[1024 + k] * wv[i]; a2 += svec[2048 + k] * wv[i]; a3 += svec[3072 + k] * wv[i]; a4 += svec[4096 + k] * wv[i];
                    a5 += svec[5120 + k] * wv[i]; a6 += svec[6144 + k] * wv[i]; a7 += svec[7168 + k] * wv[i]; a8 += svec[8192 + k] * wv[i]; } }
            const float bb = args.ada_b[layer * 6144 + col]; float* mo = pMOD + (size_t)layer * 9 * 6144 + col;
            mo[0] = a0 + bb; mo[6144] = a1 + bb; mo[2 * 6144] = a2 + bb; mo[3 * 6144] = a3 + bb; mo[4 * 6144] = a4 + bb; mo[5 * 6144] = a5 + bb; mo[6 * 6144] = a6 + bb; mo[7 * 6144] = a7 + bb; mo[8 * 6144] = a8 + bb; } }
        LAS float* scr = (LAS float*)(F.lds + 57344 + F.wave * 8448);
        LAS unsigned* wcnt = (LAS unsigned*)(F.lds + 126976);
        constexpr int NITEMS = 2 * (16 * 40) + 2 * (16 * 32) + 2 * (16 * 96) + 2 * (16 * 32) + 2 * (16 * 176) + 2 * (44 * 32) + 16 * (16 * 224) + 16 * (56 * 32);
        for (;;) {
            const int n = __builtin_amdgcn_readfirstlane((int)__hip_atomic_fetch_add(wcnt, F.lane == 0 ? 1u : 0u, __ATOMIC_RELAXED, __HIP_MEMORY_SCOPE_WORKGROUP));
            const int it = ((n >> 3) * F.G + F.vcu) * 8 + (n & 7);
            if (it >= NITEMS) break;
            int r = it;
            if (transpose_job(r, args.mix_in_w, 2, DM, MIXIN, (bf16_t*)(WSP + WS_WMIXIN), false, false, scr, F.lane)) continue;
            if (transpose_job(r, args.mix_out_w, 2, DM, DM, (bf16_t*)(WSP + WS_WMIXOUT), false, false, scr, F.lane)) continue;
            if (transpose_job(r, args.diff_qkv_w, 2, DM, 3072, (bf16_t*)(WSP + WS_WQKV), false, false, scr, F.lane)) continue;
            if (transpose_job(r, args.diff_out_w, 2, DM, DM, (bf16_t*)(WSP + WS_WDOUT), false, false, scr, F.lane)) continue;
            if (transpose_job(r, args.ffn_in_w, 2, DM, 2 * FFN, (bf16_t*)(WSP + WS_WFFNIN), true, F8_DENSE, scr, F.lane)) continue;
            if (transpose_job(r, args.ffn_out_w, 2, FFN, DM, (bf16_t*)(WSP + WS_WFFNOUT), false, F8_DENSE || F8_DDOWN, scr, F.lane)) continue;
            if (transpose_job(r, args.expert_in_w, 16, DM, 2 * EDIM, (bf16_t*)(WSP + WS_WEXPIN), true, true, scr, F.lane)) continue;
            transpose_job(r, args.expert_out_w, 16, EDIM, DM, (bf16_t*)(WSP + WS_WEXPOUT), false, true, scr, F.lane);
        }
        __syncthreads();
    }
    SEAM();
    if (IN() && PH_ON(1)) { REFRAME();
        ThinP P{}; P.nrows = RT; P.xin_lat = args.x; P.xin_ctx = args.ctx; P.ymode = 0; P.H = pH; P.gb = args.norm_g; P.shsc = pMOD;
        for (int rep = 0; rep < REP_P0B; ++rep) thin_phase(F, P);
        for (int rep = 0; rep < EXTRA_BARS; ++rep) xcd_barrier(bar);
    }
    SEAM();

    for (int layer = 0; layer < DEPTH; ++layer) {
        const int j = layer >> 1; const bool even = !(layer & 1), lastl = layer == DEPTH - 1;
        const float* modl = pMOD + (size_t)layer * 9 * 6144; const float* ng = args.norm_g + (size_t)layer * 4 * DM;
        const int Mrows = lastl ? RL : RT;
        if (IN() && PH_ON(2)) { REFRAME();
            pg8::Dims d{DM, DM}; SchedDense S;
            if (even) { S.init(pH, DM, (bf16_t*)(WSP + WS_WMIXIN) + (size_t)j * MIXIN * DM, DM, RT, MIXIN, DM, F.G, (int)blockIdx.x);
                EpiRope E{pZ, MIXIN, 4, 9, pROPECS, 4, 8, QK_C, nullptr, 0}; for (int rep = 0; rep < REP_PROJ; ++rep) pg8::gemm_phase(F.lds, d, S, E); }
            else { S.init(pH, DM, (bf16_t*)(WSP + WS_WQKV) + (size_t)j * 3072 * DM, DM, RT, 3072, DM, F.G, (int)blockIdx.x);
                EpiRope E{pZ, 3072, 0, 16, pROPECS, 0, 8, QK_C, pQK8, 16}; for (int rep = 0; rep < REP_PROJ; ++rep) pg8::gemm_phase(F.lds, d, S, E); }
        }
        SEAM();
        if (IN() && PH_ON(3)) { REFRAME();
            if (even) {
                if (PH_ON(16)) { pg8::Dims d{128, MIXIN}; SchedF1 S{(const char*)pWP, (const char*)pZ, F.G, F.vcu}; EpiPQt E{pPQT, pPQTC}; for (int rep = 0; rep < REP_FOUR; ++rep) pg8::gemm_phase(F.lds, d, S, E); }
            } else {
                const float* lv = args.diff_lambda + j * 256;
                const int ln = opaque(F.lane); const float s01 = wave_sum(lv[ln] * lv[64 + ln], ln), s23 = wave_sum(lv[128 + ln] * lv[192 + ln], ln);
                const float lam_init = 0.8f - 0.6f * __expf(-0.3f * (float)layer);
                const float lam = __expf(s01) - __expf(s23) + lam_init;
                const float* subg = args.diff_subln_g + j * 128;
                const int nu = lastl ? 2048 : 2048 + 128;
                CLK_BEG(1)
                for (int rep = 0; rep < REP_DIFF; ++rep)
                for (int u = F.vcu; u < (PH_ON(18) ? nu : 0); u += F.G) {
                    if (u < 2048) diff_attn_unit((char*)lds, pZ, pQK8, pOB, subg, lam, 1.f - lam_init, u >> 8, (u >> 5) & 7, u & 31, false);
                    else { const int v = u - 2048; diff_attn_unit((char*)lds, pZ, pQK8, pOB, subg, lam, 1.f - lam_init, v >> 4, (v >> 1) & 7, v & 1, true); }
                }
                __syncthreads();
                CLK_END(1)
            }
        }
        SEAM();
        if (IN() && PH_ON(4)) { REFRAME();
            if (even) { pg8::Dims d{FP, FP}; SchedF2 S{(const char*)pCS, (const char*)pCSC, (const char*)pPQT, (const char*)pPQTC, F.G, F.vcu}; EpiFour2 E{pY}; for (int rep = 0; rep < REP_FOUR; ++rep) pg8::gemm_phase<EpiFour2, SchedF2, false>(F.lds, d, S, E);
                const float* sink = args.win_sink + j * 8;
                for (int rep = 0; rep < REP_WIN; ++rep)
                for (int u = F.vcu; u < (PH_ON(17) ? 1024 + 64 : 0); u += F.G) {
                    if (u < 1024) win_attn_unit2((char*)lds, pZ, pY, sink, u >> 7, (u >> 6) & 1, u & 63, false);
                    else { const int v = u - 1024; win_attn_unit2((char*)lds, pZ, pY, sink, v >> 3, (v >> 2) & 1, v & 3, true); }
                }
                __syncthreads();
            }
        }
        if (even) SEAM(); else ++ph;
        if (IN() && PH_ON(5)) { REFRAME();
            pg8::Dims d{DM, DM}; SchedDense S;
            S.init(even ? pY : pOB, DM, (bf16_t*)(WSP + (even ? WS_WMIXOUT : WS_WDOUT)) + (size_t)j * DM * DM, DM, Mrows, DM, DM, F.G, (int)blockIdx.x);
            CLK_BEG(4)
            EpiStore E{pYO, DM, 1.f}; for (int rep = 0; rep < REP_PROJ; ++rep) pg8::gemm_phase(F.lds, d, S, E);
            CLK_END(4)
        }
        SEAM();
        if (IN() && PH_ON(6)) { REFRAME();
            ThinP P{}; P.nrows = Mrows; P.xin16 = layer != 0; P.xout16 = true;
            if (layer == 0) { P.xin_lat = args.x; P.xin_ctx = args.ctx; } else { P.xin_lat = pX; P.xin_ctx = pX + (size_t)RL * DM; }
            P.xout_lat = pX; P.xout_ctx = pX + (size_t)RL * DM; P.ymode = 1; P.Ysrc = pYO; P.gate = modl + 2048; P.ga = ng + DM;
            P.H = pH; P.h8 = !even || F8_DENSE; P.gb = ng + 2 * DM; P.shsc = modl + 3072;
            if (!even) { P.router = args.router_w + (size_t)j * DM * 8; P.route = pROUTE; P.cnt = F.ctl + CW_CNT + 16 * j; P.HSv = (unsigned char*)pHS; }
            thin_phase(F, P);
        }
        SEAM();
        unsigned c0 = 0, c1 = 0, c2 = 0, c3 = 0, c4 = 0, c5 = 0, c6 = 0, c7 = 0;
        if (!even) { unsigned* cn = F.ctl + CW_CNT + 16 * j; unsigned a = 0;
            c0 = 0; a += (rfl(xb_ld(cn + 0)) + 255u) & ~255u; c1 = a; a += (rfl(xb_ld(cn + 1)) + 255u) & ~255u; c2 = a; a += (rfl(xb_ld(cn + 2)) + 255u) & ~255u; c3 = a;
            a += (rfl(xb_ld(cn + 3)) + 255u) & ~255u; c4 = a; a += (rfl(xb_ld(cn + 4)) + 255u) & ~255u; c5 = a; a += (rfl(xb_ld(cn + 5)) + 255u) & ~255u; c6 = a;
            a += (rfl(xb_ld(cn + 6)) + 255u) & ~255u; c7 = a; a += (rfl(xb_ld(cn + 7)) + 255u) & ~255u; c0 = a; }
        ++ph;
        if (IN() && PH_ON(8)) { REFRAME();
            const bool f8 = !even || F8_DENSE; const int eb = f8 ? 1 : 2;
            pg8::Dims d{DM * eb / 2, DM * eb / 2}; SchedGroup S;
            if (even) { S.A = (const char*)pH; S.B = (const char*)(WSP + WS_WFFNIN) + (size_t)j * 2 * FFN * DM * eb; S.nRT = RT / 256; S.P1 = S.P2 = S.P3 = S.P4 = S.P5 = S.P6 = S.P7 = 1 << 30; S.nN = 2 * FFN / 256; S.gB = 0; S.aE = 0; }
            else { S.aE = (size_t)RT * DM; S.A = (const char*)pHS; S.B = (const char*)(WSP + WS_WEXPIN) + (size_t)j * NEXP * 2 * EDIM * DM; S.nRT = (int)(c0 >> 8);
                S.P1 = (int)(c1 >> 8); S.P2 = (int)(c2 >> 8); S.P3 = (int)(c3 >> 8); S.P4 = (int)(c4 >> 8); S.P5 = (int)(c5 >> 8); S.P6 = (int)(c6 >> 8); S.P7 = (int)(c7 >> 8);
                S.nN = 2 * EDIM / 256; S.gB = (size_t)2 * EDIM * DM; }
            S.nwg = S.nRT * S.nN; S.G = F.G; S.c = (int)blockIdx.x; S.nkt = DM * eb / 128; S.tA = (size_t)256 * DM * eb; S.tB = (size_t)256 * DM * eb;
            CLK_BEG(even ? 2 : 3)
            if (f8) { EpiSwiglu<true> E{(unsigned char*)(even ? pA2 : pA2M), even ? FFN : EDIM, 1.f / (F8_SH * F8_SW)}; for (int rep = 0; rep < REP_MOE; ++rep) pg8::gemm_phase<EpiSwiglu<true>, SchedGroup, true, ALIGN_SWIGLU>(F.lds, d, S, E); }
            else if (F8_DDOWN) { EpiSwiglu<true> E{(unsigned char*)pA2, FFN, 1.f}; for (int rep = 0; rep < REP_MOE; ++rep) pg8::gemm_phase<EpiSwiglu<true>, SchedGroup, false>(F.lds, d, S, E); }
            else { EpiSwiglu<false> E{(unsigned char*)pA2, FFN, 1.f}; for (int rep = 0; rep < REP_MOE; ++rep) pg8::gemm_phase<EpiSwiglu<false>, SchedGroup, false>(F.lds, d, S, E); }
            CLK_END(even ? 2 : 3)
        }
        SEAM();
        if (IN() && PH_ON(9)) { REFRAME();
            const bool f8 = !even || F8_DENSE || F8_DDOWN; const int eb = f8 ? 1 : 2;
            const int Kh = even ? FFN : EDIM; pg8::Dims d{Kh * eb / 2, Kh * eb / 2}; SchedGroup S;
            if (even) { S.A = (const char*)pA2; S.B = (const char*)(WSP + WS_WFFNOUT) + (size_t)j * DM * FFN * eb; S.nRT = RT / 256; S.P1 = S.P2 = S.P3 = S.P4 = S.P5 = S.P6 = S.P7 = 1 << 30; S.gB = 0; }
            else { S.A = (const char*)pA2M; S.B = (const char*)(WSP + WS_WEXPOUT) + (size_t)j * NEXP * DM * EDIM; S.nRT = (int)(c0 >> 8);
                S.P1 = (int)(c1 >> 8); S.P2 = (int)(c2 >> 8); S.P3 = (int)(c3 >> 8); S.P4 = (int)(c4 >> 8); S.P5 = (int)(c5 >> 8); S.P6 = (int)(c6 >> 8); S.P7 = (int)(c7 >> 8);
                S.gB = (size_t)DM * EDIM; }
            S.aE = 0; S.nN = DM / 256; S.nwg = S.nRT * S.nN; S.G = F.G; S.c = (int)blockIdx.x; S.nkt = Kh * eb / 128; S.tA = (size_t)256 * Kh * eb; S.tB = (size_t)256 * Kh * eb;
            if (f8) { EpiStore E{even ? pYO : pHS, DM, 1.f / (F8_SA * F8_SW)}; for (int rep = 0; rep < REP_MOE; ++rep) pg8::gemm_phase<EpiStore, SchedGroup, true>(F.lds, d, S, E); }
            else { EpiStore E{pYO, DM, 1.f}; for (int rep = 0; rep < REP_MOE; ++rep) pg8::gemm_phase<EpiStore, SchedGroup, false>(F.lds, d, S, E); }
        }
        SEAM();
        if (IN() && PH_ON(10)) { REFRAME();
            ThinP P{}; P.nrows = Mrows; P.xin16 = true; P.xout16 = !lastl; P.xin_lat = pX; P.xin_ctx = pX + (size_t)RL * DM;
            if (lastl) P.xout_lat = args.out; else P.xout_lat = pX;
            P.xout_ctx = pX + (size_t)RL * DM; P.ymode = even ? 1 : 2; P.Ysrc = even ? pYO : pHS; P.gate = modl + 5120; P.ga = ng + 3 * DM;
            P.route = pROUTE; P.cnt = F.ctl + CW_CNT + 16 * j;
            if (!lastl) { P.H = pH; P.gb = ng + 4 * DM; P.shsc = modl + 9 * 6144; }
            thin_phase(F, P);
        }
        SEAM();
    }
    if (PROBE_CLK) {
        const unsigned long long dur_ = clk_r ? clk_c * 5000ull / clk_r : 0ull, t0_ = __builtin_amdgcn_s_memrealtime();
        while (__builtin_amdgcn_s_memrealtime() - t0_ < dur_) __builtin_amdgcn_s_sleep(8);
    }
    if (WAITPROBE) {
        unsigned* wsum = F.ctl + 48;
        if (threadIdx.x == 0) __hip_atomic_fetch_add(wsum, (unsigned)wait_acc, __ATOMIC_RELAXED, __HIP_MEMORY_SCOPE_AGENT);
        xcd_barrier(bar);
        const unsigned mean = xb_ld(wsum) / gridDim.x; const unsigned long long t0_ = __builtin_amdgcn_s_memrealtime();
        while (__builtin_amdgcn_s_memrealtime() - t0_ < (unsigned long long)mean * WAITPROBE) __builtin_amdgcn_s_sleep(8);
    }
#undef IN
#undef SEAM
#undef REFRAME
}

#ifndef MK_PER_PHASE
#define MK_PER_PHASE 0
#endif
extern "C" void kernel_launch(void* const* d_in, const int* in_sizes, int n_in, void* d_out, int out_size, void* d_ws, size_t ws_size, hipStream_t stream) {
    static int grid = 0;
    if (grid == 0) {
        if (n_in != 19 || in_sizes[0] != RL * DM || out_size != RL * DM || ws_size < WS_END) {
            fprintf(stderr, "kernel_launch: unexpected shapes / workspace (n_in %d in0 %d out %d ws %zu need %zu)\n", n_in, n_in > 0 ? in_sizes[0] : -1, out_size, ws_size, (size_t)WS_END); grid = -1; return; }
        int dev = 0, cus = 0, per_cu = 0;
        if (hipGetDevice(&dev) != hipSuccess || hipDeviceGetAttribute(&cus, hipDeviceAttributeMultiprocessorCount, dev) != hipSuccess) { grid = -1; return; }
        if (hipFuncSetAttribute((const void*)dit_fwd, hipFuncAttributeMaxDynamicSharedMemorySize, LDS_BYTES) != hipSuccess) { fprintf(stderr, "kernel_launch: hipFuncSetAttribute failed\n"); grid = -1; return; }
        if (hipOccupancyMaxActiveBlocksPerMultiprocessor(&per_cu, (const void*)dit_fwd, 512, LDS_BYTES) != hipSuccess || per_cu < 1)
            fprintf(stderr, "kernel_launch: occupancy query reports %d\n", per_cu);
        (void)hipGetLastError();
        grid = cus;
    }
    if (grid < 0) return;
    if (hipMemsetAsync((char*)d_ws + WS_CTL, 0, CTL_BYTES, stream) != hipSuccess) return;
    Args a{};
    const float** ap = (const float**)&a;
    for (int i = 0; i < 19; ++i) ap[i] = (const float*)d_in[i];
    a.out = (float*)d_out; a.ws = (unsigned char*)d_ws;
#if MK_PER_PHASE
    for (int p = 0; p < NPHASE; ++p) { a.ph_lo = p; a.ph_hi = p + 1; hipLaunchKernelGGL(dit_fwd, dim3(grid), dim3(512), LDS_BYTES, stream, a); }
#else
    a.ph_lo = 0; a.ph_hi = NPHASE;
    hipLaunchKernelGGL(dit_fwd, dim3(grid), dim3(512), LDS_BYTES, stream, a);
#endif
}
```

```cpp
#include <hip/hip_runtime.h>
#include <cstdio>
#include <cstdint>

#ifndef PHMASK
#define PHMASK 0xFFFFFFFFu
#endif
#define PH_ON(i) ((PHMASK >> (i)) & 1u)
#ifndef REP_DIFF
#define REP_DIFF 1
#endif
#ifndef REP_MOE
#define REP_MOE 1
#endif
#ifndef REP_P0
#define REP_P0 1
#endif
#ifndef REP_P0B
#define REP_P0B 1
#endif
#ifndef EXTRA_BARS
#define EXTRA_BARS 0
#endif
#ifndef REP_EPI
#define REP_EPI 1
#endif
#ifndef WAITSEL
#define WAITSEL 0xFFFFu
#endif
#ifndef WAITPROBE
#define WAITPROBE 0
#endif
#ifndef KREP
#define KREP 1
#endif
#ifndef REP_PROJ
#define REP_PROJ 1
#endif
#ifndef REP_FOUR
#define REP_FOUR 1
#endif
#ifndef REP_WIN
#define REP_WIN 1
#endif
#ifndef PROBE_CLK
#define PROBE_CLK 0
#endif
#define LAS __attribute__((address_space(3)))
#define GAS __attribute__((address_space(1)))
typedef unsigned short bf16_t;
typedef short bf16x8 __attribute__((ext_vector_type(8)));
typedef short s16x4 __attribute__((ext_vector_type(4)));
typedef float f32x2 __attribute__((ext_vector_type(2)));
typedef float f32x4 __attribute__((ext_vector_type(4)));
typedef float f32x16 __attribute__((ext_vector_type(16)));
typedef unsigned u32x2 __attribute__((ext_vector_type(2)));
typedef unsigned u32x4 __attribute__((ext_vector_type(4)));
typedef __bf16 bf16x2_t __attribute__((ext_vector_type(2)));
typedef int v8i_t __attribute__((ext_vector_type(8)));

constexpr int DM = 1024, NB = 8, SEQ = 4096, CTX = 256, DEPTH = 4;
constexpr int RL = NB * SEQ, RC = NB * CTX, RT = RL + RC;
constexpr int MIXIN = 1280, FFN = 2816, NEXP = 8, EDIM = 3584;
constexpr int MAXSLOT = 71680;
constexpr float EPS = 1e-6f;
constexpr float LOG2E = 1.4426950408889634f;
constexpr float QK_C = 0.125f * LOG2E;

constexpr size_t MiB = 1u << 20;
constexpr size_t WS_CTL = 0, CTL_BYTES = 32 * 1024;
constexpr size_t WS_MOD = 1 * MiB;
constexpr size_t WS_ROPE = WS_MOD + 900 * 1024;
constexpr size_t WS_WP = WS_ROPE + 8 * 1024;
constexpr size_t WS_ROUTE = 2 * MiB;
constexpr size_t WS_CS = 4 * MiB;
constexpr size_t WS_CSC = 68 * MiB;
constexpr size_t WS_WMIXIN = 72 * MiB;
constexpr size_t WS_WMIXOUT = 77 * MiB;
constexpr size_t WS_WQKV = 81 * MiB;
constexpr size_t WS_WDOUT = 93 * MiB;
constexpr size_t WS_WFFNIN = 97 * MiB;
constexpr size_t WS_WFFNOUT = 119 * MiB;
constexpr size_t WS_WEXPIN = 130 * MiB;
constexpr size_t WS_WEXPOUT = 354 * MiB;
constexpr size_t WS_X = 466 * MiB;
constexpr size_t WS_H = 602 * MiB;
constexpr size_t WS_YO = 670 * MiB;
constexpr size_t WS_RA = 738 * MiB;
constexpr size_t WS_Z = WS_RA;
constexpr size_t WS_VT8 = WS_RA;
constexpr size_t WS_Y = WS_RA + 85 * MiB;
constexpr size_t WS_PQT = WS_RA + 153 * MiB;
constexpr size_t WS_O = WS_RA + 204 * MiB;
constexpr size_t WS_RB = 1010 * MiB;
constexpr size_t WS_A2 = WS_RB;
constexpr size_t WS_QK8 = WS_RB;
constexpr size_t WS_PQTC = WS_RB + 190 * MiB;
constexpr size_t WS_A2M = WS_H;
constexpr size_t WS_HS = 1092 * MiB;
constexpr size_t WS_END = 1364 * MiB;
static_assert(WS_A2M + (size_t)MAXSLOT * EDIM * 2 <= WS_HS, "A2m overlay");
static_assert(WS_HS + (size_t)NEXP * RT * DM <= WS_END && WS_HS + (size_t)MAXSLOT * DM * 2 <= WS_END && WS_PQTC + 64 * MiB <= WS_END, "ws end");

constexpr int CW_TMO = 0;
constexpr int CW_CNT = 64;
constexpr int CW_BAR = 4096;

constexpr int RING_BYTES = 131072;
constexpr int MISC_OFF = RING_BYTES + 320;
constexpr int LDS_BYTES = 147456;

__device__ __forceinline__ unsigned cvtpk(float lo, float hi) { f32x2 v = {lo, hi}; bf16x2_t b = __builtin_convertvector(v, bf16x2_t); return __builtin_bit_cast(unsigned, b); }
#ifndef F8_DENSE
#define F8_DENSE false
#endif
#ifndef F8_DDOWN
#define F8_DDOWN true
#endif
#ifndef F8_FOUR
#define F8_FOUR false
#endif
static_assert(!F8_FOUR, "fp8 Fourier path retired");
constexpr int FP = 4096;
constexpr float F8_SCS = 256.f, F8_SPQ = 8.f;
constexpr float F8_SH = 4.f, F8_SW = 64.f, F8_SA = 4.f;
__device__ __forceinline__ float f8clamp(float v) { return __builtin_amdgcn_fmed3f(v, -448.f, 448.f); }
__device__ __forceinline__ unsigned pk4_fp8(float a, float b, float c, float d) {
    unsigned w = 0; w = __builtin_amdgcn_cvt_pk_fp8_f32(f8clamp(a), f8clamp(b), w, false); w = __builtin_amdgcn_cvt_pk_fp8_f32(f8clamp(c), f8clamp(d), w, true); return w; }
__device__ __forceinline__ float bf_lo(unsigned u) { return __uint_as_float(u << 16); }
__device__ __forceinline__ float bf_hi(unsigned u) { return __uint_as_float(u & 0xffff0000u); }
__device__ __forceinline__ float wave_sum(float v, int lane) {
#pragma unroll
    for (int o = 1; o < 64; o <<= 1) v += __int_as_float(__builtin_amdgcn_ds_bpermute((lane ^ o) << 2, __float_as_int(v)));
    return v;
}
__device__ __forceinline__ unsigned rfl(unsigned v) { return (unsigned)__builtin_amdgcn_readfirstlane((int)v); }
__device__ __forceinline__ const char* uptr(const char* p) {
    unsigned lo = (unsigned)__builtin_amdgcn_readfirstlane((int)(unsigned)(uintptr_t)p), hi = (unsigned)__builtin_amdgcn_readfirstlane((int)(unsigned)((uintptr_t)p >> 32));
    asm volatile("" : "+s"(lo), "+s"(hi));
    return (const char*)(((uintptr_t)hi << 32) | lo);
}
__device__ __forceinline__ GAS unsigned char* gptr(const void* p) {
    unsigned lo = (unsigned)__builtin_amdgcn_readfirstlane((int)(unsigned)(uintptr_t)p), hi = (unsigned)__builtin_amdgcn_readfirstlane((int)(unsigned)((uintptr_t)p >> 32));
    asm volatile("" : "+s"(lo), "+s"(hi));
    return (GAS unsigned char*)(((uintptr_t)hi << 32) | lo);
}
__device__ __forceinline__ int sopaque(int v) { v = __builtin_amdgcn_readfirstlane(v); asm volatile("" : "+s"(v)); return v; }
__device__ __forceinline__ int opaque(int v) { asm volatile("" : "+v"(v)); return v; }
#define LDS_WAIT() asm volatile("s_waitcnt lgkmcnt(0)" ::: "memory")
#define VM_WAIT() asm volatile("s_waitcnt vmcnt(0)" ::: "memory")
#define SBAR() __builtin_amdgcn_sched_barrier(0)

namespace pg8 {
constexpr int BM = 256, BK = 64, HALF = 128, HTB = HALF * BK * 2, STAGE_BYTES = 8 * HTB, NXCD = 8, WGM = 8;
__host__ __device__ __forceinline__ int lds_byte(int r, int c) { const int st = (r >> 4) * 2 + (c >> 5), rr = r & 15, cc = c & 31, ob = rr * 64 + cc * 2; return st * 1024 + (ob ^ (((ob >> 9) & 1) << 5)); }
__host__ __device__ __forceinline__ void stage_rc(int b, int& R, int& C) { const int st = b / 1024, sb = b % 1024, swz = sb ^ (((sb >> 9) & 1) << 5); R = (st >> 1) * 16 + swz / 64; C = (st & 1) * 32 + (swz % 64) / 2; }
__host__ __device__ __forceinline__ int perm32(int rho) { const int n = rho >> 4, i = rho & 15; return 8 * (i >> 2) + 4 * n + (i & 3); }

struct Unit { int pm, pn, e, nkt; };
struct Dims { int lda, ldb; };

__device__ __forceinline__ int xcd_remap(int wgid, int nwg) {
    const int q = nwg / NXCD, r = nwg % NXCD, xcd = wgid % NXCD, off = wgid / NXCD;
    return (xcd < r ? xcd * (q + 1) : r * (q + 1) + (xcd - r) * q) + off;
}

#ifndef ALIGN_SWIGLU
#define ALIGN_SWIGLU true
#endif
#ifndef ALIGN_DEFAULT
#define ALIGN_DEFAULT true
#endif
template <class Epi, class Sched, bool F8 = false, bool ALIGN_EPI = ALIGN_DEFAULT>
__device__ __forceinline__ void gemm_phase(LAS unsigned char* lds, const Dims g, const Sched& S, const Epi& E) {
    const int tid = opaque(threadIdx.x), wid = __builtin_amdgcn_readfirstlane(tid >> 6), lane = tid & 63, wr = wid >> 2, wc = wid & 3, fr = lane & 15, fq = lane >> 4;
    unsigned voffA[2], voffB[2];
#pragma unroll
    for (int i = 0; i < 2; ++i) { int R, C; stage_rc(tid * 16 + i * 8192, R, C); const int Rb = Epi::PERM ? ((R & ~31) + perm32(R & 31)) : R;
        voffA[i] = (unsigned)(R * g.lda + C) * 2u; voffB[i] = (unsigned)(Rb * g.ldb + C) * 2u; }
    const size_t kstep = (size_t)(BK * 2);
    const size_t hstepA = (size_t)HALF * g.lda * 2, hstepB = (size_t)HALF * g.ldb * 2;
    const unsigned ldsw = (unsigned)wid * 1024u;
    const int aoff = lds_byte(wr * 64 + fr, fq * 8), boff = lds_byte(wc * 32 + fr, fq * 8);
#define PG8_SA(b, h) (((b) * 2 + (h)) * HTB)
#define PG8_SB(b, h) ((4 + (b) * 2 + (h)) * HTB)
#define PG8_STAGE(bufoff, gbase, voff) do { _Pragma("unroll") for (int _i = 0; _i < 2; ++_i) \
        __builtin_amdgcn_global_load_lds((const unsigned*)((const char*)(gbase) + (voff)[_i]), (LAS unsigned*)(lds + (bufoff) + ldsw + _i * 8192), 16, 0, 0); } while (0)
#define PG8_LDA(dst, b, h) do { _Pragma("unroll") for (int m = 0; m < 4; ++m) _Pragma("unroll") for (int k = 0; k < 2; ++k) dst[m][k] = *(const LAS bf16x8*)(lds + PG8_SA(b, h) + aoff + m * 2048 + k * 1024); } while (0)
#define PG8_LDB(dst, b, h) do { _Pragma("unroll") for (int n = 0; n < 2; ++n) _Pragma("unroll") for (int k = 0; k < 2; ++k) dst[n][k] = *(const LAS bf16x8*)(lds + PG8_SB(b, h) + boff + n * 2048 + k * 1024); } while (0)
#define PG8_V8(x) __builtin_bit_cast(v8i_t, (x))
#define PG8_MMA(ai, bj, At, Bt) do { __builtin_amdgcn_s_setprio(1); _Pragma("unroll") for (int m = 0; m < 4; ++m) _Pragma("unroll") for (int n = 0; n < 2; ++n) { \
        if constexpr (F8) { struct P2 { bf16x8 a, b; }; const v8i_t a8_ = PG8_V8((P2{Bt[n][0], Bt[n][1]})), b8_ = PG8_V8((P2{At[m][0], At[m][1]})); \
            asm volatile("v_mfma_f32_16x16x128_f8f6f4 %0, %1, %2, %0" : "+v"(acc[ai][bj][m][n]) : "v"(a8_), "v"(b8_)); }   \
        else { _Pragma("unroll") for (int k = 0; k < 2; ++k) acc[ai][bj][m][n] = __builtin_amdgcn_mfma_f32_16x16x32_bf16(Bt[n][k], At[m][k], acc[ai][bj][m][n], 0, 0, 0); } } \
        __builtin_amdgcn_s_setprio(0); } while (0)
#define PG8_WAIT_V(n) asm volatile("s_waitcnt vmcnt(" #n ")" ::: "memory")
#define PG8_WAIT_L(n) asm volatile("s_waitcnt lgkmcnt(" #n ")" ::: "memory")
#define PG8_BAR __builtin_amdgcn_s_barrier()
#define PG8_SCHED __builtin_amdgcn_sched_barrier(0)
    Unit cur, nxt; int ui = 0;
    if (!S.next(0, cur)) return;
    constexpr bool MIR = Sched::MIRROR;
    unsigned vB2c[2] = {0u, 0u}, vB2n[2] = {0u, 0u}; const char* cB2 = nullptr; const char* nB2 = nullptr;
#define PG8_MKV2(dst, un) do { const int t2_ = opaque(threadIdx.x); _Pragma("unroll") for (int i_ = 0; i_ < 2; ++i_) { int R_, C_; stage_rc(t2_ * 16 + i_ * 8192, R_, C_); \
        const int Rb_ = Epi::PERM ? ((R_ & ~31) + perm32(R_ & 31)) : R_; dst[i_] = S.voff2(un, Rb_, C_, g.ldb); } } while (0)
    if constexpr (MIR) { PG8_MKV2(vB2c, cur); cB2 = uptr(S.bptr2(cur)); }
    f32x4 acc[2][2][4][2];
#pragma unroll
    for (int a = 0; a < 2; ++a)
#pragma unroll
        for (int b = 0; b < 2; ++b)
#pragma unroll
            for (int m = 0; m < 4; ++m)
#pragma unroll
                for (int n = 0; n < 2; ++n) acc[a][b][m][n] = (f32x4){0.f, 0.f, 0.f, 0.f};
    bf16x8 At[4][2], B0[2][2], B1[2][2];
    const char* cA = uptr(S.aptr(cur)); const char* cB = uptr(S.bptr(cur));
    PG8_STAGE(PG8_SB(0, 0), cB, voffB); if constexpr (MIR) PG8_STAGE(PG8_SB(0, 1), cB2, vB2c); else PG8_STAGE(PG8_SB(0, 1), cB + hstepB, voffB); PG8_STAGE(PG8_SA(0, 0), cA, voffA); PG8_STAGE(PG8_SA(0, 1), cA + hstepA, voffA);
    if (wr == 1) PG8_BAR;
    PG8_WAIT_V(2); PG8_BAR;
    PG8_STAGE(PG8_SB(1, 0), cB + kstep, voffB); PG8_STAGE(PG8_SA(1, 0), cA + kstep, voffA); if constexpr (MIR) PG8_STAGE(PG8_SB(1, 1), cB2 + kstep, vB2c); else PG8_STAGE(PG8_SB(1, 1), cB + hstepB + kstep, voffB);
    PG8_WAIT_V(6); PG8_BAR;
    for (;;) {
        const bool has_next = S.next(ui + 1, nxt);
        const char* nA = uptr(has_next ? S.aptr(nxt) : cA); const char* nB = uptr(has_next ? S.bptr(nxt) : cB);
        if constexpr (MIR) { if (has_next) { PG8_MKV2(vB2n, nxt); nB2 = uptr(S.bptr2(nxt)); } else { vB2n[0] = vB2c[0]; vB2n[1] = vB2c[1]; nB2 = cB2; } }
        const int nt = sopaque(cur.nkt);
        for (int t = 0; t < KREP * nt; t += 2) {
            const bool last = (t == KREP * nt - 2);
            const char* a1 = cA + (size_t)(KREP == 1 ? t + 1 : (t + 1) % nt) * kstep;
            const char* a2 = last ? nA : cA + (size_t)(KREP == 1 ? t + 2 : (t + 2) % nt) * kstep; const char* b2 = last ? nB : cB + (size_t)(KREP == 1 ? t + 2 : (t + 2) % nt) * kstep;
            const char* a3 = a2 + kstep; const char* b3 = b2 + kstep;
            const char* m2 = nullptr; unsigned vm[2] = {0u, 0u};
            if constexpr (MIR) { m2 = last ? nB2 : cB2 + (size_t)(t + 2) * kstep; vm[0] = last ? vB2n[0] : vB2c[0]; vm[1] = last ? vB2n[1] : vB2c[1]; }
            PG8_LDB(B0, 0, 0); PG8_LDB(B1, 0, 1); PG8_SCHED; PG8_LDA(At, 0, 0); PG8_STAGE(PG8_SA(1, 1), a1 + hstepA, voffA);
            PG8_WAIT_V(8); PG8_WAIT_L(0); PG8_BAR; PG8_MMA(0, 0, At, B0); PG8_MMA(0, 1, At, B1); PG8_BAR; PG8_SCHED;
            PG8_LDA(At, 0, 1); PG8_STAGE(PG8_SB(0, 0), b2, voffB); if constexpr (MIR) PG8_STAGE(PG8_SB(0, 1), m2, vm); else PG8_STAGE(PG8_SB(0, 1), b2 + hstepB, voffB); PG8_STAGE(PG8_SA(0, 0), a2, voffA);
            PG8_WAIT_V(8); PG8_WAIT_L(0); PG8_BAR; PG8_MMA(1, 0, At, B0); PG8_MMA(1, 1, At, B1); PG8_BAR; PG8_SCHED;
            PG8_LDB(B0, 1, 0); PG8_LDB(B1, 1, 1); PG8_SCHED; PG8_LDA(At, 1, 0); PG8_STAGE(PG8_SA(0, 1), a2 + hstepA, voffA);
            PG8_WAIT_V(8); PG8_WAIT_L(0); PG8_BAR; PG8_MMA(0, 0, At, B0); PG8_MMA(0, 1, At, B1); PG8_BAR; PG8_SCHED;
            PG8_LDA(At, 1, 1); PG8_STAGE(PG8_SB(1, 0), b3, voffB); if constexpr (MIR) PG8_STAGE(PG8_SB(1, 1), m2 + kstep, vm); else PG8_STAGE(PG8_SB(1, 1), b3 + hstepB, voffB); PG8_STAGE(PG8_SA(1, 0), a3, voffA);
            PG8_WAIT_V(8); PG8_WAIT_L(0); PG8_BAR; PG8_MMA(1, 0, At, B0); PG8_MMA(1, 1, At, B1); PG8_BAR; PG8_SCHED;
        }
        if constexpr (ALIGN_EPI) { if (wr == 0) PG8_BAR; }
        if constexpr (F8) asm volatile("s_nop 15\n\ts_nop 15" ::: "memory");
        for (int repe = 0; repe < REP_EPI; ++repe) { const int l2 = opaque(threadIdx.x) & 63; E(acc, cur, wr, wc, l2 & 15, l2 >> 4); }
        if (!has_next) break;
#pragma unroll
        for (int a = 0; a < 2; ++a)
#pragma unroll
            for (int b = 0; b < 2; ++b)
#pragma unroll
                for (int m = 0; m < 4; ++m)
#pragma unroll
                    for (int n = 0; n < 2; ++n) acc[a][b][m][n] = (f32x4){0.f, 0.f, 0.f, 0.f};
        cur = nxt; cA = nA; cB = nB; ++ui;
        if constexpr (MIR) { cB2 = nB2; vB2c[0] = vB2n[0]; vB2c[1] = vB2n[1]; }
        if constexpr (ALIGN_EPI) { if (wr == 1) PG8_BAR; }
    }
    PG8_WAIT_V(0);
    if constexpr (!ALIGN_EPI) { if (wr == 0) PG8_BAR; }
    PG8_BAR;
#undef PG8_MKV2
#undef PG8_SA
#undef PG8_SB
#undef PG8_STAGE
#undef PG8_LDA
#undef PG8_LDB
#undef PG8_MMA
#undef PG8_V8
#undef PG8_WAIT_V
#undef PG8_WAIT_L
#undef PG8_BAR
#undef PG8_SCHED
}
}
using pg8::Unit;

struct EpiStore {
    static constexpr bool PERM = true;
    bf16_t* O; int ldc; float scale;
    __device__ __forceinline__ void operator()(const f32x4 (&acc)[2][2][4][2], const Unit& u, int wr, int wc, int fr, int fq) const {
        const int row0 = u.pm * 256 + wr * 64 + fr, col0 = u.pn * 256 + wc * 32 + 8 * fq;
#pragma unroll
        for (int ai = 0; ai < 2; ++ai)
#pragma unroll
            for (int m = 0; m < 4; ++m) { bf16_t* rowp = O + (size_t)(row0 + ai * 128 + m * 16) * ldc + col0;
#pragma unroll
                for (int bj = 0; bj < 2; ++bj) { const f32x4 v0 = acc[ai][bj][m][0] * (scale * (1.f / KREP)), v1 = acc[ai][bj][m][1] * (scale * (1.f / KREP));
                    u32x4 w; w.x = cvtpk(v0[0], v0[1]); w.y = cvtpk(v0[2], v0[3]); w.z = cvtpk(v1[0], v1[1]); w.w = cvtpk(v1[2], v1[3]);
                    *(u32x4*)(rowp + bj * 128) = w; } }
    }
};
template <bool F8OUT> struct EpiSwiglu {
    static constexpr bool PERM = true;
    unsigned char* O; int ldc; float scale;
    __device__ __forceinline__ void operator()(const f32x4 (&acc)[2][2][4][2], const Unit& u, int wr, int wc, int fr, int fq) const {
        const int row0 = u.pm * 256 + wr * 64 + fr, col0 = u.pn * 128 + wc * 32 + 8 * fq;
        const float us = F8OUT ? scale * F8_SA : scale;
        const float k1 = -scale * LOG2E * (1.f / KREP), ik2 = 1.f / (scale * us * (1.f / KREP) * (1.f / KREP));
#pragma unroll
        for (int ai = 0; ai < 2; ++ai)
#pragma unroll
            for (int m = 0; m < 4; ++m) { unsigned char* rowp = O + ((size_t)(row0 + ai * 128 + m * 16) * ldc + col0) * (F8OUT ? 1 : 2);
                float r[8];
#pragma unroll
                for (int n = 0; n < 2; ++n) { const f32x4 g = acc[ai][0][m][n], u = acc[ai][1][m][n]; const f32x4 t = g * k1;
                    f32x4 e; e[0] = __builtin_amdgcn_exp2f(t[0]); e[1] = __builtin_amdgcn_exp2f(t[1]); e[2] = __builtin_amdgcn_exp2f(t[2]); e[3] = __builtin_amdgcn_exp2f(t[3]);
                    const f32x4 d = e * ik2 + ik2;
                    f32x4 q; q[0] = __builtin_amdgcn_rcpf(d[0]); q[1] = __builtin_amdgcn_rcpf(d[1]); q[2] = __builtin_amdgcn_rcpf(d[2]); q[3] = __builtin_amdgcn_rcpf(d[3]);
                    const f32x4 o = (g * u) * q; r[n * 4 + 0] = o[0]; r[n * 4 + 1] = o[1]; r[n * 4 + 2] = o[2]; r[n * 4 + 3] = o[3]; }
                if constexpr (F8OUT) { u32x2 w; w.x = pk4_fp8(r[0], r[1], r[2], r[3]); w.y = pk4_fp8(r[4], r[5], r[6], r[7]); *(u32x2*)rowp = w; }
                else { u32x4 w; w.x = cvtpk(r[0], r[1]); w.y = cvtpk(r[2], r[3]); w.z = cvtpk(r[4], r[5]); w.w = cvtpk(r[6], r[7]); *(u32x4*)rowp = w; } }
    }
};
struct EpiRope {
    static constexpr bool PERM = false;
    bf16_t* O; int ldc; int rlo, rhi; const f32x2* cs;
    int qlo, qhi; float qscale;
    unsigned char* O8; int f8hi;
    __device__ __forceinline__ void operator()(const f32x4 (&acc)[2][2][4][2], const Unit& u, int wr, int wc, int fr, int fq) const {
        const int row0 = u.pm * 256 + wr * 64 + fr, col0 = u.pn * 256 + wc * 32 + 4 * fq;
        const bool lat = u.pm < 128;
#pragma unroll
        for (int ai = 0; ai < 2; ++ai)
#pragma unroll
            for (int m = 0; m < 4; ++m) { const int row = row0 + ai * 128 + m * 16; bf16_t* rowp = O + (size_t)row * ldc + col0;
                const int t = row & 4095, pos = (wc & 1) ? (t & 63) : (t >> 6);
                const f32x2* c4 = cs + pos * 16 + 4 * fq;
                const f32x2 c0 = c4[0], c1 = c4[1], c2 = c4[2], c3 = c4[3];
#pragma unroll
                for (int bj = 0; bj < 2; ++bj) { f32x4 p1 = acc[ai][bj][m][0] * (1.f / KREP), p2 = acc[ai][bj][m][1] * (1.f / KREP);
                    const int blk = u.pn * 2 + bj;
                    if (lat && blk >= rlo && blk < rhi) {
                        const f32x4 cv = {c0.x, c1.x, c2.x, c3.x}, sv = {c0.y, c1.y, c2.y, c3.y};
                        const f32x4 o1 = p1 * cv - p2 * sv, o2 = p2 * cv + p1 * sv; p1 = o1; p2 = o2; }
                    if (blk >= qlo && blk < qhi) { p1 = p1 * qscale; p2 = p2 * qscale; }
                    if (blk < f8hi) { unsigned char* r8 = O8 + (size_t)row * 2048 + col0 + bj * 128;
                        *(unsigned*)r8 = pk4_fp8(p1[0], p1[1], p1[2], p1[3]); *(unsigned*)(r8 + 16) = pk4_fp8(p2[0], p2[1], p2[2], p2[3]); }
                    else { u32x2 w1, w2; w1.x = cvtpk(p1[0], p1[1]); w1.y = cvtpk(p1[2], p1[3]); w2.x = cvtpk(p2[0], p2[1]); w2.y = cvtpk(p2[2], p2[3]);
                        *(u32x2*)(rowp + bj * 128) = w1; *(u32x2*)(rowp + bj * 128 + 16) = w2; } } }
    }
};
struct EpiVt {
    static constexpr bool PERM = true;
    unsigned char* Vt;
    __device__ __forceinline__ void operator()(const f32x4 (&acc)[2][2][4][2], const Unit& u, int wr, int wc, int fr, int fq) const {
        const bool ctx = u.pn >= 128; const int b = ctx ? u.pn - 128 : u.pn >> 4, kt0 = ctx ? 0 : 4 + (u.pn & 15) * 4;
#pragma unroll
        for (int ai = 0; ai < 2; ++ai)
#pragma unroll
            for (int m = 0; m < 4; ++m) { const int d = wr * 64 + m * 16 + fr;
                unsigned char* tb = Vt + ((size_t)(b * 8 + u.pm * 2 + ai) * 68 + kt0) * 8192 + d * 64;
#pragma unroll
                for (int bj = 0; bj < 2; ++bj) { const int c = bj * 128 + wc * 32 + 8 * fq, s0 = c & 63;
                    const f32x4 v0 = acc[ai][bj][m][0] * (1.f / KREP), v1 = acc[ai][bj][m][1] * (1.f / KREP);
                    u32x2 w; w.x = pk4_fp8(v0[0], v0[1], v0[2], v0[3]); w.y = pk4_fp8(v1[0], v1[1], v1[2], v1[3]);
                    *(u32x2*)(tb + (c >> 6) * 8192 + ((((s0 >> 4) ^ (d >> 2)) & 3) << 4) + (s0 & 15)) = w; } }
    }
};
struct EpiPQt {
    static constexpr bool PERM = true;
    bf16_t* Plat; bf16_t* Pctx;
    __device__ __forceinline__ void operator()(const f32x4 (&acc)[2][2][4][2], const Unit& u, int wr, int wc, int fr, int fq) const {
        const bool ctx = u.e >= 32; const int bg = ctx ? u.e - 32 : u.e;
        bf16_t* base = (ctx ? Pctx : Plat) + (size_t)bg * 128 * FP;
        if (ctx) {
            const int col0 = wc * 32 + 8 * fq;
#pragma unroll
            for (int ai = 0; ai < 2; ++ai)
#pragma unroll
                for (int m = 0; m < 4; ++m) { bf16_t* rowp = base + (size_t)(wr * 64 + m * 16 + fr) * FP + ai * CTX + col0;
#pragma unroll
                    for (int bj = 0; bj < 2; ++bj) { const f32x4 v0 = acc[ai][bj][m][0] * (1.f / KREP), v1 = acc[ai][bj][m][1] * (1.f / KREP);
                        u32x4 w; w.x = cvtpk(v0[0], v0[1]); w.y = cvtpk(v0[2], v0[3]); w.z = cvtpk(v1[0], v1[1]); w.w = cvtpk(v1[2], v1[3]); *(u32x4*)(rowp + bj * 128) = w; } }
        } else {
            const int col0 = u.pn * 128 + wc * 32 + 8 * fq;
            const bool sp = u.pn == 0 && wc == 0 && fq == 0;
#pragma unroll
            for (int m = 0; m < 4; ++m) { bf16_t* rowp = base + (size_t)(wr * 64 + m * 16 + fr) * FP + col0;
                f32x4 p0 = (acc[0][0][m][0] + acc[0][1][m][0]) * (1.f / KREP), p1 = (acc[0][0][m][1] + acc[0][1][m][1]) * (1.f / KREP);
                f32x4 q0 = (acc[1][0][m][0] - acc[1][1][m][0]) * (1.f / KREP), q1 = (acc[1][0][m][1] - acc[1][1][m][1]) * (1.f / KREP);
                if (sp) { p0[0] = acc[0][0][m][0][0] * (1.f / KREP); q0[0] = acc[0][1][m][0][0] * (1.f / KREP); }
                u32x4 w; w.x = cvtpk(p0[0], p0[1]); w.y = cvtpk(p0[2], p0[3]); w.z = cvtpk(p1[0], p1[1]); w.w = cvtpk(p1[2], p1[3]); *(u32x4*)rowp = w;
                w.x = cvtpk(q0[0], q0[1]); w.y = cvtpk(q0[2], q0[3]); w.z = cvtpk(q1[0], q1[1]); w.w = cvtpk(q1[2], q1[3]); *(u32x4*)(rowp + 2048) = w; }
        }
    }
};
struct EpiFour2 {
    static constexpr bool PERM = true;
    bf16_t* O;
    __device__ __forceinline__ void operator()(const f32x4 (&acc)[2][2][4][2], const Unit& u, int wr, int wc, int fr, int fq) const {
        EpiStore s{O, DM, (u.pm < 128 ? 0.0013810679320049757f   : 0.005524271728019903f  )};
        s(acc, u, wr, wc, fr, fq);
    }
};

struct SchedDense {
    static constexpr bool MIRROR = false;
    const char* A; const char* B; int nM, nN, nwg, G, c, nkt; size_t tA, tB;
    __device__ __forceinline__ void init(const void* A_, int lda, const void* B_, int ldb, int M, int N, int K, int G_, int c_) {
        A = (const char*)A_; B = (const char*)B_; nM = M / 256; nN = N / 256; nwg = nM * nN; G = G_; c = c_; nkt = K / 64; tA = (size_t)256 * lda * 2; tB = (size_t)256 * ldb * 2; }
    __device__ __forceinline__ bool next(int i, Unit& u) const {
        const long L = (long)i * G + c; if (L >= nwg) return false;
        const int wgid = pg8::xcd_remap((int)L, nwg);
        const int nig = pg8::WGM * nN, gid = wgid / nig, fm = gid * pg8::WGM, gsz = (nM - fm) < pg8::WGM ? (nM - fm) : pg8::WGM;
        u.pm = fm + ((wgid % nig) % gsz); u.pn = (wgid % nig) / gsz; u.e = 0; u.nkt = nkt; return true;
    }
    __device__ __forceinline__ const char* aptr(const Unit& u) const { return A + (size_t)u.pm * tA; }
    __device__ __forceinline__ const char* bptr(const Unit& u) const { return B + (size_t)u.pn * tB; }
};
struct SchedGroup {
    static constexpr bool MIRROR = false;
    const char* A; const char* B; int P1, P2, P3, P4, P5, P6, P7, nRT, nN, nwg, G, c, nkt; size_t tA, tB, gB, aE;
    __device__ __forceinline__ bool next(int i, Unit& u) const {
        const long L = (long)i * G + c; if (L >= nwg) return false;
        const int wgid = pg8::xcd_remap((int)L, nwg);
        const int nig = pg8::WGM * nN, gid = wgid / nig, fm = gid * pg8::WGM, gsz = (nRT - fm) < pg8::WGM ? (nRT - fm) : pg8::WGM;
        const int rt = fm + ((wgid % nig) % gsz);
        u.pm = rt; u.pn = (wgid % nig) / gsz; u.nkt = nkt;
        u.e = (rt >= P1) + (rt >= P2) + (rt >= P3) + (rt >= P4) + (rt >= P5) + (rt >= P6) + (rt >= P7); return true;
    }
    __device__ __forceinline__ const char* aptr(const Unit& u) const {
        if (aE == 0) return A + (size_t)u.pm * tA;
        const int pe = u.e == 0 ? 0 : u.e == 1 ? P1 : u.e == 2 ? P2 : u.e == 3 ? P3 : u.e == 4 ? P4 : u.e == 5 ? P5 : u.e == 6 ? P6 : P7;
        return A + (size_t)u.e * aE + (size_t)(u.pm - pe) * tA; }
    __device__ __forceinline__ const char* bptr(const Unit& u) const { return B + (size_t)u.e * gB + (size_t)u.pn * tB; }
};
struct SchedF1 {
    static constexpr bool MIRROR = true;
    const char* Wp; const char* Z; int G, c;
    __device__ __forceinline__ bool next(int i, Unit& u) const {
        const int L = i * G + c; if (L >= 544) return false;
        u.pm = 0; u.nkt = 2;
        if (L < 512) { u.e = L >> 4; u.pn = L & 15; } else { u.e = 32 + (L - 512); u.pn = 0; }
        return true;
    }
    __device__ __forceinline__ const char* aptr(const Unit&) const { return Wp; }
    __device__ __forceinline__ const char* bptr(const Unit& u) const {
        const bool ctx = u.e >= 32; const int bg = ctx ? u.e - 32 : u.e, b = bg >> 2, gq = bg & 3;
        const size_t row0 = ctx ? (size_t)RL + b * CTX : (size_t)b * SEQ + u.pn * 128;
        return Z + (row0 * MIXIN + gq * 128) * 2; }
    __device__ __forceinline__ const char* bptr2(const Unit& u) const {
        const bool ctx = u.e >= 32; const int bg = ctx ? u.e - 32 : u.e, b = bg >> 2, gq = bg & 3;
        const size_t row0 = ctx ? (size_t)RL + b * CTX + 128 : (size_t)b * SEQ;
        return Z + (row0 * MIXIN + gq * 128) * 2; }
    __device__ __forceinline__ unsigned voff2(const Unit& u, int R, int C, int ldb) const {
        const int tok = u.e >= 32 ? R : (u.pn == 0 && R == 0) ? 2048 : 4096 - 128 * u.pn - R;
        return (unsigned)(tok * ldb + C) * 2u; }
};
struct SchedF2 {
    static constexpr bool MIRROR = false;
    const char* CSl; const char* CSc; const char* Plat; const char* Pctx; int G, vcu;
    static constexpr size_t EB = 2;
    __device__ __forceinline__ bool next(int i, Unit& u) const {
        const int L = i * G + vcu; if (L >= 272) return false;
        if (L < 256) { const int b = L >> 5, mt = (L & 31) >> 1; u.pm = b * 16 + mt; u.pn = L & 1; u.e = b; u.nkt = 64; }
        else { const int b = (L - 256) >> 1; u.pm = 128 + b; u.pn = L & 1; u.e = 8 + b; u.nkt = 8; }
        return true;
    }
    __device__ __forceinline__ const char* aptr(const Unit& u) const { return u.e < 8 ? CSl + (size_t)(u.pm & 15) * 256 * FP * EB : CSc; }
    __device__ __forceinline__ const char* bptr(const Unit& u) const { return (u.e < 8 ? Plat + (size_t)u.e * 512 * FP * EB : Pctx + (size_t)(u.e - 8) * 512 * FP * EB) + (size_t)u.pn * 256 * FP * EB; }
};

#define XB_TMO      128
#define XB_XCNT(j)  (256  + 64 * (j))
#define XB_XSUB(j)  (1280 + 64 * (j))
#define XB_XGEN(j)  (2304 + 64 * (j))
#define XB_TOP      3328
#define XB_TOPGEN   3392
#define XCD_BAR_WORDS 3456
#define XB_SPIN_CAP (1u << 21)
__device__ __forceinline__ unsigned xb_ld(unsigned* p)              { return __hip_atomic_load(p, __ATOMIC_RELAXED, __HIP_MEMORY_SCOPE_AGENT); }
__device__ __forceinline__ unsigned xb_add(unsigned* p, unsigned v) { return __hip_atomic_fetch_add(p, v, __ATOMIC_RELAXED, __HIP_MEMORY_SCOPE_AGENT); }
__device__ __forceinline__ unsigned xb_xcc_id() { return (unsigned)__builtin_amdgcn_s_getreg((3 << 11) | 20) & 0xFu; }
#define XB_SPIN(cond, bar) do { unsigned _sp = 0; while (cond) { __builtin_amdgcn_s_sleep(1); \
    if ((++_sp & 255u) == 0u) { if (xb_ld(&(bar)[XB_TMO])) break; if (_sp > XB_SPIN_CAP) { atomicAdd(&(bar)[XB_TMO], 1u); break; } } } } while (0)
struct XcdBarrier { unsigned* bar; unsigned x; volatile LAS unsigned* st; };
__device__ __forceinline__ XcdBarrier xcd_barrier_post(unsigned* bar, volatile LAS unsigned* st) {
    XcdBarrier b; b.bar = bar; b.x = xb_xcc_id(); b.st = st;
    if (threadIdx.x == 0) (void)xb_add(&bar[XB_XCNT(b.x)], 1u);
    return b;
}
__device__ __forceinline__ void xcd_barrier_complete(unsigned* bar, unsigned x, unsigned& nloc, unsigned& nx) {
    const unsigned G = gridDim.x * gridDim.y * gridDim.z;
    unsigned sum, cnt, mine, sp = 0u;
    for (;;) {
        sum = 0u; cnt = 0u; mine = 0u;
#pragma unroll
        for (unsigned j = 0; j < 16; ++j) { const unsigned c = xb_ld(&bar[XB_XCNT(j)]); sum += c; cnt += (c > 0u) ? 1u : 0u; mine = (j == x) ? c : mine; }
        if (sum == G) break;
        __builtin_amdgcn_s_sleep(1);
        if ((++sp & 255u) == 0u) { if (xb_ld(&bar[XB_TMO])) break; if (sp > XB_SPIN_CAP) { atomicAdd(&bar[XB_TMO], 1u); break; } }
    }
    nloc = mine > 0u ? mine : 1u; nx = cnt > 0u ? cnt : 1u;
}
__device__ __forceinline__ void xcd_barrier(const XcdBarrier& b) {
    asm volatile("s_waitcnt vmcnt(0)" ::: "memory");
    __syncthreads();
    if (threadIdx.x == 0) {
        unsigned* bar = (unsigned*)uptr((const char*)b.bar);
        __builtin_amdgcn_s_waitcnt(0);
        unsigned nloc = b.st[0], nx = b.st[1];
        if (nloc == 0u) { xcd_barrier_complete(bar, b.x, nloc, nx); b.st[0] = nloc; b.st[1] = nx; }
        const unsigned old = xb_add(&bar[XB_XSUB(b.x)], 1u);
        const unsigned gen = old / nloc;
        if (old + 1u == (gen + 1u) * nloc) {
            __builtin_amdgcn_fence(__ATOMIC_RELEASE, "agent");
            asm volatile("s_waitcnt vmcnt(0)" ::: "memory");
            const unsigned og = xb_add(&bar[XB_TOP], 1u);
            const unsigned tg = og / nx;
            if (og + 1u == (tg + 1u) * nx) xb_add(&bar[XB_TOPGEN], 1u);
            else XB_SPIN(xb_ld(&bar[XB_TOPGEN]) == tg, bar);
            __builtin_amdgcn_fence(__ATOMIC_ACQUIRE, "agent");
            xb_add(&bar[XB_XGEN(b.x)], 1u);
            asm volatile("s_waitcnt vmcnt(0)" ::: "memory");
        } else {
            XB_SPIN(xb_ld(&bar[XB_XGEN(b.x)]) == gen, bar);
            __builtin_amdgcn_fence(__ATOMIC_ACQUIRE, "agent");
            asm volatile("s_waitcnt vmcnt(0)" ::: "memory");
        }
    }
    __syncthreads();
}

__device__ __forceinline__ int crow(int r, int hi) { return (r & 3) + 8 * (r >> 2) + 4 * hi; }
template <int KW> __device__ __forceinline__ int kswz(int row, int colB) { return KW == 128 ? row * 256 + (colB ^ ((row & 7) << 4)) : row * 128 + (colB ^ (((row >> 1) & 7) << 4)); }
template <int DV> __device__ __forceinline__ int v_st(int k, int c) { const int kk = (k & ~0xC) | ((k & 4) << 1) | ((k & 8) >> 1); return ((kk >> 3) * (DV / 32) + (c >> 5)) * 512 + ((kk & 7) * 32 + (c & 31)) * 2; }
__device__ __forceinline__ int v_rd_base(int lane) { return ((lane & 3) << 3) | (((lane >> 2) & 3) << 6) | (((lane >> 4) & 1) << 5) | (((lane >> 5) & 1) << 8); }
template <int OFF> __device__ __forceinline__ s16x4 tr_read(int vb) { s16x4 r; asm volatile("ds_read_b64_tr_b16 %0, %1 offset:%2" : "=&v"(r) : "v"(vb), "i"(OFF) : "memory"); return r; }
template <int DV, int D0> __device__ __forceinline__ void pv_one(f32x16& od, int vb, bf16x8 pa0, bf16x8 pa1, bf16x8 pa2, bf16x8 pa3) {
    constexpr int KS = (DV / 32) * 1024, HF = (DV / 32) * 512;
    const s16x4 l0 = tr_read<D0 * 512 + 0 * KS>(vb), h0 = tr_read<D0 * 512 + 0 * KS + HF>(vb), l1 = tr_read<D0 * 512 + 1 * KS>(vb), h1 = tr_read<D0 * 512 + 1 * KS + HF>(vb);
    const s16x4 l2 = tr_read<D0 * 512 + 2 * KS>(vb), h2 = tr_read<D0 * 512 + 2 * KS + HF>(vb), l3 = tr_read<D0 * 512 + 3 * KS>(vb), h3 = tr_read<D0 * 512 + 3 * KS + HF>(vb);
    asm volatile("s_waitcnt lgkmcnt(0)" ::: "memory"); SBAR();
#define PKV(L, H) (bf16x8){L[0], L[1], L[2], L[3], H[0], H[1], H[2], H[3]}
    od = __builtin_amdgcn_mfma_f32_32x32x16_bf16(pa0, PKV(l0, h0), od, 0, 0, 0);
    od = __builtin_amdgcn_mfma_f32_32x32x16_bf16(pa1, PKV(l1, h1), od, 0, 0, 0);
    od = __builtin_amdgcn_mfma_f32_32x32x16_bf16(pa2, PKV(l2, h2), od, 0, 0, 0);
    od = __builtin_amdgcn_mfma_f32_32x32x16_bf16(pa3, PKV(l3, h3), od, 0, 0, 0);
#undef PKV
}
#define PV_RD(D0, L, H) do { L[0] = tr_read<(D0) * 512 + 0 * KS>(vb); H[0] = tr_read<(D0) * 512 + 0 * KS + HF>(vb); L[1] = tr_read<(D0) * 512 + 1 * KS>(vb); H[1] = tr_read<(D0) * 512 + 1 * KS + HF>(vb); \
    L[2] = tr_read<(D0) * 512 + 2 * KS>(vb); H[2] = tr_read<(D0) * 512 + 2 * KS + HF>(vb); L[3] = tr_read<(D0) * 512 + 3 * KS>(vb); H[3] = tr_read<(D0) * 512 + 3 * KS + HF>(vb); } while (0)
#define PV_MM(od, L, H) do { od = __builtin_amdgcn_mfma_f32_32x32x16_bf16(pa0, PKV(L[0], H[0]), od, 0, 0, 0); od = __builtin_amdgcn_mfma_f32_32x32x16_bf16(pa1, PKV(L[1], H[1]), od, 0, 0, 0); \
    od = __builtin_amdgcn_mfma_f32_32x32x16_bf16(pa2, PKV(L[2], H[2]), od, 0, 0, 0); od = __builtin_amdgcn_mfma_f32_32x32x16_bf16(pa3, PKV(L[3], H[3]), od, 0, 0, 0); } while (0)
#define PKV(L, H) (bf16x8){L[0], L[1], L[2], L[3], H[0], H[1], H[2], H[3]}
template <int DV> __device__ __forceinline__ void pv_all(f32x16* o, int vb, bf16x8 pa0, bf16x8 pa1, bf16x8 pa2, bf16x8 pa3) {
    constexpr int KS = (DV / 32) * 1024, HF = (DV / 32) * 512;
    s16x4 la[4], ha[4], lb[4], hb[4];
    PV_RD(0, la, ha);
    PV_RD(1, lb, hb); asm volatile("s_waitcnt lgkmcnt(8)" ::: "memory"); SBAR(); PV_MM(o[0], la, ha);
    if constexpr (DV == 128) {
        PV_RD(2, la, ha); asm volatile("s_waitcnt lgkmcnt(8)" ::: "memory"); SBAR(); PV_MM(o[1], lb, hb);
        PV_RD(3, lb, hb); asm volatile("s_waitcnt lgkmcnt(8)" ::: "memory"); SBAR(); PV_MM(o[2], la, ha);
        asm volatile("s_waitcnt lgkmcnt(0)" ::: "memory"); SBAR(); PV_MM(o[3], lb, hb);
    } else {
        asm volatile("s_waitcnt lgkmcnt(0)" ::: "memory"); SBAR(); PV_MM(o[1], lb, hb);
    }
}
#undef PV_RD
#undef PV_MM
#undef PKV
template <int KW> __device__ __forceinline__ void qkt64(f32x16& p0, f32x16& p1, const char* Ks, const bf16x8* qr, int kcb, int r32, int hi) {
    bf16x8 kb0[4], kb1[4];
#pragma unroll
    for (int d0 = 0; d0 < 4; ++d0) { const int cb = kcb + (d0 * 16 + hi * 8) * 2;
        kb0[d0] = *reinterpret_cast<const bf16x8*>(Ks + kswz<KW>(r32, cb));
        kb1[d0] = *reinterpret_cast<const bf16x8*>(Ks + kswz<KW>(32 + r32, cb)); }
    p0 = f32x16{}; p1 = f32x16{};
#pragma unroll
    for (int d0 = 0; d0 < 4; ++d0) {
        p0 = __builtin_amdgcn_mfma_f32_32x32x16_bf16(kb0[d0], qr[d0], p0, 0, 0, 0);
        p1 = __builtin_amdgcn_mfma_f32_32x32x16_bf16(kb1[d0], qr[d0], p1, 0, 0, 0); }
}
__device__ __forceinline__ void qkt64_f8(f32x16& p0, f32x16& p1, const char* Ks, v8i_t qf, int g0, int r32, const f32x16& cinit) {
    const int sw = r32 & 7; const char* kr = Ks + r32 * 128;
    const u32x4 a0 = *reinterpret_cast<const u32x4*>(kr + ((g0 ^ sw) << 4)), a1 = *reinterpret_cast<const u32x4*>(kr + (((g0 + 1) ^ sw) << 4));
    const u32x4 b0 = *reinterpret_cast<const u32x4*>(kr + 4096 + ((g0 ^ sw) << 4)), b1 = *reinterpret_cast<const u32x4*>(kr + 4096 + (((g0 + 1) ^ sw) << 4));
    const v8i_t A0 = {(int)a0.x, (int)a0.y, (int)a0.z, (int)a0.w, (int)a1.x, (int)a1.y, (int)a1.z, (int)a1.w}, A1 = {(int)b0.x, (int)b0.y, (int)b0.z, (int)b0.w, (int)b1.x, (int)b1.y, (int)b1.z, (int)b1.w};
    p0 = __builtin_amdgcn_mfma_scale_f32_32x32x64_f8f6f4(A0, qf, cinit, 0, 0, 0, 0, 0, 0);
    p1 = __builtin_amdgcn_mfma_scale_f32_32x32x64_f8f6f4(A1, qf, cinit, 0, 0, 0, 0, 0, 0);
}
template <int KW> __device__ __forceinline__ void qkt64n(f32x16& p0, f32x16& p1, const char* Ks, const bf16x8* qr, int kcb, int r32, int hi, const f32x16& cinit) {
#pragma unroll
    for (int d0 = 0; d0 < 4; ++d0) { const int cb = kcb + (d0 * 16 + hi * 8) * 2;
        const bf16x8 b0 = *reinterpret_cast<const bf16x8*>(Ks + kswz<KW>(r32, cb));
        const bf16x8 b1 = *reinterpret_cast<const bf16x8*>(Ks + kswz<KW>(32 + r32, cb));
        if (d0 == 0) { p0 = __builtin_amdgcn_mfma_f32_32x32x16_bf16(b0, qr[0], cinit, 0, 0, 0); p1 = __builtin_amdgcn_mfma_f32_32x32x16_bf16(b1, qr[0], cinit, 0, 0, 0); }
        else { p0 = __builtin_amdgcn_mfma_f32_32x32x16_bf16(b0, qr[d0], p0, 0, 0, 0); p1 = __builtin_amdgcn_mfma_f32_32x32x16_bf16(b1, qr[d0], p1, 0, 0, 0); } }
}
template <int ND> __device__ __forceinline__ void softmax_step(f32x16& p0, f32x16& p1, float& m_reg, float& l_reg, f32x16* o, float* al_l, int r32, int hi,
                                                              bf16x8& pa0, bf16x8& pa1, bf16x8& pa2, bf16x8& pa3) {
    float pmax = p0[0];
#pragma unroll
    for (int r = 1; r < 16; ++r) pmax = fmaxf(pmax, p0[r]);
#pragma unroll
    for (int r = 0; r < 16; ++r) pmax = fmaxf(pmax, p1[r]);
    { auto rr = __builtin_amdgcn_permlane32_swap(__float_as_uint(pmax), __float_as_uint(pmax), false, false); pmax = fmaxf(__uint_as_float(rr[0]), __uint_as_float(rr[1])); }
    const float mn = fmaxf(m_reg, pmax);
    const float alpha = __builtin_amdgcn_exp2f((m_reg - mn) * QK_C); m_reg = mn;
    const float mnC = -mn * QK_C;
#pragma unroll
    for (int r = 0; r < 16; ++r) { p0[r] = __builtin_amdgcn_exp2f(fmaf(p0[r], QK_C, mnC)); p1[r] = __builtin_amdgcn_exp2f(fmaf(p1[r], QK_C, mnC)); }
    float ps = 0.f;
#pragma unroll
    for (int r = 0; r < 16; ++r) ps += p0[r] + p1[r];
    { auto rr = __builtin_amdgcn_permlane32_swap(__float_as_uint(ps), __float_as_uint(ps), false, false); ps = __uint_as_float(rr[0]) + __uint_as_float(rr[1]); }
    l_reg = l_reg * alpha + ps;
    if (__any(alpha < 1.f)) { if (hi == 0) al_l[r32] = alpha; LDS_WAIT();
#pragma unroll
        for (int d = 0; d < ND; ++d)
#pragma unroll
            for (int r = 0; r < 16; ++r) o[d][r] *= al_l[crow(r, hi)];
    }
#define PK4(P, BASE, OUT) do { unsigned a0 = cvtpk(P[BASE + 0], P[BASE + 1]), a1 = cvtpk(P[BASE + 2], P[BASE + 3]);   \
    unsigned b0 = cvtpk(P[BASE + 4], P[BASE + 5]), b1 = cvtpk(P[BASE + 6], P[BASE + 7]);                              \
    auto r0 = __builtin_amdgcn_permlane32_swap(a0, b0, false, false); auto r1 = __builtin_amdgcn_permlane32_swap(a1, b1, false, false); \
    u32x4 w = {r0[0], r1[0], r0[1], r1[1]}; OUT = *reinterpret_cast<bf16x8*>(&w); } while (0)
    PK4(p0, 0, pa0); PK4(p0, 8, pa1); PK4(p1, 0, pa2); PK4(p1, 8, pa3);
#undef PK4
}

constexpr int AT_K = 0, AT_V = 16384, AT_WS = 32768, AT_XCH = 36864;

__device__ __forceinline__ void win_attn_unit(char* lds, const bf16_t* Z, bf16_t* Y, const float* sink, int b, int kvh, int qc, bool ctxq) {
    const int tid = opaque(threadIdx.x), wid = __builtin_amdgcn_readfirstlane(tid >> 6), lane = tid & 63, r32 = lane & 31, hi = lane >> 5;
    const int head = kvh * 4 + (wid >> 1), qsub = wid & 1;
    const int q0 = qc * 64;
    const size_t qrow0 = (ctxq ? (size_t)RL + b * CTX : (size_t)b * SEQ) + q0 + qsub * 32;
    float* wsf = (float*)(lds + AT_WS) + wid * 128; float* al_l = wsf; float* li_l = wsf + 32;
    bf16x8 qr[4];
    { const bf16_t* qp = Z + (qrow0 + r32) * MIXIN + 512 + head * 64 + hi * 8;
#pragma unroll
      for (int d0 = 0; d0 < 4; ++d0) qr[d0] = *reinterpret_cast<const bf16x8*>(qp + d0 * 16); }
    float m_reg = -1e30f, l_reg = 0.f; f32x16 o[2] = {};
    const int srow = tid >> 3, scol = (tid & 7) * 8;
    const int vb = (int)(uintptr_t)(lds + AT_V) + v_rd_base(lane);
    const int qrel = qsub * 32 + r32;
    const int NT = ctxq ? 4 : 9;
    for (int t = 0; t < NT; ++t) {
        size_t krow; int mode = 0;
        if (t < 4) krow = (size_t)RL + b * CTX + t * 64;
        else { const int p0 = q0 - 128 + (t - 4) * 64; if (p0 < 0 || p0 >= SEQ) continue; krow = (size_t)b * SEQ + p0; mode = (t == 4) ? 1 : (t == 8) ? 2 : 0; }
        __syncthreads();
        { const bf16_t* kp = Z + (krow + srow) * MIXIN + 1024 + kvh * 64 + scol;
          const bf16x8 kv = *reinterpret_cast<const bf16x8*>(kp), vv = *reinterpret_cast<const bf16x8*>(kp + 128);
          *reinterpret_cast<bf16x8*>(lds + AT_K + kswz<64>(srow, scol * 2)) = kv;
          *reinterpret_cast<bf16x8*>(lds + AT_V + v_st<64>(srow, scol)) = vv; }
        __syncthreads();
        f32x16 p0, p1; qkt64<64>(p0, p1, lds + AT_K, qr, 0, r32, hi);
        if (mode == 1) {
#pragma unroll
            for (int r = 0; r < 16; ++r) { const int kk = crow(r, hi); if (kk < qrel) p0[r] = -1e30f; if (kk + 32 < qrel) p1[r] = -1e30f; } }
        else if (mode == 2) {
#pragma unroll
            for (int r = 0; r < 16; ++r) { const int kk = crow(r, hi); if (kk > qrel) p0[r] = -1e30f; if (kk + 32 > qrel) p1[r] = -1e30f; } }
        bf16x8 pa0, pa1, pa2, pa3;
        softmax_step<2>(p0, p1, m_reg, l_reg, o, al_l, r32, hi, pa0, pa1, pa2, pa3);
        pv_one<64, 0>(o[0], vb, pa0, pa1, pa2, pa3); pv_one<64, 1>(o[1], vb, pa0, pa1, pa2, pa3);
    }
    l_reg += __builtin_amdgcn_exp2f(sink[head] * LOG2E - m_reg * QK_C);
    if (hi == 0) li_l[r32] = l_reg; LDS_WAIT();
    bf16_t* yp = Y + qrow0 * DM + 512 + head * 64;
#pragma unroll
    for (int r = 0; r < 16; ++r) { const int orow = crow(r, hi); const float rl = __builtin_amdgcn_rcpf(li_l[orow]);
#pragma unroll
        for (int d0 = 0; d0 < 2; ++d0) { const unsigned w = cvtpk(o[d0][r] * rl, 0.f); yp[(size_t)orow * DM + d0 * 32 + r32] = (bf16_t)(w & 0xffffu); } }
}

constexpr float DA_THR = 8.f;
constexpr float DA_THRL = DA_THR * LOG2E;
template <bool FIRST> __device__ __forceinline__ void da_partialSM(f32x16& p0, f32x16& p1, float& mhat, f32x16& negm, float& alpha) {
    float pmax = fmaxf(p0[0], p0[1]), pmb = fmaxf(p1[0], p1[1]);
#pragma unroll
    for (int r = 2; r < 16; r += 2) { pmax = fmaxf(fmaxf(pmax, p0[r]), p0[r + 1]); pmb = fmaxf(fmaxf(pmb, p1[r]), p1[r + 1]); }
    pmax = fmaxf(pmax, pmb);
    { auto rr = __builtin_amdgcn_permlane32_swap(__float_as_uint(pmax), __float_as_uint(pmax), false, false); pmax = fmaxf(__uint_as_float(rr[0]), __uint_as_float(rr[1])); }
    alpha = 1.f;
    if (FIRST || !__builtin_expect(__all(pmax <= DA_THRL), 1)) {
        const float dl = FIRST ? pmax : fmaxf(pmax, 0.f);
        mhat += dl; alpha = __builtin_amdgcn_exp2f(-dl);
#pragma unroll
        for (int r = 0; r < 16; ++r) { p0[r] -= dl; p1[r] -= dl; negm[r] = -mhat; }
    }
#pragma unroll
    for (int r = 0; r < 16; ++r) p0[r] = __builtin_amdgcn_exp2f(p0[r]);
}
__device__ __forceinline__ void da_finishSM(f32x16& p0, f32x16& p1, float alpha, float& l_reg, bf16x8& pa0, bf16x8& pa1, bf16x8& pa2, bf16x8& pa3) {
#pragma unroll
    for (int r = 0; r < 16; ++r) p1[r] = __builtin_amdgcn_exp2f(p1[r]);
    float s0 = p0[0], s1 = p0[1], s2 = p0[2], s3 = p0[3];
#pragma unroll
    for (int r = 4; r < 16; r += 4) { s0 += p0[r]; s1 += p0[r + 1]; s2 += p0[r + 2]; s3 += p0[r + 3]; }
#pragma unroll
    for (int r = 0; r < 16; r += 4) { s0 += p1[r]; s1 += p1[r + 1]; s2 += p1[r + 2]; s3 += p1[r + 3]; }
    float ps = (s0 + s1) + (s2 + s3);
    { auto rr = __builtin_amdgcn_permlane32_swap(__float_as_uint(ps), __float_as_uint(ps), false, false); ps = __uint_as_float(rr[0]) + __uint_as_float(rr[1]); }
    l_reg = l_reg * alpha + ps;
#define PK4(P, BASE, OUT) do { unsigned a0 = cvtpk(P[BASE + 0], P[BASE + 1]), a1 = cvtpk(P[BASE + 2], P[BASE + 3]);   \
    unsigned b0 = cvtpk(P[BASE + 4], P[BASE + 5]), b1 = cvtpk(P[BASE + 6], P[BASE + 7]);                              \
    auto r0 = __builtin_amdgcn_permlane32_swap(a0, b0, false, false); auto r1 = __builtin_amdgcn_permlane32_swap(a1, b1, false, false); \
    u32x4 w = {r0[0], r1[0], r0[1], r1[1]}; OUT = *reinterpret_cast<bf16x8*>(&w); } while (0)
    PK4(p0, 0, pa0); PK4(p0, 8, pa1); PK4(p1, 0, pa2); PK4(p1, 8, pa3);
#undef PK4
}
constexpr float DA8_OFF = 5.f, DA8_THRL = 3.f;
template <bool FIRST> __device__ __forceinline__ void da8_partialSM(f32x16& p0, f32x16& p1, float& mhat, f32x16& negm, float& alpha) {
    float pmax = fmaxf(p0[0], p0[1]), pmb = fmaxf(p1[0], p1[1]);
#pragma unroll
    for (int r = 2; r < 16; r += 2) { pmax = fmaxf(fmaxf(pmax, p0[r]), p0[r + 1]); pmb = fmaxf(fmaxf(pmb, p1[r]), p1[r + 1]); }
    pmax = fmaxf(pmax, pmb);
    { auto rr = __builtin_amdgcn_permlane32_swap(__float_as_uint(pmax), __float_as_uint(pmax), false, false); pmax = fmaxf(__uint_as_float(rr[0]), __uint_as_float(rr[1])); }
    alpha = 1.f;
    if (FIRST || !__builtin_expect(__all(pmax <= DA8_OFF + DA8_THRL), 1)) {
        const float dl = FIRST ? pmax - DA8_OFF : fmaxf(pmax - DA8_OFF, 0.f);
        mhat += dl; alpha = __builtin_amdgcn_exp2f(-dl);
#pragma unroll
        for (int r = 0; r < 16; ++r) { p0[r] -= dl; p1[r] -= dl; negm[r] = DA8_OFF - mhat; }
    }
#pragma unroll
    for (int r = 0; r < 16; ++r) p0[r] = __builtin_amdgcn_exp2f(p0[r]);
}
__device__ __forceinline__ void da8_finishSM(f32x16& p0, f32x16& p1, float alpha, float& l_reg, v8i_t& P8) {
#pragma unroll
    for (int r = 0; r < 16; ++r) p1[r] = __builtin_amdgcn_exp2f(p1[r]);
    float s0 = p0[0], s1 = p0[1], s2 = p0[2], s3 = p0[3];
#pragma unroll
    for (int r = 4; r < 16; r += 4) { s0 += p0[r]; s1 += p0[r + 1]; s2 += p0[r + 2]; s3 += p0[r + 3]; }
#pragma unroll
    for (int r = 0; r < 16; r += 4) { s0 += p1[r]; s1 += p1[r + 1]; s2 += p1[r + 2]; s3 += p1[r + 3]; }
    float ps = (s0 + s1) + (s2 + s3);
    { auto rr = __builtin_amdgcn_permlane32_swap(__float_as_uint(ps), __float_as_uint(ps), false, false); ps = __uint_as_float(rr[0]) + __uint_as_float(rr[1]); }
    l_reg = l_reg * alpha + ps;
#pragma unroll
    for (int w = 0; w < 4; ++w) { int a = __builtin_amdgcn_cvt_pk_fp8_f32(p0[4 * w], p0[4 * w + 1], 0, false); a = __builtin_amdgcn_cvt_pk_fp8_f32(p0[4 * w + 2], p0[4 * w + 3], a, true); P8[w] = a;
        int c = __builtin_amdgcn_cvt_pk_fp8_f32(p1[4 * w], p1[4 * w + 1], 0, false); c = __builtin_amdgcn_cvt_pk_fp8_f32(p1[4 * w + 2], p1[4 * w + 3], c, true); P8[4 + w] = c; }
}
__device__ __forceinline__ void da8_pv(f32x16* o, const char* Vs, int r32, int hi, v8i_t P8) {
    const int sw = (r32 >> 2) & 3; const char* vr = Vs + r32 * 64; const int o0 = ((hi * 2) ^ sw) << 4, o1 = ((hi * 2 + 1) ^ sw) << 4;
    u32x4 x0[4], x1[4];
#pragma unroll
    for (int db = 0; db < 4; ++db) { x0[db] = *reinterpret_cast<const u32x4*>(vr + db * 2048 + o0); x1[db] = *reinterpret_cast<const u32x4*>(vr + db * 2048 + o1); }
#pragma unroll
    for (int db = 0; db < 4; ++db) { const v8i_t B = {(int)x0[db].x, (int)x0[db].y, (int)x0[db].z, (int)x0[db].w, (int)x1[db].x, (int)x1[db].y, (int)x1[db].z, (int)x1[db].w};
        o[db] = __builtin_amdgcn_mfma_scale_f32_32x32x64_f8f6f4(P8, B, o[db], 0, 0, 0, 0, 0, 0); }
}
__device__ __forceinline__ void da_pv(f32x16* o, int vb, bf16x8 pa0, bf16x8 pa1, bf16x8 pa2, bf16x8 pa3) {
    pv_all<128>(o, vb, pa0, pa1, pa2, pa3);
}
constexpr int DA_V = 0, DA_K = 49152, DA_WS = 81920, DA_XCH = 0;
__device__ __forceinline__ void diff_attn_unit(char* lds, const unsigned char* VT8, const unsigned char* QK8, bf16_t* O, const float* subg, float lam, float oscale, int b, int h, int qb, bool ctxq) {
    const int tid = opaque(threadIdx.x), wid = __builtin_amdgcn_readfirstlane(tid >> 6), lane = tid & 63, r32 = lane & 31, hi = lane >> 5;
    const int comp = wid >> 2, qsub = wid & 3;
    const size_t qrow0 = (ctxq ? (size_t)RL + b * CTX : (size_t)b * SEQ) + qb * 128 + qsub * 32;
    char* V_lds = lds + DA_V; char* K_lds = lds + DA_K;
    float* wsf = (float*)(lds + DA_WS) + wid * 128; float* al_l = wsf; float* li_l = wsf + 32;
    __syncthreads();
    v8i_t qf;
    { const unsigned char* qp = QK8 + (qrow0 + r32) * 2048 + (2 * h + comp) * 64 + hi * 32;
      const u32x4 q0 = *reinterpret_cast<const u32x4*>(qp), q1 = *reinterpret_cast<const u32x4*>(qp + 16);
      qf = (v8i_t){(int)q0.x, (int)q0.y, (int)q0.z, (int)q0.w, (int)q1.x, (int)q1.y, (int)q1.z, (int)q1.w}; }
    float m_reg = 0.f, l_reg = 0.f; f32x16 o[4] = {}; f32x16 negm;
#pragma unroll
    for (int r = 0; r < 16; ++r) negm[r] = DA8_OFF;
    const int kkey = tid >> 3, krow = ((kkey >> 4) & 1) * 32 + (kkey & 3) + 8 * ((kkey & 15) >> 2) + 4 * (kkey >> 5), kst = krow * 128 + ((((tid & 7) ^ (krow & 7))) << 4);
    const unsigned char* kp8 = QK8 + (size_t)kkey * 2048 + 1024 + h * 128 + (tid & 7) * 16;
    const int kg0 = comp * 4 + hi * 2;
    const unsigned char* vt8 = VT8 + (size_t)(b * 8 + h) * 68 * 8192 + tid * 16;
    const size_t rowc = (size_t)RL + b * CTX, rowl = (size_t)b * SEQ;
    const int NT = ctxq ? 4 : 68;
    u32x4 ks, vs;
#define KROW(t) ((t) < 4 ? rowc + (size_t)(t) * 64 : rowl + (size_t)((t) - 4) * 64)
#define LOADK(t) do { ks = *reinterpret_cast<const u32x4*>(kp8 + KROW(t) * 2048); } while (0)
#define LOADV(t) do { vs = *reinterpret_cast<const u32x4*>(vt8 + (size_t)(t) * 8192); } while (0)
#define WRITEK(bf) do { *reinterpret_cast<u32x4*>(K_lds + (bf) * 8192 + kst) = ks; } while (0)
#define WRITEV(bf) do { *reinterpret_cast<u32x4*>(V_lds + (bf) * 8192 + tid * 16) = vs; } while (0)
#define RESC(a) do { if (__any((a) < 1.f)) { if (hi == 0) al_l[r32] = (a); LDS_WAIT(); \
    _Pragma("unroll") for (int d = 0; d < 4; ++d) _Pragma("unroll") for (int r = 0; r < 16; ++r) o[d][r] *= al_l[crow(r, hi)]; } } while (0)
#define QKT(P0, P1, kb) do { SBAR(); qkt64_f8(P0, P1, K_lds + (kb) * 8192, qf, kg0, r32, negm); } while (0)
#define FIN(P0, P1, al) do { da8_finishSM(P0, P1, al, l_reg, P8); SBAR(); } while (0)
#define PVT(vi) da8_pv(o, V_lds + (vi) * 8192, r32, hi, P8)
    f32x16 pA0, pA1, pB0, pB1; float alA = 1.f, alB = 1.f; v8i_t P8;
    int vm2 = 1, vm1 = 2, vc = 0;
#define VROT() do { const int t_ = vm2; vm2 = vm1; vm1 = vc; vc = t_; } while (0)
    const bool grpB = comp != 0;
    LOADK(0); VM_WAIT(); WRITEK(0); LOADK(1); LOADV(0); __syncthreads();
    QKT(pA0, pA1, 0);
    if (!grpB) da8_partialSM<true>(pA0, pA1, m_reg, negm, alA);
    VM_WAIT(); WRITEK(1); WRITEV(vc); LOADK(2); LOADV(1); VROT();
    __syncthreads();
    if (grpB) da8_partialSM<true>(pA0, pA1, m_reg, negm, alA);
    QKT(pB0, pB1, 1); FIN(pA0, pA1, alA);
    if (!grpB) { PVT(vm1); da8_partialSM<false>(pB0, pB1, m_reg, negm, alB); RESC(alB); }
    VM_WAIT(); WRITEK(0); WRITEV(vc); LOADK(3); LOADV(2); VROT();
    __syncthreads();
    for (int j = 2; j + 1 < NT; j += 2) {
        if (grpB) { PVT(vm2); da8_partialSM<false>(pB0, pB1, m_reg, negm, alB); RESC(alB); }
        QKT(pA0, pA1, 0); FIN(pB0, pB1, alB);
        if (!grpB) { PVT(vm1); da8_partialSM<false>(pA0, pA1, m_reg, negm, alA); RESC(alA); }
        VM_WAIT(); WRITEK(1); WRITEV(vc); if (j + 2 < NT) LOADK(j + 2); LOADV(j + 1); VROT();
        __syncthreads();
        if (grpB) { PVT(vm2); da8_partialSM<false>(pA0, pA1, m_reg, negm, alA); RESC(alA); }
        QKT(pB0, pB1, 1); FIN(pA0, pA1, alA);
        if (!grpB) { PVT(vm1); da8_partialSM<false>(pB0, pB1, m_reg, negm, alB); RESC(alB); }
        VM_WAIT(); if (j + 2 < NT) { WRITEK(0); } WRITEV(vc); if (j + 3 < NT) LOADK(j + 3); if (j + 2 < NT) LOADV(j + 2); VROT();
        __syncthreads();
    }
    if (grpB) { PVT(vm2); da8_partialSM<false>(pB0, pB1, m_reg, negm, alB); RESC(alB); }
    FIN(pB0, pB1, alB); PVT(vm1);
#undef LOADK
#undef LOADV
#undef WRITEK
#undef WRITEV
#undef QKT
#undef FIN
#undef PVT
#undef VROT
#define SLOAD(a, b)
#define SWRITE(a, b)
#define SWAIT()
#undef KROW
#undef SLOAD
#undef SWRITE
#undef SWAIT
#undef RESC
    if (hi == 0) li_l[r32] = l_reg; LDS_WAIT();
    float rl[16];
#pragma unroll
    for (int r = 0; r < 16; ++r) rl[r] = __builtin_amdgcn_rcpf(li_l[crow(r, hi)]);
    __syncthreads();
    float* xch = (float*)(lds + DA_XCH) + qsub * (32 * 132);
    if (comp == 1) {
#pragma unroll
        for (int d0 = 0; d0 < 4; ++d0)
#pragma unroll
            for (int r = 0; r < 16; ++r) xch[crow(r, hi) * 132 + d0 * 32 + r32] = o[d0][r] * rl[r];
    }
    __syncthreads();
    if (comp == 0) {
#pragma unroll
        for (int d0 = 0; d0 < 4; ++d0)
#pragma unroll
            for (int r = 0; r < 16; ++r) { const int idx = crow(r, hi) * 132 + d0 * 32 + r32; const float v = o[d0][r] * rl[r] - lam * xch[idx]; xch[idx] = v; }
        LDS_WAIT();
        const int row = lane >> 1, hf = lane & 1; const float* rp = xch + row * 132 + hf * 64;
        f32x4 v[16]; float ss = 0.f;
#pragma unroll
        for (int j = 0; j < 16; ++j) { v[j] = *reinterpret_cast<const f32x4*>(rp + 4 * j); ss += v[j][0] * v[j][0] + v[j][1] * v[j][1] + v[j][2] * v[j][2] + v[j][3] * v[j][3]; }
        ss += __int_as_float(__builtin_amdgcn_ds_bpermute((lane ^ 1) << 2, __float_as_int(ss)));
        const float rs = __builtin_amdgcn_rsqf(ss * (1.f / 128.f) + EPS) * oscale;
        bf16_t* op = O + (qrow0 + row) * DM + h * 128 + hf * 64;
#pragma unroll
        for (int j = 0; j < 16; j += 2) { const f32x4 g0 = *reinterpret_cast<const f32x4*>(subg + hf * 64 + 4 * j), g1 = *reinterpret_cast<const f32x4*>(subg + hf * 64 + 4 * j + 4);
            const f32x4 a = v[j] * g0 * rs, c = v[j + 1] * g1 * rs;
            u32x4 w; w.x = cvtpk(a[0], a[1]); w.y = cvtpk(a[2], a[3]); w.z = cvtpk(c[0], c[1]); w.w = cvtpk(c[2], c[3]);
            *reinterpret_cast<u32x4*>(op + 4 * j) = w; }
    }
}

constexpr int WA_V = 0, WA_K = 16384, WA_WS = 32768, WA_ST = 36864;
__device__ __forceinline__ void wa_mask(f32x16& p0, f32x16& p1, int mode, int qrel, int hi) {
    if (mode == 1) {
#pragma unroll
        for (int r = 0; r < 16; ++r) { const int kk = crow(r, hi); if (kk < qrel) p0[r] = -1e30f; if (kk + 32 < qrel) p1[r] = -1e30f; } }
    else if (mode == 2) {
#pragma unroll
        for (int r = 0; r < 16; ++r) { const int kk = crow(r, hi); if (kk > qrel) p0[r] = -1e30f; if (kk + 32 > qrel) p1[r] = -1e30f; } }
    else if (mode == 3) {
#pragma unroll
        for (int r = 0; r < 16; ++r) { p0[r] = -1e30f; p1[r] = -1e30f; } }
}
__device__ __forceinline__ void win_attn_unit2(char* lds, const bf16_t* Z, bf16_t* Y, const float* sink, int b, int kvh, int qc, bool ctxq) {
    const int tid = opaque(threadIdx.x), wid = __builtin_amdgcn_readfirstlane(tid >> 6), lane = tid & 63, r32 = lane & 31, hi = lane >> 5;
    const int head = kvh * 4 + (wid >> 1), qsub = wid & 1, q0 = qc * 64;
    const size_t rowc = (size_t)RL + b * CTX, rowl = (size_t)b * SEQ;
    const size_t qrow0 = (ctxq ? rowc : rowl) + q0 + qsub * 32;
    char* V_lds = lds + WA_V; char* K_lds = lds + WA_K;
    float* wsf = (float*)(lds + WA_WS) + wid * 128; float* al_l = wsf; float* li_l = wsf + 32;
    __syncthreads();
    bf16x8 qr[4];
    { const bf16_t* qp = Z + (qrow0 + r32) * MIXIN + 512 + head * 64 + hi * 8;
#pragma unroll
      for (int d0 = 0; d0 < 4; ++d0) qr[d0] = *reinterpret_cast<const bf16x8*>(qp + d0 * 16); }
    float m_reg = 0.f, l_reg = 0.f; f32x16 o[2] = {}; f32x16 negm = {};
    const int srow = tid >> 3, scol = (tid & 7) * 8, vst = v_st<64>(srow, scol), kst = kswz<64>(srow, scol * 2);
    const int vb0 = (int)(uintptr_t)V_lds + v_rd_base(lane);
    const bf16_t* kvp = Z + (size_t)srow * MIXIN + 1024 + kvh * 64 + scol;
    const int skip_lo = ctxq ? 0 : (q0 == 0 ? 2 : q0 == 64 ? 1 : 0);
    const int nloc = ctxq ? 0 : 5 - skip_lo - (q0 == SEQ - 64 ? 2 : q0 == SEQ - 128 ? 1 : 0);
    const int NTr = 4 + nloc, NT = (NTr + 1) & ~1;
    const int qrel = qsub * 32 + r32;
    struct { bf16x8 vs, ks; } sr_;
#define KROW(t) ((t) < 4 ? rowc + (size_t)(t) * 64 : (t) < NTr ? rowl + (size_t)(q0 - 128 + ((t) - 4 + skip_lo) * 64) : rowc)
#define TMODE(t) ((t) < 4 ? 0 : (t) >= NTr ? 3 : ((t) - 4 + skip_lo) == 0 ? 1 : ((t) - 4 + skip_lo) == 4 ? 2 : 0)
#define SLOAD(t) do { const bf16_t* p_ = kvp + KROW(t) * MIXIN; sr_.ks = *reinterpret_cast<const bf16x8*>(p_); sr_.vs = *reinterpret_cast<const bf16x8*>(p_ + 128); } while (0)
#define SWRITE(bf) do { *reinterpret_cast<bf16x8*>(V_lds + (bf) * 8192 + vst) = sr_.vs; *reinterpret_cast<bf16x8*>(K_lds + (bf) * 8192 + kst) = sr_.ks; } while (0)
#define SWAIT() asm volatile("s_waitcnt vmcnt(0)" ::: "memory")
#define RESC(a) do { if (__any((a) < 1.f)) { if (hi == 0) al_l[r32] = (a); LDS_WAIT(); \
    _Pragma("unroll") for (int d = 0; d < 2; ++d) _Pragma("unroll") for (int r = 0; r < 16; ++r) o[d][r] *= al_l[crow(r, hi)]; } } while (0)
#define WPV(vb) pv_all<64>(o, (vb), pa0, pa1, pa2, pa3)
    f32x16 pA0, pA1, pB0, pB1; float alA, alB; bf16x8 pa0, pa1, pa2, pa3;
    SLOAD(0); VM_WAIT(); SWRITE(0); __syncthreads();
    qkt64n<64>(pA0, pA1, K_lds, qr, 0, r32, hi, negm); da_partialSM<true>(pA0, pA1, m_reg, negm, alA);
    SLOAD(1);
    SWAIT(); SWRITE(1); __syncthreads();
    for (int j = 1; j + 1 < NT; j += 2) {
        SBAR(); qkt64n<64>(pB0, pB1, K_lds + 8192, qr, 0, r32, hi, negm);
        da_finishSM(pA0, pA1, alA, l_reg, pa0, pa1, pa2, pa3); SBAR();
        SLOAD(j + 1); SBAR();
        WPV(vb0); wa_mask(pB0, pB1, TMODE(j), qrel, hi); da_partialSM<false>(pB0, pB1, m_reg, negm, alB);
        __syncthreads(); SWAIT(); SWRITE(0);
        RESC(alB); __syncthreads();
        SBAR(); qkt64n<64>(pA0, pA1, K_lds, qr, 0, r32, hi, negm);
        da_finishSM(pB0, pB1, alB, l_reg, pa0, pa1, pa2, pa3); SBAR();
        SLOAD(j + 2); SBAR();
        WPV(vb0 + 8192); wa_mask(pA0, pA1, TMODE(j + 1), qrel, hi); da_partialSM<false>(pA0, pA1, m_reg, negm, alA);
        __syncthreads(); SWAIT(); SWRITE(1);
        RESC(alA); __syncthreads();
    }
    SBAR(); qkt64n<64>(pB0, pB1, K_lds + 8192, qr, 0, r32, hi, negm);
    da_finishSM(pA0, pA1, alA, l_reg, pa0, pa1, pa2, pa3); SBAR();
    WPV(vb0); wa_mask(pB0, pB1, TMODE(NT - 1), qrel, hi); da_partialSM<false>(pB0, pB1, m_reg, negm, alB);
    __syncthreads(); RESC(alB);
    da_finishSM(pB0, pB1, alB, l_reg, pa0, pa1, pa2, pa3); SBAR();
    WPV(vb0 + 8192);
#undef KROW
#undef TMODE
#undef SLOAD
#undef SWRITE
#undef SWAIT
#undef RESC
#undef WPV
    l_reg += __builtin_amdgcn_exp2f(sink[head] * LOG2E - m_reg);
    if (hi == 0) li_l[r32] = l_reg; LDS_WAIT();
    bf16_t* stg = (bf16_t*)(lds + WA_ST) + wid * 2048;
#pragma unroll
    for (int r = 0; r < 16; ++r) { const int orow = crow(r, hi); const float rl = __builtin_amdgcn_rcpf(li_l[orow]);
#pragma unroll
        for (int d0 = 0; d0 < 2; ++d0) stg[orow * 64 + d0 * 32 + r32] = (bf16_t)(cvtpk(o[d0][r] * rl, 0.f) & 0xffffu); }
    LDS_WAIT();
    bf16_t* yp = Y + qrow0 * DM + 512 + head * 64;
#pragma unroll
    for (int i = 0; i < 4; ++i) { const int row = i * 8 + (lane >> 3), ch = lane & 7; const u32x4 v = *reinterpret_cast<const u32x4*>(stg + row * 64 + ch * 8); *reinterpret_cast<u32x4*>(yp + (size_t)row * DM + ch * 8) = v; }
}

struct Args {
    const float *x, *c, *ctx, *c_ctx, *ada_w, *ada_b, *norm_g, *mix_in_w, *mix_out_w, *win_sink, *diff_qkv_w, *diff_out_w, *diff_lambda, *diff_subln_g,
                *ffn_in_w, *ffn_out_w, *router_w, *expert_in_w, *expert_out_w;
    float* out; unsigned char* ws; int ph_lo, ph_hi;
};
struct Frame {
    LAS unsigned char* lds; unsigned char* ldsg; volatile LAS unsigned* MISC; unsigned* ctl;
    int tid, lane, wave, vcu, G;
};

__device__ __forceinline__ unsigned f2bf(float f) { unsigned u = __builtin_bit_cast(unsigned, f); return (u + 0x7fffu + ((u >> 16) & 1u)) >> 16; }
__device__ __forceinline__ unsigned pk2(float lo, float hi) { return f2bf(lo) | (f2bf(hi) << 16); }
__device__ __forceinline__ void transpose_item(const float* W, int K, int N, bf16_t* WT, int n0, int c0, int k0, LAS float* scr, int lane) {
#pragma unroll 8
    for (int i = 0; i < 32; ++i) { const int kk = 2 * i + (lane >> 5); scr[kk * 33 + (lane & 31)] = W[(size_t)(k0 + kk) * N + c0 + (lane & 31)]; }
    LDS_WAIT(); asm volatile("" ::: "memory");
    const int c = lane & 7;
#pragma unroll
    for (int j = 0; j < 4; ++j) { const int n = (lane >> 3) + 8 * j; const LAS float* s = scr + (8 * c) * 33 + n;
        u32x4 o; o.x = pk2(s[0 * 33], s[1 * 33]); o.y = pk2(s[2 * 33], s[3 * 33]); o.z = pk2(s[4 * 33], s[5 * 33]); o.w = pk2(s[6 * 33], s[7 * 33]);
        *(u32x4*)(WT + (size_t)(n0 + n) * K + k0 + 8 * c) = o; }
    LDS_WAIT(); asm volatile("" ::: "memory");
}
__device__ __forceinline__ void transpose_item_f8(const float* W, int K, int N, unsigned char* WT, int n0, int c0, int k0, LAS float* scr, int lane) {
#pragma unroll 8
    for (int i = 0; i < 32; ++i) { const int kk = 2 * i + (lane >> 5); scr[kk * 33 + (lane & 31)] = W[(size_t)(k0 + kk) * N + c0 + (lane & 31)] * F8_SW; }
    LDS_WAIT(); asm volatile("" ::: "memory");
    const int c = lane & 7;
#pragma unroll
    for (int j = 0; j < 4; ++j) { const int n = (lane >> 3) + 8 * j; const LAS float* s = scr + (8 * c) * 33 + n;
        u32x2 o; o.x = pk4_fp8(s[0 * 33], s[1 * 33], s[2 * 33], s[3 * 33]); o.y = pk4_fp8(s[4 * 33], s[5 * 33], s[6 * 33], s[7 * 33]);
        *(u32x2*)(WT + (size_t)(n0 + n) * K + k0 + 8 * c) = o; }
    LDS_WAIT(); asm volatile("" ::: "memory");
}
__device__ __forceinline__ bool transpose_job(int& r, const float* W, int nb, int K, int N, void* WT, bool glu, bool f8, LAS float* scr, int lane) {
    const int nblk = N / 32, per = (K / 64) * nblk, tot = nb * per;
    if (r >= tot) { r -= tot; return false; }
    const int mtx = r / per, it = r % per, kb = it / nblk, nbk = it % nblk, n0 = 32 * nbk;
    int c0 = n0;
    if (glu) { const int tile = n0 >> 8, w = n0 & 255; c0 = (w < 128) ? tile * 128 + w : (N >> 1) + tile * 128 + (w - 128); }
    if (f8) transpose_item_f8(W + (size_t)mtx * K * N, K, N, (unsigned char*)WT + (size_t)mtx * K * N, n0, c0, 64 * kb, scr, lane);
    else transpose_item(W + (size_t)mtx * K * N, K, N, (bf16_t*)WT + (size_t)mtx * K * N, n0, c0, 64 * kb, scr, lane);
    return true;
}

struct ThinP {
    int nrows;
    const void* xin_lat; const void* xin_ctx;
    void* xout_lat; void* xout_ctx;
    bool xin16, xout16;
    int ymode;
    const bf16_t* Ysrc; const float* gate; const float* ga;
    bool h8;
    bf16_t* H; const float* gb; const float* shsc;
    const float* router; int* route; unsigned* cnt;
    unsigned char* HSv;
};
#define TH_DECL(PFX) f32x4 PFX##x0 = {}, PFX##x1 = {}, PFX##x2 = {}, PFX##x3 = {}; u32x2 PFX##xh0 = {}, PFX##xh1 = {}, PFX##xh2 = {}, PFX##xh3 = {}; u32x2 PFX##ya0 = {}, PFX##ya1 = {}, PFX##ya2 = {}, PFX##ya3 = {}, PFX##yb0 = {}, PFX##yb1 = {}, PFX##yb2 = {}, PFX##yb3 = {}; float PFX##w0 = 0.f, PFX##w1 = 0.f
#define TH_LOAD(PFX, r_, it_) do { const int rr_ = (r_); \
    if (P.xin16) { const bf16_t* xr_ = (rr_ < RL ? (const bf16_t*)P.xin_lat + (size_t)rr_ * DM : (const bf16_t*)P.xin_ctx + (size_t)(rr_ - RL) * DM) + 4 * lane; \
        PFX##xh0 = __builtin_nontemporal_load(reinterpret_cast<const u32x2*>(xr_)); PFX##xh1 = __builtin_nontemporal_load(reinterpret_cast<const u32x2*>(xr_ + 256)); PFX##xh2 = __builtin_nontemporal_load(reinterpret_cast<const u32x2*>(xr_ + 512)); PFX##xh3 = __builtin_nontemporal_load(reinterpret_cast<const u32x2*>(xr_ + 768)); } \
    else { const float* xr_ = (rr_ < RL ? (const float*)P.xin_lat + (size_t)rr_ * DM : (const float*)P.xin_ctx + (size_t)(rr_ - RL) * DM) + 4 * lane; \
        PFX##x0 = __builtin_nontemporal_load(reinterpret_cast<const f32x4*>(xr_)); PFX##x1 = __builtin_nontemporal_load(reinterpret_cast<const f32x4*>(xr_ + 256)); PFX##x2 = __builtin_nontemporal_load(reinterpret_cast<const f32x4*>(xr_ + 512)); PFX##x3 = __builtin_nontemporal_load(reinterpret_cast<const f32x4*>(xr_ + 768)); } \
    const bf16_t* ya_ = P.Ysrc; const bf16_t* yb_ = P.Ysrc; \
    if (P.ymode == 1) ya_ = P.Ysrc + (size_t)rr_ * DM; \
    else if (P.ymode == 2) { const LAS int* rt_ = rtl + (it_) * 6; \
        const int e0_ = rt_[0], p0_ = rt_[1], e1_ = rt_[2], p1_ = rt_[3]; PFX##w0 = __int_as_float(rt_[4]); PFX##w1 = __int_as_float(rt_[5]); \
        const unsigned b0_ = e0_ == 0 ? 0u : e0_ == 1 ? cb1 : e0_ == 2 ? cb2 : e0_ == 3 ? cb3 : e0_ == 4 ? cb4 : e0_ == 5 ? cb5 : e0_ == 6 ? cb6 : cb7; \
        const unsigned b1_ = e1_ == 0 ? 0u : e1_ == 1 ? cb1 : e1_ == 2 ? cb2 : e1_ == 3 ? cb3 : e1_ == 4 ? cb4 : e1_ == 5 ? cb5 : e1_ == 6 ? cb6 : cb7; \
        ya_ = P.Ysrc + (size_t)(b0_ + p0_) * DM; yb_ = P.Ysrc + (size_t)(b1_ + p1_) * DM; } \
    if (P.ymode) { ya_ += 4 * lane; PFX##ya0 = __builtin_nontemporal_load(reinterpret_cast<const u32x2*>(ya_)); PFX##ya1 = __builtin_nontemporal_load(reinterpret_cast<const u32x2*>(ya_ + 256)); PFX##ya2 = __builtin_nontemporal_load(reinterpret_cast<const u32x2*>(ya_ + 512)); PFX##ya3 = __builtin_nontemporal_load(reinterpret_cast<const u32x2*>(ya_ + 768)); } \
    if (P.ymode == 2) { yb_ += 4 * lane; PFX##yb0 = __builtin_nontemporal_load(reinterpret_cast<const u32x2*>(yb_)); PFX##yb1 = __builtin_nontemporal_load(reinterpret_cast<const u32x2*>(yb_ + 256)); PFX##yb2 = __builtin_nontemporal_load(reinterpret_cast<const u32x2*>(yb_ + 512)); PFX##yb3 = __builtin_nontemporal_load(reinterpret_cast<const u32x2*>(yb_ + 768)); } \
    } while (0)
#define TH_ARGS(PFX) PFX##x0, PFX##x1, PFX##x2, PFX##x3, PFX##xh0, PFX##xh1, PFX##xh2, PFX##xh3, PFX##ya0, PFX##ya1, PFX##ya2, PFX##ya3, PFX##yb0, PFX##yb1, PFX##yb2, PFX##yb3, PFX##w0, PFX##w1
__device__ __forceinline__ void thin_proc(const ThinP& P, f32x4 x0, f32x4 x1, f32x4 x2, f32x4 x3, u32x2 xh0, u32x2 xh1, u32x2 xh2, u32x2 xh3, u32x2 ya0, u32x2 ya1, u32x2 ya2, u32x2 ya3, u32x2 yb0, u32x2 yb1, u32x2 yb2, u32x2 yb3, float yw0, float yw1,
                                          f32x4 GA0, f32x4 GA1, f32x4 GA2, f32x4 GA3, f32x4 GB0, f32x4 GB1, f32x4 GB2, f32x4 GB3, f32x4 SH0, f32x4 SH1, f32x4 SH2, f32x4 SH3,
                                          int r, int li, int lane, LAS float* rwT, LAS int* rec, LAS unsigned* lcnt) {
    const int idx = r < RL ? (r >> 12) : 8;
#define BF4(w) ((f32x4){bf_lo((w).x), bf_hi((w).x), bf_lo((w).y), bf_hi((w).y)})
    f32x4 xv[4] = {x0, x1, x2, x3};
    if (P.xin16) { xv[0] = BF4(xh0); xv[1] = BF4(xh1); xv[2] = BF4(xh2); xv[3] = BF4(xh3); }
    if (P.ymode) {
        f32x4 yv[4];
        if (P.ymode == 1) { yv[0] = BF4(ya0); yv[1] = BF4(ya1); yv[2] = BF4(ya2); yv[3] = BF4(ya3); }
        else { yv[0] = BF4(ya0) * yw0 + BF4(yb0) * yw1; yv[1] = BF4(ya1) * yw0 + BF4(yb1) * yw1; yv[2] = BF4(ya2) * yw0 + BF4(yb2) * yw1; yv[3] = BF4(ya3) * yw0 + BF4(yb3) * yw1; }
#undef BF4
        float ss = 0.f;
#pragma unroll
        for (int j = 0; j < 4; ++j) ss += yv[j][0] * yv[j][0] + yv[j][1] * yv[j][1] + yv[j][2] * yv[j][2] + yv[j][3] * yv[j][3];
        const float rs = __builtin_amdgcn_rsqf(wave_sum(ss, lane) * (1.f / DM) + EPS);
        xv[0] = xv[0] + GA0 * (yv[0] * rs); xv[1] = xv[1] + GA1 * (yv[1] * rs); xv[2] = xv[2] + GA2 * (yv[2] * rs); xv[3] = xv[3] + GA3 * (yv[3] * rs);
    }
    if (P.xout_lat) {
        if (P.xout16) { bf16_t* xo = r < RL ? (bf16_t*)P.xout_lat + (size_t)r * DM : (bf16_t*)P.xout_ctx + (size_t)(r - RL) * DM;
#pragma unroll
            for (int j = 0; j < 4; ++j) { u32x2 w; w.x = cvtpk(xv[j][0], xv[j][1]); w.y = cvtpk(xv[j][2], xv[j][3]); __builtin_nontemporal_store(w, reinterpret_cast<u32x2*>(xo + 4 * lane + 256 * j)); } }
        else { float* xo = r < RL ? (float*)P.xout_lat + (size_t)r * DM : (float*)P.xout_ctx + (size_t)(r - RL) * DM;
#pragma unroll
            for (int j = 0; j < 4; ++j) __builtin_nontemporal_store(xv[j], reinterpret_cast<f32x4*>(xo + 4 * lane + 256 * j)); } }
    if (P.H) {
        float ss = 0.f;
#pragma unroll
        for (int j = 0; j < 4; ++j) ss += xv[j][0] * xv[j][0] + xv[j][1] * xv[j][1] + xv[j][2] * xv[j][2] + xv[j][3] * xv[j][3];
        const float rs = __builtin_amdgcn_rsqf(wave_sum(ss, lane) * (1.f / DM) + EPS);
        bf16_t* hr = P.H + (size_t)r * DM;
        f32x4 hv[4] = {xv[0] * rs * GB0 + SH0, xv[1] * rs * GB1 + SH1, xv[2] * rs * GB2 + SH2, xv[3] * rs * GB3 + SH3};
#pragma unroll
        for (int j = 0; j < 4; ++j) {
            if (P.h8) { *reinterpret_cast<unsigned*>((unsigned char*)P.H + (size_t)r * DM + 4 * lane + 256 * j) = pk4_fp8(hv[j][0] * F8_SH, hv[j][1] * F8_SH, hv[j][2] * F8_SH, hv[j][3] * F8_SH); }
            else { u32x2 w; w.x = cvtpk(hv[j][0], hv[j][1]); w.y = cvtpk(hv[j][2], hv[j][3]); *reinterpret_cast<u32x2*>(hr + 4 * lane + 256 * j) = w; } }
        if (P.router) {
            float lg[8];
#pragma unroll
            for (int e = 0; e < 8; ++e) { float a = 0.f;
#pragma unroll
                for (int j = 0; j < 4; ++j) { const f32x4 w = *reinterpret_cast<const LAS f32x4*>(rwT + e * 1024 + 4 * lane + 256 * j); a += hv[j][0] * w[0] + hv[j][1] * w[1] + hv[j][2] * w[2] + hv[j][3] * w[3]; }
                lg[e] = wave_sum(a, lane); }
            int i0 = 0; float v0 = lg[0];
#pragma unroll
            for (int e = 1; e < 8; ++e) if (lg[e] > v0) { v0 = lg[e]; i0 = e; }
            int i1 = -1; float v1 = -3.4e38f;
#pragma unroll
            for (int e = 0; e < 8; ++e) if (e != i0 && lg[e] > v1) { v1 = lg[e]; i1 = e; }
            const float w0 = 1.f / (1.f + __expf(v1 - v0)), w1 = 1.f - w0;
            if (lane == 0) { const unsigned lp0 = __hip_atomic_fetch_add(lcnt + i0, 1u, __ATOMIC_RELAXED, __HIP_MEMORY_SCOPE_WORKGROUP), lp1 = __hip_atomic_fetch_add(lcnt + i1, 1u, __ATOMIC_RELAXED, __HIP_MEMORY_SCOPE_WORKGROUP);
                LAS int* rc = rec + li * 6; rc[0] = i0; rc[1] = (int)lp0; rc[2] = i1; rc[3] = (int)lp1; rc[4] = __float_as_int(w0); rc[5] = __float_as_int(w1); }
        }
    }
}
__device__ __forceinline__ void thin_phase(Frame& F, const ThinP& P) {
    const int lane = opaque(F.lane);
    const int nlat = P.nrows < RL ? P.nrows : RL, nctx = P.nrows - nlat;
    const int chL = (nlat + F.G - 1) / F.G, chC = (nctx + F.G - 1) / F.G;
    const int r0L = F.vcu * chL, r0C = F.vcu * chC;
    const int nl = r0L >= nlat ? 0 : (r0L + chL <= nlat ? chL : nlat - r0L), nc = r0C >= nctx ? 0 : (r0C + chC <= nctx ? chC : nctx - r0C), nrw = nl + nc;
#define TROW(li_) ((li_) < nl ? r0L + (li_) : RL + r0C + ((li_) - nl))
    LAS float* rwT = (LAS float*)F.lds;
    LAS int* rec = (LAS int*)(F.lds + 32768);
    LAS unsigned* lcnt = (LAS unsigned*)(F.lds + 65536);
    unsigned cb1 = 0, cb2 = 0, cb3 = 0, cb4 = 0, cb5 = 0, cb6 = 0, cb7 = 0;
    if (P.ymode == 2) { unsigned a = 0;
        a += (xb_ld(P.cnt + 0) + 255u) & ~255u; cb1 = a; a += (xb_ld(P.cnt + 1) + 255u) & ~255u; cb2 = a; a += (xb_ld(P.cnt + 2) + 255u) & ~255u; cb3 = a;
        a += (xb_ld(P.cnt + 3) + 255u) & ~255u; cb4 = a; a += (xb_ld(P.cnt + 4) + 255u) & ~255u; cb5 = a; a += (xb_ld(P.cnt + 5) + 255u) & ~255u; cb6 = a;
        a += (xb_ld(P.cnt + 6) + 255u) & ~255u; cb7 = a; }
    if (P.router) {
        for (int i = F.tid; i < 8192; i += 512) { const int col = i >> 3, e = i & 7; rwT[e * 1024 + col] = P.router[i]; }
        if (F.tid < 16) lcnt[F.tid] = 0u;
        __syncthreads();
    }
    LAS int* rtl = (LAS int*)(F.lds + 98304) + F.wave * 6 * 64;
    if (P.ymode == 2) { const int li_ = F.wave + 8 * lane;
        if (li_ < nrw) { const int* rt = P.route + (size_t)TROW(li_) * 8; const u32x4 a = *reinterpret_cast<const u32x4*>(rt); const u32x2 b = *reinterpret_cast<const u32x2*>(rt + 4);
            LAS int* d = rtl + lane * 6; d[0] = (int)a.x; d[1] = (int)a.y; d[2] = (int)a.z; d[3] = (int)a.w; d[4] = (int)b.x; d[5] = (int)b.y; }
        LDS_WAIT(); }
    f32x4 GA0 = {}, GA1 = {}, GA2 = {}, GA3 = {}, GB0 = {}, GB1 = {}, GB2 = {}, GB3 = {}, SH0 = {}, SH1 = {}, SH2 = {}, SH3 = {}; int cur_idx = -1;
#define TH_VEC(r_) do { const int ix_ = (r_) < RL ? ((r_) >> 12) : 8; if (ix_ != cur_idx) { cur_idx = ix_; \
        if (P.ymode) { const float* gt_ = P.gate + (size_t)ix_ * 6144 + 4 * lane; const float* ga_ = P.ga + 4 * lane; \
            GA0 = *reinterpret_cast<const f32x4*>(gt_) * *reinterpret_cast<const f32x4*>(ga_); GA1 = *reinterpret_cast<const f32x4*>(gt_ + 256) * *reinterpret_cast<const f32x4*>(ga_ + 256); \
            GA2 = *reinterpret_cast<const f32x4*>(gt_ + 512) * *reinterpret_cast<const f32x4*>(ga_ + 512); GA3 = *reinterpret_cast<const f32x4*>(gt_ + 768) * *reinterpret_cast<const f32x4*>(ga_ + 768); } \
        if (P.H) { const float* sh_ = P.shsc + (size_t)ix_ * 6144 + 4 * lane; const float* gb_ = P.gb + 4 * lane; \
            GB0 = *reinterpret_cast<const f32x4*>(gb_) * (*reinterpret_cast<const f32x4*>(sh_ + 1024) + 1.f); GB1 = *reinterpret_cast<const f32x4*>(gb_ + 256) * (*reinterpret_cast<const f32x4*>(sh_ + 1280) + 1.f); \
            GB2 = *reinterpret_cast<const f32x4*>(gb_ + 512) * (*reinterpret_cast<const f32x4*>(sh_ + 1536) + 1.f); GB3 = *reinterpret_cast<const f32x4*>(gb_ + 768) * (*reinterpret_cast<const f32x4*>(sh_ + 1792) + 1.f); \
            SH0 = *reinterpret_cast<const f32x4*>(sh_); SH1 = *reinterpret_cast<const f32x4*>(sh_ + 256); SH2 = *reinterpret_cast<const f32x4*>(sh_ + 512); SH3 = *reinterpret_cast<const f32x4*>(sh_ + 768); } } } while (0)
#define TH_VARGS GA0, GA1, GA2, GA3, GB0, GB1, GB2, GB3, SH0, SH1, SH2, SH3
    TH_DECL(A_); TH_DECL(B_);
    int li = F.wave;
    if (li < nrw) TH_LOAD(A_, TROW(li), 0);
    for (int it = 0; li < nrw; li += 16, it += 2) {
        const bool hb = li + 8 < nrw;
        if (hb) TH_LOAD(B_, TROW(li + 8), it + 1);
        TH_VEC(TROW(li)); thin_proc(P, TH_ARGS(A_), TH_VARGS, TROW(li), li, lane, rwT, rec, lcnt);
        if (li + 16 < nrw) TH_LOAD(A_, TROW(li + 16), it + 2);
        if (hb) { TH_VEC(TROW(li + 8)); thin_proc(P, TH_ARGS(B_), TH_VARGS, TROW(li + 8), li + 8, lane, rwT, rec, lcnt); }
    }
    if (P.router) {
        __syncthreads();
        if (F.tid < 8) lcnt[8 + F.tid] = __hip_atomic_fetch_add(P.cnt + F.tid, lcnt[F.tid], __ATOMIC_RELAXED, __HIP_MEMORY_SCOPE_AGENT);
        __syncthreads();
        for (int i = F.tid; i < nrw; i += 512) { const LAS int* rc = rec + i * 6; int* rt = P.route + (size_t)TROW(i) * 8;
            const int e0 = rc[0], e1 = rc[2];
            rt[0] = e0; rt[1] = rc[1] + (int)lcnt[8 + e0]; rt[2] = e1; rt[3] = rc[3] + (int)lcnt[8 + e1]; rt[4] = rc[4]; rt[5] = rc[5]; }
        VM_WAIT();
        for (int lb = F.wave; lb < nrw; lb += 32) {
            u32x4 v[4]; size_t s0[4], s1[4];
#pragma unroll
            for (int q = 0; q < 4; ++q) { const int lq = lb + 8 * q; const int r = TROW(lq); if (lq < nrw) { const LAS int* rc = rec + lq * 6; const int e0 = rc[0], e1 = rc[2];
                s0[q] = (size_t)e0 * RT + (size_t)(rc[1] + (int)lcnt[8 + e0]); s1[q] = (size_t)e1 * RT + (size_t)(rc[3] + (int)lcnt[8 + e1]);
                v[q] = *(reinterpret_cast<const u32x4*>((const unsigned char*)P.H + (size_t)r * DM) + lane); } }
#pragma unroll
            for (int q = 0; q < 4; ++q) { if (lb + 8 * q < nrw) {
                *(reinterpret_cast<u32x4*>(P.HSv + s0[q] * DM) + lane) = v[q]; *(reinterpret_cast<u32x4*>(P.HSv + s1[q] * DM) + lane) = v[q]; } }
        }
        __syncthreads();
    }
#undef TROW
#undef TH_VEC
#undef TH_VARGS
}

constexpr int NPHASE = 2 + DEPTH * 9;
__global__ void __launch_bounds__(512, 2) dit_fwd(Args args) {
    extern __shared__ __attribute__((aligned(16))) unsigned char lds[];
    Frame F;
    F.lds = (LAS unsigned char*)lds; F.ldsg = lds; F.MISC = (volatile LAS unsigned*)(F.lds + MISC_OFF);
    F.tid = threadIdx.x; F.lane = F.tid & 63; F.wave = __builtin_amdgcn_readfirstlane(F.tid >> 6);
    F.G = gridDim.x; { const int bx = blockIdx.x; F.vcu = (F.G % 8 == 0) ? (bx % 8) * (F.G / 8) + bx / 8 : bx; }
    F.ctl = (unsigned*)(args.ws + WS_CTL);
    for (int u = F.tid; u < (LDS_BYTES - RING_BYTES) / 4; u += 512) ((LAS unsigned*)(F.lds + RING_BYTES))[u] = 0u;
    __syncthreads();
    XcdBarrier bar = xcd_barrier_post(F.ctl + CW_BAR, F.MISC + 8);
    const int lo = args.ph_lo, hi = args.ph_hi;
    int ph = 0;
#define IN() (lo <= ph && ph < hi)
    unsigned long long wait_acc = 0, clk_c = 0, clk_r = 0;
#define CLK_BEG(sel) unsigned long long c0_ = 0, r0_ = 0; if (PROBE_CLK == (sel)) { c0_ = __builtin_amdgcn_s_memtime(); r0_ = __builtin_amdgcn_s_memrealtime(); }
#define CLK_END(sel) if (PROBE_CLK == (sel)) { clk_c += __builtin_amdgcn_s_memtime() - c0_; clk_r += __builtin_amdgcn_s_memrealtime() - r0_; }
#define SEAM() do { if (lo <= ph && ph + 1 < hi) { if (WAITPROBE) { const unsigned long long t0_ = __builtin_amdgcn_s_memrealtime(); xcd_barrier(bar); const unsigned long long dt_ = __builtin_amdgcn_s_memrealtime() - t0_; const int k_ = ph < 2 ? 9 + ph : (ph - 2) % 9; if ((WAITSEL >> k_) & 1u) wait_acc += dt_; } else xcd_barrier(bar); } ++ph; } while (0)
    GAS unsigned char* wsg = (GAS unsigned char*)args.ws;
#define WSP ((unsigned char*)wsg)
#define pMOD    ((float*)(WSP + WS_MOD))
#define pROPECS ((f32x2*)(WSP + WS_ROPE))
#define pWP     ((bf16_t*)(WSP + WS_WP))
#define pROUTE  ((int*)(WSP + WS_ROUTE))
#define pCS     ((bf16_t*)(WSP + WS_CS))
#define pCSC    ((bf16_t*)(WSP + WS_CSC))
#define pX      ((bf16_t*)(WSP + WS_X))
#define pH      ((bf16_t*)(WSP + WS_H))
#define pYO     ((bf16_t*)(WSP + WS_YO))
#define pZ      ((bf16_t*)(WSP + WS_Z))
#define pY      ((bf16_t*)(WSP + WS_Y))
#define pPQT    ((bf16_t*)(WSP + WS_PQT))
#define pPQTC   ((bf16_t*)(WSP + WS_PQTC))
#define pOB     ((bf16_t*)(WSP + WS_O))
#define pQK8    ((unsigned char*)(WSP + WS_QK8))
#define pVT8    ((unsigned char*)(WSP + WS_VT8))
#define pA2     ((bf16_t*)(WSP + WS_A2))
#define pA2M    ((bf16_t*)(WSP + WS_A2M))
#define pHS     ((bf16_t*)(WSP + WS_HS))
    const int vcu0 = F.vcu;
#define REFRAME() do { F.tid = opaque(threadIdx.x); F.lane = F.tid & 63; F.wave = __builtin_amdgcn_readfirstlane(F.tid >> 6); F.G = sopaque((int)gridDim.x); F.vcu = sopaque(vcu0); \
        wsg = gptr(args.ws); F.ctl = (unsigned*)(WSP + WS_CTL); } while (0)
    for (int rep0 = 0; rep0 < REP_P0; ++rep0)
    if (IN() && PH_ON(0)) { REFRAME();
        const int gw = F.vcu * 8 + F.wave, NGW = F.G * 8, gt = F.vcu * 512 + F.tid, NGT = F.G * 512;
        LAS float* ctab = (LAS float*)F.lds;
        LAS float* svec = (LAS float*)(F.lds + 16384);
        if (F.tid == 0) *(LAS unsigned*)(F.lds + 126976) = 0u;
        for (int i = F.tid; i < 4096; i += 512) ctab[i] = cospif((float)i * (1.f / 2048.f));
        for (int i = F.tid; i < 9 * 1024; i += 512) { const float v = i < 8192 ? args.c[i] : args.c_ctx[i - 8192]; svec[i] = v / (1.f + __expf(-v)); }
        __syncthreads();
        for (int i = gt; i < 4096 * 512; i += NGT) { const int k = i >> 9, l0 = (i & 511) * 8; float v[8];
#pragma unroll
            for (int e = 0; e < 8; ++e) { const int col = l0 + e; const int ph_ = (k * (col <= 2048 ? col : col - 2048)) & 4095; v[e] = col <= 2048 ? ctab[ph_] : -ctab[(ph_ - 1024) & 4095]; }
            *reinterpret_cast<u32x4*>(pCS + (size_t)k * FP + l0) = (u32x4){pk2(v[0], v[1]), pk2(v[2], v[3]), pk2(v[4], v[5]), pk2(v[6], v[7])}; }
        for (int i = gt; i < 256 * 64; i += NGT) { const int k = i >> 6, l0 = (i & 63) * 8; float v[8];
#pragma unroll
            for (int e = 0; e < 8; ++e) { const int col = l0 + e, l = col & 255; const int ph_ = (k * l * 16) & 4095; v[e] = col < 256 ? ctab[ph_] : -ctab[(ph_ - 1024) & 4095]; }
            *reinterpret_cast<u32x4*>(pCSC + (size_t)k * FP + l0) = (u32x4){pk2(v[0], v[1]), pk2(v[2], v[3]), pk2(v[4], v[5]), pk2(v[6], v[7])}; }
        for (int i = gt; i < 256 * 128; i += NGT) { const int row = i >> 7, c = i & 127, m = row & 127; const int ph_ = (m * c * 32) & 4095;
            const float v = row < 128 ? ctab[ph_] : ctab[(ph_ - 1024) & 4095]; pWP[i] = (bf16_t)f2bf(v); }
        for (int i = gt; i < 64 * 16; i += NGT) { const int pos = i >> 4, k = i & 15; const float inv = __powf(10000.f, -(float)(2 * k) / 32.f); float s, c; sincosf((float)pos * inv, &s, &c); pROPECS[i] = (f32x2){c, s}; }
        for (int task = F.vcu + F.wave * F.G; task < 512; task += 8 * F.G) { const int layer = task >> 7, col = (task & 127) * 48 + F.lane;
            if (F.lane < 48) {
            const float* w = args.ada_w + (size_t)layer * DM * 6144 + col;
            float a0 = 0, a1 = 0, a2 = 0, a3 = 0, a4 = 0, a5 = 0, a6 = 0, a7 = 0, a8 = 0;
            for (int k0 = 0; k0 < DM; k0 += 32) { float wv[32];
#pragma unroll
                for (int i = 0; i < 32; ++i) wv[i] = w[(size_t)(k0 + i) * 6144];
#pragma unroll
                for (int i = 0; i < 32; ++i) { const int k = k0 + i;
                    a0 += svec[k] * wv[i]; a1 += svec[1024 + k] * wv[i]; a2 += svec[2048 + k] * wv[i]; a3 += svec[3072 + k] * wv[i]; a4 += svec[4096 + k] * wv[i];
                    a5 += svec[5120 + k] * wv[i]; a6 += svec[6144 + k] * wv[i]; a7 += svec[7168 + k] * wv[i]; a8 += svec[8192 + k] * wv[i]; } }
            const float bb = args.ada_b[layer * 6144 + col]; float* mo = pMOD + (size_t)layer * 9 * 6144 + col;
            mo[0] = a0 + bb; mo[6144] = a1 + bb; mo[2 * 6144] = a2 + bb; mo[3 * 6144] = a3 + bb; mo[4 * 6144] = a4 + bb; mo[5 * 6144] = a5 + bb; mo[6 * 6144] = a6 + bb; mo[7 * 6144] = a7 + bb; mo[8 * 6144] = a8 + bb; } }
        LAS float* scr = (LAS float*)(F.lds + 57344 + F.wave * 8448);
        LAS unsigned* wcnt = (LAS unsigned*)(F.lds + 126976);
        constexpr int NITEMS = 2 * (16 * 40) + 2 * (16 * 32) + 2 * (16 * 96) + 2 * (16 * 32) + 2 * (16 * 176) + 2 * (44 * 32) + 16 * (16 * 224) + 16 * (56 * 32);
        for (;;) {
            const int n = __builtin_amdgcn_readfirstlane((int)__hip_atomic_fetch_add(wcnt, F.lane == 0 ? 1u : 0u, __ATOMIC_RELAXED, __HIP_MEMORY_SCOPE_WORKGROUP));
            const int it = ((n >> 3) * F.G + F.vcu) * 8 + (n & 7);
            if (it >= NITEMS) break;
            int r = it;
            if (transpose_job(r, args.mix_in_w, 2, DM, MIXIN, (bf16_t*)(WSP + WS_WMIXIN), false, false, scr, F.lane)) continue;
            if (transpose_job(r, args.mix_out_w, 2, DM, DM, (bf16_t*)(WSP + WS_WMIXOUT), false, false, scr, F.lane)) continue;
            if (transpose_job(r, args.diff_qkv_w, 2, DM, 3072, (bf16_t*)(WSP + WS_WQKV), false, false, scr, F.lane)) continue;
            if (transpose_job(r, args.diff_out_w, 2, DM, DM, (bf16_t*)(WSP + WS_WDOUT), false, false, scr, F.lane)) continue;
            if (transpose_job(r, args.ffn_in_w, 2, DM, 2 * FFN, (bf16_t*)(WSP + WS_WFFNIN), true, F8_DENSE, scr, F.lane)) continue;
            if (transpose_job(r, args.ffn_out_w, 2, FFN, DM, (bf16_t*)(WSP + WS_WFFNOUT), false, F8_DENSE || F8_DDOWN, scr, F.lane)) continue;
            if (transpose_job(r, args.expert_in_w, 16, DM, 2 * EDIM, (bf16_t*)(WSP + WS_WEXPIN), true, true, scr, F.lane)) continue;
            transpose_job(r, args.expert_out_w, 16, EDIM, DM, (bf16_t*)(WSP + WS_WEXPOUT), false, true, scr, F.lane);
        }
        __syncthreads();
    }
    SEAM();
    if (IN() && PH_ON(1)) { REFRAME();
        ThinP P{}; P.nrows = RT; P.xin_lat = args.x; P.xin_ctx = args.ctx; P.ymode = 0; P.H = pH; P.gb = args.norm_g; P.shsc = pMOD;
        for (int rep = 0; rep < REP_P0B; ++rep) thin_phase(F, P);
        for (int rep = 0; rep < EXTRA_BARS; ++rep) xcd_barrier(bar);
    }
    SEAM();

    for (int layer = 0; layer < DEPTH; ++layer) {
        const int j = layer >> 1; const bool even = !(layer & 1), lastl = layer == DEPTH - 1;
        const float* modl = pMOD + (size_t)layer * 9 * 6144; const float* ng = args.norm_g + (size_t)layer * 4 * DM;
        const int Mrows = lastl ? RL : RT;
        if (IN() && PH_ON(2)) { REFRAME();
            pg8::Dims d{DM, DM}; SchedDense S;
            if (even) { S.init(pH, DM, (bf16_t*)(WSP + WS_WMIXIN) + (size_t)j * MIXIN * DM, DM, RT, MIXIN, DM, F.G, (int)blockIdx.x);
                EpiRope E{pZ, MIXIN, 4, 9, pROPECS, 4, 8, QK_C, nullptr, 0}; for (int rep = 0; rep < REP_PROJ; ++rep) pg8::gemm_phase(F.lds, d, S, E); }
            else { const bf16_t* wq = (bf16_t*)(WSP + WS_WQKV) + (size_t)j * 3072 * DM;
                S.init(pH, DM, wq, DM, RT, 2048, DM, F.G, (int)blockIdx.x);
                EpiRope E{pZ, 3072, 0, 16, pROPECS, 0, 8, QK_C, pQK8, 16}; for (int rep = 0; rep < REP_PROJ; ++rep) pg8::gemm_phase(F.lds, d, S, E);
                SchedDense S2; S2.init(wq + (size_t)2048 * DM, DM, pH, DM, DM, RT, DM, F.G, (int)((blockIdx.x + 3 * (gridDim.x / 4)) % gridDim.x));
                EpiVt E2{pVT8}; for (int rep = 0; rep < REP_PROJ; ++rep) pg8::gemm_phase(F.lds, d, S2, E2); }
        }
        SEAM();
        if (IN() && PH_ON(3)) { REFRAME();
            if (even) {
                if (PH_ON(16)) { pg8::Dims d{128, MIXIN}; SchedF1 S{(const char*)pWP, (const char*)pZ, F.G, F.vcu}; EpiPQt E{pPQT, pPQTC}; for (int rep = 0; rep < REP_FOUR; ++rep) pg8::gemm_phase(F.lds, d, S, E); }
            } else {
                const float* lv = args.diff_lambda + j * 256;
                const int ln = opaque(F.lane); const float s01 = wave_sum(lv[ln] * lv[64 + ln], ln), s23 = wave_sum(lv[128 + ln] * lv[192 + ln], ln);
                const float lam_init = 0.8f - 0.6f * __expf(-0.3f * (float)layer);
                const float lam = __expf(s01) - __expf(s23) + lam_init;
                const float* subg = args.diff_subln_g + j * 128;
                const int nu = lastl ? 2048 : 2048 + 128;
                CLK_BEG(1)
                for (int rep = 0; rep < REP_DIFF; ++rep)
                for (int u = F.vcu; u < (PH_ON(18) ? nu : 0); u += F.G) {
                    if (u < 2048) diff_attn_unit((char*)lds, pVT8, pQK8, pOB, subg, lam, 1.f - lam_init, u >> 8, (u >> 5) & 7, u & 31, false);
                    else { const int v = u - 2048; diff_attn_unit((char*)lds, pVT8, pQK8, pOB, subg, lam, 1.f - lam_init, v >> 4, (v >> 1) & 7, v & 1, true); }
                }
                __syncthreads();
                CLK_END(1)
            }
        }
        SEAM();
        if (IN() && PH_ON(4)) { REFRAME();
            if (even) { pg8::Dims d{FP, FP}; SchedF2 S{(const char*)pCS, (const char*)pCSC, (const char*)pPQT, (const char*)pPQTC, F.G, F.vcu}; EpiFour2 E{pY}; for (int rep = 0; rep < REP_FOUR; ++rep) pg8::gemm_phase<EpiFour2, SchedF2, false>(F.lds, d, S, E);
                const float* sink = args.win_sink + j * 8;
                for (int rep = 0; rep < REP_WIN; ++rep)
                for (int u = F.vcu; u < (PH_ON(17) ? 1024 + 64 : 0); u += F.G) {
                    if (u < 1024) win_attn_unit2((char*)lds, pZ, pY, sink, u >> 7, (u >> 6) & 1, u & 63, false);
                    else { const int v = u - 1024; win_attn_unit2((char*)lds, pZ, pY, sink, v >> 3, (v >> 2) & 1, v & 3, true); }
                }
                __syncthreads();
            }
        }
        if (even) SEAM(); else ++ph;
        if (IN() && PH_ON(5)) { REFRAME();
            pg8::Dims d{DM, DM}; SchedDense S;
            S.init(even ? pY : pOB, DM, (bf16_t*)(WSP + (even ? WS_WMIXOUT : WS_WDOUT)) + (size_t)j * DM * DM, DM, Mrows, DM, DM, F.G, (int)blockIdx.x);
            CLK_BEG(4)
            EpiStore E{pYO, DM, 1.f}; for (int rep = 0; rep < REP_PROJ; ++rep) pg8::gemm_phase(F.lds, d, S, E);
            CLK_END(4)
        }
        SEAM();
        if (IN() && PH_ON(6)) { REFRAME();
            ThinP P{}; P.nrows = Mrows; P.xin16 = layer != 0; P.xout16 = true;
            if (layer == 0) { P.xin_lat = args.x; P.xin_ctx = args.ctx; } else { P.xin_lat = pX; P.xin_ctx = pX + (size_t)RL * DM; }
            P.xout_lat = pX; P.xout_ctx = pX + (size_t)RL * DM; P.ymode = 1; P.Ysrc = pYO; P.gate = modl + 2048; P.ga = ng + DM;
            P.H = pH; P.h8 = !even || F8_DENSE; P.gb = ng + 2 * DM; P.shsc = modl + 3072;
            if (!even) { P.router = args.router_w + (size_t)j * DM * 8; P.route = pROUTE; P.cnt = F.ctl + CW_CNT + 16 * j; P.HSv = (unsigned char*)pHS; }
            thin_phase(F, P);
        }
        SEAM();
        unsigned c0 = 0, c1 = 0, c2 = 0, c3 = 0, c4 = 0, c5 = 0, c6 = 0, c7 = 0;
        if (!even) { unsigned* cn = F.ctl + CW_CNT + 16 * j; unsigned a = 0;
            c0 = 0; a += (rfl(xb_ld(cn + 0)) + 255u) & ~255u; c1 = a; a += (rfl(xb_ld(cn + 1)) + 255u) & ~255u; c2 = a; a += (rfl(xb_ld(cn + 2)) + 255u) & ~255u; c3 = a;
            a += (rfl(xb_ld(cn + 3)) + 255u) & ~255u; c4 = a; a += (rfl(xb_ld(cn + 4)) + 255u) & ~255u; c5 = a; a += (rfl(xb_ld(cn + 5)) + 255u) & ~255u; c6 = a;
            a += (rfl(xb_ld(cn + 6)) + 255u) & ~255u; c7 = a; a += (rfl(xb_ld(cn + 7)) + 255u) & ~255u; c0 = a; }
        ++ph;
        if (IN() && PH_ON(8)) { REFRAME();
            const bool f8 = !even || F8_DENSE; const int eb = f8 ? 1 : 2;
            pg8::Dims d{DM * eb / 2, DM * eb / 2}; SchedGroup S;
            if (even) { S.A = (const char*)pH; S.B = (const char*)(WSP + WS_WFFNIN) + (size_t)j * 2 * FFN * DM * eb; S.nRT = RT / 256; S.P1 = S.P2 = S.P3 = S.P4 = S.P5 = S.P6 = S.P7 = 1 << 30; S.nN = 2 * FFN / 256; S.gB = 0; S.aE = 0; }
            else { S.aE = (size_t)RT * DM; S.A = (const char*)pHS; S.B = (const char*)(WSP + WS_WEXPIN) + (size_t)j * NEXP * 2 * EDIM * DM; S.nRT = (int)(c0 >> 8);
                S.P1 = (int)(c1 >> 8); S.P2 = (int)(c2 >> 8); S.P3 = (int)(c3 >> 8); S.P4 = (int)(c4 >> 8); S.P5 = (int)(c5 >> 8); S.P6 = (int)(c6 >> 8); S.P7 = (int)(c7 >> 8);
                S.nN = 2 * EDIM / 256; S.gB = (size_t)2 * EDIM * DM; }
            S.nwg = S.nRT * S.nN; S.G = F.G; S.c = (int)blockIdx.x; S.nkt = DM * eb / 128; S.tA = (size_t)256 * DM * eb; S.tB = (size_t)256 * DM * eb;
            CLK_BEG(even ? 2 : 3)
            if (f8) { EpiSwiglu<true> E{(unsigned char*)(even ? pA2 : pA2M), even ? FFN : EDIM, 1.f / (F8_SH * F8_SW)}; for (int rep = 0; rep < REP_MOE; ++rep) pg8::gemm_phase<EpiSwiglu<true>, SchedGroup, true, ALIGN_SWIGLU>(F.lds, d, S, E); }
            else if (F8_DDOWN) { EpiSwiglu<true> E{(unsigned char*)pA2, FFN, 1.f}; for (int rep = 0; rep < REP_MOE; ++rep) pg8::gemm_phase<EpiSwiglu<true>, SchedGroup, false>(F.lds, d, S, E); }
            else { EpiSwiglu<false> E{(unsigned char*)pA2, FFN, 1.f}; for (int rep = 0; rep < REP_MOE; ++rep) pg8::gemm_phase<EpiSwiglu<false>, SchedGroup, false>(F.lds, d, S, E); }
            CLK_END(even ? 2 : 3)
        }
        SEAM();
        if (IN() && PH_ON(9)) { REFRAME();
            const bool f8 = !even || F8_DENSE || F8_DDOWN; const int eb = f8 ? 1 : 2;
            const int Kh = even ? FFN : EDIM; pg8::Dims d{Kh * eb / 2, Kh * eb / 2}; SchedGroup S;
            if (even) { S.A = (const char*)pA2; S.B = (const char*)(WSP + WS_WFFNOUT) + (size_t)j * DM * FFN * eb; S.nRT = RT / 256; S.P1 = S.P2 = S.P3 = S.P4 = S.P5 = S.P6 = S.P7 = 1 << 30; S.gB = 0; }
            else { S.A = (const char*)pA2M; S.B = (const char*)(WSP + WS_WEXPOUT) + (size_t)j * NEXP * DM * EDIM; S.nRT = (int)(c0 >> 8);
                S.P1 = (int)(c1 >> 8); S.P2 = (int)(c2 >> 8); S.P3 = (int)(c3 >> 8); S.P4 = (int)(c4 >> 8); S.P5 = (int)(c5 >> 8); S.P6 = (int)(c6 >> 8); S.P7 = (int)(c7 >> 8);
                S.gB = (size_t)DM * EDIM; }
            S.aE = 0; S.nN = DM / 256; S.nwg = S.nRT * S.nN; S.G = F.G; S.c = (int)blockIdx.x; S.nkt = Kh * eb / 128; S.tA = (size_t)256 * Kh * eb; S.tB = (size_t)256 * Kh * eb;
            if (f8) { EpiStore E{even ? pYO : pHS, DM, 1.f / (F8_SA * F8_SW)}; for (int rep = 0; rep < REP_MOE; ++rep) pg8::gemm_phase<EpiStore, SchedGroup, true>(F.lds, d, S, E); }
            else { EpiStore E{pYO, DM, 1.f}; for (int rep = 0; rep < REP_MOE; ++rep) pg8::gemm_phase<EpiStore, SchedGroup, false>(F.lds, d, S, E); }
        }
        SEAM();
        if (IN() && PH_ON(10)) { REFRAME();
            ThinP P{}; P.nrows = Mrows; P.xin16 = true; P.xout16 = !lastl; P.xin_lat = pX; P.xin_ctx = pX + (size_t)RL * DM;
            if (lastl) P.xout_lat = args.out; else P.xout_lat = pX;
            P.xout_ctx = pX + (size_t)RL * DM; P.ymode = even ? 1 : 2; P.Ysrc = even ? pYO : pHS; P.gate = modl + 5120; P.ga = ng + 3 * DM;
            P.route = pROUTE; P.cnt = F.ctl + CW_CNT + 16 * j;
            if (!lastl) { P.H = pH; P.gb = ng + 4 * DM; P.shsc = modl + 9 * 6144; }
            thin_phase(F, P);
        }
        SEAM();
    }
    if (PROBE_CLK) {
        const unsigned long long dur_ = clk_r ? clk_c * 5000ull / clk_r : 0ull, t0_ = __builtin_amdgcn_s_memrealtime();
        while (__builtin_amdgcn_s_memrealtime() - t0_ < dur_) __builtin_amdgcn_s_sleep(8);
    }
    if (WAITPROBE) {
        unsigned* wsum = F.ctl + 48;
        if (threadIdx.x == 0) __hip_atomic_fetch_add(wsum, (unsigned)wait_acc, __ATOMIC_RELAXED, __HIP_MEMORY_SCOPE_AGENT);
        xcd_barrier(bar);
        const unsigned mean = xb_ld(wsum) / gridDim.x; const unsigned long long t0_ = __builtin_amdgcn_s_memrealtime();
        while (__builtin_amdgcn_s_memrealtime() - t0_ < (unsigned long long)mean * WAITPROBE) __builtin_amdgcn_s_sleep(8);
    }
#undef IN
#undef SEAM
#undef REFRAME
}

#ifndef MK_PER_PHASE
#define MK_PER_PHASE 0
#endif
extern "C" void kernel_launch(void* const* d_in, const int* in_sizes, int n_in, void* d_out, int out_size, void* d_ws, size_t ws_size, hipStream_t stream) {
    static int grid = 0;
    if (grid == 0) {
        if (n_in != 19 || in_sizes[0] != RL * DM || out_size != RL * DM || ws_size < WS_END) {
            fprintf(stderr, "kernel_launch: unexpected shapes / workspace (n_in %d in0 %d out %d ws %zu need %zu)\n", n_in, n_in > 0 ? in_sizes[0] : -1, out_size, ws_size, (size_t)WS_END); grid = -1; return; }
        int dev = 0, cus = 0, per_cu = 0;
        if (hipGetDevice(&dev) != hipSuccess || hipDeviceGetAttribute(&cus, hipDeviceAttributeMultiprocessorCount, dev) != hipSuccess) { grid = -1; return; }
        if (hipFuncSetAttribute((const void*)dit_fwd, hipFuncAttributeMaxDynamicSharedMemorySize, LDS_BYTES) != hipSuccess) { fprintf(stderr, "kernel_launch: hipFuncSetAttribute failed\n"); grid = -1; return; }
        if (hipOccupancyMaxActiveBlocksPerMultiprocessor(&per_cu, (const void*)dit_fwd, 512, LDS_BYTES) != hipSuccess || per_cu < 1)
            fprintf(stderr, "kernel_launch: occupancy query reports %d\n", per_cu);
        (void)hipGetLastError();
        grid = cus;
    }
    if (grid < 0) return;
    if (hipMemsetAsync((char*)d_ws + WS_CTL, 0, CTL_BYTES, stream) != hipSuccess) return;
    Args a{};
    const float** ap = (const float**)&a;
    for (int i = 0; i < 19; ++i) ap[i] = (const float*)d_in[i];
    a.out = (float*)d_out; a.ws = (unsigned char*)d_ws;
#if MK_PER_PHASE
    for (int p = 0; p < NPHASE; ++p) { a.ph_lo = p; a.ph_hi = p + 1; hipLaunchKernelGGL(dit_fwd, dim3(grid), dim3(512), LDS_BYTES, stream, a); }
#else
    a.ph_lo = 0; a.ph_hi = NPHASE;
    hipLaunchKernelGGL(dit_fwd, dim3(grid), dim3(512), LDS_BYTES, stream, a);
#endif
}
```

```cpp
#include <hip/hip_runtime.h>
#include <cstdio>
#include <cstdint>

#ifndef PHMASK
#define PHMASK 0xFFFFFFFFu
#endif
#define PH_ON(i) ((PHMASK >> (i)) & 1u)
#ifndef REP_DIFF
#define REP_DIFF 1
#endif
#ifndef REP_MOE
#define REP_MOE 1
#endif
#ifndef REP_P0
#define REP_P0 1
#endif
#ifndef REP_P0B
#define REP_P0B 1
#endif
#ifndef EXTRA_BARS
#define EXTRA_BARS 0
#endif
#ifndef REP_EPI
#define REP_EPI 1
#endif
#ifndef WAITSEL
#define WAITSEL 0xFFFFu
#endif
#ifndef WAITPROBE
#define WAITPROBE 0
#endif
#ifndef KREP
#define KREP 1
#endif
#ifndef REP_PROJ
#define REP_PROJ 1
#endif
#ifndef REP_FOUR
#define REP_FOUR 1
#endif
#ifndef REP_WIN
#define REP_WIN 1
#endif
#ifndef PROBE_CLK
#define PROBE_CLK 0
#endif
#define LAS __attribute__((address_space(3)))
#define GAS __attribute__((address_space(1)))
typedef unsigned short bf16_t;
typedef short bf16x8 __attribute__((ext_vector_type(8)));
typedef short s16x4 __attribute__((ext_vector_type(4)));
typedef float f32x2 __attribute__((ext_vector_type(2)));
typedef float f32x4 __attribute__((ext_vector_type(4)));
typedef float f32x16 __attribute__((ext_vector_type(16)));
typedef unsigned u32x2 __attribute__((ext_vector_type(2)));
typedef unsigned u32x4 __attribute__((ext_vector_type(4)));
typedef __bf16 bf16x2_t __attribute__((ext_vector_type(2)));
typedef int v8i_t __attribute__((ext_vector_type(8)));

constexpr int DM = 1024, NB = 8, SEQ = 4096, CTX = 256, DEPTH = 4;
constexpr int RL = NB * SEQ, RC = NB * CTX, RT = RL + RC;
constexpr int MIXIN = 1280, FFN = 2816, NEXP = 8, EDIM = 3584;
constexpr int MAXSLOT = 71680;
constexpr float EPS = 1e-6f;
constexpr float LOG2E = 1.4426950408889634f;
constexpr float QK_C = 0.125f * LOG2E;

constexpr size_t MiB = 1u << 20;
constexpr size_t WS_CTL = 0, CTL_BYTES = 32 * 1024;
constexpr size_t WS_MOD = 1 * MiB;
constexpr size_t WS_ROPE = WS_MOD + 900 * 1024;
constexpr size_t WS_WP = WS_ROPE + 8 * 1024;
constexpr size_t WS_ROUTE = 2 * MiB;
constexpr size_t WS_CS = 4 * MiB;
constexpr size_t WS_CSC = 68 * MiB;
constexpr size_t WS_WMIXIN = 72 * MiB;
constexpr size_t WS_WMIXOUT = 77 * MiB;
constexpr size_t WS_WQKV = 81 * MiB;
constexpr size_t WS_WDOUT = 93 * MiB;
constexpr size_t WS_WFFNIN = 97 * MiB;
constexpr size_t WS_WFFNOUT = 119 * MiB;
constexpr size_t WS_WEXPIN = 130 * MiB;
constexpr size_t WS_WEXPOUT = 354 * MiB;
constexpr size_t WS_X = 466 * MiB;
constexpr size_t WS_H = 602 * MiB;
constexpr size_t WS_YO = 670 * MiB;
constexpr size_t WS_RA = 738 * MiB;
constexpr size_t WS_Z = WS_RA;
constexpr size_t WS_VT8 = WS_RA;
constexpr size_t WS_Y = WS_RA + 85 * MiB;
constexpr size_t WS_PQT = WS_RA + 153 * MiB;
constexpr size_t WS_O = WS_RA + 204 * MiB;
constexpr size_t WS_RB = 1010 * MiB;
constexpr size_t WS_A2 = WS_RB;
constexpr size_t WS_QK8 = WS_RB;
constexpr size_t WS_PQTC = WS_RB + 190 * MiB;
constexpr size_t WS_A2M = WS_H;
constexpr size_t WS_HS = 1092 * MiB;
constexpr size_t WS_END = 1364 * MiB;
static_assert(WS_A2M + (size_t)MAXSLOT * EDIM * 2 <= WS_HS, "A2m overlay");
static_assert(WS_HS + (size_t)NEXP * RT * DM <= WS_END && WS_HS + (size_t)MAXSLOT * DM * 2 <= WS_END && WS_PQTC + 64 * MiB <= WS_END, "ws end");

constexpr int CW_TMO = 0;
constexpr int CW_CNT = 64;
constexpr int CW_BAR = 4096;

constexpr int RING_BYTES = 131072;
constexpr int MISC_OFF = RING_BYTES + 320;
constexpr int LDS_BYTES = 147456;

__device__ __forceinline__ unsigned cvtpk(float lo, float hi) { f32x2 v = {lo, hi}; bf16x2_t b = __builtin_convertvector(v, bf16x2_t); return __builtin_bit_cast(unsigned, b); }
#ifndef F8_DENSE
#define F8_DENSE false
#endif
#ifndef F8_DDOWN
#define F8_DDOWN true
#endif
#ifndef F8_FOUR
#define F8_FOUR false
#endif
static_assert(!F8_FOUR, "fp8 Fourier path retired");
constexpr int FP = 4096;
constexpr float F8_SCS = 256.f, F8_SPQ = 8.f;
constexpr float F8_SH = 4.f, F8_SW = 64.f, F8_SA = 4.f;
__device__ __forceinline__ float f8clamp(float v) { return __builtin_amdgcn_fmed3f(v, -448.f, 448.f); }
__device__ __forceinline__ unsigned pk4_fp8(float a, float b, float c, float d) {
    unsigned w = 0; w = __builtin_amdgcn_cvt_pk_fp8_f32(f8clamp(a), f8clamp(b), w, false); w = __builtin_amdgcn_cvt_pk_fp8_f32(f8clamp(c), f8clamp(d), w, true); return w; }
__device__ __forceinline__ float bf_lo(unsigned u) { return __uint_as_float(u << 16); }
__device__ __forceinline__ float bf_hi(unsigned u) { return __uint_as_float(u & 0xffff0000u); }
__device__ __forceinline__ float wave_sum(float v, int lane) {
#pragma unroll
    for (int o = 1; o < 64; o <<= 1) v += __int_as_float(__builtin_amdgcn_ds_bpermute((lane ^ o) << 2, __float_as_int(v)));
    return v;
}
__device__ __forceinline__ unsigned rfl(unsigned v) { return (unsigned)__builtin_amdgcn_readfirstlane((int)v); }
__device__ __forceinline__ const char* uptr(const char* p) {
    unsigned lo = (unsigned)__builtin_amdgcn_readfirstlane((int)(unsigned)(uintptr_t)p), hi = (unsigned)__builtin_amdgcn_readfirstlane((int)(unsigned)((uintptr_t)p >> 32));
    asm volatile("" : "+s"(lo), "+s"(hi));
    return (const char*)(((uintptr_t)hi << 32) | lo);
}
__device__ __forceinline__ GAS unsigned char* gptr(const void* p) {
    unsigned lo = (unsigned)__builtin_amdgcn_readfirstlane((int)(unsigned)(uintptr_t)p), hi = (unsigned)__builtin_amdgcn_readfirstlane((int)(unsigned)((uintptr_t)p >> 32));
    asm volatile("" : "+s"(lo), "+s"(hi));
    return (GAS unsigned char*)(((uintptr_t)hi << 32) | lo);
}
__device__ __forceinline__ int sopaque(int v) { v = __builtin_amdgcn_readfirstlane(v); asm volatile("" : "+s"(v)); return v; }
__device__ __forceinline__ int opaque(int v) { asm volatile("" : "+v"(v)); return v; }
#define LDS_WAIT() asm volatile("s_waitcnt lgkmcnt(0)" ::: "memory")
#define VM_WAIT() asm volatile("s_waitcnt vmcnt(0)" ::: "memory")
#define SBAR() __builtin_amdgcn_sched_barrier(0)

namespace pg8 {
constexpr int BM = 256, BK = 64, HALF = 128, HTB = HALF * BK * 2, STAGE_BYTES = 8 * HTB, NXCD = 8, WGM = 8;
__host__ __device__ __forceinline__ int lds_byte(int r, int c) { const int st = (r >> 4) * 2 + (c >> 5), rr = r & 15, cc = c & 31, ob = rr * 64 + cc * 2; return st * 1024 + (ob ^ (((ob >> 9) & 1) << 5)); }
__host__ __device__ __forceinline__ void stage_rc(int b, int& R, int& C) { const int st = b / 1024, sb = b % 1024, swz = sb ^ (((sb >> 9) & 1) << 5); R = (st >> 1) * 16 + swz / 64; C = (st & 1) * 32 + (swz % 64) / 2; }
__host__ __device__ __forceinline__ int perm32(int rho) { const int n = rho >> 4, i = rho & 15; return 8 * (i >> 2) + 4 * n + (i & 3); }

struct Unit { int pm, pn, e, nkt; };
struct Dims { int lda, ldb; };

__device__ __forceinline__ int xcd_remap(int wgid, int nwg) {
    const int q = nwg / NXCD, r = nwg % NXCD, xcd = wgid % NXCD, off = wgid / NXCD;
    return (xcd < r ? xcd * (q + 1) : r * (q + 1) + (xcd - r) * q) + off;
}

#ifndef ALIGN_SWIGLU
#define ALIGN_SWIGLU true
#endif
#ifndef ALIGN_DEFAULT
#define ALIGN_DEFAULT true
#endif
template <class Epi, class Sched, bool F8 = false, bool ALIGN_EPI = ALIGN_DEFAULT>
__device__ __forceinline__ void gemm_phase(LAS unsigned char* lds, const Dims g, const Sched& S, const Epi& E) {
    const int tid = opaque(threadIdx.x), wid = __builtin_amdgcn_readfirstlane(tid >> 6), lane = tid & 63, wr = wid >> 2, wc = wid & 3, fr = lane & 15, fq = lane >> 4;
    unsigned voffA[2], voffB[2];
#pragma unroll
    for (int i = 0; i < 2; ++i) { int R, C; stage_rc(tid * 16 + i * 8192, R, C); const int Rb = Epi::PERM ? ((R & ~31) + perm32(R & 31)) : R;
        voffA[i] = (unsigned)(R * g.lda + C) * 2u; voffB[i] = (unsigned)(Rb * g.ldb + C) * 2u; }
    const size_t kstep = (size_t)(BK * 2);
    const size_t hstepA = (size_t)HALF * g.lda * 2, hstepB = (size_t)HALF * g.ldb * 2;
    const unsigned ldsw = (unsigned)wid * 1024u;
    const int aoff = lds_byte(wr * 64 + fr, fq * 8), boff = lds_byte(wc * 32 + fr, fq * 8);
#define PG8_SA(b, h) (((b) * 2 + (h)) * HTB)
#define PG8_SB(b, h) ((4 + (b) * 2 + (h)) * HTB)
#define PG8_STAGE(bufoff, gbase, voff) do { _Pragma("unroll") for (int _i = 0; _i < 2; ++_i) \
        __builtin_amdgcn_global_load_lds((const unsigned*)((const char*)(gbase) + (voff)[_i]), (LAS unsigned*)(lds + (bufoff) + ldsw + _i * 8192), 16, 0, 0); } while (0)
#define PG8_LDA(dst, b, h) do { _Pragma("unroll") for (int m = 0; m < 4; ++m) _Pragma("unroll") for (int k = 0; k < 2; ++k) dst[m][k] = *(const LAS bf16x8*)(lds + PG8_SA(b, h) + aoff + m * 2048 + k * 1024); } while (0)
#define PG8_LDB(dst, b, h) do { _Pragma("unroll") for (int n = 0; n < 2; ++n) _Pragma("unroll") for (int k = 0; k < 2; ++k) dst[n][k] = *(const LAS bf16x8*)(lds + PG8_SB(b, h) + boff + n * 2048 + k * 1024); } while (0)
#define PG8_V8(x) __builtin_bit_cast(v8i_t, (x))
#define PG8_MMA(ai, bj, At, Bt) do { __builtin_amdgcn_s_setprio(1); _Pragma("unroll") for (int m = 0; m < 4; ++m) _Pragma("unroll") for (int n = 0; n < 2; ++n) { \
        if constexpr (F8) { struct P2 { bf16x8 a, b; }; const v8i_t a8_ = PG8_V8((P2{Bt[n][0], Bt[n][1]})), b8_ = PG8_V8((P2{At[m][0], At[m][1]})); \
            asm volatile("v_mfma_f32_16x16x128_f8f6f4 %0, %1, %2, %0" : "+v"(acc[ai][bj][m][n]) : "v"(a8_), "v"(b8_)); }   \
        else { _Pragma("unroll") for (int k = 0; k < 2; ++k) acc[ai][bj][m][n] = __builtin_amdgcn_mfma_f32_16x16x32_bf16(Bt[n][k], At[m][k], acc[ai][bj][m][n], 0, 0, 0); } } \
        __builtin_amdgcn_s_setprio(0); } while (0)
#define PG8_WAIT_V(n) asm volatile("s_waitcnt vmcnt(" #n ")" ::: "memory")
#define PG8_WAIT_L(n) asm volatile("s_waitcnt lgkmcnt(" #n ")" ::: "memory")
#define PG8_BAR __builtin_amdgcn_s_barrier()
#define PG8_SCHED __builtin_amdgcn_sched_barrier(0)
    Unit cur, nxt; int ui = 0;
    if (!S.next(0, cur)) return;
    constexpr bool MIR = Sched::MIRROR;
    unsigned vB2c[2] = {0u, 0u}, vB2n[2] = {0u, 0u}; const char* cB2 = nullptr; const char* nB2 = nullptr;
#define PG8_MKV2(dst, un) do { const int t2_ = opaque(threadIdx.x); _Pragma("unroll") for (int i_ = 0; i_ < 2; ++i_) { int R_, C_; stage_rc(t2_ * 16 + i_ * 8192, R_, C_); \
        const int Rb_ = Epi::PERM ? ((R_ & ~31) + perm32(R_ & 31)) : R_; dst[i_] = S.voff2(un, Rb_, C_, g.ldb); } } while (0)
    if constexpr (MIR) { PG8_MKV2(vB2c, cur); cB2 = uptr(S.bptr2(cur)); }
    f32x4 acc[2][2][4][2];
#pragma unroll
    for (int a = 0; a < 2; ++a)
#pragma unroll
        for (int b = 0; b < 2; ++b)
#pragma unroll
            for (int m = 0; m < 4; ++m)
#pragma unroll
                for (int n = 0; n < 2; ++n) acc[a][b][m][n] = (f32x4){0.f, 0.f, 0.f, 0.f};
    bf16x8 At[4][2], B0[2][2], B1[2][2];
    const char* cA = uptr(S.aptr(cur)); const char* cB = uptr(S.bptr(cur));
    PG8_STAGE(PG8_SB(0, 0), cB, voffB); if constexpr (MIR) PG8_STAGE(PG8_SB(0, 1), cB2, vB2c); else PG8_STAGE(PG8_SB(0, 1), cB + hstepB, voffB); PG8_STAGE(PG8_SA(0, 0), cA, voffA); PG8_STAGE(PG8_SA(0, 1), cA + hstepA, voffA);
    if (wr == 1) PG8_BAR;
    PG8_WAIT_V(2); PG8_BAR;
    PG8_STAGE(PG8_SB(1, 0), cB + kstep, voffB); PG8_STAGE(PG8_SA(1, 0), cA + kstep, voffA); if constexpr (MIR) PG8_STAGE(PG8_SB(1, 1), cB2 + kstep, vB2c); else PG8_STAGE(PG8_SB(1, 1), cB + hstepB + kstep, voffB);
    PG8_WAIT_V(6); PG8_BAR;
    for (;;) {
        const bool has_next = S.next(ui + 1, nxt);
        const char* nA = uptr(has_next ? S.aptr(nxt) : cA); const char* nB = uptr(has_next ? S.bptr(nxt) : cB);
        if constexpr (MIR) { if (has_next) { PG8_MKV2(vB2n, nxt); nB2 = uptr(S.bptr2(nxt)); } else { vB2n[0] = vB2c[0]; vB2n[1] = vB2c[1]; nB2 = cB2; } }
        const int nt = sopaque(cur.nkt);
        for (int t = 0; t < KREP * nt; t += 2) {
            const bool last = (t == KREP * nt - 2);
            const char* a1 = cA + (size_t)(KREP == 1 ? t + 1 : (t + 1) % nt) * kstep;
            const char* a2 = last ? nA : cA + (size_t)(KREP == 1 ? t + 2 : (t + 2) % nt) * kstep; const char* b2 = last ? nB : cB + (size_t)(KREP == 1 ? t + 2 : (t + 2) % nt) * kstep;
            const char* a3 = a2 + kstep; const char* b3 = b2 + kstep;
            const char* m2 = nullptr; unsigned vm[2] = {0u, 0u};
            if constexpr (MIR) { m2 = last ? nB2 : cB2 + (size_t)(t + 2) * kstep; vm[0] = last ? vB2n[0] : vB2c[0]; vm[1] = last ? vB2n[1] : vB2c[1]; }
            PG8_LDB(B0, 0, 0); PG8_LDB(B1, 0, 1); PG8_SCHED; PG8_LDA(At, 0, 0); PG8_STAGE(PG8_SA(1, 1), a1 + hstepA, voffA);
            PG8_WAIT_V(8); PG8_WAIT_L(0); PG8_BAR; PG8_MMA(0, 0, At, B0); PG8_MMA(0, 1, At, B1); PG8_BAR; PG8_SCHED;
            PG8_LDA(At, 0, 1); PG8_STAGE(PG8_SB(0, 0), b2, voffB); if constexpr (MIR) PG8_STAGE(PG8_SB(0, 1), m2, vm); else PG8_STAGE(PG8_SB(0, 1), b2 + hstepB, voffB); PG8_STAGE(PG8_SA(0, 0), a2, voffA);
            PG8_WAIT_V(8); PG8_WAIT_L(0); PG8_BAR; PG8_MMA(1, 0, At, B0); PG8_MMA(1, 1, At, B1); PG8_BAR; PG8_SCHED;
            PG8_LDB(B0, 1, 0); PG8_LDB(B1, 1, 1); PG8_SCHED; PG8_LDA(At, 1, 0); PG8_STAGE(PG8_SA(0, 1), a2 + hstepA, voffA);
            PG8_WAIT_V(8); PG8_WAIT_L(0); PG8_BAR; PG8_MMA(0, 0, At, B0); PG8_MMA(0, 1, At, B1); PG8_BAR; PG8_SCHED;
            PG8_LDA(At, 1, 1); PG8_STAGE(PG8_SB(1, 0), b3, voffB); if constexpr (MIR) PG8_STAGE(PG8_SB(1, 1), m2 + kstep, vm); else PG8_STAGE(PG8_SB(1, 1), b3 + hstepB, voffB); PG8_STAGE(PG8_SA(1, 0), a3, voffA);
            PG8_WAIT_V(8); PG8_WAIT_L(0); PG8_BAR; PG8_MMA(1, 0, At, B0); PG8_MMA(1, 1, At, B1); PG8_BAR; PG8_SCHED;
        }
        if constexpr (ALIGN_EPI) { if (wr == 0) PG8_BAR; }
        if constexpr (F8) asm volatile("s_nop 15\n\ts_nop 15" ::: "memory");
        for (int repe = 0; repe < REP_EPI; ++repe) { const int l2 = opaque(threadIdx.x) & 63; E(acc, cur, wr, wc, l2 & 15, l2 >> 4); }
        if (!has_next) break;
#pragma unroll
        for (int a = 0; a < 2; ++a)
#pragma unroll
            for (int b = 0; b < 2; ++b)
#pragma unroll
                for (int m = 0; m < 4; ++m)
#pragma unroll
                    for (int n = 0; n < 2; ++n) acc[a][b][m][n] = (f32x4){0.f, 0.f, 0.f, 0.f};
        cur = nxt; cA = nA; cB = nB; ++ui;
        if constexpr (MIR) { cB2 = nB2; vB2c[0] = vB2n[0]; vB2c[1] = vB2n[1]; }
        if constexpr (ALIGN_EPI) { if (wr == 1) PG8_BAR; }
    }
    PG8_WAIT_V(0);
    if constexpr (!ALIGN_EPI) { if (wr == 0) PG8_BAR; }
    PG8_BAR;
#undef PG8_MKV2
#undef PG8_SA
#undef PG8_SB
#undef PG8_STAGE
#undef PG8_LDA
#undef PG8_LDB
#undef PG8_MMA
#undef PG8_V8
#undef PG8_WAIT_V
#undef PG8_WAIT_L
#undef PG8_BAR
#undef PG8_SCHED
}
}
using pg8::Unit;

struct EpiStore {
    static constexpr bool PERM = true;
    bf16_t* O; int ldc; float scale;
    __device__ __forceinline__ void operator()(const f32x4 (&acc)[2][2][4][2], const Unit& u, int wr, int wc, int fr, int fq) const {
        const int row0 = u.pm * 256 + wr * 64 + fr, col0 = u.pn * 256 + wc * 32 + 8 * fq;
#pragma unroll
        for (int ai = 0; ai < 2; ++ai)
#pragma unroll
            for (int m = 0; m < 4; ++m) { bf16_t* rowp = O + (size_t)(row0 + ai * 128 + m * 16) * ldc + col0;
#pragma unroll
                for (int bj = 0; bj < 2; ++bj) { const f32x4 v0 = acc[ai][bj][m][0] * (scale * (1.f / KREP)), v1 = acc[ai][bj][m][1] * (scale * (1.f / KREP));
                    u32x4 w; w.x = cvtpk(v0[0], v0[1]); w.y = cvtpk(v0[2], v0[3]); w.z = cvtpk(v1[0], v1[1]); w.w = cvtpk(v1[2], v1[3]);
                    *(u32x4*)(rowp + bj * 128) = w; } }
    }
};
template <bool F8OUT> struct EpiSwiglu {
    static constexpr bool PERM = true;
    unsigned char* O; int ldc; float scale;
    __device__ __forceinline__ void operator()(const f32x4 (&acc)[2][2][4][2], const Unit& u, int wr, int wc, int fr, int fq) const {
        const int row0 = u.pm * 256 + wr * 64 + fr, col0 = u.pn * 128 + wc * 32 + 8 * fq;
        const float us = F8OUT ? scale * F8_SA : scale;
        const float k1 = -scale * LOG2E * (1.f / KREP), ik2 = 1.f / (scale * us * (1.f / KREP) * (1.f / KREP));
#pragma unroll
        for (int ai = 0; ai < 2; ++ai)
#pragma unroll
            for (int m = 0; m < 4; ++m) { unsigned char* rowp = O + ((size_t)(row0 + ai * 128 + m * 16) * ldc + col0) * (F8OUT ? 1 : 2);
                float r[8];
#pragma unroll
                for (int n = 0; n < 2; ++n) { const f32x4 g = acc[ai][0][m][n], u = acc[ai][1][m][n]; const f32x4 t = g * k1;
                    f32x4 e; e[0] = __builtin_amdgcn_exp2f(t[0]); e[1] = __builtin_amdgcn_exp2f(t[1]); e[2] = __builtin_amdgcn_exp2f(t[2]); e[3] = __builtin_amdgcn_exp2f(t[3]);
                    const f32x4 d = e * ik2 + ik2;
                    f32x4 q; q[0] = __builtin_amdgcn_rcpf(d[0]); q[1] = __builtin_amdgcn_rcpf(d[1]); q[2] = __builtin_amdgcn_rcpf(d[2]); q[3] = __builtin_amdgcn_rcpf(d[3]);
                    const f32x4 o = (g * u) * q; r[n * 4 + 0] = o[0]; r[n * 4 + 1] = o[1]; r[n * 4 + 2] = o[2]; r[n * 4 + 3] = o[3]; }
                if constexpr (F8OUT) { u32x2 w; w.x = pk4_fp8(r[0], r[1], r[2], r[3]); w.y = pk4_fp8(r[4], r[5], r[6], r[7]); *(u32x2*)rowp = w; }
                else { u32x4 w; w.x = cvtpk(r[0], r[1]); w.y = cvtpk(r[2], r[3]); w.z = cvtpk(r[4], r[5]); w.w = cvtpk(r[6], r[7]); *(u32x4*)rowp = w; } }
    }
};
template <bool ODD> struct EpiRope {
    static constexpr bool PERM = false;
    unsigned char* ws;
    static constexpr int ldc = ODD ? 3072 : MIXIN, rlo = ODD ? 0 : 4, rhi = ODD ? 16 : 9, qlo = ODD ? 0 : 4, qhi = 8, f8hi = ODD ? 16 : 0;
    __device__ __forceinline__ void operator()(const f32x4 (&acc)[2][2][4][2], const Unit& u, int wr, int wc, int fr, int fq) const {
        const float ascale = ODD ? 1.f / (F8_SH * F8_SW) : 1.f, qscale = QK_C;
        bf16_t* O = (bf16_t*)(ws + WS_Z); const f32x2* cs = (const f32x2*)(ws + WS_ROPE); unsigned char* O8 = ws + WS_QK8;
        const int row0 = u.pm * 256 + wr * 64 + fr, col0 = u.pn * 256 + wc * 32 + 4 * fq;
        const bool lat = u.pm < 128;
#pragma unroll
        for (int ai = 0; ai < 2; ++ai)
#pragma unroll
            for (int m = 0; m < 4; ++m) { const int row = row0 + ai * 128 + m * 16; bf16_t* rowp = O + (size_t)row * ldc + col0;
                const int t = row & 4095, pos = (wc & 1) ? (t & 63) : (t >> 6);
                const f32x2* c4 = cs + pos * 16 + 4 * fq;
                const f32x2 c0 = c4[0], c1 = c4[1], c2 = c4[2], c3 = c4[3];
#pragma unroll
                for (int bj = 0; bj < 2; ++bj) { f32x4 p1 = acc[ai][bj][m][0] * (ascale * (1.f / KREP)), p2 = acc[ai][bj][m][1] * (ascale * (1.f / KREP));
                    const int blk = u.pn * 2 + bj;
                    if (lat && blk >= rlo && blk < rhi) {
                        const f32x4 cv = {c0.x, c1.x, c2.x, c3.x}, sv = {c0.y, c1.y, c2.y, c3.y};
                        const f32x4 o1 = p1 * cv - p2 * sv, o2 = p2 * cv + p1 * sv; p1 = o1; p2 = o2; }
                    if (blk >= qlo && blk < qhi) { p1 = p1 * qscale; p2 = p2 * qscale; }
                    if (ODD) { unsigned char* r8 = O8 + (size_t)row * 2048 + col0 + bj * 128;
                        *(unsigned*)r8 = pk4_fp8(p1[0], p1[1], p1[2], p1[3]); *(unsigned*)(r8 + 16) = pk4_fp8(p2[0], p2[1], p2[2], p2[3]); }
                    else { u32x2 w1, w2; w1.x = cvtpk(p1[0], p1[1]); w1.y = cvtpk(p1[2], p1[3]); w2.x = cvtpk(p2[0], p2[1]); w2.y = cvtpk(p2[2], p2[3]);
                        *(u32x2*)(rowp + bj * 128) = w1; *(u32x2*)(rowp + bj * 128 + 16) = w2; } } }
    }
};
struct EpiVt {
    static constexpr bool PERM = true;
    unsigned char* ws;
    __device__ __forceinline__ void operator()(const f32x4 (&acc)[2][2][4][2], const Unit& u, int wr, int wc, int fr, int fq) const {
        unsigned char* Vt = ws + WS_VT8; const float scale = 1.f / (F8_SH * F8_SW);
        const bool ctx = u.pn >= 128; const int b = ctx ? u.pn - 128 : u.pn >> 4, kt0 = ctx ? 0 : 4 + (u.pn & 15) * 4;
#pragma unroll
        for (int ai = 0; ai < 2; ++ai)
#pragma unroll
            for (int m = 0; m < 4; ++m) { const int d = wr * 64 + m * 16 + fr;
                unsigned char* tb = Vt + ((size_t)(b * 8 + u.pm * 2 + ai) * 68 + kt0) * 8192 + d * 64;
#pragma unroll
                for (int bj = 0; bj < 2; ++bj) { const int c = bj * 128 + wc * 32 + 8 * fq, s0 = c & 63;
                    const f32x4 v0 = acc[ai][bj][m][0] * (scale * (1.f / KREP)), v1 = acc[ai][bj][m][1] * (scale * (1.f / KREP));
                    u32x2 w; w.x = pk4_fp8(v0[0], v0[1], v0[2], v0[3]); w.y = pk4_fp8(v1[0], v1[1], v1[2], v1[3]);
                    *(u32x2*)(tb + (c >> 6) * 8192 + ((((s0 >> 4) ^ (d >> 2)) & 3) << 4) + (s0 & 15)) = w; } }
    }
};
struct EpiPQt {
    static constexpr bool PERM = true;
    bf16_t* Plat; bf16_t* Pctx;
    __device__ __forceinline__ void operator()(const f32x4 (&acc)[2][2][4][2], const Unit& u, int wr, int wc, int fr, int fq) const {
        const bool ctx = u.e >= 32; const int bg = ctx ? u.e - 32 : u.e;
        bf16_t* base = (ctx ? Pctx : Plat) + (size_t)bg * 128 * FP;
        if (ctx) {
            const int col0 = wc * 32 + 8 * fq;
#pragma unroll
            for (int ai = 0; ai < 2; ++ai)
#pragma unroll
                for (int m = 0; m < 4; ++m) { bf16_t* rowp = base + (size_t)(wr * 64 + m * 16 + fr) * FP + ai * CTX + col0;
#pragma unroll
                    for (int bj = 0; bj < 2; ++bj) { const f32x4 v0 = acc[ai][bj][m][0] * (1.f / KREP), v1 = acc[ai][bj][m][1] * (1.f / KREP);
                        u32x4 w; w.x = cvtpk(v0[0], v0[1]); w.y = cvtpk(v0[2], v0[3]); w.z = cvtpk(v1[0], v1[1]); w.w = cvtpk(v1[2], v1[3]); *(u32x4*)(rowp + bj * 128) = w; } }
        } else {
            const int col0 = u.pn * 128 + wc * 32 + 8 * fq;
            const bool sp = u.pn == 0 && wc == 0 && fq == 0;
#pragma unroll
            for (int m = 0; m < 4; ++m) { bf16_t* rowp = base + (size_t)(wr * 64 + m * 16 + fr) * FP + col0;
                f32x4 p0 = (acc[0][0][m][0] + acc[0][1][m][0]) * (1.f / KREP), p1 = (acc[0][0][m][1] + acc[0][1][m][1]) * (1.f / KREP);
                f32x4 q0 = (acc[1][0][m][0] - acc[1][1][m][0]) * (1.f / KREP), q1 = (acc[1][0][m][1] - acc[1][1][m][1]) * (1.f / KREP);
                if (sp) { p0[0] = acc[0][0][m][0][0] * (1.f / KREP); q0[0] = acc[0][1][m][0][0] * (1.f / KREP); }
                u32x4 w; w.x = cvtpk(p0[0], p0[1]); w.y = cvtpk(p0[2], p0[3]); w.z = cvtpk(p1[0], p1[1]); w.w = cvtpk(p1[2], p1[3]); *(u32x4*)rowp = w;
                w.x = cvtpk(q0[0], q0[1]); w.y = cvtpk(q0[2], q0[3]); w.z = cvtpk(q1[0], q1[1]); w.w = cvtpk(q1[2], q1[3]); *(u32x4*)(rowp + 2048) = w; }
        }
    }
};
struct EpiFour2 {
    static constexpr bool PERM = true;
    bf16_t* O;
    __device__ __forceinline__ void operator()(const f32x4 (&acc)[2][2][4][2], const Unit& u, int wr, int wc, int fr, int fq) const {
        EpiStore s{O, DM, (u.pm < 128 ? 0.0013810679320049757f   : 0.005524271728019903f  )};
        s(acc, u, wr, wc, fr, fq);
    }
};

struct SchedDense {
    static constexpr bool MIRROR = false;
    const char* A; const char* B; int nM, nN, nwg, G, c, nkt; size_t tA, tB;
    __device__ __forceinline__ void init(const void* A_, int lda, const void* B_, int ldb, int M, int N, int K, int G_, int c_) {
        A = (const char*)A_; B = (const char*)B_; nM = M / 256; nN = N / 256; nwg = nM * nN; G = G_; c = c_; nkt = K / 64; tA = (size_t)256 * lda * 2; tB = (size_t)256 * ldb * 2; }
    __device__ __forceinline__ bool next(int i, Unit& u) const {
        const long L = (long)i * G + c; if (L >= nwg) return false;
        const int wgid = pg8::xcd_remap((int)L, nwg);
        const int nig = pg8::WGM * nN, gid = wgid / nig, fm = gid * pg8::WGM, gsz = (nM - fm) < pg8::WGM ? (nM - fm) : pg8::WGM;
        u.pm = fm + ((wgid % nig) % gsz); u.pn = (wgid % nig) / gsz; u.e = 0; u.nkt = nkt; return true;
    }
    __device__ __forceinline__ const char* aptr(const Unit& u) const { return A + (size_t)u.pm * tA; }
    __device__ __forceinline__ const char* bptr(const Unit& u) const { return B + (size_t)u.pn * tB; }
};
struct SchedGroup {
    static constexpr bool MIRROR = false;
    const char* A; const char* B; int P1, P2, P3, P4, P5, P6, P7, nRT, nN, nwg, G, c, nkt; size_t tA, tB, gB, aE;
    __device__ __forceinline__ bool next(int i, Unit& u) const {
        const long L = (long)i * G + c; if (L >= nwg) return false;
        const int wgid = pg8::xcd_remap((int)L, nwg);
        const int nig = pg8::WGM * nN, gid = wgid / nig, fm = gid * pg8::WGM, gsz = (nRT - fm) < pg8::WGM ? (nRT - fm) : pg8::WGM;
        const int rt = fm + ((wgid % nig) % gsz);
        u.pm = rt; u.pn = (wgid % nig) / gsz; u.nkt = nkt;
        u.e = (rt >= P1) + (rt >= P2) + (rt >= P3) + (rt >= P4) + (rt >= P5) + (rt >= P6) + (rt >= P7); return true;
    }
    __device__ __forceinline__ const char* aptr(const Unit& u) const {
        if (aE == 0) return A + (size_t)u.pm * tA;
        const int pe = u.e == 0 ? 0 : u.e == 1 ? P1 : u.e == 2 ? P2 : u.e == 3 ? P3 : u.e == 4 ? P4 : u.e == 5 ? P5 : u.e == 6 ? P6 : P7;
        return A + (size_t)u.e * aE + (size_t)(u.pm - pe) * tA; }
    __device__ __forceinline__ const char* bptr(const Unit& u) const { return B + (size_t)u.e * gB + (size_t)u.pn * tB; }
};
struct SchedF1 {
    static constexpr bool MIRROR = true;
    const char* Wp; const char* Z; int G, c;
    __device__ __forceinline__ bool next(int i, Unit& u) const {
        const int L = i * G + c; if (L >= 544) return false;
        u.pm = 0; u.nkt = 2;
        if (L < 512) { u.e = L >> 4; u.pn = L & 15; } else { u.e = 32 + (L - 512); u.pn = 0; }
        return true;
    }
    __device__ __forceinline__ const char* aptr(const Unit&) const { return Wp; }
    __device__ __forceinline__ const char* bptr(const Unit& u) const {
        const bool ctx = u.e >= 32; const int bg = ctx ? u.e - 32 : u.e, b = bg >> 2, gq = bg & 3;
        const size_t row0 = ctx ? (size_t)RL + b * CTX : (size_t)b * SEQ + u.pn * 128;
        return Z + (row0 * MIXIN + gq * 128) * 2; }
    __device__ __forceinline__ const char* bptr2(const Unit& u) const {
        const bool ctx = u.e >= 32; const int bg = ctx ? u.e - 32 : u.e, b = bg >> 2, gq = bg & 3;
        const size_t row0 = ctx ? (size_t)RL + b * CTX + 128 : (size_t)b * SEQ;
        return Z + (row0 * MIXIN + gq * 128) * 2; }
    __device__ __forceinline__ unsigned voff2(const Unit& u, int R, int C, int ldb) const {
        const int tok = u.e >= 32 ? R : (u.pn == 0 && R == 0) ? 2048 : 4096 - 128 * u.pn - R;
        return (unsigned)(tok * ldb + C) * 2u; }
};
struct SchedF2 {
    static constexpr bool MIRROR = false;
    const char* CSl; const char* CSc; const char* Plat; const char* Pctx; int G, vcu;
    static constexpr size_t EB = 2;
    __device__ __forceinline__ bool next(int i, Unit& u) const {
        const int L = i * G + vcu; if (L >= 272) return false;
        if (L < 256) { const int b = L >> 5, mt = (L & 31) >> 1; u.pm = b * 16 + mt; u.pn = L & 1; u.e = b; u.nkt = 64; }
        else { const int b = (L - 256) >> 1; u.pm = 128 + b; u.pn = L & 1; u.e = 8 + b; u.nkt = 8; }
        return true;
    }
    __device__ __forceinline__ const char* aptr(const Unit& u) const { return u.e < 8 ? CSl + (size_t)(u.pm & 15) * 256 * FP * EB : CSc; }
    __device__ __forceinline__ const char* bptr(const Unit& u) const { return (u.e < 8 ? Plat + (size_t)u.e * 512 * FP * EB : Pctx + (size_t)(u.e - 8) * 512 * FP * EB) + (size_t)u.pn * 256 * FP * EB; }
};

#define XB_TMO      128
#define XB_XCNT(j)  (256  + 64 * (j))
#define XB_XSUB(j)  (1280 + 64 * (j))
#define XB_XGEN(j)  (2304 + 64 * (j))
#define XB_TOP      3328
#define XB_TOPGEN   3392
#define XCD_BAR_WORDS 3456
#define XB_SPIN_CAP (1u << 21)
__device__ __forceinline__ unsigned xb_ld(unsigned* p)              { return __hip_atomic_load(p, __ATOMIC_RELAXED, __HIP_MEMORY_SCOPE_AGENT); }
__device__ __forceinline__ unsigned xb_add(unsigned* p, unsigned v) { return __hip_atomic_fetch_add(p, v, __ATOMIC_RELAXED, __HIP_MEMORY_SCOPE_AGENT); }
__device__ __forceinline__ unsigned xb_xcc_id() { return (unsigned)__builtin_amdgcn_s_getreg((3 << 11) | 20) & 0xFu; }
#define XB_SPIN(cond, bar) do { unsigned _sp = 0; while (cond) { __builtin_amdgcn_s_sleep(1); \
    if ((++_sp & 255u) == 0u) { if (xb_ld(&(bar)[XB_TMO])) break; if (_sp > XB_SPIN_CAP) { atomicAdd(&(bar)[XB_TMO], 1u); break; } } } } while (0)
struct XcdBarrier { unsigned* bar; unsigned x; volatile LAS unsigned* st; };
__device__ __forceinline__ XcdBarrier xcd_barrier_post(unsigned* bar, volatile LAS unsigned* st) {
    XcdBarrier b; b.bar = bar; b.x = xb_xcc_id(); b.st = st;
    if (threadIdx.x == 0) (void)xb_add(&bar[XB_XCNT(b.x)], 1u);
    return b;
}
__device__ __forceinline__ void xcd_barrier_complete(unsigned* bar, unsigned x, unsigned& nloc, unsigned& nx) {
    const unsigned G = gridDim.x * gridDim.y * gridDim.z;
    unsigned sum, cnt, mine, sp = 0u;
    for (;;) {
        sum = 0u; cnt = 0u; mine = 0u;
#pragma unroll
        for (unsigned j = 0; j < 16; ++j) { const unsigned c = xb_ld(&bar[XB_XCNT(j)]); sum += c; cnt += (c > 0u) ? 1u : 0u; mine = (j == x) ? c : mine; }
        if (sum == G) break;
        __builtin_amdgcn_s_sleep(1);
        if ((++sp & 255u) == 0u) { if (xb_ld(&bar[XB_TMO])) break; if (sp > XB_SPIN_CAP) { atomicAdd(&bar[XB_TMO], 1u); break; } }
    }
    nloc = mine > 0u ? mine : 1u; nx = cnt > 0u ? cnt : 1u;
}
__device__ __forceinline__ void xcd_barrier(const XcdBarrier& b) {
    asm volatile("s_waitcnt vmcnt(0)" ::: "memory");
    __syncthreads();
    if (threadIdx.x == 0) {
        unsigned* bar = (unsigned*)uptr((const char*)b.bar);
        __builtin_amdgcn_s_waitcnt(0);
        unsigned nloc = b.st[0], nx = b.st[1];
        if (nloc == 0u) { xcd_barrier_complete(bar, b.x, nloc, nx); b.st[0] = nloc; b.st[1] = nx; }
        const unsigned old = xb_add(&bar[XB_XSUB(b.x)], 1u);
        const unsigned gen = old / nloc;
        if (old + 1u == (gen + 1u) * nloc) {
            __builtin_amdgcn_fence(__ATOMIC_RELEASE, "agent");
            asm volatile("s_waitcnt vmcnt(0)" ::: "memory");
            const unsigned og = xb_add(&bar[XB_TOP], 1u);
            const unsigned tg = og / nx;
            if (og + 1u == (tg + 1u) * nx) xb_add(&bar[XB_TOPGEN], 1u);
            else XB_SPIN(xb_ld(&bar[XB_TOPGEN]) == tg, bar);
            __builtin_amdgcn_fence(__ATOMIC_ACQUIRE, "agent");
            xb_add(&bar[XB_XGEN(b.x)], 1u);
            asm volatile("s_waitcnt vmcnt(0)" ::: "memory");
        } else {
            XB_SPIN(xb_ld(&bar[XB_XGEN(b.x)]) == gen, bar);
            __builtin_amdgcn_fence(__ATOMIC_ACQUIRE, "agent");
            asm volatile("s_waitcnt vmcnt(0)" ::: "memory");
        }
    }
    __syncthreads();
}

__device__ __forceinline__ int crow(int r, int hi) { return (r & 3) + 8 * (r >> 2) + 4 * hi; }
template <int KW> __device__ __forceinline__ int kswz(int row, int colB) { return KW == 128 ? row * 256 + (colB ^ ((row & 7) << 4)) : row * 128 + (colB ^ (((row >> 1) & 7) << 4)); }
template <int DV> __device__ __forceinline__ int v_st(int k, int c) { const int kk = (k & ~0xC) | ((k & 4) << 1) | ((k & 8) >> 1); return ((kk >> 3) * (DV / 32) + (c >> 5)) * 512 + ((kk & 7) * 32 + (c & 31)) * 2; }
__device__ __forceinline__ int v_rd_base(int lane) { return ((lane & 3) << 3) | (((lane >> 2) & 3) << 6) | (((lane >> 4) & 1) << 5) | (((lane >> 5) & 1) << 8); }
template <int OFF> __device__ __forceinline__ s16x4 tr_read(int vb) { s16x4 r; asm volatile("ds_read_b64_tr_b16 %0, %1 offset:%2" : "=&v"(r) : "v"(vb), "i"(OFF) : "memory"); return r; }
template <int DV, int D0> __device__ __forceinline__ void pv_one(f32x16& od, int vb, bf16x8 pa0, bf16x8 pa1, bf16x8 pa2, bf16x8 pa3) {
    constexpr int KS = (DV / 32) * 1024, HF = (DV / 32) * 512;
    const s16x4 l0 = tr_read<D0 * 512 + 0 * KS>(vb), h0 = tr_read<D0 * 512 + 0 * KS + HF>(vb), l1 = tr_read<D0 * 512 + 1 * KS>(vb), h1 = tr_read<D0 * 512 + 1 * KS + HF>(vb);
    const s16x4 l2 = tr_read<D0 * 512 + 2 * KS>(vb), h2 = tr_read<D0 * 512 + 2 * KS + HF>(vb), l3 = tr_read<D0 * 512 + 3 * KS>(vb), h3 = tr_read<D0 * 512 + 3 * KS + HF>(vb);
    asm volatile("s_waitcnt lgkmcnt(0)" ::: "memory"); SBAR();
#define PKV(L, H) (bf16x8){L[0], L[1], L[2], L[3], H[0], H[1], H[2], H[3]}
    od = __builtin_amdgcn_mfma_f32_32x32x16_bf16(pa0, PKV(l0, h0), od, 0, 0, 0);
    od = __builtin_amdgcn_mfma_f32_32x32x16_bf16(pa1, PKV(l1, h1), od, 0, 0, 0);
    od = __builtin_amdgcn_mfma_f32_32x32x16_bf16(pa2, PKV(l2, h2), od, 0, 0, 0);
    od = __builtin_amdgcn_mfma_f32_32x32x16_bf16(pa3, PKV(l3, h3), od, 0, 0, 0);
#undef PKV
}
#define PV_RD(D0, L, H) do { L[0] = tr_read<(D0) * 512 + 0 * KS>(vb); H[0] = tr_read<(D0) * 512 + 0 * KS + HF>(vb); L[1] = tr_read<(D0) * 512 + 1 * KS>(vb); H[1] = tr_read<(D0) * 512 + 1 * KS + HF>(vb); \
    L[2] = tr_read<(D0) * 512 + 2 * KS>(vb); H[2] = tr_read<(D0) * 512 + 2 * KS + HF>(vb); L[3] = tr_read<(D0) * 512 + 3 * KS>(vb); H[3] = tr_read<(D0) * 512 + 3 * KS + HF>(vb); } while (0)
#define PV_MM(od, L, H) do { od = __builtin_amdgcn_mfma_f32_32x32x16_bf16(pa0, PKV(L[0], H[0]), od, 0, 0, 0); od = __builtin_amdgcn_mfma_f32_32x32x16_bf16(pa1, PKV(L[1], H[1]), od, 0, 0, 0); \
    od = __builtin_amdgcn_mfma_f32_32x32x16_bf16(pa2, PKV(L[2], H[2]), od, 0, 0, 0); od = __builtin_amdgcn_mfma_f32_32x32x16_bf16(pa3, PKV(L[3], H[3]), od, 0, 0, 0); } while (0)
#define PKV(L, H) (bf16x8){L[0], L[1], L[2], L[3], H[0], H[1], H[2], H[3]}
template <int DV> __device__ __forceinline__ void pv_all(f32x16* o, int vb, bf16x8 pa0, bf16x8 pa1, bf16x8 pa2, bf16x8 pa3) {
    constexpr int KS = (DV / 32) * 1024, HF = (DV / 32) * 512;
    s16x4 la[4], ha[4], lb[4], hb[4];
    PV_RD(0, la, ha);
    PV_RD(1, lb, hb); asm volatile("s_waitcnt lgkmcnt(8)" ::: "memory"); SBAR(); PV_MM(o[0], la, ha);
    if constexpr (DV == 128) {
        PV_RD(2, la, ha); asm volatile("s_waitcnt lgkmcnt(8)" ::: "memory"); SBAR(); PV_MM(o[1], lb, hb);
        PV_RD(3, lb, hb); asm volatile("s_waitcnt lgkmcnt(8)" ::: "memory"); SBAR(); PV_MM(o[2], la, ha);
        asm volatile("s_waitcnt lgkmcnt(0)" ::: "memory"); SBAR(); PV_MM(o[3], lb, hb);
    } else {
        asm volatile("s_waitcnt lgkmcnt(0)" ::: "memory"); SBAR(); PV_MM(o[1], lb, hb);
    }
}
#undef PV_RD
#undef PV_MM
#undef PKV
template <int KW> __device__ __forceinline__ void qkt64(f32x16& p0, f32x16& p1, const char* Ks, const bf16x8* qr, int kcb, int r32, int hi) {
    bf16x8 kb0[4], kb1[4];
#pragma unroll
    for (int d0 = 0; d0 < 4; ++d0) { const int cb = kcb + (d0 * 16 + hi * 8) * 2;
        kb0[d0] = *reinterpret_cast<const bf16x8*>(Ks + kswz<KW>(r32, cb));
        kb1[d0] = *reinterpret_cast<const bf16x8*>(Ks + kswz<KW>(32 + r32, cb)); }
    p0 = f32x16{}; p1 = f32x16{};
#pragma unroll
    for (int d0 = 0; d0 < 4; ++d0) {
        p0 = __builtin_amdgcn_mfma_f32_32x32x16_bf16(kb0[d0], qr[d0], p0, 0, 0, 0);
        p1 = __builtin_amdgcn_mfma_f32_32x32x16_bf16(kb1[d0], qr[d0], p1, 0, 0, 0); }
}
__device__ __forceinline__ void qkt64_f8(f32x16& p0, f32x16& p1, const char* Ks, v8i_t qf, int g0, int r32, const f32x16& cinit) {
    const int sw = r32 & 7; const char* kr = Ks + r32 * 128;
    const u32x4 a0 = *reinterpret_cast<const u32x4*>(kr + ((g0 ^ sw) << 4)), a1 = *reinterpret_cast<const u32x4*>(kr + (((g0 + 1) ^ sw) << 4));
    const u32x4 b0 = *reinterpret_cast<const u32x4*>(kr + 4096 + ((g0 ^ sw) << 4)), b1 = *reinterpret_cast<const u32x4*>(kr + 4096 + (((g0 + 1) ^ sw) << 4));
    const v8i_t A0 = {(int)a0.x, (int)a0.y, (int)a0.z, (int)a0.w, (int)a1.x, (int)a1.y, (int)a1.z, (int)a1.w}, A1 = {(int)b0.x, (int)b0.y, (int)b0.z, (int)b0.w, (int)b1.x, (int)b1.y, (int)b1.z, (int)b1.w};
    p0 = __builtin_amdgcn_mfma_scale_f32_32x32x64_f8f6f4(A0, qf, cinit, 0, 0, 0, 0, 0, 0);
    p1 = __builtin_amdgcn_mfma_scale_f32_32x32x64_f8f6f4(A1, qf, cinit, 0, 0, 0, 0, 0, 0);
}
template <int KW> __device__ __forceinline__ void qkt64n(f32x16& p0, f32x16& p1, const char* Ks, const bf16x8* qr, int kcb, int r32, int hi, const f32x16& cinit) {
#pragma unroll
    for (int d0 = 0; d0 < 4; ++d0) { const int cb = kcb + (d0 * 16 + hi * 8) * 2;
        const bf16x8 b0 = *reinterpret_cast<const bf16x8*>(Ks + kswz<KW>(r32, cb));
        const bf16x8 b1 = *reinterpret_cast<const bf16x8*>(Ks + kswz<KW>(32 + r32, cb));
        if (d0 == 0) { p0 = __builtin_amdgcn_mfma_f32_32x32x16_bf16(b0, qr[0], cinit, 0, 0, 0); p1 = __builtin_amdgcn_mfma_f32_32x32x16_bf16(b1, qr[0], cinit, 0, 0, 0); }
        else { p0 = __builtin_amdgcn_mfma_f32_32x32x16_bf16(b0, qr[d0], p0, 0, 0, 0); p1 = __builtin_amdgcn_mfma_f32_32x32x16_bf16(b1, qr[d0], p1, 0, 0, 0); } }
}
template <int ND> __device__ __forceinline__ void softmax_step(f32x16& p0, f32x16& p1, float& m_reg, float& l_reg, f32x16* o, float* al_l, int r32, int hi,
                                                              bf16x8& pa0, bf16x8& pa1, bf16x8& pa2, bf16x8& pa3) {
    float pmax = p0[0];
#pragma unroll
    for (int r = 1; r < 16; ++r) pmax = fmaxf(pmax, p0[r]);
#pragma unroll
    for (int r = 0; r < 16; ++r) pmax = fmaxf(pmax, p1[r]);
    { auto rr = __builtin_amdgcn_permlane32_swap(__float_as_uint(pmax), __float_as_uint(pmax), false, false); pmax = fmaxf(__uint_as_float(rr[0]), __uint_as_float(rr[1])); }
    const float mn = fmaxf(m_reg, pmax);
    const float alpha = __builtin_amdgcn_exp2f((m_reg - mn) * QK_C); m_reg = mn;
    const float mnC = -mn * QK_C;
#pragma unroll
    for (int r = 0; r < 16; ++r) { p0[r] = __builtin_amdgcn_exp2f(fmaf(p0[r], QK_C, mnC)); p1[r] = __builtin_amdgcn_exp2f(fmaf(p1[r], QK_C, mnC)); }
    float ps = 0.f;
#pragma unroll
    for (int r = 0; r < 16; ++r) ps += p0[r] + p1[r];
    { auto rr = __builtin_amdgcn_permlane32_swap(__float_as_uint(ps), __float_as_uint(ps), false, false); ps = __uint_as_float(rr[0]) + __uint_as_float(rr[1]); }
    l_reg = l_reg * alpha + ps;
    if (__any(alpha < 1.f)) { if (hi == 0) al_l[r32] = alpha; LDS_WAIT();
#pragma unroll
        for (int d = 0; d < ND; ++d)
#pragma unroll
            for (int r = 0; r < 16; ++r) o[d][r] *= al_l[crow(r, hi)];
    }
#define PK4(P, BASE, OUT) do { unsigned a0 = cvtpk(P[BASE + 0], P[BASE + 1]), a1 = cvtpk(P[BASE + 2], P[BASE + 3]);   \
    unsigned b0 = cvtpk(P[BASE + 4], P[BASE + 5]), b1 = cvtpk(P[BASE + 6], P[BASE + 7]);                              \
    auto r0 = __builtin_amdgcn_permlane32_swap(a0, b0, false, false); auto r1 = __builtin_amdgcn_permlane32_swap(a1, b1, false, false); \
    u32x4 w = {r0[0], r1[0], r0[1], r1[1]}; OUT = *reinterpret_cast<bf16x8*>(&w); } while (0)
    PK4(p0, 0, pa0); PK4(p0, 8, pa1); PK4(p1, 0, pa2); PK4(p1, 8, pa3);
#undef PK4
}

constexpr int AT_K = 0, AT_V = 16384, AT_WS = 32768, AT_XCH = 36864;

__device__ __forceinline__ void win_attn_unit(char* lds, const bf16_t* Z, bf16_t* Y, const float* sink, int b, int kvh, int qc, bool ctxq) {
    const int tid = opaque(threadIdx.x), wid = __builtin_amdgcn_readfirstlane(tid >> 6), lane = tid & 63, r32 = lane & 31, hi = lane >> 5;
    const int head = kvh * 4 + (wid >> 1), qsub = wid & 1;
    const int q0 = qc * 64;
    const size_t qrow0 = (ctxq ? (size_t)RL + b * CTX : (size_t)b * SEQ) + q0 + qsub * 32;
    float* wsf = (float*)(lds + AT_WS) + wid * 128; float* al_l = wsf; float* li_l = wsf + 32;
    bf16x8 qr[4];
    { const bf16_t* qp = Z + (qrow0 + r32) * MIXIN + 512 + head * 64 + hi * 8;
#pragma unroll
      for (int d0 = 0; d0 < 4; ++d0) qr[d0] = *reinterpret_cast<const bf16x8*>(qp + d0 * 16); }
    float m_reg = -1e30f, l_reg = 0.f; f32x16 o[2] = {};
    const int srow = tid >> 3, scol = (tid & 7) * 8;
    const int vb = (int)(uintptr_t)(lds + AT_V) + v_rd_base(lane);
    const int qrel = qsub * 32 + r32;
    const int NT = ctxq ? 4 : 9;
    for (int t = 0; t < NT; ++t) {
        size_t krow; int mode = 0;
        if (t < 4) krow = (size_t)RL + b * CTX + t * 64;
        else { const int p0 = q0 - 128 + (t - 4) * 64; if (p0 < 0 || p0 >= SEQ) continue; krow = (size_t)b * SEQ + p0; mode = (t == 4) ? 1 : (t == 8) ? 2 : 0; }
        __syncthreads();
        { const bf16_t* kp = Z + (krow + srow) * MIXIN + 1024 + kvh * 64 + scol;
          const bf16x8 kv = *reinterpret_cast<const bf16x8*>(kp), vv = *reinterpret_cast<const bf16x8*>(kp + 128);
          *reinterpret_cast<bf16x8*>(lds + AT_K + kswz<64>(srow, scol * 2)) = kv;
          *reinterpret_cast<bf16x8*>(lds + AT_V + v_st<64>(srow, scol)) = vv; }
        __syncthreads();
        f32x16 p0, p1; qkt64<64>(p0, p1, lds + AT_K, qr, 0, r32, hi);
        if (mode == 1) {
#pragma unroll
            for (int r = 0; r < 16; ++r) { const int kk = crow(r, hi); if (kk < qrel) p0[r] = -1e30f; if (kk + 32 < qrel) p1[r] = -1e30f; } }
        else if (mode == 2) {
#pragma unroll
            for (int r = 0; r < 16; ++r) { const int kk = crow(r, hi); if (kk > qrel) p0[r] = -1e30f; if (kk + 32 > qrel) p1[r] = -1e30f; } }
        bf16x8 pa0, pa1, pa2, pa3;
        softmax_step<2>(p0, p1, m_reg, l_reg, o, al_l, r32, hi, pa0, pa1, pa2, pa3);
        pv_one<64, 0>(o[0], vb, pa0, pa1, pa2, pa3); pv_one<64, 1>(o[1], vb, pa0, pa1, pa2, pa3);
    }
    l_reg += __builtin_amdgcn_exp2f(sink[head] * LOG2E - m_reg * QK_C);
    if (hi == 0) li_l[r32] = l_reg; LDS_WAIT();
    bf16_t* yp = Y + qrow0 * DM + 512 + head * 64;
#pragma unroll
    for (int r = 0; r < 16; ++r) { const int orow = crow(r, hi); const float rl = __builtin_amdgcn_rcpf(li_l[orow]);
#pragma unroll
        for (int d0 = 0; d0 < 2; ++d0) { const unsigned w = cvtpk(o[d0][r] * rl, 0.f); yp[(size_t)orow * DM + d0 * 32 + r32] = (bf16_t)(w & 0xffffu); } }
}

constexpr float DA_THR = 8.f;
constexpr float DA_THRL = DA_THR * LOG2E;
template <bool FIRST> __device__ __forceinline__ void da_partialSM(f32x16& p0, f32x16& p1, float& mhat, f32x16& negm, float& alpha) {
    float pmax = fmaxf(p0[0], p0[1]), pmb = fmaxf(p1[0], p1[1]);
#pragma unroll
    for (int r = 2; r < 16; r += 2) { pmax = fmaxf(fmaxf(pmax, p0[r]), p0[r + 1]); pmb = fmaxf(fmaxf(pmb, p1[r]), p1[r + 1]); }
    pmax = fmaxf(pmax, pmb);
    { auto rr = __builtin_amdgcn_permlane32_swap(__float_as_uint(pmax), __float_as_uint(pmax), false, false); pmax = fmaxf(__uint_as_float(rr[0]), __uint_as_float(rr[1])); }
    alpha = 1.f;
    if (FIRST || !__builtin_expect(__all(pmax <= DA_THRL), 1)) {
        const float dl = FIRST ? pmax : fmaxf(pmax, 0.f);
        mhat += dl; alpha = __builtin_amdgcn_exp2f(-dl);
#pragma unroll
        for (int r = 0; r < 16; ++r) { p0[r] -= dl; p1[r] -= dl; negm[r] = -mhat; }
    }
#pragma unroll
    for (int r = 0; r < 16; ++r) p0[r] = __builtin_amdgcn_exp2f(p0[r]);
}
__device__ __forceinline__ void da_finishSM(f32x16& p0, f32x16& p1, float alpha, float& l_reg, bf16x8& pa0, bf16x8& pa1, bf16x8& pa2, bf16x8& pa3) {
#pragma unroll
    for (int r = 0; r < 16; ++r) p1[r] = __builtin_amdgcn_exp2f(p1[r]);
    float s0 = p0[0], s1 = p0[1], s2 = p0[2], s3 = p0[3];
#pragma unroll
    for (int r = 4; r < 16; r += 4) { s0 += p0[r]; s1 += p0[r + 1]; s2 += p0[r + 2]; s3 += p0[r + 3]; }
#pragma unroll
    for (int r = 0; r < 16; r += 4) { s0 += p1[r]; s1 += p1[r + 1]; s2 += p1[r + 2]; s3 += p1[r + 3]; }
    float ps = (s0 + s1) + (s2 + s3);
    { auto rr = __builtin_amdgcn_permlane32_swap(__float_as_uint(ps), __float_as_uint(ps), false, false); ps = __uint_as_float(rr[0]) + __uint_as_float(rr[1]); }
    l_reg = l_reg * alpha + ps;
#define PK4(P, BASE, OUT) do { unsigned a0 = cvtpk(P[BASE + 0], P[BASE + 1]), a1 = cvtpk(P[BASE + 2], P[BASE + 3]);   \
    unsigned b0 = cvtpk(P[BASE + 4], P[BASE + 5]), b1 = cvtpk(P[BASE + 6], P[BASE + 7]);                              \
    auto r0 = __builtin_amdgcn_permlane32_swap(a0, b0, false, false); auto r1 = __builtin_amdgcn_permlane32_swap(a1, b1, false, false); \
    u32x4 w = {r0[0], r1[0], r0[1], r1[1]}; OUT = *reinterpret_cast<bf16x8*>(&w); } while (0)
    PK4(p0, 0, pa0); PK4(p0, 8, pa1); PK4(p1, 0, pa2); PK4(p1, 8, pa3);
#undef PK4
}
constexpr float DA8_OFF = 5.f, DA8_THRL = 3.f;
template <bool FIRST> __device__ __forceinline__ void da8_partialSM(f32x16& p0, f32x16& p1, float& mhat, f32x16& negm, float& alpha) {
    float pmax = fmaxf(p0[0], p0[1]), pmb = fmaxf(p1[0], p1[1]);
#pragma unroll
    for (int r = 2; r < 16; r += 2) { pmax = fmaxf(fmaxf(pmax, p0[r]), p0[r + 1]); pmb = fmaxf(fmaxf(pmb, p1[r]), p1[r + 1]); }
    pmax = fmaxf(pmax, pmb);
    { auto rr = __builtin_amdgcn_permlane32_swap(__float_as_uint(pmax), __float_as_uint(pmax), false, false); pmax = fmaxf(__uint_as_float(rr[0]), __uint_as_float(rr[1])); }
    alpha = 1.f;
    if (FIRST || !__builtin_expect(__all(pmax <= DA8_OFF + DA8_THRL), 1)) {
        const float dl = FIRST ? pmax - DA8_OFF : fmaxf(pmax - DA8_OFF, 0.f);
        mhat += dl; alpha = __builtin_amdgcn_exp2f(-dl);
#pragma unroll
        for (int r = 0; r < 16; ++r) { p0[r] -= dl; p1[r] -= dl; negm[r] = DA8_OFF - mhat; }
    }
#pragma unroll
    for (int r = 0; r < 16; ++r) p0[r] = __builtin_amdgcn_exp2f(p0[r]);
}
__device__ __forceinline__ void da8_finishSM(f32x16& p0, f32x16& p1, float alpha, float& l_reg, v8i_t& P8) {
#pragma unroll
    for (int r = 0; r < 16; ++r) p1[r] = __builtin_amdgcn_exp2f(p1[r]);
    float s0 = p0[0], s1 = p0[1], s2 = p0[2], s3 = p0[3];
#pragma unroll
    for (int r = 4; r < 16; r += 4) { s0 += p0[r]; s1 += p0[r + 1]; s2 += p0[r + 2]; s3 += p0[r + 3]; }
#pragma unroll
    for (int r = 0; r < 16; r += 4) { s0 += p1[r]; s1 += p1[r + 1]; s2 += p1[r + 2]; s3 += p1[r + 3]; }
    float ps = (s0 + s1) + (s2 + s3);
    { auto rr = __builtin_amdgcn_permlane32_swap(__float_as_uint(ps), __float_as_uint(ps), false, false); ps = __uint_as_float(rr[0]) + __uint_as_float(rr[1]); }
    l_reg = l_reg * alpha + ps;
#pragma unroll
    for (int w = 0; w < 4; ++w) { int a = __builtin_amdgcn_cvt_pk_fp8_f32(p0[4 * w], p0[4 * w + 1], 0, false); a = __builtin_amdgcn_cvt_pk_fp8_f32(p0[4 * w + 2], p0[4 * w + 3], a, true); P8[w] = a;
        int c = __builtin_amdgcn_cvt_pk_fp8_f32(p1[4 * w], p1[4 * w + 1], 0, false); c = __builtin_amdgcn_cvt_pk_fp8_f32(p1[4 * w + 2], p1[4 * w + 3], c, true); P8[4 + w] = c; }
}
__device__ __forceinline__ void da8_pv(f32x16* o, const char* Vs, int r32, int hi, v8i_t P8) {
    const int sw = (r32 >> 2) & 3; const char* vr = Vs + r32 * 64; const int o0 = ((hi * 2) ^ sw) << 4, o1 = ((hi * 2 + 1) ^ sw) << 4;
    u32x4 x0[4], x1[4];
#pragma unroll
    for (int db = 0; db < 4; ++db) { x0[db] = *reinterpret_cast<const u32x4*>(vr + db * 2048 + o0); x1[db] = *reinterpret_cast<const u32x4*>(vr + db * 2048 + o1); }
#pragma unroll
    for (int db = 0; db < 4; ++db) { const v8i_t B = {(int)x0[db].x, (int)x0[db].y, (int)x0[db].z, (int)x0[db].w, (int)x1[db].x, (int)x1[db].y, (int)x1[db].z, (int)x1[db].w};
        o[db] = __builtin_amdgcn_mfma_scale_f32_32x32x64_f8f6f4(P8, B, o[db], 0, 0, 0, 0, 0, 0); }
}
__device__ __forceinline__ void da_pv(f32x16* o, int vb, bf16x8 pa0, bf16x8 pa1, bf16x8 pa2, bf16x8 pa3) {
    pv_all<128>(o, vb, pa0, pa1, pa2, pa3);
}
constexpr int DA_V = 0, DA_K = 49152, DA_WS = 81920, DA_XCH = 0;
__device__ __forceinline__ void diff_attn_unit(char* lds, const unsigned char* VT8, const unsigned char* QK8, bf16_t* O, const float* subg, float lam, float oscale, int b, int h, int qb, bool ctxq) {
    const int tid = opaque(threadIdx.x), wid = __builtin_amdgcn_readfirstlane(tid >> 6), lane = tid & 63, r32 = lane & 31, hi = lane >> 5;
    const int comp = wid >> 2, qsub = wid & 3;
    const size_t qrow0 = (ctxq ? (size_t)RL + b * CTX : (size_t)b * SEQ) + qb * 128 + qsub * 32;
    char* V_lds = lds + DA_V; char* K_lds = lds + DA_K;
    float* wsf = (float*)(lds + DA_WS) + wid * 128; float* al_l = wsf; float* li_l = wsf + 32;
    __syncthreads();
    v8i_t qf;
    { const unsigned char* qp = QK8 + (qrow0 + r32) * 2048 + (2 * h + comp) * 64 + hi * 32;
      const u32x4 q0 = *reinterpret_cast<const u32x4*>(qp), q1 = *reinterpret_cast<const u32x4*>(qp + 16);
      qf = (v8i_t){(int)q0.x, (int)q0.y, (int)q0.z, (int)q0.w, (int)q1.x, (int)q1.y, (int)q1.z, (int)q1.w}; }
    float m_reg = 0.f, l_reg = 0.f; f32x16 o[4] = {}; f32x16 negm;
#pragma unroll
    for (int r = 0; r < 16; ++r) negm[r] = DA8_OFF;
    const int kkey = tid >> 3, krow = ((kkey >> 4) & 1) * 32 + (kkey & 3) + 8 * ((kkey & 15) >> 2) + 4 * (kkey >> 5), kst = krow * 128 + ((((tid & 7) ^ (krow & 7))) << 4);
    const unsigned char* kp8 = QK8 + (size_t)kkey * 2048 + 1024 + h * 128 + (tid & 7) * 16;
    const int kg0 = comp * 4 + hi * 2;
    const unsigned char* vt8 = VT8 + (size_t)(b * 8 + h) * 68 * 8192 + tid * 16;
    const size_t rowc = (size_t)RL + b * CTX, rowl = (size_t)b * SEQ;
    const int NT = ctxq ? 4 : 68;
    u32x4 ks, vs;
#define KROW(t) ((t) < 4 ? rowc + (size_t)(t) * 64 : rowl + (size_t)((t) - 4) * 64)
#define LOADK(t) do { ks = *reinterpret_cast<const u32x4*>(kp8 + KROW(t) * 2048); } while (0)
#define LOADV(t) do { vs = *reinterpret_cast<const u32x4*>(vt8 + (size_t)(t) * 8192); } while (0)
#define WRITEK(bf) do { *reinterpret_cast<u32x4*>(K_lds + (bf) * 8192 + kst) = ks; } while (0)
#define WRITEV(bf) do { *reinterpret_cast<u32x4*>(V_lds + (bf) * 8192 + tid * 16) = vs; } while (0)
#define RESC(a) do { if (__any((a) < 1.f)) { if (hi == 0) al_l[r32] = (a); LDS_WAIT(); \
    _Pragma("unroll") for (int d = 0; d < 4; ++d) _Pragma("unroll") for (int r = 0; r < 16; ++r) o[d][r] *= al_l[crow(r, hi)]; } } while (0)
#define QKT(P0, P1, kb) do { SBAR(); qkt64_f8(P0, P1, K_lds + (kb) * 8192, qf, kg0, r32, negm); } while (0)
#define FIN(P0, P1, al) do { da8_finishSM(P0, P1, al, l_reg, P8); SBAR(); } while (0)
#define PVT(vi) da8_pv(o, V_lds + (vi) * 8192, r32, hi, P8)
    f32x16 pA0, pA1, pB0, pB1; float alA = 1.f, alB = 1.f; v8i_t P8;
    int vm2 = 1, vm1 = 2, vc = 0;
#define VROT() do { const int t_ = vm2; vm2 = vm1; vm1 = vc; vc = t_; } while (0)
    const bool grpB = comp != 0;
    LOADK(0); VM_WAIT(); WRITEK(0); LOADK(1); LOADV(0); __syncthreads();
    QKT(pA0, pA1, 0);
    if (!grpB) da8_partialSM<true>(pA0, pA1, m_reg, negm, alA);
    VM_WAIT(); WRITEK(1); WRITEV(vc); LOADK(2); LOADV(1); VROT();
    __syncthreads();
    if (grpB) da8_partialSM<true>(pA0, pA1, m_reg, negm, alA);
    QKT(pB0, pB1, 1); FIN(pA0, pA1, alA);
    if (!grpB) { PVT(vm1); da8_partialSM<false>(pB0, pB1, m_reg, negm, alB); RESC(alB); }
    VM_WAIT(); WRITEK(0); WRITEV(vc); LOADK(3); LOADV(2); VROT();
    __syncthreads();
    for (int j = 2; j + 1 < NT; j += 2) {
        if (grpB) { PVT(vm2); da8_partialSM<false>(pB0, pB1, m_reg, negm, alB); RESC(alB); }
        QKT(pA0, pA1, 0); FIN(pB0, pB1, alB);
        if (!grpB) { PVT(vm1); da8_partialSM<false>(pA0, pA1, m_reg, negm, alA); RESC(alA); }
        VM_WAIT(); WRITEK(1); WRITEV(vc); if (j + 2 < NT) LOADK(j + 2); LOADV(j + 1); VROT();
        __syncthreads();
        if (grpB) { PVT(vm2); da8_partialSM<false>(pA0, pA1, m_reg, negm, alA); RESC(alA); }
        QKT(pB0, pB1, 1); FIN(pA0, pA1, alA);
        if (!grpB) { PVT(vm1); da8_partialSM<false>(pB0, pB1, m_reg, negm, alB); RESC(alB); }
        VM_WAIT(); if (j + 2 < NT) { WRITEK(0); } WRITEV(vc); if (j + 3 < NT) LOADK(j + 3); if (j + 2 < NT) LOADV(j + 2); VROT();
        __syncthreads();
    }
    if (grpB) { PVT(vm2); da8_partialSM<false>(pB0, pB1, m_reg, negm, alB); RESC(alB); }
    FIN(pB0, pB1, alB); PVT(vm1);
#undef LOADK
#undef LOADV
#undef WRITEK
#undef WRITEV
#undef QKT
#undef FIN
#undef PVT
#undef VROT
#define SLOAD(a, b)
#define SWRITE(a, b)
#define SWAIT()
#undef KROW
#undef SLOAD
#undef SWRITE
#undef SWAIT
#undef RESC
    if (hi == 0) li_l[r32] = l_reg; LDS_WAIT();
    float rl[16];
#pragma unroll
    for (int r = 0; r < 16; ++r) rl[r] = __builtin_amdgcn_rcpf(li_l[crow(r, hi)]);
    __syncthreads();
    float* xch = (float*)(lds + DA_XCH) + qsub * (32 * 132);
    if (comp == 1) {
#pragma unroll
        for (int d0 = 0; d0 < 4; ++d0)
#pragma unroll
            for (int r = 0; r < 16; ++r) xch[crow(r, hi) * 132 + d0 * 32 + r32] = o[d0][r] * rl[r];
    }
    __syncthreads();
    if (comp == 0) {
#pragma unroll
        for (int d0 = 0; d0 < 4; ++d0)
#pragma unroll
            for (int r = 0; r < 16; ++r) { const int idx = crow(r, hi) * 132 + d0 * 32 + r32; const float v = o[d0][r] * rl[r] - lam * xch[idx]; xch[idx] = v; }
        LDS_WAIT();
        const int row = lane >> 1, hf = lane & 1; const float* rp = xch + row * 132 + hf * 64;
        f32x4 v[16]; float ss = 0.f;
#pragma unroll
        for (int j = 0; j < 16; ++j) { v[j] = *reinterpret_cast<const f32x4*>(rp + 4 * j); ss += v[j][0] * v[j][0] + v[j][1] * v[j][1] + v[j][2] * v[j][2] + v[j][3] * v[j][3]; }
        ss += __int_as_float(__builtin_amdgcn_ds_bpermute((lane ^ 1) << 2, __float_as_int(ss)));
        const float rs = __builtin_amdgcn_rsqf(ss * (1.f / 128.f) + EPS) * oscale;
        bf16_t* op = O + (qrow0 + row) * DM + h * 128 + hf * 64;
#pragma unroll
        for (int j = 0; j < 16; j += 2) { const f32x4 g0 = *reinterpret_cast<const f32x4*>(subg + hf * 64 + 4 * j), g1 = *reinterpret_cast<const f32x4*>(subg + hf * 64 + 4 * j + 4);
            const f32x4 a = v[j] * g0 * rs, c = v[j + 1] * g1 * rs;
            u32x4 w; w.x = cvtpk(a[0], a[1]); w.y = cvtpk(a[2], a[3]); w.z = cvtpk(c[0], c[1]); w.w = cvtpk(c[2], c[3]);
            *reinterpret_cast<u32x4*>(op + 4 * j) = w; }
    }
}

constexpr int WA_V = 0, WA_K = 16384, WA_WS = 32768, WA_ST = 36864;
__device__ __forceinline__ void wa_mask(f32x16& p0, f32x16& p1, int mode, int qrel, int hi) {
    if (mode == 1) {
#pragma unroll
        for (int r = 0; r < 16; ++r) { const int kk = crow(r, hi); if (kk < qrel) p0[r] = -1e30f; if (kk + 32 < qrel) p1[r] = -1e30f; } }
    else if (mode == 2) {
#pragma unroll
        for (int r = 0; r < 16; ++r) { const int kk = crow(r, hi); if (kk > qrel) p0[r] = -1e30f; if (kk + 32 > qrel) p1[r] = -1e30f; } }
    else if (mode == 3) {
#pragma unroll
        for (int r = 0; r < 16; ++r) { p0[r] = -1e30f; p1[r] = -1e30f; } }
}
__device__ __forceinline__ void win_attn_unit2(char* lds, const bf16_t* Z, bf16_t* Y, const float* sink, int b, int kvh, int qc, bool ctxq) {
    const int tid = opaque(threadIdx.x), wid = __builtin_amdgcn_readfirstlane(tid >> 6), lane = tid & 63, r32 = lane & 31, hi = lane >> 5;
    const int head = kvh * 4 + (wid >> 1), qsub = wid & 1, q0 = qc * 64;
    const size_t rowc = (size_t)RL + b * CTX, rowl = (size_t)b * SEQ;
    const size_t qrow0 = (ctxq ? rowc : rowl) + q0 + qsub * 32;
    char* V_lds = lds + WA_V; char* K_lds = lds + WA_K;
    float* wsf = (float*)(lds + WA_WS) + wid * 128; float* al_l = wsf; float* li_l = wsf + 32;
    __syncthreads();
    bf16x8 qr[4];
    { const bf16_t* qp = Z + (qrow0 + r32) * MIXIN + 512 + head * 64 + hi * 8;
#pragma unroll
      for (int d0 = 0; d0 < 4; ++d0) qr[d0] = *reinterpret_cast<const bf16x8*>(qp + d0 * 16); }
    float m_reg = 0.f, l_reg = 0.f; f32x16 o[2] = {}; f32x16 negm = {};
    const int srow = tid >> 3, scol = (tid & 7) * 8, vst = v_st<64>(srow, scol), kst = kswz<64>(srow, scol * 2);
    const int vb0 = (int)(uintptr_t)V_lds + v_rd_base(lane);
    const bf16_t* kvp = Z + (size_t)srow * MIXIN + 1024 + kvh * 64 + scol;
    const int skip_lo = ctxq ? 0 : (q0 == 0 ? 2 : q0 == 64 ? 1 : 0);
    const int nloc = ctxq ? 0 : 5 - skip_lo - (q0 == SEQ - 64 ? 2 : q0 == SEQ - 128 ? 1 : 0);
    const int NTr = 4 + nloc, NT = (NTr + 1) & ~1;
    const int qrel = qsub * 32 + r32;
    struct { bf16x8 vs, ks; } sr_;
#define KROW(t) ((t) < 4 ? rowc + (size_t)(t) * 64 : (t) < NTr ? rowl + (size_t)(q0 - 128 + ((t) - 4 + skip_lo) * 64) : rowc)
#define TMODE(t) ((t) < 4 ? 0 : (t) >= NTr ? 3 : ((t) - 4 + skip_lo) == 0 ? 1 : ((t) - 4 + skip_lo) == 4 ? 2 : 0)
#define SLOAD(t) do { const bf16_t* p_ = kvp + KROW(t) * MIXIN; sr_.ks = *reinterpret_cast<const bf16x8*>(p_); sr_.vs = *reinterpret_cast<const bf16x8*>(p_ + 128); } while (0)
#define SWRITE(bf) do { *reinterpret_cast<bf16x8*>(V_lds + (bf) * 8192 + vst) = sr_.vs; *reinterpret_cast<bf16x8*>(K_lds + (bf) * 8192 + kst) = sr_.ks; } while (0)
#define SWAIT() asm volatile("s_waitcnt vmcnt(0)" ::: "memory")
#define RESC(a) do { if (__any((a) < 1.f)) { if (hi == 0) al_l[r32] = (a); LDS_WAIT(); \
    _Pragma("unroll") for (int d = 0; d < 2; ++d) _Pragma("unroll") for (int r = 0; r < 16; ++r) o[d][r] *= al_l[crow(r, hi)]; } } while (0)
#define WPV(vb) pv_all<64>(o, (vb), pa0, pa1, pa2, pa3)
    f32x16 pA0, pA1, pB0, pB1; float alA, alB; bf16x8 pa0, pa1, pa2, pa3;
    SLOAD(0); VM_WAIT(); SWRITE(0); __syncthreads();
    qkt64n<64>(pA0, pA1, K_lds, qr, 0, r32, hi, negm); da_partialSM<true>(pA0, pA1, m_reg, negm, alA);
    SLOAD(1);
    SWAIT(); SWRITE(1); __syncthreads();
    for (int j = 1; j + 1 < NT; j += 2) {
        SBAR(); qkt64n<64>(pB0, pB1, K_lds + 8192, qr, 0, r32, hi, negm);
        da_finishSM(pA0, pA1, alA, l_reg, pa0, pa1, pa2, pa3); SBAR();
        SLOAD(j + 1); SBAR();
        WPV(vb0); wa_mask(pB0, pB1, TMODE(j), qrel, hi); da_partialSM<false>(pB0, pB1, m_reg, negm, alB);
        __syncthreads(); SWAIT(); SWRITE(0);
        RESC(alB); __syncthreads();
        SBAR(); qkt64n<64>(pA0, pA1, K_lds, qr, 0, r32, hi, negm);
        da_finishSM(pB0, pB1, alB, l_reg, pa0, pa1, pa2, pa3); SBAR();
        SLOAD(j + 2); SBAR();
        WPV(vb0 + 8192); wa_mask(pA0, pA1, TMODE(j + 1), qrel, hi); da_partialSM<false>(pA0, pA1, m_reg, negm, alA);
        __syncthreads(); SWAIT(); SWRITE(1);
        RESC(alA); __syncthreads();
    }
    SBAR(); qkt64n<64>(pB0, pB1, K_lds + 8192, qr, 0, r32, hi, negm);
    da_finishSM(pA0, pA1, alA, l_reg, pa0, pa1, pa2, pa3); SBAR();
    WPV(vb0); wa_mask(pB0, pB1, TMODE(NT - 1), qrel, hi); da_partialSM<false>(pB0, pB1, m_reg, negm, alB);
    __syncthreads(); RESC(alB);
    da_finishSM(pB0, pB1, alB, l_reg, pa0, pa1, pa2, pa3); SBAR();
    WPV(vb0 + 8192);
#undef KROW
#undef TMODE
#undef SLOAD
#undef SWRITE
#undef SWAIT
#undef RESC
#undef WPV
    l_reg += __builtin_amdgcn_exp2f(sink[head] * LOG2E - m_reg);
    if (hi == 0) li_l[r32] = l_reg; LDS_WAIT();
    bf16_t* stg = (bf16_t*)(lds + WA_ST) + wid * 2048;
#pragma unroll
    for (int r = 0; r < 16; ++r) { const int orow = crow(r, hi); const float rl = __builtin_amdgcn_rcpf(li_l[orow]);
#pragma unroll
        for (int d0 = 0; d0 < 2; ++d0) stg[orow * 64 + d0 * 32 + r32] = (bf16_t)(cvtpk(o[d0][r] * rl, 0.f) & 0xffffu); }
    LDS_WAIT();
    bf16_t* yp = Y + qrow0 * DM + 512 + head * 64;
#pragma unroll
    for (int i = 0; i < 4; ++i) { const int row = i * 8 + (lane >> 3), ch = lane & 7; const u32x4 v = *reinterpret_cast<const u32x4*>(stg + row * 64 + ch * 8); *reinterpret_cast<u32x4*>(yp + (size_t)row * DM + ch * 8) = v; }
}

struct Args {
    const float *x, *c, *ctx, *c_ctx, *ada_w, *ada_b, *norm_g, *mix_in_w, *mix_out_w, *win_sink, *diff_qkv_w, *diff_out_w, *diff_lambda, *diff_subln_g,
                *ffn_in_w, *ffn_out_w, *router_w, *expert_in_w, *expert_out_w;
    float* out; unsigned char* ws; int ph_lo, ph_hi;
};
struct Frame {
    LAS unsigned char* lds; unsigned char* ldsg; volatile LAS unsigned* MISC; unsigned* ctl;
    int tid, lane, wave, vcu, G;
};

__device__ __forceinline__ unsigned f2bf(float f) { unsigned u = __builtin_bit_cast(unsigned, f); return (u + 0x7fffu + ((u >> 16) & 1u)) >> 16; }
__device__ __forceinline__ unsigned pk2(float lo, float hi) { return f2bf(lo) | (f2bf(hi) << 16); }
__device__ __forceinline__ void transpose_item(const float* W, int K, int N, bf16_t* WT, int n0, int c0, int k0, LAS float* scr, int lane) {
#pragma unroll 8
    for (int i = 0; i < 32; ++i) { const int kk = 2 * i + (lane >> 5); scr[kk * 33 + (lane & 31)] = W[(size_t)(k0 + kk) * N + c0 + (lane & 31)]; }
    LDS_WAIT(); asm volatile("" ::: "memory");
    const int c = lane & 7;
#pragma unroll
    for (int j = 0; j < 4; ++j) { const int n = (lane >> 3) + 8 * j; const LAS float* s = scr + (8 * c) * 33 + n;
        u32x4 o; o.x = pk2(s[0 * 33], s[1 * 33]); o.y = pk2(s[2 * 33], s[3 * 33]); o.z = pk2(s[4 * 33], s[5 * 33]); o.w = pk2(s[6 * 33], s[7 * 33]);
        *(u32x4*)(WT + (size_t)(n0 + n) * K + k0 + 8 * c) = o; }
    LDS_WAIT(); asm volatile("" ::: "memory");
}
__device__ __forceinline__ void transpose_item_f8(const float* W, int K, int N, unsigned char* WT, int n0, int c0, int k0, LAS float* scr, int lane) {
#pragma unroll 8
    for (int i = 0; i < 32; ++i) { const int kk = 2 * i + (lane >> 5); scr[kk * 33 + (lane & 31)] = W[(size_t)(k0 + kk) * N + c0 + (lane & 31)] * F8_SW; }
    LDS_WAIT(); asm volatile("" ::: "memory");
    const int c = lane & 7;
#pragma unroll
    for (int j = 0; j < 4; ++j) { const int n = (lane >> 3) + 8 * j; const LAS float* s = scr + (8 * c) * 33 + n;
        u32x2 o; o.x = pk4_fp8(s[0 * 33], s[1 * 33], s[2 * 33], s[3 * 33]); o.y = pk4_fp8(s[4 * 33], s[5 * 33], s[6 * 33], s[7 * 33]);
        *(u32x2*)(WT + (size_t)(n0 + n) * K + k0 + 8 * c) = o; }
    LDS_WAIT(); asm volatile("" ::: "memory");
}
__device__ __forceinline__ bool transpose_job(int& r, const float* W, int nb, int K, int N, void* WT, bool glu, bool f8, LAS float* scr, int lane) {
    const int nblk = N / 32, per = (K / 64) * nblk, tot = nb * per;
    if (r >= tot) { r -= tot; return false; }
    const int mtx = r / per, it = r % per, kb = it / nblk, nbk = it % nblk, n0 = 32 * nbk;
    int c0 = n0;
    if (glu) { const int tile = n0 >> 8, w = n0 & 255; c0 = (w < 128) ? tile * 128 + w : (N >> 1) + tile * 128 + (w - 128); }
    if (f8) transpose_item_f8(W + (size_t)mtx * K * N, K, N, (unsigned char*)WT + (size_t)mtx * K * N, n0, c0, 64 * kb, scr, lane);
    else transpose_item(W + (size_t)mtx * K * N, K, N, (bf16_t*)WT + (size_t)mtx * K * N, n0, c0, 64 * kb, scr, lane);
    return true;
}

struct ThinP {
    int nrows;
    const void* xin_lat; const void* xin_ctx;
    void* xout_lat; void* xout_ctx;
    bool xin16, xout16;
    int ymode;
    const bf16_t* Ysrc; const float* gate; const float* ga;
    bool h8;
    bf16_t* H; const float* gb; const float* shsc;
    const float* router; int* route; unsigned* cnt;
    unsigned char* HSv;
};
#define TH_DECL(PFX) f32x4 PFX##x0 = {}, PFX##x1 = {}, PFX##x2 = {}, PFX##x3 = {}; u32x2 PFX##xh0 = {}, PFX##xh1 = {}, PFX##xh2 = {}, PFX##xh3 = {}; u32x2 PFX##ya0 = {}, PFX##ya1 = {}, PFX##ya2 = {}, PFX##ya3 = {}, PFX##yb0 = {}, PFX##yb1 = {}, PFX##yb2 = {}, PFX##yb3 = {}; float PFX##w0 = 0.f, PFX##w1 = 0.f
#define TH_LOAD(PFX, r_, it_) do { const int rr_ = (r_); \
    if (P.xin16) { const bf16_t* xr_ = (rr_ < RL ? (const bf16_t*)P.xin_lat + (size_t)rr_ * DM : (const bf16_t*)P.xin_ctx + (size_t)(rr_ - RL) * DM) + 4 * lane; \
        PFX##xh0 = __builtin_nontemporal_load(reinterpret_cast<const u32x2*>(xr_)); PFX##xh1 = __builtin_nontemporal_load(reinterpret_cast<const u32x2*>(xr_ + 256)); PFX##xh2 = __builtin_nontemporal_load(reinterpret_cast<const u32x2*>(xr_ + 512)); PFX##xh3 = __builtin_nontemporal_load(reinterpret_cast<const u32x2*>(xr_ + 768)); } \
    else { const float* xr_ = (rr_ < RL ? (const float*)P.xin_lat + (size_t)rr_ * DM : (const float*)P.xin_ctx + (size_t)(rr_ - RL) * DM) + 4 * lane; \
        PFX##x0 = __builtin_nontemporal_load(reinterpret_cast<const f32x4*>(xr_)); PFX##x1 = __builtin_nontemporal_load(reinterpret_cast<const f32x4*>(xr_ + 256)); PFX##x2 = __builtin_nontemporal_load(reinterpret_cast<const f32x4*>(xr_ + 512)); PFX##x3 = __builtin_nontemporal_load(reinterpret_cast<const f32x4*>(xr_ + 768)); } \
    const bf16_t* ya_ = P.Ysrc; const bf16_t* yb_ = P.Ysrc; \
    if (P.ymode == 1) ya_ = P.Ysrc + (size_t)rr_ * DM; \
    else if (P.ymode == 2) { const LAS int* rt_ = rtl + (it_) * 6; \
        const int e0_ = rt_[0], p0_ = rt_[1], e1_ = rt_[2], p1_ = rt_[3]; PFX##w0 = __int_as_float(rt_[4]); PFX##w1 = __int_as_float(rt_[5]); \
        const unsigned b0_ = e0_ == 0 ? 0u : e0_ == 1 ? cb1 : e0_ == 2 ? cb2 : e0_ == 3 ? cb3 : e0_ == 4 ? cb4 : e0_ == 5 ? cb5 : e0_ == 6 ? cb6 : cb7; \
        const unsigned b1_ = e1_ == 0 ? 0u : e1_ == 1 ? cb1 : e1_ == 2 ? cb2 : e1_ == 3 ? cb3 : e1_ == 4 ? cb4 : e1_ == 5 ? cb5 : e1_ == 6 ? cb6 : cb7; \
        ya_ = P.Ysrc + (size_t)(b0_ + p0_) * DM; yb_ = P.Ysrc + (size_t)(b1_ + p1_) * DM; } \
    if (P.ymode) { ya_ += 4 * lane; PFX##ya0 = __builtin_nontemporal_load(reinterpret_cast<const u32x2*>(ya_)); PFX##ya1 = __builtin_nontemporal_load(reinterpret_cast<const u32x2*>(ya_ + 256)); PFX##ya2 = __builtin_nontemporal_load(reinterpret_cast<const u32x2*>(ya_ + 512)); PFX##ya3 = __builtin_nontemporal_load(reinterpret_cast<const u32x2*>(ya_ + 768)); } \
    if (P.ymode == 2) { yb_ += 4 * lane; PFX##yb0 = __builtin_nontemporal_load(reinterpret_cast<const u32x2*>(yb_)); PFX##yb1 = __builtin_nontemporal_load(reinterpret_cast<const u32x2*>(yb_ + 256)); PFX##yb2 = __builtin_nontemporal_load(reinterpret_cast<const u32x2*>(yb_ + 512)); PFX##yb3 = __builtin_nontemporal_load(reinterpret_cast<const u32x2*>(yb_ + 768)); } \
    } while (0)
#define TH_ARGS(PFX) PFX##x0, PFX##x1, PFX##x2, PFX##x3, PFX##xh0, PFX##xh1, PFX##xh2, PFX##xh3, PFX##ya0, PFX##ya1, PFX##ya2, PFX##ya3, PFX##yb0, PFX##yb1, PFX##yb2, PFX##yb3, PFX##w0, PFX##w1
__device__ __forceinline__ void thin_proc(const ThinP& P, f32x4 x0, f32x4 x1, f32x4 x2, f32x4 x3, u32x2 xh0, u32x2 xh1, u32x2 xh2, u32x2 xh3, u32x2 ya0, u32x2 ya1, u32x2 ya2, u32x2 ya3, u32x2 yb0, u32x2 yb1, u32x2 yb2, u32x2 yb3, float yw0, float yw1,
                                          f32x4 GA0, f32x4 GA1, f32x4 GA2, f32x4 GA3, f32x4 GB0, f32x4 GB1, f32x4 GB2, f32x4 GB3, f32x4 SH0, f32x4 SH1, f32x4 SH2, f32x4 SH3,
                                          int r, int li, int lane, LAS float* rwT, LAS int* rec, LAS unsigned* lcnt) {
    const int idx = r < RL ? (r >> 12) : 8;
#define BF4(w) ((f32x4){bf_lo((w).x), bf_hi((w).x), bf_lo((w).y), bf_hi((w).y)})
    f32x4 xv[4] = {x0, x1, x2, x3};
    if (P.xin16) { xv[0] = BF4(xh0); xv[1] = BF4(xh1); xv[2] = BF4(xh2); xv[3] = BF4(xh3); }
    if (P.ymode) {
        f32x4 yv[4];
        if (P.ymode == 1) { yv[0] = BF4(ya0); yv[1] = BF4(ya1); yv[2] = BF4(ya2); yv[3] = BF4(ya3); }
        else { yv[0] = BF4(ya0) * yw0 + BF4(yb0) * yw1; yv[1] = BF4(ya1) * yw0 + BF4(yb1) * yw1; yv[2] = BF4(ya2) * yw0 + BF4(yb2) * yw1; yv[3] = BF4(ya3) * yw0 + BF4(yb3) * yw1; }
#undef BF4
        float ss = 0.f;
#pragma unroll
        for (int j = 0; j < 4; ++j) ss += yv[j][0] * yv[j][0] + yv[j][1] * yv[j][1] + yv[j][2] * yv[j][2] + yv[j][3] * yv[j][3];
        const float rs = __builtin_amdgcn_rsqf(wave_sum(ss, lane) * (1.f / DM) + EPS);
        xv[0] = xv[0] + GA0 * (yv[0] * rs); xv[1] = xv[1] + GA1 * (yv[1] * rs); xv[2] = xv[2] + GA2 * (yv[2] * rs); xv[3] = xv[3] + GA3 * (yv[3] * rs);
    }
    if (P.xout_lat) {
        if (P.xout16) { bf16_t* xo = r < RL ? (bf16_t*)P.xout_lat + (size_t)r * DM : (bf16_t*)P.xout_ctx + (size_t)(r - RL) * DM;
#pragma unroll
            for (int j = 0; j < 4; ++j) { u32x2 w; w.x = cvtpk(xv[j][0], xv[j][1]); w.y = cvtpk(xv[j][2], xv[j][3]); __builtin_nontemporal_store(w, reinterpret_cast<u32x2*>(xo + 4 * lane + 256 * j)); } }
        else { float* xo = r < RL ? (float*)P.xout_lat + (size_t)r * DM : (float*)P.xout_ctx + (size_t)(r - RL) * DM;
#pragma unroll
            for (int j = 0; j < 4; ++j) __builtin_nontemporal_store(xv[j], reinterpret_cast<f32x4*>(xo + 4 * lane + 256 * j)); } }
    if (P.H) {
        float ss = 0.f;
#pragma unroll
        for (int j = 0; j < 4; ++j) ss += xv[j][0] * xv[j][0] + xv[j][1] * xv[j][1] + xv[j][2] * xv[j][2] + xv[j][3] * xv[j][3];
        const float rs = __builtin_amdgcn_rsqf(wave_sum(ss, lane) * (1.f / DM) + EPS);
        bf16_t* hr = P.H + (size_t)r * DM;
        f32x4 hv[4] = {xv[0] * rs * GB0 + SH0, xv[1] * rs * GB1 + SH1, xv[2] * rs * GB2 + SH2, xv[3] * rs * GB3 + SH3};
#pragma unroll
        for (int j = 0; j < 4; ++j) {
            if (P.h8) { *reinterpret_cast<unsigned*>((unsigned char*)P.H + (size_t)r * DM + 4 * lane + 256 * j) = pk4_fp8(hv[j][0] * F8_SH, hv[j][1] * F8_SH, hv[j][2] * F8_SH, hv[j][3] * F8_SH); }
            else { u32x2 w; w.x = cvtpk(hv[j][0], hv[j][1]); w.y = cvtpk(hv[j][2], hv[j][3]); *reinterpret_cast<u32x2*>(hr + 4 * lane + 256 * j) = w; } }
        if (P.router) {
            float lg[8];
#pragma unroll
            for (int e = 0; e < 8; ++e) { float a = 0.f;
#pragma unroll
                for (int j = 0; j < 4; ++j) { const f32x4 w = *reinterpret_cast<const LAS f32x4*>(rwT + e * 1024 + 4 * lane + 256 * j); a += hv[j][0] * w[0] + hv[j][1] * w[1] + hv[j][2] * w[2] + hv[j][3] * w[3]; }
                lg[e] = wave_sum(a, lane); }
            int i0 = 0; float v0 = lg[0];
#pragma unroll
            for (int e = 1; e < 8; ++e) if (lg[e] > v0) { v0 = lg[e]; i0 = e; }
            int i1 = -1; float v1 = -3.4e38f;
#pragma unroll
            for (int e = 0; e < 8; ++e) if (e != i0 && lg[e] > v1) { v1 = lg[e]; i1 = e; }
            const float w0 = 1.f / (1.f + __expf(v1 - v0)), w1 = 1.f - w0;
            if (lane == 0) { const unsigned lp0 = __hip_atomic_fetch_add(lcnt + i0, 1u, __ATOMIC_RELAXED, __HIP_MEMORY_SCOPE_WORKGROUP), lp1 = __hip_atomic_fetch_add(lcnt + i1, 1u, __ATOMIC_RELAXED, __HIP_MEMORY_SCOPE_WORKGROUP);
                LAS int* rc = rec + li * 6; rc[0] = i0; rc[1] = (int)lp0; rc[2] = i1; rc[3] = (int)lp1; rc[4] = __float_as_int(w0); rc[5] = __float_as_int(w1); }
        }
    }
}
__device__ __forceinline__ void thin_phase(Frame& F, const ThinP& P) {
    const int lane = opaque(F.lane);
    const int nlat = P.nrows < RL ? P.nrows : RL, nctx = P.nrows - nlat;
    const int chL = (nlat + F.G - 1) / F.G, chC = (nctx + F.G - 1) / F.G;
    const int r0L = F.vcu * chL, r0C = F.vcu * chC;
    const int nl = r0L >= nlat ? 0 : (r0L + chL <= nlat ? chL : nlat - r0L), nc = r0C >= nctx ? 0 : (r0C + chC <= nctx ? chC : nctx - r0C), nrw = nl + nc;
#define TROW(li_) ((li_) < nl ? r0L + (li_) : RL + r0C + ((li_) - nl))
    LAS float* rwT = (LAS float*)F.lds;
    LAS int* rec = (LAS int*)(F.lds + 32768);
    LAS unsigned* lcnt = (LAS unsigned*)(F.lds + 65536);
    unsigned cb1 = 0, cb2 = 0, cb3 = 0, cb4 = 0, cb5 = 0, cb6 = 0, cb7 = 0;
    if (P.ymode == 2) { unsigned a = 0;
        a += (xb_ld(P.cnt + 0) + 255u) & ~255u; cb1 = a; a += (xb_ld(P.cnt + 1) + 255u) & ~255u; cb2 = a; a += (xb_ld(P.cnt + 2) + 255u) & ~255u; cb3 = a;
        a += (xb_ld(P.cnt + 3) + 255u) & ~255u; cb4 = a; a += (xb_ld(P.cnt + 4) + 255u) & ~255u; cb5 = a; a += (xb_ld(P.cnt + 5) + 255u) & ~255u; cb6 = a;
        a += (xb_ld(P.cnt + 6) + 255u) & ~255u; cb7 = a; }
    if (P.router) {
        for (int i = F.tid; i < 8192; i += 512) { const int col = i >> 3, e = i & 7; rwT[e * 1024 + col] = P.router[i]; }
        if (F.tid < 16) lcnt[F.tid] = 0u;
        __syncthreads();
    }
    LAS int* rtl = (LAS int*)(F.lds + 98304) + F.wave * 6 * 64;
    if (P.ymode == 2) { const int li_ = F.wave + 8 * lane;
        if (li_ < nrw) { const int* rt = P.route + (size_t)TROW(li_) * 8; const u32x4 a = *reinterpret_cast<const u32x4*>(rt); const u32x2 b = *reinterpret_cast<const u32x2*>(rt + 4);
            LAS int* d = rtl + lane * 6; d[0] = (int)a.x; d[1] = (int)a.y; d[2] = (int)a.z; d[3] = (int)a.w; d[4] = (int)b.x; d[5] = (int)b.y; }
        LDS_WAIT(); }
    f32x4 GA0 = {}, GA1 = {}, GA2 = {}, GA3 = {}, GB0 = {}, GB1 = {}, GB2 = {}, GB3 = {}, SH0 = {}, SH1 = {}, SH2 = {}, SH3 = {}; int cur_idx = -1;
#define TH_VEC(r_) do { const int ix_ = (r_) < RL ? ((r_) >> 12) : 8; if (ix_ != cur_idx) { cur_idx = ix_; \
        if (P.ymode) { const float* gt_ = P.gate + (size_t)ix_ * 6144 + 4 * lane; const float* ga_ = P.ga + 4 * lane; \
            GA0 = *reinterpret_cast<const f32x4*>(gt_) * *reinterpret_cast<const f32x4*>(ga_); GA1 = *reinterpret_cast<const f32x4*>(gt_ + 256) * *reinterpret_cast<const f32x4*>(ga_ + 256); \
            GA2 = *reinterpret_cast<const f32x4*>(gt_ + 512) * *reinterpret_cast<const f32x4*>(ga_ + 512); GA3 = *reinterpret_cast<const f32x4*>(gt_ + 768) * *reinterpret_cast<const f32x4*>(ga_ + 768); } \
        if (P.H) { const float* sh_ = P.shsc + (size_t)ix_ * 6144 + 4 * lane; const float* gb_ = P.gb + 4 * lane; \
            GB0 = *reinterpret_cast<const f32x4*>(gb_) * (*reinterpret_cast<const f32x4*>(sh_ + 1024) + 1.f); GB1 = *reinterpret_cast<const f32x4*>(gb_ + 256) * (*reinterpret_cast<const f32x4*>(sh_ + 1280) + 1.f); \
            GB2 = *reinterpret_cast<const f32x4*>(gb_ + 512) * (*reinterpret_cast<const f32x4*>(sh_ + 1536) + 1.f); GB3 = *reinterpret_cast<const f32x4*>(gb_ + 768) * (*reinterpret_cast<const f32x4*>(sh_ + 1792) + 1.f); \
            SH0 = *reinterpret_cast<const f32x4*>(sh_); SH1 = *reinterpret_cast<const f32x4*>(sh_ + 256); SH2 = *reinterpret_cast<const f32x4*>(sh_ + 512); SH3 = *reinterpret_cast<const f32x4*>(sh_ + 768); } } } while (0)
#define TH_VARGS GA0, GA1, GA2, GA3, GB0, GB1, GB2, GB3, SH0, SH1, SH2, SH3
    TH_DECL(A_); TH_DECL(B_);
    int li = F.wave;
    if (li < nrw) TH_LOAD(A_, TROW(li), 0);
    for (int it = 0; li < nrw; li += 16, it += 2) {
        const bool hb = li + 8 < nrw;
        if (hb) TH_LOAD(B_, TROW(li + 8), it + 1);
        TH_VEC(TROW(li)); thin_proc(P, TH_ARGS(A_), TH_VARGS, TROW(li), li, lane, rwT, rec, lcnt);
        if (li + 16 < nrw) TH_LOAD(A_, TROW(li + 16), it + 2);
        if (hb) { TH_VEC(TROW(li + 8)); thin_proc(P, TH_ARGS(B_), TH_VARGS, TROW(li + 8), li + 8, lane, rwT, rec, lcnt); }
    }
    if (P.router) {
        __syncthreads();
        if (F.tid < 8) lcnt[8 + F.tid] = __hip_atomic_fetch_add(P.cnt + F.tid, lcnt[F.tid], __ATOMIC_RELAXED, __HIP_MEMORY_SCOPE_AGENT);
        __syncthreads();
        for (int i = F.tid; i < nrw; i += 512) { const LAS int* rc = rec + i * 6; int* rt = P.route + (size_t)TROW(i) * 8;
            const int e0 = rc[0], e1 = rc[2];
            rt[0] = e0; rt[1] = rc[1] + (int)lcnt[8 + e0]; rt[2] = e1; rt[3] = rc[3] + (int)lcnt[8 + e1]; rt[4] = rc[4]; rt[5] = rc[5]; }
        VM_WAIT();
        for (int lb = F.wave; lb < nrw; lb += 32) {
            u32x4 v[4]; size_t s0[4], s1[4];
#pragma unroll
            for (int q = 0; q < 4; ++q) { const int lq = lb + 8 * q; const int r = TROW(lq); if (lq < nrw) { const LAS int* rc = rec + lq * 6; const int e0 = rc[0], e1 = rc[2];
                s0[q] = (size_t)e0 * RT + (size_t)(rc[1] + (int)lcnt[8 + e0]); s1[q] = (size_t)e1 * RT + (size_t)(rc[3] + (int)lcnt[8 + e1]);
                v[q] = *(reinterpret_cast<const u32x4*>((const unsigned char*)P.H + (size_t)r * DM) + lane); } }
#pragma unroll
            for (int q = 0; q < 4; ++q) { if (lb + 8 * q < nrw) {
                *(reinterpret_cast<u32x4*>(P.HSv + s0[q] * DM) + lane) = v[q]; *(reinterpret_cast<u32x4*>(P.HSv + s1[q] * DM) + lane) = v[q]; } }
        }
        __syncthreads();
    }
#undef TROW
#undef TH_VEC
#undef TH_VARGS
}

constexpr int NPHASE = 2 + DEPTH * 9;
__global__ void __launch_bounds__(512, 2) dit_fwd(Args args) {
    extern __shared__ __attribute__((aligned(16))) unsigned char lds[];
    Frame F;
    F.lds = (LAS unsigned char*)lds; F.ldsg = lds; F.MISC = (volatile LAS unsigned*)(F.lds + MISC_OFF);
    F.tid = threadIdx.x; F.lane = F.tid & 63; F.wave = __builtin_amdgcn_readfirstlane(F.tid >> 6);
    F.G = gridDim.x; { const int bx = blockIdx.x; F.vcu = (F.G % 8 == 0) ? (bx % 8) * (F.G / 8) + bx / 8 : bx; }
    F.ctl = (unsigned*)(args.ws + WS_CTL);
    for (int u = F.tid; u < (LDS_BYTES - RING_BYTES) / 4; u += 512) ((LAS unsigned*)(F.lds + RING_BYTES))[u] = 0u;
    __syncthreads();
    XcdBarrier bar = xcd_barrier_post(F.ctl + CW_BAR, F.MISC + 8);
    const int lo = args.ph_lo, hi = args.ph_hi;
    int ph = 0;
#define IN() (lo <= ph && ph < hi)
    unsigned long long wait_acc = 0, clk_c = 0, clk_r = 0;
#define CLK_BEG(sel) unsigned long long c0_ = 0, r0_ = 0; if (PROBE_CLK == (sel)) { c0_ = __builtin_amdgcn_s_memtime(); r0_ = __builtin_amdgcn_s_memrealtime(); }
#define CLK_END(sel) if (PROBE_CLK == (sel)) { clk_c += __builtin_amdgcn_s_memtime() - c0_; clk_r += __builtin_amdgcn_s_memrealtime() - r0_; }
#define SEAM() do { if (lo <= ph && ph + 1 < hi) { if (WAITPROBE) { const unsigned long long t0_ = __builtin_amdgcn_s_memrealtime(); xcd_barrier(bar); const unsigned long long dt_ = __builtin_amdgcn_s_memrealtime() - t0_; const int k_ = ph < 2 ? 9 + ph : (ph - 2) % 9; if ((WAITSEL >> k_) & 1u) wait_acc += dt_; } else xcd_barrier(bar); } ++ph; } while (0)
    GAS unsigned char* wsg = (GAS unsigned char*)args.ws;
#define WSP ((unsigned char*)wsg)
#define pMOD    ((float*)(WSP + WS_MOD))
#define pROPECS ((f32x2*)(WSP + WS_ROPE))
#define pWP     ((bf16_t*)(WSP + WS_WP))
#define pROUTE  ((int*)(WSP + WS_ROUTE))
#define pCS     ((bf16_t*)(WSP + WS_CS))
#define pCSC    ((bf16_t*)(WSP + WS_CSC))
#define pX      ((bf16_t*)(WSP + WS_X))
#define pH      ((bf16_t*)(WSP + WS_H))
#define pYO     ((bf16_t*)(WSP + WS_YO))
#define pZ      ((bf16_t*)(WSP + WS_Z))
#define pY      ((bf16_t*)(WSP + WS_Y))
#define pPQT    ((bf16_t*)(WSP + WS_PQT))
#define pPQTC   ((bf16_t*)(WSP + WS_PQTC))
#define pOB     ((bf16_t*)(WSP + WS_O))
#define pQK8    ((unsigned char*)(WSP + WS_QK8))
#define pVT8    ((unsigned char*)(WSP + WS_VT8))
#define pA2     ((bf16_t*)(WSP + WS_A2))
#define pA2M    ((bf16_t*)(WSP + WS_A2M))
#define pHS     ((bf16_t*)(WSP + WS_HS))
    const int vcu0 = F.vcu;
#define REFRAME() do { F.tid = opaque(threadIdx.x); F.lane = F.tid & 63; F.wave = __builtin_amdgcn_readfirstlane(F.tid >> 6); F.G = sopaque((int)gridDim.x); F.vcu = sopaque(vcu0); \
        wsg = gptr(args.ws); F.ctl = (unsigned*)(WSP + WS_CTL); } while (0)
    for (int rep0 = 0; rep0 < REP_P0; ++rep0)
    if (IN() && PH_ON(0)) { REFRAME();
        const int gw = F.vcu * 8 + F.wave, NGW = F.G * 8, gt = F.vcu * 512 + F.tid, NGT = F.G * 512;
        LAS float* ctab = (LAS float*)F.lds;
        LAS float* svec = (LAS float*)(F.lds + 16384);
        if (F.tid == 0) *(LAS unsigned*)(F.lds + 126976) = 0u;
        for (int i = F.tid; i < 4096; i += 512) ctab[i] = cospif((float)i * (1.f / 2048.f));
        for (int i = F.tid; i < 9 * 1024; i += 512) { const float v = i < 8192 ? args.c[i] : args.c_ctx[i - 8192]; svec[i] = v / (1.f + __expf(-v)); }
        __syncthreads();
        for (int i = gt; i < 4096 * 512; i += NGT) { const int k = i >> 9, l0 = (i & 511) * 8; float v[8];
#pragma unroll
            for (int e = 0; e < 8; ++e) { const int col = l0 + e; const int ph_ = (k * (col <= 2048 ? col : col - 2048)) & 4095; v[e] = col <= 2048 ? ctab[ph_] : -ctab[(ph_ - 1024) & 4095]; }
            *reinterpret_cast<u32x4*>(pCS + (size_t)k * FP + l0) = (u32x4){pk2(v[0], v[1]), pk2(v[2], v[3]), pk2(v[4], v[5]), pk2(v[6], v[7])}; }
        for (int i = gt; i < 256 * 64; i += NGT) { const int k = i >> 6, l0 = (i & 63) * 8; float v[8];
#pragma unroll
            for (int e = 0; e < 8; ++e) { const int col = l0 + e, l = col & 255; const int ph_ = (k * l * 16) & 4095; v[e] = col < 256 ? ctab[ph_] : -ctab[(ph_ - 1024) & 4095]; }
            *reinterpret_cast<u32x4*>(pCSC + (size_t)k * FP + l0) = (u32x4){pk2(v[0], v[1]), pk2(v[2], v[3]), pk2(v[4], v[5]), pk2(v[6], v[7])}; }
        for (int i = gt; i < 256 * 128; i += NGT) { const int row = i >> 7, c = i & 127, m = row & 127; const int ph_ = (m * c * 32) & 4095;
            const float v = row < 128 ? ctab[ph_] : ctab[(ph_ - 1024) & 4095]; pWP[i] = (bf16_t)f2bf(v); }
        for (int i = gt; i < 64 * 16; i += NGT) { const int pos = i >> 4, k = i & 15; const float inv = __powf(10000.f, -(float)(2 * k) / 32.f); float s, c; sincosf((float)pos * inv, &s, &c); pROPECS[i] = (f32x2){c, s}; }
        for (int task = F.vcu + F.wave * F.G; task < 512; task += 8 * F.G) { const int layer = task >> 7, col = (task & 127) * 48 + F.lane;
            if (F.lane < 48) {
            const float* w = args.ada_w + (size_t)layer * DM * 6144 + col;
            float a0 = 0, a1 = 0, a2 = 0, a3 = 0, a4 = 0, a5 = 0, a6 = 0, a7 = 0, a8 = 0;
            for (int k0 = 0; k0 < DM; k0 += 32) { float wv[32];
#pragma unroll
                for (int i = 0; i < 32; ++i) wv[i] = w[(size_t)(k0 + i) * 6144];
#pragma unroll
                for (int i = 0; i < 32; ++i) { const int k = k0 + i;
                    a0 += svec[k] * wv[i]; a1 += svec[1024 + k] * wv[i]; a2 += svec[2048 + k] * wv[i]; a3 += svec[3072 + k] * wv[i]; a4 += svec[4096 + k] * wv[i];
                    a5 += svec[5120 + k] * wv[i]; a6 += svec[6144 + k] * wv[i]; a7 += svec[7168 + k] * wv[i]; a8 += svec[8192 + k] * wv[i]; } }
            const float bb = args.ada_b[layer * 6144 + col]; float* mo = pMOD + (size_t)layer * 9 * 6144 + col;
            mo[0] = a0 + bb; mo[6144] = a1 + bb; mo[2 * 6144] = a2 + bb; mo[3 * 6144] = a3 + bb; mo[4 * 6144] = a4 + bb; mo[5 * 6144] = a5 + bb; mo[6 * 6144] = a6 + bb; mo[7 * 6144] = a7 + bb; mo[8 * 6144] = a8 + bb; } }
        LAS float* scr = (LAS float*)(F.lds + 57344 + F.wave * 8448);
        LAS unsigned* wcnt = (LAS unsigned*)(F.lds + 126976);
        constexpr int NITEMS = 2 * (16 * 40) + 2 * (16 * 32) + 2 * (16 * 96) + 2 * (16 * 32) + 2 * (16 * 176) + 2 * (44 * 32) + 16 * (16 * 224) + 16 * (56 * 32);
        for (;;) {
            const int n = __builtin_amdgcn_readfirstlane((int)__hip_atomic_fetch_add(wcnt, F.lane == 0 ? 1u : 0u, __ATOMIC_RELAXED, __HIP_MEMORY_SCOPE_WORKGROUP));
            const int it = ((n >> 3) * F.G + F.vcu) * 8 + (n & 7);
            if (it >= NITEMS) break;
            int r = it;
            if (transpose_job(r, args.mix_in_w, 2, DM, MIXIN, (bf16_t*)(WSP + WS_WMIXIN), false, false, scr, F.lane)) continue;
            if (transpose_job(r, args.mix_out_w, 2, DM, DM, (bf16_t*)(WSP + WS_WMIXOUT), false, false, scr, F.lane)) continue;
            if (transpose_job(r, args.diff_qkv_w, 2, DM, 3072, (bf16_t*)(WSP + WS_WQKV), false, true, scr, F.lane)) continue;
            if (transpose_job(r, args.diff_out_w, 2, DM, DM, (bf16_t*)(WSP + WS_WDOUT), false, false, scr, F.lane)) continue;
            if (transpose_job(r, args.ffn_in_w, 2, DM, 2 * FFN, (bf16_t*)(WSP + WS_WFFNIN), true, F8_DENSE, scr, F.lane)) continue;
            if (transpose_job(r, args.ffn_out_w, 2, FFN, DM, (bf16_t*)(WSP + WS_WFFNOUT), false, F8_DENSE || F8_DDOWN, scr, F.lane)) continue;
            if (transpose_job(r, args.expert_in_w, 16, DM, 2 * EDIM, (bf16_t*)(WSP + WS_WEXPIN), true, true, scr, F.lane)) continue;
            transpose_job(r, args.expert_out_w, 16, EDIM, DM, (bf16_t*)(WSP + WS_WEXPOUT), false, true, scr, F.lane);
        }
        __syncthreads();
    }
    SEAM();
    if (IN() && PH_ON(1)) { REFRAME();
        ThinP P{}; P.nrows = RT; P.xin_lat = args.x; P.xin_ctx = args.ctx; P.ymode = 0; P.H = pH; P.gb = args.norm_g; P.shsc = pMOD;
        for (int rep = 0; rep < REP_P0B; ++rep) thin_phase(F, P);
        for (int rep = 0; rep < EXTRA_BARS; ++rep) xcd_barrier(bar);
    }
    SEAM();

    for (int layer = 0; layer < DEPTH; ++layer) {
        const int j = layer >> 1; const bool even = !(layer & 1), lastl = layer == DEPTH - 1;
        const float* modl = pMOD + (size_t)layer * 9 * 6144; const float* ng = args.norm_g + (size_t)layer * 4 * DM;
        const int Mrows = lastl ? RL : RT;
        if (IN() && PH_ON(2)) { REFRAME();
            pg8::Dims d{DM, DM}; SchedDense S;
            if (even) { S.init(pH, DM, (bf16_t*)(WSP + WS_WMIXIN) + (size_t)j * MIXIN * DM, DM, RT, MIXIN, DM, F.G, (int)blockIdx.x);
                EpiRope<false> E{WSP}; for (int rep = 0; rep < REP_PROJ; ++rep) pg8::gemm_phase(F.lds, d, S, E); }
            else { const unsigned char* wq = (const unsigned char*)(WSP + WS_WQKV) + (size_t)j * 3072 * DM;
                pg8::Dims d8{DM / 2, DM / 2};
                S.init(pH, DM / 2, wq, DM / 2, RT, 2048, DM / 2, F.G, (int)blockIdx.x);
                EpiRope<true> E{WSP}; for (int rep = 0; rep < REP_PROJ; ++rep) pg8::gemm_phase<EpiRope<true>, SchedDense, true>(F.lds, d8, S, E);
                SchedDense S2; S2.init(wq + (size_t)2048 * DM, DM / 2, pH, DM / 2, DM, RT, DM / 2, F.G, (int)((blockIdx.x + 3 * (gridDim.x / 4)) % gridDim.x));
                EpiVt E2{WSP}; for (int rep = 0; rep < REP_PROJ; ++rep) pg8::gemm_phase<EpiVt, SchedDense, true>(F.lds, d8, S2, E2); }
        }
        SEAM();
        if (IN() && PH_ON(3)) { REFRAME();
            if (even) {
                if (PH_ON(16)) { pg8::Dims d{128, MIXIN}; SchedF1 S{(const char*)pWP, (const char*)pZ, F.G, F.vcu}; EpiPQt E{pPQT, pPQTC}; for (int rep = 0; rep < REP_FOUR; ++rep) pg8::gemm_phase(F.lds, d, S, E); }
            } else {
                const float* lv = args.diff_lambda + j * 256;
                const int ln = opaque(F.lane); const float s01 = wave_sum(lv[ln] * lv[64 + ln], ln), s23 = wave_sum(lv[128 + ln] * lv[192 + ln], ln);
                const float lam_init = 0.8f - 0.6f * __expf(-0.3f * (float)layer);
                const float lam = __expf(s01) - __expf(s23) + lam_init;
                const float* subg = args.diff_subln_g + j * 128;
                const int nu = lastl ? 2048 : 2048 + 128;
                CLK_BEG(1)
                for (int rep = 0; rep < REP_DIFF; ++rep)
                for (int u = F.vcu; u < (PH_ON(18) ? nu : 0); u += F.G) {
                    if (u < 2048) diff_attn_unit((char*)lds, pVT8, pQK8, pOB, subg, lam, 1.f - lam_init, u >> 8, (u >> 5) & 7, u & 31, false);
                    else { const int v = u - 2048; diff_attn_unit((char*)lds, pVT8, pQK8, pOB, subg, lam, 1.f - lam_init, v >> 4, (v >> 1) & 7, v & 1, true); }
                }
                __syncthreads();
                CLK_END(1)
            }
        }
        SEAM();
        if (IN() && PH_ON(4)) { REFRAME();
            if (even) { pg8::Dims d{FP, FP}; SchedF2 S{(const char*)pCS, (const char*)pCSC, (const char*)pPQT, (const char*)pPQTC, F.G, F.vcu}; EpiFour2 E{pY}; for (int rep = 0; rep < REP_FOUR; ++rep) pg8::gemm_phase<EpiFour2, SchedF2, false>(F.lds, d, S, E);
                const float* sink = args.win_sink + j * 8;
                for (int rep = 0; rep < REP_WIN; ++rep)
                for (int u = F.vcu; u < (PH_ON(17) ? 1024 + 64 : 0); u += F.G) {
                    if (u < 1024) win_attn_unit2((char*)lds, pZ, pY, sink, u >> 7, (u >> 6) & 1, u & 63, false);
                    else { const int v = u - 1024; win_attn_unit2((char*)lds, pZ, pY, sink, v >> 3, (v >> 2) & 1, v & 3, true); }
                }
                __syncthreads();
            }
        }
        if (even) SEAM(); else ++ph;
        if (IN() && PH_ON(5)) { REFRAME();
            pg8::Dims d{DM, DM}; SchedDense S;
            S.init(even ? pY : pOB, DM, (bf16_t*)(WSP + (even ? WS_WMIXOUT : WS_WDOUT)) + (size_t)j * DM * DM, DM, Mrows, DM, DM, F.G, (int)blockIdx.x);
            CLK_BEG(4)
            EpiStore E{pYO, DM, 1.f}; for (int rep = 0; rep < REP_PROJ; ++rep) pg8::gemm_phase(F.lds, d, S, E);
            CLK_END(4)
        }
        SEAM();
        if (IN() && PH_ON(6)) { REFRAME();
            ThinP P{}; P.nrows = Mrows; P.xin16 = layer != 0; P.xout16 = true;
            if (layer == 0) { P.xin_lat = args.x; P.xin_ctx = args.ctx; } else { P.xin_lat = pX; P.xin_ctx = pX + (size_t)RL * DM; }
            P.xout_lat = pX; P.xout_ctx = pX + (size_t)RL * DM; P.ymode = 1; P.Ysrc = pYO; P.gate = modl + 2048; P.ga = ng + DM;
            P.H = pH; P.h8 = !even || F8_DENSE; P.gb = ng + 2 * DM; P.shsc = modl + 3072;
            if (!even) { P.router = args.router_w + (size_t)j * DM * 8; P.route = pROUTE; P.cnt = F.ctl + CW_CNT + 16 * j; P.HSv = (unsigned char*)pHS; }
            thin_phase(F, P);
        }
        SEAM();
        unsigned c0 = 0, c1 = 0, c2 = 0, c3 = 0, c4 = 0, c5 = 0, c6 = 0, c7 = 0;
        if (!even) { unsigned* cn = F.ctl + CW_CNT + 16 * j; unsigned a = 0;
            c0 = 0; a += (rfl(xb_ld(cn + 0)) + 255u) & ~255u; c1 = a; a += (rfl(xb_ld(cn + 1)) + 255u) & ~255u; c2 = a; a += (rfl(xb_ld(cn + 2)) + 255u) & ~255u; c3 = a;
            a += (rfl(xb_ld(cn + 3)) + 255u) & ~255u; c4 = a; a += (rfl(xb_ld(cn + 4)) + 255u) & ~255u; c5 = a; a += (rfl(xb_ld(cn + 5)) + 255u) & ~255u; c6 = a;
            a += (rfl(xb_ld(cn + 6)) + 255u) & ~255u; c7 = a; a += (rfl(xb_ld(cn + 7)) + 255u) & ~255u; c0 = a; }
        ++ph;
        if (IN() && PH_ON(8)) { REFRAME();
            const bool f8 = !even || F8_DENSE; const int eb = f8 ? 1 : 2;
            pg8::Dims d{DM * eb / 2, DM * eb / 2}; SchedGroup S;
            if (even) { S.A = (const char*)pH; S.B = (const char*)(WSP + WS_WFFNIN) + (size_t)j * 2 * FFN * DM * eb; S.nRT = RT / 256; S.P1 = S.P2 = S.P3 = S.P4 = S.P5 = S.P6 = S.P7 = 1 << 30; S.nN = 2 * FFN / 256; S.gB = 0; S.aE = 0; }
            else { S.aE = (size_t)RT * DM; S.A = (const char*)pHS; S.B = (const char*)(WSP + WS_WEXPIN) + (size_t)j * NEXP * 2 * EDIM * DM; S.nRT = (int)(c0 >> 8);
                S.P1 = (int)(c1 >> 8); S.P2 = (int)(c2 >> 8); S.P3 = (int)(c3 >> 8); S.P4 = (int)(c4 >> 8); S.P5 = (int)(c5 >> 8); S.P6 = (int)(c6 >> 8); S.P7 = (int)(c7 >> 8);
                S.nN = 2 * EDIM / 256; S.gB = (size_t)2 * EDIM * DM; }
            S.nwg = S.nRT * S.nN; S.G = F.G; S.c = (int)blockIdx.x; S.nkt = DM * eb / 128; S.tA = (size_t)256 * DM * eb; S.tB = (size_t)256 * DM * eb;
            CLK_BEG(even ? 2 : 3)
            if (f8) { EpiSwiglu<true> E{(unsigned char*)(even ? pA2 : pA2M), even ? FFN : EDIM, 1.f / (F8_SH * F8_SW)}; for (int rep = 0; rep < REP_MOE; ++rep) pg8::gemm_phase<EpiSwiglu<true>, SchedGroup, true, ALIGN_SWIGLU>(F.lds, d, S, E); }
            else if (F8_DDOWN) { EpiSwiglu<true> E{(unsigned char*)pA2, FFN, 1.f}; for (int rep = 0; rep < REP_MOE; ++rep) pg8::gemm_phase<EpiSwiglu<true>, SchedGroup, false>(F.lds, d, S, E); }
            else { EpiSwiglu<false> E{(unsigned char*)pA2, FFN, 1.f}; for (int rep = 0; rep < REP_MOE; ++rep) pg8::gemm_phase<EpiSwiglu<false>, SchedGroup, false>(F.lds, d, S, E); }
            CLK_END(even ? 2 : 3)
        }
        SEAM();
        if (IN() && PH_ON(9)) { REFRAME();
            const bool f8 = !even || F8_DENSE || F8_DDOWN; const int eb = f8 ? 1 : 2;
            const int Kh = even ? FFN : EDIM; pg8::Dims d{Kh * eb / 2, Kh * eb / 2}; SchedGroup S;
            if (even) { S.A = (const char*)pA2; S.B = (const char*)(WSP + WS_WFFNOUT) + (size_t)j * DM * FFN * eb; S.nRT = RT / 256; S.P1 = S.P2 = S.P3 = S.P4 = S.P5 = S.P6 = S.P7 = 1 << 30; S.gB = 0; }
            else { S.A = (const char*)pA2M; S.B = (const char*)(WSP + WS_WEXPOUT) + (size_t)j * NEXP * DM * EDIM; S.nRT = (int)(c0 >> 8);
                S.P1 = (int)(c1 >> 8); S.P2 = (int)(c2 >> 8); S.P3 = (int)(c3 >> 8); S.P4 = (int)(c4 >> 8); S.P5 = (int)(c5 >> 8); S.P6 = (int)(c6 >> 8); S.P7 = (int)(c7 >> 8);
                S.gB = (size_t)DM * EDIM; }
            S.aE = 0; S.nN = DM / 256; S.nwg = S.nRT * S.nN; S.G = F.G; S.c = (int)blockIdx.x; S.nkt = Kh * eb / 128; S.tA = (size_t)256 * Kh * eb; S.tB = (size_t)256 * Kh * eb;
            if (f8) { EpiStore E{even ? pYO : pHS, DM, 1.f / (F8_SA * F8_SW)}; for (int rep = 0; rep < REP_MOE; ++rep) pg8::gemm_phase<EpiStore, SchedGroup, true>(F.lds, d, S, E); }
            else { EpiStore E{pYO, DM, 1.f}; for (int rep = 0; rep < REP_MOE; ++rep) pg8::gemm_phase<EpiStore, SchedGroup, false>(F.lds, d, S, E); }
        }
        SEAM();
        if (IN() && PH_ON(10)) { REFRAME();
            ThinP P{}; P.nrows = Mrows; P.xin16 = true; P.xout16 = !lastl; P.xin_lat = pX; P.xin_ctx = pX + (size_t)RL * DM;
            if (lastl) P.xout_lat = args.out; else P.xout_lat = pX;
            P.xout_ctx = pX + (size_t)RL * DM; P.ymode = even ? 1 : 2; P.Ysrc = even ? pYO : pHS; P.gate = modl + 5120; P.ga = ng + 3 * DM;
            P.route = pROUTE; P.cnt = F.ctl + CW_CNT + 16 * j;
            if (!lastl) { P.H = pH; P.h8 = even; P.gb = ng + 4 * DM; P.shsc = modl + 9 * 6144; }
            thin_phase(F, P);
        }
        SEAM();
    }
    if (PROBE_CLK) {
        const unsigned long long dur_ = clk_r ? clk_c * 5000ull / clk_r : 0ull, t0_ = __builtin_amdgcn_s_memrealtime();
        while (__builtin_amdgcn_s_memrealtime() - t0_ < dur_) __builtin_amdgcn_s_sleep(8);
    }
    if (WAITPROBE) {
        unsigned* wsum = F.ctl + 48;
        if (threadIdx.x == 0) __hip_atomic_fetch_add(wsum, (unsigned)wait_acc, __ATOMIC_RELAXED, __HIP_MEMORY_SCOPE_AGENT);
        xcd_barrier(bar);
        const unsigned mean = xb_ld(wsum) / gridDim.x; const unsigned long long t0_ = __builtin_amdgcn_s_memrealtime();
        while (__builtin_amdgcn_s_memrealtime() - t0_ < (unsigned long long)mean * WAITPROBE) __builtin_amdgcn_s_sleep(8);
    }
#undef IN
#undef SEAM
#undef REFRAME
}

#ifndef MK_PER_PHASE
#define MK_PER_PHASE 0
#endif
extern "C" void kernel_launch(void* const* d_in, const int* in_sizes, int n_in, void* d_out, int out_size, void* d_ws, size_t ws_size, hipStream_t stream) {
    static int grid = 0;
    if (grid == 0) {
        if (n_in != 19 || in_sizes[0] != RL * DM || out_size != RL * DM || ws_size < WS_END) {
            fprintf(stderr, "kernel_launch: unexpected shapes / workspace (n_in %d in0 %d out %d ws %zu need %zu)\n", n_in, n_in > 0 ? in_sizes[0] : -1, out_size, ws_size, (size_t)WS_END); grid = -1; return; }
        int dev = 0, cus = 0, per_cu = 0;
        if (hipGetDevice(&dev) != hipSuccess || hipDeviceGetAttribute(&cus, hipDeviceAttributeMultiprocessorCount, dev) != hipSuccess) { grid = -1; return; }
        if (hipFuncSetAttribute((const void*)dit_fwd, hipFuncAttributeMaxDynamicSharedMemorySize, LDS_BYTES) != hipSuccess) { fprintf(stderr, "kernel_launch: hipFuncSetAttribute failed\n"); grid = -1; return; }
        if (hipOccupancyMaxActiveBlocksPerMultiprocessor(&per_cu, (const void*)dit_fwd, 512, LDS_BYTES) != hipSuccess || per_cu < 1)
            fprintf(stderr, "kernel_launch: occupancy query reports %d\n", per_cu);
        (void)hipGetLastError();
        grid = cus;
    }
    if (grid < 0) return;
    if (hipMemsetAsync((char*)d_ws + WS_CTL, 0, CTL_BYTES, stream) != hipSuccess) return;
    Args a{};
    const float** ap = (const float**)&a;
    for (int i = 0; i < 19; ++i) ap[i] = (const float*)d_in[i];
    a.out = (float*)d_out; a.ws = (unsigned char*)d_ws;
#if MK_PER_PHASE
    for (int p = 0; p < NPHASE; ++p) { a.ph_lo = p; a.ph_hi = p + 1; hipLaunchKernelGGL(dit_fwd, dim3(grid), dim3(512), LDS_BYTES, stream, a); }
#else
    a.ph_lo = 0; a.ph_hi = NPHASE;
    hipLaunchKernelGGL(dit_fwd, dim3(grid), dim3(512), LDS_BYTES, stream, a);
#endif
}
```

```cpp
#include <hip/hip_runtime.h>
#include <cstdio>
#include <cstdint>

#ifndef PHMASK
#define PHMASK 0xFFFFFFFFu
#endif
#define PH_ON(i) ((PHMASK >> (i)) & 1u)
#ifndef REP_DIFF
#define REP_DIFF 1
#endif
#ifndef REP_MOE
#define REP_MOE 1
#endif
#ifndef REP_P0
#define REP_P0 1
#endif
#ifndef REP_P0B
#define REP_P0B 1
#endif
#ifndef EXTRA_BARS
#define EXTRA_BARS 0
#endif
#ifndef REP_EPI
#define REP_EPI 1
#endif
#ifndef WAITSEL
#define WAITSEL 0xFFFFu
#endif
#ifndef WAITPROBE
#define WAITPROBE 0
#endif
#ifndef KREP
#define KREP 1
#endif
#ifndef REP_PROJ
#define REP_PROJ 1
#endif
#ifndef REP_FOUR
#define REP_FOUR 1
#endif
#ifndef REP_WIN
#define REP_WIN 1
#endif
#ifndef PROBE_CLK
#define PROBE_CLK 0
#endif
#define LAS __attribute__((address_space(3)))
#define GAS __attribute__((address_space(1)))
typedef unsigned short bf16_t;
typedef short bf16x8 __attribute__((ext_vector_type(8)));
typedef short s16x4 __attribute__((ext_vector_type(4)));
typedef float f32x2 __attribute__((ext_vector_type(2)));
typedef float f32x4 __attribute__((ext_vector_type(4)));
typedef float f32x16 __attribute__((ext_vector_type(16)));
typedef unsigned u32x2 __attribute__((ext_vector_type(2)));
typedef unsigned u32x4 __attribute__((ext_vector_type(4)));
typedef __bf16 bf16x2_t __attribute__((ext_vector_type(2)));
typedef int v8i_t __attribute__((ext_vector_type(8)));

constexpr int DM = 1024, NB = 8, SEQ = 4096, CTX = 256, DEPTH = 4;
constexpr int RL = NB * SEQ, RC = NB * CTX, RT = RL + RC;
constexpr int MIXIN = 1280, FFN = 2816, NEXP = 8, EDIM = 3584;
constexpr int MAXSLOT = 71680;
constexpr float EPS = 1e-6f;
constexpr float LOG2E = 1.4426950408889634f;
constexpr float QK_C = 0.125f * LOG2E;

constexpr size_t MiB = 1u << 20;
constexpr size_t WS_CTL = 0, CTL_BYTES = 32 * 1024;
constexpr size_t WS_MOD = 1 * MiB;
constexpr size_t WS_ROPE = WS_MOD + 900 * 1024;
constexpr size_t WS_WP = WS_ROPE + 8 * 1024;
constexpr size_t WS_ROUTE = 2 * MiB;
constexpr size_t WS_CS = 4 * MiB;
constexpr size_t WS_CSC = 68 * MiB;
constexpr size_t WS_WMIXIN = 72 * MiB;
constexpr size_t WS_WMIXOUT = 77 * MiB;
constexpr size_t WS_WQKV = 81 * MiB;
constexpr size_t WS_WDOUT = 93 * MiB;
constexpr size_t WS_WFFNIN = 97 * MiB;
constexpr size_t WS_WFFNOUT = 119 * MiB;
constexpr size_t WS_WEXPIN = 130 * MiB;
constexpr size_t WS_WEXPOUT = 354 * MiB;
constexpr size_t WS_X = 466 * MiB;
constexpr size_t WS_H = 602 * MiB;
constexpr size_t WS_YO = 670 * MiB;
constexpr size_t WS_RA = 738 * MiB;
constexpr size_t WS_Z = WS_RA;
constexpr size_t WS_VT8 = WS_RA;
constexpr size_t WS_Y = WS_RA + 85 * MiB;
constexpr size_t WS_PQT = WS_RA + 153 * MiB;
constexpr size_t WS_O = WS_RA + 204 * MiB;
constexpr size_t WS_RB = 1010 * MiB;
constexpr size_t WS_A2 = WS_RB;
constexpr size_t WS_QK8 = WS_RB;
constexpr size_t WS_PQTC = WS_RB + 190 * MiB;
constexpr size_t WS_A2M = WS_H;
constexpr size_t WS_HS = 1092 * MiB;
constexpr size_t WS_END = 1364 * MiB;
static_assert(WS_A2M + (size_t)MAXSLOT * EDIM * 2 <= WS_HS, "A2m overlay");
static_assert(WS_HS + (size_t)NEXP * RT * DM <= WS_END && WS_HS + (size_t)MAXSLOT * DM * 2 <= WS_END && WS_PQTC + 64 * MiB <= WS_END, "ws end");

constexpr int CW_TMO = 0;
constexpr int CW_CNT = 64;
constexpr int CW_BAR = 4096;

constexpr int RING_BYTES = 131072;
constexpr int MISC_OFF = RING_BYTES + 320;
constexpr int LDS_BYTES = 147456;

__device__ __forceinline__ unsigned cvtpk(float lo, float hi) { f32x2 v = {lo, hi}; bf16x2_t b = __builtin_convertvector(v, bf16x2_t); return __builtin_bit_cast(unsigned, b); }
#ifndef F8_DENSE
#define F8_DENSE false
#endif
#ifndef F8_DDOWN
#define F8_DDOWN true
#endif
#ifndef F8_FOUR
#define F8_FOUR false
#endif
static_assert(!F8_FOUR, "fp8 Fourier path retired");
constexpr int FP = 4096;
constexpr float F8_SCS = 256.f, F8_SPQ = 8.f;
constexpr float F8_SH = 4.f, F8_SW = 64.f, F8_SA = 4.f;
__device__ __forceinline__ float f8clamp(float v) { return __builtin_amdgcn_fmed3f(v, -448.f, 448.f); }
__device__ __forceinline__ unsigned pk4_fp8(float a, float b, float c, float d) {
    unsigned w = 0; w = __builtin_amdgcn_cvt_pk_fp8_f32(f8clamp(a), f8clamp(b), w, false); w = __builtin_amdgcn_cvt_pk_fp8_f32(f8clamp(c), f8clamp(d), w, true); return w; }
__device__ __forceinline__ float bf_lo(unsigned u) { return __uint_as_float(u << 16); }
__device__ __forceinline__ float bf_hi(unsigned u) { return __uint_as_float(u & 0xffff0000u); }
__device__ __forceinline__ float wave_sum(float v, int lane) {
#pragma unroll
    for (int o = 1; o < 64; o <<= 1) v += __int_as_float(__builtin_amdgcn_ds_bpermute((lane ^ o) << 2, __float_as_int(v)));
    return v;
}
__device__ __forceinline__ unsigned rfl(unsigned v) { return (unsigned)__builtin_amdgcn_readfirstlane((int)v); }
__device__ __forceinline__ const char* uptr(const char* p) {
    unsigned lo = (unsigned)__builtin_amdgcn_readfirstlane((int)(unsigned)(uintptr_t)p), hi = (unsigned)__builtin_amdgcn_readfirstlane((int)(unsigned)((uintptr_t)p >> 32));
    asm volatile("" : "+s"(lo), "+s"(hi));
    return (const char*)(((uintptr_t)hi << 32) | lo);
}
__device__ __forceinline__ GAS unsigned char* gptr(const void* p) {
    unsigned lo = (unsigned)__builtin_amdgcn_readfirstlane((int)(unsigned)(uintptr_t)p), hi = (unsigned)__builtin_amdgcn_readfirstlane((int)(unsigned)((uintptr_t)p >> 32));
    asm volatile("" : "+s"(lo), "+s"(hi));
    return (GAS unsigned char*)(((uintptr_t)hi << 32) | lo);
}
__device__ __forceinline__ int sopaque(int v) { v = __builtin_amdgcn_readfirstlane(v); asm volatile("" : "+s"(v)); return v; }
__device__ __forceinline__ int opaque(int v) { asm volatile("" : "+v"(v)); return v; }
#define LDS_WAIT() asm volatile("s_waitcnt lgkmcnt(0)" ::: "memory")
#define VM_WAIT() asm volatile("s_waitcnt vmcnt(0)" ::: "memory")
#define SBAR() __builtin_amdgcn_sched_barrier(0)

namespace pg8 {
constexpr int BM = 256, BK = 64, HALF = 128, HTB = HALF * BK * 2, STAGE_BYTES = 8 * HTB, NXCD = 8, WGM = 8;
__host__ __device__ __forceinline__ int lds_byte(int r, int c) { const int st = (r >> 4) * 2 + (c >> 5), rr = r & 15, cc = c & 31, ob = rr * 64 + cc * 2; return st * 1024 + (ob ^ (((ob >> 9) & 1) << 5)); }
__host__ __device__ __forceinline__ void stage_rc(int b, int& R, int& C) { const int st = b / 1024, sb = b % 1024, swz = sb ^ (((sb >> 9) & 1) << 5); R = (st >> 1) * 16 + swz / 64; C = (st & 1) * 32 + (swz % 64) / 2; }
__host__ __device__ __forceinline__ int perm32(int rho) { const int n = rho >> 4, i = rho & 15; return 8 * (i >> 2) + 4 * n + (i & 3); }

struct Unit { int pm, pn, e, nkt; };
struct Dims { int lda, ldb; };

__device__ __forceinline__ int xcd_remap(int wgid, int nwg) {
    const int q = nwg / NXCD, r = nwg % NXCD, xcd = wgid % NXCD, off = wgid / NXCD;
    return (xcd < r ? xcd * (q + 1) : r * (q + 1) + (xcd - r) * q) + off;
}

#ifndef ALIGN_SWIGLU
#define ALIGN_SWIGLU true
#endif
#ifndef ALIGN_DEFAULT
#define ALIGN_DEFAULT true
#endif
template <class Epi, class Sched, bool F8 = false, bool ALIGN_EPI = ALIGN_DEFAULT>
__device__ __forceinline__ void gemm_phase(LAS unsigned char* lds, const Dims g, const Sched& S, const Epi& E) {
    const int tid = opaque(threadIdx.x), wid = __builtin_amdgcn_readfirstlane(tid >> 6), lane = tid & 63, wr = wid >> 2, wc = wid & 3, fr = lane & 15, fq = lane >> 4;
    unsigned voffA[2], voffB[2];
#pragma unroll
    for (int i = 0; i < 2; ++i) { int R, C; stage_rc(tid * 16 + i * 8192, R, C); const int Rb = Epi::PERM ? ((R & ~31) + perm32(R & 31)) : R;
        voffA[i] = (unsigned)(R * g.lda + C) * 2u; voffB[i] = (unsigned)(Rb * g.ldb + C) * 2u; }
    const size_t kstep = (size_t)(BK * 2);
    const size_t hstepA = (size_t)HALF * g.lda * 2, hstepB = (size_t)HALF * g.ldb * 2;
    const unsigned ldsw = (unsigned)wid * 1024u;
    const int aoff = lds_byte(wr * 64 + fr, fq * 8), boff = lds_byte(wc * 32 + fr, fq * 8);
#define PG8_SA(b, h) (((b) * 2 + (h)) * HTB)
#define PG8_SB(b, h) ((4 + (b) * 2 + (h)) * HTB)
#define PG8_STAGE(bufoff, gbase, voff) do { _Pragma("unroll") for (int _i = 0; _i < 2; ++_i) \
        __builtin_amdgcn_global_load_lds((const unsigned*)((const char*)(gbase) + (voff)[_i]), (LAS unsigned*)(lds + (bufoff) + ldsw + _i * 8192), 16, 0, 0); } while (0)
#define PG8_LDA(dst, b, h) do { _Pragma("unroll") for (int m = 0; m < 4; ++m) _Pragma("unroll") for (int k = 0; k < 2; ++k) dst[m][k] = *(const LAS bf16x8*)(lds + PG8_SA(b, h) + aoff + m * 2048 + k * 1024); } while (0)
#define PG8_LDB(dst, b, h) do { _Pragma("unroll") for (int n = 0; n < 2; ++n) _Pragma("unroll") for (int k = 0; k < 2; ++k) dst[n][k] = *(const LAS bf16x8*)(lds + PG8_SB(b, h) + boff + n * 2048 + k * 1024); } while (0)
#define PG8_V8(x) __builtin_bit_cast(v8i_t, (x))
#define PG8_MMA(ai, bj, At, Bt) do { __builtin_amdgcn_s_setprio(1); _Pragma("unroll") for (int m = 0; m < 4; ++m) _Pragma("unroll") for (int n = 0; n < 2; ++n) { \
        if constexpr (F8) { struct P2 { bf16x8 a, b; }; const v8i_t a8_ = PG8_V8((P2{Bt[n][0], Bt[n][1]})), b8_ = PG8_V8((P2{At[m][0], At[m][1]})); \
            asm volatile("v_mfma_f32_16x16x128_f8f6f4 %0, %1, %2, %0" : "+v"(acc[ai][bj][m][n]) : "v"(a8_), "v"(b8_)); }   \
        else { _Pragma("unroll") for (int k = 0; k < 2; ++k) acc[ai][bj][m][n] = __builtin_amdgcn_mfma_f32_16x16x32_bf16(Bt[n][k], At[m][k], acc[ai][bj][m][n], 0, 0, 0); } } \
        __builtin_amdgcn_s_setprio(0); } while (0)
#define PG8_WAIT_V(n) asm volatile("s_waitcnt vmcnt(" #n ")" ::: "memory")
#define PG8_WAIT_L(n) asm volatile("s_waitcnt lgkmcnt(" #n ")" ::: "memory")
#define PG8_BAR __builtin_amdgcn_s_barrier()
#define PG8_SCHED __builtin_amdgcn_sched_barrier(0)
    Unit cur, nxt; int ui = 0;
    if (!S.next(0, cur)) return;
    constexpr bool MIR = Sched::MIRROR;
    unsigned vB2c[2] = {0u, 0u}, vB2n[2] = {0u, 0u}; const char* cB2 = nullptr; const char* nB2 = nullptr;
#define PG8_MKV2(dst, un) do { const int t2_ = opaque(threadIdx.x); _Pragma("unroll") for (int i_ = 0; i_ < 2; ++i_) { int R_, C_; stage_rc(t2_ * 16 + i_ * 8192, R_, C_); \
        const int Rb_ = Epi::PERM ? ((R_ & ~31) + perm32(R_ & 31)) : R_; dst[i_] = S.voff2(un, Rb_, C_, g.ldb); } } while (0)
    if constexpr (MIR) { PG8_MKV2(vB2c, cur); cB2 = uptr(S.bptr2(cur)); }
    f32x4 acc[2][2][4][2];
#pragma unroll
    for (int a = 0; a < 2; ++a)
#pragma unroll
        for (int b = 0; b < 2; ++b)
#pragma unroll
            for (int m = 0; m < 4; ++m)
#pragma unroll
                for (int n = 0; n < 2; ++n) acc[a][b][m][n] = (f32x4){0.f, 0.f, 0.f, 0.f};
    bf16x8 At[4][2], B0[2][2], B1[2][2];
    const char* cA = uptr(S.aptr(cur)); const char* cB = uptr(S.bptr(cur));
    PG8_STAGE(PG8_SB(0, 0), cB, voffB); if constexpr (MIR) PG8_STAGE(PG8_SB(0, 1), cB2, vB2c); else PG8_STAGE(PG8_SB(0, 1), cB + hstepB, voffB); PG8_STAGE(PG8_SA(0, 0), cA, voffA); PG8_STAGE(PG8_SA(0, 1), cA + hstepA, voffA);
    if (wr == 1) PG8_BAR;
    PG8_WAIT_V(2); PG8_BAR;
    PG8_STAGE(PG8_SB(1, 0), cB + kstep, voffB); PG8_STAGE(PG8_SA(1, 0), cA + kstep, voffA); if constexpr (MIR) PG8_STAGE(PG8_SB(1, 1), cB2 + kstep, vB2c); else PG8_STAGE(PG8_SB(1, 1), cB + hstepB + kstep, voffB);
    PG8_WAIT_V(6); PG8_BAR;
    for (;;) {
        const bool has_next = S.next(ui + 1, nxt);
        const char* nA = uptr(has_next ? S.aptr(nxt) : cA); const char* nB = uptr(has_next ? S.bptr(nxt) : cB);
        if constexpr (MIR) { if (has_next) { PG8_MKV2(vB2n, nxt); nB2 = uptr(S.bptr2(nxt)); } else { vB2n[0] = vB2c[0]; vB2n[1] = vB2c[1]; nB2 = cB2; } }
        const int nt = sopaque(cur.nkt);
        for (int t = 0; t < KREP * nt; t += 2) {
            const bool last = (t == KREP * nt - 2);
            const char* a1 = cA + (size_t)(KREP == 1 ? t + 1 : (t + 1) % nt) * kstep;
            const char* a2 = last ? nA : cA + (size_t)(KREP == 1 ? t + 2 : (t + 2) % nt) * kstep; const char* b2 = last ? nB : cB + (size_t)(KREP == 1 ? t + 2 : (t + 2) % nt) * kstep;
            const char* a3 = a2 + kstep; const char* b3 = b2 + kstep;
            const char* m2 = nullptr; unsigned vm[2] = {0u, 0u};
            if constexpr (MIR) { m2 = last ? nB2 : cB2 + (size_t)(t + 2) * kstep; vm[0] = last ? vB2n[0] : vB2c[0]; vm[1] = last ? vB2n[1] : vB2c[1]; }
            PG8_LDB(B0, 0, 0); PG8_LDB(B1, 0, 1); PG8_SCHED; PG8_LDA(At, 0, 0); PG8_STAGE(PG8_SA(1, 1), a1 + hstepA, voffA);
            PG8_WAIT_V(8); PG8_WAIT_L(0); PG8_BAR; PG8_MMA(0, 0, At, B0); PG8_MMA(0, 1, At, B1); PG8_BAR; PG8_SCHED;
            PG8_LDA(At, 0, 1); PG8_STAGE(PG8_SB(0, 0), b2, voffB); if constexpr (MIR) PG8_STAGE(PG8_SB(0, 1), m2, vm); else PG8_STAGE(PG8_SB(0, 1), b2 + hstepB, voffB); PG8_STAGE(PG8_SA(0, 0), a2, voffA);
            PG8_WAIT_V(8); PG8_WAIT_L(0); PG8_BAR; PG8_MMA(1, 0, At, B0); PG8_MMA(1, 1, At, B1); PG8_BAR; PG8_SCHED;
            PG8_LDB(B0, 1, 0); PG8_LDB(B1, 1, 1); PG8_SCHED; PG8_LDA(At, 1, 0); PG8_STAGE(PG8_SA(0, 1), a2 + hstepA, voffA);
            PG8_WAIT_V(8); PG8_WAIT_L(0); PG8_BAR; PG8_MMA(0, 0, At, B0); PG8_MMA(0, 1, At, B1); PG8_BAR; PG8_SCHED;
            PG8_LDA(At, 1, 1); PG8_STAGE(PG8_SB(1, 0), b3, voffB); if constexpr (MIR) PG8_STAGE(PG8_SB(1, 1), m2 + kstep, vm); else PG8_STAGE(PG8_SB(1, 1), b3 + hstepB, voffB); PG8_STAGE(PG8_SA(1, 0), a3, voffA);
            PG8_WAIT_V(8); PG8_WAIT_L(0); PG8_BAR; PG8_MMA(1, 0, At, B0); PG8_MMA(1, 1, At, B1); PG8_BAR; PG8_SCHED;
        }
        if constexpr (ALIGN_EPI) { if (wr == 0) PG8_BAR; }
        if constexpr (F8) asm volatile("s_nop 15\n\ts_nop 15" ::: "memory");
        for (int repe = 0; repe < REP_EPI; ++repe) { const int l2 = opaque(threadIdx.x) & 63; E(acc, cur, wr, wc, l2 & 15, l2 >> 4); }
        if (!has_next) break;
#pragma unroll
        for (int a = 0; a < 2; ++a)
#pragma unroll
            for (int b = 0; b < 2; ++b)
#pragma unroll
                for (int m = 0; m < 4; ++m)
#pragma unroll
                    for (int n = 0; n < 2; ++n) acc[a][b][m][n] = (f32x4){0.f, 0.f, 0.f, 0.f};
        cur = nxt; cA = nA; cB = nB; ++ui;
        if constexpr (MIR) { cB2 = nB2; vB2c[0] = vB2n[0]; vB2c[1] = vB2n[1]; }
        if constexpr (ALIGN_EPI) { if (wr == 1) PG8_BAR; }
    }
    PG8_WAIT_V(0);
    if constexpr (!ALIGN_EPI) { if (wr == 0) PG8_BAR; }
    PG8_BAR;
#undef PG8_MKV2
#undef PG8_SA
#undef PG8_SB
#undef PG8_STAGE
#undef PG8_LDA
#undef PG8_LDB
#undef PG8_MMA
#undef PG8_V8
#undef PG8_WAIT_V
#undef PG8_WAIT_L
#undef PG8_BAR
#undef PG8_SCHED
}
}
using pg8::Unit;

struct EpiStore {
    static constexpr bool PERM = true;
    bf16_t* O; int ldc; float scale;
    __device__ __forceinline__ void operator()(const f32x4 (&acc)[2][2][4][2], const Unit& u, int wr, int wc, int fr, int fq) const {
        const int row0 = u.pm * 256 + wr * 64 + fr, col0 = u.pn * 256 + wc * 32 + 8 * fq;
#pragma unroll
        for (int ai = 0; ai < 2; ++ai)
#pragma unroll
            for (int m = 0; m < 4; ++m) { bf16_t* rowp = O + (size_t)(row0 + ai * 128 + m * 16) * ldc + col0;
#pragma unroll
                for (int bj = 0; bj < 2; ++bj) { const f32x4 v0 = acc[ai][bj][m][0] * (scale * (1.f / KREP)), v1 = acc[ai][bj][m][1] * (scale * (1.f / KREP));
                    u32x4 w; w.x = cvtpk(v0[0], v0[1]); w.y = cvtpk(v0[2], v0[3]); w.z = cvtpk(v1[0], v1[1]); w.w = cvtpk(v1[2], v1[3]);
                    *(u32x4*)(rowp + bj * 128) = w; } }
    }
};
template <bool F8OUT> struct EpiSwiglu {
    static constexpr bool PERM = true;
    unsigned char* O; int ldc; float scale;
    __device__ __forceinline__ void operator()(const f32x4 (&acc)[2][2][4][2], const Unit& u, int wr, int wc, int fr, int fq) const {
        const int row0 = u.pm * 256 + wr * 64 + fr, col0 = u.pn * 128 + wc * 32 + 8 * fq;
        const float us = F8OUT ? scale * F8_SA : scale;
        const float k1 = -scale * LOG2E * (1.f / KREP), ik2 = 1.f / (scale * us * (1.f / KREP) * (1.f / KREP));
#pragma unroll
        for (int ai = 0; ai < 2; ++ai)
#pragma unroll
            for (int m = 0; m < 4; ++m) { unsigned char* rowp = O + ((size_t)(row0 + ai * 128 + m * 16) * ldc + col0) * (F8OUT ? 1 : 2);
                float r[8];
#pragma unroll
                for (int n = 0; n < 2; ++n) { const f32x4 g = acc[ai][0][m][n], u = acc[ai][1][m][n]; const f32x4 t = g * k1;
                    f32x4 e; e[0] = __builtin_amdgcn_exp2f(t[0]); e[1] = __builtin_amdgcn_exp2f(t[1]); e[2] = __builtin_amdgcn_exp2f(t[2]); e[3] = __builtin_amdgcn_exp2f(t[3]);
                    const f32x4 d = e * ik2 + ik2;
                    f32x4 q; q[0] = __builtin_amdgcn_rcpf(d[0]); q[1] = __builtin_amdgcn_rcpf(d[1]); q[2] = __builtin_amdgcn_rcpf(d[2]); q[3] = __builtin_amdgcn_rcpf(d[3]);
                    const f32x4 o = (g * u) * q; r[n * 4 + 0] = o[0]; r[n * 4 + 1] = o[1]; r[n * 4 + 2] = o[2]; r[n * 4 + 3] = o[3]; }
                if constexpr (F8OUT) { u32x2 w; w.x = pk4_fp8(r[0], r[1], r[2], r[3]); w.y = pk4_fp8(r[4], r[5], r[6], r[7]); *(u32x2*)rowp = w; }
                else { u32x4 w; w.x = cvtpk(r[0], r[1]); w.y = cvtpk(r[2], r[3]); w.z = cvtpk(r[4], r[5]); w.w = cvtpk(r[6], r[7]); *(u32x4*)rowp = w; } }
    }
};
template <bool ODD> struct EpiRope {
    static constexpr bool PERM = false;
    unsigned char* ws;
    static constexpr int ldc = ODD ? 3072 : MIXIN, rlo = ODD ? 0 : 4, rhi = ODD ? 16 : 9, qlo = ODD ? 0 : 4, qhi = 8, f8hi = ODD ? 16 : 0;
    __device__ __forceinline__ void operator()(const f32x4 (&acc)[2][2][4][2], const Unit& u, int wr, int wc, int fr, int fq) const {
        const float ascale = ODD ? 1.f / (F8_SH * F8_SW) : 1.f, qscale = QK_C;
        bf16_t* O = (bf16_t*)(ws + WS_Z); const f32x2* cs = (const f32x2*)(ws + WS_ROPE); unsigned char* O8 = ws + WS_QK8;
        const int row0 = u.pm * 256 + wr * 64 + fr, col0 = u.pn * 256 + wc * 32 + 4 * fq;
        const bool lat = u.pm < 128;
#pragma unroll
        for (int ai = 0; ai < 2; ++ai)
#pragma unroll
            for (int m = 0; m < 4; ++m) { const int row = row0 + ai * 128 + m * 16; bf16_t* rowp = O + (size_t)row * ldc + col0;
                const int t = row & 4095, pos = (wc & 1) ? (t & 63) : (t >> 6);
                const f32x2* c4 = cs + pos * 16 + 4 * fq;
                const f32x2 c0 = c4[0], c1 = c4[1], c2 = c4[2], c3 = c4[3];
#pragma unroll
                for (int bj = 0; bj < 2; ++bj) { f32x4 p1 = acc[ai][bj][m][0] * (ascale * (1.f / KREP)), p2 = acc[ai][bj][m][1] * (ascale * (1.f / KREP));
                    const int blk = u.pn * 2 + bj;
                    if (lat && blk >= rlo && blk < rhi) {
                        const f32x4 cv = {c0.x, c1.x, c2.x, c3.x}, sv = {c0.y, c1.y, c2.y, c3.y};
                        const f32x4 o1 = p1 * cv - p2 * sv, o2 = p2 * cv + p1 * sv; p1 = o1; p2 = o2; }
                    if (blk >= qlo && blk < qhi) { p1 = p1 * qscale; p2 = p2 * qscale; }
                    if (ODD) { unsigned char* r8 = O8 + (size_t)row * 2048 + col0 + bj * 128;
                        *(unsigned*)r8 = pk4_fp8(p1[0], p1[1], p1[2], p1[3]); *(unsigned*)(r8 + 16) = pk4_fp8(p2[0], p2[1], p2[2], p2[3]); }
                    else { u32x2 w1, w2; w1.x = cvtpk(p1[0], p1[1]); w1.y = cvtpk(p1[2], p1[3]); w2.x = cvtpk(p2[0], p2[1]); w2.y = cvtpk(p2[2], p2[3]);
                        *(u32x2*)(rowp + bj * 128) = w1; *(u32x2*)(rowp + bj * 128 + 16) = w2; } } }
    }
};
struct EpiVt {
    static constexpr bool PERM = true;
    unsigned char* ws;
    __device__ __forceinline__ void operator()(const f32x4 (&acc)[2][2][4][2], const Unit& u, int wr, int wc, int fr, int fq) const {
        unsigned char* Vt = ws + WS_VT8; const float scale = 1.f / (F8_SH * F8_SW);
        const bool ctx = u.pn >= 128; const int b = ctx ? u.pn - 128 : u.pn >> 4, kt0 = ctx ? 0 : 4 + (u.pn & 15) * 4;
#pragma unroll
        for (int ai = 0; ai < 2; ++ai)
#pragma unroll
            for (int m = 0; m < 4; ++m) { const int d = wr * 64 + m * 16 + fr;
                unsigned char* tb = Vt + ((size_t)(b * 8 + u.pm * 2 + ai) * 68 + kt0) * 8192 + d * 64;
#pragma unroll
                for (int bj = 0; bj < 2; ++bj) { const int c = bj * 128 + wc * 32 + 8 * fq, s0 = c & 63;
                    const f32x4 v0 = acc[ai][bj][m][0] * (scale * (1.f / KREP)), v1 = acc[ai][bj][m][1] * (scale * (1.f / KREP));
                    u32x2 w; w.x = pk4_fp8(v0[0], v0[1], v0[2], v0[3]); w.y = pk4_fp8(v1[0], v1[1], v1[2], v1[3]);
                    *(u32x2*)(tb + (c >> 6) * 8192 + ((((s0 >> 4) ^ (d >> 2)) & 3) << 4) + (s0 & 15)) = w; } }
    }
};
struct EpiPQt {
    static constexpr bool PERM = true;
    bf16_t* Plat; bf16_t* Pctx;
    __device__ __forceinline__ void operator()(const f32x4 (&acc)[2][2][4][2], const Unit& u, int wr, int wc, int fr, int fq) const {
        const bool ctx = u.e >= 32; const int bg = ctx ? u.e - 32 : u.e;
        bf16_t* base = (ctx ? Pctx : Plat) + (size_t)bg * 128 * FP;
        if (ctx) {
            const int col0 = wc * 32 + 8 * fq;
#pragma unroll
            for (int ai = 0; ai < 2; ++ai)
#pragma unroll
                for (int m = 0; m < 4; ++m) { bf16_t* rowp = base + (size_t)(wr * 64 + m * 16 + fr) * FP + ai * CTX + col0;
#pragma unroll
                    for (int bj = 0; bj < 2; ++bj) { const f32x4 v0 = acc[ai][bj][m][0] * (1.f / KREP), v1 = acc[ai][bj][m][1] * (1.f / KREP);
                        u32x4 w; w.x = cvtpk(v0[0], v0[1]); w.y = cvtpk(v0[2], v0[3]); w.z = cvtpk(v1[0], v1[1]); w.w = cvtpk(v1[2], v1[3]); *(u32x4*)(rowp + bj * 128) = w; } }
        } else {
            const int col0 = u.pn * 128 + wc * 32 + 8 * fq;
            const bool sp = u.pn == 0 && wc == 0 && fq == 0;
#pragma unroll
            for (int m = 0; m < 4; ++m) { bf16_t* rowp = base + (size_t)(wr * 64 + m * 16 + fr) * FP + col0;
                f32x4 p0 = (acc[0][0][m][0] + acc[0][1][m][0]) * (1.f / KREP), p1 = (acc[0][0][m][1] + acc[0][1][m][1]) * (1.f / KREP);
                f32x4 q0 = (acc[1][0][m][0] - acc[1][1][m][0]) * (1.f / KREP), q1 = (acc[1][0][m][1] - acc[1][1][m][1]) * (1.f / KREP);
                if (sp) { p0[0] = acc[0][0][m][0][0] * (1.f / KREP); q0[0] = acc[0][1][m][0][0] * (1.f / KREP); }
                u32x4 w; w.x = cvtpk(p0[0], p0[1]); w.y = cvtpk(p0[2], p0[3]); w.z = cvtpk(p1[0], p1[1]); w.w = cvtpk(p1[2], p1[3]); *(u32x4*)rowp = w;
                w.x = cvtpk(q0[0], q0[1]); w.y = cvtpk(q0[2], q0[3]); w.z = cvtpk(q1[0], q1[1]); w.w = cvtpk(q1[2], q1[3]); *(u32x4*)(rowp + 2048) = w; }
        }
    }
};
struct EpiFour2 {
    static constexpr bool PERM = true;
    bf16_t* O;
    __device__ __forceinline__ void operator()(const f32x4 (&acc)[2][2][4][2], const Unit& u, int wr, int wc, int fr, int fq) const {
        EpiStore s{O, DM, (u.pm < 128 ? 0.0013810679320049757f   : 0.005524271728019903f  )};
        s(acc, u, wr, wc, fr, fq);
    }
};

struct SchedDense {
    static constexpr bool MIRROR = false;
    const char* A; const char* B; int nM, nN, nwg, G, c, nkt; size_t tA, tB;
    __device__ __forceinline__ void init(const void* A_, int lda, const void* B_, int ldb, int M, int N, int K, int G_, int c_) {
        A = (const char*)A_; B = (const char*)B_; nM = M / 256; nN = N / 256; nwg = nM * nN; G = G_; c = c_; nkt = K / 64; tA = (size_t)256 * lda * 2; tB = (size_t)256 * ldb * 2; }
    __device__ __forceinline__ bool next(int i, Unit& u) const {
        const long L = (long)i * G + c; if (L >= nwg) return false;
        const int wgid = pg8::xcd_remap((int)L, nwg);
        const int nig = pg8::WGM * nN, gid = wgid / nig, fm = gid * pg8::WGM, gsz = (nM - fm) < pg8::WGM ? (nM - fm) : pg8::WGM;
        u.pm = fm + ((wgid % nig) % gsz); u.pn = (wgid % nig) / gsz; u.e = 0; u.nkt = nkt; return true;
    }
    __device__ __forceinline__ const char* aptr(const Unit& u) const { return A + (size_t)u.pm * tA; }
    __device__ __forceinline__ const char* bptr(const Unit& u) const { return B + (size_t)u.pn * tB; }
};
struct SchedGroup {
    static constexpr bool MIRROR = false;
    const char* A; const char* B; int P1, P2, P3, P4, P5, P6, P7, nRT, nN, nwg, G, c, nkt; size_t tA, tB, gB, aE;
    __device__ __forceinline__ bool next(int i, Unit& u) const {
        const long L = (long)i * G + c; if (L >= nwg) return false;
        const int wgid = pg8::xcd_remap((int)L, nwg);
        const int nig = pg8::WGM * nN, gid = wgid / nig, fm = gid * pg8::WGM, gsz = (nRT - fm) < pg8::WGM ? (nRT - fm) : pg8::WGM;
        const int rt = fm + ((wgid % nig) % gsz);
        u.pm = rt; u.pn = (wgid % nig) / gsz; u.nkt = nkt;
        u.e = (rt >= P1) + (rt >= P2) + (rt >= P3) + (rt >= P4) + (rt >= P5) + (rt >= P6) + (rt >= P7); return true;
    }
    __device__ __forceinline__ const char* aptr(const Unit& u) const {
        if (aE == 0) return A + (size_t)u.pm * tA;
        const int pe = u.e == 0 ? 0 : u.e == 1 ? P1 : u.e == 2 ? P2 : u.e == 3 ? P3 : u.e == 4 ? P4 : u.e == 5 ? P5 : u.e == 6 ? P6 : P7;
        return A + (size_t)u.e * aE + (size_t)(u.pm - pe) * tA; }
    __device__ __forceinline__ const char* bptr(const Unit& u) const { return B + (size_t)u.e * gB + (size_t)u.pn * tB; }
};
struct SchedF1 {
    static constexpr bool MIRROR = true;
    const char* Wp; const char* Z; int G, c;
    __device__ __forceinline__ bool next(int i, Unit& u) const {
        const int L = i * G + c; if (L >= 544) return false;
        u.pm = 0; u.nkt = 2;
        if (L < 512) { u.e = L >> 4; u.pn = L & 15; } else { u.e = 32 + (L - 512); u.pn = 0; }
        return true;
    }
    __device__ __forceinline__ const char* aptr(const Unit&) const { return Wp; }
    __device__ __forceinline__ const char* bptr(const Unit& u) const {
        const bool ctx = u.e >= 32; const int bg = ctx ? u.e - 32 : u.e, b = bg >> 2, gq = bg & 3;
        const size_t row0 = ctx ? (size_t)RL + b * CTX : (size_t)b * SEQ + u.pn * 128;
        return Z + (row0 * MIXIN + gq * 128) * 2; }
    __device__ __forceinline__ const char* bptr2(const Unit& u) const {
        const bool ctx = u.e >= 32; const int bg = ctx ? u.e - 32 : u.e, b = bg >> 2, gq = bg & 3;
        const size_t row0 = ctx ? (size_t)RL + b * CTX + 128 : (size_t)b * SEQ;
        return Z + (row0 * MIXIN + gq * 128) * 2; }
    __device__ __forceinline__ unsigned voff2(const Unit& u, int R, int C, int ldb) const {
        const int tok = u.e >= 32 ? R : (u.pn == 0 && R == 0) ? 2048 : 4096 - 128 * u.pn - R;
        return (unsigned)(tok * ldb + C) * 2u; }
};
struct SchedF2 {
    static constexpr bool MIRROR = false;
    const char* CSl; const char* CSc; const char* Plat; const char* Pctx; int G, vcu;
    static constexpr size_t EB = 2;
    __device__ __forceinline__ bool next(int i, Unit& u) const {
        const int L = i * G + vcu; if (L >= 272) return false;
        if (L < 256) { const int b = L >> 5, mt = (L & 31) >> 1; u.pm = b * 16 + mt; u.pn = L & 1; u.e = b; u.nkt = 64; }
        else { const int b = (L - 256) >> 1; u.pm = 128 + b; u.pn = L & 1; u.e = 8 + b; u.nkt = 8; }
        return true;
    }
    __device__ __forceinline__ const char* aptr(const Unit& u) const { return u.e < 8 ? CSl + (size_t)(u.pm & 15) * 256 * FP * EB : CSc; }
    __device__ __forceinline__ const char* bptr(const Unit& u) const { return (u.e < 8 ? Plat + (size_t)u.e * 512 * FP * EB : Pctx + (size_t)(u.e - 8) * 512 * FP * EB) + (size_t)u.pn * 256 * FP * EB; }
};

#define XB_TMO      128
#define XB_XCNT(j)  (256  + 64 * (j))
#define XB_XSUB(j)  (1280 + 64 * (j))
#define XB_XGEN(j)  (2304 + 64 * (j))
#define XB_TOP      3328
#define XB_TOPGEN   3392
#define XCD_BAR_WORDS 3456
#define XB_SPIN_CAP (1u << 21)
__device__ __forceinline__ unsigned xb_ld(unsigned* p)              { return __hip_atomic_load(p, __ATOMIC_RELAXED, __HIP_MEMORY_SCOPE_AGENT); }
__device__ __forceinline__ unsigned xb_add(unsigned* p, unsigned v) { return __hip_atomic_fetch_add(p, v, __ATOMIC_RELAXED, __HIP_MEMORY_SCOPE_AGENT); }
__device__ __forceinline__ unsigned xb_xcc_id() { return (unsigned)__builtin_amdgcn_s_getreg((3 << 11) | 20) & 0xFu; }
#define XB_SPIN(cond, bar) do { unsigned _sp = 0; while (cond) { __builtin_amdgcn_s_sleep(1); \
    if ((++_sp & 255u) == 0u) { if (xb_ld(&(bar)[XB_TMO])) break; if (_sp > XB_SPIN_CAP) { atomicAdd(&(bar)[XB_TMO], 1u); break; } } } } while (0)
struct XcdBarrier { unsigned* bar; unsigned x; volatile LAS unsigned* st; };
__device__ __forceinline__ XcdBarrier xcd_barrier_post(unsigned* bar, volatile LAS unsigned* st) {
    XcdBarrier b; b.bar = bar; b.x = xb_xcc_id(); b.st = st;
    if (threadIdx.x == 0) (void)xb_add(&bar[XB_XCNT(b.x)], 1u);
    return b;
}
__device__ __forceinline__ void xcd_barrier_complete(unsigned* bar, unsigned x, unsigned& nloc, unsigned& nx) {
    const unsigned G = gridDim.x * gridDim.y * gridDim.z;
    unsigned sum, cnt, mine, sp = 0u;
    for (;;) {
        sum = 0u; cnt = 0u; mine = 0u;
#pragma unroll
        for (unsigned j = 0; j < 16; ++j) { const unsigned c = xb_ld(&bar[XB_XCNT(j)]); sum += c; cnt += (c > 0u) ? 1u : 0u; mine = (j == x) ? c : mine; }
        if (sum == G) break;
        __builtin_amdgcn_s_sleep(1);
        if ((++sp & 255u) == 0u) { if (xb_ld(&bar[XB_TMO])) break; if (sp > XB_SPIN_CAP) { atomicAdd(&bar[XB_TMO], 1u); break; } }
    }
    nloc = mine > 0u ? mine : 1u; nx = cnt > 0u ? cnt : 1u;
}
__device__ __forceinline__ void xcd_barrier(const XcdBarrier& b) {
    asm volatile("s_waitcnt vmcnt(0)" ::: "memory");
    __syncthreads();
    if (threadIdx.x == 0) {
        unsigned* bar = (unsigned*)uptr((const char*)b.bar);
        __builtin_amdgcn_s_waitcnt(0);
        unsigned nloc = b.st[0], nx = b.st[1];
        if (nloc == 0u) { xcd_barrier_complete(bar, b.x, nloc, nx); b.st[0] = nloc; b.st[1] = nx; }
        const unsigned old = xb_add(&bar[XB_XSUB(b.x)], 1u);
        const unsigned gen = old / nloc;
        if (old + 1u == (gen + 1u) * nloc) {
            __builtin_amdgcn_fence(__ATOMIC_RELEASE, "agent");
            asm volatile("s_waitcnt vmcnt(0)" ::: "memory");
            const unsigned og = xb_add(&bar[XB_TOP], 1u);
            const unsigned tg = og / nx;
            if (og + 1u == (tg + 1u) * nx) xb_add(&bar[XB_TOPGEN], 1u);
            else XB_SPIN(xb_ld(&bar[XB_TOPGEN]) == tg, bar);
            __builtin_amdgcn_fence(__ATOMIC_ACQUIRE, "agent");
            xb_add(&bar[XB_XGEN(b.x)], 1u);
            asm volatile("s_waitcnt vmcnt(0)" ::: "memory");
        } else {
            XB_SPIN(xb_ld(&bar[XB_XGEN(b.x)]) == gen, bar);
            __builtin_amdgcn_fence(__ATOMIC_ACQUIRE, "agent");
            asm volatile("s_waitcnt vmcnt(0)" ::: "memory");
        }
    }
    __syncthreads();
}

__device__ __forceinline__ int crow(int r, int hi) { return (r & 3) + 8 * (r >> 2) + 4 * hi; }
template <int KW> __device__ __forceinline__ int kswz(int row, int colB) { return KW == 128 ? row * 256 + (colB ^ ((row & 7) << 4)) : row * 128 + (colB ^ (((row >> 1) & 7) << 4)); }
template <int DV> __device__ __forceinline__ int v_st(int k, int c) { const int kk = (k & ~0xC) | ((k & 4) << 1) | ((k & 8) >> 1); return ((kk >> 3) * (DV / 32) + (c >> 5)) * 512 + ((kk & 7) * 32 + (c & 31)) * 2; }
__device__ __forceinline__ int v_rd_base(int lane) { return ((lane & 3) << 3) | (((lane >> 2) & 3) << 6) | (((lane >> 4) & 1) << 5) | (((lane >> 5) & 1) << 8); }
template <int OFF> __device__ __forceinline__ s16x4 tr_read(int vb) { s16x4 r; asm volatile("ds_read_b64_tr_b16 %0, %1 offset:%2" : "=&v"(r) : "v"(vb), "i"(OFF) : "memory"); return r; }
template <int DV, int D0> __device__ __forceinline__ void pv_one(f32x16& od, int vb, bf16x8 pa0, bf16x8 pa1, bf16x8 pa2, bf16x8 pa3) {
    constexpr int KS = (DV / 32) * 1024, HF = (DV / 32) * 512;
    const s16x4 l0 = tr_read<D0 * 512 + 0 * KS>(vb), h0 = tr_read<D0 * 512 + 0 * KS + HF>(vb), l1 = tr_read<D0 * 512 + 1 * KS>(vb), h1 = tr_read<D0 * 512 + 1 * KS + HF>(vb);
    const s16x4 l2 = tr_read<D0 * 512 + 2 * KS>(vb), h2 = tr_read<D0 * 512 + 2 * KS + HF>(vb), l3 = tr_read<D0 * 512 + 3 * KS>(vb), h3 = tr_read<D0 * 512 + 3 * KS + HF>(vb);
    asm volatile("s_waitcnt lgkmcnt(0)" ::: "memory"); SBAR();
#define PKV(L, H) (bf16x8){L[0], L[1], L[2], L[3], H[0], H[1], H[2], H[3]}
    od = __builtin_amdgcn_mfma_f32_32x32x16_bf16(pa0, PKV(l0, h0), od, 0, 0, 0);
    od = __builtin_amdgcn_mfma_f32_32x32x16_bf16(pa1, PKV(l1, h1), od, 0, 0, 0);
    od = __builtin_amdgcn_mfma_f32_32x32x16_bf16(pa2, PKV(l2, h2), od, 0, 0, 0);
    od = __builtin_amdgcn_mfma_f32_32x32x16_bf16(pa3, PKV(l3, h3), od, 0, 0, 0);
#undef PKV
}
#define PV_RD(D0, L, H) do { L[0] = tr_read<(D0) * 512 + 0 * KS>(vb); H[0] = tr_read<(D0) * 512 + 0 * KS + HF>(vb); L[1] = tr_read<(D0) * 512 + 1 * KS>(vb); H[1] = tr_read<(D0) * 512 + 1 * KS + HF>(vb); \
    L[2] = tr_read<(D0) * 512 + 2 * KS>(vb); H[2] = tr_read<(D0) * 512 + 2 * KS + HF>(vb); L[3] = tr_read<(D0) * 512 + 3 * KS>(vb); H[3] = tr_read<(D0) * 512 + 3 * KS + HF>(vb); } while (0)
#define PV_MM(od, L, H) do { od = __builtin_amdgcn_mfma_f32_32x32x16_bf16(pa0, PKV(L[0], H[0]), od, 0, 0, 0); od = __builtin_amdgcn_mfma_f32_32x32x16_bf16(pa1, PKV(L[1], H[1]), od, 0, 0, 0); \
    od = __builtin_amdgcn_mfma_f32_32x32x16_bf16(pa2, PKV(L[2], H[2]), od, 0, 0, 0); od = __builtin_amdgcn_mfma_f32_32x32x16_bf16(pa3, PKV(L[3], H[3]), od, 0, 0, 0); } while (0)
#define PKV(L, H) (bf16x8){L[0], L[1], L[2], L[3], H[0], H[1], H[2], H[3]}
template <int DV> __device__ __forceinline__ void pv_all(f32x16* o, int vb, bf16x8 pa0, bf16x8 pa1, bf16x8 pa2, bf16x8 pa3) {
    constexpr int KS = (DV / 32) * 1024, HF = (DV / 32) * 512;
    s16x4 la[4], ha[4], lb[4], hb[4];
    PV_RD(0, la, ha);
    PV_RD(1, lb, hb); asm volatile("s_waitcnt lgkmcnt(8)" ::: "memory"); SBAR(); PV_MM(o[0], la, ha);
    if constexpr (DV == 128) {
        PV_RD(2, la, ha); asm volatile("s_waitcnt lgkmcnt(8)" ::: "memory"); SBAR(); PV_MM(o[1], lb, hb);
        PV_RD(3, lb, hb); asm volatile("s_waitcnt lgkmcnt(8)" ::: "memory"); SBAR(); PV_MM(o[2], la, ha);
        asm volatile("s_waitcnt lgkmcnt(0)" ::: "memory"); SBAR(); PV_MM(o[3], lb, hb);
    } else {
        asm volatile("s_waitcnt lgkmcnt(0)" ::: "memory"); SBAR(); PV_MM(o[1], lb, hb);
    }
}
#undef PV_RD
#undef PV_MM
#undef PKV
template <int KW> __device__ __forceinline__ void qkt64(f32x16& p0, f32x16& p1, const char* Ks, const bf16x8* qr, int kcb, int r32, int hi) {
    bf16x8 kb0[4], kb1[4];
#pragma unroll
    for (int d0 = 0; d0 < 4; ++d0) { const int cb = kcb + (d0 * 16 + hi * 8) * 2;
        kb0[d0] = *reinterpret_cast<const bf16x8*>(Ks + kswz<KW>(r32, cb));
        kb1[d0] = *reinterpret_cast<const bf16x8*>(Ks + kswz<KW>(32 + r32, cb)); }
    p0 = f32x16{}; p1 = f32x16{};
#pragma unroll
    for (int d0 = 0; d0 < 4; ++d0) {
        p0 = __builtin_amdgcn_mfma_f32_32x32x16_bf16(kb0[d0], qr[d0], p0, 0, 0, 0);
        p1 = __builtin_amdgcn_mfma_f32_32x32x16_bf16(kb1[d0], qr[d0], p1, 0, 0, 0); }
}
__device__ __forceinline__ void qkt64_f8(f32x16& p0, f32x16& p1, const char* Ks, v8i_t qf, int g0, int r32, const f32x16& cinit) {
    const int sw = r32 & 7; const char* kr = Ks + r32 * 128;
    const u32x4 a0 = *reinterpret_cast<const u32x4*>(kr + ((g0 ^ sw) << 4)), a1 = *reinterpret_cast<const u32x4*>(kr + (((g0 + 1) ^ sw) << 4));
    const u32x4 b0 = *reinterpret_cast<const u32x4*>(kr + 4096 + ((g0 ^ sw) << 4)), b1 = *reinterpret_cast<const u32x4*>(kr + 4096 + (((g0 + 1) ^ sw) << 4));
    const v8i_t A0 = {(int)a0.x, (int)a0.y, (int)a0.z, (int)a0.w, (int)a1.x, (int)a1.y, (int)a1.z, (int)a1.w}, A1 = {(int)b0.x, (int)b0.y, (int)b0.z, (int)b0.w, (int)b1.x, (int)b1.y, (int)b1.z, (int)b1.w};
    p0 = __builtin_amdgcn_mfma_scale_f32_32x32x64_f8f6f4(A0, qf, cinit, 0, 0, 0, 0, 0, 0);
    p1 = __builtin_amdgcn_mfma_scale_f32_32x32x64_f8f6f4(A1, qf, cinit, 0, 0, 0, 0, 0, 0);
}
template <int KW> __device__ __forceinline__ void qkt64n(f32x16& p0, f32x16& p1, const char* Ks, const bf16x8* qr, int kcb, int r32, int hi, const f32x16& cinit) {
#pragma unroll
    for (int d0 = 0; d0 < 4; ++d0) { const int cb = kcb + (d0 * 16 + hi * 8) * 2;
        const bf16x8 b0 = *reinterpret_cast<const bf16x8*>(Ks + kswz<KW>(r32, cb));
        const bf16x8 b1 = *reinterpret_cast<const bf16x8*>(Ks + kswz<KW>(32 + r32, cb));
        if (d0 == 0) { p0 = __builtin_amdgcn_mfma_f32_32x32x16_bf16(b0, qr[0], cinit, 0, 0, 0); p1 = __builtin_amdgcn_mfma_f32_32x32x16_bf16(b1, qr[0], cinit, 0, 0, 0); }
        else { p0 = __builtin_amdgcn_mfma_f32_32x32x16_bf16(b0, qr[d0], p0, 0, 0, 0); p1 = __builtin_amdgcn_mfma_f32_32x32x16_bf16(b1, qr[d0], p1, 0, 0, 0); } }
}
template <int ND> __device__ __forceinline__ void softmax_step(f32x16& p0, f32x16& p1, float& m_reg, float& l_reg, f32x16* o, float* al_l, int r32, int hi,
                                                              bf16x8& pa0, bf16x8& pa1, bf16x8& pa2, bf16x8& pa3) {
    float pmax = p0[0];
#pragma unroll
    for (int r = 1; r < 16; ++r) pmax = fmaxf(pmax, p0[r]);
#pragma unroll
    for (int r = 0; r < 16; ++r) pmax = fmaxf(pmax, p1[r]);
    { auto rr = __builtin_amdgcn_permlane32_swap(__float_as_uint(pmax), __float_as_uint(pmax), false, false); pmax = fmaxf(__uint_as_float(rr[0]), __uint_as_float(rr[1])); }
    const float mn = fmaxf(m_reg, pmax);
    const float alpha = __builtin_amdgcn_exp2f((m_reg - mn) * QK_C); m_reg = mn;
    const float mnC = -mn * QK_C;
#pragma unroll
    for (int r = 0; r < 16; ++r) { p0[r] = __builtin_amdgcn_exp2f(fmaf(p0[r], QK_C, mnC)); p1[r] = __builtin_amdgcn_exp2f(fmaf(p1[r], QK_C, mnC)); }
    float ps = 0.f;
#pragma unroll
    for (int r = 0; r < 16; ++r) ps += p0[r] + p1[r];
    { auto rr = __builtin_amdgcn_permlane32_swap(__float_as_uint(ps), __float_as_uint(ps), false, false); ps = __uint_as_float(rr[0]) + __uint_as_float(rr[1]); }
    l_reg = l_reg * alpha + ps;
    if (__any(alpha < 1.f)) { if (hi == 0) al_l[r32] = alpha; LDS_WAIT();
#pragma unroll
        for (int d = 0; d < ND; ++d)
#pragma unroll
            for (int r = 0; r < 16; ++r) o[d][r] *= al_l[crow(r, hi)];
    }
#define PK4(P, BASE, OUT) do { unsigned a0 = cvtpk(P[BASE + 0], P[BASE + 1]), a1 = cvtpk(P[BASE + 2], P[BASE + 3]);   \
    unsigned b0 = cvtpk(P[BASE + 4], P[BASE + 5]), b1 = cvtpk(P[BASE + 6], P[BASE + 7]);                              \
    auto r0 = __builtin_amdgcn_permlane32_swap(a0, b0, false, false); auto r1 = __builtin_amdgcn_permlane32_swap(a1, b1, false, false); \
    u32x4 w = {r0[0], r1[0], r0[1], r1[1]}; OUT = *reinterpret_cast<bf16x8*>(&w); } while (0)
    PK4(p0, 0, pa0); PK4(p0, 8, pa1); PK4(p1, 0, pa2); PK4(p1, 8, pa3);
#undef PK4
}

constexpr int AT_K = 0, AT_V = 16384, AT_WS = 32768, AT_XCH = 36864;

__device__ __forceinline__ void win_attn_unit(char* lds, const bf16_t* Z, bf16_t* Y, const float* sink, int b, int kvh, int qc, bool ctxq) {
    const int tid = opaque(threadIdx.x), wid = __builtin_amdgcn_readfirstlane(tid >> 6), lane = tid & 63, r32 = lane & 31, hi = lane >> 5;
    const int head = kvh * 4 + (wid >> 1), qsub = wid & 1;
    const int q0 = qc * 64;
    const size_t qrow0 = (ctxq ? (size_t)RL + b * CTX : (size_t)b * SEQ) + q0 + qsub * 32;
    float* wsf = (float*)(lds + AT_WS) + wid * 128; float* al_l = wsf; float* li_l = wsf + 32;
    bf16x8 qr[4];
    { const bf16_t* qp = Z + (qrow0 + r32) * MIXIN + 512 + head * 64 + hi * 8;
#pragma unroll
      for (int d0 = 0; d0 < 4; ++d0) qr[d0] = *reinterpret_cast<const bf16x8*>(qp + d0 * 16); }
    float m_reg = -1e30f, l_reg = 0.f; f32x16 o[2] = {};
    const int srow = tid >> 3, scol = (tid & 7) * 8;
    const int vb = (int)(uintptr_t)(lds + AT_V) + v_rd_base(lane);
    const int qrel = qsub * 32 + r32;
    const int NT = ctxq ? 4 : 9;
    for (int t = 0; t < NT; ++t) {
        size_t krow; int mode = 0;
        if (t < 4) krow = (size_t)RL + b * CTX + t * 64;
        else { const int p0 = q0 - 128 + (t - 4) * 64; if (p0 < 0 || p0 >= SEQ) continue; krow = (size_t)b * SEQ + p0; mode = (t == 4) ? 1 : (t == 8) ? 2 : 0; }
        __syncthreads();
        { const bf16_t* kp = Z + (krow + srow) * MIXIN + 1024 + kvh * 64 + scol;
          const bf16x8 kv = *reinterpret_cast<const bf16x8*>(kp), vv = *reinterpret_cast<const bf16x8*>(kp + 128);
          *reinterpret_cast<bf16x8*>(lds + AT_K + kswz<64>(srow, scol * 2)) = kv;
          *reinterpret_cast<bf16x8*>(lds + AT_V + v_st<64>(srow, scol)) = vv; }
        __syncthreads();
        f32x16 p0, p1; qkt64<64>(p0, p1, lds + AT_K, qr, 0, r32, hi);
        if (mode == 1) {
#pragma unroll
            for (int r = 0; r < 16; ++r) { const int kk = crow(r, hi); if (kk < qrel) p0[r] = -1e30f; if (kk + 32 < qrel) p1[r] = -1e30f; } }
        else if (mode == 2) {
#pragma unroll
            for (int r = 0; r < 16; ++r) { const int kk = crow(r, hi); if (kk > qrel) p0[r] = -1e30f; if (kk + 32 > qrel) p1[r] = -1e30f; } }
        bf16x8 pa0, pa1, pa2, pa3;
        softmax_step<2>(p0, p1, m_reg, l_reg, o, al_l, r32, hi, pa0, pa1, pa2, pa3);
        pv_one<64, 0>(o[0], vb, pa0, pa1, pa2, pa3); pv_one<64, 1>(o[1], vb, pa0, pa1, pa2, pa3);
    }
    l_reg += __builtin_amdgcn_exp2f(sink[head] * LOG2E - m_reg * QK_C);
    if (hi == 0) li_l[r32] = l_reg; LDS_WAIT();
    bf16_t* yp = Y + qrow0 * DM + 512 + head * 64;
#pragma unroll
    for (int r = 0; r < 16; ++r) { const int orow = crow(r, hi); const float rl = __builtin_amdgcn_rcpf(li_l[orow]);
#pragma unroll
        for (int d0 = 0; d0 < 2; ++d0) { const unsigned w = cvtpk(o[d0][r] * rl, 0.f); yp[(size_t)orow * DM + d0 * 32 + r32] = (bf16_t)(w & 0xffffu); } }
}

constexpr float DA_THR = 8.f;
constexpr float DA_THRL = DA_THR * LOG2E;
template <bool FIRST> __device__ __forceinline__ void da_partialSM(f32x16& p0, f32x16& p1, float& mhat, f32x16& negm, float& alpha) {
    float pmax = fmaxf(p0[0], p0[1]), pmb = fmaxf(p1[0], p1[1]);
#pragma unroll
    for (int r = 2; r < 16; r += 2) { pmax = fmaxf(fmaxf(pmax, p0[r]), p0[r + 1]); pmb = fmaxf(fmaxf(pmb, p1[r]), p1[r + 1]); }
    pmax = fmaxf(pmax, pmb);
    { auto rr = __builtin_amdgcn_permlane32_swap(__float_as_uint(pmax), __float_as_uint(pmax), false, false); pmax = fmaxf(__uint_as_float(rr[0]), __uint_as_float(rr[1])); }
    alpha = 1.f;
    if (FIRST || !__builtin_expect(__all(pmax <= DA_THRL), 1)) {
        const float dl = FIRST ? pmax : fmaxf(pmax, 0.f);
        mhat += dl; alpha = __builtin_amdgcn_exp2f(-dl);
#pragma unroll
        for (int r = 0; r < 16; ++r) { p0[r] -= dl; p1[r] -= dl; negm[r] = -mhat; }
    }
#pragma unroll
    for (int r = 0; r < 16; ++r) p0[r] = __builtin_amdgcn_exp2f(p0[r]);
}
__device__ __forceinline__ void da_finishSM(f32x16& p0, f32x16& p1, float alpha, float& l_reg, bf16x8& pa0, bf16x8& pa1, bf16x8& pa2, bf16x8& pa3) {
#pragma unroll
    for (int r = 0; r < 16; ++r) p1[r] = __builtin_amdgcn_exp2f(p1[r]);
    float s0 = p0[0], s1 = p0[1], s2 = p0[2], s3 = p0[3];
#pragma unroll
    for (int r = 4; r < 16; r += 4) { s0 += p0[r]; s1 += p0[r + 1]; s2 += p0[r + 2]; s3 += p0[r + 3]; }
#pragma unroll
    for (int r = 0; r < 16; r += 4) { s0 += p1[r]; s1 += p1[r + 1]; s2 += p1[r + 2]; s3 += p1[r + 3]; }
    float ps = (s0 + s1) + (s2 + s3);
    { auto rr = __builtin_amdgcn_permlane32_swap(__float_as_uint(ps), __float_as_uint(ps), false, false); ps = __uint_as_float(rr[0]) + __uint_as_float(rr[1]); }
    l_reg = l_reg * alpha + ps;
#define PK4(P, BASE, OUT) do { unsigned a0 = cvtpk(P[BASE + 0], P[BASE + 1]), a1 = cvtpk(P[BASE + 2], P[BASE + 3]);   \
    unsigned b0 = cvtpk(P[BASE + 4], P[BASE + 5]), b1 = cvtpk(P[BASE + 6], P[BASE + 7]);                              \
    auto r0 = __builtin_amdgcn_permlane32_swap(a0, b0, false, false); auto r1 = __builtin_amdgcn_permlane32_swap(a1, b1, false, false); \
    u32x4 w = {r0[0], r1[0], r0[1], r1[1]}; OUT = *reinterpret_cast<bf16x8*>(&w); } while (0)
    PK4(p0, 0, pa0); PK4(p0, 8, pa1); PK4(p1, 0, pa2); PK4(p1, 8, pa3);
#undef PK4
}
constexpr float DA8_OFF = 5.f, DA8_THRL = 3.f;
template <bool FIRST> __device__ __forceinline__ void da8_partialSM(f32x16& p0, f32x16& p1, float& mhat, f32x16& negm, float& alpha) {
    float pmax = fmaxf(p0[0], p0[1]), pmb = fmaxf(p1[0], p1[1]);
#pragma unroll
    for (int r = 2; r < 16; r += 2) { pmax = fmaxf(fmaxf(pmax, p0[r]), p0[r + 1]); pmb = fmaxf(fmaxf(pmb, p1[r]), p1[r + 1]); }
    pmax = fmaxf(pmax, pmb);
    { auto rr = __builtin_amdgcn_permlane32_swap(__float_as_uint(pmax), __float_as_uint(pmax), false, false); pmax = fmaxf(__uint_as_float(rr[0]), __uint_as_float(rr[1])); }
    alpha = 1.f;
    if (FIRST || !__builtin_expect(__all(pmax <= DA8_OFF + DA8_THRL), 1)) {
        const float dl = FIRST ? pmax - DA8_OFF : fmaxf(pmax - DA8_OFF, 0.f);
        mhat += dl; alpha = __builtin_amdgcn_exp2f(-dl);
#pragma unroll
        for (int r = 0; r < 16; ++r) { p0[r] -= dl; p1[r] -= dl; negm[r] = DA8_OFF - mhat; }
    }
#pragma unroll
    for (int r = 0; r < 16; ++r) p0[r] = __builtin_amdgcn_exp2f(p0[r]);
}
__device__ __forceinline__ void da8_finishSM(f32x16& p0, f32x16& p1, v8i_t& P8) {
#pragma unroll
    for (int r = 0; r < 16; ++r) p1[r] = __builtin_amdgcn_exp2f(p1[r]);
#pragma unroll
    for (int w = 0; w < 4; ++w) { int a = __builtin_amdgcn_cvt_pk_fp8_f32(p0[4 * w], p0[4 * w + 1], 0, false); a = __builtin_amdgcn_cvt_pk_fp8_f32(p0[4 * w + 2], p0[4 * w + 3], a, true); P8[w] = a;
        int c = __builtin_amdgcn_cvt_pk_fp8_f32(p1[4 * w], p1[4 * w + 1], 0, false); c = __builtin_amdgcn_cvt_pk_fp8_f32(p1[4 * w + 2], p1[4 * w + 3], c, true); P8[4 + w] = c; }
}
__device__ __forceinline__ void da8_pv(f32x16* o, const char* Vs, int r32, int hi, v8i_t P8) {
    const int sw = (r32 >> 2) & 3; const char* vr = Vs + r32 * 64; const int o0 = ((hi * 2) ^ sw) << 4, o1 = ((hi * 2 + 1) ^ sw) << 4;
    u32x4 x0[4], x1[4];
#pragma unroll
    for (int db = 0; db < 4; ++db) { x0[db] = *reinterpret_cast<const u32x4*>(vr + db * 2048 + o0); x1[db] = *reinterpret_cast<const u32x4*>(vr + db * 2048 + o1); }
#pragma unroll
    for (int db = 0; db < 4; ++db) { const v8i_t B = {(int)x0[db].x, (int)x0[db].y, (int)x0[db].z, (int)x0[db].w, (int)x1[db].x, (int)x1[db].y, (int)x1[db].z, (int)x1[db].w};
        o[db] = __builtin_amdgcn_mfma_scale_f32_32x32x64_f8f6f4(P8, B, o[db], 0, 0, 0, 0, 0, 0); }
    const v8i_t ones = {0x38383838, 0x38383838, 0x38383838, 0x38383838, 0x38383838, 0x38383838, 0x38383838, 0x38383838};
    o[4] = __builtin_amdgcn_mfma_scale_f32_32x32x64_f8f6f4(P8, ones, o[4], 0, 0, 0, 0, 0, 0);
}
__device__ __forceinline__ void da_pv(f32x16* o, int vb, bf16x8 pa0, bf16x8 pa1, bf16x8 pa2, bf16x8 pa3) {
    pv_all<128>(o, vb, pa0, pa1, pa2, pa3);
}
constexpr int DA_V = 0, DA_K = 49152, DA_WS = 81920, DA_XCH = 0;
__device__ __forceinline__ void diff_attn_unit(char* lds, const unsigned char* VT8, const unsigned char* QK8, bf16_t* O, const float* subg, float lam, float oscale, int b, int h, int qb, bool ctxq) {
    const int tid = opaque(threadIdx.x), wid = __builtin_amdgcn_readfirstlane(tid >> 6), lane = tid & 63, r32 = lane & 31, hi = lane >> 5;
    const int comp = wid >> 2, qsub = wid & 3;
    const size_t qrow0 = (ctxq ? (size_t)RL + b * CTX : (size_t)b * SEQ) + qb * 128 + qsub * 32;
    char* V_lds = lds + DA_V; char* K_lds = lds + DA_K;
    float* wsf = (float*)(lds + DA_WS) + wid * 128; float* al_l = wsf; float* li_l = wsf + 32;
    __syncthreads();
    v8i_t qf;
    { const unsigned char* qp = QK8 + (qrow0 + r32) * 2048 + (2 * h + comp) * 64 + hi * 32;
      const u32x4 q0 = *reinterpret_cast<const u32x4*>(qp), q1 = *reinterpret_cast<const u32x4*>(qp + 16);
      qf = (v8i_t){(int)q0.x, (int)q0.y, (int)q0.z, (int)q0.w, (int)q1.x, (int)q1.y, (int)q1.z, (int)q1.w}; }
    float m_reg = 0.f; f32x16 o[5] = {}; f32x16 negm;
#pragma unroll
    for (int r = 0; r < 16; ++r) negm[r] = DA8_OFF;
    const int kkey = tid >> 3, krow = ((kkey >> 4) & 1) * 32 + (kkey & 3) + 8 * ((kkey & 15) >> 2) + 4 * (kkey >> 5), kst = krow * 128 + ((((tid & 7) ^ (krow & 7))) << 4);
    const unsigned char* kp8 = QK8 + (size_t)kkey * 2048 + 1024 + h * 128 + (tid & 7) * 16;
    const int kg0 = comp * 4 + hi * 2;
    const unsigned char* vt8 = VT8 + (size_t)(b * 8 + h) * 68 * 8192 + tid * 16;
    const size_t rowc = (size_t)RL + b * CTX, rowl = (size_t)b * SEQ;
    const int NT = ctxq ? 4 : 68;
    u32x4 ks, vs;
#define KROW(t) ((t) < 4 ? rowc + (size_t)(t) * 64 : rowl + (size_t)((t) - 4) * 64)
#define LOADK(t) do { ks = *reinterpret_cast<const u32x4*>(kp8 + KROW(t) * 2048); } while (0)
#define LOADV(t) do { vs = *reinterpret_cast<const u32x4*>(vt8 + (size_t)(t) * 8192); } while (0)
#define WRITEK(bf) do { *reinterpret_cast<u32x4*>(K_lds + (bf) * 8192 + kst) = ks; } while (0)
#define WRITEV(bf) do { *reinterpret_cast<u32x4*>(V_lds + (bf) * 8192 + tid * 16) = vs; } while (0)
#define RESC(a) do { if (__any((a) < 1.f)) { if (hi == 0) al_l[r32] = (a); LDS_WAIT(); \
    _Pragma("unroll") for (int d = 0; d < 5; ++d) _Pragma("unroll") for (int r = 0; r < 16; ++r) o[d][r] *= al_l[crow(r, hi)]; } } while (0)
#define QKT(P0, P1, kb) do { SBAR(); qkt64_f8(P0, P1, K_lds + (kb) * 8192, qf, kg0, r32, negm); } while (0)
#define FIN(P0, P1, al) do { da8_finishSM(P0, P1, P8); SBAR(); } while (0)
#define PVT(vi) da8_pv(o, V_lds + (vi) * 8192, r32, hi, P8)
    f32x16 pA0, pA1, pB0, pB1; float alA = 1.f, alB = 1.f; v8i_t P8;
    int vm2 = 1, vm1 = 2, vc = 0;
#define VROT() do { const int t_ = vm2; vm2 = vm1; vm1 = vc; vc = t_; } while (0)
    const bool grpB = comp != 0;
    LOADK(0); VM_WAIT(); WRITEK(0); LOADK(1); LOADV(0); __syncthreads();
    QKT(pA0, pA1, 0);
    if (!grpB) da8_partialSM<true>(pA0, pA1, m_reg, negm, alA);
    VM_WAIT(); WRITEK(1); WRITEV(vc); LOADK(2); LOADV(1); VROT();
    __syncthreads();
    if (grpB) da8_partialSM<true>(pA0, pA1, m_reg, negm, alA);
    QKT(pB0, pB1, 1); FIN(pA0, pA1, alA);
    if (!grpB) { PVT(vm1); da8_partialSM<false>(pB0, pB1, m_reg, negm, alB); RESC(alB); }
    VM_WAIT(); WRITEK(0); WRITEV(vc); LOADK(3); LOADV(2); VROT();
    __syncthreads();
    for (int j = 2; j + 1 < NT; j += 2) {
        if (grpB) { PVT(vm2); da8_partialSM<false>(pB0, pB1, m_reg, negm, alB); RESC(alB); }
        QKT(pA0, pA1, 0); FIN(pB0, pB1, alB);
        if (!grpB) { PVT(vm1); da8_partialSM<false>(pA0, pA1, m_reg, negm, alA); RESC(alA); }
        VM_WAIT(); WRITEK(1); WRITEV(vc); if (j + 2 < NT) LOADK(j + 2); LOADV(j + 1); VROT();
        __syncthreads();
        if (grpB) { PVT(vm2); da8_partialSM<false>(pA0, pA1, m_reg, negm, alA); RESC(alA); }
        QKT(pB0, pB1, 1); FIN(pA0, pA1, alA);
        if (!grpB) { PVT(vm1); da8_partialSM<false>(pB0, pB1, m_reg, negm, alB); RESC(alB); }
        VM_WAIT(); if (j + 2 < NT) { WRITEK(0); } WRITEV(vc); if (j + 3 < NT) LOADK(j + 3); if (j + 2 < NT) LOADV(j + 2); VROT();
        __syncthreads();
    }
    if (grpB) { PVT(vm2); da8_partialSM<false>(pB0, pB1, m_reg, negm, alB); RESC(alB); }
    FIN(pB0, pB1, alB); PVT(vm1);
#undef LOADK
#undef LOADV
#undef WRITEK
#undef WRITEV
#undef QKT
#undef FIN
#undef PVT
#undef VROT
#define SLOAD(a, b)
#define SWRITE(a, b)
#define SWAIT()
#undef KROW
#undef SLOAD
#undef SWRITE
#undef SWAIT
#undef RESC
    float rl[16];
#pragma unroll
    for (int r = 0; r < 16; ++r) rl[r] = __builtin_amdgcn_rcpf(o[4][r]);
    __syncthreads();
    float* xch = (float*)(lds + DA_XCH) + qsub * (32 * 132);
    if (comp == 1) {
#pragma unroll
        for (int d0 = 0; d0 < 4; ++d0)
#pragma unroll
            for (int r = 0; r < 16; ++r) xch[crow(r, hi) * 132 + d0 * 32 + r32] = o[d0][r] * rl[r];
    }
    __syncthreads();
    if (comp == 0) {
#pragma unroll
        for (int d0 = 0; d0 < 4; ++d0)
#pragma unroll
            for (int r = 0; r < 16; ++r) { const int idx = crow(r, hi) * 132 + d0 * 32 + r32; const float v = o[d0][r] * rl[r] - lam * xch[idx]; xch[idx] = v; }
        LDS_WAIT();
        const int row = lane >> 1, hf = lane & 1; const float* rp = xch + row * 132 + hf * 64;
        f32x4 v[16]; float ss = 0.f;
#pragma unroll
        for (int j = 0; j < 16; ++j) { v[j] = *reinterpret_cast<const f32x4*>(rp + 4 * j); ss += v[j][0] * v[j][0] + v[j][1] * v[j][1] + v[j][2] * v[j][2] + v[j][3] * v[j][3]; }
        ss += __int_as_float(__builtin_amdgcn_ds_bpermute((lane ^ 1) << 2, __float_as_int(ss)));
        const float rs = __builtin_amdgcn_rsqf(ss * (1.f / 128.f) + EPS) * oscale;
        bf16_t* op = O + (qrow0 + row) * DM + h * 128 + hf * 64;
#pragma unroll
        for (int j = 0; j < 16; j += 2) { const f32x4 g0 = *reinterpret_cast<const f32x4*>(subg + hf * 64 + 4 * j), g1 = *reinterpret_cast<const f32x4*>(subg + hf * 64 + 4 * j + 4);
            const f32x4 a = v[j] * g0 * rs, c = v[j + 1] * g1 * rs;
            u32x4 w; w.x = cvtpk(a[0], a[1]); w.y = cvtpk(a[2], a[3]); w.z = cvtpk(c[0], c[1]); w.w = cvtpk(c[2], c[3]);
            *reinterpret_cast<u32x4*>(op + 4 * j) = w; }
    }
}

constexpr int WA_V = 0, WA_K = 16384, WA_WS = 32768, WA_ST = 36864;
__device__ __forceinline__ void wa_mask(f32x16& p0, f32x16& p1, int mode, int qrel, int hi) {
    if (mode == 1) {
#pragma unroll
        for (int r = 0; r < 16; ++r) { const int kk = crow(r, hi); if (kk < qrel) p0[r] = -1e30f; if (kk + 32 < qrel) p1[r] = -1e30f; } }
    else if (mode == 2) {
#pragma unroll
        for (int r = 0; r < 16; ++r) { const int kk = crow(r, hi); if (kk > qrel) p0[r] = -1e30f; if (kk + 32 > qrel) p1[r] = -1e30f; } }
    else if (mode == 3) {
#pragma unroll
        for (int r = 0; r < 16; ++r) { p0[r] = -1e30f; p1[r] = -1e30f; } }
}
__device__ __forceinline__ void win_attn_unit2(char* lds, const bf16_t* Z, bf16_t* Y, const float* sink, int b, int kvh, int qc, bool ctxq) {
    const int tid = opaque(threadIdx.x), wid = __builtin_amdgcn_readfirstlane(tid >> 6), lane = tid & 63, r32 = lane & 31, hi = lane >> 5;
    const int head = kvh * 4 + (wid >> 1), qsub = wid & 1, q0 = qc * 64;
    const size_t rowc = (size_t)RL + b * CTX, rowl = (size_t)b * SEQ;
    const size_t qrow0 = (ctxq ? rowc : rowl) + q0 + qsub * 32;
    char* V_lds = lds + WA_V; char* K_lds = lds + WA_K;
    float* wsf = (float*)(lds + WA_WS) + wid * 128; float* al_l = wsf; float* li_l = wsf + 32;
    __syncthreads();
    bf16x8 qr[4];
    { const bf16_t* qp = Z + (qrow0 + r32) * MIXIN + 512 + head * 64 + hi * 8;
#pragma unroll
      for (int d0 = 0; d0 < 4; ++d0) qr[d0] = *reinterpret_cast<const bf16x8*>(qp + d0 * 16); }
    float m_reg = 0.f, l_reg = 0.f; f32x16 o[2] = {}; f32x16 negm = {};
    const int srow = tid >> 3, scol = (tid & 7) * 8, vst = v_st<64>(srow, scol), kst = kswz<64>(srow, scol * 2);
    const int vb0 = (int)(uintptr_t)V_lds + v_rd_base(lane);
    const bf16_t* kvp = Z + (size_t)srow * MIXIN + 1024 + kvh * 64 + scol;
    const int skip_lo = ctxq ? 0 : (q0 == 0 ? 2 : q0 == 64 ? 1 : 0);
    const int nloc = ctxq ? 0 : 5 - skip_lo - (q0 == SEQ - 64 ? 2 : q0 == SEQ - 128 ? 1 : 0);
    const int NTr = 4 + nloc, NT = (NTr + 1) & ~1;
    const int qrel = qsub * 32 + r32;
    struct { bf16x8 vs, ks; } sr_;
#define KROW(t) ((t) < 4 ? rowc + (size_t)(t) * 64 : (t) < NTr ? rowl + (size_t)(q0 - 128 + ((t) - 4 + skip_lo) * 64) : rowc)
#define TMODE(t) ((t) < 4 ? 0 : (t) >= NTr ? 3 : ((t) - 4 + skip_lo) == 0 ? 1 : ((t) - 4 + skip_lo) == 4 ? 2 : 0)
#define SLOAD(t) do { const bf16_t* p_ = kvp + KROW(t) * MIXIN; sr_.ks = *reinterpret_cast<const bf16x8*>(p_); sr_.vs = *reinterpret_cast<const bf16x8*>(p_ + 128); } while (0)
#define SWRITE(bf) do { *reinterpret_cast<bf16x8*>(V_lds + (bf) * 8192 + vst) = sr_.vs; *reinterpret_cast<bf16x8*>(K_lds + (bf) * 8192 + kst) = sr_.ks; } while (0)
#define SWAIT() asm volatile("s_waitcnt vmcnt(0)" ::: "memory")
#define RESC(a) do { if (__any((a) < 1.f)) { if (hi == 0) al_l[r32] = (a); LDS_WAIT(); \
    _Pragma("unroll") for (int d = 0; d < 2; ++d) _Pragma("unroll") for (int r = 0; r < 16; ++r) o[d][r] *= al_l[crow(r, hi)]; } } while (0)
#define WPV(vb) pv_all<64>(o, (vb), pa0, pa1, pa2, pa3)
    f32x16 pA0, pA1, pB0, pB1; float alA, alB; bf16x8 pa0, pa1, pa2, pa3;
    SLOAD(0); VM_WAIT(); SWRITE(0); __syncthreads();
    qkt64n<64>(pA0, pA1, K_lds, qr, 0, r32, hi, negm); da_partialSM<true>(pA0, pA1, m_reg, negm, alA);
    SLOAD(1);
    SWAIT(); SWRITE(1); __syncthreads();
    for (int j = 1; j + 1 < NT; j += 2) {
        SBAR(); qkt64n<64>(pB0, pB1, K_lds + 8192, qr, 0, r32, hi, negm);
        da_finishSM(pA0, pA1, alA, l_reg, pa0, pa1, pa2, pa3); SBAR();
        SLOAD(j + 1); SBAR();
        WPV(vb0); wa_mask(pB0, pB1, TMODE(j), qrel, hi); da_partialSM<false>(pB0, pB1, m_reg, negm, alB);
        __syncthreads(); SWAIT(); SWRITE(0);
        RESC(alB); __syncthreads();
        SBAR(); qkt64n<64>(pA0, pA1, K_lds, qr, 0, r32, hi, negm);
        da_finishSM(pB0, pB1, alB, l_reg, pa0, pa1, pa2, pa3); SBAR();
        SLOAD(j + 2); SBAR();
        WPV(vb0 + 8192); wa_mask(pA0, pA1, TMODE(j + 1), qrel, hi); da_partialSM<false>(pA0, pA1, m_reg, negm, alA);
        __syncthreads(); SWAIT(); SWRITE(1);
        RESC(alA); __syncthreads();
    }
    SBAR(); qkt64n<64>(pB0, pB1, K_lds + 8192, qr, 0, r32, hi, negm);
    da_finishSM(pA0, pA1, alA, l_reg, pa0, pa1, pa2, pa3); SBAR();
    WPV(vb0); wa_mask(pB0, pB1, TMODE(NT - 1), qrel, hi); da_partialSM<false>(pB0, pB1, m_reg, negm, alB);
    __syncthreads(); RESC(alB);
    da_finishSM(pB0, pB1, alB, l_reg, pa0, pa1, pa2, pa3); SBAR();
    WPV(vb0 + 8192);
#undef KROW
#undef TMODE
#undef SLOAD
#undef SWRITE
#undef SWAIT
#undef RESC
#undef WPV
    l_reg += __builtin_amdgcn_exp2f(sink[head] * LOG2E - m_reg);
    if (hi == 0) li_l[r32] = l_reg; LDS_WAIT();
    bf16_t* stg = (bf16_t*)(lds + WA_ST) + wid * 2048;
#pragma unroll
    for (int r = 0; r < 16; ++r) { const int orow = crow(r, hi); const float rl = __builtin_amdgcn_rcpf(li_l[orow]);
#pragma unroll
        for (int d0 = 0; d0 < 2; ++d0) stg[orow * 64 + d0 * 32 + r32] = (bf16_t)(cvtpk(o[d0][r] * rl, 0.f) & 0xffffu); }
    LDS_WAIT();
    bf16_t* yp = Y + qrow0 * DM + 512 + head * 64;
#pragma unroll
    for (int i = 0; i < 4; ++i) { const int row = i * 8 + (lane >> 3), ch = lane & 7; const u32x4 v = *reinterpret_cast<const u32x4*>(stg + row * 64 + ch * 8); *reinterpret_cast<u32x4*>(yp + (size_t)row * DM + ch * 8) = v; }
}

struct Args {
    const float *x, *c, *ctx, *c_ctx, *ada_w, *ada_b, *norm_g, *mix_in_w, *mix_out_w, *win_sink, *diff_qkv_w, *diff_out_w, *diff_lambda, *diff_subln_g,
                *ffn_in_w, *ffn_out_w, *router_w, *expert_in_w, *expert_out_w;
    float* out; unsigned char* ws; int ph_lo, ph_hi;
};
struct Frame {
    LAS unsigned char* lds; unsigned char* ldsg; volatile LAS unsigned* MISC; unsigned* ctl;
    int tid, lane, wave, vcu, G;
};

__device__ __forceinline__ unsigned f2bf(float f) { unsigned u = __builtin_bit_cast(unsigned, f); return (u + 0x7fffu + ((u >> 16) & 1u)) >> 16; }
__device__ __forceinline__ unsigned pk2(float lo, float hi) { return f2bf(lo) | (f2bf(hi) << 16); }
__device__ __forceinline__ void transpose_item(const float* W, int K, int N, bf16_t* WT, int n0, int c0, int k0, LAS float* scr, int lane) {
#pragma unroll 8
    for (int i = 0; i < 32; ++i) { const int kk = 2 * i + (lane >> 5); scr[kk * 33 + (lane & 31)] = W[(size_t)(k0 + kk) * N + c0 + (lane & 31)]; }
    LDS_WAIT(); asm volatile("" ::: "memory");
    const int c = lane & 7;
#pragma unroll
    for (int j = 0; j < 4; ++j) { const int n = (lane >> 3) + 8 * j; const LAS float* s = scr + (8 * c) * 33 + n;
        u32x4 o; o.x = pk2(s[0 * 33], s[1 * 33]); o.y = pk2(s[2 * 33], s[3 * 33]); o.z = pk2(s[4 * 33], s[5 * 33]); o.w = pk2(s[6 * 33], s[7 * 33]);
        *(u32x4*)(WT + (size_t)(n0 + n) * K + k0 + 8 * c) = o; }
    LDS_WAIT(); asm volatile("" ::: "memory");
}
__device__ __forceinline__ void transpose_item_f8(const float* W, int K, int N, unsigned char* WT, int n0, int c0, int k0, LAS float* scr, int lane) {
#pragma unroll 8
    for (int i = 0; i < 32; ++i) { const int kk = 2 * i + (lane >> 5); scr[kk * 33 + (lane & 31)] = W[(size_t)(k0 + kk) * N + c0 + (lane & 31)] * F8_SW; }
    LDS_WAIT(); asm volatile("" ::: "memory");
    const int c = lane & 7;
#pragma unroll
    for (int j = 0; j < 4; ++j) { const int n = (lane >> 3) + 8 * j; const LAS float* s = scr + (8 * c) * 33 + n;
        u32x2 o; o.x = pk4_fp8(s[0 * 33], s[1 * 33], s[2 * 33], s[3 * 33]); o.y = pk4_fp8(s[4 * 33], s[5 * 33], s[6 * 33], s[7 * 33]);
        *(u32x2*)(WT + (size_t)(n0 + n) * K + k0 + 8 * c) = o; }
    LDS_WAIT(); asm volatile("" ::: "memory");
}
__device__ __forceinline__ bool transpose_job(int& r, const float* W, int nb, int K, int N, void* WT, bool glu, bool f8, LAS float* scr, int lane) {
    const int nblk = N / 32, per = (K / 64) * nblk, tot = nb * per;
    if (r >= tot) { r -= tot; return false; }
    const int mtx = r / per, it = r % per, kb = it / nblk, nbk = it % nblk, n0 = 32 * nbk;
    int c0 = n0;
    if (glu) { const int tile = n0 >> 8, w = n0 & 255; c0 = (w < 128) ? tile * 128 + w : (N >> 1) + tile * 128 + (w - 128); }
    if (f8) transpose_item_f8(W + (size_t)mtx * K * N, K, N, (unsigned char*)WT + (size_t)mtx * K * N, n0, c0, 64 * kb, scr, lane);
    else transpose_item(W + (size_t)mtx * K * N, K, N, (bf16_t*)WT + (size_t)mtx * K * N, n0, c0, 64 * kb, scr, lane);
    return true;
}

struct ThinP {
    int nrows;
    const void* xin_lat; const void* xin_ctx;
    void* xout_lat; void* xout_ctx;
    bool xin16, xout16;
    int ymode;
    const bf16_t* Ysrc; const float* gate; const float* ga;
    bool h8;
    bf16_t* H; const float* gb; const float* shsc;
    const float* router; int* route; unsigned* cnt;
    unsigned char* HSv;
};
#define TH_DECL(PFX) f32x4 PFX##x0 = {}, PFX##x1 = {}, PFX##x2 = {}, PFX##x3 = {}; u32x2 PFX##xh0 = {}, PFX##xh1 = {}, PFX##xh2 = {}, PFX##xh3 = {}; u32x2 PFX##ya0 = {}, PFX##ya1 = {}, PFX##ya2 = {}, PFX##ya3 = {}, PFX##yb0 = {}, PFX##yb1 = {}, PFX##yb2 = {}, PFX##yb3 = {}; float PFX##w0 = 0.f, PFX##w1 = 0.f
#define TH_LOAD(PFX, r_, it_) do { const int rr_ = (r_); \
    if (P.xin16) { const bf16_t* xr_ = (rr_ < RL ? (const bf16_t*)P.xin_lat + (size_t)rr_ * DM : (const bf16_t*)P.xin_ctx + (size_t)(rr_ - RL) * DM) + 4 * lane; \
        PFX##xh0 = __builtin_nontemporal_load(reinterpret_cast<const u32x2*>(xr_)); PFX##xh1 = __builtin_nontemporal_load(reinterpret_cast<const u32x2*>(xr_ + 256)); PFX##xh2 = __builtin_nontemporal_load(reinterpret_cast<const u32x2*>(xr_ + 512)); PFX##xh3 = __builtin_nontemporal_load(reinterpret_cast<const u32x2*>(xr_ + 768)); } \
    else { const float* xr_ = (rr_ < RL ? (const float*)P.xin_lat + (size_t)rr_ * DM : (const float*)P.xin_ctx + (size_t)(rr_ - RL) * DM) + 4 * lane; \
        PFX##x0 = __builtin_nontemporal_load(reinterpret_cast<const f32x4*>(xr_)); PFX##x1 = __builtin_nontemporal_load(reinterpret_cast<const f32x4*>(xr_ + 256)); PFX##x2 = __builtin_nontemporal_load(reinterpret_cast<const f32x4*>(xr_ + 512)); PFX##x3 = __builtin_nontemporal_load(reinterpret_cast<const f32x4*>(xr_ + 768)); } \
    const bf16_t* ya_ = P.Ysrc; const bf16_t* yb_ = P.Ysrc; \
    if (P.ymode == 1) ya_ = P.Ysrc + (size_t)rr_ * DM; \
    else if (P.ymode == 2) { const LAS int* rt_ = rtl + (it_) * 6; \
        const int e0_ = rt_[0], p0_ = rt_[1], e1_ = rt_[2], p1_ = rt_[3]; PFX##w0 = __int_as_float(rt_[4]); PFX##w1 = __int_as_float(rt_[5]); \
        const unsigned b0_ = e0_ == 0 ? 0u : e0_ == 1 ? cb1 : e0_ == 2 ? cb2 : e0_ == 3 ? cb3 : e0_ == 4 ? cb4 : e0_ == 5 ? cb5 : e0_ == 6 ? cb6 : cb7; \
        const unsigned b1_ = e1_ == 0 ? 0u : e1_ == 1 ? cb1 : e1_ == 2 ? cb2 : e1_ == 3 ? cb3 : e1_ == 4 ? cb4 : e1_ == 5 ? cb5 : e1_ == 6 ? cb6 : cb7; \
        ya_ = P.Ysrc + (size_t)(b0_ + p0_) * DM; yb_ = P.Ysrc + (size_t)(b1_ + p1_) * DM; } \
    if (P.ymode) { ya_ += 4 * lane; PFX##ya0 = __builtin_nontemporal_load(reinterpret_cast<const u32x2*>(ya_)); PFX##ya1 = __builtin_nontemporal_load(reinterpret_cast<const u32x2*>(ya_ + 256)); PFX##ya2 = __builtin_nontemporal_load(reinterpret_cast<const u32x2*>(ya_ + 512)); PFX##ya3 = __builtin_nontemporal_load(reinterpret_cast<const u32x2*>(ya_ + 768)); } \
    if (P.ymode == 2) { yb_ += 4 * lane; PFX##yb0 = __builtin_nontemporal_load(reinterpret_cast<const u32x2*>(yb_)); PFX##yb1 = __builtin_nontemporal_load(reinterpret_cast<const u32x2*>(yb_ + 256)); PFX##yb2 = __builtin_nontemporal_load(reinterpret_cast<const u32x2*>(yb_ + 512)); PFX##yb3 = __builtin_nontemporal_load(reinterpret_cast<const u32x2*>(yb_ + 768)); } \
    } while (0)
#define TH_ARGS(PFX) PFX##x0, PFX##x1, PFX##x2, PFX##x3, PFX##xh0, PFX##xh1, PFX##xh2, PFX##xh3, PFX##ya0, PFX##ya1, PFX##ya2, PFX##ya3, PFX##yb0, PFX##yb1, PFX##yb2, PFX##yb3, PFX##w0, PFX##w1
__device__ __forceinline__ void thin_proc(const ThinP& P, f32x4 x0, f32x4 x1, f32x4 x2, f32x4 x3, u32x2 xh0, u32x2 xh1, u32x2 xh2, u32x2 xh3, u32x2 ya0, u32x2 ya1, u32x2 ya2, u32x2 ya3, u32x2 yb0, u32x2 yb1, u32x2 yb2, u32x2 yb3, float yw0, float yw1,
                                          f32x4 GA0, f32x4 GA1, f32x4 GA2, f32x4 GA3, f32x4 GB0, f32x4 GB1, f32x4 GB2, f32x4 GB3, f32x4 SH0, f32x4 SH1, f32x4 SH2, f32x4 SH3,
                                          int r, int li, int lane, LAS float* rwT, LAS int* rec, LAS unsigned* lcnt) {
    const int idx = r < RL ? (r >> 12) : 8;
#define BF4(w) ((f32x4){bf_lo((w).x), bf_hi((w).x), bf_lo((w).y), bf_hi((w).y)})
    f32x4 xv[4] = {x0, x1, x2, x3};
    if (P.xin16) { xv[0] = BF4(xh0); xv[1] = BF4(xh1); xv[2] = BF4(xh2); xv[3] = BF4(xh3); }
    if (P.ymode) {
        f32x4 yv[4];
        if (P.ymode == 1) { yv[0] = BF4(ya0); yv[1] = BF4(ya1); yv[2] = BF4(ya2); yv[3] = BF4(ya3); }
        else { yv[0] = BF4(ya0) * yw0 + BF4(yb0) * yw1; yv[1] = BF4(ya1) * yw0 + BF4(yb1) * yw1; yv[2] = BF4(ya2) * yw0 + BF4(yb2) * yw1; yv[3] = BF4(ya3) * yw0 + BF4(yb3) * yw1; }
#undef BF4
        float ss = 0.f;
#pragma unroll
        for (int j = 0; j < 4; ++j) ss += yv[j][0] * yv[j][0] + yv[j][1] * yv[j][1] + yv[j][2] * yv[j][2] + yv[j][3] * yv[j][3];
        const float rs = __builtin_amdgcn_rsqf(wave_sum(ss, lane) * (1.f / DM) + EPS);
        xv[0] = xv[0] + GA0 * (yv[0] * rs); xv[1] = xv[1] + GA1 * (yv[1] * rs); xv[2] = xv[2] + GA2 * (yv[2] * rs); xv[3] = xv[3] + GA3 * (yv[3] * rs);
    }
    if (P.xout_lat) {
        if (P.xout16) { bf16_t* xo = r < RL ? (bf16_t*)P.xout_lat + (size_t)r * DM : (bf16_t*)P.xout_ctx + (size_t)(r - RL) * DM;
#pragma unroll
            for (int j = 0; j < 4; ++j) { u32x2 w; w.x = cvtpk(xv[j][0], xv[j][1]); w.y = cvtpk(xv[j][2], xv[j][3]); __builtin_nontemporal_store(w, reinterpret_cast<u32x2*>(xo + 4 * lane + 256 * j)); } }
        else { float* xo = r < RL ? (float*)P.xout_lat + (size_t)r * DM : (float*)P.xout_ctx + (size_t)(r - RL) * DM;
#pragma unroll
            for (int j = 0; j < 4; ++j) __builtin_nontemporal_store(xv[j], reinterpret_cast<f32x4*>(xo + 4 * lane + 256 * j)); } }
    if (P.H) {
        float ss = 0.f;
#pragma unroll
        for (int j = 0; j < 4; ++j) ss += xv[j][0] * xv[j][0] + xv[j][1] * xv[j][1] + xv[j][2] * xv[j][2] + xv[j][3] * xv[j][3];
        const float rs = __builtin_amdgcn_rsqf(wave_sum(ss, lane) * (1.f / DM) + EPS);
        bf16_t* hr = P.H + (size_t)r * DM;
        f32x4 hv[4] = {xv[0] * rs * GB0 + SH0, xv[1] * rs * GB1 + SH1, xv[2] * rs * GB2 + SH2, xv[3] * rs * GB3 + SH3};
#pragma unroll
        for (int j = 0; j < 4; ++j) {
            if (P.h8) { *reinterpret_cast<unsigned*>((unsigned char*)P.H + (size_t)r * DM + 4 * lane + 256 * j) = pk4_fp8(hv[j][0] * F8_SH, hv[j][1] * F8_SH, hv[j][2] * F8_SH, hv[j][3] * F8_SH); }
            else { u32x2 w; w.x = cvtpk(hv[j][0], hv[j][1]); w.y = cvtpk(hv[j][2], hv[j][3]); *reinterpret_cast<u32x2*>(hr + 4 * lane + 256 * j) = w; } }
        if (P.router) {
            float lg[8];
#pragma unroll
            for (int e = 0; e < 8; ++e) { float a = 0.f;
#pragma unroll
                for (int j = 0; j < 4; ++j) { const f32x4 w = *reinterpret_cast<const LAS f32x4*>(rwT + e * 1024 + 4 * lane + 256 * j); a += hv[j][0] * w[0] + hv[j][1] * w[1] + hv[j][2] * w[2] + hv[j][3] * w[3]; }
                lg[e] = wave_sum(a, lane); }
            int i0 = 0; float v0 = lg[0];
#pragma unroll
            for (int e = 1; e < 8; ++e) if (lg[e] > v0) { v0 = lg[e]; i0 = e; }
            int i1 = -1; float v1 = -3.4e38f;
#pragma unroll
            for (int e = 0; e < 8; ++e) if (e != i0 && lg[e] > v1) { v1 = lg[e]; i1 = e; }
            const float w0 = 1.f / (1.f + __expf(v1 - v0)), w1 = 1.f - w0;
            if (lane == 0) { const unsigned lp0 = __hip_atomic_fetch_add(lcnt + i0, 1u, __ATOMIC_RELAXED, __HIP_MEMORY_SCOPE_WORKGROUP), lp1 = __hip_atomic_fetch_add(lcnt + i1, 1u, __ATOMIC_RELAXED, __HIP_MEMORY_SCOPE_WORKGROUP);
                LAS int* rc = rec + li * 6; rc[0] = i0; rc[1] = (int)lp0; rc[2] = i1; rc[3] = (int)lp1; rc[4] = __float_as_int(w0); rc[5] = __float_as_int(w1); }
        }
    }
}
__device__ __forceinline__ void thin_phase(Frame& F, const ThinP& P) {
    const int lane = opaque(F.lane);
    const int nlat = P.nrows < RL ? P.nrows : RL, nctx = P.nrows - nlat;
    const int chL = (nlat + F.G - 1) / F.G, chC = (nctx + F.G - 1) / F.G;
    const int r0L = F.vcu * chL, r0C = F.vcu * chC;
    const int nl = r0L >= nlat ? 0 : (r0L + chL <= nlat ? chL : nlat - r0L), nc = r0C >= nctx ? 0 : (r0C + chC <= nctx ? chC : nctx - r0C), nrw = nl + nc;
#define TROW(li_) ((li_) < nl ? r0L + (li_) : RL + r0C + ((li_) - nl))
    LAS float* rwT = (LAS float*)F.lds;
    LAS int* rec = (LAS int*)(F.lds + 32768);
    LAS unsigned* lcnt = (LAS unsigned*)(F.lds + 65536);
    unsigned cb1 = 0, cb2 = 0, cb3 = 0, cb4 = 0, cb5 = 0, cb6 = 0, cb7 = 0;
    if (P.ymode == 2) { unsigned a = 0;
        a += (xb_ld(P.cnt + 0) + 255u) & ~255u; cb1 = a; a += (xb_ld(P.cnt + 1) + 255u) & ~255u; cb2 = a; a += (xb_ld(P.cnt + 2) + 255u) & ~255u; cb3 = a;
        a += (xb_ld(P.cnt + 3) + 255u) & ~255u; cb4 = a; a += (xb_ld(P.cnt + 4) + 255u) & ~255u; cb5 = a; a += (xb_ld(P.cnt + 5) + 255u) & ~255u; cb6 = a;
        a += (xb_ld(P.cnt + 6) + 255u) & ~255u; cb7 = a; }
    if (P.router) {
        for (int i = F.tid; i < 8192; i += 512) { const int col = i >> 3, e = i & 7; rwT[e * 1024 + col] = P.router[i]; }
        if (F.tid < 16) lcnt[F.tid] = 0u;
        __syncthreads();
    }
    LAS int* rtl = (LAS int*)(F.lds + 98304) + F.wave * 6 * 64;
    if (P.ymode == 2) { const int li_ = F.wave + 8 * lane;
        if (li_ < nrw) { const int* rt = P.route + (size_t)TROW(li_) * 8; const u32x4 a = *reinterpret_cast<const u32x4*>(rt); const u32x2 b = *reinterpret_cast<const u32x2*>(rt + 4);
            LAS int* d = rtl + lane * 6; d[0] = (int)a.x; d[1] = (int)a.y; d[2] = (int)a.z; d[3] = (int)a.w; d[4] = (int)b.x; d[5] = (int)b.y; }
        LDS_WAIT(); }
    f32x4 GA0 = {}, GA1 = {}, GA2 = {}, GA3 = {}, GB0 = {}, GB1 = {}, GB2 = {}, GB3 = {}, SH0 = {}, SH1 = {}, SH2 = {}, SH3 = {}; int cur_idx = -1;
#define TH_VEC(r_) do { const int ix_ = (r_) < RL ? ((r_) >> 12) : 8; if (ix_ != cur_idx) { cur_idx = ix_; \
        if (P.ymode) { const float* gt_ = P.gate + (size_t)ix_ * 6144 + 4 * lane; const float* ga_ = P.ga + 4 * lane; \
            GA0 = *reinterpret_cast<const f32x4*>(gt_) * *reinterpret_cast<const f32x4*>(ga_); GA1 = *reinterpret_cast<const f32x4*>(gt_ + 256) * *reinterpret_cast<const f32x4*>(ga_ + 256); \
            GA2 = *reinterpret_cast<const f32x4*>(gt_ + 512) * *reinterpret_cast<const f32x4*>(ga_ + 512); GA3 = *reinterpret_cast<const f32x4*>(gt_ + 768) * *reinterpret_cast<const f32x4*>(ga_ + 768); } \
        if (P.H) { const float* sh_ = P.shsc + (size_t)ix_ * 6144 + 4 * lane; const float* gb_ = P.gb + 4 * lane; \
            GB0 = *reinterpret_cast<const f32x4*>(gb_) * (*reinterpret_cast<const f32x4*>(sh_ + 1024) + 1.f); GB1 = *reinterpret_cast<const f32x4*>(gb_ + 256) * (*reinterpret_cast<const f32x4*>(sh_ + 1280) + 1.f); \
            GB2 = *reinterpret_cast<const f32x4*>(gb_ + 512) * (*reinterpret_cast<const f32x4*>(sh_ + 1536) + 1.f); GB3 = *reinterpret_cast<const f32x4*>(gb_ + 768) * (*reinterpret_cast<const f32x4*>(sh_ + 1792) + 1.f); \
            SH0 = *reinterpret_cast<const f32x4*>(sh_); SH1 = *reinterpret_cast<const f32x4*>(sh_ + 256); SH2 = *reinterpret_cast<const f32x4*>(sh_ + 512); SH3 = *reinterpret_cast<const f32x4*>(sh_ + 768); } } } while (0)
#define TH_VARGS GA0, GA1, GA2, GA3, GB0, GB1, GB2, GB3, SH0, SH1, SH2, SH3
    TH_DECL(A_); TH_DECL(B_);
    int li = F.wave;
    if (li < nrw) TH_LOAD(A_, TROW(li), 0);
    for (int it = 0; li < nrw; li += 16, it += 2) {
        const bool hb = li + 8 < nrw;
        if (hb) TH_LOAD(B_, TROW(li + 8), it + 1);
        TH_VEC(TROW(li)); thin_proc(P, TH_ARGS(A_), TH_VARGS, TROW(li), li, lane, rwT, rec, lcnt);
        if (li + 16 < nrw) TH_LOAD(A_, TROW(li + 16), it + 2);
        if (hb) { TH_VEC(TROW(li + 8)); thin_proc(P, TH_ARGS(B_), TH_VARGS, TROW(li + 8), li + 8, lane, rwT, rec, lcnt); }
    }
    if (P.router) {
        __syncthreads();
        if (F.tid < 8) lcnt[8 + F.tid] = __hip_atomic_fetch_add(P.cnt + F.tid, lcnt[F.tid], __ATOMIC_RELAXED, __HIP_MEMORY_SCOPE_AGENT);
        __syncthreads();
        for (int i = F.tid; i < nrw; i += 512) { const LAS int* rc = rec + i * 6; int* rt = P.route + (size_t)TROW(i) * 8;
            const int e0 = rc[0], e1 = rc[2];
            rt[0] = e0; rt[1] = rc[1] + (int)lcnt[8 + e0]; rt[2] = e1; rt[3] = rc[3] + (int)lcnt[8 + e1]; rt[4] = rc[4]; rt[5] = rc[5]; }
        VM_WAIT();
        for (int lb = F.wave; lb < nrw; lb += 32) {
            u32x4 v[4]; size_t s0[4], s1[4];
#pragma unroll
            for (int q = 0; q < 4; ++q) { const int lq = lb + 8 * q; const int r = TROW(lq); if (lq < nrw) { const LAS int* rc = rec + lq * 6; const int e0 = rc[0], e1 = rc[2];
                s0[q] = (size_t)e0 * RT + (size_t)(rc[1] + (int)lcnt[8 + e0]); s1[q] = (size_t)e1 * RT + (size_t)(rc[3] + (int)lcnt[8 + e1]);
                v[q] = *(reinterpret_cast<const u32x4*>((const unsigned char*)P.H + (size_t)r * DM) + lane); } }
#pragma unroll
            for (int q = 0; q < 4; ++q) { if (lb + 8 * q < nrw) {
                *(reinterpret_cast<u32x4*>(P.HSv + s0[q] * DM) + lane) = v[q]; *(reinterpret_cast<u32x4*>(P.HSv + s1[q] * DM) + lane) = v[q]; } }
        }
        __syncthreads();
    }
#undef TROW
#undef TH_VEC
#undef TH_VARGS
}

constexpr int NPHASE = 2 + DEPTH * 9;
__global__ void __launch_bounds__(512, 2) dit_fwd(Args args) {
    extern __shared__ __attribute__((aligned(16))) unsigned char lds[];
    Frame F;
    F.lds = (LAS unsigned char*)lds; F.ldsg = lds; F.MISC = (volatile LAS unsigned*)(F.lds + MISC_OFF);
    F.tid = threadIdx.x; F.lane = F.tid & 63; F.wave = __builtin_amdgcn_readfirstlane(F.tid >> 6);
    F.G = gridDim.x; { const int bx = blockIdx.x; F.vcu = (F.G % 8 == 0) ? (bx % 8) * (F.G / 8) + bx / 8 : bx; }
    F.ctl = (unsigned*)(args.ws + WS_CTL);
    for (int u = F.tid; u < (LDS_BYTES - RING_BYTES) / 4; u += 512) ((LAS unsigned*)(F.lds + RING_BYTES))[u] = 0u;
    __syncthreads();
    XcdBarrier bar = xcd_barrier_post(F.ctl + CW_BAR, F.MISC + 8);
    const int lo = args.ph_lo, hi = args.ph_hi;
    int ph = 0;
#define IN() (lo <= ph && ph < hi)
    unsigned long long wait_acc = 0, clk_c = 0, clk_r = 0;
#define CLK_BEG(sel) unsigned long long c0_ = 0, r0_ = 0; if (PROBE_CLK == (sel)) { c0_ = __builtin_amdgcn_s_memtime(); r0_ = __builtin_amdgcn_s_memrealtime(); }
#define CLK_END(sel) if (PROBE_CLK == (sel)) { clk_c += __builtin_amdgcn_s_memtime() - c0_; clk_r += __builtin_amdgcn_s_memrealtime() - r0_; }
#define SEAM() do { if (lo <= ph && ph + 1 < hi) { if (WAITPROBE) { const unsigned long long t0_ = __builtin_amdgcn_s_memrealtime(); xcd_barrier(bar); const unsigned long long dt_ = __builtin_amdgcn_s_memrealtime() - t0_; const int k_ = ph < 2 ? 9 + ph : (ph - 2) % 9; if ((WAITSEL >> k_) & 1u) wait_acc += dt_; } else xcd_barrier(bar); } ++ph; } while (0)
    GAS unsigned char* wsg = (GAS unsigned char*)args.ws;
#define WSP ((unsigned char*)wsg)
#define pMOD    ((float*)(WSP + WS_MOD))
#define pROPECS ((f32x2*)(WSP + WS_ROPE))
#define pWP     ((bf16_t*)(WSP + WS_WP))
#define pROUTE  ((int*)(WSP + WS_ROUTE))
#define pCS     ((bf16_t*)(WSP + WS_CS))
#define pCSC    ((bf16_t*)(WSP + WS_CSC))
#define pX      ((bf16_t*)(WSP + WS_X))
#define pH      ((bf16_t*)(WSP + WS_H))
#define pYO     ((bf16_t*)(WSP + WS_YO))
#define pZ      ((bf16_t*)(WSP + WS_Z))
#define pY      ((bf16_t*)(WSP + WS_Y))
#define pPQT    ((bf16_t*)(WSP + WS_PQT))
#define pPQTC   ((bf16_t*)(WSP + WS_PQTC))
#define pOB     ((bf16_t*)(WSP + WS_O))
#define pQK8    ((unsigned char*)(WSP + WS_QK8))
#define pVT8    ((unsigned char*)(WSP + WS_VT8))
#define pA2     ((bf16_t*)(WSP + WS_A2))
#define pA2M    ((bf16_t*)(WSP + WS_A2M))
#define pHS     ((bf16_t*)(WSP + WS_HS))
    const int vcu0 = F.vcu;
#define REFRAME() do { F.tid = opaque(threadIdx.x); F.lane = F.tid & 63; F.wave = __builtin_amdgcn_readfirstlane(F.tid >> 6); F.G = sopaque((int)gridDim.x); F.vcu = sopaque(vcu0); \
        wsg = gptr(args.ws); F.ctl = (unsigned*)(WSP + WS_CTL); } while (0)
    for (int rep0 = 0; rep0 < REP_P0; ++rep0)
    if (IN() && PH_ON(0)) { REFRAME();
        const int gw = F.vcu * 8 + F.wave, NGW = F.G * 8, gt = F.vcu * 512 + F.tid, NGT = F.G * 512;
        LAS float* ctab = (LAS float*)F.lds;
        LAS float* svec = (LAS float*)(F.lds + 16384);
        if (F.tid == 0) *(LAS unsigned*)(F.lds + 126976) = 0u;
        for (int i = F.tid; i < 4096; i += 512) ctab[i] = cospif((float)i * (1.f / 2048.f));
        for (int i = F.tid; i < 9 * 1024; i += 512) { const float v = i < 8192 ? args.c[i] : args.c_ctx[i - 8192]; svec[i] = v / (1.f + __expf(-v)); }
        __syncthreads();
        for (int i = gt; i < 4096 * 512; i += NGT) { const int k = i >> 9, l0 = (i & 511) * 8; float v[8];
#pragma unroll
            for (int e = 0; e < 8; ++e) { const int col = l0 + e; const int ph_ = (k * (col <= 2048 ? col : col - 2048)) & 4095; v[e] = col <= 2048 ? ctab[ph_] : -ctab[(ph_ - 1024) & 4095]; }
            *reinterpret_cast<u32x4*>(pCS + (size_t)k * FP + l0) = (u32x4){pk2(v[0], v[1]), pk2(v[2], v[3]), pk2(v[4], v[5]), pk2(v[6], v[7])}; }
        for (int i = gt; i < 256 * 64; i += NGT) { const int k = i >> 6, l0 = (i & 63) * 8; float v[8];
#pragma unroll
            for (int e = 0; e < 8; ++e) { const int col = l0 + e, l = col & 255; const int ph_ = (k * l * 16) & 4095; v[e] = col < 256 ? ctab[ph_] : -ctab[(ph_ - 1024) & 4095]; }
            *reinterpret_cast<u32x4*>(pCSC + (size_t)k * FP + l0) = (u32x4){pk2(v[0], v[1]), pk2(v[2], v[3]), pk2(v[4], v[5]), pk2(v[6], v[7])}; }
        for (int i = gt; i < 256 * 128; i += NGT) { const int row = i >> 7, c = i & 127, m = row & 127; const int ph_ = (m * c * 32) & 4095;
            const float v = row < 128 ? ctab[ph_] : ctab[(ph_ - 1024) & 4095]; pWP[i] = (bf16_t)f2bf(v); }
        for (int i = gt; i < 64 * 16; i += NGT) { const int pos = i >> 4, k = i & 15; const float inv = __powf(10000.f, -(float)(2 * k) / 32.f); float s, c; sincosf((float)pos * inv, &s, &c); pROPECS[i] = (f32x2){c, s}; }
        for (int task = F.vcu + F.wave * F.G; task < 512; task += 8 * F.G) { const int layer = task >> 7, col = (task & 127) * 48 + F.lane;
            if (F.lane < 48) {
            const float* w = args.ada_w + (size_t)layer * DM * 6144 + col;
            float a0 = 0, a1 = 0, a2 = 0, a3 = 0, a4 = 0, a5 = 0, a6 = 0, a7 = 0, a8 = 0;
            for (int k0 = 0; k0 < DM; k0 += 32) { float wv[32];
#pragma unroll
                for (int i = 0; i < 32; ++i) wv[i] = w[(size_t)(k0 + i) * 6144];
#pragma unroll
                for (int i = 0; i < 32; ++i) { const int k = k0 + i;
                    a0 += svec[k] * wv[i]; a1 += svec[1024 + k] * wv[i]; a2 += svec[2048 + k] * wv[i]; a3 += svec[3072 + k] * wv[i]; a4 += svec[4096 + k] * wv[i];
                    a5 += svec[5120 + k] * wv[i]; a6 += svec[6144 + k] * wv[i]; a7 += svec[7168 + k] * wv[i]; a8 += svec[8192 + k] * wv[i]; } }
            const float bb = args.ada_b[layer * 6144 + col]; float* mo = pMOD + (size_t)layer * 9 * 6144 + col;
            mo[0] = a0 + bb; mo[6144] = a1 + bb; mo[2 * 6144] = a2 + bb; mo[3 * 6144] = a3 + bb; mo[4 * 6144] = a4 + bb; mo[5 * 6144] = a5 + bb; mo[6 * 6144] = a6 + bb; mo[7 * 6144] = a7 + bb; mo[8 * 6144] = a8 + bb; } }
        LAS float* scr = (LAS float*)(F.lds + 57344 + F.wave * 8448);
        LAS unsigned* wcnt = (LAS unsigned*)(F.lds + 126976);
        constexpr int NITEMS = 2 * (16 * 40) + 2 * (16 * 32) + 2 * (16 * 96) + 2 * (16 * 32) + 2 * (16 * 176) + 2 * (44 * 32) + 16 * (16 * 224) + 16 * (56 * 32);
        for (;;) {
            const int n = __builtin_amdgcn_readfirstlane((int)__hip_atomic_fetch_add(wcnt, F.lane == 0 ? 1u : 0u, __ATOMIC_RELAXED, __HIP_MEMORY_SCOPE_WORKGROUP));
            const int it = ((n >> 3) * F.G + F.vcu) * 8 + (n & 7);
            if (it >= NITEMS) break;
            int r = it;
            if (transpose_job(r, args.mix_in_w, 2, DM, MIXIN, (bf16_t*)(WSP + WS_WMIXIN), false, false, scr, F.lane)) continue;
            if (transpose_job(r, args.mix_out_w, 2, DM, DM, (bf16_t*)(WSP + WS_WMIXOUT), false, false, scr, F.lane)) continue;
            if (transpose_job(r, args.diff_qkv_w, 2, DM, 3072, (bf16_t*)(WSP + WS_WQKV), false, true, scr, F.lane)) continue;
            if (transpose_job(r, args.diff_out_w, 2, DM, DM, (bf16_t*)(WSP + WS_WDOUT), false, false, scr, F.lane)) continue;
            if (transpose_job(r, args.ffn_in_w, 2, DM, 2 * FFN, (bf16_t*)(WSP + WS_WFFNIN), true, F8_DENSE, scr, F.lane)) continue;
            if (transpose_job(r, args.ffn_out_w, 2, FFN, DM, (bf16_t*)(WSP + WS_WFFNOUT), false, F8_DENSE || F8_DDOWN, scr, F.lane)) continue;
            if (transpose_job(r, args.expert_in_w, 16, DM, 2 * EDIM, (bf16_t*)(WSP + WS_WEXPIN), true, true, scr, F.lane)) continue;
            transpose_job(r, args.expert_out_w, 16, EDIM, DM, (bf16_t*)(WSP + WS_WEXPOUT), false, true, scr, F.lane);
        }
        __syncthreads();
    }
    SEAM();
    if (IN() && PH_ON(1)) { REFRAME();
        ThinP P{}; P.nrows = RT; P.xin_lat = args.x; P.xin_ctx = args.ctx; P.ymode = 0; P.H = pH; P.gb = args.norm_g; P.shsc = pMOD;
        for (int rep = 0; rep < REP_P0B; ++rep) thin_phase(F, P);
        for (int rep = 0; rep < EXTRA_BARS; ++rep) xcd_barrier(bar);
    }
    SEAM();

    for (int layer = 0; layer < DEPTH; ++layer) {
        const int j = layer >> 1; const bool even = !(layer & 1), lastl = layer == DEPTH - 1;
        const float* modl = pMOD + (size_t)layer * 9 * 6144; const float* ng = args.norm_g + (size_t)layer * 4 * DM;
        const int Mrows = lastl ? RL : RT;
        if (IN() && PH_ON(2)) { REFRAME();
            pg8::Dims d{DM, DM}; SchedDense S;
            if (even) { S.init(pH, DM, (bf16_t*)(WSP + WS_WMIXIN) + (size_t)j * MIXIN * DM, DM, RT, MIXIN, DM, F.G, (int)blockIdx.x);
                EpiRope<false> E{WSP}; for (int rep = 0; rep < REP_PROJ; ++rep) pg8::gemm_phase(F.lds, d, S, E); }
            else { const unsigned char* wq = (const unsigned char*)(WSP + WS_WQKV) + (size_t)j * 3072 * DM;
                pg8::Dims d8{DM / 2, DM / 2};
                S.init(pH, DM / 2, wq, DM / 2, RT, 2048, DM / 2, F.G, (int)blockIdx.x);
                EpiRope<true> E{WSP}; for (int rep = 0; rep < REP_PROJ; ++rep) pg8::gemm_phase<EpiRope<true>, SchedDense, true>(F.lds, d8, S, E);
                SchedDense S2; S2.init(wq + (size_t)2048 * DM, DM / 2, pH, DM / 2, DM, RT, DM / 2, F.G, (int)((blockIdx.x + 3 * (gridDim.x / 4)) % gridDim.x));
                EpiVt E2{WSP}; for (int rep = 0; rep < REP_PROJ; ++rep) pg8::gemm_phase<EpiVt, SchedDense, true>(F.lds, d8, S2, E2); }
        }
        SEAM();
        if (IN() && PH_ON(3)) { REFRAME();
            if (even) {
                if (PH_ON(16)) { pg8::Dims d{128, MIXIN}; SchedF1 S{(const char*)pWP, (const char*)pZ, F.G, F.vcu}; EpiPQt E{pPQT, pPQTC}; for (int rep = 0; rep < REP_FOUR; ++rep) pg8::gemm_phase(F.lds, d, S, E); }
            } else {
                const float* lv = args.diff_lambda + j * 256;
                const int ln = opaque(F.lane); const float s01 = wave_sum(lv[ln] * lv[64 + ln], ln), s23 = wave_sum(lv[128 + ln] * lv[192 + ln], ln);
                const float lam_init = 0.8f - 0.6f * __expf(-0.3f * (float)layer);
                const float lam = __expf(s01) - __expf(s23) + lam_init;
                const float* subg = args.diff_subln_g + j * 128;
                const int nu = lastl ? 2048 : 2048 + 128;
                CLK_BEG(1)
                for (int rep = 0; rep < REP_DIFF; ++rep)
                for (int u = F.vcu; u < (PH_ON(18) ? nu : 0); u += F.G) {
                    if (u < 2048) diff_attn_unit((char*)lds, pVT8, pQK8, pOB, subg, lam, 1.f - lam_init, u >> 8, (u >> 5) & 7, u & 31, false);
                    else { const int v = u - 2048; diff_attn_unit((char*)lds, pVT8, pQK8, pOB, subg, lam, 1.f - lam_init, v >> 4, (v >> 1) & 7, v & 1, true); }
                }
                __syncthreads();
                CLK_END(1)
            }
        }
        SEAM();
        if (IN() && PH_ON(4)) { REFRAME();
            if (even) { pg8::Dims d{FP, FP}; SchedF2 S{(const char*)pCS, (const char*)pCSC, (const char*)pPQT, (const char*)pPQTC, F.G, F.vcu}; EpiFour2 E{pY}; for (int rep = 0; rep < REP_FOUR; ++rep) pg8::gemm_phase<EpiFour2, SchedF2, false>(F.lds, d, S, E);
                const float* sink = args.win_sink + j * 8;
                for (int rep = 0; rep < REP_WIN; ++rep)
                for (int u = F.vcu; u < (PH_ON(17) ? 1024 + 64 : 0); u += F.G) {
                    if (u < 1024) win_attn_unit2((char*)lds, pZ, pY, sink, u >> 7, (u >> 6) & 1, u & 63, false);
                    else { const int v = u - 1024; win_attn_unit2((char*)lds, pZ, pY, sink, v >> 3, (v >> 2) & 1, v & 3, true); }
                }
                __syncthreads();
            }
        }
        if (even) SEAM(); else ++ph;
        if (IN() && PH_ON(5)) { REFRAME();
            pg8::Dims d{DM, DM}; SchedDense S;
            S.init(even ? pY : pOB, DM, (bf16_t*)(WSP + (even ? WS_WMIXOUT : WS_WDOUT)) + (size_t)j * DM * DM, DM, Mrows, DM, DM, F.G, (int)blockIdx.x);
            CLK_BEG(4)
            EpiStore E{pYO, DM, 1.f}; for (int rep = 0; rep < REP_PROJ; ++rep) pg8::gemm_phase(F.lds, d, S, E);
            CLK_END(4)
        }
        SEAM();
        if (IN() && PH_ON(6)) { REFRAME();
            ThinP P{}; P.nrows = Mrows; P.xin16 = layer != 0; P.xout16 = true;
            if (layer == 0) { P.xin_lat = args.x; P.xin_ctx = args.ctx; } else { P.xin_lat = pX; P.xin_ctx = pX + (size_t)RL * DM; }
            P.xout_lat = pX; P.xout_ctx = pX + (size_t)RL * DM; P.ymode = 1; P.Ysrc = pYO; P.gate = modl + 2048; P.ga = ng + DM;
            P.H = pH; P.h8 = !even || F8_DENSE; P.gb = ng + 2 * DM; P.shsc = modl + 3072;
            if (!even) { P.router = args.router_w + (size_t)j * DM * 8; P.route = pROUTE; P.cnt = F.ctl + CW_CNT + 16 * j; P.HSv = (unsigned char*)pHS; }
            thin_phase(F, P);
        }
        SEAM();
        unsigned c0 = 0, c1 = 0, c2 = 0, c3 = 0, c4 = 0, c5 = 0, c6 = 0, c7 = 0;
        if (!even) { unsigned* cn = F.ctl + CW_CNT + 16 * j; unsigned a = 0;
            c0 = 0; a += (rfl(xb_ld(cn + 0)) + 255u) & ~255u; c1 = a; a += (rfl(xb_ld(cn + 1)) + 255u) & ~255u; c2 = a; a += (rfl(xb_ld(cn + 2)) + 255u) & ~255u; c3 = a;
            a += (rfl(xb_ld(cn + 3)) + 255u) & ~255u; c4 = a; a += (rfl(xb_ld(cn + 4)) + 255u) & ~255u; c5 = a; a += (rfl(xb_ld(cn + 5)) + 255u) & ~255u; c6 = a;
            a += (rfl(xb_ld(cn + 6)) + 255u) & ~255u; c7 = a; a += (rfl(xb_ld(cn + 7)) + 255u) & ~255u; c0 = a; }
        ++ph;
        if (IN() && PH_ON(8)) { REFRAME();
            const bool f8 = !even || F8_DENSE; const int eb = f8 ? 1 : 2;
            pg8::Dims d{DM * eb / 2, DM * eb / 2}; SchedGroup S;
            if (even) { S.A = (const char*)pH; S.B = (const char*)(WSP + WS_WFFNIN) + (size_t)j * 2 * FFN * DM * eb; S.nRT = RT / 256; S.P1 = S.P2 = S.P3 = S.P4 = S.P5 = S.P6 = S.P7 = 1 << 30; S.nN = 2 * FFN / 256; S.gB = 0; S.aE = 0; }
            else { S.aE = (size_t)RT * DM; S.A = (const char*)pHS; S.B = (const char*)(WSP + WS_WEXPIN) + (size_t)j * NEXP * 2 * EDIM * DM; S.nRT = (int)(c0 >> 8);
                S.P1 = (int)(c1 >> 8); S.P2 = (int)(c2 >> 8); S.P3 = (int)(c3 >> 8); S.P4 = (int)(c4 >> 8); S.P5 = (int)(c5 >> 8); S.P6 = (int)(c6 >> 8); S.P7 = (int)(c7 >> 8);
                S.nN = 2 * EDIM / 256; S.gB = (size_t)2 * EDIM * DM; }
            S.nwg = S.nRT * S.nN; S.G = F.G; S.c = (int)blockIdx.x; S.nkt = DM * eb / 128; S.tA = (size_t)256 * DM * eb; S.tB = (size_t)256 * DM * eb;
            CLK_BEG(even ? 2 : 3)
            if (f8) { EpiSwiglu<true> E{(unsigned char*)(even ? pA2 : pA2M), even ? FFN : EDIM, 1.f / (F8_SH * F8_SW)}; for (int rep = 0; rep < REP_MOE; ++rep) pg8::gemm_phase<EpiSwiglu<true>, SchedGroup, true, ALIGN_SWIGLU>(F.lds, d, S, E); }
            else if (F8_DDOWN) { EpiSwiglu<true> E{(unsigned char*)pA2, FFN, 1.f}; for (int rep = 0; rep < REP_MOE; ++rep) pg8::gemm_phase<EpiSwiglu<true>, SchedGroup, false>(F.lds, d, S, E); }
            else { EpiSwiglu<false> E{(unsigned char*)pA2, FFN, 1.f}; for (int rep = 0; rep < REP_MOE; ++rep) pg8::gemm_phase<EpiSwiglu<false>, SchedGroup, false>(F.lds, d, S, E); }
            CLK_END(even ? 2 : 3)
        }
        SEAM();
        if (IN() && PH_ON(9)) { REFRAME();
            const bool f8 = !even || F8_DENSE || F8_DDOWN; const int eb = f8 ? 1 : 2;
            const int Kh = even ? FFN : EDIM; pg8::Dims d{Kh * eb / 2, Kh * eb / 2}; SchedGroup S;
            if (even) { S.A = (const char*)pA2; S.B = (const char*)(WSP + WS_WFFNOUT) + (size_t)j * DM * FFN * eb; S.nRT = RT / 256; S.P1 = S.P2 = S.P3 = S.P4 = S.P5 = S.P6 = S.P7 = 1 << 30; S.gB = 0; }
            else { S.A = (const char*)pA2M; S.B = (const char*)(WSP + WS_WEXPOUT) + (size_t)j * NEXP * DM * EDIM; S.nRT = (int)(c0 >> 8);
                S.P1 = (int)(c1 >> 8); S.P2 = (int)(c2 >> 8); S.P3 = (int)(c3 >> 8); S.P4 = (int)(c4 >> 8); S.P5 = (int)(c5 >> 8); S.P6 = (int)(c6 >> 8); S.P7 = (int)(c7 >> 8);
                S.gB = (size_t)DM * EDIM; }
            S.aE = 0; S.nN = DM / 256; S.nwg = S.nRT * S.nN; S.G = F.G; S.c = (int)blockIdx.x; S.nkt = Kh * eb / 128; S.tA = (size_t)256 * Kh * eb; S.tB = (size_t)256 * Kh * eb;
            if (f8) { EpiStore E{even ? pYO : pHS, DM, 1.f / (F8_SA * F8_SW)}; for (int rep = 0; rep < REP_MOE; ++rep) pg8::gemm_phase<EpiStore, SchedGroup, true>(F.lds, d, S, E); }
            else { EpiStore E{pYO, DM, 1.f}; for (int rep = 0; rep < REP_MOE; ++rep) pg8::gemm_phase<EpiStore, SchedGroup, false>(F.lds, d, S, E); }
        }
        SEAM();
        if (IN() && PH_ON(10)) { REFRAME();
            ThinP P{}; P.nrows = Mrows; P.xin16 = true; P.xout16 = !lastl; P.xin_lat = pX; P.xin_ctx = pX + (size_t)RL * DM;
            if (lastl) P.xout_lat = args.out; else P.xout_lat = pX;
            P.xout_ctx = pX + (size_t)RL * DM; P.ymode = even ? 1 : 2; P.Ysrc = even ? pYO : pHS; P.gate = modl + 5120; P.ga = ng + 3 * DM;
            P.route = pROUTE; P.cnt = F.ctl + CW_CNT + 16 * j;
            if (!lastl) { P.H = pH; P.h8 = even; P.gb = ng + 4 * DM; P.shsc = modl + 9 * 6144; }
            thin_phase(F, P);
        }
        SEAM();
    }
    if (PROBE_CLK) {
        const unsigned long long dur_ = clk_r ? clk_c * 5000ull / clk_r : 0ull, t0_ = __builtin_amdgcn_s_memrealtime();
        while (__builtin_amdgcn_s_memrealtime() - t0_ < dur_) __builtin_amdgcn_s_sleep(8);
    }
    if (WAITPROBE) {
        unsigned* wsum = F.ctl + 48;
        if (threadIdx.x == 0) __hip_atomic_fetch_add(wsum, (unsigned)wait_acc, __ATOMIC_RELAXED, __HIP_MEMORY_SCOPE_AGENT);
        xcd_barrier(bar);
        const unsigned mean = xb_ld(wsum) / gridDim.x; const unsigned long long t0_ = __builtin_amdgcn_s_memrealtime();
        while (__builtin_amdgcn_s_memrealtime() - t0_ < (unsigned long long)mean * WAITPROBE) __builtin_amdgcn_s_sleep(8);
    }
#undef IN
#undef SEAM
#undef REFRAME
}

#ifndef MK_PER_PHASE
#define MK_PER_PHASE 0
#endif
extern "C" void kernel_launch(void* const* d_in, const int* in_sizes, int n_in, void* d_out, int out_size, void* d_ws, size_t ws_size, hipStream_t stream) {
    static int grid = 0;
    if (grid == 0) {
        if (n_in != 19 || in_sizes[0] != RL * DM || out_size != RL * DM || ws_size < WS_END) {
            fprintf(stderr, "kernel_launch: unexpected shapes / workspace (n_in %d in0 %d out %d ws %zu need %zu)\n", n_in, n_in > 0 ? in_sizes[0] : -1, out_size, ws_size, (size_t)WS_END); grid = -1; return; }
        int dev = 0, cus = 0, per_cu = 0;
        if (hipGetDevice(&dev) != hipSuccess || hipDeviceGetAttribute(&cus, hipDeviceAttributeMultiprocessorCount, dev) != hipSuccess) { grid = -1; return; }
        if (hipFuncSetAttribute((const void*)dit_fwd, hipFuncAttributeMaxDynamicSharedMemorySize, LDS_BYTES) != hipSuccess) { fprintf(stderr, "kernel_launch: hipFuncSetAttribute failed\n"); grid = -1; return; }
        if (hipOccupancyMaxActiveBlocksPerMultiprocessor(&per_cu, (const void*)dit_fwd, 512, LDS_BYTES) != hipSuccess || per_cu < 1)
            fprintf(stderr, "kernel_launch: occupancy query reports %d\n", per_cu);
        (void)hipGetLastError();
        grid = cus;
    }
    if (grid < 0) return;
    if (hipMemsetAsync((char*)d_ws + WS_CTL, 0, CTL_BYTES, stream) != hipSuccess) return;
    Args a{};
    const float** ap = (const float**)&a;
    for (int i = 0; i < 19; ++i) ap[i] = (const float*)d_in[i];
    a.out = (float*)d_out; a.ws = (unsigned char*)d_ws;
#if MK_PER_PHASE
    for (int p = 0; p < NPHASE; ++p) { a.ph_lo = p; a.ph_hi = p + 1; hipLaunchKernelGGL(dit_fwd, dim3(grid), dim3(512), LDS_BYTES, stream, a); }
#else
    a.ph_lo = 0; a.ph_hi = NPHASE;
    hipLaunchKernelGGL(dit_fwd, dim3(grid), dim3(512), LDS_BYTES, stream, a);
#endif
}
```

```cpp
#include <hip/hip_runtime.h>
#include <cstdio>
#include <cstdint>

#ifndef PHMASK
#define PHMASK 0xFFFFFFFFu
#endif
#define PH_ON(i) ((PHMASK >> (i)) & 1u)
#ifndef REP_DIFF
#define REP_DIFF 1
#endif
#ifndef REP_MOE
#define REP_MOE 1
#endif
#ifndef REP_P0
#define REP_P0 1
#endif
#ifndef REP_P0B
#define REP_P0B 1
#endif
#ifndef EXTRA_BARS
#define EXTRA_BARS 0
#endif
#ifndef REP_EPI
#define REP_EPI 1
#endif
#ifndef WAITSEL
#define WAITSEL 0xFFFFu
#endif
#ifndef WAITPROBE
#define WAITPROBE 0
#endif
#ifndef KREP
#define KREP 1
#endif
#ifndef REP_PROJ
#define REP_PROJ 1
#endif
#ifndef REP_FOUR
#define REP_FOUR 1
#endif
#ifndef REP_WIN
#define REP_WIN 1
#endif
#ifndef PROBE_CLK
#define PROBE_CLK 0
#endif
#define LAS __attribute__((address_space(3)))
#define GAS __attribute__((address_space(1)))
typedef unsigned short bf16_t;
typedef short bf16x8 __attribute__((ext_vector_type(8)));
typedef short s16x4 __attribute__((ext_vector_type(4)));
typedef float f32x2 __attribute__((ext_vector_type(2)));
typedef float f32x4 __attribute__((ext_vector_type(4)));
typedef float f32x16 __attribute__((ext_vector_type(16)));
typedef unsigned u32x2 __attribute__((ext_vector_type(2)));
typedef unsigned u32x4 __attribute__((ext_vector_type(4)));
typedef __bf16 bf16x2_t __attribute__((ext_vector_type(2)));
typedef int v8i_t __attribute__((ext_vector_type(8)));

constexpr int DM = 1024, NB = 8, SEQ = 4096, CTX = 256, DEPTH = 4;
constexpr int RL = NB * SEQ, RC = NB * CTX, RT = RL + RC;
constexpr int MIXIN = 1280, FFN = 2816, NEXP = 8, EDIM = 3584;
constexpr int MAXSLOT = 71680;
constexpr float EPS = 1e-6f;
constexpr float LOG2E = 1.4426950408889634f;
constexpr float QK_C = 0.125f * LOG2E;

constexpr size_t MiB = 1u << 20;
constexpr size_t WS_CTL = 0, CTL_BYTES = 32 * 1024;
constexpr size_t WS_MOD = 1 * MiB;
constexpr size_t WS_ROPE = WS_MOD + 900 * 1024;
constexpr size_t WS_WP = WS_ROPE + 8 * 1024;
constexpr size_t WS_ROUTE = 2 * MiB;
constexpr size_t WS_CS = 4 * MiB;
constexpr size_t WS_CSC = 68 * MiB;
constexpr size_t WS_WMIXIN = 72 * MiB;
constexpr size_t WS_WMIXOUT = 77 * MiB;
constexpr size_t WS_WQKV = 81 * MiB;
constexpr size_t WS_WDOUT = 93 * MiB;
constexpr size_t WS_WFFNIN = 97 * MiB;
constexpr size_t WS_WFFNOUT = 119 * MiB;
constexpr size_t WS_WEXPIN = 130 * MiB;
constexpr size_t WS_WEXPOUT = 354 * MiB;
constexpr size_t WS_X = 466 * MiB;
constexpr size_t WS_H = 602 * MiB;
constexpr size_t WS_YO = 670 * MiB;
constexpr size_t WS_RA = 738 * MiB;
constexpr size_t WS_Z = WS_RA;
constexpr size_t WS_VT8 = WS_RA;
constexpr size_t WS_Y = WS_RA + 85 * MiB;
constexpr size_t WS_PQT = WS_RA + 153 * MiB;
constexpr size_t WS_O = WS_RA + 204 * MiB;
constexpr size_t WS_RB = 1010 * MiB;
constexpr size_t WS_A2 = WS_RB;
constexpr size_t WS_QK8 = WS_RB;
constexpr size_t WS_PQTC = WS_RB + 190 * MiB;
constexpr size_t WS_A2M = WS_H;
constexpr size_t WS_HS = 1092 * MiB;
constexpr size_t WS_END = 1364 * MiB;
static_assert(WS_A2M + (size_t)MAXSLOT * EDIM * 2 <= WS_HS, "A2m overlay");
static_assert(WS_HS + (size_t)NEXP * RT * DM <= WS_END && WS_HS + (size_t)MAXSLOT * DM * 2 <= WS_END && WS_PQTC + 64 * MiB <= WS_END, "ws end");

constexpr int CW_TMO = 0;
constexpr int CW_CNT = 64;
constexpr int CW_BAR = 4096;

constexpr int RING_BYTES = 131072;
constexpr int MISC_OFF = RING_BYTES + 320;
constexpr int LDS_BYTES = 147456;

__device__ __forceinline__ unsigned cvtpk(float lo, float hi) { f32x2 v = {lo, hi}; bf16x2_t b = __builtin_convertvector(v, bf16x2_t); return __builtin_bit_cast(unsigned, b); }
#ifndef F8_DENSE
#define F8_DENSE false
#endif
#ifndef F8_DDOWN
#define F8_DDOWN true
#endif
#ifndef F8_FOUR
#define F8_FOUR false
#endif
static_assert(!F8_FOUR, "fp8 Fourier path retired");
constexpr int FP = 4096;
constexpr float F8_SCS = 256.f, F8_SPQ = 8.f;
constexpr float F8_SH = 4.f, F8_SW = 64.f, F8_SA = 4.f;
__device__ __forceinline__ float f8clamp(float v) { return __builtin_amdgcn_fmed3f(v, -448.f, 448.f); }
__device__ __forceinline__ unsigned pk4_fp8(float a, float b, float c, float d) {
    unsigned w = 0; w = __builtin_amdgcn_cvt_pk_fp8_f32(f8clamp(a), f8clamp(b), w, false); w = __builtin_amdgcn_cvt_pk_fp8_f32(f8clamp(c), f8clamp(d), w, true); return w; }
__device__ __forceinline__ float bf_lo(unsigned u) { return __uint_as_float(u << 16); }
__device__ __forceinline__ float bf_hi(unsigned u) { return __uint_as_float(u & 0xffff0000u); }
__device__ __forceinline__ float wave_sum(float v, int lane) {
#pragma unroll
    for (int o = 1; o < 64; o <<= 1) v += __int_as_float(__builtin_amdgcn_ds_bpermute((lane ^ o) << 2, __float_as_int(v)));
    return v;
}
__device__ __forceinline__ unsigned rfl(unsigned v) { return (unsigned)__builtin_amdgcn_readfirstlane((int)v); }
__device__ __forceinline__ const char* uptr(const char* p) {
    unsigned lo = (unsigned)__builtin_amdgcn_readfirstlane((int)(unsigned)(uintptr_t)p), hi = (unsigned)__builtin_amdgcn_readfirstlane((int)(unsigned)((uintptr_t)p >> 32));
    asm volatile("" : "+s"(lo), "+s"(hi));
    return (const char*)(((uintptr_t)hi << 32) | lo);
}
__device__ __forceinline__ GAS unsigned char* gptr(const void* p) {
    unsigned lo = (unsigned)__builtin_amdgcn_readfirstlane((int)(unsigned)(uintptr_t)p), hi = (unsigned)__builtin_amdgcn_readfirstlane((int)(unsigned)((uintptr_t)p >> 32));
    asm volatile("" : "+s"(lo), "+s"(hi));
    return (GAS unsigned char*)(((uintptr_t)hi << 32) | lo);
}
__device__ __forceinline__ int sopaque(int v) { v = __builtin_amdgcn_readfirstlane(v); asm volatile("" : "+s"(v)); return v; }
__device__ __forceinline__ int opaque(int v) { asm volatile("" : "+v"(v)); return v; }
#define LDS_WAIT() asm volatile("s_waitcnt lgkmcnt(0)" ::: "memory")
#define VM_WAIT() asm volatile("s_waitcnt vmcnt(0)" ::: "memory")
#define SBAR() __builtin_amdgcn_sched_barrier(0)

namespace pg8 {
constexpr int BM = 256, BK = 64, HALF = 128, HTB = HALF * BK * 2, STAGE_BYTES = 8 * HTB, NXCD = 8, WGM = 8;
__host__ __device__ __forceinline__ int lds_byte(int r, int c) { const int st = (r >> 4) * 2 + (c >> 5), rr = r & 15, cc = c & 31, ob = rr * 64 + cc * 2; return st * 1024 + (ob ^ (((ob >> 9) & 1) << 5)); }
__host__ __device__ __forceinline__ void stage_rc(int b, int& R, int& C) { const int st = b / 1024, sb = b % 1024, swz = sb ^ (((sb >> 9) & 1) << 5); R = (st >> 1) * 16 + swz / 64; C = (st & 1) * 32 + (swz % 64) / 2; }
__host__ __device__ __forceinline__ int perm32(int rho) { const int n = rho >> 4, i = rho & 15; return 8 * (i >> 2) + 4 * n + (i & 3); }

struct Unit { int pm, pn, e, nkt; };
struct Dims { int lda, ldb; };

__device__ __forceinline__ int xcd_remap(int wgid, int nwg) {
    const int q = nwg / NXCD, r = nwg % NXCD, xcd = wgid % NXCD, off = wgid / NXCD;
    return (xcd < r ? xcd * (q + 1) : r * (q + 1) + (xcd - r) * q) + off;
}

#ifndef ALIGN_SWIGLU
#define ALIGN_SWIGLU true
#endif
#ifndef ALIGN_DEFAULT
#define ALIGN_DEFAULT true
#endif
template <class Epi, class Sched, bool F8 = false, bool ALIGN_EPI = ALIGN_DEFAULT>
__device__ __forceinline__ void gemm_phase(LAS unsigned char* lds, const Dims g, const Sched& S, const Epi& E) {
    const int tid = opaque(threadIdx.x), wid = __builtin_amdgcn_readfirstlane(tid >> 6), lane = tid & 63, wr = wid >> 2, wc = wid & 3, fr = lane & 15, fq = lane >> 4;
    unsigned voffA[2], voffB[2];
#pragma unroll
    for (int i = 0; i < 2; ++i) { int R, C; stage_rc(tid * 16 + i * 8192, R, C); const int Rb = Epi::PERM ? ((R & ~31) + perm32(R & 31)) : R;
        voffA[i] = (unsigned)(R * g.lda + C) * 2u; voffB[i] = (unsigned)(Rb * g.ldb + C) * 2u; }
    const size_t kstep = (size_t)(BK * 2);
    const size_t hstepA = (size_t)HALF * g.lda * 2, hstepB = (size_t)HALF * g.ldb * 2;
    const unsigned ldsw = (unsigned)wid * 1024u;
    const int aoff = lds_byte(wr * 64 + fr, fq * 8), boff = lds_byte(wc * 32 + fr, fq * 8);
#define PG8_SA(b, h) (((b) * 2 + (h)) * HTB)
#define PG8_SB(b, h) ((4 + (b) * 2 + (h)) * HTB)
#define PG8_STAGE(bufoff, gbase, voff) do { _Pragma("unroll") for (int _i = 0; _i < 2; ++_i) \
        __builtin_amdgcn_global_load_lds((const unsigned*)((const char*)(gbase) + (voff)[_i]), (LAS unsigned*)(lds + (bufoff) + ldsw + _i * 8192), 16, 0, 0); } while (0)
#define PG8_LDA(dst, b, h) do { _Pragma("unroll") for (int m = 0; m < 4; ++m) _Pragma("unroll") for (int k = 0; k < 2; ++k) dst[m][k] = *(const LAS bf16x8*)(lds + PG8_SA(b, h) + aoff + m * 2048 + k * 1024); } while (0)
#define PG8_LDB(dst, b, h) do { _Pragma("unroll") for (int n = 0; n < 2; ++n) _Pragma("unroll") for (int k = 0; k < 2; ++k) dst[n][k] = *(const LAS bf16x8*)(lds + PG8_SB(b, h) + boff + n * 2048 + k * 1024); } while (0)
#define PG8_V8(x) __builtin_bit_cast(v8i_t, (x))
#define PG8_MMA(ai, bj, At, Bt) do { __builtin_amdgcn_s_setprio(1); _Pragma("unroll") for (int m = 0; m < 4; ++m) _Pragma("unroll") for (int n = 0; n < 2; ++n) { \
        if constexpr (F8) { struct P2 { bf16x8 a, b; }; const v8i_t a8_ = PG8_V8((P2{Bt[n][0], Bt[n][1]})), b8_ = PG8_V8((P2{At[m][0], At[m][1]})); \
            asm volatile("v_mfma_f32_16x16x128_f8f6f4 %0, %1, %2, %0" : "+v"(acc[ai][bj][m][n]) : "v"(a8_), "v"(b8_)); }   \
        else { _Pragma("unroll") for (int k = 0; k < 2; ++k) acc[ai][bj][m][n] = __builtin_amdgcn_mfma_f32_16x16x32_bf16(Bt[n][k], At[m][k], acc[ai][bj][m][n], 0, 0, 0); } } \
        __builtin_amdgcn_s_setprio(0); } while (0)
#define PG8_WAIT_V(n) asm volatile("s_waitcnt vmcnt(" #n ")" ::: "memory")
#define PG8_WAIT_L(n) asm volatile("s_waitcnt lgkmcnt(" #n ")" ::: "memory")
#define PG8_BAR __builtin_amdgcn_s_barrier()
#define PG8_SCHED __builtin_amdgcn_sched_barrier(0)
    Unit cur, nxt; int ui = 0;
    if (!S.next(0, cur)) return;
    constexpr bool MIR = Sched::MIRROR;
    unsigned vB2c[2] = {0u, 0u}, vB2n[2] = {0u, 0u}; const char* cB2 = nullptr; const char* nB2 = nullptr;
#define PG8_MKV2(dst, un) do { const int t2_ = opaque(threadIdx.x); _Pragma("unroll") for (int i_ = 0; i_ < 2; ++i_) { int R_, C_; stage_rc(t2_ * 16 + i_ * 8192, R_, C_); \
        const int Rb_ = Epi::PERM ? ((R_ & ~31) + perm32(R_ & 31)) : R_; dst[i_] = S.voff2(un, Rb_, C_, g.ldb); } } while (0)
    if constexpr (MIR) { PG8_MKV2(vB2c, cur); cB2 = uptr(S.bptr2(cur)); }
    f32x4 acc[2][2][4][2];
#pragma unroll
    for (int a = 0; a < 2; ++a)
#pragma unroll
        for (int b = 0; b < 2; ++b)
#pragma unroll
            for (int m = 0; m < 4; ++m)
#pragma unroll
                for (int n = 0; n < 2; ++n) acc[a][b][m][n] = (f32x4){0.f, 0.f, 0.f, 0.f};
    bf16x8 At[4][2], B0[2][2], B1[2][2];
    const char* cA = uptr(S.aptr(cur)); const char* cB = uptr(S.bptr(cur));
    PG8_STAGE(PG8_SB(0, 0), cB, voffB); if constexpr (MIR) PG8_STAGE(PG8_SB(0, 1), cB2, vB2c); else PG8_STAGE(PG8_SB(0, 1), cB + hstepB, voffB); PG8_STAGE(PG8_SA(0, 0), cA, voffA); PG8_STAGE(PG8_SA(0, 1), cA + hstepA, voffA);
    if (wr == 1) PG8_BAR;
    PG8_WAIT_V(2); PG8_BAR;
    PG8_STAGE(PG8_SB(1, 0), cB + kstep, voffB); PG8_STAGE(PG8_SA(1, 0), cA + kstep, voffA); if constexpr (MIR) PG8_STAGE(PG8_SB(1, 1), cB2 + kstep, vB2c); else PG8_STAGE(PG8_SB(1, 1), cB + hstepB + kstep, voffB);
    PG8_WAIT_V(6); PG8_BAR;
    for (;;) {
        const bool has_next = S.next(ui + 1, nxt);
        const char* nA = uptr(has_next ? S.aptr(nxt) : cA); const char* nB = uptr(has_next ? S.bptr(nxt) : cB);
        if constexpr (MIR) { if (has_next) { PG8_MKV2(vB2n, nxt); nB2 = uptr(S.bptr2(nxt)); } else { vB2n[0] = vB2c[0]; vB2n[1] = vB2c[1]; nB2 = cB2; } }
        const int nt = sopaque(cur.nkt);
        for (int t = 0; t < KREP * nt; t += 2) {
            const bool last = (t == KREP * nt - 2);
            const char* a1 = cA + (size_t)(KREP == 1 ? t + 1 : (t + 1) % nt) * kstep;
            const char* a2 = last ? nA : cA + (size_t)(KREP == 1 ? t + 2 : (t + 2) % nt) * kstep; const char* b2 = last ? nB : cB + (size_t)(KREP == 1 ? t + 2 : (t + 2) % nt) * kstep;
            const char* a3 = a2 + kstep; const char* b3 = b2 + kstep;
            const char* m2 = nullptr; unsigned vm[2] = {0u, 0u};
            if constexpr (MIR) { m2 = last ? nB2 : cB2 + (size_t)(t + 2) * kstep; vm[0] = last ? vB2n[0] : vB2c[0]; vm[1] = last ? vB2n[1] : vB2c[1]; }
            PG8_LDB(B0, 0, 0); PG8_LDB(B1, 0, 1); PG8_SCHED; PG8_LDA(At, 0, 0); PG8_STAGE(PG8_SA(1, 1), a1 + hstepA, voffA);
            PG8_WAIT_V(8); PG8_WAIT_L(0); PG8_BAR; PG8_MMA(0, 0, At, B0); PG8_MMA(0, 1, At, B1); PG8_BAR; PG8_SCHED;
            PG8_LDA(At, 0, 1); PG8_STAGE(PG8_SB(0, 0), b2, voffB); if constexpr (MIR) PG8_STAGE(PG8_SB(0, 1), m2, vm); else PG8_STAGE(PG8_SB(0, 1), b2 + hstepB, voffB); PG8_STAGE(PG8_SA(0, 0), a2, voffA);
            PG8_WAIT_V(8); PG8_WAIT_L(0); PG8_BAR; PG8_MMA(1, 0, At, B0); PG8_MMA(1, 1, At, B1); PG8_BAR; PG8_SCHED;
            PG8_LDB(B0, 1, 0); PG8_LDB(B1, 1, 1); PG8_SCHED; PG8_LDA(At, 1, 0); PG8_STAGE(PG8_SA(0, 1), a2 + hstepA, voffA);
            PG8_WAIT_V(8); PG8_WAIT_L(0); PG8_BAR; PG8_MMA(0, 0, At, B0); PG8_MMA(0, 1, At, B1); PG8_BAR; PG8_SCHED;
            PG8_LDA(At, 1, 1); PG8_STAGE(PG8_SB(1, 0), b3, voffB); if constexpr (MIR) PG8_STAGE(PG8_SB(1, 1), m2 + kstep, vm); else PG8_STAGE(PG8_SB(1, 1), b3 + hstepB, voffB); PG8_STAGE(PG8_SA(1, 0), a3, voffA);
            PG8_WAIT_V(8); PG8_WAIT_L(0); PG8_BAR; PG8_MMA(1, 0, At, B0); PG8_MMA(1, 1, At, B1); PG8_BAR; PG8_SCHED;
        }
        if constexpr (ALIGN_EPI) { if (wr == 0) PG8_BAR; }
        if constexpr (F8) asm volatile("s_nop 15\n\ts_nop 15" ::: "memory");
        for (int repe = 0; repe < REP_EPI; ++repe) { const int l2 = opaque(threadIdx.x) & 63; E(acc, cur, wr, wc, l2 & 15, l2 >> 4); }
        if (!has_next) break;
#pragma unroll
        for (int a = 0; a < 2; ++a)
#pragma unroll
            for (int b = 0; b < 2; ++b)
#pragma unroll
                for (int m = 0; m < 4; ++m)
#pragma unroll
                    for (int n = 0; n < 2; ++n) acc[a][b][m][n] = (f32x4){0.f, 0.f, 0.f, 0.f};
        cur = nxt; cA = nA; cB = nB; ++ui;
        if constexpr (MIR) { cB2 = nB2; vB2c[0] = vB2n[0]; vB2c[1] = vB2n[1]; }
        if constexpr (ALIGN_EPI) { if (wr == 1) PG8_BAR; }
    }
    PG8_WAIT_V(0);
    if constexpr (!ALIGN_EPI) { if (wr == 0) PG8_BAR; }
    PG8_BAR;
#undef PG8_MKV2
#undef PG8_SA
#undef PG8_SB
#undef PG8_STAGE
#undef PG8_LDA
#undef PG8_LDB
#undef PG8_MMA
#undef PG8_V8
#undef PG8_WAIT_V
#undef PG8_WAIT_L
#undef PG8_BAR
#undef PG8_SCHED
}
}
using pg8::Unit;

struct EpiStore {
    static constexpr bool PERM = true;
    bf16_t* O; int ldc; float scale;
    __device__ __forceinline__ void operator()(const f32x4 (&acc)[2][2][4][2], const Unit& u, int wr, int wc, int fr, int fq) const {
        const int row0 = u.pm * 256 + wr * 64 + fr, col0 = u.pn * 256 + wc * 32 + 8 * fq;
#pragma unroll
        for (int ai = 0; ai < 2; ++ai)
#pragma unroll
            for (int m = 0; m < 4; ++m) { bf16_t* rowp = O + (size_t)(row0 + ai * 128 + m * 16) * ldc + col0;
#pragma unroll
                for (int bj = 0; bj < 2; ++bj) { const f32x4 v0 = acc[ai][bj][m][0] * (scale * (1.f / KREP)), v1 = acc[ai][bj][m][1] * (scale * (1.f / KREP));
                    u32x4 w; w.x = cvtpk(v0[0], v0[1]); w.y = cvtpk(v0[2], v0[3]); w.z = cvtpk(v1[0], v1[1]); w.w = cvtpk(v1[2], v1[3]);
                    *(u32x4*)(rowp + bj * 128) = w; } }
    }
};
template <bool F8OUT> struct EpiSwiglu {
    static constexpr bool PERM = true;
    unsigned char* O; int ldc; float scale;
    __device__ __forceinline__ void operator()(const f32x4 (&acc)[2][2][4][2], const Unit& u, int wr, int wc, int fr, int fq) const {
        const int row0 = u.pm * 256 + wr * 64 + fr, col0 = u.pn * 128 + wc * 32 + 8 * fq;
        const float us = F8OUT ? scale * F8_SA : scale;
        const float k1 = -scale * LOG2E * (1.f / KREP), ik2 = 1.f / (scale * us * (1.f / KREP) * (1.f / KREP));
#pragma unroll
        for (int ai = 0; ai < 2; ++ai)
#pragma unroll
            for (int m = 0; m < 4; ++m) { unsigned char* rowp = O + ((size_t)(row0 + ai * 128 + m * 16) * ldc + col0) * (F8OUT ? 1 : 2);
                float r[8];
#pragma unroll
                for (int n = 0; n < 2; ++n) { const f32x4 g = acc[ai][0][m][n], u = acc[ai][1][m][n]; const f32x4 t = g * k1;
                    f32x4 e; e[0] = __builtin_amdgcn_exp2f(t[0]); e[1] = __builtin_amdgcn_exp2f(t[1]); e[2] = __builtin_amdgcn_exp2f(t[2]); e[3] = __builtin_amdgcn_exp2f(t[3]);
                    const f32x4 d = e * ik2 + ik2;
                    f32x4 q; q[0] = __builtin_amdgcn_rcpf(d[0]); q[1] = __builtin_amdgcn_rcpf(d[1]); q[2] = __builtin_amdgcn_rcpf(d[2]); q[3] = __builtin_amdgcn_rcpf(d[3]);
                    const f32x4 o = (g * u) * q; r[n * 4 + 0] = o[0]; r[n * 4 + 1] = o[1]; r[n * 4 + 2] = o[2]; r[n * 4 + 3] = o[3]; }
                if constexpr (F8OUT) { u32x2 w; w.x = pk4_fp8(r[0], r[1], r[2], r[3]); w.y = pk4_fp8(r[4], r[5], r[6], r[7]); *(u32x2*)rowp = w; }
                else { u32x4 w; w.x = cvtpk(r[0], r[1]); w.y = cvtpk(r[2], r[3]); w.z = cvtpk(r[4], r[5]); w.w = cvtpk(r[6], r[7]); *(u32x4*)rowp = w; } }
    }
};
template <bool ODD> struct EpiRope {
    static constexpr bool PERM = false;
    unsigned char* ws;
    static constexpr int ldc = ODD ? 3072 : MIXIN, rlo = ODD ? 0 : 4, rhi = ODD ? 16 : 9, qlo = ODD ? 0 : 4, qhi = 8, f8hi = ODD ? 16 : 0;
    __device__ __forceinline__ void operator()(const f32x4 (&acc)[2][2][4][2], const Unit& u, int wr, int wc, int fr, int fq) const {
        const float ascale = ODD ? 1.f / (F8_SH * F8_SW) : 1.f, qscale = QK_C;
        bf16_t* O = (bf16_t*)(ws + WS_Z); const f32x2* cs = (const f32x2*)(ws + WS_ROPE); unsigned char* O8 = ws + WS_QK8;
        const int row0 = u.pm * 256 + wr * 64 + fr, col0 = u.pn * 256 + wc * 32 + 4 * fq;
        const bool lat = u.pm < 128;
#pragma unroll
        for (int ai = 0; ai < 2; ++ai)
#pragma unroll
            for (int m = 0; m < 4; ++m) { const int row = row0 + ai * 128 + m * 16; bf16_t* rowp = O + (size_t)row * ldc + col0;
                const int t = row & 4095, pos = (wc & 1) ? (t & 63) : (t >> 6);
                const f32x2* c4 = cs + pos * 16 + 4 * fq;
                const f32x2 c0 = c4[0], c1 = c4[1], c2 = c4[2], c3 = c4[3];
#pragma unroll
                for (int bj = 0; bj < 2; ++bj) { f32x4 p1 = acc[ai][bj][m][0] * (ascale * (1.f / KREP)), p2 = acc[ai][bj][m][1] * (ascale * (1.f / KREP));
                    const int blk = u.pn * 2 + bj;
                    if (lat && blk >= rlo && blk < rhi) {
                        const f32x4 cv = {c0.x, c1.x, c2.x, c3.x}, sv = {c0.y, c1.y, c2.y, c3.y};
                        const f32x4 o1 = p1 * cv - p2 * sv, o2 = p2 * cv + p1 * sv; p1 = o1; p2 = o2; }
                    if (blk >= qlo && blk < qhi) { p1 = p1 * qscale; p2 = p2 * qscale; }
                    if (ODD) { unsigned char* r8 = O8 + (size_t)row * 2048 + col0 + bj * 128;
                        *(unsigned*)r8 = pk4_fp8(p1[0], p1[1], p1[2], p1[3]); *(unsigned*)(r8 + 16) = pk4_fp8(p2[0], p2[1], p2[2], p2[3]); }
                    else { u32x2 w1, w2; w1.x = cvtpk(p1[0], p1[1]); w1.y = cvtpk(p1[2], p1[3]); w2.x = cvtpk(p2[0], p2[1]); w2.y = cvtpk(p2[2], p2[3]);
                        *(u32x2*)(rowp + bj * 128) = w1; *(u32x2*)(rowp + bj * 128 + 16) = w2; } } }
    }
};
struct EpiVt {
    static constexpr bool PERM = true;
    unsigned char* ws;
    __device__ __forceinline__ void operator()(const f32x4 (&acc)[2][2][4][2], const Unit& u, int wr, int wc, int fr, int fq) const {
        unsigned char* Vt = ws + WS_VT8; const float scale = 1.f / (F8_SH * F8_SW);
        const bool ctx = u.pn >= 128; const int b = ctx ? u.pn - 128 : u.pn >> 4, kt0 = ctx ? 0 : 4 + (u.pn & 15) * 4;
#pragma unroll
        for (int ai = 0; ai < 2; ++ai)
#pragma unroll
            for (int m = 0; m < 4; ++m) { const int d = wr * 64 + m * 16 + fr;
                unsigned char* tb = Vt + ((size_t)(b * 8 + u.pm * 2 + ai) * 68 + kt0) * 8192 + d * 64;
#pragma unroll
                for (int bj = 0; bj < 2; ++bj) { const int c = bj * 128 + wc * 32 + 8 * fq, s0 = c & 63;
                    const f32x4 v0 = acc[ai][bj][m][0] * (scale * (1.f / KREP)), v1 = acc[ai][bj][m][1] * (scale * (1.f / KREP));
                    u32x2 w; w.x = pk4_fp8(v0[0], v0[1], v0[2], v0[3]); w.y = pk4_fp8(v1[0], v1[1], v1[2], v1[3]);
                    *(u32x2*)(tb + (c >> 6) * 8192 + ((((s0 >> 4) ^ (d >> 2)) & 3) << 4) + (s0 & 15)) = w; } }
    }
};
struct EpiPQt {
    static constexpr bool PERM = true;
    bf16_t* Plat; bf16_t* Pctx;
    __device__ __forceinline__ void operator()(const f32x4 (&acc)[2][2][4][2], const Unit& u, int wr, int wc, int fr, int fq) const {
        const bool ctx = u.e >= 32; const int bg = ctx ? u.e - 32 : u.e;
        bf16_t* base = (ctx ? Pctx : Plat) + (size_t)bg * 128 * FP;
        if (ctx) {
            const int col0 = wc * 32 + 8 * fq;
#pragma unroll
            for (int ai = 0; ai < 2; ++ai)
#pragma unroll
                for (int m = 0; m < 4; ++m) { bf16_t* rowp = base + (size_t)(wr * 64 + m * 16 + fr) * FP + ai * CTX + col0;
#pragma unroll
                    for (int bj = 0; bj < 2; ++bj) { const f32x4 v0 = acc[ai][bj][m][0] * (1.f / KREP), v1 = acc[ai][bj][m][1] * (1.f / KREP);
                        u32x4 w; w.x = cvtpk(v0[0], v0[1]); w.y = cvtpk(v0[2], v0[3]); w.z = cvtpk(v1[0], v1[1]); w.w = cvtpk(v1[2], v1[3]); *(u32x4*)(rowp + bj * 128) = w; } }
        } else {
            const int col0 = u.pn * 128 + wc * 32 + 8 * fq;
            const bool sp = u.pn == 0 && wc == 0 && fq == 0;
#pragma unroll
            for (int m = 0; m < 4; ++m) { bf16_t* rowp = base + (size_t)(wr * 64 + m * 16 + fr) * FP + col0;
                f32x4 p0 = (acc[0][0][m][0] + acc[0][1][m][0]) * (1.f / KREP), p1 = (acc[0][0][m][1] + acc[0][1][m][1]) * (1.f / KREP);
                f32x4 q0 = (acc[1][0][m][0] - acc[1][1][m][0]) * (1.f / KREP), q1 = (acc[1][0][m][1] - acc[1][1][m][1]) * (1.f / KREP);
                if (sp) { p0[0] = acc[0][0][m][0][0] * (1.f / KREP); q0[0] = acc[0][1][m][0][0] * (1.f / KREP); }
                u32x4 w; w.x = cvtpk(p0[0], p0[1]); w.y = cvtpk(p0[2], p0[3]); w.z = cvtpk(p1[0], p1[1]); w.w = cvtpk(p1[2], p1[3]); *(u32x4*)rowp = w;
                w.x = cvtpk(q0[0], q0[1]); w.y = cvtpk(q0[2], q0[3]); w.z = cvtpk(q1[0], q1[1]); w.w = cvtpk(q1[2], q1[3]); *(u32x4*)(rowp + 2048) = w; }
        }
    }
};
struct EpiFour2 {
    static constexpr bool PERM = true;
    bf16_t* O;
    __device__ __forceinline__ void operator()(const f32x4 (&acc)[2][2][4][2], const Unit& u, int wr, int wc, int fr, int fq) const {
        EpiStore s{O, DM, (u.pm < 128 ? 0.0013810679320049757f   : 0.005524271728019903f  )};
        s(acc, u, wr, wc, fr, fq);
    }
};

struct SchedDense {
    static constexpr bool MIRROR = false;
    const char* A; const char* B; int nM, nN, nwg, G, c, nkt; size_t tA, tB;
    __device__ __forceinline__ void init(const void* A_, int lda, const void* B_, int ldb, int M, int N, int K, int G_, int c_) {
        A = (const char*)A_; B = (const char*)B_; nM = M / 256; nN = N / 256; nwg = nM * nN; G = G_; c = c_; nkt = K / 64; tA = (size_t)256 * lda * 2; tB = (size_t)256 * ldb * 2; }
    __device__ __forceinline__ bool next(int i, Unit& u) const {
        const long L = (long)i * G + c; if (L >= nwg) return false;
        const int wgid = pg8::xcd_remap((int)L, nwg);
        const int nig = pg8::WGM * nN, gid = wgid / nig, fm = gid * pg8::WGM, gsz = (nM - fm) < pg8::WGM ? (nM - fm) : pg8::WGM;
        u.pm = fm + ((wgid % nig) % gsz); u.pn = (wgid % nig) / gsz; u.e = 0; u.nkt = nkt; return true;
    }
    __device__ __forceinline__ const char* aptr(const Unit& u) const { return A + (size_t)u.pm * tA; }
    __device__ __forceinline__ const char* bptr(const Unit& u) const { return B + (size_t)u.pn * tB; }
};
struct SchedGroup {
    static constexpr bool MIRROR = false;
    const char* A; const char* B; int P1, P2, P3, P4, P5, P6, P7, nRT, nN, nwg, G, c, nkt; size_t tA, tB, gB, aE;
    __device__ __forceinline__ bool next(int i, Unit& u) const {
        const long L = (long)i * G + c; if (L >= nwg) return false;
        const int wgid = pg8::xcd_remap((int)L, nwg);
        const int nig = pg8::WGM * nN, gid = wgid / nig, fm = gid * pg8::WGM, gsz = (nRT - fm) < pg8::WGM ? (nRT - fm) : pg8::WGM;
        const int rt = fm + ((wgid % nig) % gsz);
        u.pm = rt; u.pn = (wgid % nig) / gsz; u.nkt = nkt;
        u.e = (rt >= P1) + (rt >= P2) + (rt >= P3) + (rt >= P4) + (rt >= P5) + (rt >= P6) + (rt >= P7); return true;
    }
    __device__ __forceinline__ const char* aptr(const Unit& u) const {
        if (aE == 0) return A + (size_t)u.pm * tA;
        const int pe = u.e == 0 ? 0 : u.e == 1 ? P1 : u.e == 2 ? P2 : u.e == 3 ? P3 : u.e == 4 ? P4 : u.e == 5 ? P5 : u.e == 6 ? P6 : P7;
        return A + (size_t)u.e * aE + (size_t)(u.pm - pe) * tA; }
    __device__ __forceinline__ const char* bptr(const Unit& u) const { return B + (size_t)u.e * gB + (size_t)u.pn * tB; }
};
struct SchedF1 {
    static constexpr bool MIRROR = true;
    const char* Wp; const char* Z; int G, c;
    __device__ __forceinline__ bool next(int i, Unit& u) const {
        const int L = i * G + c; if (L >= 544) return false;
        u.pm = 0; u.nkt = 2;
        if (L < 512) { u.e = L >> 4; u.pn = L & 15; } else { u.e = 32 + (L - 512); u.pn = 0; }
        return true;
    }
    __device__ __forceinline__ const char* aptr(const Unit&) const { return Wp; }
    __device__ __forceinline__ const char* bptr(const Unit& u) const {
        const bool ctx = u.e >= 32; const int bg = ctx ? u.e - 32 : u.e, b = bg >> 2, gq = bg & 3;
        const size_t row0 = ctx ? (size_t)RL + b * CTX : (size_t)b * SEQ + u.pn * 128;
        return Z + (row0 * MIXIN + gq * 128) * 2; }
    __device__ __forceinline__ const char* bptr2(const Unit& u) const {
        const bool ctx = u.e >= 32; const int bg = ctx ? u.e - 32 : u.e, b = bg >> 2, gq = bg & 3;
        const size_t row0 = ctx ? (size_t)RL + b * CTX + 128 : (size_t)b * SEQ;
        return Z + (row0 * MIXIN + gq * 128) * 2; }
    __device__ __forceinline__ unsigned voff2(const Unit& u, int R, int C, int ldb) const {
        const int tok = u.e >= 32 ? R : (u.pn == 0 && R == 0) ? 2048 : 4096 - 128 * u.pn - R;
        return (unsigned)(tok * ldb + C) * 2u; }
};
struct SchedF2 {
    static constexpr bool MIRROR = false;
    const char* CSl; const char* CSc; const char* Plat; const char* Pctx; int G, vcu;
    static constexpr size_t EB = 2;
    __device__ __forceinline__ bool next(int i, Unit& u) const {
        const int L = i * G + vcu; if (L >= 272) return false;
        if (L < 256) { const int b = L >> 5, mt = (L & 31) >> 1; u.pm = b * 16 + mt; u.pn = L & 1; u.e = b; u.nkt = 64; }
        else { const int b = (L - 256) >> 1; u.pm = 128 + b; u.pn = L & 1; u.e = 8 + b; u.nkt = 8; }
        return true;
    }
    __device__ __forceinline__ const char* aptr(const Unit& u) const { return u.e < 8 ? CSl + (size_t)(u.pm & 15) * 256 * FP * EB : CSc; }
    __device__ __forceinline__ const char* bptr(const Unit& u) const { return (u.e < 8 ? Plat + (size_t)u.e * 512 * FP * EB : Pctx + (size_t)(u.e - 8) * 512 * FP * EB) + (size_t)u.pn * 256 * FP * EB; }
};

#define XB_TMO      128
#define XB_XCNT(j)  (256  + 64 * (j))
#define XB_XSUB(j)  (1280 + 64 * (j))
#define XB_XGEN(j)  (2304 + 64 * (j))
#define XB_TOP      3328
#define XB_TOPGEN   3392
#define XCD_BAR_WORDS 3456
#define XB_SPIN_CAP (1u << 21)
__device__ __forceinline__ unsigned xb_ld(unsigned* p)              { return __hip_atomic_load(p, __ATOMIC_RELAXED, __HIP_MEMORY_SCOPE_AGENT); }
__device__ __forceinline__ unsigned xb_add(unsigned* p, unsigned v) { return __hip_atomic_fetch_add(p, v, __ATOMIC_RELAXED, __HIP_MEMORY_SCOPE_AGENT); }
__device__ __forceinline__ unsigned xb_xcc_id() { return (unsigned)__builtin_amdgcn_s_getreg((3 << 11) | 20) & 0xFu; }
#define XB_SPIN(cond, bar) do { unsigned _sp = 0; while (cond) { __builtin_amdgcn_s_sleep(1); \
    if ((++_sp & 255u) == 0u) { if (xb_ld(&(bar)[XB_TMO])) break; if (_sp > XB_SPIN_CAP) { atomicAdd(&(bar)[XB_TMO], 1u); break; } } } } while (0)
struct XcdBarrier { unsigned* bar; unsigned x; volatile LAS unsigned* st; };
__device__ __forceinline__ XcdBarrier xcd_barrier_post(unsigned* bar, volatile LAS unsigned* st) {
    XcdBarrier b; b.bar = bar; b.x = xb_xcc_id(); b.st = st;
    if (threadIdx.x == 0) (void)xb_add(&bar[XB_XCNT(b.x)], 1u);
    return b;
}
__device__ __forceinline__ void xcd_barrier_complete(unsigned* bar, unsigned x, unsigned& nloc, unsigned& nx) {
    const unsigned G = gridDim.x * gridDim.y * gridDim.z;
    unsigned sum, cnt, mine, sp = 0u;
    for (;;) {
        sum = 0u; cnt = 0u; mine = 0u;
#pragma unroll
        for (unsigned j = 0; j < 16; ++j) { const unsigned c = xb_ld(&bar[XB_XCNT(j)]); sum += c; cnt += (c > 0u) ? 1u : 0u; mine = (j == x) ? c : mine; }
        if (sum == G) break;
        __builtin_amdgcn_s_sleep(1);
        if ((++sp & 255u) == 0u) { if (xb_ld(&bar[XB_TMO])) break; if (sp > XB_SPIN_CAP) { atomicAdd(&bar[XB_TMO], 1u); break; } }
    }
    nloc = mine > 0u ? mine : 1u; nx = cnt > 0u ? cnt : 1u;
}
__device__ __forceinline__ void xcd_barrier(const XcdBarrier& b) {
    asm volatile("s_waitcnt vmcnt(0)" ::: "memory");
    __syncthreads();
    if (threadIdx.x == 0) {
        unsigned* bar = (unsigned*)uptr((const char*)b.bar);
        __builtin_amdgcn_s_waitcnt(0);
        unsigned nloc = b.st[0], nx = b.st[1];
        if (nloc == 0u) { xcd_barrier_complete(bar, b.x, nloc, nx); b.st[0] = nloc; b.st[1] = nx; }
        const unsigned old = xb_add(&bar[XB_XSUB(b.x)], 1u);
        const unsigned gen = old / nloc;
        if (old + 1u == (gen + 1u) * nloc) {
            __builtin_amdgcn_fence(__ATOMIC_RELEASE, "agent");
            asm volatile("s_waitcnt vmcnt(0)" ::: "memory");
            const unsigned og = xb_add(&bar[XB_TOP], 1u);
            const unsigned tg = og / nx;
            if (og + 1u == (tg + 1u) * nx) xb_add(&bar[XB_TOPGEN], 1u);
            else XB_SPIN(xb_ld(&bar[XB_TOPGEN]) == tg, bar);
            __builtin_amdgcn_fence(__ATOMIC_ACQUIRE, "agent");
            xb_add(&bar[XB_XGEN(b.x)], 1u);
            asm volatile("s_waitcnt vmcnt(0)" ::: "memory");
        } else {
            XB_SPIN(xb_ld(&bar[XB_XGEN(b.x)]) == gen, bar);
            __builtin_amdgcn_fence(__ATOMIC_ACQUIRE, "agent");
            asm volatile("s_waitcnt vmcnt(0)" ::: "memory");
        }
    }
    __syncthreads();
}

__device__ __forceinline__ int crow(int r, int hi) { return (r & 3) + 8 * (r >> 2) + 4 * hi; }
template <int KW> __device__ __forceinline__ int kswz(int row, int colB) { return KW == 128 ? row * 256 + (colB ^ ((row & 7) << 4)) : row * 128 + (colB ^ (((row >> 1) & 7) << 4)); }
template <int DV> __device__ __forceinline__ int v_st(int k, int c) { const int kk = (k & ~0xC) | ((k & 4) << 1) | ((k & 8) >> 1); return ((kk >> 3) * (DV / 32) + (c >> 5)) * 512 + ((kk & 7) * 32 + (c & 31)) * 2; }
__device__ __forceinline__ int v_rd_base(int lane) { return ((lane & 3) << 3) | (((lane >> 2) & 3) << 6) | (((lane >> 4) & 1) << 5) | (((lane >> 5) & 1) << 8); }
template <int OFF> __device__ __forceinline__ s16x4 tr_read(int vb) { s16x4 r; asm volatile("ds_read_b64_tr_b16 %0, %1 offset:%2" : "=&v"(r) : "v"(vb), "i"(OFF) : "memory"); return r; }
template <int DV, int D0> __device__ __forceinline__ void pv_one(f32x16& od, int vb, bf16x8 pa0, bf16x8 pa1, bf16x8 pa2, bf16x8 pa3) {
    constexpr int KS = (DV / 32) * 1024, HF = (DV / 32) * 512;
    const s16x4 l0 = tr_read<D0 * 512 + 0 * KS>(vb), h0 = tr_read<D0 * 512 + 0 * KS + HF>(vb), l1 = tr_read<D0 * 512 + 1 * KS>(vb), h1 = tr_read<D0 * 512 + 1 * KS + HF>(vb);
    const s16x4 l2 = tr_read<D0 * 512 + 2 * KS>(vb), h2 = tr_read<D0 * 512 + 2 * KS + HF>(vb), l3 = tr_read<D0 * 512 + 3 * KS>(vb), h3 = tr_read<D0 * 512 + 3 * KS + HF>(vb);
    asm volatile("s_waitcnt lgkmcnt(0)" ::: "memory"); SBAR();
#define PKV(L, H) (bf16x8){L[0], L[1], L[2], L[3], H[0], H[1], H[2], H[3]}
    od = __builtin_amdgcn_mfma_f32_32x32x16_bf16(pa0, PKV(l0, h0), od, 0, 0, 0);
    od = __builtin_amdgcn_mfma_f32_32x32x16_bf16(pa1, PKV(l1, h1), od, 0, 0, 0);
    od = __builtin_amdgcn_mfma_f32_32x32x16_bf16(pa2, PKV(l2, h2), od, 0, 0, 0);
    od = __builtin_amdgcn_mfma_f32_32x32x16_bf16(pa3, PKV(l3, h3), od, 0, 0, 0);
#undef PKV
}
#define PV_RD(D0, L, H) do { L[0] = tr_read<(D0) * 512 + 0 * KS>(vb); H[0] = tr_read<(D0) * 512 + 0 * KS + HF>(vb); L[1] = tr_read<(D0) * 512 + 1 * KS>(vb); H[1] = tr_read<(D0) * 512 + 1 * KS + HF>(vb); \
    L[2] = tr_read<(D0) * 512 + 2 * KS>(vb); H[2] = tr_read<(D0) * 512 + 2 * KS + HF>(vb); L[3] = tr_read<(D0) * 512 + 3 * KS>(vb); H[3] = tr_read<(D0) * 512 + 3 * KS + HF>(vb); } while (0)
#define PV_MM(od, L, H) do { od = __builtin_amdgcn_mfma_f32_32x32x16_bf16(pa0, PKV(L[0], H[0]), od, 0, 0, 0); od = __builtin_amdgcn_mfma_f32_32x32x16_bf16(pa1, PKV(L[1], H[1]), od, 0, 0, 0); \
    od = __builtin_amdgcn_mfma_f32_32x32x16_bf16(pa2, PKV(L[2], H[2]), od, 0, 0, 0); od = __builtin_amdgcn_mfma_f32_32x32x16_bf16(pa3, PKV(L[3], H[3]), od, 0, 0, 0); } while (0)
#define PKV(L, H) (bf16x8){L[0], L[1], L[2], L[3], H[0], H[1], H[2], H[3]}
template <int DV> __device__ __forceinline__ void pv_all(f32x16* o, int vb, bf16x8 pa0, bf16x8 pa1, bf16x8 pa2, bf16x8 pa3) {
    constexpr int KS = (DV / 32) * 1024, HF = (DV / 32) * 512;
    s16x4 la[4], ha[4], lb[4], hb[4];
    PV_RD(0, la, ha);
    PV_RD(1, lb, hb); asm volatile("s_waitcnt lgkmcnt(8)" ::: "memory"); SBAR(); PV_MM(o[0], la, ha);
    if constexpr (DV == 128) {
        PV_RD(2, la, ha); asm volatile("s_waitcnt lgkmcnt(8)" ::: "memory"); SBAR(); PV_MM(o[1], lb, hb);
        PV_RD(3, lb, hb); asm volatile("s_waitcnt lgkmcnt(8)" ::: "memory"); SBAR(); PV_MM(o[2], la, ha);
        asm volatile("s_waitcnt lgkmcnt(0)" ::: "memory"); SBAR(); PV_MM(o[3], lb, hb);
    } else {
        asm volatile("s_waitcnt lgkmcnt(0)" ::: "memory"); SBAR(); PV_MM(o[1], lb, hb);
    }
}
#undef PV_RD
#undef PV_MM
#undef PKV
template <int KW> __device__ __forceinline__ void qkt64(f32x16& p0, f32x16& p1, const char* Ks, const bf16x8* qr, int kcb, int r32, int hi) {
    bf16x8 kb0[4], kb1[4];
#pragma unroll
    for (int d0 = 0; d0 < 4; ++d0) { const int cb = kcb + (d0 * 16 + hi * 8) * 2;
        kb0[d0] = *reinterpret_cast<const bf16x8*>(Ks + kswz<KW>(r32, cb));
        kb1[d0] = *reinterpret_cast<const bf16x8*>(Ks + kswz<KW>(32 + r32, cb)); }
    p0 = f32x16{}; p1 = f32x16{};
#pragma unroll
    for (int d0 = 0; d0 < 4; ++d0) {
        p0 = __builtin_amdgcn_mfma_f32_32x32x16_bf16(kb0[d0], qr[d0], p0, 0, 0, 0);
        p1 = __builtin_amdgcn_mfma_f32_32x32x16_bf16(kb1[d0], qr[d0], p1, 0, 0, 0); }
}
__device__ __forceinline__ void qkt64_f8(f32x16& p0, f32x16& p1, const char* Ks, v8i_t qf, int g0, int r32, const f32x16& cinit) {
    const int sw = r32 & 7; const char* kr = Ks + r32 * 128;
    const u32x4 a0 = *reinterpret_cast<const u32x4*>(kr + ((g0 ^ sw) << 4)), a1 = *reinterpret_cast<const u32x4*>(kr + (((g0 + 1) ^ sw) << 4));
    const u32x4 b0 = *reinterpret_cast<const u32x4*>(kr + 4096 + ((g0 ^ sw) << 4)), b1 = *reinterpret_cast<const u32x4*>(kr + 4096 + (((g0 + 1) ^ sw) << 4));
    const v8i_t A0 = {(int)a0.x, (int)a0.y, (int)a0.z, (int)a0.w, (int)a1.x, (int)a1.y, (int)a1.z, (int)a1.w}, A1 = {(int)b0.x, (int)b0.y, (int)b0.z, (int)b0.w, (int)b1.x, (int)b1.y, (int)b1.z, (int)b1.w};
    p0 = __builtin_amdgcn_mfma_scale_f32_32x32x64_f8f6f4(A0, qf, cinit, 0, 0, 0, 0, 0, 0);
    p1 = __builtin_amdgcn_mfma_scale_f32_32x32x64_f8f6f4(A1, qf, cinit, 0, 0, 0, 0, 0, 0);
}
template <int KW> __device__ __forceinline__ void qkt64n(f32x16& p0, f32x16& p1, const char* Ks, const bf16x8* qr, int kcb, int r32, int hi, const f32x16& cinit) {
#pragma unroll
    for (int d0 = 0; d0 < 4; ++d0) { const int cb = kcb + (d0 * 16 + hi * 8) * 2;
        const bf16x8 b0 = *reinterpret_cast<const bf16x8*>(Ks + kswz<KW>(r32, cb));
        const bf16x8 b1 = *reinterpret_cast<const bf16x8*>(Ks + kswz<KW>(32 + r32, cb));
        if (d0 == 0) { p0 = __builtin_amdgcn_mfma_f32_32x32x16_bf16(b0, qr[0], cinit, 0, 0, 0); p1 = __builtin_amdgcn_mfma_f32_32x32x16_bf16(b1, qr[0], cinit, 0, 0, 0); }
        else { p0 = __builtin_amdgcn_mfma_f32_32x32x16_bf16(b0, qr[d0], p0, 0, 0, 0); p1 = __builtin_amdgcn_mfma_f32_32x32x16_bf16(b1, qr[d0], p1, 0, 0, 0); } }
}
template <int ND> __device__ __forceinline__ void softmax_step(f32x16& p0, f32x16& p1, float& m_reg, float& l_reg, f32x16* o, float* al_l, int r32, int hi,
                                                              bf16x8& pa0, bf16x8& pa1, bf16x8& pa2, bf16x8& pa3) {
    float pmax = p0[0];
#pragma unroll
    for (int r = 1; r < 16; ++r) pmax = fmaxf(pmax, p0[r]);
#pragma unroll
    for (int r = 0; r < 16; ++r) pmax = fmaxf(pmax, p1[r]);
    { auto rr = __builtin_amdgcn_permlane32_swap(__float_as_uint(pmax), __float_as_uint(pmax), false, false); pmax = fmaxf(__uint_as_float(rr[0]), __uint_as_float(rr[1])); }
    const float mn = fmaxf(m_reg, pmax);
    const float alpha = __builtin_amdgcn_exp2f((m_reg - mn) * QK_C); m_reg = mn;
    const float mnC = -mn * QK_C;
#pragma unroll
    for (int r = 0; r < 16; ++r) { p0[r] = __builtin_amdgcn_exp2f(fmaf(p0[r], QK_C, mnC)); p1[r] = __builtin_amdgcn_exp2f(fmaf(p1[r], QK_C, mnC)); }
    float ps = 0.f;
#pragma unroll
    for (int r = 0; r < 16; ++r) ps += p0[r] + p1[r];
    { auto rr = __builtin_amdgcn_permlane32_swap(__float_as_uint(ps), __float_as_uint(ps), false, false); ps = __uint_as_float(rr[0]) + __uint_as_float(rr[1]); }
    l_reg = l_reg * alpha + ps;
    if (__any(alpha < 1.f)) { if (hi == 0) al_l[r32] = alpha; LDS_WAIT();
#pragma unroll
        for (int d = 0; d < ND; ++d)
#pragma unroll
            for (int r = 0; r < 16; ++r) o[d][r] *= al_l[crow(r, hi)];
    }
#define PK4(P, BASE, OUT) do { unsigned a0 = cvtpk(P[BASE + 0], P[BASE + 1]), a1 = cvtpk(P[BASE + 2], P[BASE + 3]);   \
    unsigned b0 = cvtpk(P[BASE + 4], P[BASE + 5]), b1 = cvtpk(P[BASE + 6], P[BASE + 7]);                              \
    auto r0 = __builtin_amdgcn_permlane32_swap(a0, b0, false, false); auto r1 = __builtin_amdgcn_permlane32_swap(a1, b1, false, false); \
    u32x4 w = {r0[0], r1[0], r0[1], r1[1]}; OUT = *reinterpret_cast<bf16x8*>(&w); } while (0)
    PK4(p0, 0, pa0); PK4(p0, 8, pa1); PK4(p1, 0, pa2); PK4(p1, 8, pa3);
#undef PK4
}

constexpr int AT_K = 0, AT_V = 16384, AT_WS = 32768, AT_XCH = 36864;

__device__ __forceinline__ void win_attn_unit(char* lds, const bf16_t* Z, bf16_t* Y, const float* sink, int b, int kvh, int qc, bool ctxq) {
    const int tid = opaque(threadIdx.x), wid = __builtin_amdgcn_readfirstlane(tid >> 6), lane = tid & 63, r32 = lane & 31, hi = lane >> 5;
    const int head = kvh * 4 + (wid >> 1), qsub = wid & 1;
    const int q0 = qc * 64;
    const size_t qrow0 = (ctxq ? (size_t)RL + b * CTX : (size_t)b * SEQ) + q0 + qsub * 32;
    float* wsf = (float*)(lds + AT_WS) + wid * 128; float* al_l = wsf; float* li_l = wsf + 32;
    bf16x8 qr[4];
    { const bf16_t* qp = Z + (qrow0 + r32) * MIXIN + 512 + head * 64 + hi * 8;
#pragma unroll
      for (int d0 = 0; d0 < 4; ++d0) qr[d0] = *reinterpret_cast<const bf16x8*>(qp + d0 * 16); }
    float m_reg = -1e30f, l_reg = 0.f; f32x16 o[2] = {};
    const int srow = tid >> 3, scol = (tid & 7) * 8;
    const int vb = (int)(uintptr_t)(lds + AT_V) + v_rd_base(lane);
    const int qrel = qsub * 32 + r32;
    const int NT = ctxq ? 4 : 9;
    for (int t = 0; t < NT; ++t) {
        size_t krow; int mode = 0;
        if (t < 4) krow = (size_t)RL + b * CTX + t * 64;
        else { const int p0 = q0 - 128 + (t - 4) * 64; if (p0 < 0 || p0 >= SEQ) continue; krow = (size_t)b * SEQ + p0; mode = (t == 4) ? 1 : (t == 8) ? 2 : 0; }
        __syncthreads();
        { const bf16_t* kp = Z + (krow + srow) * MIXIN + 1024 + kvh * 64 + scol;
          const bf16x8 kv = *reinterpret_cast<const bf16x8*>(kp), vv = *reinterpret_cast<const bf16x8*>(kp + 128);
          *reinterpret_cast<bf16x8*>(lds + AT_K + kswz<64>(srow, scol * 2)) = kv;
          *reinterpret_cast<bf16x8*>(lds + AT_V + v_st<64>(srow, scol)) = vv; }
        __syncthreads();
        f32x16 p0, p1; qkt64<64>(p0, p1, lds + AT_K, qr, 0, r32, hi);
        if (mode == 1) {
#pragma unroll
            for (int r = 0; r < 16; ++r) { const int kk = crow(r, hi); if (kk < qrel) p0[r] = -1e30f; if (kk + 32 < qrel) p1[r] = -1e30f; } }
        else if (mode == 2) {
#pragma unroll
            for (int r = 0; r < 16; ++r) { const int kk = crow(r, hi); if (kk > qrel) p0[r] = -1e30f; if (kk + 32 > qrel) p1[r] = -1e30f; } }
        bf16x8 pa0, pa1, pa2, pa3;
        softmax_step<2>(p0, p1, m_reg, l_reg, o, al_l, r32, hi, pa0, pa1, pa2, pa3);
        pv_one<64, 0>(o[0], vb, pa0, pa1, pa2, pa3); pv_one<64, 1>(o[1], vb, pa0, pa1, pa2, pa3);
    }
    l_reg += __builtin_amdgcn_exp2f(sink[head] * LOG2E - m_reg * QK_C);
    if (hi == 0) li_l[r32] = l_reg; LDS_WAIT();
    bf16_t* yp = Y + qrow0 * DM + 512 + head * 64;
#pragma unroll
    for (int r = 0; r < 16; ++r) { const int orow = crow(r, hi); const float rl = __builtin_amdgcn_rcpf(li_l[orow]);
#pragma unroll
        for (int d0 = 0; d0 < 2; ++d0) { const unsigned w = cvtpk(o[d0][r] * rl, 0.f); yp[(size_t)orow * DM + d0 * 32 + r32] = (bf16_t)(w & 0xffffu); } }
}

constexpr float DA_THR = 8.f;
constexpr float DA_THRL = DA_THR * LOG2E;
template <bool FIRST> __device__ __forceinline__ void da_partialSM(f32x16& p0, f32x16& p1, float& mhat, f32x16& negm, float& alpha) {
    float pmax = fmaxf(p0[0], p0[1]), pmb = fmaxf(p1[0], p1[1]);
#pragma unroll
    for (int r = 2; r < 16; r += 2) { pmax = fmaxf(fmaxf(pmax, p0[r]), p0[r + 1]); pmb = fmaxf(fmaxf(pmb, p1[r]), p1[r + 1]); }
    pmax = fmaxf(pmax, pmb);
    { auto rr = __builtin_amdgcn_permlane32_swap(__float_as_uint(pmax), __float_as_uint(pmax), false, false); pmax = fmaxf(__uint_as_float(rr[0]), __uint_as_float(rr[1])); }
    alpha = 1.f;
    if (FIRST || !__builtin_expect(__all(pmax <= DA_THRL), 1)) {
        const float dl = FIRST ? pmax : fmaxf(pmax, 0.f);
        mhat += dl; alpha = __builtin_amdgcn_exp2f(-dl);
#pragma unroll
        for (int r = 0; r < 16; ++r) { p0[r] -= dl; p1[r] -= dl; negm[r] = -mhat; }
    }
#pragma unroll
    for (int r = 0; r < 16; ++r) p0[r] = __builtin_amdgcn_exp2f(p0[r]);
}
__device__ __forceinline__ void da_finishSM(f32x16& p0, f32x16& p1, float alpha, float& l_reg, bf16x8& pa0, bf16x8& pa1, bf16x8& pa2, bf16x8& pa3) {
#pragma unroll
    for (int r = 0; r < 16; ++r) p1[r] = __builtin_amdgcn_exp2f(p1[r]);
    float s0 = p0[0], s1 = p0[1], s2 = p0[2], s3 = p0[3];
#pragma unroll
    for (int r = 4; r < 16; r += 4) { s0 += p0[r]; s1 += p0[r + 1]; s2 += p0[r + 2]; s3 += p0[r + 3]; }
#pragma unroll
    for (int r = 0; r < 16; r += 4) { s0 += p1[r]; s1 += p1[r + 1]; s2 += p1[r + 2]; s3 += p1[r + 3]; }
    float ps = (s0 + s1) + (s2 + s3);
    { auto rr = __builtin_amdgcn_permlane32_swap(__float_as_uint(ps), __float_as_uint(ps), false, false); ps = __uint_as_float(rr[0]) + __uint_as_float(rr[1]); }
    l_reg = l_reg * alpha + ps;
#define PK4(P, BASE, OUT) do { unsigned a0 = cvtpk(P[BASE + 0], P[BASE + 1]), a1 = cvtpk(P[BASE + 2], P[BASE + 3]);   \
    unsigned b0 = cvtpk(P[BASE + 4], P[BASE + 5]), b1 = cvtpk(P[BASE + 6], P[BASE + 7]);                              \
    auto r0 = __builtin_amdgcn_permlane32_swap(a0, b0, false, false); auto r1 = __builtin_amdgcn_permlane32_swap(a1, b1, false, false); \
    u32x4 w = {r0[0], r1[0], r0[1], r1[1]}; OUT = *reinterpret_cast<bf16x8*>(&w); } while (0)
    PK4(p0, 0, pa0); PK4(p0, 8, pa1); PK4(p1, 0, pa2); PK4(p1, 8, pa3);
#undef PK4
}
constexpr float DA8_OFF = 5.f, DA8_THRL = 3.f;
template <bool FIRST> __device__ __forceinline__ void da8_partialSM(f32x16& p0, f32x16& p1, float& mhat, f32x16& negm, float& alpha) {
    float pmax = fmaxf(p0[0], p0[1]), pmb = fmaxf(p1[0], p1[1]);
#pragma unroll
    for (int r = 2; r < 16; r += 2) { pmax = fmaxf(fmaxf(pmax, p0[r]), p0[r + 1]); pmb = fmaxf(fmaxf(pmb, p1[r]), p1[r + 1]); }
    pmax = fmaxf(pmax, pmb);
    { auto rr = __builtin_amdgcn_permlane32_swap(__float_as_uint(pmax), __float_as_uint(pmax), false, false); pmax = fmaxf(__uint_as_float(rr[0]), __uint_as_float(rr[1])); }
    alpha = 1.f;
    if (FIRST || !__builtin_expect(__all(pmax <= DA8_OFF + DA8_THRL), 1)) {
        const float dl = FIRST ? pmax - DA8_OFF : fmaxf(pmax - DA8_OFF, 0.f);
        mhat += dl; alpha = __builtin_amdgcn_exp2f(-dl);
#pragma unroll
        for (int r = 0; r < 16; ++r) { p0[r] -= dl; p1[r] -= dl; negm[r] = DA8_OFF - mhat; }
    }
#pragma unroll
    for (int r = 0; r < 16; ++r) p0[r] = __builtin_amdgcn_exp2f(p0[r]);
}
__device__ __forceinline__ void da8_finishSM(f32x16& p0, f32x16& p1, v8i_t& P8) {
#pragma unroll
    for (int r = 0; r < 16; ++r) p1[r] = __builtin_amdgcn_exp2f(p1[r]);
#pragma unroll
    for (int w = 0; w < 4; ++w) { int a = __builtin_amdgcn_cvt_pk_fp8_f32(p0[4 * w], p0[4 * w + 1], 0, false); a = __builtin_amdgcn_cvt_pk_fp8_f32(p0[4 * w + 2], p0[4 * w + 3], a, true); P8[w] = a;
        int c = __builtin_amdgcn_cvt_pk_fp8_f32(p1[4 * w], p1[4 * w + 1], 0, false); c = __builtin_amdgcn_cvt_pk_fp8_f32(p1[4 * w + 2], p1[4 * w + 3], c, true); P8[4 + w] = c; }
}
__device__ __forceinline__ void da8_pv(f32x16* o, const char* Vs, int r32, int hi, v8i_t P8) {
    const int sw = (r32 >> 2) & 3; const char* vr = Vs + r32 * 64; const int o0 = ((hi * 2) ^ sw) << 4, o1 = ((hi * 2 + 1) ^ sw) << 4;
    u32x4 x0[4], x1[4];
#pragma unroll
    for (int db = 0; db < 4; ++db) { x0[db] = *reinterpret_cast<const u32x4*>(vr + db * 2048 + o0); x1[db] = *reinterpret_cast<const u32x4*>(vr + db * 2048 + o1); }
#pragma unroll
    for (int db = 0; db < 4; ++db) { const v8i_t B = {(int)x0[db].x, (int)x0[db].y, (int)x0[db].z, (int)x0[db].w, (int)x1[db].x, (int)x1[db].y, (int)x1[db].z, (int)x1[db].w};
        o[db] = __builtin_amdgcn_mfma_scale_f32_32x32x64_f8f6f4(P8, B, o[db], 0, 0, 0, 0, 0, 0); }
    const v8i_t ones = {0x38383838, 0x38383838, 0x38383838, 0x38383838, 0x38383838, 0x38383838, 0x38383838, 0x38383838};
    o[4] = __builtin_amdgcn_mfma_scale_f32_32x32x64_f8f6f4(P8, ones, o[4], 0, 0, 0, 0, 0, 0);
}
__device__ __forceinline__ void da_pv(f32x16* o, int vb, bf16x8 pa0, bf16x8 pa1, bf16x8 pa2, bf16x8 pa3) {
    pv_all<128>(o, vb, pa0, pa1, pa2, pa3);
}
constexpr int DA_V = 0, DA_K = 49152, DA_WS = 81920, DA_XCH = 0;
__device__ __forceinline__ void diff_attn_unit(char* lds, const unsigned char* VT8, const unsigned char* QK8, bf16_t* O, const float* subg, float lam, float oscale, int b, int h, int qb, bool ctxq) {
    const int tid = opaque(threadIdx.x), wid = __builtin_amdgcn_readfirstlane(tid >> 6), lane = tid & 63, r32 = lane & 31, hi = lane >> 5;
    const int comp = wid >> 2, qsub = wid & 3;
    const size_t qrow0 = (ctxq ? (size_t)RL + b * CTX : (size_t)b * SEQ) + qb * 128 + qsub * 32;
    char* V_lds = lds + DA_V; char* K_lds = lds + DA_K;
    float* wsf = (float*)(lds + DA_WS) + wid * 128; float* al_l = wsf; float* li_l = wsf + 32;
    __syncthreads();
    v8i_t qf;
    { const unsigned char* qp = QK8 + (qrow0 + r32) * 2048 + (2 * h + comp) * 64 + hi * 32;
      const u32x4 q0 = *reinterpret_cast<const u32x4*>(qp), q1 = *reinterpret_cast<const u32x4*>(qp + 16);
      qf = (v8i_t){(int)q0.x, (int)q0.y, (int)q0.z, (int)q0.w, (int)q1.x, (int)q1.y, (int)q1.z, (int)q1.w}; }
    float m_reg = 0.f; f32x16 o[5] = {}; f32x16 negm;
#pragma unroll
    for (int r = 0; r < 16; ++r) negm[r] = DA8_OFF;
    const int kkey = tid >> 3, krow = ((kkey >> 4) & 1) * 32 + (kkey & 3) + 8 * ((kkey & 15) >> 2) + 4 * (kkey >> 5), kst = krow * 128 + ((((tid & 7) ^ (krow & 7))) << 4);
    const unsigned char* kp8 = QK8 + (size_t)kkey * 2048 + 1024 + h * 128 + (tid & 7) * 16;
    const int kg0 = comp * 4 + hi * 2;
    const unsigned char* vt8 = VT8 + (size_t)(b * 8 + h) * 68 * 8192 + tid * 16;
    const size_t rowc = (size_t)RL + b * CTX, rowl = (size_t)b * SEQ;
    const int NT = ctxq ? 4 : 68;
    u32x4 ks, vs;
#define KROW(t) ((t) < 4 ? rowc + (size_t)(t) * 64 : rowl + (size_t)((t) - 4) * 64)
#define LOADK(t) do { ks = *reinterpret_cast<const u32x4*>(kp8 + KROW(t) * 2048); } while (0)
#define LOADV(t) do { vs = *reinterpret_cast<const u32x4*>(vt8 + (size_t)(t) * 8192); } while (0)
#define WRITEK(bf) do { *reinterpret_cast<u32x4*>(K_lds + (bf) * 8192 + kst) = ks; } while (0)
#define WRITEV(bf) do { *reinterpret_cast<u32x4*>(V_lds + (bf) * 8192 + tid * 16) = vs; } while (0)
#define RESC(a) do { if (__any((a) < 1.f)) { if (hi == 0) al_l[r32] = (a); LDS_WAIT(); \
    _Pragma("unroll") for (int d = 0; d < 5; ++d) _Pragma("unroll") for (int r = 0; r < 16; ++r) o[d][r] *= al_l[crow(r, hi)]; } } while (0)
#define QKT(P0, P1, kb) do { qkt64_f8(P0, P1, K_lds + (kb) * 8192, qf, kg0, r32, negm); } while (0)
#define FIN(P0, P1, al) do { da8_finishSM(P0, P1, P8); } while (0)
#define PVT(vi) da8_pv(o, V_lds + (vi) * 8192, r32, hi, P8)
    f32x16 pA0, pA1, pB0, pB1; float alA = 1.f, alB = 1.f; v8i_t P8;
    int vm2 = 1, vm1 = 2, vc = 0;
#define VROT() do { const int t_ = vm2; vm2 = vm1; vm1 = vc; vc = t_; } while (0)
    const bool grpB = comp != 0;
    LOADK(0); VM_WAIT(); WRITEK(0); LOADK(1); LOADV(0); __syncthreads();
    QKT(pA0, pA1, 0);
    if (!grpB) da8_partialSM<true>(pA0, pA1, m_reg, negm, alA);
    VM_WAIT(); WRITEK(1); WRITEV(vc); LOADK(2); LOADV(1); VROT();
    __syncthreads();
    if (grpB) da8_partialSM<true>(pA0, pA1, m_reg, negm, alA);
    QKT(pB0, pB1, 1); FIN(pA0, pA1, alA);
    if (!grpB) { PVT(vm1); da8_partialSM<false>(pB0, pB1, m_reg, negm, alB); RESC(alB); }
    VM_WAIT(); WRITEK(0); WRITEV(vc); LOADK(3); LOADV(2); VROT();
    __syncthreads();
    for (int j = 2; j + 1 < NT; j += 2) {
        if (grpB) { PVT(vm2); da8_partialSM<false>(pB0, pB1, m_reg, negm, alB); RESC(alB); }
        QKT(pA0, pA1, 0); FIN(pB0, pB1, alB);
        if (!grpB) { PVT(vm1); da8_partialSM<false>(pA0, pA1, m_reg, negm, alA); RESC(alA); }
        VM_WAIT(); WRITEK(1); WRITEV(vc); if (j + 2 < NT) LOADK(j + 2); LOADV(j + 1); VROT();
        __syncthreads();
        if (grpB) { PVT(vm2); da8_partialSM<false>(pA0, pA1, m_reg, negm, alA); RESC(alA); }
        QKT(pB0, pB1, 1); FIN(pA0, pA1, alA);
        if (!grpB) { PVT(vm1); da8_partialSM<false>(pB0, pB1, m_reg, negm, alB); RESC(alB); }
        VM_WAIT(); if (j + 2 < NT) { WRITEK(0); } WRITEV(vc); if (j + 3 < NT) LOADK(j + 3); if (j + 2 < NT) LOADV(j + 2); VROT();
        __syncthreads();
    }
    if (grpB) { PVT(vm2); da8_partialSM<false>(pB0, pB1, m_reg, negm, alB); RESC(alB); }
    FIN(pB0, pB1, alB); PVT(vm1);
#undef LOADK
#undef LOADV
#undef WRITEK
#undef WRITEV
#undef QKT
#undef FIN
#undef PVT
#undef VROT
#define SLOAD(a, b)
#define SWRITE(a, b)
#define SWAIT()
#undef KROW
#undef SLOAD
#undef SWRITE
#undef SWAIT
#undef RESC
    float rl[16];
#pragma unroll
    for (int r = 0; r < 16; ++r) rl[r] = __builtin_amdgcn_rcpf(o[4][r]);
    __syncthreads();
    float* xch = (float*)(lds + DA_XCH) + qsub * (32 * 132);
    if (comp == 1) {
#pragma unroll
        for (int d0 = 0; d0 < 4; ++d0)
#pragma unroll
            for (int r = 0; r < 16; ++r) xch[crow(r, hi) * 132 + d0 * 32 + r32] = o[d0][r] * rl[r];
    }
    __syncthreads();
    if (comp == 0) {
#pragma unroll
        for (int d0 = 0; d0 < 4; ++d0)
#pragma unroll
            for (int r = 0; r < 16; ++r) { const int idx = crow(r, hi) * 132 + d0 * 32 + r32; const float v = o[d0][r] * rl[r] - lam * xch[idx]; xch[idx] = v; }
        LDS_WAIT();
        const int row = lane >> 1, hf = lane & 1; const float* rp = xch + row * 132 + hf * 64;
        f32x4 v[16]; float ss = 0.f;
#pragma unroll
        for (int j = 0; j < 16; ++j) { v[j] = *reinterpret_cast<const f32x4*>(rp + 4 * j); ss += v[j][0] * v[j][0] + v[j][1] * v[j][1] + v[j][2] * v[j][2] + v[j][3] * v[j][3]; }
        ss += __int_as_float(__builtin_amdgcn_ds_bpermute((lane ^ 1) << 2, __float_as_int(ss)));
        const float rs = __builtin_amdgcn_rsqf(ss * (1.f / 128.f) + EPS) * oscale;
        bf16_t* op = O + (qrow0 + row) * DM + h * 128 + hf * 64;
#pragma unroll
        for (int j = 0; j < 16; j += 2) { const f32x4 g0 = *reinterpret_cast<const f32x4*>(subg + hf * 64 + 4 * j), g1 = *reinterpret_cast<const f32x4*>(subg + hf * 64 + 4 * j + 4);
            const f32x4 a = v[j] * g0 * rs, c = v[j + 1] * g1 * rs;
            u32x4 w; w.x = cvtpk(a[0], a[1]); w.y = cvtpk(a[2], a[3]); w.z = cvtpk(c[0], c[1]); w.w = cvtpk(c[2], c[3]);
            *reinterpret_cast<u32x4*>(op + 4 * j) = w; }
    }
}

constexpr int WA_V = 0, WA_K = 16384, WA_WS = 32768, WA_ST = 36864;
__device__ __forceinline__ void wa_mask(f32x16& p0, f32x16& p1, int mode, int qrel, int hi) {
    if (mode == 1) {
#pragma unroll
        for (int r = 0; r < 16; ++r) { const int kk = crow(r, hi); if (kk < qrel) p0[r] = -1e30f; if (kk + 32 < qrel) p1[r] = -1e30f; } }
    else if (mode == 2) {
#pragma unroll
        for (int r = 0; r < 16; ++r) { const int kk = crow(r, hi); if (kk > qrel) p0[r] = -1e30f; if (kk + 32 > qrel) p1[r] = -1e30f; } }
    else if (mode == 3) {
#pragma unroll
        for (int r = 0; r < 16; ++r) { p0[r] = -1e30f; p1[r] = -1e30f; } }
}
__device__ __forceinline__ void win_attn_unit2(char* lds, const bf16_t* Z, bf16_t* Y, const float* sink, int b, int kvh, int qc, bool ctxq) {
    const int tid = opaque(threadIdx.x), wid = __builtin_amdgcn_readfirstlane(tid >> 6), lane = tid & 63, r32 = lane & 31, hi = lane >> 5;
    const int head = kvh * 4 + (wid >> 1), qsub = wid & 1, q0 = qc * 64;
    const size_t rowc = (size_t)RL + b * CTX, rowl = (size_t)b * SEQ;
    const size_t qrow0 = (ctxq ? rowc : rowl) + q0 + qsub * 32;
    char* V_lds = lds + WA_V; char* K_lds = lds + WA_K;
    float* wsf = (float*)(lds + WA_WS) + wid * 128; float* al_l = wsf; float* li_l = wsf + 32;
    __syncthreads();
    bf16x8 qr[4];
    { const bf16_t* qp = Z + (qrow0 + r32) * MIXIN + 512 + head * 64 + hi * 8;
#pragma unroll
      for (int d0 = 0; d0 < 4; ++d0) qr[d0] = *reinterpret_cast<const bf16x8*>(qp + d0 * 16); }
    float m_reg = 0.f, l_reg = 0.f; f32x16 o[2] = {}; f32x16 negm = {};
    const int srow = tid >> 3, scol = (tid & 7) * 8, vst = v_st<64>(srow, scol), kst = kswz<64>(srow, scol * 2);
    const int vb0 = (int)(uintptr_t)V_lds + v_rd_base(lane);
    const bf16_t* kvp = Z + (size_t)srow * MIXIN + 1024 + kvh * 64 + scol;
    const int skip_lo = ctxq ? 0 : (q0 == 0 ? 2 : q0 == 64 ? 1 : 0);
    const int nloc = ctxq ? 0 : 5 - skip_lo - (q0 == SEQ - 64 ? 2 : q0 == SEQ - 128 ? 1 : 0);
    const int NTr = 4 + nloc, NT = (NTr + 1) & ~1;
    const int qrel = qsub * 32 + r32;
    struct { bf16x8 vs, ks; } sr_;
#define KROW(t) ((t) < 4 ? rowc + (size_t)(t) * 64 : (t) < NTr ? rowl + (size_t)(q0 - 128 + ((t) - 4 + skip_lo) * 64) : rowc)
#define TMODE(t) ((t) < 4 ? 0 : (t) >= NTr ? 3 : ((t) - 4 + skip_lo) == 0 ? 1 : ((t) - 4 + skip_lo) == 4 ? 2 : 0)
#define SLOAD(t) do { const bf16_t* p_ = kvp + KROW(t) * MIXIN; sr_.ks = *reinterpret_cast<const bf16x8*>(p_); sr_.vs = *reinterpret_cast<const bf16x8*>(p_ + 128); } while (0)
#define SWRITE(bf) do { *reinterpret_cast<bf16x8*>(V_lds + (bf) * 8192 + vst) = sr_.vs; *reinterpret_cast<bf16x8*>(K_lds + (bf) * 8192 + kst) = sr_.ks; } while (0)
#define SWAIT() asm volatile("s_waitcnt vmcnt(0)" ::: "memory")
#define RESC(a) do { if (__any((a) < 1.f)) { if (hi == 0) al_l[r32] = (a); LDS_WAIT(); \
    _Pragma("unroll") for (int d = 0; d < 2; ++d) _Pragma("unroll") for (int r = 0; r < 16; ++r) o[d][r] *= al_l[crow(r, hi)]; } } while (0)
#define WPV(vb) pv_all<64>(o, (vb), pa0, pa1, pa2, pa3)
    f32x16 pA0, pA1, pB0, pB1; float alA, alB; bf16x8 pa0, pa1, pa2, pa3;
    SLOAD(0); VM_WAIT(); SWRITE(0); __syncthreads();
    qkt64n<64>(pA0, pA1, K_lds, qr, 0, r32, hi, negm); da_partialSM<true>(pA0, pA1, m_reg, negm, alA);
    SLOAD(1);
    SWAIT(); SWRITE(1); __syncthreads();
    for (int j = 1; j + 1 < NT; j += 2) {
        SBAR(); qkt64n<64>(pB0, pB1, K_lds + 8192, qr, 0, r32, hi, negm);
        da_finishSM(pA0, pA1, alA, l_reg, pa0, pa1, pa2, pa3); SBAR();
        SLOAD(j + 1); SBAR();
        WPV(vb0); wa_mask(pB0, pB1, TMODE(j), qrel, hi); da_partialSM<false>(pB0, pB1, m_reg, negm, alB);
        __syncthreads(); SWAIT(); SWRITE(0);
        RESC(alB); __syncthreads();
        SBAR(); qkt64n<64>(pA0, pA1, K_lds, qr, 0, r32, hi, negm);
        da_finishSM(pB0, pB1, alB, l_reg, pa0, pa1, pa2, pa3); SBAR();
        SLOAD(j + 2); SBAR();
        WPV(vb0 + 8192); wa_mask(pA0, pA1, TMODE(j + 1), qrel, hi); da_partialSM<false>(pA0, pA1, m_reg, negm, alA);
        __syncthreads(); SWAIT(); SWRITE(1);
        RESC(alA); __syncthreads();
    }
    SBAR(); qkt64n<64>(pB0, pB1, K_lds + 8192, qr, 0, r32, hi, negm);
    da_finishSM(pA0, pA1, alA, l_reg, pa0, pa1, pa2, pa3); SBAR();
    WPV(vb0); wa_mask(pB0, pB1, TMODE(NT - 1), qrel, hi); da_partialSM<false>(pB0, pB1, m_reg, negm, alB);
    __syncthreads(); RESC(alB);
    da_finishSM(pB0, pB1, alB, l_reg, pa0, pa1, pa2, pa3); SBAR();
    WPV(vb0 + 8192);
#undef KROW
#undef TMODE
#undef SLOAD
#undef SWRITE
#undef SWAIT
#undef RESC
#undef WPV
    l_reg += __builtin_amdgcn_exp2f(sink[head] * LOG2E - m_reg);
    if (hi == 0) li_l[r32] = l_reg; LDS_WAIT();
    bf16_t* stg = (bf16_t*)(lds + WA_ST) + wid * 2048;
#pragma unroll
    for (int r = 0; r < 16; ++r) { const int orow = crow(r, hi); const float rl = __builtin_amdgcn_rcpf(li_l[orow]);
#pragma unroll
        for (int d0 = 0; d0 < 2; ++d0) stg[orow * 64 + d0 * 32 + r32] = (bf16_t)(cvtpk(o[d0][r] * rl, 0.f) & 0xffffu); }
    LDS_WAIT();
    bf16_t* yp = Y + qrow0 * DM + 512 + head * 64;
#pragma unroll
    for (int i = 0; i < 4; ++i) { const int row = i * 8 + (lane >> 3), ch = lane & 7; const u32x4 v = *reinterpret_cast<const u32x4*>(stg + row * 64 + ch * 8); *reinterpret_cast<u32x4*>(yp + (size_t)row * DM + ch * 8) = v; }
}

struct Args {
    const float *x, *c, *ctx, *c_ctx, *ada_w, *ada_b, *norm_g, *mix_in_w, *mix_out_w, *win_sink, *diff_qkv_w, *diff_out_w, *diff_lambda, *diff_subln_g,
                *ffn_in_w, *ffn_out_w, *router_w, *expert_in_w, *expert_out_w;
    float* out; unsigned char* ws; int ph_lo, ph_hi;
};
struct Frame {
    LAS unsigned char* lds; unsigned char* ldsg; volatile LAS unsigned* MISC; unsigned* ctl;
    int tid, lane, wave, vcu, G;
};

__device__ __forceinline__ unsigned f2bf(float f) { unsigned u = __builtin_bit_cast(unsigned, f); return (u + 0x7fffu + ((u >> 16) & 1u)) >> 16; }
__device__ __forceinline__ unsigned pk2(float lo, float hi) { return f2bf(lo) | (f2bf(hi) << 16); }
__device__ __forceinline__ void transpose_item(const float* W, int K, int N, bf16_t* WT, int n0, int c0, int k0, LAS float* scr, int lane) {
#pragma unroll 8
    for (int i = 0; i < 32; ++i) { const int kk = 2 * i + (lane >> 5); scr[kk * 33 + (lane & 31)] = W[(size_t)(k0 + kk) * N + c0 + (lane & 31)]; }
    LDS_WAIT(); asm volatile("" ::: "memory");
    const int c = lane & 7;
#pragma unroll
    for (int j = 0; j < 4; ++j) { const int n = (lane >> 3) + 8 * j; const LAS float* s = scr + (8 * c) * 33 + n;
        u32x4 o; o.x = pk2(s[0 * 33], s[1 * 33]); o.y = pk2(s[2 * 33], s[3 * 33]); o.z = pk2(s[4 * 33], s[5 * 33]); o.w = pk2(s[6 * 33], s[7 * 33]);
        *(u32x4*)(WT + (size_t)(n0 + n) * K + k0 + 8 * c) = o; }
    LDS_WAIT(); asm volatile("" ::: "memory");
}
__device__ __forceinline__ void transpose_item_f8(const float* W, int K, int N, unsigned char* WT, int n0, int c0, int k0, LAS float* scr, int lane) {
#pragma unroll 8
    for (int i = 0; i < 32; ++i) { const int kk = 2 * i + (lane >> 5); scr[kk * 33 + (lane & 31)] = W[(size_t)(k0 + kk) * N + c0 + (lane & 31)] * F8_SW; }
    LDS_WAIT(); asm volatile("" ::: "memory");
    const int c = lane & 7;
#pragma unroll
    for (int j = 0; j < 4; ++j) { const int n = (lane >> 3) + 8 * j; const LAS float* s = scr + (8 * c) * 33 + n;
        u32x2 o; o.x = pk4_fp8(s[0 * 33], s[1 * 33], s[2 * 33], s[3 * 33]); o.y = pk4_fp8(s[4 * 33], s[5 * 33], s[6 * 33], s[7 * 33]);
        *(u32x2*)(WT + (size_t)(n0 + n) * K + k0 + 8 * c) = o; }
    LDS_WAIT(); asm volatile("" ::: "memory");
}
__device__ __forceinline__ bool transpose_job(int& r, const float* W, int nb, int K, int N, void* WT, bool glu, bool f8, LAS float* scr, int lane) {
    const int nblk = N / 32, per = (K / 64) * nblk, tot = nb * per;
    if (r >= tot) { r -= tot; return false; }
    const int mtx = r / per, it = r % per, kb = it / nblk, nbk = it % nblk, n0 = 32 * nbk;
    int c0 = n0;
    if (glu) { const int tile = n0 >> 8, w = n0 & 255; c0 = (w < 128) ? tile * 128 + w : (N >> 1) + tile * 128 + (w - 128); }
    if (f8) transpose_item_f8(W + (size_t)mtx * K * N, K, N, (unsigned char*)WT + (size_t)mtx * K * N, n0, c0, 64 * kb, scr, lane);
    else transpose_item(W + (size_t)mtx * K * N, K, N, (bf16_t*)WT + (size_t)mtx * K * N, n0, c0, 64 * kb, scr, lane);
    return true;
}

struct ThinP {
    int nrows;
    const void* xin_lat; const void* xin_ctx;
    void* xout_lat; void* xout_ctx;
    bool xin16, xout16;
    int ymode;
    const bf16_t* Ysrc; const float* gate; const float* ga;
    bool h8;
    bf16_t* H; const float* gb; const float* shsc;
    const float* router; int* route; unsigned* cnt;
    unsigned char* HSv;
};
#define TH_DECL(PFX) f32x4 PFX##x0 = {}, PFX##x1 = {}, PFX##x2 = {}, PFX##x3 = {}; u32x2 PFX##xh0 = {}, PFX##xh1 = {}, PFX##xh2 = {}, PFX##xh3 = {}; u32x2 PFX##ya0 = {}, PFX##ya1 = {}, PFX##ya2 = {}, PFX##ya3 = {}, PFX##yb0 = {}, PFX##yb1 = {}, PFX##yb2 = {}, PFX##yb3 = {}; float PFX##w0 = 0.f, PFX##w1 = 0.f
#define TH_LOAD(PFX, r_, it_) do { const int rr_ = (r_); \
    if (P.xin16) { const bf16_t* xr_ = (rr_ < RL ? (const bf16_t*)P.xin_lat + (size_t)rr_ * DM : (const bf16_t*)P.xin_ctx + (size_t)(rr_ - RL) * DM) + 4 * lane; \
        PFX##xh0 = __builtin_nontemporal_load(reinterpret_cast<const u32x2*>(xr_)); PFX##xh1 = __builtin_nontemporal_load(reinterpret_cast<const u32x2*>(xr_ + 256)); PFX##xh2 = __builtin_nontemporal_load(reinterpret_cast<const u32x2*>(xr_ + 512)); PFX##xh3 = __builtin_nontemporal_load(reinterpret_cast<const u32x2*>(xr_ + 768)); } \
    else { const float* xr_ = (rr_ < RL ? (const float*)P.xin_lat + (size_t)rr_ * DM : (const float*)P.xin_ctx + (size_t)(rr_ - RL) * DM) + 4 * lane; \
        PFX##x0 = __builtin_nontemporal_load(reinterpret_cast<const f32x4*>(xr_)); PFX##x1 = __builtin_nontemporal_load(reinterpret_cast<const f32x4*>(xr_ + 256)); PFX##x2 = __builtin_nontemporal_load(reinterpret_cast<const f32x4*>(xr_ + 512)); PFX##x3 = __builtin_nontemporal_load(reinterpret_cast<const f32x4*>(xr_ + 768)); } \
    const bf16_t* ya_ = P.Ysrc; const bf16_t* yb_ = P.Ysrc; \
    if (P.ymode == 1) ya_ = P.Ysrc + (size_t)rr_ * DM; \
    else if (P.ymode == 2) { const LAS int* rt_ = rtl + (it_) * 6; \
        const int e0_ = rt_[0], p0_ = rt_[1], e1_ = rt_[2], p1_ = rt_[3]; PFX##w0 = __int_as_float(rt_[4]); PFX##w1 = __int_as_float(rt_[5]); \
        const unsigned b0_ = e0_ == 0 ? 0u : e0_ == 1 ? cb1 : e0_ == 2 ? cb2 : e0_ == 3 ? cb3 : e0_ == 4 ? cb4 : e0_ == 5 ? cb5 : e0_ == 6 ? cb6 : cb7; \
        const unsigned b1_ = e1_ == 0 ? 0u : e1_ == 1 ? cb1 : e1_ == 2 ? cb2 : e1_ == 3 ? cb3 : e1_ == 4 ? cb4 : e1_ == 5 ? cb5 : e1_ == 6 ? cb6 : cb7; \
        ya_ = P.Ysrc + (size_t)(b0_ + p0_) * DM; yb_ = P.Ysrc + (size_t)(b1_ + p1_) * DM; } \
    if (P.ymode) { ya_ += 4 * lane; PFX##ya0 = __builtin_nontemporal_load(reinterpret_cast<const u32x2*>(ya_)); PFX##ya1 = __builtin_nontemporal_load(reinterpret_cast<const u32x2*>(ya_ + 256)); PFX##ya2 = __builtin_nontemporal_load(reinterpret_cast<const u32x2*>(ya_ + 512)); PFX##ya3 = __builtin_nontemporal_load(reinterpret_cast<const u32x2*>(ya_ + 768)); } \
    if (P.ymode == 2) { yb_ += 4 * lane; PFX##yb0 = __builtin_nontemporal_load(reinterpret_cast<const u32x2*>(yb_)); PFX##yb1 = __builtin_nontemporal_load(reinterpret_cast<const u32x2*>(yb_ + 256)); PFX##yb2 = __builtin_nontemporal_load(reinterpret_cast<const u32x2*>(yb_ + 512)); PFX##yb3 = __builtin_nontemporal_load(reinterpret_cast<const u32x2*>(yb_ + 768)); } \
    } while (0)
#define TH_ARGS(PFX) PFX##x0, PFX##x1, PFX##x2, PFX##x3, PFX##xh0, PFX##xh1, PFX##xh2, PFX##xh3, PFX##ya0, PFX##ya1, PFX##ya2, PFX##ya3, PFX##yb0, PFX##yb1, PFX##yb2, PFX##yb3, PFX##w0, PFX##w1
__device__ __forceinline__ void thin_proc(const ThinP& P, f32x4 x0, f32x4 x1, f32x4 x2, f32x4 x3, u32x2 xh0, u32x2 xh1, u32x2 xh2, u32x2 xh3, u32x2 ya0, u32x2 ya1, u32x2 ya2, u32x2 ya3, u32x2 yb0, u32x2 yb1, u32x2 yb2, u32x2 yb3, float yw0, float yw1,
                                          f32x4 GA0, f32x4 GA1, f32x4 GA2, f32x4 GA3, f32x4 GB0, f32x4 GB1, f32x4 GB2, f32x4 GB3, f32x4 SH0, f32x4 SH1, f32x4 SH2, f32x4 SH3,
                                          int r, int li, int lane, LAS float* rwT, LAS int* rec, LAS unsigned* lcnt) {
    const int idx = r < RL ? (r >> 12) : 8;
#define BF4(w) ((f32x4){bf_lo((w).x), bf_hi((w).x), bf_lo((w).y), bf_hi((w).y)})
    f32x4 xv[4] = {x0, x1, x2, x3};
    if (P.xin16) { xv[0] = BF4(xh0); xv[1] = BF4(xh1); xv[2] = BF4(xh2); xv[3] = BF4(xh3); }
    if (P.ymode) {
        f32x4 yv[4];
        if (P.ymode == 1) { yv[0] = BF4(ya0); yv[1] = BF4(ya1); yv[2] = BF4(ya2); yv[3] = BF4(ya3); }
        else { yv[0] = BF4(ya0) * yw0 + BF4(yb0) * yw1; yv[1] = BF4(ya1) * yw0 + BF4(yb1) * yw1; yv[2] = BF4(ya2) * yw0 + BF4(yb2) * yw1; yv[3] = BF4(ya3) * yw0 + BF4(yb3) * yw1; }
#undef BF4
        float ss = 0.f;
#pragma unroll
        for (int j = 0; j < 4; ++j) ss += yv[j][0] * yv[j][0] + yv[j][1] * yv[j][1] + yv[j][2] * yv[j][2] + yv[j][3] * yv[j][3];
        const float rs = __builtin_amdgcn_rsqf(wave_sum(ss, lane) * (1.f / DM) + EPS);
        xv[0] = xv[0] + GA0 * (yv[0] * rs); xv[1] = xv[1] + GA1 * (yv[1] * rs); xv[2] = xv[2] + GA2 * (yv[2] * rs); xv[3] = xv[3] + GA3 * (yv[3] * rs);
    }
    if (P.xout_lat) {
        if (P.xout16) { bf16_t* xo = r < RL ? (bf16_t*)P.xout_lat + (size_t)r * DM : (bf16_t*)P.xout_ctx + (size_t)(r - RL) * DM;
#pragma unroll
            for (int j = 0; j < 4; ++j) { u32x2 w; w.x = cvtpk(xv[j][0], xv[j][1]); w.y = cvtpk(xv[j][2], xv[j][3]); __builtin_nontemporal_store(w, reinterpret_cast<u32x2*>(xo + 4 * lane + 256 * j)); } }
        else { float* xo = r < RL ? (float*)P.xout_lat + (size_t)r * DM : (float*)P.xout_ctx + (size_t)(r - RL) * DM;
#pragma unroll
            for (int j = 0; j < 4; ++j) __builtin_nontemporal_store(xv[j], reinterpret_cast<f32x4*>(xo + 4 * lane + 256 * j)); } }
    if (P.H) {
        float ss = 0.f;
#pragma unroll
        for (int j = 0; j < 4; ++j) ss += xv[j][0] * xv[j][0] + xv[j][1] * xv[j][1] + xv[j][2] * xv[j][2] + xv[j][3] * xv[j][3];
        const float rs = __builtin_amdgcn_rsqf(wave_sum(ss, lane) * (1.f / DM) + EPS);
        bf16_t* hr = P.H + (size_t)r * DM;
        f32x4 hv[4] = {xv[0] * rs * GB0 + SH0, xv[1] * rs * GB1 + SH1, xv[2] * rs * GB2 + SH2, xv[3] * rs * GB3 + SH3};
#pragma unroll
        for (int j = 0; j < 4; ++j) {
            if (P.h8) { *reinterpret_cast<unsigned*>((unsigned char*)P.H + (size_t)r * DM + 4 * lane + 256 * j) = pk4_fp8(hv[j][0] * F8_SH, hv[j][1] * F8_SH, hv[j][2] * F8_SH, hv[j][3] * F8_SH); }
            else { u32x2 w; w.x = cvtpk(hv[j][0], hv[j][1]); w.y = cvtpk(hv[j][2], hv[j][3]); *reinterpret_cast<u32x2*>(hr + 4 * lane + 256 * j) = w; } }
        if (P.router) {
            float lg[8];
#pragma unroll
            for (int e = 0; e < 8; ++e) { float a = 0.f;
#pragma unroll
                for (int j = 0; j < 4; ++j) { const f32x4 w = *reinterpret_cast<const LAS f32x4*>(rwT + e * 1024 + 4 * lane + 256 * j); a += hv[j][0] * w[0] + hv[j][1] * w[1] + hv[j][2] * w[2] + hv[j][3] * w[3]; }
                lg[e] = wave_sum(a, lane); }
            int i0 = 0; float v0 = lg[0];
#pragma unroll
            for (int e = 1; e < 8; ++e) if (lg[e] > v0) { v0 = lg[e]; i0 = e; }
            int i1 = -1; float v1 = -3.4e38f;
#pragma unroll
            for (int e = 0; e < 8; ++e) if (e != i0 && lg[e] > v1) { v1 = lg[e]; i1 = e; }
            const float w0 = 1.f / (1.f + __expf(v1 - v0)), w1 = 1.f - w0;
            if (lane == 0) { const unsigned lp0 = __hip_atomic_fetch_add(lcnt + i0, 1u, __ATOMIC_RELAXED, __HIP_MEMORY_SCOPE_WORKGROUP), lp1 = __hip_atomic_fetch_add(lcnt + i1, 1u, __ATOMIC_RELAXED, __HIP_MEMORY_SCOPE_WORKGROUP);
                LAS int* rc = rec + li * 6; rc[0] = i0; rc[1] = (int)lp0; rc[2] = i1; rc[3] = (int)lp1; rc[4] = __float_as_int(w0); rc[5] = __float_as_int(w1); }
        }
    }
}
__device__ __forceinline__ void thin_phase(Frame& F, const ThinP& P) {
    const int lane = opaque(F.lane);
    const int nlat = P.nrows < RL ? P.nrows : RL, nctx = P.nrows - nlat;
    const int chL = (nlat + F.G - 1) / F.G, chC = (nctx + F.G - 1) / F.G;
    const int r0L = F.vcu * chL, r0C = F.vcu * chC;
    const int nl = r0L >= nlat ? 0 : (r0L + chL <= nlat ? chL : nlat - r0L), nc = r0C >= nctx ? 0 : (r0C + chC <= nctx ? chC : nctx - r0C), nrw = nl + nc;
#define TROW(li_) ((li_) < nl ? r0L + (li_) : RL + r0C + ((li_) - nl))
    LAS float* rwT = (LAS float*)F.lds;
    LAS int* rec = (LAS int*)(F.lds + 32768);
    LAS unsigned* lcnt = (LAS unsigned*)(F.lds + 65536);
    unsigned cb1 = 0, cb2 = 0, cb3 = 0, cb4 = 0, cb5 = 0, cb6 = 0, cb7 = 0;
    if (P.ymode == 2) { unsigned a = 0;
        a += (xb_ld(P.cnt + 0) + 255u) & ~255u; cb1 = a; a += (xb_ld(P.cnt + 1) + 255u) & ~255u; cb2 = a; a += (xb_ld(P.cnt + 2) + 255u) & ~255u; cb3 = a;
        a += (xb_ld(P.cnt + 3) + 255u) & ~255u; cb4 = a; a += (xb_ld(P.cnt + 4) + 255u) & ~255u; cb5 = a; a += (xb_ld(P.cnt + 5) + 255u) & ~255u; cb6 = a;
        a += (xb_ld(P.cnt + 6) + 255u) & ~255u; cb7 = a; }
    if (P.router) {
        for (int i = F.tid; i < 8192; i += 512) { const int col = i >> 3, e = i & 7; rwT[e * 1024 + col] = P.router[i]; }
        if (F.tid < 16) lcnt[F.tid] = 0u;
        __syncthreads();
    }
    LAS int* rtl = (LAS int*)(F.lds + 98304) + F.wave * 6 * 64;
    if (P.ymode == 2) { const int li_ = F.wave + 8 * lane;
        if (li_ < nrw) { const int* rt = P.route + (size_t)TROW(li_) * 8; const u32x4 a = *reinterpret_cast<const u32x4*>(rt); const u32x2 b = *reinterpret_cast<const u32x2*>(rt + 4);
            LAS int* d = rtl + lane * 6; d[0] = (int)a.x; d[1] = (int)a.y; d[2] = (int)a.z; d[3] = (int)a.w; d[4] = (int)b.x; d[5] = (int)b.y; }
        LDS_WAIT(); }
    f32x4 GA0 = {}, GA1 = {}, GA2 = {}, GA3 = {}, GB0 = {}, GB1 = {}, GB2 = {}, GB3 = {}, SH0 = {}, SH1 = {}, SH2 = {}, SH3 = {}; int cur_idx = -1;
#define TH_VEC(r_) do { const int ix_ = (r_) < RL ? ((r_) >> 12) : 8; if (ix_ != cur_idx) { cur_idx = ix_; \
        if (P.ymode) { const float* gt_ = P.gate + (size_t)ix_ * 6144 + 4 * lane; const float* ga_ = P.ga + 4 * lane; \
            GA0 = *reinterpret_cast<const f32x4*>(gt_) * *reinterpret_cast<const f32x4*>(ga_); GA1 = *reinterpret_cast<const f32x4*>(gt_ + 256) * *reinterpret_cast<const f32x4*>(ga_ + 256); \
            GA2 = *reinterpret_cast<const f32x4*>(gt_ + 512) * *reinterpret_cast<const f32x4*>(ga_ + 512); GA3 = *reinterpret_cast<const f32x4*>(gt_ + 768) * *reinterpret_cast<const f32x4*>(ga_ + 768); } \
        if (P.H) { const float* sh_ = P.shsc + (size_t)ix_ * 6144 + 4 * lane; const float* gb_ = P.gb + 4 * lane; \
            GB0 = *reinterpret_cast<const f32x4*>(gb_) * (*reinterpret_cast<const f32x4*>(sh_ + 1024) + 1.f); GB1 = *reinterpret_cast<const f32x4*>(gb_ + 256) * (*reinterpret_cast<const f32x4*>(sh_ + 1280) + 1.f); \
            GB2 = *reinterpret_cast<const f32x4*>(gb_ + 512) * (*reinterpret_cast<const f32x4*>(sh_ + 1536) + 1.f); GB3 = *reinterpret_cast<const f32x4*>(gb_ + 768) * (*reinterpret_cast<const f32x4*>(sh_ + 1792) + 1.f); \
            SH0 = *reinterpret_cast<const f32x4*>(sh_); SH1 = *reinterpret_cast<const f32x4*>(sh_ + 256); SH2 = *reinterpret_cast<const f32x4*>(sh_ + 512); SH3 = *reinterpret_cast<const f32x4*>(sh_ + 768); } } } while (0)
#define TH_VARGS GA0, GA1, GA2, GA3, GB0, GB1, GB2, GB3, SH0, SH1, SH2, SH3
    TH_DECL(A_); TH_DECL(B_);
    int li = F.wave;
    if (li < nrw) TH_LOAD(A_, TROW(li), 0);
    for (int it = 0; li < nrw; li += 16, it += 2) {
        const bool hb = li + 8 < nrw;
        if (hb) TH_LOAD(B_, TROW(li + 8), it + 1);
        TH_VEC(TROW(li)); thin_proc(P, TH_ARGS(A_), TH_VARGS, TROW(li), li, lane, rwT, rec, lcnt);
        if (li + 16 < nrw) TH_LOAD(A_, TROW(li + 16), it + 2);
        if (hb) { TH_VEC(TROW(li + 8)); thin_proc(P, TH_ARGS(B_), TH_VARGS, TROW(li + 8), li + 8, lane, rwT, rec, lcnt); }
    }
    if (P.router) {
        __syncthreads();
        if (F.tid < 8) lcnt[8 + F.tid] = __hip_atomic_fetch_add(P.cnt + F.tid, lcnt[F.tid], __ATOMIC_RELAXED, __HIP_MEMORY_SCOPE_AGENT);
        __syncthreads();
        for (int i = F.tid; i < nrw; i += 512) { const LAS int* rc = rec + i * 6; int* rt = P.route + (size_t)TROW(i) * 8;
            const int e0 = rc[0], e1 = rc[2];
            rt[0] = e0; rt[1] = rc[1] + (int)lcnt[8 + e0]; rt[2] = e1; rt[3] = rc[3] + (int)lcnt[8 + e1]; rt[4] = rc[4]; rt[5] = rc[5]; }
        VM_WAIT();
        for (int lb = F.wave; lb < nrw; lb += 32) {
            u32x4 v[4]; size_t s0[4], s1[4];
#pragma unroll
            for (int q = 0; q < 4; ++q) { const int lq = lb + 8 * q; const int r = TROW(lq); if (lq < nrw) { const LAS int* rc = rec + lq * 6; const int e0 = rc[0], e1 = rc[2];
                s0[q] = (size_t)e0 * RT + (size_t)(rc[1] + (int)lcnt[8 + e0]); s1[q] = (size_t)e1 * RT + (size_t)(rc[3] + (int)lcnt[8 + e1]);
                v[q] = *(reinterpret_cast<const u32x4*>((const unsigned char*)P.H + (size_t)r * DM) + lane); } }
#pragma unroll
            for (int q = 0; q < 4; ++q) { if (lb + 8 * q < nrw) {
                *(reinterpret_cast<u32x4*>(P.HSv + s0[q] * DM) + lane) = v[q]; *(reinterpret_cast<u32x4*>(P.HSv + s1[q] * DM) + lane) = v[q]; } }
        }
        __syncthreads();
    }
#undef TROW
#undef TH_VEC
#undef TH_VARGS
}

constexpr int NPHASE = 2 + DEPTH * 9;
__global__ void __launch_bounds__(512, 2) dit_fwd(Args args) {
    extern __shared__ __attribute__((aligned(16))) unsigned char lds[];
    Frame F;
    F.lds = (LAS unsigned char*)lds; F.ldsg = lds; F.MISC = (volatile LAS unsigned*)(F.lds + MISC_OFF);
    F.tid = threadIdx.x; F.lane = F.tid & 63; F.wave = __builtin_amdgcn_readfirstlane(F.tid >> 6);
    F.G = gridDim.x; { const int bx = blockIdx.x; F.vcu = (F.G % 8 == 0) ? (bx % 8) * (F.G / 8) + bx / 8 : bx; }
    F.ctl = (unsigned*)(args.ws + WS_CTL);
    for (int u = F.tid; u < (LDS_BYTES - RING_BYTES) / 4; u += 512) ((LAS unsigned*)(F.lds + RING_BYTES))[u] = 0u;
    __syncthreads();
    XcdBarrier bar = xcd_barrier_post(F.ctl + CW_BAR, F.MISC + 8);
    const int lo = args.ph_lo, hi = args.ph_hi;
    int ph = 0;
#define IN() (lo <= ph && ph < hi)
    unsigned long long wait_acc = 0, clk_c = 0, clk_r = 0;
#define CLK_BEG(sel) unsigned long long c0_ = 0, r0_ = 0; if (PROBE_CLK == (sel)) { c0_ = __builtin_amdgcn_s_memtime(); r0_ = __builtin_amdgcn_s_memrealtime(); }
#define CLK_END(sel) if (PROBE_CLK == (sel)) { clk_c += __builtin_amdgcn_s_memtime() - c0_; clk_r += __builtin_amdgcn_s_memrealtime() - r0_; }
#define SEAM() do { if (lo <= ph && ph + 1 < hi) { if (WAITPROBE) { const unsigned long long t0_ = __builtin_amdgcn_s_memrealtime(); xcd_barrier(bar); const unsigned long long dt_ = __builtin_amdgcn_s_memrealtime() - t0_; const int k_ = ph < 2 ? 9 + ph : (ph - 2) % 9; if ((WAITSEL >> k_) & 1u) wait_acc += dt_; } else xcd_barrier(bar); } ++ph; } while (0)
    GAS unsigned char* wsg = (GAS unsigned char*)args.ws;
#define WSP ((unsigned char*)wsg)
#define pMOD    ((float*)(WSP + WS_MOD))
#define pROPECS ((f32x2*)(WSP + WS_ROPE))
#define pWP     ((bf16_t*)(WSP + WS_WP))
#define pROUTE  ((int*)(WSP + WS_ROUTE))
#define pCS     ((bf16_t*)(WSP + WS_CS))
#define pCSC    ((bf16_t*)(WSP + WS_CSC))
#define pX      ((bf16_t*)(WSP + WS_X))
#define pH      ((bf16_t*)(WSP + WS_H))
#define pYO     ((bf16_t*)(WSP + WS_YO))
#define pZ      ((bf16_t*)(WSP + WS_Z))
#define pY      ((bf16_t*)(WSP + WS_Y))
#define pPQT    ((bf16_t*)(WSP + WS_PQT))
#define pPQTC   ((bf16_t*)(WSP + WS_PQTC))
#define pOB     ((bf16_t*)(WSP + WS_O))
#define pQK8    ((unsigned char*)(WSP + WS_QK8))
#define pVT8    ((unsigned char*)(WSP + WS_VT8))
#define pA2     ((bf16_t*)(WSP + WS_A2))
#define pA2M    ((bf16_t*)(WSP + WS_A2M))
#define pHS     ((bf16_t*)(WSP + WS_HS))
    const int vcu0 = F.vcu;
#define REFRAME() do { F.tid = opaque(threadIdx.x); F.lane = F.tid & 63; F.wave = __builtin_amdgcn_readfirstlane(F.tid >> 6); F.G = sopaque((int)gridDim.x); F.vcu = sopaque(vcu0); \
        wsg = gptr(args.ws); F.ctl = (unsigned*)(WSP + WS_CTL); } while (0)
    for (int rep0 = 0; rep0 < REP_P0; ++rep0)
    if (IN() && PH_ON(0)) { REFRAME();
        const int gw = F.vcu * 8 + F.wave, NGW = F.G * 8, gt = F.vcu * 512 + F.tid, NGT = F.G * 512;
        LAS float* ctab = (LAS float*)F.lds;
        LAS float* svec = (LAS float*)(F.lds + 16384);
        if (F.tid == 0) *(LAS unsigned*)(F.lds + 126976) = 0u;
        for (int i = F.tid; i < 4096; i += 512) ctab[i] = cospif((float)i * (1.f / 2048.f));
        for (int i = F.tid; i < 9 * 1024; i += 512) { const float v = i < 8192 ? args.c[i] : args.c_ctx[i - 8192]; svec[i] = v / (1.f + __expf(-v)); }
        __syncthreads();
        for (int i = gt; i < 4096 * 512; i += NGT) { const int k = i >> 9, l0 = (i & 511) * 8; float v[8];
#pragma unroll
            for (int e = 0; e < 8; ++e) { const int col = l0 + e; const int ph_ = (k * (col <= 2048 ? col : col - 2048)) & 4095; v[e] = col <= 2048 ? ctab[ph_] : -ctab[(ph_ - 1024) & 4095]; }
            *reinterpret_cast<u32x4*>(pCS + (size_t)k * FP + l0) = (u32x4){pk2(v[0], v[1]), pk2(v[2], v[3]), pk2(v[4], v[5]), pk2(v[6], v[7])}; }
        for (int i = gt; i < 256 * 64; i += NGT) { const int k = i >> 6, l0 = (i & 63) * 8; float v[8];
#pragma unroll
            for (int e = 0; e < 8; ++e) { const int col = l0 + e, l = col & 255; const int ph_ = (k * l * 16) & 4095; v[e] = col < 256 ? ctab[ph_] : -ctab[(ph_ - 1024) & 4095]; }
            *reinterpret_cast<u32x4*>(pCSC + (size_t)k * FP + l0) = (u32x4){pk2(v[0], v[1]), pk2(v[2], v[3]), pk2(v[4], v[5]), pk2(v[6], v[7])}; }
        for (int i = gt; i < 256 * 128; i += NGT) { const int row = i >> 7, c = i & 127, m = row & 127; const int ph_ = (m * c * 32) & 4095;
            const float v = row < 128 ? ctab[ph_] : ctab[(ph_ - 1024) & 4095]; pWP[i] = (bf16_t)f2bf(v); }
        for (int i = gt; i < 64 * 16; i += NGT) { const int pos = i >> 4, k = i & 15; const float inv = __powf(10000.f, -(float)(2 * k) / 32.f); float s, c; sincosf((float)pos * inv, &s, &c); pROPECS[i] = (f32x2){c, s}; }
        for (int task = F.vcu + F.wave * F.G; task < 512; task += 8 * F.G) { const int layer = task >> 7, col = (task & 127) * 48 + F.lane;
            if (F.lane < 48) {
            const float* w = args.ada_w + (size_t)layer * DM * 6144 + col;
            float a0 = 0, a1 = 0, a2 = 0, a3 = 0, a4 = 0, a5 = 0, a6 = 0, a7 = 0, a8 = 0;
            for (int k0 = 0; k0 < DM; k0 += 32) { float wv[32];
#pragma unroll
                for (int i = 0; i < 32; ++i) wv[i] = w[(size_t)(k0 + i) * 6144];
#pragma unroll
                for (int i = 0; i < 32; ++i) { const int k = k0 + i;
                    a0 += svec[k] * wv[i]; a1 += svec[1024 + k] * wv[i]; a2 += svec[2048 + k] * wv[i]; a3 += svec[3072 + k] * wv[i]; a4 += svec[4096 + k] * wv[i];
                    a5 += svec[5120 + k] * wv[i]; a6 += svec[6144 + k] * wv[i]; a7 += svec[7168 + k] * wv[i]; a8 += svec[8192 + k] * wv[i]; } }
            const float bb = args.ada_b[layer * 6144 + col]; float* mo = pMOD + (size_t)layer * 9 * 6144 + col;
            mo[0] = a0 + bb; mo[6144] = a1 + bb; mo[2 * 6144] = a2 + bb; mo[3 * 6144] = a3 + bb; mo[4 * 6144] = a4 + bb; mo[5 * 6144] = a5 + bb; mo[6 * 6144] = a6 + bb; mo[7 * 6144] = a7 + bb; mo[8 * 6144] = a8 + bb; } }
        LAS float* scr = (LAS float*)(F.lds + 57344 + F.wave * 8448);
        LAS unsigned* wcnt = (LAS unsigned*)(F.lds + 126976);
        constexpr int NITEMS = 2 * (16 * 40) + 2 * (16 * 32) + 2 * (16 * 96) + 2 * (16 * 32) + 2 * (16 * 176) + 2 * (44 * 32) + 16 * (16 * 224) + 16 * (56 * 32);
        for (;;) {
            const int n = __builtin_amdgcn_readfirstlane((int)__hip_atomic_fetch_add(wcnt, F.lane == 0 ? 1u : 0u, __ATOMIC_RELAXED, __HIP_MEMORY_SCOPE_WORKGROUP));
            const int it = ((n >> 3) * F.G + F.vcu) * 8 + (n & 7);
            if (it >= NITEMS) break;
            int r = it;
            if (transpose_job(r, args.mix_in_w, 2, DM, MIXIN, (bf16_t*)(WSP + WS_WMIXIN), false, false, scr, F.lane)) continue;
            if (transpose_job(r, args.mix_out_w, 2, DM, DM, (bf16_t*)(WSP + WS_WMIXOUT), false, false, scr, F.lane)) continue;
            if (transpose_job(r, args.diff_qkv_w, 2, DM, 3072, (bf16_t*)(WSP + WS_WQKV), false, true, scr, F.lane)) continue;
            if (transpose_job(r, args.diff_out_w, 2, DM, DM, (bf16_t*)(WSP + WS_WDOUT), false, false, scr, F.lane)) continue;
            if (transpose_job(r, args.ffn_in_w, 2, DM, 2 * FFN, (bf16_t*)(WSP + WS_WFFNIN), true, F8_DENSE, scr, F.lane)) continue;
            if (transpose_job(r, args.ffn_out_w, 2, FFN, DM, (bf16_t*)(WSP + WS_WFFNOUT), false, F8_DENSE || F8_DDOWN, scr, F.lane)) continue;
            if (transpose_job(r, args.expert_in_w, 16, DM, 2 * EDIM, (bf16_t*)(WSP + WS_WEXPIN), true, true, scr, F.lane)) continue;
            transpose_job(r, args.expert_out_w, 16, EDIM, DM, (bf16_t*)(WSP + WS_WEXPOUT), false, true, scr, F.lane);
        }
        __syncthreads();
    }
    SEAM();
    if (IN() && PH_ON(1)) { REFRAME();
        ThinP P{}; P.nrows = RT; P.xin_lat = args.x; P.xin_ctx = args.ctx; P.ymode = 0; P.H = pH; P.gb = args.norm_g; P.shsc = pMOD;
        for (int rep = 0; rep < REP_P0B; ++rep) thin_phase(F, P);
        for (int rep = 0; rep < EXTRA_BARS; ++rep) xcd_barrier(bar);
    }
    SEAM();

    for (int layer = 0; layer < DEPTH; ++layer) {
        const int j = layer >> 1; const bool even = !(layer & 1), lastl = layer == DEPTH - 1;
        const float* modl = pMOD + (size_t)layer * 9 * 6144; const float* ng = args.norm_g + (size_t)layer * 4 * DM;
        const int Mrows = lastl ? RL : RT;
        if (IN() && PH_ON(2)) { REFRAME();
            pg8::Dims d{DM, DM}; SchedDense S;
            if (even) { S.init(pH, DM, (bf16_t*)(WSP + WS_WMIXIN) + (size_t)j * MIXIN * DM, DM, RT, MIXIN, DM, F.G, (int)blockIdx.x);
                EpiRope<false> E{WSP}; for (int rep = 0; rep < REP_PROJ; ++rep) pg8::gemm_phase(F.lds, d, S, E); }
            else { const unsigned char* wq = (const unsigned char*)(WSP + WS_WQKV) + (size_t)j * 3072 * DM;
                pg8::Dims d8{DM / 2, DM / 2};
                S.init(pH, DM / 2, wq, DM / 2, RT, 2048, DM / 2, F.G, (int)blockIdx.x);
                EpiRope<true> E{WSP}; for (int rep = 0; rep < REP_PROJ; ++rep) pg8::gemm_phase<EpiRope<true>, SchedDense, true>(F.lds, d8, S, E);
                SchedDense S2; S2.init(wq + (size_t)2048 * DM, DM / 2, pH, DM / 2, DM, RT, DM / 2, F.G, (int)((blockIdx.x + 3 * (gridDim.x / 4)) % gridDim.x));
                EpiVt E2{WSP}; for (int rep = 0; rep < REP_PROJ; ++rep) pg8::gemm_phase<EpiVt, SchedDense, true>(F.lds, d8, S2, E2); }
        }
        SEAM();
        if (IN() && PH_ON(3)) { REFRAME();
            if (even) {
                if (PH_ON(16)) { pg8::Dims d{128, MIXIN}; SchedF1 S{(const char*)pWP, (const char*)pZ, F.G, F.vcu}; EpiPQt E{pPQT, pPQTC}; for (int rep = 0; rep < REP_FOUR; ++rep) pg8::gemm_phase(F.lds, d, S, E); }
            } else {
                const float* lv = args.diff_lambda + j * 256;
                const int ln = opaque(F.lane); const float s01 = wave_sum(lv[ln] * lv[64 + ln], ln), s23 = wave_sum(lv[128 + ln] * lv[192 + ln], ln);
                const float lam_init = 0.8f - 0.6f * __expf(-0.3f * (float)layer);
                const float lam = __expf(s01) - __expf(s23) + lam_init;
                const float* subg = args.diff_subln_g + j * 128;
                const int nu = lastl ? 2048 : 2048 + 128;
                CLK_BEG(1)
                for (int rep = 0; rep < REP_DIFF; ++rep)
                for (int u = F.vcu; u < (PH_ON(18) ? nu : 0); u += F.G) {
                    if (u < 2048) diff_attn_unit((char*)lds, pVT8, pQK8, pOB, subg, lam, 1.f - lam_init, u >> 8, (u >> 5) & 7, u & 31, false);
                    else { const int v = u - 2048; diff_attn_unit((char*)lds, pVT8, pQK8, pOB, subg, lam, 1.f - lam_init, v >> 4, (v >> 1) & 7, v & 1, true); }
                }
                __syncthreads();
                CLK_END(1)
            }
        }
        SEAM();
        if (IN() && PH_ON(4)) { REFRAME();
            if (even) { pg8::Dims d{FP, FP}; SchedF2 S{(const char*)pCS, (const char*)pCSC, (const char*)pPQT, (const char*)pPQTC, F.G, F.vcu}; EpiFour2 E{pY}; for (int rep = 0; rep < REP_FOUR; ++rep) pg8::gemm_phase<EpiFour2, SchedF2, false>(F.lds, d, S, E);
                const float* sink = args.win_sink + j * 8;
                for (int rep = 0; rep < REP_WIN; ++rep)
                for (int u = F.vcu; u < (PH_ON(17) ? 1024 + 64 : 0); u += F.G) {
                    if (u < 1024) win_attn_unit2((char*)lds, pZ, pY, sink, u >> 7, (u >> 6) & 1, u & 63, false);
                    else { const int v = u - 1024; win_attn_unit2((char*)lds, pZ, pY, sink, v >> 3, (v >> 2) & 1, v & 3, true); }
                }
                __syncthreads();
            }
        }
        if (even) SEAM(); else ++ph;
        if (IN() && PH_ON(5)) { REFRAME();
            pg8::Dims d{DM, DM}; SchedDense S;
            S.init(even ? pY : pOB, DM, (bf16_t*)(WSP + (even ? WS_WMIXOUT : WS_WDOUT)) + (size_t)j * DM * DM, DM, Mrows, DM, DM, F.G, (int)blockIdx.x);
            CLK_BEG(4)
            EpiStore E{pYO, DM, 1.f}; for (int rep = 0; rep < REP_PROJ; ++rep) pg8::gemm_phase(F.lds, d, S, E);
            CLK_END(4)
        }
        SEAM();
        if (IN() && PH_ON(6)) { REFRAME();
            ThinP P{}; P.nrows = Mrows; P.xin16 = layer != 0; P.xout16 = true;
            if (layer == 0) { P.xin_lat = args.x; P.xin_ctx = args.ctx; } else { P.xin_lat = pX; P.xin_ctx = pX + (size_t)RL * DM; }
            P.xout_lat = pX; P.xout_ctx = pX + (size_t)RL * DM; P.ymode = 1; P.Ysrc = pYO; P.gate = modl + 2048; P.ga = ng + DM;
            P.H = pH; P.h8 = !even || F8_DENSE; P.gb = ng + 2 * DM; P.shsc = modl + 3072;
            if (!even) { P.router = args.router_w + (size_t)j * DM * 8; P.route = pROUTE; P.cnt = F.ctl + CW_CNT + 16 * j; P.HSv = (unsigned char*)pHS; }
            thin_phase(F, P);
        }
        SEAM();
        unsigned c0 = 0, c1 = 0, c2 = 0, c3 = 0, c4 = 0, c5 = 0, c6 = 0, c7 = 0;
        if (!even) { unsigned* cn = F.ctl + CW_CNT + 16 * j; unsigned a = 0;
            c0 = 0; a += (rfl(xb_ld(cn + 0)) + 255u) & ~255u; c1 = a; a += (rfl(xb_ld(cn + 1)) + 255u) & ~255u; c2 = a; a += (rfl(xb_ld(cn + 2)) + 255u) & ~255u; c3 = a;
            a += (rfl(xb_ld(cn + 3)) + 255u) & ~255u; c4 = a; a += (rfl(xb_ld(cn + 4)) + 255u) & ~255u; c5 = a; a += (rfl(xb_ld(cn + 5)) + 255u) & ~255u; c6 = a;
            a += (rfl(xb_ld(cn + 6)) + 255u) & ~255u; c7 = a; a += (rfl(xb_ld(cn + 7)) + 255u) & ~255u; c0 = a; }
        ++ph;
        if (IN() && PH_ON(8)) { REFRAME();
            const bool f8 = !even || F8_DENSE; const int eb = f8 ? 1 : 2;
            pg8::Dims d{DM * eb / 2, DM * eb / 2}; SchedGroup S;
            if (even) { S.A = (const char*)pH; S.B = (const char*)(WSP + WS_WFFNIN) + (size_t)j * 2 * FFN * DM * eb; S.nRT = RT / 256; S.P1 = S.P2 = S.P3 = S.P4 = S.P5 = S.P6 = S.P7 = 1 << 30; S.nN = 2 * FFN / 256; S.gB = 0; S.aE = 0; }
            else { S.aE = (size_t)RT * DM; S.A = (const char*)pHS; S.B = (const char*)(WSP + WS_WEXPIN) + (size_t)j * NEXP * 2 * EDIM * DM; S.nRT = (int)(c0 >> 8);
                S.P1 = (int)(c1 >> 8); S.P2 = (int)(c2 >> 8); S.P3 = (int)(c3 >> 8); S.P4 = (int)(c4 >> 8); S.P5 = (int)(c5 >> 8); S.P6 = (int)(c6 >> 8); S.P7 = (int)(c7 >> 8);
                S.nN = 2 * EDIM / 256; S.gB = (size_t)2 * EDIM * DM; }
            S.nwg = S.nRT * S.nN; S.G = F.G; S.c = (int)blockIdx.x; S.nkt = DM * eb / 128; S.tA = (size_t)256 * DM * eb; S.tB = (size_t)256 * DM * eb;
            CLK_BEG(even ? 2 : 3)
            if (f8) { EpiSwiglu<true> E{(unsigned char*)(even ? pA2 : pA2M), even ? FFN : EDIM, 1.f / (F8_SH * F8_SW)}; for (int rep = 0; rep < REP_MOE; ++rep) pg8::gemm_phase<EpiSwiglu<true>, SchedGroup, true, ALIGN_SWIGLU>(F.lds, d, S, E); }
            else if (F8_DDOWN) { EpiSwiglu<true> E{(unsigned char*)pA2, FFN, 1.f}; for (int rep = 0; rep < REP_MOE; ++rep) pg8::gemm_phase<EpiSwiglu<true>, SchedGroup, false>(F.lds, d, S, E); }
            else { EpiSwiglu<false> E{(unsigned char*)pA2, FFN, 1.f}; for (int rep = 0; rep < REP_MOE; ++rep) pg8::gemm_phase<EpiSwiglu<false>, SchedGroup, false>(F.lds, d, S, E); }
            CLK_END(even ? 2 : 3)
        }
        SEAM();
        if (IN() && PH_ON(9)) { REFRAME();
            const bool f8 = !even || F8_DENSE || F8_DDOWN; const int eb = f8 ? 1 : 2;
            const int Kh = even ? FFN : EDIM; pg8::Dims d{Kh * eb / 2, Kh * eb / 2}; SchedGroup S;
            if (even) { S.A = (const char*)pA2; S.B = (const char*)(WSP + WS_WFFNOUT) + (size_t)j * DM * FFN * eb; S.nRT = RT / 256; S.P1 = S.P2 = S.P3 = S.P4 = S.P5 = S.P6 = S.P7 = 1 << 30; S.gB = 0; }
            else { S.A = (const char*)pA2M; S.B = (const char*)(WSP + WS_WEXPOUT) + (size_t)j * NEXP * DM * EDIM; S.nRT = (int)(c0 >> 8);
                S.P1 = (int)(c1 >> 8); S.P2 = (int)(c2 >> 8); S.P3 = (int)(c3 >> 8); S.P4 = (int)(c4 >> 8); S.P5 = (int)(c5 >> 8); S.P6 = (int)(c6 >> 8); S.P7 = (int)(c7 >> 8);
                S.gB = (size_t)DM * EDIM; }
            S.aE = 0; S.nN = DM / 256; S.nwg = S.nRT * S.nN; S.G = F.G; S.c = (int)blockIdx.x; S.nkt = Kh * eb / 128; S.tA = (size_t)256 * Kh * eb; S.tB = (size_t)256 * Kh * eb;
            if (f8) { EpiStore E{even ? pYO : pHS, DM, 1.f / (F8_SA * F8_SW)}; for (int rep = 0; rep < REP_MOE; ++rep) pg8::gemm_phase<EpiStore, SchedGroup, true>(F.lds, d, S, E); }
            else { EpiStore E{pYO, DM, 1.f}; for (int rep = 0; rep < REP_MOE; ++rep) pg8::gemm_phase<EpiStore, SchedGroup, false>(F.lds, d, S, E); }
        }
        SEAM();
        if (IN() && PH_ON(10)) { REFRAME();
            ThinP P{}; P.nrows = Mrows; P.xin16 = true; P.xout16 = !lastl; P.xin_lat = pX; P.xin_ctx = pX + (size_t)RL * DM;
            if (lastl) P.xout_lat = args.out; else P.xout_lat = pX;
            P.xout_ctx = pX + (size_t)RL * DM; P.ymode = even ? 1 : 2; P.Ysrc = even ? pYO : pHS; P.gate = modl + 5120; P.ga = ng + 3 * DM;
            P.route = pROUTE; P.cnt = F.ctl + CW_CNT + 16 * j;
            if (!lastl) { P.H = pH; P.h8 = even; P.gb = ng + 4 * DM; P.shsc = modl + 9 * 6144; }
            thin_phase(F, P);
        }
        SEAM();
    }
    if (PROBE_CLK) {
        const unsigned long long dur_ = clk_r ? clk_c * 5000ull / clk_r : 0ull, t0_ = __builtin_amdgcn_s_memrealtime();
        while (__builtin_amdgcn_s_memrealtime() - t0_ < dur_) __builtin_amdgcn_s_sleep(8);
    }
    if (WAITPROBE) {
        unsigned* wsum = F.ctl + 48;
        if (threadIdx.x == 0) __hip_atomic_fetch_add(wsum, (unsigned)wait_acc, __ATOMIC_RELAXED, __HIP_MEMORY_SCOPE_AGENT);
        xcd_barrier(bar);
        const unsigned mean = xb_ld(wsum) / gridDim.x; const unsigned long long t0_ = __builtin_amdgcn_s_memrealtime();
        while (__builtin_amdgcn_s_memrealtime() - t0_ < (unsigned long long)mean * WAITPROBE) __builtin_amdgcn_s_sleep(8);
    }
#undef IN
#undef SEAM
#undef REFRAME
}

#ifndef MK_PER_PHASE
#define MK_PER_PHASE 0
#endif
extern "C" void kernel_launch(void* const* d_in, const int* in_sizes, int n_in, void* d_out, int out_size, void* d_ws, size_t ws_size, hipStream_t stream) {
    static int grid = 0;
    if (grid == 0) {
        if (n_in != 19 || in_sizes[0] != RL * DM || out_size != RL * DM || ws_size < WS_END) {
            fprintf(stderr, "kernel_launch: unexpected shapes / workspace (n_in %d in0 %d out %d ws %zu need %zu)\n", n_in, n_in > 0 ? in_sizes[0] : -1, out_size, ws_size, (size_t)WS_END); grid = -1; return; }
        int dev = 0, cus = 0, per_cu = 0;
        if (hipGetDevice(&dev) != hipSuccess || hipDeviceGetAttribute(&cus, hipDeviceAttributeMultiprocessorCount, dev) != hipSuccess) { grid = -1; return; }
        if (hipFuncSetAttribute((const void*)dit_fwd, hipFuncAttributeMaxDynamicSharedMemorySize, LDS_BYTES) != hipSuccess) { fprintf(stderr, "kernel_launch: hipFuncSetAttribute failed\n"); grid = -1; return; }
        if (hipOccupancyMaxActiveBlocksPerMultiprocessor(&per_cu, (const void*)dit_fwd, 512, LDS_BYTES) != hipSuccess || per_cu < 1)
            fprintf(stderr, "kernel_launch: occupancy query reports %d\n", per_cu);
        (void)hipGetLastError();
        grid = cus;
    }
    if (grid < 0) return;
    if (hipMemsetAsync((char*)d_ws + WS_CTL, 0, CTL_BYTES, stream) != hipSuccess) return;
    Args a{};
    const float** ap = (const float**)&a;
    for (int i = 0; i < 19; ++i) ap[i] = (const float*)d_in[i];
    a.out = (float*)d_out; a.ws = (unsigned char*)d_ws;
#if MK_PER_PHASE
    for (int p = 0; p < NPHASE; ++p) { a.ph_lo = p; a.ph_hi = p + 1; hipLaunchKernelGGL(dit_fwd, dim3(grid), dim3(512), LDS_BYTES, stream, a); }
#else
    a.ph_lo = 0; a.ph_hi = NPHASE;
    hipLaunchKernelGGL(dit_fwd, dim3(grid), dim3(512), LDS_BYTES, stream, a);
#endif
}
```

```cpp
#include <hip/hip_runtime.h>
#include <cstdio>
#include <cstdint>

#ifndef PHMASK
#define PHMASK 0xFFFFFFFFu
#endif
#define PH_ON(i) ((PHMASK >> (i)) & 1u)
#ifndef REP_DIFF
#define REP_DIFF 1
#endif
#ifndef REP_MOE
#define REP_MOE 1
#endif
#ifndef REP_P0
#define REP_P0 1
#endif
#ifndef REP_P0B
#define REP_P0B 1
#endif
#ifndef EXTRA_BARS
#define EXTRA_BARS 0
#endif
#ifndef REP_EPI
#define REP_EPI 1
#endif
#ifndef WAITSEL
#define WAITSEL 0xFFFFu
#endif
#ifndef WAITPROBE
#define WAITPROBE 0
#endif
#ifndef KREP
#define KREP 1
#endif
#ifndef REP_PROJ
#define REP_PROJ 1
#endif
#ifndef REP_FOUR
#define REP_FOUR 1
#endif
#ifndef REP_WIN
#define REP_WIN 1
#endif
#ifndef PROBE_CLK
#define PROBE_CLK 0
#endif
#define LAS __attribute__((address_space(3)))
#define GAS __attribute__((address_space(1)))
typedef unsigned short bf16_t;
typedef short bf16x8 __attribute__((ext_vector_type(8)));
typedef short s16x4 __attribute__((ext_vector_type(4)));
typedef float f32x2 __attribute__((ext_vector_type(2)));
typedef float f32x4 __attribute__((ext_vector_type(4)));
typedef float f32x16 __attribute__((ext_vector_type(16)));
typedef unsigned u32x2 __attribute__((ext_vector_type(2)));
typedef unsigned u32x4 __attribute__((ext_vector_type(4)));
typedef __bf16 bf16x2_t __attribute__((ext_vector_type(2)));
typedef int v8i_t __attribute__((ext_vector_type(8)));

constexpr int DM = 1024, NB = 8, SEQ = 4096, CTX = 256, DEPTH = 4;
constexpr int RL = NB * SEQ, RC = NB * CTX, RT = RL + RC;
constexpr int MIXIN = 1280, FFN = 2816, NEXP = 8, EDIM = 3584;
constexpr int MAXSLOT = 71680;
constexpr float EPS = 1e-6f;
constexpr float LOG2E = 1.4426950408889634f;
constexpr float QK_C = 0.125f * LOG2E;

constexpr size_t MiB = 1u << 20;
constexpr size_t WS_CTL = 0, CTL_BYTES = 32 * 1024;
constexpr size_t WS_MOD = 1 * MiB;
constexpr size_t WS_ROPE = WS_MOD + 900 * 1024;
constexpr size_t WS_WP = WS_ROPE + 8 * 1024;
constexpr size_t WS_ROUTE = 2 * MiB;
constexpr size_t WS_CS = 4 * MiB;
constexpr size_t WS_CSC = 68 * MiB;
constexpr size_t WS_WMIXIN = 72 * MiB;
constexpr size_t WS_WMIXOUT = 77 * MiB;
constexpr size_t WS_WQKV = 81 * MiB;
constexpr size_t WS_WDOUT = 93 * MiB;
constexpr size_t WS_WFFNIN = 97 * MiB;
constexpr size_t WS_WFFNOUT = 119 * MiB;
constexpr size_t WS_WEXPIN = 130 * MiB;
constexpr size_t WS_WEXPOUT = 354 * MiB;
constexpr size_t WS_X = 466 * MiB;
constexpr size_t WS_H = 602 * MiB;
constexpr size_t WS_YO = 670 * MiB;
constexpr size_t WS_RA = 738 * MiB;
constexpr size_t WS_Z = WS_RA;
constexpr size_t WS_VT8 = WS_RA;
constexpr size_t WS_Y = WS_RA + 85 * MiB;
constexpr size_t WS_PQT = WS_RA + 153 * MiB;
constexpr size_t WS_O = WS_RA + 204 * MiB;
constexpr size_t WS_RB = 1010 * MiB;
constexpr size_t WS_A2 = WS_RB;
constexpr size_t WS_QK8 = WS_RB;
constexpr size_t WS_PQTC = WS_RB + 190 * MiB;
constexpr size_t WS_A2M = WS_H;
constexpr size_t WS_HS = 1092 * MiB;
constexpr size_t WS_END = 1364 * MiB;
static_assert(WS_A2M + (size_t)MAXSLOT * EDIM * 2 <= WS_HS, "A2m overlay");
static_assert(WS_HS + (size_t)NEXP * RT * DM <= WS_END && WS_HS + (size_t)MAXSLOT * DM * 2 <= WS_END && WS_PQTC + 64 * MiB <= WS_END, "ws end");

constexpr int CW_TMO = 0;
constexpr int CW_CNT = 64;
constexpr int CW_BAR = 4096;

constexpr int RING_BYTES = 131072;
constexpr int MISC_OFF = RING_BYTES + 320;
constexpr int LDS_BYTES = 147456;

__device__ __forceinline__ unsigned cvtpk(float lo, float hi) { f32x2 v = {lo, hi}; bf16x2_t b = __builtin_convertvector(v, bf16x2_t); return __builtin_bit_cast(unsigned, b); }
#ifndef F8_DENSE
#define F8_DENSE true
#endif
#ifndef F8_DDOWN
#define F8_DDOWN true
#endif
#ifndef F8_FOUR
#define F8_FOUR false
#endif
static_assert(!F8_FOUR, "fp8 Fourier path retired");
constexpr int FP = 4096;
constexpr float F8_SCS = 256.f, F8_SPQ = 8.f;
constexpr float F8_SH = 4.f, F8_SW = 64.f, F8_SA = 4.f;
__device__ __forceinline__ float f8clamp(float v) { return __builtin_amdgcn_fmed3f(v, -448.f, 448.f); }
__device__ __forceinline__ unsigned pk4_fp8(float a, float b, float c, float d) {
    unsigned w = 0; w = __builtin_amdgcn_cvt_pk_fp8_f32(f8clamp(a), f8clamp(b), w, false); w = __builtin_amdgcn_cvt_pk_fp8_f32(f8clamp(c), f8clamp(d), w, true); return w; }
__device__ __forceinline__ float bf_lo(unsigned u) { return __uint_as_float(u << 16); }
__device__ __forceinline__ float bf_hi(unsigned u) { return __uint_as_float(u & 0xffff0000u); }
__device__ __forceinline__ float wave_sum(float v, int lane) {
#pragma unroll
    for (int o = 1; o < 64; o <<= 1) v += __int_as_float(__builtin_amdgcn_ds_bpermute((lane ^ o) << 2, __float_as_int(v)));
    return v;
}
__device__ __forceinline__ unsigned rfl(unsigned v) { return (unsigned)__builtin_amdgcn_readfirstlane((int)v); }
__device__ __forceinline__ const char* uptr(const char* p) {
    unsigned lo = (unsigned)__builtin_amdgcn_readfirstlane((int)(unsigned)(uintptr_t)p), hi = (unsigned)__builtin_amdgcn_readfirstlane((int)(unsigned)((uintptr_t)p >> 32));
    asm volatile("" : "+s"(lo), "+s"(hi));
    return (const char*)(((uintptr_t)hi << 32) | lo);
}
__device__ __forceinline__ GAS unsigned char* gptr(const void* p) {
    unsigned lo = (unsigned)__builtin_amdgcn_readfirstlane((int)(unsigned)(uintptr_t)p), hi = (unsigned)__builtin_amdgcn_readfirstlane((int)(unsigned)((uintptr_t)p >> 32));
    asm volatile("" : "+s"(lo), "+s"(hi));
    return (GAS unsigned char*)(((uintptr_t)hi << 32) | lo);
}
__device__ __forceinline__ int sopaque(int v) { v = __builtin_amdgcn_readfirstlane(v); asm volatile("" : "+s"(v)); return v; }
__device__ __forceinline__ int opaque(int v) { asm volatile("" : "+v"(v)); return v; }
#define LDS_WAIT() asm volatile("s_waitcnt lgkmcnt(0)" ::: "memory")
#define VM_WAIT() asm volatile("s_waitcnt vmcnt(0)" ::: "memory")
#define SBAR() __builtin_amdgcn_sched_barrier(0)

namespace pg8 {
constexpr int BM = 256, BK = 64, HALF = 128, HTB = HALF * BK * 2, STAGE_BYTES = 8 * HTB, NXCD = 8, WGM = 8;
__host__ __device__ __forceinline__ int lds_byte(int r, int c) { const int st = (r >> 4) * 2 + (c >> 5), rr = r & 15, cc = c & 31, ob = rr * 64 + cc * 2; return st * 1024 + (ob ^ (((ob >> 9) & 1) << 5)); }
__host__ __device__ __forceinline__ void stage_rc(int b, int& R, int& C) { const int st = b / 1024, sb = b % 1024, swz = sb ^ (((sb >> 9) & 1) << 5); R = (st >> 1) * 16 + swz / 64; C = (st & 1) * 32 + (swz % 64) / 2; }
__host__ __device__ __forceinline__ int perm32(int rho) { const int n = rho >> 4, i = rho & 15; return 8 * (i >> 2) + 4 * n + (i & 3); }

struct Unit { int pm, pn, e, nkt; };
struct Dims { int lda, ldb; };

__device__ __forceinline__ int xcd_remap(int wgid, int nwg) {
    const int q = nwg / NXCD, r = nwg % NXCD, xcd = wgid % NXCD, off = wgid / NXCD;
    return (xcd < r ? xcd * (q + 1) : r * (q + 1) + (xcd - r) * q) + off;
}

#ifndef ALIGN_SWIGLU
#define ALIGN_SWIGLU true
#endif
#ifndef ALIGN_DEFAULT
#define ALIGN_DEFAULT true
#endif
template <class Epi, class Sched, bool F8 = false, bool ALIGN_EPI = ALIGN_DEFAULT>
__device__ __forceinline__ void gemm_phase(LAS unsigned char* lds, const Dims g, const Sched& S, const Epi& E) {
    const int tid = opaque(threadIdx.x), wid = __builtin_amdgcn_readfirstlane(tid >> 6), lane = tid & 63, wr = wid >> 2, wc = wid & 3, fr = lane & 15, fq = lane >> 4;
    unsigned voffA[2], voffB[2];
#pragma unroll
    for (int i = 0; i < 2; ++i) { int R, C; stage_rc(tid * 16 + i * 8192, R, C); const int Rb = Epi::PERM ? ((R & ~31) + perm32(R & 31)) : R;
        voffA[i] = (unsigned)(R * g.lda + C) * 2u; voffB[i] = (unsigned)(Rb * g.ldb + C) * 2u; }
    const size_t kstep = (size_t)(BK * 2);
    const size_t hstepA = (size_t)HALF * g.lda * 2, hstepB = (size_t)HALF * g.ldb * 2;
    const unsigned ldsw = (unsigned)wid * 1024u;
    const int aoff = lds_byte(wr * 64 + fr, fq * 8), boff = lds_byte(wc * 32 + fr, fq * 8);
#define PG8_SA(b, h) (((b) * 2 + (h)) * HTB)
#define PG8_SB(b, h) ((4 + (b) * 2 + (h)) * HTB)
#define PG8_STAGE(bufoff, gbase, voff) do { _Pragma("unroll") for (int _i = 0; _i < 2; ++_i) \
        __builtin_amdgcn_global_load_lds((const unsigned*)((const char*)(gbase) + (voff)[_i]), (LAS unsigned*)(lds + (bufoff) + ldsw + _i * 8192), 16, 0, 0); } while (0)
#define PG8_LDA(dst, b, h) do { _Pragma("unroll") for (int m = 0; m < 4; ++m) _Pragma("unroll") for (int k = 0; k < 2; ++k) dst[m][k] = *(const LAS bf16x8*)(lds + PG8_SA(b, h) + aoff + m * 2048 + k * 1024); } while (0)
#define PG8_LDB(dst, b, h) do { _Pragma("unroll") for (int n = 0; n < 2; ++n) _Pragma("unroll") for (int k = 0; k < 2; ++k) dst[n][k] = *(const LAS bf16x8*)(lds + PG8_SB(b, h) + boff + n * 2048 + k * 1024); } while (0)
#define PG8_V8(x) __builtin_bit_cast(v8i_t, (x))
#define PG8_MMA(ai, bj, At, Bt) do { __builtin_amdgcn_s_setprio(1); _Pragma("unroll") for (int m = 0; m < 4; ++m) _Pragma("unroll") for (int n = 0; n < 2; ++n) { \
        if constexpr (F8) { struct P2 { bf16x8 a, b; }; const v8i_t a8_ = PG8_V8((P2{Bt[n][0], Bt[n][1]})), b8_ = PG8_V8((P2{At[m][0], At[m][1]})); \
            asm volatile("v_mfma_f32_16x16x128_f8f6f4 %0, %1, %2, %0" : "+v"(acc[ai][bj][m][n]) : "v"(a8_), "v"(b8_)); }   \
        else { _Pragma("unroll") for (int k = 0; k < 2; ++k) acc[ai][bj][m][n] = __builtin_amdgcn_mfma_f32_16x16x32_bf16(Bt[n][k], At[m][k], acc[ai][bj][m][n], 0, 0, 0); } } \
        __builtin_amdgcn_s_setprio(0); } while (0)
#define PG8_WAIT_V(n) asm volatile("s_waitcnt vmcnt(" #n ")" ::: "memory")
#define PG8_WAIT_L(n) asm volatile("s_waitcnt lgkmcnt(" #n ")" ::: "memory")
#define PG8_BAR __builtin_amdgcn_s_barrier()
#define PG8_SCHED __builtin_amdgcn_sched_barrier(0)
    Unit cur, nxt; int ui = 0;
    if (!S.next(0, cur)) return;
    constexpr bool MIR = Sched::MIRROR;
    unsigned vB2c[2] = {0u, 0u}, vB2n[2] = {0u, 0u}; const char* cB2 = nullptr; const char* nB2 = nullptr;
#define PG8_MKV2(dst, un) do { const int t2_ = opaque(threadIdx.x); _Pragma("unroll") for (int i_ = 0; i_ < 2; ++i_) { int R_, C_; stage_rc(t2_ * 16 + i_ * 8192, R_, C_); \
        const int Rb_ = Epi::PERM ? ((R_ & ~31) + perm32(R_ & 31)) : R_; dst[i_] = S.voff2(un, Rb_, C_, g.ldb); } } while (0)
    if constexpr (MIR) { PG8_MKV2(vB2c, cur); cB2 = uptr(S.bptr2(cur)); }
    f32x4 acc[2][2][4][2];
#pragma unroll
    for (int a = 0; a < 2; ++a)
#pragma unroll
        for (int b = 0; b < 2; ++b)
#pragma unroll
            for (int m = 0; m < 4; ++m)
#pragma unroll
                for (int n = 0; n < 2; ++n) acc[a][b][m][n] = (f32x4){0.f, 0.f, 0.f, 0.f};
    bf16x8 At[4][2], B0[2][2], B1[2][2];
    const char* cA = uptr(S.aptr(cur)); const char* cB = uptr(S.bptr(cur));
    PG8_STAGE(PG8_SB(0, 0), cB, voffB); if constexpr (MIR) PG8_STAGE(PG8_SB(0, 1), cB2, vB2c); else PG8_STAGE(PG8_SB(0, 1), cB + hstepB, voffB); PG8_STAGE(PG8_SA(0, 0), cA, voffA); PG8_STAGE(PG8_SA(0, 1), cA + hstepA, voffA);
    if (wr == 1) PG8_BAR;
    PG8_WAIT_V(2); PG8_BAR;
    PG8_STAGE(PG8_SB(1, 0), cB + kstep, voffB); PG8_STAGE(PG8_SA(1, 0), cA + kstep, voffA); if constexpr (MIR) PG8_STAGE(PG8_SB(1, 1), cB2 + kstep, vB2c); else PG8_STAGE(PG8_SB(1, 1), cB + hstepB + kstep, voffB);
    PG8_WAIT_V(6); PG8_BAR;
    for (;;) {
        const bool has_next = S.next(ui + 1, nxt);
        const char* nA = uptr(has_next ? S.aptr(nxt) : cA); const char* nB = uptr(has_next ? S.bptr(nxt) : cB);
        if constexpr (MIR) { if (has_next) { PG8_MKV2(vB2n, nxt); nB2 = uptr(S.bptr2(nxt)); } else { vB2n[0] = vB2c[0]; vB2n[1] = vB2c[1]; nB2 = cB2; } }
        const int nt = sopaque(cur.nkt);
        for (int t = 0; t < KREP * nt; t += 2) {
            const bool last = (t == KREP * nt - 2);
            const char* a1 = cA + (size_t)(KREP == 1 ? t + 1 : (t + 1) % nt) * kstep;
            const char* a2 = last ? nA : cA + (size_t)(KREP == 1 ? t + 2 : (t + 2) % nt) * kstep; const char* b2 = last ? nB : cB + (size_t)(KREP == 1 ? t + 2 : (t + 2) % nt) * kstep;
            const char* a3 = a2 + kstep; const char* b3 = b2 + kstep;
            const char* m2 = nullptr; unsigned vm[2] = {0u, 0u};
            if constexpr (MIR) { m2 = last ? nB2 : cB2 + (size_t)(t + 2) * kstep; vm[0] = last ? vB2n[0] : vB2c[0]; vm[1] = last ? vB2n[1] : vB2c[1]; }
            PG8_LDB(B0, 0, 0); PG8_LDB(B1, 0, 1); PG8_SCHED; PG8_LDA(At, 0, 0); PG8_STAGE(PG8_SA(1, 1), a1 + hstepA, voffA);
            PG8_WAIT_V(8); PG8_WAIT_L(0); PG8_BAR; PG8_MMA(0, 0, At, B0); PG8_MMA(0, 1, At, B1); PG8_BAR; PG8_SCHED;
            PG8_LDA(At, 0, 1); PG8_STAGE(PG8_SB(0, 0), b2, voffB); if constexpr (MIR) PG8_STAGE(PG8_SB(0, 1), m2, vm); else PG8_STAGE(PG8_SB(0, 1), b2 + hstepB, voffB); PG8_STAGE(PG8_SA(0, 0), a2, voffA);
            PG8_WAIT_V(8); PG8_WAIT_L(0); PG8_BAR; PG8_MMA(1, 0, At, B0); PG8_MMA(1, 1, At, B1); PG8_BAR; PG8_SCHED;
            PG8_LDB(B0, 1, 0); PG8_LDB(B1, 1, 1); PG8_SCHED; PG8_LDA(At, 1, 0); PG8_STAGE(PG8_SA(0, 1), a2 + hstepA, voffA);
            PG8_WAIT_V(8); PG8_WAIT_L(0); PG8_BAR; PG8_MMA(0, 0, At, B0); PG8_MMA(0, 1, At, B1); PG8_BAR; PG8_SCHED;
            PG8_LDA(At, 1, 1); PG8_STAGE(PG8_SB(1, 0), b3, voffB); if constexpr (MIR) PG8_STAGE(PG8_SB(1, 1), m2 + kstep, vm); else PG8_STAGE(PG8_SB(1, 1), b3 + hstepB, voffB); PG8_STAGE(PG8_SA(1, 0), a3, voffA);
            PG8_WAIT_V(8); PG8_WAIT_L(0); PG8_BAR; PG8_MMA(1, 0, At, B0); PG8_MMA(1, 1, At, B1); PG8_BAR; PG8_SCHED;
        }
        if constexpr (ALIGN_EPI) { if (wr == 0) PG8_BAR; }
        if constexpr (F8) asm volatile("s_nop 15\n\ts_nop 15" ::: "memory");
        for (int repe = 0; repe < REP_EPI; ++repe) { const int l2 = opaque(threadIdx.x) & 63; E(acc, cur, wr, wc, l2 & 15, l2 >> 4); }
        if (!has_next) break;
#pragma unroll
        for (int a = 0; a < 2; ++a)
#pragma unroll
            for (int b = 0; b < 2; ++b)
#pragma unroll
                for (int m = 0; m < 4; ++m)
#pragma unroll
                    for (int n = 0; n < 2; ++n) acc[a][b][m][n] = (f32x4){0.f, 0.f, 0.f, 0.f};
        cur = nxt; cA = nA; cB = nB; ++ui;
        if constexpr (MIR) { cB2 = nB2; vB2c[0] = vB2n[0]; vB2c[1] = vB2n[1]; }
        if constexpr (ALIGN_EPI) { if (wr == 1) PG8_BAR; }
    }
    PG8_WAIT_V(0);
    if constexpr (!ALIGN_EPI) { if (wr == 0) PG8_BAR; }
    PG8_BAR;
#undef PG8_MKV2
#undef PG8_SA
#undef PG8_SB
#undef PG8_STAGE
#undef PG8_LDA
#undef PG8_LDB
#undef PG8_MMA
#undef PG8_V8
#undef PG8_WAIT_V
#undef PG8_WAIT_L
#undef PG8_BAR
#undef PG8_SCHED
}
}
using pg8::Unit;

struct EpiStore {
    static constexpr bool PERM = true;
    bf16_t* O; int ldc; float scale;
    __device__ __forceinline__ void operator()(const f32x4 (&acc)[2][2][4][2], const Unit& u, int wr, int wc, int fr, int fq) const {
        const int row0 = u.pm * 256 + wr * 64 + fr, col0 = u.pn * 256 + wc * 32 + 8 * fq;
#pragma unroll
        for (int ai = 0; ai < 2; ++ai)
#pragma unroll
            for (int m = 0; m < 4; ++m) { bf16_t* rowp = O + (size_t)(row0 + ai * 128 + m * 16) * ldc + col0;
#pragma unroll
                for (int bj = 0; bj < 2; ++bj) { const f32x4 v0 = acc[ai][bj][m][0] * (scale * (1.f / KREP)), v1 = acc[ai][bj][m][1] * (scale * (1.f / KREP));
                    u32x4 w; w.x = cvtpk(v0[0], v0[1]); w.y = cvtpk(v0[2], v0[3]); w.z = cvtpk(v1[0], v1[1]); w.w = cvtpk(v1[2], v1[3]);
                    *(u32x4*)(rowp + bj * 128) = w; } }
    }
};
template <bool F8OUT> struct EpiSwiglu {
    static constexpr bool PERM = true;
    unsigned char* O; int ldc; float scale;
    __device__ __forceinline__ void operator()(const f32x4 (&acc)[2][2][4][2], const Unit& u, int wr, int wc, int fr, int fq) const {
        const int row0 = u.pm * 256 + wr * 64 + fr, col0 = u.pn * 128 + wc * 32 + 8 * fq;
        const float us = F8OUT ? scale * F8_SA : scale;
        const float k1 = -scale * LOG2E * (1.f / KREP), ik2 = 1.f / (scale * us * (1.f / KREP) * (1.f / KREP));
#pragma unroll
        for (int ai = 0; ai < 2; ++ai)
#pragma unroll
            for (int m = 0; m < 4; ++m) { unsigned char* rowp = O + ((size_t)(row0 + ai * 128 + m * 16) * ldc + col0) * (F8OUT ? 1 : 2);
                float r[8];
#pragma unroll
                for (int n = 0; n < 2; ++n) { const f32x4 g = acc[ai][0][m][n], u = acc[ai][1][m][n]; const f32x4 t = g * k1;
                    f32x4 e; e[0] = __builtin_amdgcn_exp2f(t[0]); e[1] = __builtin_amdgcn_exp2f(t[1]); e[2] = __builtin_amdgcn_exp2f(t[2]); e[3] = __builtin_amdgcn_exp2f(t[3]);
                    const f32x4 d = e * ik2 + ik2;
                    f32x4 q; q[0] = __builtin_amdgcn_rcpf(d[0]); q[1] = __builtin_amdgcn_rcpf(d[1]); q[2] = __builtin_amdgcn_rcpf(d[2]); q[3] = __builtin_amdgcn_rcpf(d[3]);
                    const f32x4 o = (g * u) * q; r[n * 4 + 0] = o[0]; r[n * 4 + 1] = o[1]; r[n * 4 + 2] = o[2]; r[n * 4 + 3] = o[3]; }
                if constexpr (F8OUT) { u32x2 w; w.x = pk4_fp8(r[0], r[1], r[2], r[3]); w.y = pk4_fp8(r[4], r[5], r[6], r[7]); *(u32x2*)rowp = w; }
                else { u32x4 w; w.x = cvtpk(r[0], r[1]); w.y = cvtpk(r[2], r[3]); w.z = cvtpk(r[4], r[5]); w.w = cvtpk(r[6], r[7]); *(u32x4*)rowp = w; } }
    }
};
template <bool ODD> struct EpiRope {
    static constexpr bool PERM = false;
    unsigned char* ws;
    static constexpr int ldc = ODD ? 3072 : MIXIN, rlo = ODD ? 0 : 4, rhi = ODD ? 16 : 9, qlo = ODD ? 0 : 4, qhi = 8, f8hi = ODD ? 16 : 0;
    __device__ __forceinline__ void operator()(const f32x4 (&acc)[2][2][4][2], const Unit& u, int wr, int wc, int fr, int fq) const {
        const float ascale = ODD ? 1.f / (F8_SH * F8_SW) : 1.f, qscale = QK_C;
        bf16_t* O = (bf16_t*)(ws + WS_Z); const f32x2* cs = (const f32x2*)(ws + WS_ROPE); unsigned char* O8 = ws + WS_QK8;
        const int row0 = u.pm * 256 + wr * 64 + fr, col0 = u.pn * 256 + wc * 32 + 4 * fq;
        const bool lat = u.pm < 128;
#pragma unroll
        for (int ai = 0; ai < 2; ++ai)
#pragma unroll
            for (int m = 0; m < 4; ++m) { const int row = row0 + ai * 128 + m * 16; bf16_t* rowp = O + (size_t)row * ldc + col0;
                const int t = row & 4095, pos = (wc & 1) ? (t & 63) : (t >> 6);
                const f32x2* c4 = cs + pos * 16 + 4 * fq;
                const f32x2 c0 = c4[0], c1 = c4[1], c2 = c4[2], c3 = c4[3];
#pragma unroll
                for (int bj = 0; bj < 2; ++bj) { f32x4 p1 = acc[ai][bj][m][0] * (ascale * (1.f / KREP)), p2 = acc[ai][bj][m][1] * (ascale * (1.f / KREP));
                    const int blk = u.pn * 2 + bj;
                    if (lat && blk >= rlo && blk < rhi) {
                        const f32x4 cv = {c0.x, c1.x, c2.x, c3.x}, sv = {c0.y, c1.y, c2.y, c3.y};
                        const f32x4 o1 = p1 * cv - p2 * sv, o2 = p2 * cv + p1 * sv; p1 = o1; p2 = o2; }
                    if (blk >= qlo && blk < qhi) { p1 = p1 * qscale; p2 = p2 * qscale; }
                    if (ODD) { unsigned char* r8 = O8 + (size_t)row * 2048 + col0 + bj * 128;
                        *(unsigned*)r8 = pk4_fp8(p1[0], p1[1], p1[2], p1[3]); *(unsigned*)(r8 + 16) = pk4_fp8(p2[0], p2[1], p2[2], p2[3]); }
                    else { u32x2 w1, w2; w1.x = cvtpk(p1[0], p1[1]); w1.y = cvtpk(p1[2], p1[3]); w2.x = cvtpk(p2[0], p2[1]); w2.y = cvtpk(p2[2], p2[3]);
                        *(u32x2*)(rowp + bj * 128) = w1; *(u32x2*)(rowp + bj * 128 + 16) = w2; } } }
    }
};
struct EpiVt {
    static constexpr bool PERM = true;
    unsigned char* ws;
    __device__ __forceinline__ void operator()(const f32x4 (&acc)[2][2][4][2], const Unit& u, int wr, int wc, int fr, int fq) const {
        unsigned char* Vt = ws + WS_VT8; const float scale = 1.f / (F8_SH * F8_SW);
        const bool ctx = u.pn >= 128; const int b = ctx ? u.pn - 128 : u.pn >> 4, kt0 = ctx ? 0 : 4 + (u.pn & 15) * 4;
#pragma unroll
        for (int ai = 0; ai < 2; ++ai)
#pragma unroll
            for (int m = 0; m < 4; ++m) { const int d = wr * 64 + m * 16 + fr;
                unsigned char* tb = Vt + ((size_t)(b * 8 + u.pm * 2 + ai) * 68 + kt0) * 8192 + d * 64;
#pragma unroll
                for (int bj = 0; bj < 2; ++bj) { const int c = bj * 128 + wc * 32 + 8 * fq, s0 = c & 63;
                    const f32x4 v0 = acc[ai][bj][m][0] * (scale * (1.f / KREP)), v1 = acc[ai][bj][m][1] * (scale * (1.f / KREP));
                    u32x2 w; w.x = pk4_fp8(v0[0], v0[1], v0[2], v0[3]); w.y = pk4_fp8(v1[0], v1[1], v1[2], v1[3]);
                    *(u32x2*)(tb + (c >> 6) * 8192 + ((((s0 >> 4) ^ (d >> 2)) & 3) << 4) + (s0 & 15)) = w; } }
    }
};
struct EpiPQt {
    static constexpr bool PERM = true;
    bf16_t* Plat; bf16_t* Pctx;
    __device__ __forceinline__ void operator()(const f32x4 (&acc)[2][2][4][2], const Unit& u, int wr, int wc, int fr, int fq) const {
        const bool ctx = u.e >= 32; const int bg = ctx ? u.e - 32 : u.e;
        bf16_t* base = (ctx ? Pctx : Plat) + (size_t)bg * 128 * FP;
        if (ctx) {
            const int col0 = wc * 32 + 8 * fq;
#pragma unroll
            for (int ai = 0; ai < 2; ++ai)
#pragma unroll
                for (int m = 0; m < 4; ++m) { bf16_t* rowp = base + (size_t)(wr * 64 + m * 16 + fr) * FP + ai * CTX + col0;
#pragma unroll
                    for (int bj = 0; bj < 2; ++bj) { const f32x4 v0 = acc[ai][bj][m][0] * (1.f / KREP), v1 = acc[ai][bj][m][1] * (1.f / KREP);
                        u32x4 w; w.x = cvtpk(v0[0], v0[1]); w.y = cvtpk(v0[2], v0[3]); w.z = cvtpk(v1[0], v1[1]); w.w = cvtpk(v1[2], v1[3]); *(u32x4*)(rowp + bj * 128) = w; } }
        } else {
            const int col0 = u.pn * 128 + wc * 32 + 8 * fq;
            const bool sp = u.pn == 0 && wc == 0 && fq == 0;
#pragma unroll
            for (int m = 0; m < 4; ++m) { bf16_t* rowp = base + (size_t)(wr * 64 + m * 16 + fr) * FP + col0;
                f32x4 p0 = (acc[0][0][m][0] + acc[0][1][m][0]) * (1.f / KREP), p1 = (acc[0][0][m][1] + acc[0][1][m][1]) * (1.f / KREP);
                f32x4 q0 = (acc[1][0][m][0] - acc[1][1][m][0]) * (1.f / KREP), q1 = (acc[1][0][m][1] - acc[1][1][m][1]) * (1.f / KREP);
                if (sp) { p0[0] = acc[0][0][m][0][0] * (1.f / KREP); q0[0] = acc[0][1][m][0][0] * (1.f / KREP); }
                u32x4 w; w.x = cvtpk(p0[0], p0[1]); w.y = cvtpk(p0[2], p0[3]); w.z = cvtpk(p1[0], p1[1]); w.w = cvtpk(p1[2], p1[3]); *(u32x4*)rowp = w;
                w.x = cvtpk(q0[0], q0[1]); w.y = cvtpk(q0[2], q0[3]); w.z = cvtpk(q1[0], q1[1]); w.w = cvtpk(q1[2], q1[3]); *(u32x4*)(rowp + 2048) = w; }
        }
    }
};
struct EpiFour2 {
    static constexpr bool PERM = true;
    bf16_t* O;
    __device__ __forceinline__ void operator()(const f32x4 (&acc)[2][2][4][2], const Unit& u, int wr, int wc, int fr, int fq) const {
        EpiStore s{O, DM, (u.pm < 128 ? 0.0013810679320049757f   : 0.005524271728019903f  )};
        s(acc, u, wr, wc, fr, fq);
    }
};

struct SchedDense {
    static constexpr bool MIRROR = false;
    const char* A; const char* B; int nM, nN, nwg, G, c, nkt; size_t tA, tB;
    __device__ __forceinline__ void init(const void* A_, int lda, const void* B_, int ldb, int M, int N, int K, int G_, int c_) {
        A = (const char*)A_; B = (const char*)B_; nM = M / 256; nN = N / 256; nwg = nM * nN; G = G_; c = c_; nkt = K / 64; tA = (size_t)256 * lda * 2; tB = (size_t)256 * ldb * 2; }
    __device__ __forceinline__ bool next(int i, Unit& u) const {
        const long L = (long)i * G + c; if (L >= nwg) return false;
        const int wgid = pg8::xcd_remap((int)L, nwg);
        const int nig = pg8::WGM * nN, gid = wgid / nig, fm = gid * pg8::WGM, gsz = (nM - fm) < pg8::WGM ? (nM - fm) : pg8::WGM;
        u.pm = fm + ((wgid % nig) % gsz); u.pn = (wgid % nig) / gsz; u.e = 0; u.nkt = nkt; return true;
    }
    __device__ __forceinline__ const char* aptr(const Unit& u) const { return A + (size_t)u.pm * tA; }
    __device__ __forceinline__ const char* bptr(const Unit& u) const { return B + (size_t)u.pn * tB; }
};
struct SchedGroup {
    static constexpr bool MIRROR = false;
    const char* A; const char* B; int P1, P2, P3, P4, P5, P6, P7, nRT, nN, nwg, G, c, nkt; size_t tA, tB, gB, aE;
    __device__ __forceinline__ bool next(int i, Unit& u) const {
        const long L = (long)i * G + c; if (L >= nwg) return false;
        const int wgid = pg8::xcd_remap((int)L, nwg);
        const int nig = pg8::WGM * nN, gid = wgid / nig, fm = gid * pg8::WGM, gsz = (nRT - fm) < pg8::WGM ? (nRT - fm) : pg8::WGM;
        const int rt = fm + ((wgid % nig) % gsz);
        u.pm = rt; u.pn = (wgid % nig) / gsz; u.nkt = nkt;
        u.e = (rt >= P1) + (rt >= P2) + (rt >= P3) + (rt >= P4) + (rt >= P5) + (rt >= P6) + (rt >= P7); return true;
    }
    __device__ __forceinline__ const char* aptr(const Unit& u) const {
        if (aE == 0) return A + (size_t)u.pm * tA;
        const int pe = u.e == 0 ? 0 : u.e == 1 ? P1 : u.e == 2 ? P2 : u.e == 3 ? P3 : u.e == 4 ? P4 : u.e == 5 ? P5 : u.e == 6 ? P6 : P7;
        return A + (size_t)u.e * aE + (size_t)(u.pm - pe) * tA; }
    __device__ __forceinline__ const char* bptr(const Unit& u) const { return B + (size_t)u.e * gB + (size_t)u.pn * tB; }
};
struct SchedF1 {
    static constexpr bool MIRROR = true;
    const char* Wp; const char* Z; int G, c;
    __device__ __forceinline__ bool next(int i, Unit& u) const {
        const int L = i * G + c; if (L >= 544) return false;
        u.pm = 0; u.nkt = 2;
        if (L < 512) { u.e = L >> 4; u.pn = L & 15; } else { u.e = 32 + (L - 512); u.pn = 0; }
        return true;
    }
    __device__ __forceinline__ const char* aptr(const Unit&) const { return Wp; }
    __device__ __forceinline__ const char* bptr(const Unit& u) const {
        const bool ctx = u.e >= 32; const int bg = ctx ? u.e - 32 : u.e, b = bg >> 2, gq = bg & 3;
        const size_t row0 = ctx ? (size_t)RL + b * CTX : (size_t)b * SEQ + u.pn * 128;
        return Z + (row0 * MIXIN + gq * 128) * 2; }
    __device__ __forceinline__ const char* bptr2(const Unit& u) const {
        const bool ctx = u.e >= 32; const int bg = ctx ? u.e - 32 : u.e, b = bg >> 2, gq = bg & 3;
        const size_t row0 = ctx ? (size_t)RL + b * CTX + 128 : (size_t)b * SEQ;
        return Z + (row0 * MIXIN + gq * 128) * 2; }
    __device__ __forceinline__ unsigned voff2(const Unit& u, int R, int C, int ldb) const {
        const int tok = u.e >= 32 ? R : (u.pn == 0 && R == 0) ? 2048 : 4096 - 128 * u.pn - R;
        return (unsigned)(tok * ldb + C) * 2u; }
};
struct SchedF2 {
    static constexpr bool MIRROR = false;
    const char* CSl; const char* CSc; const char* Plat; const char* Pctx; int G, vcu;
    static constexpr size_t EB = 2;
    __device__ __forceinline__ bool next(int i, Unit& u) const {
        const int L = i * G + vcu; if (L >= 272) return false;
        if (L < 256) { const int b = L >> 5, mt = (L & 31) >> 1; u.pm = b * 16 + mt; u.pn = L & 1; u.e = b; u.nkt = 64; }
        else { const int b = (L - 256) >> 1; u.pm = 128 + b; u.pn = L & 1; u.e = 8 + b; u.nkt = 8; }
        return true;
    }
    __device__ __forceinline__ const char* aptr(const Unit& u) const { return u.e < 8 ? CSl + (size_t)(u.pm & 15) * 256 * FP * EB : CSc; }
    __device__ __forceinline__ const char* bptr(const Unit& u) const { return (u.e < 8 ? Plat + (size_t)u.e * 512 * FP * EB : Pctx + (size_t)(u.e - 8) * 512 * FP * EB) + (size_t)u.pn * 256 * FP * EB; }
};

#define XB_TMO      128
#define XB_XCNT(j)  (256  + 64 * (j))
#define XB_XSUB(j)  (1280 + 64 * (j))
#define XB_XGEN(j)  (2304 + 64 * (j))
#define XB_TOP      3328
#define XB_TOPGEN   3392
#define XCD_BAR_WORDS 3456
#define XB_SPIN_CAP (1u << 21)
__device__ __forceinline__ unsigned xb_ld(unsigned* p)              { return __hip_atomic_load(p, __ATOMIC_RELAXED, __HIP_MEMORY_SCOPE_AGENT); }
__device__ __forceinline__ unsigned xb_add(unsigned* p, unsigned v) { return __hip_atomic_fetch_add(p, v, __ATOMIC_RELAXED, __HIP_MEMORY_SCOPE_AGENT); }
__device__ __forceinline__ unsigned xb_xcc_id() { return (unsigned)__builtin_amdgcn_s_getreg((3 << 11) | 20) & 0xFu; }
#define XB_SPIN(cond, bar) do { unsigned _sp = 0; while (cond) { __builtin_amdgcn_s_sleep(1); \
    if ((++_sp & 255u) == 0u) { if (xb_ld(&(bar)[XB_TMO])) break; if (_sp > XB_SPIN_CAP) { atomicAdd(&(bar)[XB_TMO], 1u); break; } } } } while (0)
struct XcdBarrier { unsigned* bar; unsigned x; volatile LAS unsigned* st; };
__device__ __forceinline__ XcdBarrier xcd_barrier_post(unsigned* bar, volatile LAS unsigned* st) {
    XcdBarrier b; b.bar = bar; b.x = xb_xcc_id(); b.st = st;
    if (threadIdx.x == 0) (void)xb_add(&bar[XB_XCNT(b.x)], 1u);
    return b;
}
__device__ __forceinline__ void xcd_barrier_complete(unsigned* bar, unsigned x, unsigned& nloc, unsigned& nx) {
    const unsigned G = gridDim.x * gridDim.y * gridDim.z;
    unsigned sum, cnt, mine, sp = 0u;
    for (;;) {
        sum = 0u; cnt = 0u; mine = 0u;
#pragma unroll
        for (unsigned j = 0; j < 16; ++j) { const unsigned c = xb_ld(&bar[XB_XCNT(j)]); sum += c; cnt += (c > 0u) ? 1u : 0u; mine = (j == x) ? c : mine; }
        if (sum == G) break;
        __builtin_amdgcn_s_sleep(1);
        if ((++sp & 255u) == 0u) { if (xb_ld(&bar[XB_TMO])) break; if (sp > XB_SPIN_CAP) { atomicAdd(&bar[XB_TMO], 1u); break; } }
    }
    nloc = mine > 0u ? mine : 1u; nx = cnt > 0u ? cnt : 1u;
}
__device__ __forceinline__ void xcd_barrier(const XcdBarrier& b) {
    asm volatile("s_waitcnt vmcnt(0)" ::: "memory");
    __syncthreads();
    if (threadIdx.x == 0) {
        unsigned* bar = (unsigned*)uptr((const char*)b.bar);
        __builtin_amdgcn_s_waitcnt(0);
        unsigned nloc = b.st[0], nx = b.st[1];
        if (nloc == 0u) { xcd_barrier_complete(bar, b.x, nloc, nx); b.st[0] = nloc; b.st[1] = nx; }
        const unsigned old = xb_add(&bar[XB_XSUB(b.x)], 1u);
        const unsigned gen = old / nloc;
        if (old + 1u == (gen + 1u) * nloc) {
            __builtin_amdgcn_fence(__ATOMIC_RELEASE, "agent");
            asm volatile("s_waitcnt vmcnt(0)" ::: "memory");
            const unsigned og = xb_add(&bar[XB_TOP], 1u);
            const unsigned tg = og / nx;
            if (og + 1u == (tg + 1u) * nx) xb_add(&bar[XB_TOPGEN], 1u);
            else XB_SPIN(xb_ld(&bar[XB_TOPGEN]) == tg, bar);
            __builtin_amdgcn_fence(__ATOMIC_ACQUIRE, "agent");
            xb_add(&bar[XB_XGEN(b.x)], 1u);
            asm volatile("s_waitcnt vmcnt(0)" ::: "memory");
        } else {
            XB_SPIN(xb_ld(&bar[XB_XGEN(b.x)]) == gen, bar);
            __builtin_amdgcn_fence(__ATOMIC_ACQUIRE, "agent");
            asm volatile("s_waitcnt vmcnt(0)" ::: "memory");
        }
    }
    __syncthreads();
}

__device__ __forceinline__ int crow(int r, int hi) { return (r & 3) + 8 * (r >> 2) + 4 * hi; }
template <int KW> __device__ __forceinline__ int kswz(int row, int colB) { return KW == 128 ? row * 256 + (colB ^ ((row & 7) << 4)) : row * 128 + (colB ^ (((row >> 1) & 7) << 4)); }
template <int DV> __device__ __forceinline__ int v_st(int k, int c) { const int kk = (k & ~0xC) | ((k & 4) << 1) | ((k & 8) >> 1); return ((kk >> 3) * (DV / 32) + (c >> 5)) * 512 + ((kk & 7) * 32 + (c & 31)) * 2; }
__device__ __forceinline__ int v_rd_base(int lane) { return ((lane & 3) << 3) | (((lane >> 2) & 3) << 6) | (((lane >> 4) & 1) << 5) | (((lane >> 5) & 1) << 8); }
template <int OFF> __device__ __forceinline__ s16x4 tr_read(int vb) { s16x4 r; asm volatile("ds_read_b64_tr_b16 %0, %1 offset:%2" : "=&v"(r) : "v"(vb), "i"(OFF) : "memory"); return r; }
template <int DV, int D0> __device__ __forceinline__ void pv_one(f32x16& od, int vb, bf16x8 pa0, bf16x8 pa1, bf16x8 pa2, bf16x8 pa3) {
    constexpr int KS = (DV / 32) * 1024, HF = (DV / 32) * 512;
    const s16x4 l0 = tr_read<D0 * 512 + 0 * KS>(vb), h0 = tr_read<D0 * 512 + 0 * KS + HF>(vb), l1 = tr_read<D0 * 512 + 1 * KS>(vb), h1 = tr_read<D0 * 512 + 1 * KS + HF>(vb);
    const s16x4 l2 = tr_read<D0 * 512 + 2 * KS>(vb), h2 = tr_read<D0 * 512 + 2 * KS + HF>(vb), l3 = tr_read<D0 * 512 + 3 * KS>(vb), h3 = tr_read<D0 * 512 + 3 * KS + HF>(vb);
    asm volatile("s_waitcnt lgkmcnt(0)" ::: "memory"); SBAR();
#define PKV(L, H) (bf16x8){L[0], L[1], L[2], L[3], H[0], H[1], H[2], H[3]}
    od = __builtin_amdgcn_mfma_f32_32x32x16_bf16(pa0, PKV(l0, h0), od, 0, 0, 0);
    od = __builtin_amdgcn_mfma_f32_32x32x16_bf16(pa1, PKV(l1, h1), od, 0, 0, 0);
    od = __builtin_amdgcn_mfma_f32_32x32x16_bf16(pa2, PKV(l2, h2), od, 0, 0, 0);
    od = __builtin_amdgcn_mfma_f32_32x32x16_bf16(pa3, PKV(l3, h3), od, 0, 0, 0);
#undef PKV
}
#define PV_RD(D0, L, H) do { L[0] = tr_read<(D0) * 512 + 0 * KS>(vb); H[0] = tr_read<(D0) * 512 + 0 * KS + HF>(vb); L[1] = tr_read<(D0) * 512 + 1 * KS>(vb); H[1] = tr_read<(D0) * 512 + 1 * KS + HF>(vb); \
    L[2] = tr_read<(D0) * 512 + 2 * KS>(vb); H[2] = tr_read<(D0) * 512 + 2 * KS + HF>(vb); L[3] = tr_read<(D0) * 512 + 3 * KS>(vb); H[3] = tr_read<(D0) * 512 + 3 * KS + HF>(vb); } while (0)
#define PV_MM(od, L, H) do { od = __builtin_amdgcn_mfma_f32_32x32x16_bf16(pa0, PKV(L[0], H[0]), od, 0, 0, 0); od = __builtin_amdgcn_mfma_f32_32x32x16_bf16(pa1, PKV(L[1], H[1]), od, 0, 0, 0); \
    od = __builtin_amdgcn_mfma_f32_32x32x16_bf16(pa2, PKV(L[2], H[2]), od, 0, 0, 0); od = __builtin_amdgcn_mfma_f32_32x32x16_bf16(pa3, PKV(L[3], H[3]), od, 0, 0, 0); } while (0)
#define PKV(L, H) (bf16x8){L[0], L[1], L[2], L[3], H[0], H[1], H[2], H[3]}
template <int DV> __device__ __forceinline__ void pv_all(f32x16* o, int vb, bf16x8 pa0, bf16x8 pa1, bf16x8 pa2, bf16x8 pa3) {
    constexpr int KS = (DV / 32) * 1024, HF = (DV / 32) * 512;
    s16x4 la[4], ha[4], lb[4], hb[4];
    PV_RD(0, la, ha);
    PV_RD(1, lb, hb); asm volatile("s_waitcnt lgkmcnt(8)" ::: "memory"); SBAR(); PV_MM(o[0], la, ha);
    if constexpr (DV == 128) {
        PV_RD(2, la, ha); asm volatile("s_waitcnt lgkmcnt(8)" ::: "memory"); SBAR(); PV_MM(o[1], lb, hb);
        PV_RD(3, lb, hb); asm volatile("s_waitcnt lgkmcnt(8)" ::: "memory"); SBAR(); PV_MM(o[2], la, ha);
        asm volatile("s_waitcnt lgkmcnt(0)" ::: "memory"); SBAR(); PV_MM(o[3], lb, hb);
    } else {
        asm volatile("s_waitcnt lgkmcnt(0)" ::: "memory"); SBAR(); PV_MM(o[1], lb, hb);
    }
}
#undef PV_RD
#undef PV_MM
#undef PKV
template <int KW> __device__ __forceinline__ void qkt64(f32x16& p0, f32x16& p1, const char* Ks, const bf16x8* qr, int kcb, int r32, int hi) {
    bf16x8 kb0[4], kb1[4];
#pragma unroll
    for (int d0 = 0; d0 < 4; ++d0) { const int cb = kcb + (d0 * 16 + hi * 8) * 2;
        kb0[d0] = *reinterpret_cast<const bf16x8*>(Ks + kswz<KW>(r32, cb));
        kb1[d0] = *reinterpret_cast<const bf16x8*>(Ks + kswz<KW>(32 + r32, cb)); }
    p0 = f32x16{}; p1 = f32x16{};
#pragma unroll
    for (int d0 = 0; d0 < 4; ++d0) {
        p0 = __builtin_amdgcn_mfma_f32_32x32x16_bf16(kb0[d0], qr[d0], p0, 0, 0, 0);
        p1 = __builtin_amdgcn_mfma_f32_32x32x16_bf16(kb1[d0], qr[d0], p1, 0, 0, 0); }
}
__device__ __forceinline__ void qkt64_f8(f32x16& p0, f32x16& p1, const char* Ks, v8i_t qf, int g0, int r32, const f32x16& cinit) {
    const int sw = r32 & 7; const char* kr = Ks + r32 * 128;
    const u32x4 a0 = *reinterpret_cast<const u32x4*>(kr + ((g0 ^ sw) << 4)), a1 = *reinterpret_cast<const u32x4*>(kr + (((g0 + 1) ^ sw) << 4));
    const u32x4 b0 = *reinterpret_cast<const u32x4*>(kr + 4096 + ((g0 ^ sw) << 4)), b1 = *reinterpret_cast<const u32x4*>(kr + 4096 + (((g0 + 1) ^ sw) << 4));
    const v8i_t A0 = {(int)a0.x, (int)a0.y, (int)a0.z, (int)a0.w, (int)a1.x, (int)a1.y, (int)a1.z, (int)a1.w}, A1 = {(int)b0.x, (int)b0.y, (int)b0.z, (int)b0.w, (int)b1.x, (int)b1.y, (int)b1.z, (int)b1.w};
    p0 = __builtin_amdgcn_mfma_scale_f32_32x32x64_f8f6f4(A0, qf, cinit, 0, 0, 0, 0, 0, 0);
    p1 = __builtin_amdgcn_mfma_scale_f32_32x32x64_f8f6f4(A1, qf, cinit, 0, 0, 0, 0, 0, 0);
}
template <int KW> __device__ __forceinline__ void qkt64n(f32x16& p0, f32x16& p1, const char* Ks, const bf16x8* qr, int kcb, int r32, int hi, const f32x16& cinit) {
#pragma unroll
    for (int d0 = 0; d0 < 4; ++d0) { const int cb = kcb + (d0 * 16 + hi * 8) * 2;
        const bf16x8 b0 = *reinterpret_cast<const bf16x8*>(Ks + kswz<KW>(r32, cb));
        const bf16x8 b1 = *reinterpret_cast<const bf16x8*>(Ks + kswz<KW>(32 + r32, cb));
        if (d0 == 0) { p0 = __builtin_amdgcn_mfma_f32_32x32x16_bf16(b0, qr[0], cinit, 0, 0, 0); p1 = __builtin_amdgcn_mfma_f32_32x32x16_bf16(b1, qr[0], cinit, 0, 0, 0); }
        else { p0 = __builtin_amdgcn_mfma_f32_32x32x16_bf16(b0, qr[d0], p0, 0, 0, 0); p1 = __builtin_amdgcn_mfma_f32_32x32x16_bf16(b1, qr[d0], p1, 0, 0, 0); } }
}
template <int ND> __device__ __forceinline__ void softmax_step(f32x16& p0, f32x16& p1, float& m_reg, float& l_reg, f32x16* o, float* al_l, int r32, int hi,
                                                              bf16x8& pa0, bf16x8& pa1, bf16x8& pa2, bf16x8& pa3) {
    float pmax = p0[0];
#pragma unroll
    for (int r = 1; r < 16; ++r) pmax = fmaxf(pmax, p0[r]);
#pragma unroll
    for (int r = 0; r < 16; ++r) pmax = fmaxf(pmax, p1[r]);
    { auto rr = __builtin_amdgcn_permlane32_swap(__float_as_uint(pmax), __float_as_uint(pmax), false, false); pmax = fmaxf(__uint_as_float(rr[0]), __uint_as_float(rr[1])); }
    const float mn = fmaxf(m_reg, pmax);
    const float alpha = __builtin_amdgcn_exp2f((m_reg - mn) * QK_C); m_reg = mn;
    const float mnC = -mn * QK_C;
#pragma unroll
    for (int r = 0; r < 16; ++r) { p0[r] = __builtin_amdgcn_exp2f(fmaf(p0[r], QK_C, mnC)); p1[r] = __builtin_amdgcn_exp2f(fmaf(p1[r], QK_C, mnC)); }
    float ps = 0.f;
#pragma unroll
    for (int r = 0; r < 16; ++r) ps += p0[r] + p1[r];
    { auto rr = __builtin_amdgcn_permlane32_swap(__float_as_uint(ps), __float_as_uint(ps), false, false); ps = __uint_as_float(rr[0]) + __uint_as_float(rr[1]); }
    l_reg = l_reg * alpha + ps;
    if (__any(alpha < 1.f)) { if (hi == 0) al_l[r32] = alpha; LDS_WAIT();
#pragma unroll
        for (int d = 0; d < ND; ++d)
#pragma unroll
            for (int r = 0; r < 16; ++r) o[d][r] *= al_l[crow(r, hi)];
    }
#define PK4(P, BASE, OUT) do { unsigned a0 = cvtpk(P[BASE + 0], P[BASE + 1]), a1 = cvtpk(P[BASE + 2], P[BASE + 3]);   \
    unsigned b0 = cvtpk(P[BASE + 4], P[BASE + 5]), b1 = cvtpk(P[BASE + 6], P[BASE + 7]);                              \
    auto r0 = __builtin_amdgcn_permlane32_swap(a0, b0, false, false); auto r1 = __builtin_amdgcn_permlane32_swap(a1, b1, false, false); \
    u32x4 w = {r0[0], r1[0], r0[1], r1[1]}; OUT = *reinterpret_cast<bf16x8*>(&w); } while (0)
    PK4(p0, 0, pa0); PK4(p0, 8, pa1); PK4(p1, 0, pa2); PK4(p1, 8, pa3);
#undef PK4
}

constexpr int AT_K = 0, AT_V = 16384, AT_WS = 32768, AT_XCH = 36864;

__device__ __forceinline__ void win_attn_unit(char* lds, const bf16_t* Z, bf16_t* Y, const float* sink, int b, int kvh, int qc, bool ctxq) {
    const int tid = opaque(threadIdx.x), wid = __builtin_amdgcn_readfirstlane(tid >> 6), lane = tid & 63, r32 = lane & 31, hi = lane >> 5;
    const int head = kvh * 4 + (wid >> 1), qsub = wid & 1;
    const int q0 = qc * 64;
    const size_t qrow0 = (ctxq ? (size_t)RL + b * CTX : (size_t)b * SEQ) + q0 + qsub * 32;
    float* wsf = (float*)(lds + AT_WS) + wid * 128; float* al_l = wsf; float* li_l = wsf + 32;
    bf16x8 qr[4];
    { const bf16_t* qp = Z + (qrow0 + r32) * MIXIN + 512 + head * 64 + hi * 8;
#pragma unroll
      for (int d0 = 0; d0 < 4; ++d0) qr[d0] = *reinterpret_cast<const bf16x8*>(qp + d0 * 16); }
    float m_reg = -1e30f, l_reg = 0.f; f32x16 o[2] = {};
    const int srow = tid >> 3, scol = (tid & 7) * 8;
    const int vb = (int)(uintptr_t)(lds + AT_V) + v_rd_base(lane);
    const int qrel = qsub * 32 + r32;
    const int NT = ctxq ? 4 : 9;
    for (int t = 0; t < NT; ++t) {
        size_t krow; int mode = 0;
        if (t < 4) krow = (size_t)RL + b * CTX + t * 64;
        else { const int p0 = q0 - 128 + (t - 4) * 64; if (p0 < 0 || p0 >= SEQ) continue; krow = (size_t)b * SEQ + p0; mode = (t == 4) ? 1 : (t == 8) ? 2 : 0; }
        __syncthreads();
        { const bf16_t* kp = Z + (krow + srow) * MIXIN + 1024 + kvh * 64 + scol;
          const bf16x8 kv = *reinterpret_cast<const bf16x8*>(kp), vv = *reinterpret_cast<const bf16x8*>(kp + 128);
          *reinterpret_cast<bf16x8*>(lds + AT_K + kswz<64>(srow, scol * 2)) = kv;
          *reinterpret_cast<bf16x8*>(lds + AT_V + v_st<64>(srow, scol)) = vv; }
        __syncthreads();
        f32x16 p0, p1; qkt64<64>(p0, p1, lds + AT_K, qr, 0, r32, hi);
        if (mode == 1) {
#pragma unroll
            for (int r = 0; r < 16; ++r) { const int kk = crow(r, hi); if (kk < qrel) p0[r] = -1e30f; if (kk + 32 < qrel) p1[r] = -1e30f; } }
        else if (mode == 2) {
#pragma unroll
            for (int r = 0; r < 16; ++r) { const int kk = crow(r, hi); if (kk > qrel) p0[r] = -1e30f; if (kk + 32 > qrel) p1[r] = -1e30f; } }
        bf16x8 pa0, pa1, pa2, pa3;
        softmax_step<2>(p0, p1, m_reg, l_reg, o, al_l, r32, hi, pa0, pa1, pa2, pa3);
        pv_one<64, 0>(o[0], vb, pa0, pa1, pa2, pa3); pv_one<64, 1>(o[1], vb, pa0, pa1, pa2, pa3);
    }
    l_reg += __builtin_amdgcn_exp2f(sink[head] * LOG2E - m_reg * QK_C);
    if (hi == 0) li_l[r32] = l_reg; LDS_WAIT();
    bf16_t* yp = Y + qrow0 * DM + 512 + head * 64;
#pragma unroll
    for (int r = 0; r < 16; ++r) { const int orow = crow(r, hi); const float rl = __builtin_amdgcn_rcpf(li_l[orow]);
#pragma unroll
        for (int d0 = 0; d0 < 2; ++d0) { const unsigned w = cvtpk(o[d0][r] * rl, 0.f); yp[(size_t)orow * DM + d0 * 32 + r32] = (bf16_t)(w & 0xffffu); } }
}

constexpr float DA_THR = 8.f;
constexpr float DA_THRL = DA_THR * LOG2E;
template <bool FIRST> __device__ __forceinline__ void da_partialSM(f32x16& p0, f32x16& p1, float& mhat, f32x16& negm, float& alpha) {
    float pmax = fmaxf(p0[0], p0[1]), pmb = fmaxf(p1[0], p1[1]);
#pragma unroll
    for (int r = 2; r < 16; r += 2) { pmax = fmaxf(fmaxf(pmax, p0[r]), p0[r + 1]); pmb = fmaxf(fmaxf(pmb, p1[r]), p1[r + 1]); }
    pmax = fmaxf(pmax, pmb);
    { auto rr = __builtin_amdgcn_permlane32_swap(__float_as_uint(pmax), __float_as_uint(pmax), false, false); pmax = fmaxf(__uint_as_float(rr[0]), __uint_as_float(rr[1])); }
    alpha = 1.f;
    if (FIRST || !__builtin_expect(__all(pmax <= DA_THRL), 1)) {
        const float dl = FIRST ? pmax : fmaxf(pmax, 0.f);
        mhat += dl; alpha = __builtin_amdgcn_exp2f(-dl);
#pragma unroll
        for (int r = 0; r < 16; ++r) { p0[r] -= dl; p1[r] -= dl; negm[r] = -mhat; }
    }
#pragma unroll
    for (int r = 0; r < 16; ++r) p0[r] = __builtin_amdgcn_exp2f(p0[r]);
}
__device__ __forceinline__ void da_finishSM(f32x16& p0, f32x16& p1, float alpha, float& l_reg, bf16x8& pa0, bf16x8& pa1, bf16x8& pa2, bf16x8& pa3) {
#pragma unroll
    for (int r = 0; r < 16; ++r) p1[r] = __builtin_amdgcn_exp2f(p1[r]);
    float s0 = p0[0], s1 = p0[1], s2 = p0[2], s3 = p0[3];
#pragma unroll
    for (int r = 4; r < 16; r += 4) { s0 += p0[r]; s1 += p0[r + 1]; s2 += p0[r + 2]; s3 += p0[r + 3]; }
#pragma unroll
    for (int r = 0; r < 16; r += 4) { s0 += p1[r]; s1 += p1[r + 1]; s2 += p1[r + 2]; s3 += p1[r + 3]; }
    float ps = (s0 + s1) + (s2 + s3);
    { auto rr = __builtin_amdgcn_permlane32_swap(__float_as_uint(ps), __float_as_uint(ps), false, false); ps = __uint_as_float(rr[0]) + __uint_as_float(rr[1]); }
    l_reg = l_reg * alpha + ps;
#define PK4(P, BASE, OUT) do { unsigned a0 = cvtpk(P[BASE + 0], P[BASE + 1]), a1 = cvtpk(P[BASE + 2], P[BASE + 3]);   \
    unsigned b0 = cvtpk(P[BASE + 4], P[BASE + 5]), b1 = cvtpk(P[BASE + 6], P[BASE + 7]);                              \
    auto r0 = __builtin_amdgcn_permlane32_swap(a0, b0, false, false); auto r1 = __builtin_amdgcn_permlane32_swap(a1, b1, false, false); \
    u32x4 w = {r0[0], r1[0], r0[1], r1[1]}; OUT = *reinterpret_cast<bf16x8*>(&w); } while (0)
    PK4(p0, 0, pa0); PK4(p0, 8, pa1); PK4(p1, 0, pa2); PK4(p1, 8, pa3);
#undef PK4
}
constexpr float DA8_OFF = 5.f, DA8_THRL = 3.f;
template <bool FIRST> __device__ __forceinline__ void da8_partialSM(f32x16& p0, f32x16& p1, float& mhat, f32x16& negm, float& alpha) {
    float pmax = fmaxf(p0[0], p0[1]), pmb = fmaxf(p1[0], p1[1]);
#pragma unroll
    for (int r = 2; r < 16; r += 2) { pmax = fmaxf(fmaxf(pmax, p0[r]), p0[r + 1]); pmb = fmaxf(fmaxf(pmb, p1[r]), p1[r + 1]); }
    pmax = fmaxf(pmax, pmb);
    { auto rr = __builtin_amdgcn_permlane32_swap(__float_as_uint(pmax), __float_as_uint(pmax), false, false); pmax = fmaxf(__uint_as_float(rr[0]), __uint_as_float(rr[1])); }
    alpha = 1.f;
    if (FIRST || !__builtin_expect(__all(pmax <= DA8_OFF + DA8_THRL), 1)) {
        const float dl = FIRST ? pmax - DA8_OFF : fmaxf(pmax - DA8_OFF, 0.f);
        mhat += dl; alpha = __builtin_amdgcn_exp2f(-dl);
#pragma unroll
        for (int r = 0; r < 16; ++r) { p0[r] -= dl; p1[r] -= dl; negm[r] = DA8_OFF - mhat; }
    }
#pragma unroll
    for (int r = 0; r < 16; ++r) p0[r] = __builtin_amdgcn_exp2f(p0[r]);
}
__device__ __forceinline__ void da8_finishSM(f32x16& p0, f32x16& p1, v8i_t& P8) {
#pragma unroll
    for (int r = 0; r < 16; ++r) p1[r] = __builtin_amdgcn_exp2f(p1[r]);
#pragma unroll
    for (int w = 0; w < 4; ++w) { int a = __builtin_amdgcn_cvt_pk_fp8_f32(p0[4 * w], p0[4 * w + 1], 0, false); a = __builtin_amdgcn_cvt_pk_fp8_f32(p0[4 * w + 2], p0[4 * w + 3], a, true); P8[w] = a;
        int c = __builtin_amdgcn_cvt_pk_fp8_f32(p1[4 * w], p1[4 * w + 1], 0, false); c = __builtin_amdgcn_cvt_pk_fp8_f32(p1[4 * w + 2], p1[4 * w + 3], c, true); P8[4 + w] = c; }
}
__device__ __forceinline__ void da8_pv(f32x16* o, const char* Vs, int r32, int hi, v8i_t P8) {
    const int sw = (r32 >> 2) & 3; const char* vr = Vs + r32 * 64; const int o0 = ((hi * 2) ^ sw) << 4, o1 = ((hi * 2 + 1) ^ sw) << 4;
    u32x4 x0[4], x1[4];
#pragma unroll
    for (int db = 0; db < 4; ++db) { x0[db] = *reinterpret_cast<const u32x4*>(vr + db * 2048 + o0); x1[db] = *reinterpret_cast<const u32x4*>(vr + db * 2048 + o1); }
#pragma unroll
    for (int db = 0; db < 4; ++db) { const v8i_t B = {(int)x0[db].x, (int)x0[db].y, (int)x0[db].z, (int)x0[db].w, (int)x1[db].x, (int)x1[db].y, (int)x1[db].z, (int)x1[db].w};
        o[db] = __builtin_amdgcn_mfma_scale_f32_32x32x64_f8f6f4(P8, B, o[db], 0, 0, 0, 0, 0, 0); }
    const v8i_t ones = {0x38383838, 0x38383838, 0x38383838, 0x38383838, 0x38383838, 0x38383838, 0x38383838, 0x38383838};
    o[4] = __builtin_amdgcn_mfma_scale_f32_32x32x64_f8f6f4(P8, ones, o[4], 0, 0, 0, 0, 0, 0);
}
__device__ __forceinline__ void da_pv(f32x16* o, int vb, bf16x8 pa0, bf16x8 pa1, bf16x8 pa2, bf16x8 pa3) {
    pv_all<128>(o, vb, pa0, pa1, pa2, pa3);
}
constexpr int DA_V = 0, DA_K = 49152, DA_WS = 81920, DA_XCH = 0;
__device__ __forceinline__ void diff_attn_unit(char* lds, const unsigned char* VT8, const unsigned char* QK8, bf16_t* O, const float* subg, float lam, float oscale, int b, int h, int qb, bool ctxq) {
    const int tid = opaque(threadIdx.x), wid = __builtin_amdgcn_readfirstlane(tid >> 6), lane = tid & 63, r32 = lane & 31, hi = lane >> 5;
    const int comp = wid >> 2, qsub = wid & 3;
    const size_t qrow0 = (ctxq ? (size_t)RL + b * CTX : (size_t)b * SEQ) + qb * 128 + qsub * 32;
    char* V_lds = lds + DA_V; char* K_lds = lds + DA_K;
    float* wsf = (float*)(lds + DA_WS) + wid * 128; float* al_l = wsf; float* li_l = wsf + 32;
    __syncthreads();
    v8i_t qf;
    { const unsigned char* qp = QK8 + (qrow0 + r32) * 2048 + (2 * h + comp) * 64 + hi * 32;
      const u32x4 q0 = *reinterpret_cast<const u32x4*>(qp), q1 = *reinterpret_cast<const u32x4*>(qp + 16);
      qf = (v8i_t){(int)q0.x, (int)q0.y, (int)q0.z, (int)q0.w, (int)q1.x, (int)q1.y, (int)q1.z, (int)q1.w}; }
    float m_reg = 0.f; f32x16 o[5] = {}; f32x16 negm;
#pragma unroll
    for (int r = 0; r < 16; ++r) negm[r] = DA8_OFF;
    const int kkey = tid >> 3, krow = ((kkey >> 4) & 1) * 32 + (kkey & 3) + 8 * ((kkey & 15) >> 2) + 4 * (kkey >> 5), kst = krow * 128 + ((((tid & 7) ^ (krow & 7))) << 4);
    const unsigned char* kp8 = QK8 + (size_t)kkey * 2048 + 1024 + h * 128 + (tid & 7) * 16;
    const int kg0 = comp * 4 + hi * 2;
    const unsigned char* vt8 = VT8 + (size_t)(b * 8 + h) * 68 * 8192 + tid * 16;
    const size_t rowc = (size_t)RL + b * CTX, rowl = (size_t)b * SEQ;
    const int NT = ctxq ? 4 : 68;
    u32x4 ks, vs;
#define KROW(t) ((t) < 4 ? rowc + (size_t)(t) * 64 : rowl + (size_t)((t) - 4) * 64)
#define LOADK(t) do { ks = *reinterpret_cast<const u32x4*>(kp8 + KROW(t) * 2048); } while (0)
#define LOADV(t) do { vs = *reinterpret_cast<const u32x4*>(vt8 + (size_t)(t) * 8192); } while (0)
#define WRITEK(bf) do { *reinterpret_cast<u32x4*>(K_lds + (bf) * 8192 + kst) = ks; } while (0)
#define WRITEV(bf) do { *reinterpret_cast<u32x4*>(V_lds + (bf) * 8192 + tid * 16) = vs; } while (0)
#define RESC(a) do { if (__any((a) < 1.f)) { if (hi == 0) al_l[r32] = (a); LDS_WAIT(); \
    _Pragma("unroll") for (int d = 0; d < 5; ++d) _Pragma("unroll") for (int r = 0; r < 16; ++r) o[d][r] *= al_l[crow(r, hi)]; } } while (0)
#define QKT(P0, P1, kb) do { qkt64_f8(P0, P1, K_lds + (kb) * 8192, qf, kg0, r32, negm); } while (0)
#define FIN(P0, P1, al) do { da8_finishSM(P0, P1, P8); } while (0)
#define PVT(vi) da8_pv(o, V_lds + (vi) * 8192, r32, hi, P8)
    f32x16 pA0, pA1, pB0, pB1; float alA = 1.f, alB = 1.f; v8i_t P8;
    int vm2 = 1, vm1 = 2, vc = 0;
#define VROT() do { const int t_ = vm2; vm2 = vm1; vm1 = vc; vc = t_; } while (0)
    const bool grpB = comp != 0;
    LOADK(0); VM_WAIT(); WRITEK(0); LOADK(1); LOADV(0); __syncthreads();
    QKT(pA0, pA1, 0);
    if (!grpB) da8_partialSM<true>(pA0, pA1, m_reg, negm, alA);
    VM_WAIT(); WRITEK(1); WRITEV(vc); LOADK(2); LOADV(1); VROT();
    __syncthreads();
    if (grpB) da8_partialSM<true>(pA0, pA1, m_reg, negm, alA);
    QKT(pB0, pB1, 1); FIN(pA0, pA1, alA);
    if (!grpB) { PVT(vm1); da8_partialSM<false>(pB0, pB1, m_reg, negm, alB); RESC(alB); }
    VM_WAIT(); WRITEK(0); WRITEV(vc); LOADK(3); LOADV(2); VROT();
    __syncthreads();
    for (int j = 2; j + 1 < NT; j += 2) {
        if (grpB) { PVT(vm2); da8_partialSM<false>(pB0, pB1, m_reg, negm, alB); RESC(alB); }
        QKT(pA0, pA1, 0); FIN(pB0, pB1, alB);
        if (!grpB) { PVT(vm1); da8_partialSM<false>(pA0, pA1, m_reg, negm, alA); RESC(alA); }
        VM_WAIT(); WRITEK(1); WRITEV(vc); if (j + 2 < NT) LOADK(j + 2); LOADV(j + 1); VROT();
        __syncthreads();
        if (grpB) { PVT(vm2); da8_partialSM<false>(pA0, pA1, m_reg, negm, alA); RESC(alA); }
        QKT(pB0, pB1, 1); FIN(pA0, pA1, alA);
        if (!grpB) { PVT(vm1); da8_partialSM<false>(pB0, pB1, m_reg, negm, alB); RESC(alB); }
        VM_WAIT(); if (j + 2 < NT) { WRITEK(0); } WRITEV(vc); if (j + 3 < NT) LOADK(j + 3); if (j + 2 < NT) LOADV(j + 2); VROT();
        __syncthreads();
    }
    if (grpB) { PVT(vm2); da8_partialSM<false>(pB0, pB1, m_reg, negm, alB); RESC(alB); }
    FIN(pB0, pB1, alB); PVT(vm1);
#undef LOADK
#undef LOADV
#undef WRITEK
#undef WRITEV
#undef QKT
#undef FIN
#undef PVT
#undef VROT
#define SLOAD(a, b)
#define SWRITE(a, b)
#define SWAIT()
#undef KROW
#undef SLOAD
#undef SWRITE
#undef SWAIT
#undef RESC
    float rl[16];
#pragma unroll
    for (int r = 0; r < 16; ++r) rl[r] = __builtin_amdgcn_rcpf(o[4][r]);
    __syncthreads();
    float* xch = (float*)(lds + DA_XCH) + qsub * (32 * 132);
    if (comp == 1) {
#pragma unroll
        for (int d0 = 0; d0 < 4; ++d0)
#pragma unroll
            for (int r = 0; r < 16; ++r) xch[crow(r, hi) * 132 + d0 * 32 + r32] = o[d0][r] * rl[r];
    }
    __syncthreads();
    if (comp == 0) {
#pragma unroll
        for (int d0 = 0; d0 < 4; ++d0)
#pragma unroll
            for (int r = 0; r < 16; ++r) { const int idx = crow(r, hi) * 132 + d0 * 32 + r32; const float v = o[d0][r] * rl[r] - lam * xch[idx]; xch[idx] = v; }
        LDS_WAIT();
        const int row = lane >> 1, hf = lane & 1; const float* rp = xch + row * 132 + hf * 64;
        f32x4 v[16]; float ss = 0.f;
#pragma unroll
        for (int j = 0; j < 16; ++j) { v[j] = *reinterpret_cast<const f32x4*>(rp + 4 * j); ss += v[j][0] * v[j][0] + v[j][1] * v[j][1] + v[j][2] * v[j][2] + v[j][3] * v[j][3]; }
        ss += __int_as_float(__builtin_amdgcn_ds_bpermute((lane ^ 1) << 2, __float_as_int(ss)));
        const float rs = __builtin_amdgcn_rsqf(ss * (1.f / 128.f) + EPS) * oscale;
        bf16_t* op = O + (qrow0 + row) * DM + h * 128 + hf * 64;
#pragma unroll
        for (int j = 0; j < 16; j += 2) { const f32x4 g0 = *reinterpret_cast<const f32x4*>(subg + hf * 64 + 4 * j), g1 = *reinterpret_cast<const f32x4*>(subg + hf * 64 + 4 * j + 4);
            const f32x4 a = v[j] * g0 * rs, c = v[j + 1] * g1 * rs;
            u32x4 w; w.x = cvtpk(a[0], a[1]); w.y = cvtpk(a[2], a[3]); w.z = cvtpk(c[0], c[1]); w.w = cvtpk(c[2], c[3]);
            *reinterpret_cast<u32x4*>(op + 4 * j) = w; }
    }
}

constexpr int WA_V = 0, WA_K = 16384, WA_WS = 32768, WA_ST = 36864;
__device__ __forceinline__ void wa_mask(f32x16& p0, f32x16& p1, int mode, int qrel, int hi) {
    if (mode == 1) {
#pragma unroll
        for (int r = 0; r < 16; ++r) { const int kk = crow(r, hi); if (kk < qrel) p0[r] = -1e30f; if (kk + 32 < qrel) p1[r] = -1e30f; } }
    else if (mode == 2) {
#pragma unroll
        for (int r = 0; r < 16; ++r) { const int kk = crow(r, hi); if (kk > qrel) p0[r] = -1e30f; if (kk + 32 > qrel) p1[r] = -1e30f; } }
    else if (mode == 3) {
#pragma unroll
        for (int r = 0; r < 16; ++r) { p0[r] = -1e30f; p1[r] = -1e30f; } }
}
__device__ __forceinline__ void win_attn_unit2(char* lds, const bf16_t* Z, bf16_t* Y, const float* sink, int b, int kvh, int qc, bool ctxq) {
    const int tid = opaque(threadIdx.x), wid = __builtin_amdgcn_readfirstlane(tid >> 6), lane = tid & 63, r32 = lane & 31, hi = lane >> 5;
    const int head = kvh * 4 + (wid >> 1), qsub = wid & 1, q0 = qc * 64;
    const size_t rowc = (size_t)RL + b * CTX, rowl = (size_t)b * SEQ;
    const size_t qrow0 = (ctxq ? rowc : rowl) + q0 + qsub * 32;
    char* V_lds = lds + WA_V; char* K_lds = lds + WA_K;
    float* wsf = (float*)(lds + WA_WS) + wid * 128; float* al_l = wsf; float* li_l = wsf + 32;
    __syncthreads();
    bf16x8 qr[4];
    { const bf16_t* qp = Z + (qrow0 + r32) * MIXIN + 512 + head * 64 + hi * 8;
#pragma unroll
      for (int d0 = 0; d0 < 4; ++d0) qr[d0] = *reinterpret_cast<const bf16x8*>(qp + d0 * 16); }
    float m_reg = 0.f, l_reg = 0.f; f32x16 o[2] = {}; f32x16 negm = {};
    const int srow = tid >> 3, scol = (tid & 7) * 8, vst = v_st<64>(srow, scol), kst = kswz<64>(srow, scol * 2);
    const int vb0 = (int)(uintptr_t)V_lds + v_rd_base(lane);
    const bf16_t* kvp = Z + (size_t)srow * MIXIN + 1024 + kvh * 64 + scol;
    const int skip_lo = ctxq ? 0 : (q0 == 0 ? 2 : q0 == 64 ? 1 : 0);
    const int nloc = ctxq ? 0 : 5 - skip_lo - (q0 == SEQ - 64 ? 2 : q0 == SEQ - 128 ? 1 : 0);
    const int NTr = 4 + nloc, NT = (NTr + 1) & ~1;
    const int qrel = qsub * 32 + r32;
    struct { bf16x8 vs, ks; } sr_;
#define KROW(t) ((t) < 4 ? rowc + (size_t)(t) * 64 : (t) < NTr ? rowl + (size_t)(q0 - 128 + ((t) - 4 + skip_lo) * 64) : rowc)
#define TMODE(t) ((t) < 4 ? 0 : (t) >= NTr ? 3 : ((t) - 4 + skip_lo) == 0 ? 1 : ((t) - 4 + skip_lo) == 4 ? 2 : 0)
#define SLOAD(t) do { const bf16_t* p_ = kvp + KROW(t) * MIXIN; sr_.ks = *reinterpret_cast<const bf16x8*>(p_); sr_.vs = *reinterpret_cast<const bf16x8*>(p_ + 128); } while (0)
#define SWRITE(bf) do { *reinterpret_cast<bf16x8*>(V_lds + (bf) * 8192 + vst) = sr_.vs; *reinterpret_cast<bf16x8*>(K_lds + (bf) * 8192 + kst) = sr_.ks; } while (0)
#define SWAIT() asm volatile("s_waitcnt vmcnt(0)" ::: "memory")
#define RESC(a) do { if (__any((a) < 1.f)) { if (hi == 0) al_l[r32] = (a); LDS_WAIT(); \
    _Pragma("unroll") for (int d = 0; d < 2; ++d) _Pragma("unroll") for (int r = 0; r < 16; ++r) o[d][r] *= al_l[crow(r, hi)]; } } while (0)
#define WPV(vb) pv_all<64>(o, (vb), pa0, pa1, pa2, pa3)
    f32x16 pA0, pA1, pB0, pB1; float alA, alB; bf16x8 pa0, pa1, pa2, pa3;
    SLOAD(0); VM_WAIT(); SWRITE(0); __syncthreads();
    qkt64n<64>(pA0, pA1, K_lds, qr, 0, r32, hi, negm); da_partialSM<true>(pA0, pA1, m_reg, negm, alA);
    SLOAD(1);
    SWAIT(); SWRITE(1); __syncthreads();
    for (int j = 1; j + 1 < NT; j += 2) {
        SBAR(); qkt64n<64>(pB0, pB1, K_lds + 8192, qr, 0, r32, hi, negm);
        da_finishSM(pA0, pA1, alA, l_reg, pa0, pa1, pa2, pa3); SBAR();
        SLOAD(j + 1); SBAR();
        WPV(vb0); wa_mask(pB0, pB1, TMODE(j), qrel, hi); da_partialSM<false>(pB0, pB1, m_reg, negm, alB);
        __syncthreads(); SWAIT(); SWRITE(0);
        RESC(alB); __syncthreads();
        SBAR(); qkt64n<64>(pA0, pA1, K_lds, qr, 0, r32, hi, negm);
        da_finishSM(pB0, pB1, alB, l_reg, pa0, pa1, pa2, pa3); SBAR();
        SLOAD(j + 2); SBAR();
        WPV(vb0 + 8192); wa_mask(pA0, pA1, TMODE(j + 1), qrel, hi); da_partialSM<false>(pA0, pA1, m_reg, negm, alA);
        __syncthreads(); SWAIT(); SWRITE(1);
        RESC(alA); __syncthreads();
    }
    SBAR(); qkt64n<64>(pB0, pB1, K_lds + 8192, qr, 0, r32, hi, negm);
    da_finishSM(pA0, pA1, alA, l_reg, pa0, pa1, pa2, pa3); SBAR();
    WPV(vb0); wa_mask(pB0, pB1, TMODE(NT - 1), qrel, hi); da_partialSM<false>(pB0, pB1, m_reg, negm, alB);
    __syncthreads(); RESC(alB);
    da_finishSM(pB0, pB1, alB, l_reg, pa0, pa1, pa2, pa3); SBAR();
    WPV(vb0 + 8192);
#undef KROW
#undef TMODE
#undef SLOAD
#undef SWRITE
#undef SWAIT
#undef RESC
#undef WPV
    l_reg += __builtin_amdgcn_exp2f(sink[head] * LOG2E - m_reg);
    if (hi == 0) li_l[r32] = l_reg; LDS_WAIT();
    bf16_t* stg = (bf16_t*)(lds + WA_ST) + wid * 2048;
#pragma unroll
    for (int r = 0; r < 16; ++r) { const int orow = crow(r, hi); const float rl = __builtin_amdgcn_rcpf(li_l[orow]);
#pragma unroll
        for (int d0 = 0; d0 < 2; ++d0) stg[orow * 64 + d0 * 32 + r32] = (bf16_t)(cvtpk(o[d0][r] * rl, 0.f) & 0xffffu); }
    LDS_WAIT();
    bf16_t* yp = Y + qrow0 * DM + 512 + head * 64;
#pragma unroll
    for (int i = 0; i < 4; ++i) { const int row = i * 8 + (lane >> 3), ch = lane & 7; const u32x4 v = *reinterpret_cast<const u32x4*>(stg + row * 64 + ch * 8); *reinterpret_cast<u32x4*>(yp + (size_t)row * DM + ch * 8) = v; }
}

struct Args {
    const float *x, *c, *ctx, *c_ctx, *ada_w, *ada_b, *norm_g, *mix_in_w, *mix_out_w, *win_sink, *diff_qkv_w, *diff_out_w, *diff_lambda, *diff_subln_g,
                *ffn_in_w, *ffn_out_w, *router_w, *expert_in_w, *expert_out_w;
    float* out; unsigned char* ws; int ph_lo, ph_hi;
};
struct Frame {
    LAS unsigned char* lds; unsigned char* ldsg; volatile LAS unsigned* MISC; unsigned* ctl;
    int tid, lane, wave, vcu, G;
};

__device__ __forceinline__ unsigned f2bf(float f) { unsigned u = __builtin_bit_cast(unsigned, f); return (u + 0x7fffu + ((u >> 16) & 1u)) >> 16; }
__device__ __forceinline__ unsigned pk2(float lo, float hi) { return f2bf(lo) | (f2bf(hi) << 16); }
__device__ __forceinline__ void transpose_item(const float* W, int K, int N, bf16_t* WT, int n0, int c0, int k0, LAS float* scr, int lane) {
#pragma unroll 8
    for (int i = 0; i < 32; ++i) { const int kk = 2 * i + (lane >> 5); scr[kk * 33 + (lane & 31)] = W[(size_t)(k0 + kk) * N + c0 + (lane & 31)]; }
    LDS_WAIT(); asm volatile("" ::: "memory");
    const int c = lane & 7;
#pragma unroll
    for (int j = 0; j < 4; ++j) { const int n = (lane >> 3) + 8 * j; const LAS float* s = scr + (8 * c) * 33 + n;
        u32x4 o; o.x = pk2(s[0 * 33], s[1 * 33]); o.y = pk2(s[2 * 33], s[3 * 33]); o.z = pk2(s[4 * 33], s[5 * 33]); o.w = pk2(s[6 * 33], s[7 * 33]);
        *(u32x4*)(WT + (size_t)(n0 + n) * K + k0 + 8 * c) = o; }
    LDS_WAIT(); asm volatile("" ::: "memory");
}
__device__ __forceinline__ void transpose_item_f8(const float* W, int K, int N, unsigned char* WT, int n0, int c0, int k0, LAS float* scr, int lane) {
#pragma unroll 8
    for (int i = 0; i < 32; ++i) { const int kk = 2 * i + (lane >> 5); scr[kk * 33 + (lane & 31)] = W[(size_t)(k0 + kk) * N + c0 + (lane & 31)] * F8_SW; }
    LDS_WAIT(); asm volatile("" ::: "memory");
    const int c = lane & 7;
#pragma unroll
    for (int j = 0; j < 4; ++j) { const int n = (lane >> 3) + 8 * j; const LAS float* s = scr + (8 * c) * 33 + n;
        u32x2 o; o.x = pk4_fp8(s[0 * 33], s[1 * 33], s[2 * 33], s[3 * 33]); o.y = pk4_fp8(s[4 * 33], s[5 * 33], s[6 * 33], s[7 * 33]);
        *(u32x2*)(WT + (size_t)(n0 + n) * K + k0 + 8 * c) = o; }
    LDS_WAIT(); asm volatile("" ::: "memory");
}
__device__ __forceinline__ bool transpose_job(int& r, const float* W, int nb, int K, int N, void* WT, bool glu, bool f8, LAS float* scr, int lane) {
    const int nblk = N / 32, per = (K / 64) * nblk, tot = nb * per;
    if (r >= tot) { r -= tot; return false; }
    const int mtx = r / per, it = r % per, kb = it / nblk, nbk = it % nblk, n0 = 32 * nbk;
    int c0 = n0;
    if (glu) { const int tile = n0 >> 8, w = n0 & 255; c0 = (w < 128) ? tile * 128 + w : (N >> 1) + tile * 128 + (w - 128); }
    if (f8) transpose_item_f8(W + (size_t)mtx * K * N, K, N, (unsigned char*)WT + (size_t)mtx * K * N, n0, c0, 64 * kb, scr, lane);
    else transpose_item(W + (size_t)mtx * K * N, K, N, (bf16_t*)WT + (size_t)mtx * K * N, n0, c0, 64 * kb, scr, lane);
    return true;
}

struct ThinP {
    int nrows;
    const void* xin_lat; const void* xin_ctx;
    void* xout_lat; void* xout_ctx;
    bool xin16, xout16;
    int ymode;
    const bf16_t* Ysrc; const float* gate; const float* ga;
    bool h8;
    bf16_t* H; const float* gb; const float* shsc;
    const float* router; int* route; unsigned* cnt;
    unsigned char* HSv;
};
#define TH_DECL(PFX) f32x4 PFX##x0 = {}, PFX##x1 = {}, PFX##x2 = {}, PFX##x3 = {}; u32x2 PFX##xh0 = {}, PFX##xh1 = {}, PFX##xh2 = {}, PFX##xh3 = {}; u32x2 PFX##ya0 = {}, PFX##ya1 = {}, PFX##ya2 = {}, PFX##ya3 = {}, PFX##yb0 = {}, PFX##yb1 = {}, PFX##yb2 = {}, PFX##yb3 = {}; float PFX##w0 = 0.f, PFX##w1 = 0.f
#define TH_LOAD(PFX, r_, it_) do { const int rr_ = (r_); \
    if (P.xin16) { const bf16_t* xr_ = (rr_ < RL ? (const bf16_t*)P.xin_lat + (size_t)rr_ * DM : (const bf16_t*)P.xin_ctx + (size_t)(rr_ - RL) * DM) + 4 * lane; \
        PFX##xh0 = __builtin_nontemporal_load(reinterpret_cast<const u32x2*>(xr_)); PFX##xh1 = __builtin_nontemporal_load(reinterpret_cast<const u32x2*>(xr_ + 256)); PFX##xh2 = __builtin_nontemporal_load(reinterpret_cast<const u32x2*>(xr_ + 512)); PFX##xh3 = __builtin_nontemporal_load(reinterpret_cast<const u32x2*>(xr_ + 768)); } \
    else { const float* xr_ = (rr_ < RL ? (const float*)P.xin_lat + (size_t)rr_ * DM : (const float*)P.xin_ctx + (size_t)(rr_ - RL) * DM) + 4 * lane; \
        PFX##x0 = __builtin_nontemporal_load(reinterpret_cast<const f32x4*>(xr_)); PFX##x1 = __builtin_nontemporal_load(reinterpret_cast<const f32x4*>(xr_ + 256)); PFX##x2 = __builtin_nontemporal_load(reinterpret_cast<const f32x4*>(xr_ + 512)); PFX##x3 = __builtin_nontemporal_load(reinterpret_cast<const f32x4*>(xr_ + 768)); } \
    const bf16_t* ya_ = P.Ysrc; const bf16_t* yb_ = P.Ysrc; \
    if (P.ymode == 1) ya_ = P.Ysrc + (size_t)rr_ * DM; \
    else if (P.ymode == 2) { const LAS int* rt_ = rtl + (it_) * 6; \
        const int e0_ = rt_[0], p0_ = rt_[1], e1_ = rt_[2], p1_ = rt_[3]; PFX##w0 = __int_as_float(rt_[4]); PFX##w1 = __int_as_float(rt_[5]); \
        const unsigned b0_ = e0_ == 0 ? 0u : e0_ == 1 ? cb1 : e0_ == 2 ? cb2 : e0_ == 3 ? cb3 : e0_ == 4 ? cb4 : e0_ == 5 ? cb5 : e0_ == 6 ? cb6 : cb7; \
        const unsigned b1_ = e1_ == 0 ? 0u : e1_ == 1 ? cb1 : e1_ == 2 ? cb2 : e1_ == 3 ? cb3 : e1_ == 4 ? cb4 : e1_ == 5 ? cb5 : e1_ == 6 ? cb6 : cb7; \
        ya_ = P.Ysrc + (size_t)(b0_ + p0_) * DM; yb_ = P.Ysrc + (size_t)(b1_ + p1_) * DM; } \
    if (P.ymode) { ya_ += 4 * lane; PFX##ya0 = __builtin_nontemporal_load(reinterpret_cast<const u32x2*>(ya_)); PFX##ya1 = __builtin_nontemporal_load(reinterpret_cast<const u32x2*>(ya_ + 256)); PFX##ya2 = __builtin_nontemporal_load(reinterpret_cast<const u32x2*>(ya_ + 512)); PFX##ya3 = __builtin_nontemporal_load(reinterpret_cast<const u32x2*>(ya_ + 768)); } \
    if (P.ymode == 2) { yb_ += 4 * lane; PFX##yb0 = __builtin_nontemporal_load(reinterpret_cast<const u32x2*>(yb_)); PFX##yb1 = __builtin_nontemporal_load(reinterpret_cast<const u32x2*>(yb_ + 256)); PFX##yb2 = __builtin_nontemporal_load(reinterpret_cast<const u32x2*>(yb_ + 512)); PFX##yb3 = __builtin_nontemporal_load(reinterpret_cast<const u32x2*>(yb_ + 768)); } \
    } while (0)
#define TH_ARGS(PFX) PFX##x0, PFX##x1, PFX##x2, PFX##x3, PFX##xh0, PFX##xh1, PFX##xh2, PFX##xh3, PFX##ya0, PFX##ya1, PFX##ya2, PFX##ya3, PFX##yb0, PFX##yb1, PFX##yb2, PFX##yb3, PFX##w0, PFX##w1
__device__ __forceinline__ void thin_proc(const ThinP& P, f32x4 x0, f32x4 x1, f32x4 x2, f32x4 x3, u32x2 xh0, u32x2 xh1, u32x2 xh2, u32x2 xh3, u32x2 ya0, u32x2 ya1, u32x2 ya2, u32x2 ya3, u32x2 yb0, u32x2 yb1, u32x2 yb2, u32x2 yb3, float yw0, float yw1,
                                          f32x4 GA0, f32x4 GA1, f32x4 GA2, f32x4 GA3, f32x4 GB0, f32x4 GB1, f32x4 GB2, f32x4 GB3, f32x4 SH0, f32x4 SH1, f32x4 SH2, f32x4 SH3,
                                          int r, int li, int lane, LAS float* rwT, LAS int* rec, LAS unsigned* lcnt) {
    const int idx = r < RL ? (r >> 12) : 8;
#define BF4(w) ((f32x4){bf_lo((w).x), bf_hi((w).x), bf_lo((w).y), bf_hi((w).y)})
    f32x4 xv[4] = {x0, x1, x2, x3};
    if (P.xin16) { xv[0] = BF4(xh0); xv[1] = BF4(xh1); xv[2] = BF4(xh2); xv[3] = BF4(xh3); }
    if (P.ymode) {
        f32x4 yv[4];
        if (P.ymode == 1) { yv[0] = BF4(ya0); yv[1] = BF4(ya1); yv[2] = BF4(ya2); yv[3] = BF4(ya3); }
        else { yv[0] = BF4(ya0) * yw0 + BF4(yb0) * yw1; yv[1] = BF4(ya1) * yw0 + BF4(yb1) * yw1; yv[2] = BF4(ya2) * yw0 + BF4(yb2) * yw1; yv[3] = BF4(ya3) * yw0 + BF4(yb3) * yw1; }
#undef BF4
        float ss = 0.f;
#pragma unroll
        for (int j = 0; j < 4; ++j) ss += yv[j][0] * yv[j][0] + yv[j][1] * yv[j][1] + yv[j][2] * yv[j][2] + yv[j][3] * yv[j][3];
        const float rs = __builtin_amdgcn_rsqf(wave_sum(ss, lane) * (1.f / DM) + EPS);
        xv[0] = xv[0] + GA0 * (yv[0] * rs); xv[1] = xv[1] + GA1 * (yv[1] * rs); xv[2] = xv[2] + GA2 * (yv[2] * rs); xv[3] = xv[3] + GA3 * (yv[3] * rs);
    }
    if (P.xout_lat) {
        if (P.xout16) { bf16_t* xo = r < RL ? (bf16_t*)P.xout_lat + (size_t)r * DM : (bf16_t*)P.xout_ctx + (size_t)(r - RL) * DM;
#pragma unroll
            for (int j = 0; j < 4; ++j) { u32x2 w; w.x = cvtpk(xv[j][0], xv[j][1]); w.y = cvtpk(xv[j][2], xv[j][3]); __builtin_nontemporal_store(w, reinterpret_cast<u32x2*>(xo + 4 * lane + 256 * j)); } }
        else { float* xo = r < RL ? (float*)P.xout_lat + (size_t)r * DM : (float*)P.xout_ctx + (size_t)(r - RL) * DM;
#pragma unroll
            for (int j = 0; j < 4; ++j) __builtin_nontemporal_store(xv[j], reinterpret_cast<f32x4*>(xo + 4 * lane + 256 * j)); } }
    if (P.H) {
        float ss = 0.f;
#pragma unroll
        for (int j = 0; j < 4; ++j) ss += xv[j][0] * xv[j][0] + xv[j][1] * xv[j][1] + xv[j][2] * xv[j][2] + xv[j][3] * xv[j][3];
        const float rs = __builtin_amdgcn_rsqf(wave_sum(ss, lane) * (1.f / DM) + EPS);
        bf16_t* hr = P.H + (size_t)r * DM;
        f32x4 hv[4] = {xv[0] * rs * GB0 + SH0, xv[1] * rs * GB1 + SH1, xv[2] * rs * GB2 + SH2, xv[3] * rs * GB3 + SH3};
#pragma unroll
        for (int j = 0; j < 4; ++j) {
            if (P.h8) { *reinterpret_cast<unsigned*>((unsigned char*)P.H + (size_t)r * DM + 4 * lane + 256 * j) = pk4_fp8(hv[j][0] * F8_SH, hv[j][1] * F8_SH, hv[j][2] * F8_SH, hv[j][3] * F8_SH); }
            else { u32x2 w; w.x = cvtpk(hv[j][0], hv[j][1]); w.y = cvtpk(hv[j][2], hv[j][3]); *reinterpret_cast<u32x2*>(hr + 4 * lane + 256 * j) = w; } }
        if (P.router) {
            float lg[8];
#pragma unroll
            for (int e = 0; e < 8; ++e) { float a = 0.f;
#pragma unroll
                for (int j = 0; j < 4; ++j) { const f32x4 w = *reinterpret_cast<const LAS f32x4*>(rwT + e * 1024 + 4 * lane + 256 * j); a += hv[j][0] * w[0] + hv[j][1] * w[1] + hv[j][2] * w[2] + hv[j][3] * w[3]; }
                lg[e] = wave_sum(a, lane); }
            int i0 = 0; float v0 = lg[0];
#pragma unroll
            for (int e = 1; e < 8; ++e) if (lg[e] > v0) { v0 = lg[e]; i0 = e; }
            int i1 = -1; float v1 = -3.4e38f;
#pragma unroll
            for (int e = 0; e < 8; ++e) if (e != i0 && lg[e] > v1) { v1 = lg[e]; i1 = e; }
            const float w0 = 1.f / (1.f + __expf(v1 - v0)), w1 = 1.f - w0;
            if (lane == 0) { const unsigned lp0 = __hip_atomic_fetch_add(lcnt + i0, 1u, __ATOMIC_RELAXED, __HIP_MEMORY_SCOPE_WORKGROUP), lp1 = __hip_atomic_fetch_add(lcnt + i1, 1u, __ATOMIC_RELAXED, __HIP_MEMORY_SCOPE_WORKGROUP);
                LAS int* rc = rec + li * 6; rc[0] = i0; rc[1] = (int)lp0; rc[2] = i1; rc[3] = (int)lp1; rc[4] = __float_as_int(w0); rc[5] = __float_as_int(w1); }
        }
    }
}
__device__ __forceinline__ void thin_phase(Frame& F, const ThinP& P) {
    const int lane = opaque(F.lane);
    const int nlat = P.nrows < RL ? P.nrows : RL, nctx = P.nrows - nlat;
    const int chL = (nlat + F.G - 1) / F.G, chC = (nctx + F.G - 1) / F.G;
    const int r0L = F.vcu * chL, r0C = F.vcu * chC;
    const int nl = r0L >= nlat ? 0 : (r0L + chL <= nlat ? chL : nlat - r0L), nc = r0C >= nctx ? 0 : (r0C + chC <= nctx ? chC : nctx - r0C), nrw = nl + nc;
#define TROW(li_) ((li_) < nl ? r0L + (li_) : RL + r0C + ((li_) - nl))
    LAS float* rwT = (LAS float*)F.lds;
    LAS int* rec = (LAS int*)(F.lds + 32768);
    LAS unsigned* lcnt = (LAS unsigned*)(F.lds + 65536);
    unsigned cb1 = 0, cb2 = 0, cb3 = 0, cb4 = 0, cb5 = 0, cb6 = 0, cb7 = 0;
    if (P.ymode == 2) { unsigned a = 0;
        a += (xb_ld(P.cnt + 0) + 255u) & ~255u; cb1 = a; a += (xb_ld(P.cnt + 1) + 255u) & ~255u; cb2 = a; a += (xb_ld(P.cnt + 2) + 255u) & ~255u; cb3 = a;
        a += (xb_ld(P.cnt + 3) + 255u) & ~255u; cb4 = a; a += (xb_ld(P.cnt + 4) + 255u) & ~255u; cb5 = a; a += (xb_ld(P.cnt + 5) + 255u) & ~255u; cb6 = a;
        a += (xb_ld(P.cnt + 6) + 255u) & ~255u; cb7 = a; }
    if (P.router) {
        for (int i = F.tid; i < 8192; i += 512) { const int col = i >> 3, e = i & 7; rwT[e * 1024 + col] = P.router[i]; }
        if (F.tid < 16) lcnt[F.tid] = 0u;
        __syncthreads();
    }
    LAS int* rtl = (LAS int*)(F.lds + 98304) + F.wave * 6 * 64;
    if (P.ymode == 2) { const int li_ = F.wave + 8 * lane;
        if (li_ < nrw) { const int* rt = P.route + (size_t)TROW(li_) * 8; const u32x4 a = *reinterpret_cast<const u32x4*>(rt); const u32x2 b = *reinterpret_cast<const u32x2*>(rt + 4);
            LAS int* d = rtl + lane * 6; d[0] = (int)a.x; d[1] = (int)a.y; d[2] = (int)a.z; d[3] = (int)a.w; d[4] = (int)b.x; d[5] = (int)b.y; }
        LDS_WAIT(); }
    f32x4 GA0 = {}, GA1 = {}, GA2 = {}, GA3 = {}, GB0 = {}, GB1 = {}, GB2 = {}, GB3 = {}, SH0 = {}, SH1 = {}, SH2 = {}, SH3 = {}; int cur_idx = -1;
#define TH_VEC(r_) do { const int ix_ = (r_) < RL ? ((r_) >> 12) : 8; if (ix_ != cur_idx) { cur_idx = ix_; \
        if (P.ymode) { const float* gt_ = P.gate + (size_t)ix_ * 6144 + 4 * lane; const float* ga_ = P.ga + 4 * lane; \
            GA0 = *reinterpret_cast<const f32x4*>(gt_) * *reinterpret_cast<const f32x4*>(ga_); GA1 = *reinterpret_cast<const f32x4*>(gt_ + 256) * *reinterpret_cast<const f32x4*>(ga_ + 256); \
            GA2 = *reinterpret_cast<const f32x4*>(gt_ + 512) * *reinterpret_cast<const f32x4*>(ga_ + 512); GA3 = *reinterpret_cast<const f32x4*>(gt_ + 768) * *reinterpret_cast<const f32x4*>(ga_ + 768); } \
        if (P.H) { const float* sh_ = P.shsc + (size_t)ix_ * 6144 + 4 * lane; const float* gb_ = P.gb + 4 * lane; \
            GB0 = *reinterpret_cast<const f32x4*>(gb_) * (*reinterpret_cast<const f32x4*>(sh_ + 1024) + 1.f); GB1 = *reinterpret_cast<const f32x4*>(gb_ + 256) * (*reinterpret_cast<const f32x4*>(sh_ + 1280) + 1.f); \
            GB2 = *reinterpret_cast<const f32x4*>(gb_ + 512) * (*reinterpret_cast<const f32x4*>(sh_ + 1536) + 1.f); GB3 = *reinterpret_cast<const f32x4*>(gb_ + 768) * (*reinterpret_cast<const f32x4*>(sh_ + 1792) + 1.f); \
            SH0 = *reinterpret_cast<const f32x4*>(sh_); SH1 = *reinterpret_cast<const f32x4*>(sh_ + 256); SH2 = *reinterpret_cast<const f32x4*>(sh_ + 512); SH3 = *reinterpret_cast<const f32x4*>(sh_ + 768); } } } while (0)
#define TH_VARGS GA0, GA1, GA2, GA3, GB0, GB1, GB2, GB3, SH0, SH1, SH2, SH3
    TH_DECL(A_); TH_DECL(B_);
    int li = F.wave;
    if (li < nrw) TH_LOAD(A_, TROW(li), 0);
    for (int it = 0; li < nrw; li += 16, it += 2) {
        const bool hb = li + 8 < nrw;
        if (hb) TH_LOAD(B_, TROW(li + 8), it + 1);
        TH_VEC(TROW(li)); thin_proc(P, TH_ARGS(A_), TH_VARGS, TROW(li), li, lane, rwT, rec, lcnt);
        if (li + 16 < nrw) TH_LOAD(A_, TROW(li + 16), it + 2);
        if (hb) { TH_VEC(TROW(li + 8)); thin_proc(P, TH_ARGS(B_), TH_VARGS, TROW(li + 8), li + 8, lane, rwT, rec, lcnt); }
    }
    if (P.router) {
        __syncthreads();
        if (F.tid < 8) lcnt[8 + F.tid] = __hip_atomic_fetch_add(P.cnt + F.tid, lcnt[F.tid], __ATOMIC_RELAXED, __HIP_MEMORY_SCOPE_AGENT);
        __syncthreads();
        for (int i = F.tid; i < nrw; i += 512) { const LAS int* rc = rec + i * 6; int* rt = P.route + (size_t)TROW(i) * 8;
            const int e0 = rc[0], e1 = rc[2];
            rt[0] = e0; rt[1] = rc[1] + (int)lcnt[8 + e0]; rt[2] = e1; rt[3] = rc[3] + (int)lcnt[8 + e1]; rt[4] = rc[4]; rt[5] = rc[5]; }
        VM_WAIT();
        for (int lb = F.wave; lb < nrw; lb += 32) {
            u32x4 v[4]; size_t s0[4], s1[4];
#pragma unroll
            for (int q = 0; q < 4; ++q) { const int lq = lb + 8 * q; const int r = TROW(lq); if (lq < nrw) { const LAS int* rc = rec + lq * 6; const int e0 = rc[0], e1 = rc[2];
                s0[q] = (size_t)e0 * RT + (size_t)(rc[1] + (int)lcnt[8 + e0]); s1[q] = (size_t)e1 * RT + (size_t)(rc[3] + (int)lcnt[8 + e1]);
                v[q] = *(reinterpret_cast<const u32x4*>((const unsigned char*)P.H + (size_t)r * DM) + lane); } }
#pragma unroll
            for (int q = 0; q < 4; ++q) { if (lb + 8 * q < nrw) {
                *(reinterpret_cast<u32x4*>(P.HSv + s0[q] * DM) + lane) = v[q]; *(reinterpret_cast<u32x4*>(P.HSv + s1[q] * DM) + lane) = v[q]; } }
        }
        __syncthreads();
    }
#undef TROW
#undef TH_VEC
#undef TH_VARGS
}

constexpr int NPHASE = 2 + DEPTH * 9;
__global__ void __launch_bounds__(512, 2) dit_fwd(Args args) {
    extern __shared__ __attribute__((aligned(16))) unsigned char lds[];
    Frame F;
    F.lds = (LAS unsigned char*)lds; F.ldsg = lds; F.MISC = (volatile LAS unsigned*)(F.lds + MISC_OFF);
    F.tid = threadIdx.x; F.lane = F.tid & 63; F.wave = __builtin_amdgcn_readfirstlane(F.tid >> 6);
    F.G = gridDim.x; { const int bx = blockIdx.x; F.vcu = (F.G % 8 == 0) ? (bx % 8) * (F.G / 8) + bx / 8 : bx; }
    F.ctl = (unsigned*)(args.ws + WS_CTL);
    for (int u = F.tid; u < (LDS_BYTES - RING_BYTES) / 4; u += 512) ((LAS unsigned*)(F.lds + RING_BYTES))[u] = 0u;
    __syncthreads();
    XcdBarrier bar = xcd_barrier_post(F.ctl + CW_BAR, F.MISC + 8);
    const int lo = args.ph_lo, hi = args.ph_hi;
    int ph = 0;
#define IN() (lo <= ph && ph < hi)
    unsigned long long wait_acc = 0, clk_c = 0, clk_r = 0;
#define CLK_BEG(sel) unsigned long long c0_ = 0, r0_ = 0; if (PROBE_CLK == (sel)) { c0_ = __builtin_amdgcn_s_memtime(); r0_ = __builtin_amdgcn_s_memrealtime(); }
#define CLK_END(sel) if (PROBE_CLK == (sel)) { clk_c += __builtin_amdgcn_s_memtime() - c0_; clk_r += __builtin_amdgcn_s_memrealtime() - r0_; }
#define SEAM() do { if (lo <= ph && ph + 1 < hi) { if (WAITPROBE) { const unsigned long long t0_ = __builtin_amdgcn_s_memrealtime(); xcd_barrier(bar); const unsigned long long dt_ = __builtin_amdgcn_s_memrealtime() - t0_; const int k_ = ph < 2 ? 9 + ph : (ph - 2) % 9; if ((WAITSEL >> k_) & 1u) wait_acc += dt_; } else xcd_barrier(bar); } ++ph; } while (0)
    GAS unsigned char* wsg = (GAS unsigned char*)args.ws;
#define WSP ((unsigned char*)wsg)
#define pMOD    ((float*)(WSP + WS_MOD))
#define pROPECS ((f32x2*)(WSP + WS_ROPE))
#define pWP     ((bf16_t*)(WSP + WS_WP))
#define pROUTE  ((int*)(WSP + WS_ROUTE))
#define pCS     ((bf16_t*)(WSP + WS_CS))
#define pCSC    ((bf16_t*)(WSP + WS_CSC))
#define pX      ((bf16_t*)(WSP + WS_X))
#define pH      ((bf16_t*)(WSP + WS_H))
#define pYO     ((bf16_t*)(WSP + WS_YO))
#define pZ      ((bf16_t*)(WSP + WS_Z))
#define pY      ((bf16_t*)(WSP + WS_Y))
#define pPQT    ((bf16_t*)(WSP + WS_PQT))
#define pPQTC   ((bf16_t*)(WSP + WS_PQTC))
#define pOB     ((bf16_t*)(WSP + WS_O))
#define pQK8    ((unsigned char*)(WSP + WS_QK8))
#define pVT8    ((unsigned char*)(WSP + WS_VT8))
#define pA2     ((bf16_t*)(WSP + WS_A2))
#define pA2M    ((bf16_t*)(WSP + WS_A2M))
#define pHS     ((bf16_t*)(WSP + WS_HS))
    const int vcu0 = F.vcu;
#define REFRAME() do { F.tid = opaque(threadIdx.x); F.lane = F.tid & 63; F.wave = __builtin_amdgcn_readfirstlane(F.tid >> 6); F.G = sopaque((int)gridDim.x); F.vcu = sopaque(vcu0); \
        wsg = gptr(args.ws); F.ctl = (unsigned*)(WSP + WS_CTL); } while (0)
    for (int rep0 = 0; rep0 < REP_P0; ++rep0)
    if (IN() && PH_ON(0)) { REFRAME();
        const int gw = F.vcu * 8 + F.wave, NGW = F.G * 8, gt = F.vcu * 512 + F.tid, NGT = F.G * 512;
        LAS float* ctab = (LAS float*)F.lds;
        LAS float* svec = (LAS float*)(F.lds + 16384);
        if (F.tid == 0) *(LAS unsigned*)(F.lds + 126976) = 0u;
        for (int i = F.tid; i < 4096; i += 512) ctab[i] = cospif((float)i * (1.f / 2048.f));
        for (int i = F.tid; i < 9 * 1024; i += 512) { const float v = i < 8192 ? args.c[i] : args.c_ctx[i - 8192]; svec[i] = v / (1.f + __expf(-v)); }
        __syncthreads();
        for (int i = gt; i < 4096 * 512; i += NGT) { const int k = i >> 9, l0 = (i & 511) * 8; float v[8];
#pragma unroll
            for (int e = 0; e < 8; ++e) { const int col = l0 + e; const int ph_ = (k * (col <= 2048 ? col : col - 2048)) & 4095; v[e] = col <= 2048 ? ctab[ph_] : -ctab[(ph_ - 1024) & 4095]; }
            *reinterpret_cast<u32x4*>(pCS + (size_t)k * FP + l0) = (u32x4){pk2(v[0], v[1]), pk2(v[2], v[3]), pk2(v[4], v[5]), pk2(v[6], v[7])}; }
        for (int i = gt; i < 256 * 64; i += NGT) { const int k = i >> 6, l0 = (i & 63) * 8; float v[8];
#pragma unroll
            for (int e = 0; e < 8; ++e) { const int col = l0 + e, l = col & 255; const int ph_ = (k * l * 16) & 4095; v[e] = col < 256 ? ctab[ph_] : -ctab[(ph_ - 1024) & 4095]; }
            *reinterpret_cast<u32x4*>(pCSC + (size_t)k * FP + l0) = (u32x4){pk2(v[0], v[1]), pk2(v[2], v[3]), pk2(v[4], v[5]), pk2(v[6], v[7])}; }
        for (int i = gt; i < 256 * 128; i += NGT) { const int row = i >> 7, c = i & 127, m = row & 127; const int ph_ = (m * c * 32) & 4095;
            const float v = row < 128 ? ctab[ph_] : ctab[(ph_ - 1024) & 4095]; pWP[i] = (bf16_t)f2bf(v); }
        for (int i = gt; i < 64 * 16; i += NGT) { const int pos = i >> 4, k = i & 15; const float inv = __powf(10000.f, -(float)(2 * k) / 32.f); float s, c; sincosf((float)pos * inv, &s, &c); pROPECS[i] = (f32x2){c, s}; }
        for (int task = F.vcu + F.wave * F.G; task < 512; task += 8 * F.G) { const int layer = task >> 7, col = (task & 127) * 48 + F.lane;
            if (F.lane < 48) {
            const float* w = args.ada_w + (size_t)layer * DM * 6144 + col;
            float a0 = 0, a1 = 0, a2 = 0, a3 = 0, a4 = 0, a5 = 0, a6 = 0, a7 = 0, a8 = 0;
            for (int k0 = 0; k0 < DM; k0 += 32) { float wv[32];
#pragma unroll
                for (int i = 0; i < 32; ++i) wv[i] = w[(size_t)(k0 + i) * 6144];
#pragma unroll
                for (int i = 0; i < 32; ++i) { const int k = k0 + i;
                    a0 += svec[k] * wv[i]; a1 += svec[1024 + k] * wv[i]; a2 += svec[2048 + k] * wv[i]; a3 += svec[3072 + k] * wv[i]; a4 += svec[4096 + k] * wv[i];
                    a5 += svec[5120 + k] * wv[i]; a6 += svec[6144 + k] * wv[i]; a7 += svec[7168 + k] * wv[i]; a8 += svec[8192 + k] * wv[i]; } }
            const float bb = args.ada_b[layer * 6144 + col]; float* mo = pMOD + (size_t)layer * 9 * 6144 + col;
            mo[0] = a0 + bb; mo[6144] = a1 + bb; mo[2 * 6144] = a2 + bb; mo[3 * 6144] = a3 + bb; mo[4 * 6144] = a4 + bb; mo[5 * 6144] = a5 + bb; mo[6 * 6144] = a6 + bb; mo[7 * 6144] = a7 + bb; mo[8 * 6144] = a8 + bb; } }
        LAS float* scr = (LAS float*)(F.lds + 57344 + F.wave * 8448);
        LAS unsigned* wcnt = (LAS unsigned*)(F.lds + 126976);
        constexpr int NITEMS = 2 * (16 * 40) + 2 * (16 * 32) + 2 * (16 * 96) + 2 * (16 * 32) + 2 * (16 * 176) + 2 * (44 * 32) + 16 * (16 * 224) + 16 * (56 * 32);
        for (;;) {
            const int n = __builtin_amdgcn_readfirstlane((int)__hip_atomic_fetch_add(wcnt, F.lane == 0 ? 1u : 0u, __ATOMIC_RELAXED, __HIP_MEMORY_SCOPE_WORKGROUP));
            const int it = ((n >> 3) * F.G + F.vcu) * 8 + (n & 7);
            if (it >= NITEMS) break;
            int r = it;
            if (transpose_job(r, args.mix_in_w, 2, DM, MIXIN, (bf16_t*)(WSP + WS_WMIXIN), false, false, scr, F.lane)) continue;
            if (transpose_job(r, args.mix_out_w, 2, DM, DM, (bf16_t*)(WSP + WS_WMIXOUT), false, false, scr, F.lane)) continue;
            if (transpose_job(r, args.diff_qkv_w, 2, DM, 3072, (bf16_t*)(WSP + WS_WQKV), false, true, scr, F.lane)) continue;
            if (transpose_job(r, args.diff_out_w, 2, DM, DM, (bf16_t*)(WSP + WS_WDOUT), false, false, scr, F.lane)) continue;
            if (transpose_job(r, args.ffn_in_w, 2, DM, 2 * FFN, (bf16_t*)(WSP + WS_WFFNIN), true, F8_DENSE, scr, F.lane)) continue;
            if (transpose_job(r, args.ffn_out_w, 2, FFN, DM, (bf16_t*)(WSP + WS_WFFNOUT), false, F8_DENSE || F8_DDOWN, scr, F.lane)) continue;
            if (transpose_job(r, args.expert_in_w, 16, DM, 2 * EDIM, (bf16_t*)(WSP + WS_WEXPIN), true, true, scr, F.lane)) continue;
            transpose_job(r, args.expert_out_w, 16, EDIM, DM, (bf16_t*)(WSP + WS_WEXPOUT), false, true, scr, F.lane);
        }
        __syncthreads();
    }
    SEAM();
    if (IN() && PH_ON(1)) { REFRAME();
        ThinP P{}; P.nrows = RT; P.xin_lat = args.x; P.xin_ctx = args.ctx; P.ymode = 0; P.H = pH; P.gb = args.norm_g; P.shsc = pMOD;
        for (int rep = 0; rep < REP_P0B; ++rep) thin_phase(F, P);
        for (int rep = 0; rep < EXTRA_BARS; ++rep) xcd_barrier(bar);
    }
    SEAM();

    for (int layer = 0; layer < DEPTH; ++layer) {
        const int j = layer >> 1; const bool even = !(layer & 1), lastl = layer == DEPTH - 1;
        const float* modl = pMOD + (size_t)layer * 9 * 6144; const float* ng = args.norm_g + (size_t)layer * 4 * DM;
        const int Mrows = lastl ? RL : RT;
        if (IN() && PH_ON(2)) { REFRAME();
            pg8::Dims d{DM, DM}; SchedDense S;
            if (even) { S.init(pH, DM, (bf16_t*)(WSP + WS_WMIXIN) + (size_t)j * MIXIN * DM, DM, RT, MIXIN, DM, F.G, (int)blockIdx.x);
                EpiRope<false> E{WSP}; for (int rep = 0; rep < REP_PROJ; ++rep) pg8::gemm_phase(F.lds, d, S, E); }
            else { const unsigned char* wq = (const unsigned char*)(WSP + WS_WQKV) + (size_t)j * 3072 * DM;
                pg8::Dims d8{DM / 2, DM / 2};
                S.init(pH, DM / 2, wq, DM / 2, RT, 2048, DM / 2, F.G, (int)blockIdx.x);
                EpiRope<true> E{WSP}; for (int rep = 0; rep < REP_PROJ; ++rep) pg8::gemm_phase<EpiRope<true>, SchedDense, true>(F.lds, d8, S, E);
                SchedDense S2; S2.init(wq + (size_t)2048 * DM, DM / 2, pH, DM / 2, DM, RT, DM / 2, F.G, (int)((blockIdx.x + 3 * (gridDim.x / 4)) % gridDim.x));
                EpiVt E2{WSP}; for (int rep = 0; rep < REP_PROJ; ++rep) pg8::gemm_phase<EpiVt, SchedDense, true>(F.lds, d8, S2, E2); }
        }
        SEAM();
        if (IN() && PH_ON(3)) { REFRAME();
            if (even) {
                if (PH_ON(16)) { pg8::Dims d{128, MIXIN}; SchedF1 S{(const char*)pWP, (const char*)pZ, F.G, F.vcu}; EpiPQt E{pPQT, pPQTC}; for (int rep = 0; rep < REP_FOUR; ++rep) pg8::gemm_phase(F.lds, d, S, E); }
            } else {
                const float* lv = args.diff_lambda + j * 256;
                const int ln = opaque(F.lane); const float s01 = wave_sum(lv[ln] * lv[64 + ln], ln), s23 = wave_sum(lv[128 + ln] * lv[192 + ln], ln);
                const float lam_init = 0.8f - 0.6f * __expf(-0.3f * (float)layer);
                const float lam = __expf(s01) - __expf(s23) + lam_init;
                const float* subg = args.diff_subln_g + j * 128;
                const int nu = lastl ? 2048 : 2048 + 128;
                CLK_BEG(1)
                for (int rep = 0; rep < REP_DIFF; ++rep)
                for (int u = F.vcu; u < (PH_ON(18) ? nu : 0); u += F.G) {
                    if (u < 2048) diff_attn_unit((char*)lds, pVT8, pQK8, pOB, subg, lam, 1.f - lam_init, u >> 8, (u >> 5) & 7, u & 31, false);
                    else { const int v = u - 2048; diff_attn_unit((char*)lds, pVT8, pQK8, pOB, subg, lam, 1.f - lam_init, v >> 4, (v >> 1) & 7, v & 1, true); }
                }
                __syncthreads();
                CLK_END(1)
            }
        }
        SEAM();
        if (IN() && PH_ON(4)) { REFRAME();
            if (even) { pg8::Dims d{FP, FP}; SchedF2 S{(const char*)pCS, (const char*)pCSC, (const char*)pPQT, (const char*)pPQTC, F.G, F.vcu}; EpiFour2 E{pY}; for (int rep = 0; rep < REP_FOUR; ++rep) pg8::gemm_phase<EpiFour2, SchedF2, false>(F.lds, d, S, E);
                const float* sink = args.win_sink + j * 8;
                for (int rep = 0; rep < REP_WIN; ++rep)
                for (int u = F.vcu; u < (PH_ON(17) ? 1024 + 64 : 0); u += F.G) {
                    if (u < 1024) win_attn_unit2((char*)lds, pZ, pY, sink, u >> 7, (u >> 6) & 1, u & 63, false);
                    else { const int v = u - 1024; win_attn_unit2((char*)lds, pZ, pY, sink, v >> 3, (v >> 2) & 1, v & 3, true); }
                }
                __syncthreads();
            }
        }
        if (even) SEAM(); else ++ph;
        if (IN() && PH_ON(5)) { REFRAME();
            pg8::Dims d{DM, DM}; SchedDense S;
            S.init(even ? pY : pOB, DM, (bf16_t*)(WSP + (even ? WS_WMIXOUT : WS_WDOUT)) + (size_t)j * DM * DM, DM, Mrows, DM, DM, F.G, (int)blockIdx.x);
            CLK_BEG(4)
            EpiStore E{pYO, DM, 1.f}; for (int rep = 0; rep < REP_PROJ; ++rep) pg8::gemm_phase(F.lds, d, S, E);
            CLK_END(4)
        }
        SEAM();
        if (IN() && PH_ON(6)) { REFRAME();
            ThinP P{}; P.nrows = Mrows; P.xin16 = layer != 0; P.xout16 = true;
            if (layer == 0) { P.xin_lat = args.x; P.xin_ctx = args.ctx; } else { P.xin_lat = pX; P.xin_ctx = pX + (size_t)RL * DM; }
            P.xout_lat = pX; P.xout_ctx = pX + (size_t)RL * DM; P.ymode = 1; P.Ysrc = pYO; P.gate = modl + 2048; P.ga = ng + DM;
            P.H = pH; P.h8 = !even || F8_DENSE; P.gb = ng + 2 * DM; P.shsc = modl + 3072;
            if (!even) { P.router = args.router_w + (size_t)j * DM * 8; P.route = pROUTE; P.cnt = F.ctl + CW_CNT + 16 * j; P.HSv = (unsigned char*)pHS; }
            thin_phase(F, P);
        }
        SEAM();
        unsigned c0 = 0, c1 = 0, c2 = 0, c3 = 0, c4 = 0, c5 = 0, c6 = 0, c7 = 0;
        if (!even) { unsigned* cn = F.ctl + CW_CNT + 16 * j; unsigned a = 0;
            c0 = 0; a += (rfl(xb_ld(cn + 0)) + 255u) & ~255u; c1 = a; a += (rfl(xb_ld(cn + 1)) + 255u) & ~255u; c2 = a; a += (rfl(xb_ld(cn + 2)) + 255u) & ~255u; c3 = a;
            a += (rfl(xb_ld(cn + 3)) + 255u) & ~255u; c4 = a; a += (rfl(xb_ld(cn + 4)) + 255u) & ~255u; c5 = a; a += (rfl(xb_ld(cn + 5)) + 255u) & ~255u; c6 = a;
            a += (rfl(xb_ld(cn + 6)) + 255u) & ~255u; c7 = a; a += (rfl(xb_ld(cn + 7)) + 255u) & ~255u; c0 = a; }
        ++ph;
        if (IN() && PH_ON(8)) { REFRAME();
            const bool f8 = !even || F8_DENSE; const int eb = f8 ? 1 : 2;
            pg8::Dims d{DM * eb / 2, DM * eb / 2}; SchedGroup S;
            if (even) { S.A = (const char*)pH; S.B = (const char*)(WSP + WS_WFFNIN) + (size_t)j * 2 * FFN * DM * eb; S.nRT = RT / 256; S.P1 = S.P2 = S.P3 = S.P4 = S.P5 = S.P6 = S.P7 = 1 << 30; S.nN = 2 * FFN / 256; S.gB = 0; S.aE = 0; }
            else { S.aE = (size_t)RT * DM; S.A = (const char*)pHS; S.B = (const char*)(WSP + WS_WEXPIN) + (size_t)j * NEXP * 2 * EDIM * DM; S.nRT = (int)(c0 >> 8);
                S.P1 = (int)(c1 >> 8); S.P2 = (int)(c2 >> 8); S.P3 = (int)(c3 >> 8); S.P4 = (int)(c4 >> 8); S.P5 = (int)(c5 >> 8); S.P6 = (int)(c6 >> 8); S.P7 = (int)(c7 >> 8);
                S.nN = 2 * EDIM / 256; S.gB = (size_t)2 * EDIM * DM; }
            S.nwg = S.nRT * S.nN; S.G = F.G; S.c = (int)blockIdx.x; S.nkt = DM * eb / 128; S.tA = (size_t)256 * DM * eb; S.tB = (size_t)256 * DM * eb;
            CLK_BEG(even ? 2 : 3)
            if (f8) { EpiSwiglu<true> E{(unsigned char*)(even ? pA2 : pA2M), even ? FFN : EDIM, 1.f / (F8_SH * F8_SW)}; for (int rep = 0; rep < REP_MOE; ++rep) pg8::gemm_phase<EpiSwiglu<true>, SchedGroup, true, ALIGN_SWIGLU>(F.lds, d, S, E); }
            else if (F8_DDOWN) { EpiSwiglu<true> E{(unsigned char*)pA2, FFN, 1.f}; for (int rep = 0; rep < REP_MOE; ++rep) pg8::gemm_phase<EpiSwiglu<true>, SchedGroup, false>(F.lds, d, S, E); }
            else { EpiSwiglu<false> E{(unsigned char*)pA2, FFN, 1.f}; for (int rep = 0; rep < REP_MOE; ++rep) pg8::gemm_phase<EpiSwiglu<false>, SchedGroup, false>(F.lds, d, S, E); }
            CLK_END(even ? 2 : 3)
        }
        SEAM();
        if (IN() && PH_ON(9)) { REFRAME();
            const bool f8 = !even || F8_DENSE || F8_DDOWN; const int eb = f8 ? 1 : 2;
            const int Kh = even ? FFN : EDIM; pg8::Dims d{Kh * eb / 2, Kh * eb / 2}; SchedGroup S;
            if (even) { S.A = (const char*)pA2; S.B = (const char*)(WSP + WS_WFFNOUT) + (size_t)j * DM * FFN * eb; S.nRT = RT / 256; S.P1 = S.P2 = S.P3 = S.P4 = S.P5 = S.P6 = S.P7 = 1 << 30; S.gB = 0; }
            else { S.A = (const char*)pA2M; S.B = (const char*)(WSP + WS_WEXPOUT) + (size_t)j * NEXP * DM * EDIM; S.nRT = (int)(c0 >> 8);
                S.P1 = (int)(c1 >> 8); S.P2 = (int)(c2 >> 8); S.P3 = (int)(c3 >> 8); S.P4 = (int)(c4 >> 8); S.P5 = (int)(c5 >> 8); S.P6 = (int)(c6 >> 8); S.P7 = (int)(c7 >> 8);
                S.gB = (size_t)DM * EDIM; }
            S.aE = 0; S.nN = DM / 256; S.nwg = S.nRT * S.nN; S.G = F.G; S.c = (int)blockIdx.x; S.nkt = Kh * eb / 128; S.tA = (size_t)256 * Kh * eb; S.tB = (size_t)256 * Kh * eb;
            if (f8) { EpiStore E{even ? pYO : pHS, DM, 1.f / (F8_SA * F8_SW)}; for (int rep = 0; rep < REP_MOE; ++rep) pg8::gemm_phase<EpiStore, SchedGroup, true>(F.lds, d, S, E); }
            else { EpiStore E{pYO, DM, 1.f}; for (int rep = 0; rep < REP_MOE; ++rep) pg8::gemm_phase<EpiStore, SchedGroup, false>(F.lds, d, S, E); }
        }
        SEAM();
        if (IN() && PH_ON(10)) { REFRAME();
            ThinP P{}; P.nrows = Mrows; P.xin16 = true; P.xout16 = !lastl; P.xin_lat = pX; P.xin_ctx = pX + (size_t)RL * DM;
            if (lastl) P.xout_lat = args.out; else P.xout_lat = pX;
            P.xout_ctx = pX + (size_t)RL * DM; P.ymode = even ? 1 : 2; P.Ysrc = even ? pYO : pHS; P.gate = modl + 5120; P.ga = ng + 3 * DM;
            P.route = pROUTE; P.cnt = F.ctl + CW_CNT + 16 * j;
            if (!lastl) { P.H = pH; P.h8 = even; P.gb = ng + 4 * DM; P.shsc = modl + 9 * 6144; }
            thin_phase(F, P);
        }
        SEAM();
    }
    if (PROBE_CLK) {
        const unsigned long long dur_ = clk_r ? clk_c * 5000ull / clk_r : 0ull, t0_ = __builtin_amdgcn_s_memrealtime();
        while (__builtin_amdgcn_s_memrealtime() - t0_ < dur_) __builtin_amdgcn_s_sleep(8);
    }
    if (WAITPROBE) {
        unsigned* wsum = F.ctl + 48;
        if (threadIdx.x == 0) __hip_atomic_fetch_add(wsum, (unsigned)wait_acc, __ATOMIC_RELAXED, __HIP_MEMORY_SCOPE_AGENT);
        xcd_barrier(bar);
        const unsigned mean = xb_ld(wsum) / gridDim.x; const unsigned long long t0_ = __builtin_amdgcn_s_memrealtime();
        while (__builtin_amdgcn_s_memrealtime() - t0_ < (unsigned long long)mean * WAITPROBE) __builtin_amdgcn_s_sleep(8);
    }
#undef IN
#undef SEAM
#undef REFRAME
}

#ifndef MK_PER_PHASE
#define MK_PER_PHASE 0
#endif
extern "C" void kernel_launch(void* const* d_in, const int* in_sizes, int n_in, void* d_out, int out_size, void* d_ws, size_t ws_size, hipStream_t stream) {
    static int grid = 0;
    if (grid == 0) {
        if (n_in != 19 || in_sizes[0] != RL * DM || out_size != RL * DM || ws_size < WS_END) {
            fprintf(stderr, "kernel_launch: unexpected shapes / workspace (n_in %d in0 %d out %d ws %zu need %zu)\n", n_in, n_in > 0 ? in_sizes[0] : -1, out_size, ws_size, (size_t)WS_END); grid = -1; return; }
        int dev = 0, cus = 0, per_cu = 0;
        if (hipGetDevice(&dev) != hipSuccess || hipDeviceGetAttribute(&cus, hipDeviceAttributeMultiprocessorCount, dev) != hipSuccess) { grid = -1; return; }
        if (hipFuncSetAttribute((const void*)dit_fwd, hipFuncAttributeMaxDynamicSharedMemorySize, LDS_BYTES) != hipSuccess) { fprintf(stderr, "kernel_launch: hipFuncSetAttribute failed\n"); grid = -1; return; }
        if (hipOccupancyMaxActiveBlocksPerMultiprocessor(&per_cu, (const void*)dit_fwd, 512, LDS_BYTES) != hipSuccess || per_cu < 1)
            fprintf(stderr, "kernel_launch: occupancy query reports %d\n", per_cu);
        (void)hipGetLastError();
        grid = cus;
    }
    if (grid < 0) return;
    if (hipMemsetAsync((char*)d_ws + WS_CTL, 0, CTL_BYTES, stream) != hipSuccess) return;
    Args a{};
    const float** ap = (const float**)&a;
    for (int i = 0; i < 19; ++i) ap[i] = (const float*)d_in[i];
    a.out = (float*)d_out; a.ws = (unsigned char*)d_ws;
#if MK_PER_PHASE
    for (int p = 0; p < NPHASE; ++p) { a.ph_lo = p; a.ph_hi = p + 1; hipLaunchKernelGGL(dit_fwd, dim3(grid), dim3(512), LDS_BYTES, stream, a); }
#else
    a.ph_lo = 0; a.ph_hi = NPHASE;
    hipLaunchKernelGGL(dit_fwd, dim3(grid), dim3(512), LDS_BYTES, stream, a);
#endif
}
```
